# Optimizing an MI355X kernel written in HIP

```python
import math
import jax, jax.numpy as jnp
from jax import lax
import numpy as np

D_MODEL = 1024
BATCH = 8
SEQ = 2048
DEPTH = 4

CHUNK = 64
N_MIXERS = 2
N_SSD_LAYERS = (DEPTH + 1) // 2
N_ATTN_LAYERS = DEPTH // 2
EPS = 1e-6

SSD_EXPAND = 2
SSD_D_INNER = SSD_EXPAND * D_MODEL
SSD_HEAD_DIM = 64
SSD_HEADS = SSD_D_INNER // SSD_HEAD_DIM
SSD_GROUPS = 4
SSD_HEADS_PER_GROUP = SSD_HEADS // SSD_GROUPS
SSD_STATE = 128
SSD_CONV = 4
SSD_CONV_CH = SSD_D_INNER + 2 * SSD_GROUPS * SSD_STATE
SSD_IN = SSD_D_INNER + SSD_CONV_CH + SSD_HEADS

ATTN_HEADS = 8
ATTN_HEAD_DIM = D_MODEL // ATTN_HEADS // 2
ATTN_V_DIM = 2 * ATTN_HEAD_DIM
ATTN_IN = 3 * D_MODEL
ROPE_THETA = 500000.0
ROPE_DIM = ATTN_HEAD_DIM // 4
Q_BLOCK = 128

D_FF = 2816
FFN_CONV = 3

kernel_name = "hybrid_ssd_diffattn_convffn_trunk"


def rmsnorm(x, g):
    xf = x.astype(jnp.float32)
    y = xf * lax.rsqrt(jnp.mean(xf * xf, axis=-1, keepdims=True) + EPS)
    return (y * g).astype(x.dtype)


def causal_dwconv(x, w, b):
    k_width = w.shape[0]
    s = x.shape[1]
    xp = jnp.pad(x, ((0, 0), (k_width - 1, 0), (0, 0)))
    y = b
    for k in range(k_width):
        y = y + w[k] * xp[:, k:k + s]
    return y


def rope_tables(positions):
    inv_freq = ROPE_THETA ** (-jnp.arange(0, ROPE_DIM, 2, dtype=jnp.float32) / ROPE_DIM)
    ang = positions.astype(jnp.float32)[..., None] * inv_freq
    return jnp.cos(ang), jnp.sin(ang)


def apply_partial_rope(t, cos, sin):
    half = ROPE_DIM // 2
    c = cos[:, :, None, None, :]
    s = sin[:, :, None, None, :]
    tf = t.astype(jnp.float32)
    x1, x2, rest = tf[..., :half], tf[..., half:ROPE_DIM], tf[..., ROPE_DIM:]
    out = jnp.concatenate([x1 * c - x2 * s, x2 * c + x1 * s, rest], axis=-1)
    return out.astype(t.dtype)


def ssd_mixer(xn, in_w, conv_w, conv_b, dt_bias, a_log, d_skip, norm_g, out_w):
    b, s, _ = xn.shape
    nc = s // CHUNK
    G, R, P, N = SSD_GROUPS, SSD_HEADS_PER_GROUP, SSD_HEAD_DIM, SSD_STATE
    proj = xn @ in_w
    z = proj[..., :SSD_D_INNER]
    xbc = proj[..., SSD_D_INNER:SSD_D_INNER + SSD_CONV_CH]
    dt = proj[..., SSD_D_INNER + SSD_CONV_CH:]
    xbc = jax.nn.silu(causal_dwconv(xbc, conv_w, conv_b))
    xs = xbc[..., :SSD_D_INNER].reshape(b, nc, CHUNK, G, R, P)
    Bm = xbc[..., SSD_D_INNER:SSD_D_INNER + G * N].reshape(b, nc, CHUNK, G, N)
    Cm = xbc[..., SSD_D_INNER + G * N:].reshape(b, nc, CHUNK, G, N)
    dt = jax.nn.softplus(dt + dt_bias).reshape(b, nc, CHUNK, G, R)
    a = -jnp.exp(a_log).reshape(G, R)
    dA = (dt * a).transpose(0, 3, 4, 1, 2)
    x_dt = xs * dt[..., None]
    a_cs = jnp.cumsum(dA, axis=-1)
    seg = a_cs[..., :, None] - a_cs[..., None, :]
    tril = jnp.tril(jnp.ones((CHUNK, CHUNK), dtype=bool))
    lmat = jnp.where(tril, jnp.exp(jnp.where(tril, seg, -jnp.inf)), 0.0)
    cb = jnp.einsum("bclgn,bcsgn->bgcls", Cm, Bm)
    y_diag = jnp.einsum("bgrcls,bcsgrp->bclgrp", cb[:, :, None] * lmat, x_dt)
    decay = jnp.exp(a_cs[..., -1:] - a_cs)
    states = jnp.einsum("bclgn,bgrcl,bclgrp->cbgrpn", Bm, decay, x_dt)
    chunk_decay = jnp.exp(a_cs[..., -1]).transpose(3, 0, 1, 2)

    def step(h, inp):
        st, dec = inp
        return dec[..., None, None] * h + st, h

    _, h_in = lax.scan(step, jnp.zeros_like(states[0]), (states, chunk_decay))
    y_off = jnp.einsum("bclgn,cbgrpn,bgrcl->bclgrp", Cm, h_in, jnp.exp(a_cs))
    y = y_diag + y_off + xs * d_skip.reshape(G, R)[:, :, None]
    y = y.reshape(b, s, SSD_D_INNER)
    yg = (y * jax.nn.silu(z)).reshape(b, s, G, SSD_D_INNER // G)
    yg = rmsnorm(yg, 1.0).reshape(b, s, SSD_D_INNER) * norm_g
    return yg.astype(xn.dtype) @ out_w


def diff_attention(xn, cos, sin, in_w, q_norm_g, k_norm_g, lq1, lk1, lq2, lk2,
                   subln_g, out_w, lambda_init):
    b, s, _ = xn.shape
    H, HD = ATTN_HEADS, ATTN_HEAD_DIM
    proj = xn @ in_w
    q = proj[..., :D_MODEL].reshape(b, s, H, 2, HD)
    k = proj[..., D_MODEL:2 * D_MODEL].reshape(b, s, H, 2, HD)
    v = proj[..., 2 * D_MODEL:].reshape(b, s, H, ATTN_V_DIM)
    q = apply_partial_rope(rmsnorm(q, q_norm_g), cos, sin)
    k = apply_partial_rope(rmsnorm(k, k_norm_g), cos, sin)
    lam = (jnp.exp(jnp.sum(lq1.astype(jnp.float32) * lk1.astype(jnp.float32)))
           - jnp.exp(jnp.sum(lq2.astype(jnp.float32) * lk2.astype(jnp.float32)))
           + lambda_init)
    scale = 1.0 / math.sqrt(HD)
    outs = []
    for blk in range(s // Q_BLOCK):
        q0, q1 = blk * Q_BLOCK, (blk + 1) * Q_BLOCK
        qb = q[:, q0:q1]
        kc = k[:, :q1]
        vc = v[:, :q1]
        sc = jnp.einsum("bqhcd,bkhcd->bhcqk", qb, kc).astype(jnp.float32) * scale
        q_chunk = (q0 + jnp.arange(Q_BLOCK)) // CHUNK
        k_chunk = jnp.arange(q1) // CHUNK
        allowed = k_chunk[None, :] <= q_chunk[:, None]
        sc = jnp.where(allowed, sc, -jnp.inf)
        p = jax.nn.softmax(sc, axis=-1)
        attn = p[:, :, 0] - lam * p[:, :, 1]
        outs.append(jnp.einsum("bhqk,bkhe->bqhe", attn.astype(v.dtype), vc))
    o = jnp.concatenate(outs, axis=1)
    o = rmsnorm(o, subln_g) * (1.0 - lambda_init)
    return o.reshape(b, s, H * ATTN_V_DIM).astype(xn.dtype) @ out_w


def conv_ffn(xn, up_w, conv_w, conv_b, down_w):
    h = causal_dwconv(xn @ up_w, conv_w, conv_b)
    g, u = h[..., :D_FF], h[..., D_FF:]
    return (jax.nn.silu(g) * u) @ down_w


def setup_inputs(seed: int = 0) -> dict:
    key = jax.random.key(seed)
    ks = jax.random.split(key, 32)
    f32 = jnp.float32

    def nrm(k, shape, std):
        return jax.random.normal(k, shape, f32) * std

    def gain(k, shape):
        return 1.0 + 0.05 * jax.random.normal(k, shape, f32)

    out_scale = 1.0 / math.sqrt(2 * DEPTH)
    x = jax.random.normal(ks[0], (BATCH, SEQ, D_MODEL), f32)
    start = jax.random.randint(ks[1], (BATCH,), 0, 64) * CHUNK
    positions = (start[:, None] + jnp.arange(SEQ)[None, :]).astype(jnp.int32)
    dt0 = jnp.exp(jax.random.uniform(ks[6], (N_SSD_LAYERS, SSD_HEADS), f32,
                                     math.log(0.001), math.log(0.1)))
    return {
        "x": x,
        "positions": positions,
        "norm_mix_g": gain(ks[2], (DEPTH, D_MODEL)),
        "norm_ffn_g": gain(ks[3], (DEPTH, D_MODEL)),
        "ssd_in_w": nrm(ks[4], (N_SSD_LAYERS, D_MODEL, SSD_IN), D_MODEL ** -0.5),
        "ssd_conv_w": nrm(ks[5], (N_SSD_LAYERS, SSD_CONV, SSD_CONV_CH), SSD_CONV ** -0.5),
        "ssd_conv_b": nrm(ks[7], (N_SSD_LAYERS, SSD_CONV_CH), 0.02),
        "ssd_dt_bias": dt0 + jnp.log(-jnp.expm1(-dt0)),
        "ssd_a_log": jnp.log(jax.random.uniform(ks[8], (N_SSD_LAYERS, SSD_HEADS), f32, 1.0, 16.0)),
        "ssd_d": gain(ks[9], (N_SSD_LAYERS, SSD_HEADS)),
        "ssd_norm_g": gain(ks[10], (N_SSD_LAYERS, SSD_D_INNER)),
        "ssd_out_w": nrm(ks[11], (N_SSD_LAYERS, SSD_D_INNER, D_MODEL), SSD_D_INNER ** -0.5 * out_scale),
        "attn_in_w": nrm(ks[12], (N_ATTN_LAYERS, D_MODEL, ATTN_IN), D_MODEL ** -0.5),
        "attn_q_norm_g": gain(ks[13], (N_ATTN_LAYERS, ATTN_HEAD_DIM)),
        "attn_k_norm_g": gain(ks[14], (N_ATTN_LAYERS, ATTN_HEAD_DIM)),
        "attn_lq1": nrm(ks[15], (N_ATTN_LAYERS, ATTN_HEAD_DIM), 0.1),
        "attn_lk1": nrm(ks[16], (N_ATTN_LAYERS, ATTN_HEAD_DIM), 0.1),
        "attn_lq2": nrm(ks[17], (N_ATTN_LAYERS, ATTN_HEAD_DIM), 0.1),
        "attn_lk2": nrm(ks[18], (N_ATTN_LAYERS, ATTN_HEAD_DIM), 0.1),
        "attn_subln_g": gain(ks[19], (N_ATTN_LAYERS, ATTN_V_DIM)),
        "attn_out_w": nrm(ks[20], (N_ATTN_LAYERS, D_MODEL, D_MODEL), D_MODEL ** -0.5 * out_scale),
        "ffn_up_w": nrm(ks[21], (DEPTH, D_MODEL, 2 * D_FF), D_MODEL ** -0.5),
        "ffn_conv_w": nrm(ks[22], (DEPTH, FFN_CONV, 2 * D_FF), FFN_CONV ** -0.5),
        "ffn_conv_b": nrm(ks[23], (DEPTH, 2 * D_FF), 0.02),
        "ffn_down_w": nrm(ks[24], (DEPTH, D_FF, D_MODEL), D_FF ** -0.5 * out_scale),
    }


def reference(x, positions, norm_mix_g, norm_ffn_g,
              ssd_in_w, ssd_conv_w, ssd_conv_b, ssd_dt_bias, ssd_a_log, ssd_d,
              ssd_norm_g, ssd_out_w,
              attn_in_w, attn_q_norm_g, attn_k_norm_g, attn_lq1, attn_lk1,
              attn_lq2, attn_lk2, attn_subln_g, attn_out_w,
              ffn_up_w, ffn_conv_w, ffn_conv_b, ffn_down_w):
    cos, sin = rope_tables(positions)
    for i in range(DEPTH):
        j = i // N_MIXERS
        h = rmsnorm(x, norm_mix_g[i])
        if i % N_MIXERS == 0:
            x = x + ssd_mixer(h, ssd_in_w[j], ssd_conv_w[j], ssd_conv_b[j],
                              ssd_dt_bias[j], ssd_a_log[j], ssd_d[j],
                              ssd_norm_g[j], ssd_out_w[j])
        else:
            lambda_init = 0.8 - 0.6 * math.exp(-0.3 * i)
            x = x + diff_attention(h, cos, sin, attn_in_w[j], attn_q_norm_g[j],
                                   attn_k_norm_g[j], attn_lq1[j], attn_lk1[j],
                                   attn_lq2[j], attn_lk2[j], attn_subln_g[j],
                                   attn_out_w[j], lambda_init)
        h = rmsnorm(x, norm_ffn_g[i])
        x = x + conv_ffn(h, ffn_up_w[i], ffn_conv_w[i], ffn_conv_b[i], ffn_down_w[i])
    return x
```

```cpp
#include <hip/hip_runtime.h>
#include <stdint.h>
#include <math.h>
namespace nv {
constexpr int DM = 1024, NB = 8, SQ = 2048, MT = NB * SQ;
constexpr int SSD_DI = 2048, SSD_CC = 3072, SSD_IN = 5152, SSD_H = 32, SSD_G = 4, SSD_N = 128, SSD_P = 64;
constexpr int AT_H = 8, AT_HD = 64, AT_V = 128, AT_IN = 3072;
constexpr int DFF = 2816;
constexpr float EPSN = 1e-6f;
constexpr int RC = 4096;

__device__ __forceinline__ float wsum(float v) {
#pragma unroll
    for (int o = 1; o < 64; o <<= 1) v += __shfl_xor(v, o);
    return v;
}
__device__ __forceinline__ float silu_f(float v) { return v / (1.0f + expf(-v)); }

__global__ void __launch_bounds__(256) k_rmsnorm(const float* __restrict__ x, const float* __restrict__ g, float* __restrict__ o, int rows) {
    const int row = blockIdx.x * 4 + (threadIdx.x >> 6), lane = threadIdx.x & 63;
    if (row >= rows) return;
    const float4* xr = (const float4*)(x + (size_t)row * DM);
    float4 v[4]; float s = 0.f;
#pragma unroll
    for (int j = 0; j < 4; ++j) { v[j] = xr[lane + 64 * j]; s += v[j].x * v[j].x + v[j].y * v[j].y + v[j].z * v[j].z + v[j].w * v[j].w; }
    s = wsum(s);
    const float r = 1.0f / sqrtf(s * (1.0f / DM) + EPSN);
    float4* orow = (float4*)(o + (size_t)row * DM);
#pragma unroll
    for (int j = 0; j < 4; ++j) { const float4 gg = ((const float4*)g)[lane + 64 * j]; float4 w; w.x = v[j].x * r * gg.x; w.y = v[j].y * r * gg.y; w.z = v[j].z * r * gg.z; w.w = v[j].w * r * gg.w; orow[lane + 64 * j] = w; }
}

__global__ void __launch_bounds__(256) k_gemm(const float* __restrict__ A, const float* __restrict__ B, float* C, const float* R, int M, int N, int K, int lda, int ldb, int ldc) {
    __shared__ float As[8][132];
    __shared__ float Bs[8][132];
    const int tid = threadIdx.x, ty = tid >> 4, tx = tid & 15;
    const int bm = blockIdx.y * 128, bn = blockIdx.x * 128;
    float acc[8][8];
#pragma unroll
    for (int i = 0; i < 8; ++i)
#pragma unroll
        for (int j = 0; j < 8; ++j) acc[i][j] = 0.f;
    const int arow = tid >> 1, akk = (tid & 1) * 4, bkr = tid >> 5, bnn = (tid & 31) * 4;
    for (int k0 = 0; k0 < K; k0 += 8) {
        const float4 a = *(const float4*)(A + (size_t)(bm + arow) * lda + k0 + akk);
        float4 b = make_float4(0.f, 0.f, 0.f, 0.f);
        if (bn + bnn < N) b = *(const float4*)(B + (size_t)(k0 + bkr) * ldb + bn + bnn);
        __syncthreads();
        As[akk + 0][arow] = a.x; As[akk + 1][arow] = a.y; As[akk + 2][arow] = a.z; As[akk + 3][arow] = a.w;
        *(float4*)&Bs[bkr][bnn] = b;
        __syncthreads();
#pragma unroll
        for (int kk = 0; kk < 8; ++kk) {
            float av[8], bv[8];
            const float4 a0 = *(const float4*)&As[kk][ty * 8], a1 = *(const float4*)&As[kk][ty * 8 + 4];
            const float4 b0 = *(const float4*)&Bs[kk][tx * 8], b1 = *(const float4*)&Bs[kk][tx * 8 + 4];
            av[0] = a0.x; av[1] = a0.y; av[2] = a0.z; av[3] = a0.w; av[4] = a1.x; av[5] = a1.y; av[6] = a1.z; av[7] = a1.w;
            bv[0] = b0.x; bv[1] = b0.y; bv[2] = b0.z; bv[3] = b0.w; bv[4] = b1.x; bv[5] = b1.y; bv[6] = b1.z; bv[7] = b1.w;
#pragma unroll
            for (int i = 0; i < 8; ++i)
#pragma unroll
                for (int j = 0; j < 8; ++j) acc[i][j] = fmaf(av[i], bv[j], acc[i][j]);
        }
    }
#pragma unroll
    for (int i = 0; i < 8; ++i) {
        const size_t ro = (size_t)(bm + ty * 8 + i) * ldc;
#pragma unroll
        for (int j4 = 0; j4 < 2; ++j4) {
            const int col = bn + tx * 8 + j4 * 4;
            if (col < N) {
                float4 v = make_float4(acc[i][j4 * 4 + 0], acc[i][j4 * 4 + 1], acc[i][j4 * 4 + 2], acc[i][j4 * 4 + 3]);
                if (R) { const float4 r = *(const float4*)(R + ro + col); v.x += r.x; v.y += r.y; v.z += r.z; v.w += r.w; }
                *(float4*)(C + ro + col) = v;
            }
        }
    }
}

__global__ void __launch_bounds__(256) k_ssd_conv(const float* __restrict__ proj, const float* __restrict__ cw, const float* __restrict__ cb, const float* __restrict__ dtb,
                                                  float* __restrict__ act, float* __restrict__ dts, int rows) {
    const size_t idx = (size_t)blockIdx.x * 256 + threadIdx.x;
    const size_t total = (size_t)rows * SSD_CC;
    if (idx < total) {
        const int r = (int)(idx / SSD_CC), c = (int)(idx % SSD_CC), s = r % SQ;
        float v = cb[c];
#pragma unroll
        for (int k = 0; k < 4; ++k) { const int ss = s - 3 + k; if (ss >= 0) v = fmaf(cw[k * SSD_CC + c], proj[(size_t)(r - 3 + k) * SSD_IN + SSD_DI + c], v); }
        act[idx] = silu_f(v);
    }
    if (idx < (size_t)rows * SSD_H) {
        const int r = (int)(idx / SSD_H), h = (int)(idx % SSD_H);
        const float xv = proj[(size_t)r * SSD_IN + SSD_DI + SSD_CC + h] + dtb[h];
        dts[idx] = fmaxf(xv, 0.f) + log1pf(expf(-fabsf(xv)));
    }
}

__global__ void __launch_bounds__(256) k_ssd_scan(const float* __restrict__ act, const float* __restrict__ dts, const float* __restrict__ a_log, const float* __restrict__ dsk, float* __restrict__ y) {
    __shared__ float sB[32][4][33];
    __shared__ float sC[32][4][33];
    __shared__ float sX[32][64];
    __shared__ float sD[32];
    const int bs = blockIdx.x / SSD_H, h = blockIdx.x % SSD_H, g = h / 8;
    const int tid = threadIdx.x, p = tid >> 2, nq = tid & 3;
    const float a = -expf(a_log[h]), dk = dsk[h];
    float hs[32];
#pragma unroll
    for (int j = 0; j < 32; ++j) hs[j] = 0.f;
    const size_t row0 = (size_t)bs * SQ;
    for (int t0 = 0; t0 < SQ; t0 += 32) {
        __syncthreads();
        for (int i = tid; i < 32 * 128; i += 256) { const int tt = i >> 7, n = i & 127; const size_t ro = (row0 + t0 + tt) * SSD_CC;
            sB[tt][n >> 5][n & 31] = act[ro + SSD_DI + g * SSD_N + n]; sC[tt][n >> 5][n & 31] = act[ro + SSD_DI + SSD_G * SSD_N + g * SSD_N + n]; }
        for (int i = tid; i < 32 * 64; i += 256) { const int tt = i >> 6, pp = i & 63; sX[tt][pp] = act[(row0 + t0 + tt) * SSD_CC + h * SSD_P + pp]; }
        if (tid < 32) sD[tid] = dts[(row0 + t0 + tid) * SSD_H + h];
        __syncthreads();
        for (int tt = 0; tt < 32; ++tt) {
            const float dt = sD[tt], xv = sX[tt][p], dA = expf(dt * a), xdt = xv * dt;
            float part = 0.f;
#pragma unroll
            for (int j = 0; j < 32; ++j) { hs[j] = fmaf(hs[j], dA, xdt * sB[tt][nq][j]); part = fmaf(sC[tt][nq][j], hs[j], part); }
            part += __shfl_xor(part, 1); part += __shfl_xor(part, 2);
            if (nq == 0) y[(row0 + t0 + tt) * SSD_DI + h * SSD_P + p] = part + dk * xv;
        }
    }
}

__global__ void __launch_bounds__(256) k_ssd_gatenorm(const float* __restrict__ y, const float* __restrict__ proj, const float* __restrict__ ng, float* __restrict__ o) {
    const int r = blockIdx.x, tid = threadIdx.x;
    float v[8]; float s = 0.f;
#pragma unroll
    for (int j = 0; j < 8; ++j) { const int c = tid * 8 + j; const float z = proj[(size_t)r * SSD_IN + c]; v[j] = y[(size_t)r * SSD_DI + c] * silu_f(z); s += v[j] * v[j]; }
    s = wsum(s);
    const float rs = 1.0f / sqrtf(s * (1.0f / 512.0f) + EPSN);
#pragma unroll
    for (int j = 0; j < 8; ++j) { const int c = tid * 8 + j; o[(size_t)r * SSD_DI + c] = v[j] * rs * ng[c]; }
}

__global__ void __launch_bounds__(256) k_attn_prep(float* proj, const int* __restrict__ pos, const float* __restrict__ qg, const float* __restrict__ kg, int rows) {
    const size_t idx = (size_t)blockIdx.x * 256 + threadIdx.x;
    if (idx >= (size_t)rows * 32) return;
    const int r = (int)(idx / 32), v = (int)(idx % 32);
    float* px = proj + (size_t)r * AT_IN + v * 64;
    const float* g = (v < 16) ? qg : kg;
    float x[64]; float s = 0.f;
#pragma unroll
    for (int i = 0; i < 64; ++i) { x[i] = px[i]; s += x[i] * x[i]; }
    const float rs = 1.0f / sqrtf(s * (1.0f / 64.0f) + EPSN);
#pragma unroll
    for (int i = 0; i < 64; ++i) x[i] = x[i] * rs * g[i];
    const float pf = (float)pos[r];
#pragma unroll
    for (int i = 0; i < 8; ++i) {
        const float invf = powf(500000.0f, -(float)(2 * i) / 16.0f);
        const float ang = pf * invf; const float c = cosf(ang), sn = sinf(ang);
        const float x1 = x[i], x2 = x[8 + i];
        x[i] = x1 * c - x2 * sn; x[8 + i] = x2 * c + x1 * sn;
    }
#pragma unroll
    for (int i = 0; i < 64; ++i) px[i] = x[i];
}

__global__ void __launch_bounds__(256) k_attn(const float* __restrict__ qkv, const float* __restrict__ lq1, const float* __restrict__ lk1, const float* __restrict__ lq2, const float* __restrict__ lk2,
                                              const float* __restrict__ sg, float lambda_init, float* __restrict__ o) {
    extern __shared__ float sm[];
    float* sQ = sm;
    float* sK = sQ + 2 * 64 * 65;
    float* sV = sK + 2 * 64 * 65;
    float* sW = sV + 64 * 128;
    const int qc = blockIdx.x % 32, h = (blockIdx.x / 32) % AT_H, bs = blockIdx.x / (32 * AT_H);
    const int tid = threadIdx.x, r = tid >> 2, part = tid & 3;
    const size_t row0 = (size_t)bs * SQ;
    float d1 = 0.f, d2 = 0.f;
    for (int i = 0; i < 64; ++i) { d1 += lq1[i] * lk1[i]; d2 += lq2[i] * lk2[i]; }
    const float lam = expf(d1) - expf(d2) + lambda_init;
    for (int i = tid; i < 2 * 64 * 64; i += 256) { const int c = i >> 12, rr = (i >> 6) & 63, d = i & 63; sQ[(c * 64 + rr) * 65 + d] = qkv[(row0 + qc * 64 + rr) * AT_IN + h * 128 + c * 64 + d]; }
    const int nkt = qc + 1;
    float m[2] = {-INFINITY, -INFINITY}, l[2] = {0.f, 0.f};
    for (int kt = 0; kt < nkt; ++kt) {
        __syncthreads();
        for (int i = tid; i < 2 * 64 * 64; i += 256) { const int c = i >> 12, rr = (i >> 6) & 63, d = i & 63; sK[(c * 64 + rr) * 65 + d] = qkv[(row0 + kt * 64 + rr) * AT_IN + 1024 + h * 128 + c * 64 + d]; }
        __syncthreads();
#pragma unroll
        for (int c = 0; c < 2; ++c)
            for (int kk = 0; kk < 16; ++kk) {
                const int k = part * 16 + kk; float s = 0.f;
                for (int d = 0; d < 64; ++d) s = fmaf(sQ[(c * 64 + r) * 65 + d], sK[(c * 64 + k) * 65 + d], s);
                s *= 0.125f;
                const float mn = fmaxf(m[c], s);
                l[c] = l[c] * expf(m[c] - mn) + expf(s - mn); m[c] = mn;
            }
    }
#pragma unroll
    for (int c = 0; c < 2; ++c) {
#pragma unroll
        for (int o_ = 1; o_ < 4; o_ <<= 1) {
            const float mo = __shfl_xor(m[c], o_), lo = __shfl_xor(l[c], o_);
            const float mn = fmaxf(m[c], mo);
            l[c] = l[c] * expf(m[c] - mn) + lo * expf(mo - mn); m[c] = mn;
        }
    }
    const float il0 = 1.0f / l[0], il1 = lam / l[1];
    float acc[32];
#pragma unroll
    for (int j = 0; j < 32; ++j) acc[j] = 0.f;
    for (int kt = 0; kt < nkt; ++kt) {
        __syncthreads();
        for (int i = tid; i < 2 * 64 * 64; i += 256) { const int c = i >> 12, rr = (i >> 6) & 63, d = i & 63; sK[(c * 64 + rr) * 65 + d] = qkv[(row0 + kt * 64 + rr) * AT_IN + 1024 + h * 128 + c * 64 + d]; }
        for (int i = tid; i < 64 * 128; i += 256) { const int rr = i >> 7, d = i & 127; sV[rr * 128 + d] = qkv[(row0 + kt * 64 + rr) * AT_IN + 2048 + h * 128 + d]; }
        __syncthreads();
        for (int kk = 0; kk < 16; ++kk) {
            const int k = part * 16 + kk; float s0 = 0.f, s1 = 0.f;
            for (int d = 0; d < 64; ++d) { s0 = fmaf(sQ[r * 65 + d], sK[k * 65 + d], s0); s1 = fmaf(sQ[(64 + r) * 65 + d], sK[(64 + k) * 65 + d], s1); }
            sW[r * 65 + k] = expf(s0 * 0.125f - m[0]) * il0 - expf(s1 * 0.125f - m[1]) * il1;
        }
        __syncthreads();
        for (int k = 0; k < 64; ++k) {
            const float w = sW[r * 65 + k];
#pragma unroll
            for (int j = 0; j < 32; ++j) acc[j] = fmaf(w, sV[k * 128 + part * 32 + j], acc[j]);
        }
    }
    float ss = 0.f;
#pragma unroll
    for (int j = 0; j < 32; ++j) ss += acc[j] * acc[j];
    ss += __shfl_xor(ss, 1); ss += __shfl_xor(ss, 2);
    const float rs = (1.0f - lambda_init) / sqrtf(ss * (1.0f / 128.0f) + EPSN);
#pragma unroll
    for (int j = 0; j < 32; ++j) o[(row0 + qc * 64 + r) * DM + h * 128 + part * 32 + j] = acc[j] * rs * sg[part * 32 + j];
}

__global__ void __launch_bounds__(256) k_ffn_gate(const float* __restrict__ hp, const float* __restrict__ cw, const float* __restrict__ cb, float* __restrict__ hq, int rows) {
    const size_t idx = (size_t)blockIdx.x * 256 + threadIdx.x;
    if (idx >= (size_t)rows * DFF) return;
    const int r = (int)(idx / DFF), j = (int)(idx % DFF), s = r % SQ;
    float g = cb[j], u = cb[DFF + j];
#pragma unroll
    for (int k = 0; k < 3; ++k) { const int ss = s - 2 + k; if (ss >= 0) { const size_t ro = (size_t)(r - 2 + k) * (2 * DFF); g = fmaf(cw[k * 2 * DFF + j], hp[ro + j], g); u = fmaf(cw[k * 2 * DFF + DFF + j], hp[ro + DFF + j], u); } }
    hq[idx] = silu_f(g) * u;
}

constexpr int ATTN_LDS = (2 * 64 * 65 * 2 + 64 * 128 + 64 * 65) * 4;

static void forward(void* const* d_in, float* xout, float* ws, hipStream_t st) {
    const float* x_in = (const float*)d_in[0]; const int* pos = (const int*)d_in[1];
    const float* nmg = (const float*)d_in[2]; const float* nfg = (const float*)d_in[3];
    const float* s_inw = (const float*)d_in[4]; const float* s_cw = (const float*)d_in[5]; const float* s_cb = (const float*)d_in[6];
    const float* s_dtb = (const float*)d_in[7]; const float* s_alog = (const float*)d_in[8]; const float* s_d = (const float*)d_in[9];
    const float* s_ng = (const float*)d_in[10]; const float* s_ow = (const float*)d_in[11];
    const float* a_inw = (const float*)d_in[12]; const float* a_qg = (const float*)d_in[13]; const float* a_kg = (const float*)d_in[14];
    const float* a_lq1 = (const float*)d_in[15]; const float* a_lk1 = (const float*)d_in[16]; const float* a_lq2 = (const float*)d_in[17]; const float* a_lk2 = (const float*)d_in[18];
    const float* a_sg = (const float*)d_in[19]; const float* a_ow = (const float*)d_in[20];
    const float* f_uw = (const float*)d_in[21]; const float* f_cw = (const float*)d_in[22]; const float* f_cb = (const float*)d_in[23]; const float* f_dw = (const float*)d_in[24];
    float* XN = ws; float* PROJ = XN + (size_t)RC * DM; float* ACT = PROJ + (size_t)RC * 2 * DFF; float* Y = ACT + (size_t)RC * SSD_CC; float* DT = Y + (size_t)RC * SSD_DI;
    static bool attr = false;
    if (!attr) { (void)hipFuncSetAttribute((const void*)k_attn, hipFuncAttributeMaxDynamicSharedMemorySize, ATTN_LDS); attr = true; }
    for (int layer = 0; layer < 4; ++layer) {
        const int j = layer / 2;
        for (int c0 = 0; c0 < MT; c0 += RC) {
            const float* xsrc = (layer == 0 ? x_in : xout) + (size_t)c0 * DM;
            float* xdst = xout + (size_t)c0 * DM;
            k_rmsnorm<<<RC / 4, 256, 0, st>>>(xsrc, nmg + layer * DM, XN, RC);
            if (layer % 2 == 0) {
                k_gemm<<<dim3((SSD_IN + 127) / 128, RC / 128), 256, 0, st>>>(XN, s_inw + (size_t)j * DM * SSD_IN, PROJ, nullptr, RC, SSD_IN, DM, DM, SSD_IN, SSD_IN);
                k_ssd_conv<<<(RC * SSD_CC + 255) / 256, 256, 0, st>>>(PROJ, s_cw + (size_t)j * 4 * SSD_CC, s_cb + (size_t)j * SSD_CC, s_dtb + j * SSD_H, ACT, DT, RC);
                k_ssd_scan<<<(RC / SQ) * SSD_H, 256, 0, st>>>(ACT, DT, s_alog + j * SSD_H, s_d + j * SSD_H, Y);
                k_ssd_gatenorm<<<RC, 256, 0, st>>>(Y, PROJ, s_ng + (size_t)j * SSD_DI, ACT);
                k_gemm<<<dim3(DM / 128, RC / 128), 256, 0, st>>>(ACT, s_ow + (size_t)j * SSD_DI * DM, xdst, xsrc, RC, DM, SSD_DI, SSD_DI, DM, DM);
            } else {
                const float lambda_init = (float)(0.8 - 0.6 * exp(-0.3 * (double)layer));
                k_gemm<<<dim3(AT_IN / 128, RC / 128), 256, 0, st>>>(XN, a_inw + (size_t)j * DM * AT_IN, PROJ, nullptr, RC, AT_IN, DM, DM, AT_IN, AT_IN);
                k_attn_prep<<<(RC * 32 + 255) / 256, 256, 0, st>>>(PROJ, pos + c0, a_qg + j * 64, a_kg + j * 64, RC);
                k_attn<<<(RC / SQ) * AT_H * 32, 256, ATTN_LDS, st>>>(PROJ, a_lq1 + j * 64, a_lk1 + j * 64, a_lq2 + j * 64, a_lk2 + j * 64, a_sg + j * 128, lambda_init, Y);
                k_gemm<<<dim3(DM / 128, RC / 128), 256, 0, st>>>(Y, a_ow + (size_t)j * DM * DM, xdst, xsrc, RC, DM, DM, DM, DM, DM);
            }
            k_rmsnorm<<<RC / 4, 256, 0, st>>>(xdst, nfg + layer * DM, XN, RC);
            k_gemm<<<dim3(2 * DFF / 128, RC / 128), 256, 0, st>>>(XN, f_uw + (size_t)layer * DM * 2 * DFF, PROJ, nullptr, RC, 2 * DFF, DM, DM, 2 * DFF, 2 * DFF);
            k_ffn_gate<<<(RC * DFF + 255) / 256, 256, 0, st>>>(PROJ, f_cw + (size_t)layer * 3 * 2 * DFF, f_cb + (size_t)layer * 2 * DFF, ACT, RC);
            k_gemm<<<dim3(DM / 128, RC / 128), 256, 0, st>>>(ACT, f_dw + (size_t)layer * DFF * DM, xdst, xdst, RC, DM, DFF, DFF, DM, DM);
        }
    }
}
}

extern "C" void kernel_launch(void* const* d_in, const int* in_sizes, int n_in, void* d_out, int out_size, void* d_ws, size_t ws_size, hipStream_t stream) {
    (void)in_sizes; (void)n_in; (void)out_size; (void)ws_size;
    nv::forward(d_in, (float*)d_out, (float*)d_ws, stream);
}
```

```cpp
#include <hip/hip_runtime.h>
#include <stdint.h>
#include <math.h>
#include <cstdio>
namespace pg8 {
#define PG8_LAS __attribute__((address_space(3)))
typedef unsigned short bf16_t;
typedef short bf16x8 __attribute__((ext_vector_type(8)));
typedef float f32x4 __attribute__((ext_vector_type(4)));
typedef unsigned u32x4 __attribute__((ext_vector_type(4)));
typedef unsigned u32x2 __attribute__((ext_vector_type(2)));
constexpr int BM = 256, BK = 64, HALF = 128, HTB = HALF * BK * 2  , STAGE_BYTES = 8 * HTB, NXCD = 8, WGM = 8;

__host__ __device__ __forceinline__ int lds_byte(int r, int c) { const int st = (r >> 4) * 2 + (c >> 5), rr = r & 15, cc = c & 31, ob = rr * 64 + cc * 2; return st * 1024 + (ob ^ (((ob >> 9) & 1) << 5)); }
__host__ __device__ __forceinline__ void stage_rc(int b, int& R, int& C) { const int st = b / 1024, sb = b % 1024, swz = sb ^ (((sb >> 9) & 1) << 5); R = (st >> 1) * 16 + swz / 64; C = (st & 1) * 32 + (swz % 64) / 2; }
__host__ __device__ __forceinline__ int perm32(int rho) { const int n = rho >> 4, i = rho & 15; return 8 * (i >> 2) + 4 * n + (i & 3); }

struct Unit { int pm, pn; };
struct Gemm { const bf16_t* A; const bf16_t* Bt; int lda, K, a_stride, a_off; };

struct StaticOrder {
    int nM, nN, nwg, G, c;
    __host__ __device__ void init(int nM_, int nN_, int G_, int c_) { nM = nM_; nN = nN_; nwg = nM * nN; G = G_; c = c_; }
    __host__ __device__ bool next(int i, Unit& u) const {
        const long L = (long)i * G + c; if (L >= nwg) return false;
        int wgid = (int)L; { const int q = nwg / NXCD, r = nwg % NXCD, xcd = wgid % NXCD, off = wgid / NXCD; wgid = (xcd < r ? xcd * (q + 1) : r * (q + 1) + (xcd - r) * q) + off; }
        const int nig = WGM * nN, gid = wgid / nig, fm = gid * WGM, gsz = (nM - fm) < WGM ? (nM - fm) : WGM;
        u.pm = fm + ((wgid % nig) % gsz); u.pn = (wgid % nig) / gsz; return true;
    }
};

__device__ __forceinline__ unsigned cvt_pk_bf16(float lo, float hi) { unsigned r; asm volatile("v_cvt_pk_bf16_f32 %0, %1, %2" : "=v"(r) : "v"(lo), "v"(hi)); return r; }

template <class Epi, class Sched>
__device__ __forceinline__ void gemm_phase(PG8_LAS unsigned char* lds, PG8_LAS unsigned char* elds, const Gemm g, const Sched& S, const Epi& E) {
    int tid = threadIdx.x; asm volatile("" : "+v"(tid));
    const int wid = __builtin_amdgcn_readfirstlane(tid >> 6), lane = tid & 63, wr = wid >> 2, wc = wid & 3, fr = lane & 15, fq = lane >> 4;
    const int K = g.K, nt = K / BK, lda = g.lda;
    unsigned voffA[2], voffB[2];
#pragma unroll
    for (int i = 0; i < 2; ++i) { int R, C; stage_rc(tid * 16 + i * 8192, R, C); const int Rb = Epi::PERM ? ((R & ~31) + perm32(R & 31)) : R;
        voffA[i] = (unsigned)(R * lda + C) * 2u; voffB[i] = (unsigned)(Rb * K + C) * 2u; }
    const size_t kstep = (size_t)(BK * 2);
    const size_t hstepA = (size_t)HALF * lda * 2, hstepB = (size_t)HALF * K * 2;
    const size_t tstepB = 2 * hstepB;
    const unsigned ldsw = (unsigned)wid * 1024u;
    const int aoff = lds_byte(wr * 64 + fr, fq * 8), boff = lds_byte(wc * 32 + fr, fq * 8);
#define PG8_SA(b, h) (((b) * 2 + (h)) * HTB)
#define PG8_SB(b, h) ((4 + (b) * 2 + (h)) * HTB)
#define PG8_STAGE(bufoff, gbase, voff) do { _Pragma("unroll") for (int _i = 0; _i < 2; ++_i) \
        __builtin_amdgcn_global_load_lds((const unsigned*)((const char*)(gbase) + (voff)[_i]), (PG8_LAS unsigned*)(lds + (bufoff) + ldsw + _i * 8192), 16, 0, 0); } while (0)
#define PG8_LDA(dst, b, h) do { _Pragma("unroll") for (int m = 0; m < 4; ++m) _Pragma("unroll") for (int k = 0; k < 2; ++k) dst[m][k] = *(const PG8_LAS bf16x8*)(lds + PG8_SA(b, h) + aoff + m * 2048 + k * 1024); } while (0)
#define PG8_LDB(dst, b, h) do { _Pragma("unroll") for (int n = 0; n < 2; ++n) _Pragma("unroll") for (int k = 0; k < 2; ++k) dst[n][k] = *(const PG8_LAS bf16x8*)(lds + PG8_SB(b, h) + boff + n * 2048 + k * 1024); } while (0)
#define PG8_MMA(ai, bj, At, Bt) do { __builtin_amdgcn_s_setprio(1); _Pragma("unroll") for (int m = 0; m < 4; ++m) _Pragma("unroll") for (int n = 0; n < 2; ++n) _Pragma("unroll") for (int k = 0; k < 2; ++k) \
        acc[ai][bj][m][n] = __builtin_amdgcn_mfma_f32_16x16x32_bf16(Bt[n][k], At[m][k], acc[ai][bj][m][n], 0, 0, 0); __builtin_amdgcn_s_setprio(0); } while (0)
#define PG8_WAIT_V(n) asm volatile("s_waitcnt vmcnt(" #n ")" ::: "memory")
#define PG8_WAIT_L(n) asm volatile("s_waitcnt lgkmcnt(" #n ")" ::: "memory")
#define PG8_BAR __builtin_amdgcn_s_barrier()
#define PG8_SCHED __builtin_amdgcn_sched_barrier(0)
    Unit cur, nxt; int ui = 0;
    if (!S.next(0, cur)) return;
    float zf = 0.f; asm volatile("" : "+v"(zf));
    f32x4 acc[2][2][4][2];
#pragma unroll
    for (int a = 0; a < 2; ++a)
#pragma unroll
        for (int b = 0; b < 2; ++b)
#pragma unroll
            for (int m = 0; m < 4; ++m)
#pragma unroll
                for (int n = 0; n < 2; ++n) acc[a][b][m][n] = (f32x4){zf, zf, zf, zf};
    bf16x8 At[4][2], B0[2][2], B1[2][2];
    const char* cA = (const char*)g.A + ((long)cur.pm * g.a_stride + g.a_off) * (long)lda * 2; const char* cB = (const char*)g.Bt + (size_t)cur.pn * tstepB;
    PG8_STAGE(PG8_SB(0, 0), cB, voffB); PG8_STAGE(PG8_SB(0, 1), cB + hstepB, voffB); PG8_STAGE(PG8_SA(0, 0), cA, voffA); PG8_STAGE(PG8_SA(0, 1), cA + hstepA, voffA);
    if (wr == 1) PG8_BAR;
    PG8_WAIT_V(2); PG8_BAR;
    PG8_STAGE(PG8_SB(1, 0), cB + kstep, voffB); PG8_STAGE(PG8_SA(1, 0), cA + kstep, voffA); PG8_STAGE(PG8_SB(1, 1), cB + hstepB + kstep, voffB);
    PG8_WAIT_V(6); PG8_BAR;
    for (;;) {
        const bool has_next = S.next(ui + 1, nxt);
        const char* nA = has_next ? (const char*)g.A + ((long)nxt.pm * g.a_stride + g.a_off) * (long)lda * 2 : cA; const char* nB = has_next ? (const char*)g.Bt + (size_t)nxt.pn * tstepB : cB;
        for (int t = 0; t < nt; t += 2) {
            const bool last = (t == nt - 2);
            const char* a1 = cA + (size_t)(t + 1) * kstep;
            const char* a2 = last ? nA : cA + (size_t)(t + 2) * kstep; const char* b2 = last ? nB : cB + (size_t)(t + 2) * kstep;
            const char* a3 = a2 + kstep; const char* b3 = b2 + kstep;
            PG8_LDB(B0, 0, 0); PG8_LDB(B1, 0, 1); PG8_SCHED; PG8_LDA(At, 0, 0); PG8_STAGE(PG8_SA(1, 1), a1 + hstepA, voffA);
            PG8_WAIT_V(8); PG8_WAIT_L(0); PG8_BAR; PG8_MMA(0, 0, At, B0); PG8_MMA(0, 1, At, B1); PG8_BAR; PG8_SCHED;
            PG8_LDA(At, 0, 1); PG8_STAGE(PG8_SB(0, 0), b2, voffB); PG8_STAGE(PG8_SB(0, 1), b2 + hstepB, voffB); PG8_STAGE(PG8_SA(0, 0), a2, voffA);
            PG8_WAIT_V(8); PG8_WAIT_L(0); PG8_BAR; PG8_MMA(1, 0, At, B0); PG8_MMA(1, 1, At, B1); PG8_BAR; PG8_SCHED;
            PG8_LDB(B0, 1, 0); PG8_LDB(B1, 1, 1); PG8_SCHED; PG8_LDA(At, 1, 0); PG8_STAGE(PG8_SA(0, 1), a2 + hstepA, voffA);
            PG8_WAIT_V(8); PG8_WAIT_L(0); PG8_BAR; PG8_MMA(0, 0, At, B0); PG8_MMA(0, 1, At, B1); PG8_BAR; PG8_SCHED;
            PG8_LDA(At, 1, 1); PG8_STAGE(PG8_SB(1, 0), b3, voffB); PG8_STAGE(PG8_SB(1, 1), b3 + hstepB, voffB); PG8_STAGE(PG8_SA(1, 0), a3, voffA);
            PG8_WAIT_V(8); PG8_WAIT_L(0); PG8_BAR; PG8_MMA(1, 0, At, B0); PG8_MMA(1, 1, At, B1); PG8_BAR; PG8_SCHED;
        }
        if (wr == 0) PG8_BAR;
        E(acc, cur, wr, wc, elds);
        if (!has_next) break;
#pragma unroll
        for (int a = 0; a < 2; ++a)
#pragma unroll
            for (int b = 0; b < 2; ++b)
#pragma unroll
                for (int m = 0; m < 4; ++m)
#pragma unroll
                    for (int n = 0; n < 2; ++n) acc[a][b][m][n] = (f32x4){zf, zf, zf, zf};
        cur = nxt; cA = nA; cB = nB; ++ui;
        if (wr == 1) PG8_BAR;
    }
    PG8_WAIT_V(0);
    PG8_BAR;
#undef PG8_SA
#undef PG8_SB
#undef PG8_STAGE
#undef PG8_LDA
#undef PG8_LDB
#undef PG8_MMA
}
}
namespace epi {
using pg8::f32x4; using pg8::u32x4; using pg8::u32x2; using pg8::bf16_t; using pg8::Unit; using pg8::cvt_pk_bf16;
constexpr int MROWS = 16384, DMODEL = 1024;
constexpr float EPS = 1e-6f;
#define EPI_LAS __attribute__((address_space(3)))

__device__ __forceinline__ float row_rstd(const float* ssq, int row) {
    const f32x4 a = *(const f32x4*)(ssq + (size_t)row * 4);
    const float s = (a[0] + a[1]) + (a[2] + a[3]);
    return 1.0f / sqrtf(s * (1.0f / DMODEL) + EPS);
}
template <int CTRL> __device__ __forceinline__ float dppf(float old, float src) {
    return __builtin_bit_cast(float, __builtin_amdgcn_update_dpp(__builtin_bit_cast(int, old), __builtin_bit_cast(int, src), CTRL, 0xF, 0xF, false));
}
__device__ __forceinline__ float silu_fast(float v) { return v * __builtin_amdgcn_rcpf(1.0f + __builtin_amdgcn_exp2f(-1.4426950408889634f * v)); }

struct EpiResidual {
    static constexpr bool PERM = false;
    const float* xin; float* xout; bf16_t* xb; float* ssq;
    __device__ __forceinline__ void operator()(f32x4 (&acc)[2][2][4][2], const Unit& u, int wr, int wc, EPI_LAS unsigned char* elds) const {
        int fr, fq; { int t_ = threadIdx.x; asm volatile("" : "+v"(t_)); fr = t_ & 15; fq = (t_ >> 4) & 3; }
        EPI_LAS float* P = (EPI_LAS float*)elds;
        const int col0 = u.pn * 256 + wc * 32 + 4 * fq;
#pragma unroll
        for (int ai = 0; ai < 2; ++ai)
#pragma unroll
            for (int m = 0; m < 4; ++m) {
                const int row = u.pm * 256 + ai * 128 + wr * 64 + m * 16 + fr;
                const size_t off = (size_t)row * DMODEL + col0;
                float s = 0.f;
#pragma unroll
                for (int bj = 0; bj < 2; ++bj)
#pragma unroll
                    for (int n = 0; n < 2; ++n) {
                        const size_t o = off + bj * 128 + n * 16;
                        const f32x4 v = *(const f32x4*)(xin + o) + acc[ai][bj][m][n];
                        *(f32x4*)(xout + o) = v;
                        u32x2 w; w.x = cvt_pk_bf16(v[0], v[1]); w.y = cvt_pk_bf16(v[2], v[3]);
                        *(u32x2*)(xb + o) = w;
                        s += (v[0] * v[0] + v[1] * v[1]) + (v[2] * v[2] + v[3] * v[3]);
                    }
                s += __shfl_xor(s, 16); s += __shfl_xor(s, 32);
                if (fq == 0) P[(ai * 128 + wr * 64 + m * 16 + fr) * 4 + wc] = s;
                asm volatile("" ::: "memory");
            }
        asm volatile("s_waitcnt lgkmcnt(0)" ::: "memory"); __builtin_amdgcn_s_barrier(); asm volatile("" ::: "memory");
        { const int t = (wr * 4 + wc) * 64 + fq * 16 + fr; if (t < 256) { const f32x4 p = *(const EPI_LAS f32x4*)(P + t * 4); ssq[(size_t)(u.pm * 256 + t) * 4 + u.pn] = (p[0] + p[1]) + (p[2] + p[3]); } }
        asm volatile("s_waitcnt lgkmcnt(0)" ::: "memory"); __builtin_amdgcn_s_barrier(); asm volatile("" ::: "memory");
    }
};

struct EpiSsdIn {
    static constexpr bool PERM = true;
    bf16_t* proj; float* dt; const float* dtbias; const float* ssq;
    __device__ __forceinline__ void operator()(f32x4 (&acc)[2][2][4][2], const Unit& u, int wr, int wc, EPI_LAS unsigned char*) const {
        int fr, fq; { int t_ = threadIdx.x; asm volatile("" : "+v"(t_)); fr = t_ & 15; fq = (t_ >> 4) & 3; }
#pragma unroll
        for (int ai = 0; ai < 2; ++ai)
#pragma unroll
            for (int m = 0; m < 4; ++m) {
                const int row = u.pm * 256 + ai * 128 + wr * 64 + m * 16 + fr;
                const float rs = row_rstd(ssq, row);
                if (u.pn < 20) {
#pragma unroll
                    for (int bj = 0; bj < 2; ++bj) {
                        const f32x4 v0 = acc[ai][bj][m][0] * rs, v1 = acc[ai][bj][m][1] * rs;
                        u32x4 w; w.x = cvt_pk_bf16(v0[0], v0[1]); w.y = cvt_pk_bf16(v0[2], v0[3]); w.z = cvt_pk_bf16(v1[0], v1[1]); w.w = cvt_pk_bf16(v1[2], v1[3]);
                        *(u32x4*)(proj + (size_t)row * 5120 + u.pn * 256 + bj * 128 + wc * 32 + 8 * fq) = w;
                    }
                } else if (wc == 0) {
#pragma unroll
                    for (int n = 0; n < 2; ++n) {
                        const int c = 8 * fq + 4 * n;
                        const f32x4 b = *(const f32x4*)(dtbias + c);
                        f32x4 v = acc[ai][0][m][n] * rs + b, o;
#pragma unroll
                        for (int e = 0; e < 4; ++e) o[e] = fmaxf(v[e], 0.f) + log1pf(expf(-fabsf(v[e])));
                        *(f32x4*)(dt + (size_t)row * 32 + c) = o;
                    }
                }
                asm volatile("" ::: "memory");
            }
    }
};

struct EpiQKV {
    static constexpr bool PERM = true;
    bf16_t* proj; const float* ssq; const float* qg; const float* kg; const float* rope;
    __device__ __forceinline__ void operator()(f32x4 (&acc)[2][2][4][2], const Unit& u, int wr, int wc, EPI_LAS unsigned char* elds) const {
        int fr, fq; { int t_ = threadIdx.x; asm volatile("" : "+v"(t_)); fr = t_ & 15; fq = (t_ >> 4) & 3; }
        EPI_LAS float* P = (EPI_LAS float*)elds;
        const bool isqk = u.pn < 8;
#pragma unroll
        for (int ai = 0; ai < 2; ++ai)
#pragma unroll
            for (int m = 0; m < 4; ++m) {
                const int trow = ai * 128 + wr * 64 + m * 16 + fr;
                const float rs = row_rstd(ssq, u.pm * 256 + trow);
#pragma unroll
                for (int bj = 0; bj < 2; ++bj) {
                    acc[ai][bj][m][0] *= rs; acc[ai][bj][m][1] *= rs;
                    if (isqk) {
                        const f32x4 a = acc[ai][bj][m][0], b = acc[ai][bj][m][1];
                        float s = ((a[0] * a[0] + a[1] * a[1]) + (a[2] * a[2] + a[3] * a[3])) + ((b[0] * b[0] + b[1] * b[1]) + (b[2] * b[2] + b[3] * b[3]));
                        s += __shfl_xor(s, 16); s += __shfl_xor(s, 32);
                        if (fq == 0) P[trow * 8 + bj * 4 + wc] = s;
                    }
                }
                asm volatile("" ::: "memory");
            }
        if (isqk) {
            asm volatile("s_waitcnt lgkmcnt(0)" ::: "memory"); __builtin_amdgcn_s_barrier(); asm volatile("" ::: "memory");
            const float* g = (u.pn < 4) ? qg : kg;
            const int d0 = 32 * (wc & 1) + 8 * fq;
            const f32x4 g0 = *(const f32x4*)(g + d0), g1 = *(const f32x4*)(g + d0 + 4);
            const float qs = (u.pn < 4) ? (1.4426950408889634f * 0.125f) : 1.0f;
            const bool dorope = (wc & 1) == 0;
#pragma unroll
            for (int ai = 0; ai < 2; ++ai)
#pragma unroll
                for (int m = 0; m < 4; ++m) {
                    const int trow = ai * 128 + wr * 64 + m * 16 + fr;
                    const int row = u.pm * 256 + trow;
                    f32x4 c0 = {1.f, 1.f, 1.f, 1.f}, c1 = c0, s0 = {0.f, 0.f, 0.f, 0.f}, s1 = s0;
                    if (dorope && fq < 2) {
                        const f32x4* rp = (const f32x4*)(rope + (size_t)row * 16);
                        c0 = rp[0]; c1 = rp[1]; s0 = rp[2]; s1 = rp[3];
                        if (fq == 0) { s0 = -s0; s1 = -s1; }
                    }
#pragma unroll
                    for (int bj = 0; bj < 2; ++bj) {
                        const float tot = P[trow * 8 + bj * 4 + wc] + P[trow * 8 + bj * 4 + (wc ^ 1)];
                        const float nr = qs / sqrtf(tot * (1.0f / 64.0f) + EPS);
                        f32x4 v0 = acc[ai][bj][m][0] * g0 * nr, v1 = acc[ai][bj][m][1] * g1 * nr;
                        if (dorope) {
                            f32x4 o0, o1;
#pragma unroll
                            for (int e = 0; e < 4; ++e) { o0[e] = __shfl_xor(v0[e], 16); o1[e] = __shfl_xor(v1[e], 16); }
                            v0 = v0 * c0 + o0 * s0; v1 = v1 * c1 + o1 * s1;
                        }
                        u32x4 w; w.x = cvt_pk_bf16(v0[0], v0[1]); w.y = cvt_pk_bf16(v0[2], v0[3]); w.z = cvt_pk_bf16(v1[0], v1[1]); w.w = cvt_pk_bf16(v1[2], v1[3]);
                        *(u32x4*)(proj + (size_t)row * 3072 + u.pn * 256 + bj * 128 + wc * 32 + 8 * fq) = w;
                    }
                    asm volatile("" ::: "memory");
                }
            asm volatile("s_waitcnt lgkmcnt(0)" ::: "memory"); __builtin_amdgcn_s_barrier(); asm volatile("" ::: "memory");
        } else {
#pragma unroll
            for (int ai = 0; ai < 2; ++ai)
#pragma unroll
                for (int m = 0; m < 4; ++m) {
                    const int row = u.pm * 256 + ai * 128 + wr * 64 + m * 16 + fr;
#pragma unroll
                    for (int bj = 0; bj < 2; ++bj) {
                        const f32x4 v0 = acc[ai][bj][m][0], v1 = acc[ai][bj][m][1];
                        u32x4 w; w.x = cvt_pk_bf16(v0[0], v0[1]); w.y = cvt_pk_bf16(v0[2], v0[3]); w.z = cvt_pk_bf16(v1[0], v1[1]); w.w = cvt_pk_bf16(v1[2], v1[3]);
                        *(u32x4*)(proj + (size_t)row * 3072 + u.pn * 256 + bj * 128 + wc * 32 + 8 * fq) = w;
                    }
                }
        }
    }
};

struct EpiConvGate {
    static constexpr bool PERM = true;
    bf16_t* H; const float* ssq; const float* cw; const float* cb;
    template <bool MASK>
    __device__ __forceinline__ void body(f32x4 (&acc)[2][2][4][2], const Unit& u, int wr, int wc, int fr, int fq, const EPI_LAS f32x4* hb, int R0) const {
        constexpr int DFF = 2816;
#pragma unroll
        for (int n = 0; n < 2; ++n) {
            const int ch = u.pn * 128 + wc * 32 + 8 * fq + 4 * n;
            const f32x4 bg = *(const f32x4*)(cb + ch), bu = *(const f32x4*)(cb + DFF + ch);
            const f32x4 w0g = *(const f32x4*)(cw + ch), w1g = *(const f32x4*)(cw + 2 * DFF + ch), w2g = *(const f32x4*)(cw + 4 * DFF + ch);
            const f32x4 w0u = *(const f32x4*)(cw + DFF + ch), w1u = *(const f32x4*)(cw + 3 * DFF + ch), w2u = *(const f32x4*)(cw + 5 * DFF + ch);
#pragma unroll
            for (int ai = 0; ai < 2; ++ai) {
                f32x4 pg = {0.f, 0.f, 0.f, 0.f}, pu = pg;
                const int pwr = wr ^ 1, pai = (wr == 1) ? ai : ai - 1;
                if (pai >= 0 && fr >= 14) {
                    const int idx = ((((pwr * 2 + pai) * 4 + wc) * 2 + (fr - 14)) * 4 + fq) * 4;
                    pg = hb[idx + 0 + n]; pu = hb[idx + 2 + n];
                }
#pragma unroll
                for (int m = 0; m < 4; ++m) {
                    const int trow = ai * 128 + wr * 64 + m * 16 + fr, row = R0 + trow;
                    const f32x4 cg = acc[ai][0][m][n], cu = acc[ai][1][m][n];
                    const f32x4 qg_ = (m == 0) ? pg : acc[ai][0][m - 1][n], qu_ = (m == 0) ? pu : acc[ai][1][m - 1][n];
                    bool k1 = true, k2 = true;
                    if (MASK) { const int ts = row & 2047; k1 = ts >= 1; k2 = ts >= 2; }
                    float o[4];
#pragma unroll
                    for (int e = 0; e < 4; ++e) {
                        float g1 = dppf<0x111>(dppf<0x121>(0.f, qg_[e]), cg[e]);
                        float g2 = dppf<0x112>(dppf<0x122>(0.f, qg_[e]), cg[e]);
                        float u1 = dppf<0x111>(dppf<0x121>(0.f, qu_[e]), cu[e]);
                        float u2 = dppf<0x112>(dppf<0x122>(0.f, qu_[e]), cu[e]);
                        if (MASK) { g1 = k1 ? g1 : 0.f; u1 = k1 ? u1 : 0.f; g2 = k2 ? g2 : 0.f; u2 = k2 ? u2 : 0.f; }
                        const float gv = bg[e] + w0g[e] * g2 + w1g[e] * g1 + w2g[e] * cg[e];
                        const float uv = bu[e] + w0u[e] * u2 + w1u[e] * u1 + w2u[e] * cu[e];
                        o[e] = silu_fast(gv) * uv;
                    }
                    if (trow >= 2 && row < MROWS) {
                        u32x2 w; w.x = cvt_pk_bf16(o[0], o[1]); w.y = cvt_pk_bf16(o[2], o[3]);
                        *(u32x2*)(H + (size_t)row * DFF + ch) = w;
                    }
                    asm volatile("" ::: "memory");
                }
            }
        }
    }
    __device__ __forceinline__ void operator()(f32x4 (&acc)[2][2][4][2], const Unit& u, int wr, int wc, EPI_LAS unsigned char* elds) const {
        int fr, fq; { int t_ = threadIdx.x; asm volatile("" : "+v"(t_)); fr = t_ & 15; fq = (t_ >> 4) & 3; }
        const int R0 = u.pm * 254 - 2;
        EPI_LAS f32x4* hb = (EPI_LAS f32x4*)elds;
#pragma unroll
        for (int ai = 0; ai < 2; ++ai)
#pragma unroll
            for (int m = 0; m < 4; ++m) {
                int row = R0 + ai * 128 + wr * 64 + m * 16 + fr; row = row < 0 ? 0 : (row >= MROWS ? MROWS - 1 : row);
                const float rs = row_rstd(ssq, row);
#pragma unroll
                for (int bj = 0; bj < 2; ++bj) { acc[ai][bj][m][0] *= rs; acc[ai][bj][m][1] *= rs; }
                asm volatile("" ::: "memory");
            }
        if (fr >= 14) {
#pragma unroll
            for (int ai = 0; ai < 2; ++ai) {
                const int idx = ((((wr * 2 + ai) * 4 + wc) * 2 + (fr - 14)) * 4 + fq) * 4;
                hb[idx + 0] = acc[ai][0][3][0]; hb[idx + 1] = acc[ai][0][3][1]; hb[idx + 2] = acc[ai][1][3][0]; hb[idx + 3] = acc[ai][1][3][1];
            }
        }
        asm volatile("s_waitcnt lgkmcnt(0)" ::: "memory"); __builtin_amdgcn_s_barrier(); asm volatile("" ::: "memory");
        const int tf = (u.pm * 254) & 2047;
        if (tf <= 1 || tf + 253 >= 2048) body<true>(acc, u, wr, wc, fr, fq, hb, R0); else body<false>(acc, u, wr, wc, fr, fq, hb, R0);
        asm volatile("s_waitcnt lgkmcnt(0)" ::: "memory"); __builtin_amdgcn_s_barrier(); asm volatile("" ::: "memory");
    }
};
}
namespace attn {
using pg8::bf16_t; using pg8::bf16x8; using pg8::f32x4; using pg8::u32x4;
typedef float f32x16 __attribute__((ext_vector_type(16)));
typedef short s16x4 __attribute__((ext_vector_type(4)));
#define AT_LAS __attribute__((address_space(3)))
constexpr int LD = 3072, SEQ = 2048;
constexpr int KT_BYTES = 16384, VT_BYTES = 16384, STG = KT_BYTES + VT_BYTES;
constexpr int L_X = 0;
constexpr int L_WSF = 2 * STG;
constexpr int L_OST = L_WSF + 8 * 256;
constexpr int LDS_BYTES = L_OST + 4 * 8192;
__device__ __forceinline__ int crow(int r, int hi) { return (r & 3) + 8 * (r >> 2) + 4 * hi; }
__device__ __forceinline__ unsigned cvtpk(float lo, float hi) { typedef float f2 __attribute__((ext_vector_type(2))); typedef __bf16 b2 __attribute__((ext_vector_type(2))); f2 v = {lo, hi}; b2 b = __builtin_convertvector(v, b2); return __builtin_bit_cast(unsigned, b); }
__device__ __forceinline__ s16x4 vtr(const AT_LAS char* p) { typedef short v4 __attribute__((ext_vector_type(4))); return __builtin_bit_cast(s16x4, __builtin_amdgcn_ds_read_tr16_b64_v4i16((AT_LAS v4*)p)); }

struct Params { bf16_t* qkv; float mb; float lam; float out_scale_unused; };

__device__ __forceinline__ void unit(const Params& P, int b, int h, int blk, AT_LAS char* lds) {
    int tid = threadIdx.x; asm volatile("" : "+v"(tid));
    const int lane = tid & 63, r32 = lane & 31, hi = lane >> 5;
    const int wid = __builtin_amdgcn_readfirstlane(tid >> 6), comp = wid >> 2, w4 = wid & 3;
    const size_t rowb = (size_t)b * SEQ;
    const int q0 = blk * 128;
    const int nt = 2 * blk + 2, my_nt = 2 * blk + (w4 >> 1) + 1;
    const bf16_t* Kg = P.qkv + rowb * LD + 1024 + h * 128;
    const bf16_t* Vg = P.qkv + rowb * LD + 2048 + h * 128;
    u32x4 kreg[2], vreg[2];
    int kdst[2], vdst[2];
#pragma unroll
    for (int i = 0; i < 2; ++i) {
        const int p = tid + 512 * i, key = p >> 4, c16 = p & 15;
        kdst[i] = key * 256 + ((c16 ^ (key & 15)) << 4);
        vdst[i] = KT_BYTES + (c16 >> 2) * 4096 + (key >> 4) * 1024 + ((key >> 3) & 1) * 512 + (key & 7) * 64 + (c16 & 3) * 16;
    }
#define AT_LOAD(t) do { _Pragma("unroll") for (int i = 0; i < 2; ++i) { const int p = tid + 512 * i, key = p >> 4, c16 = p & 15; const size_t go = (size_t)((t) * 64 + key) * LD + c16 * 8; \
        kreg[i] = *(const u32x4*)(Kg + go); vreg[i] = *(const u32x4*)(Vg + go); } } while (0)
#define AT_STORE(s) do { _Pragma("unroll") for (int i = 0; i < 2; ++i) { *(AT_LAS u32x4*)(lds + (s) * STG + kdst[i]) = kreg[i]; *(AT_LAS u32x4*)(lds + (s) * STG + vdst[i]) = vreg[i]; } } while (0)
    AT_LOAD(0);
    bf16x8 qr[4];
    {
        const bf16_t* Qw = P.qkv + (rowb + q0 + w4 * 32 + r32) * LD + h * 128 + comp * 64 + hi * 8;
#pragma unroll
        for (int d0 = 0; d0 < 4; ++d0) qr[d0] = *(const bf16x8*)(Qw + d0 * 16);
    }
    AT_STORE(0);
    __syncthreads();
    f32x16 o[4];
#pragma unroll
    for (int i = 0; i < 4; ++i)
#pragma unroll
        for (int r = 0; r < 16; ++r) o[i][r] = 0.f;
    float lsum = 0.f;
    f32x16 negm;
#pragma unroll
    for (int r = 0; r < 16; ++r) negm[r] = -P.mb;
    const int kbase = r32 * 256, ksw = r32 & 15;
    const int vbase = KT_BYTES + ((lane >> 4) & 1) * 32 + (lane & 3) * 8 + (4 * hi + ((lane & 15) >> 2)) * 64;
    for (int t = 0; t < nt; ++t) {
        const int s = t & 1;
        if (t + 1 < nt) AT_LOAD(t + 1);
        if (t < my_nt) {
            const AT_LAS char* st = lds + s * STG;
            f32x16 p0 = negm, p1 = negm;
#pragma unroll
            for (int d0 = 0; d0 < 4; ++d0) {
                const int ch = comp * 8 + 2 * d0 + hi;
                const bf16x8 k0 = *(const AT_LAS bf16x8*)(st + kbase + ((ch ^ ksw) << 4));
                const bf16x8 k1 = *(const AT_LAS bf16x8*)(st + kbase + 32 * 256 + ((ch ^ ksw) << 4));
                p0 = __builtin_amdgcn_mfma_f32_32x32x16_bf16(k0, qr[d0], p0, 0, 0, 0);
                p1 = __builtin_amdgcn_mfma_f32_32x32x16_bf16(k1, qr[d0], p1, 0, 0, 0);
            }
            float sacc = 0.f;
#pragma unroll
            for (int r = 0; r < 16; ++r) { p0[r] = __builtin_amdgcn_exp2f(p0[r]); p1[r] = __builtin_amdgcn_exp2f(p1[r]); sacc += p0[r] + p1[r]; }
            lsum += sacc;
            u32x4 pw[4];
#pragma unroll
            for (int j = 0; j < 4; ++j) { pw[0][j] = cvtpk(p0[2 * j], p0[2 * j + 1]); pw[1][j] = cvtpk(p0[8 + 2 * j], p0[8 + 2 * j + 1]); pw[2][j] = cvtpk(p1[2 * j], p1[2 * j + 1]); pw[3][j] = cvtpk(p1[8 + 2 * j], p1[8 + 2 * j + 1]); }
#pragma unroll
            for (int bk = 0; bk < 4; ++bk)
#pragma unroll
                for (int ks = 0; ks < 4; ++ks) {
                    const s16x4 lo = vtr(st + vbase + bk * 4096 + ks * 1024), hh = vtr(st + vbase + bk * 4096 + ks * 1024 + 512);
                    const bf16x8 vf = {lo[0], lo[1], lo[2], lo[3], hh[0], hh[1], hh[2], hh[3]};
                    o[bk] = __builtin_amdgcn_mfma_f32_32x32x16_bf16(__builtin_bit_cast(bf16x8, pw[ks]), vf, o[bk], 0, 0, 0);
                }
        }
        if (t + 1 < nt) AT_STORE(s ^ 1);
        __syncthreads();
    }
    lsum += __shfl_xor(lsum, 32);
    AT_LAS float* wsf = (AT_LAS float*)(lds + L_WSF) + wid * 64;
    if (hi == 0) wsf[r32] = lsum;
    asm volatile("s_waitcnt lgkmcnt(0)" ::: "memory");
    float rl[16];
    const float sc = comp ? P.lam : 1.0f;
#pragma unroll
    for (int r = 0; r < 16; ++r) rl[r] = sc * __builtin_amdgcn_rcpf(wsf[crow(r, hi)]);
    AT_LAS float* X = (AT_LAS float*)(lds + L_X) + w4 * 4096 + lane;
    if (comp == 1) {
#pragma unroll
        for (int bk = 0; bk < 4; ++bk)
#pragma unroll
            for (int r = 0; r < 16; ++r) X[(bk * 16 + r) * 64] = o[bk][r] * rl[r];
    }
    __syncthreads();
    if (comp == 0) {
        float ss[16];
#pragma unroll
        for (int r = 0; r < 16; ++r) ss[r] = 0.f;
#pragma unroll
        for (int bk = 0; bk < 4; ++bk)
#pragma unroll
            for (int r = 0; r < 16; ++r) { const float v = o[bk][r] * rl[r] - X[(bk * 16 + r) * 64]; o[bk][r] = v; ss[r] += v * v; }
#pragma unroll
        for (int r = 0; r < 16; ++r) {
            float s = ss[r];
            s += __shfl_xor(s, 1); s += __shfl_xor(s, 2); s += __shfl_xor(s, 4); s += __shfl_xor(s, 8); s += __shfl_xor(s, 16);
            ss[r] = 1.0f / sqrtf(s * (1.0f / 128.0f) + 1e-6f);
        }
        AT_LAS bf16_t* stg = (AT_LAS bf16_t*)(lds + L_OST) + w4 * 4096;
#pragma unroll
        for (int bk = 0; bk < 4; ++bk)
#pragma unroll
            for (int r = 0; r < 16; ++r) { const float v = o[bk][r] * ss[r]; stg[crow(r, hi) * 128 + bk * 32 + r32] = (bf16_t)(cvtpk(v, 0.f) & 0xffffu); }
        asm volatile("s_waitcnt lgkmcnt(0)" ::: "memory");
        bf16_t* Ow = P.qkv + (rowb + q0 + w4 * 32) * LD + h * 128;
#pragma unroll
        for (int i = 0; i < 8; ++i) { const int row = i * 4 + (lane >> 4), c = lane & 15; const u32x4 v = *(const AT_LAS u32x4*)(stg + row * 128 + c * 8); *(u32x4*)(Ow + (size_t)row * LD + c * 8) = v; }
    }
    __syncthreads();
#undef AT_LOAD
#undef AT_STORE
}
}
namespace scan {
using pg8::bf16_t; using pg8::bf16x8; using pg8::f32x4; using pg8::u32x4; using pg8::u32x2;
typedef float f32x16 __attribute__((ext_vector_type(16)));
#define SC_LAS __attribute__((address_space(3)))
constexpr int LD = 5120, SEQ = 2048, CH = 64;
constexpr int L_C = 0;
constexpr int L_B = 16384;
constexpr int L_BD = 32768;
constexpr int L_XD = 49152;
constexpr int L_X = 57344;
constexpr int L_G = 65536;
constexpr int L_H = 73728;
constexpr int L_Y = 90112;
constexpr int L_S = L_Y + 64 * 68 * 4;
constexpr int LDS_BYTES = L_S + 1024;
__device__ __forceinline__ unsigned cvtpk(float lo, float hi) { typedef float f2 __attribute__((ext_vector_type(2))); typedef __bf16 b2 __attribute__((ext_vector_type(2))); f2 v = {lo, hi}; b2 b = __builtin_convertvector(v, b2); return __builtin_bit_cast(unsigned, b); }
__device__ __forceinline__ float bf2f(unsigned short u) { return __builtin_bit_cast(float, (unsigned)u << 16); }
typedef short s16x4 __attribute__((ext_vector_type(4)));
__device__ __forceinline__ s16x4 vtr(const SC_LAS char* p) { typedef short v4 __attribute__((ext_vector_type(4))); return __builtin_bit_cast(s16x4, __builtin_amdgcn_ds_read_tr16_b64_v4i16((SC_LAS v4*)p)); }
__device__ __forceinline__ float silu_fast(float v) { return v * __builtin_amdgcn_rcpf(1.0f + __builtin_amdgcn_exp2f(-1.4426950408889634f * v)); }

struct Params { bf16_t* proj; const float* dt; const float* conv_w; const float* conv_b; const float* a_log; const float* dskip; float* ssqp; };

__device__ __forceinline__ void unit(const Params& P, int b, int h, SC_LAS char* lds) {
    int tid = threadIdx.x; asm volatile("" : "+v"(tid));
    const int lane = tid & 63, wid = __builtin_amdgcn_readfirstlane(tid >> 6);
    const int g = h >> 3;
    const size_t rowb = (size_t)b * SEQ;
    SC_LAS float* s_dt = (SC_LAS float*)(lds + L_S); SC_LAS float* s_acs = s_dt + 64; SC_LAS float* s_dec = s_dt + 128; SC_LAS float* s_ea = s_dt + 192;
    const float a_h = -expf(P.a_log[h]), dsk = P.dskip[h];
    const bool has_item = tid < 320;
    const int cg = tid % 40, tg = tid / 40;
    int chan;
    if (cg < 8) chan = h * 64 + cg * 8; else if (cg < 24) chan = 2048 + g * 128 + (cg - 8) * 8; else chan = 2560 + g * 128 + (cg - 24) * 8;
    float cw[4][8], cbias[8];
    if (has_item) {
#pragma unroll
        for (int k = 0; k < 4; ++k) { const f32x4 a = *(const f32x4*)(P.conv_w + k * 3072 + chan), c = *(const f32x4*)(P.conv_w + k * 3072 + chan + 4);
            cw[k][0] = a[0]; cw[k][1] = a[1]; cw[k][2] = a[2]; cw[k][3] = a[3]; cw[k][4] = c[0]; cw[k][5] = c[1]; cw[k][6] = c[2]; cw[k][7] = c[3]; }
        const f32x4 a = *(const f32x4*)(P.conv_b + chan), c = *(const f32x4*)(P.conv_b + chan + 4);
        cbias[0] = a[0]; cbias[1] = a[1]; cbias[2] = a[2]; cbias[3] = a[3]; cbias[4] = c[0]; cbias[5] = c[1]; cbias[6] = c[2]; cbias[7] = c[3];
    }
    unsigned zu = 0u; asm volatile("" : "+v"(zu));
    for (int i = tid; i < 16384 / 16; i += 512) *(SC_LAS u32x4*)(lds + L_H + i * 16) = (u32x4){zu, zu, zu, zu};
    f32x16 hacc;
#pragma unroll
    for (int r = 0; r < 16; ++r) hacc[r] = 0.f;
    const int nq = wid & 3, ph = wid >> 2;
    const int tid0 = tid;
    for (int c = 0; c < SEQ / CH; ++c) {
        const int t0 = c * CH;
        int tid = tid0; asm volatile("" : "+v"(tid));
        const int lane = tid & 63, r32 = lane & 31, hi = lane >> 5, fr = lane & 15, fq = lane >> 4;
        const int orow = tid >> 3, ocg = tid & 7;
        const int cg = tid % 40, tg = tid / 40;
        if (wid == 0) {
            const float dtv = P.dt[(rowb + t0 + lane) * 32 + h];
            float acs = dtv * a_h;
#pragma unroll
            for (int o = 1; o < 64; o <<= 1) { const float up = __shfl_up(acs, o); if (lane >= o) acs += up; }
            const float last = __shfl(acs, 63);
            s_dt[lane] = dtv; s_acs[lane] = acs; s_dec[lane] = __expf(last - acs); s_ea[lane] = __expf(acs);
        }
        bf16_t* zp = P.proj + (rowb + t0 + orow) * LD + h * 64 + ocg * 8;
        const u32x4 zreg = *(const u32x4*)zp;
        u32x4 xin[11];
        if (has_item) {
#pragma unroll
            for (int i = 0; i < 11; ++i) {
                const int t = t0 + tg * 8 - 3 + i;
                xin[i] = (t >= 0) ? *(const u32x4*)(P.proj + (rowb + t) * LD + 2048 + chan) : (u32x4){zu, zu, zu, zu};
            }
        }
        __syncthreads();
        if (has_item) {
            const int l0 = tg * 8;
#pragma unroll
            for (int tt = 0; tt < 8; ++tt) {
                const int l = l0 + tt;
                float o[8];
#pragma unroll
                for (int ch = 0; ch < 8; ++ch) {
                    float v = cbias[ch];
#pragma unroll
                    for (int k = 0; k < 4; ++k) { const unsigned w = xin[tt + k][ch >> 1]; const float xv = (ch & 1) ? __builtin_bit_cast(float, w & 0xffff0000u) : __builtin_bit_cast(float, w << 16); v = fmaf(cw[k][ch], xv, v); }
                    o[ch] = silu_fast(v);
                }
                u32x4 w; w.x = cvtpk(o[0], o[1]); w.y = cvtpk(o[2], o[3]); w.z = cvtpk(o[4], o[5]); w.w = cvtpk(o[6], o[7]);
                const int img = (l >> 4) * 1024 + ((l >> 3) & 1) * 512 + (l & 7) * 64;
                if (cg < 8) {
                    *(SC_LAS u32x4*)(lds + L_X + l * 128 + cg * 16) = w;
                    const float d = s_dt[l];
                    u32x4 w2; w2.x = cvtpk(o[0] * d, o[1] * d); w2.y = cvtpk(o[2] * d, o[3] * d); w2.z = cvtpk(o[4] * d, o[5] * d); w2.w = cvtpk(o[6] * d, o[7] * d);
                    *(SC_LAS u32x4*)(lds + L_XD + (cg >> 2) * 4096 + img + (cg & 3) * 16) = w2;
                } else if (cg < 24) {
                    const int c16 = cg - 8;
                    *(SC_LAS u32x4*)(lds + L_B + l * 256 + ((c16 ^ (l & 15)) << 4)) = w;
                    const float d = s_dec[l];
                    u32x4 w2; w2.x = cvtpk(o[0] * d, o[1] * d); w2.y = cvtpk(o[2] * d, o[3] * d); w2.z = cvtpk(o[4] * d, o[5] * d); w2.w = cvtpk(o[6] * d, o[7] * d);
                    *(SC_LAS u32x4*)(lds + L_BD + (c16 >> 2) * 4096 + img + (c16 & 3) * 16) = w2;
                } else {
                    const int c16 = cg - 24;
                    *(SC_LAS u32x4*)(lds + L_C + l * 256 + ((c16 ^ (l & 15)) << 4)) = w;
                }
            }
        }
        __syncthreads();
        f32x4 yo[2];
#pragma unroll
        for (int j = 0; j < 2; ++j) {
            const int tile = wid * 2 + j, lt = tile >> 2, st = tile & 3;
            f32x4 cbt = {0.f, 0.f, 0.f, 0.f};
            if (st <= lt) {
                const int srow = 16 * st + fr, lrow = 16 * lt + fr;
#pragma unroll
                for (int kk = 0; kk < 4; ++kk) {
                    const int chk = 4 * kk + fq;
                    const bf16x8 a = *(const SC_LAS bf16x8*)(lds + L_B + srow * 256 + ((chk ^ (srow & 15)) << 4));
                    const bf16x8 bb = *(const SC_LAS bf16x8*)(lds + L_C + lrow * 256 + ((chk ^ (lrow & 15)) << 4));
                    cbt = __builtin_amdgcn_mfma_f32_16x16x32_bf16(a, bb, cbt, 0, 0, 0);
                }
            }
            {
                const int l = 16 * lt + fr, s0 = 16 * st + 4 * fq;
                const float al = s_acs[l];
                float gv[4];
#pragma unroll
                for (int e = 0; e < 4; ++e) { const int s = s0 + e; gv[e] = (s <= l) ? cbt[e] * __expf(al - s_acs[s]) : 0.f; }
                u32x2 w; w.x = cvtpk(gv[0], gv[1]); w.y = cvtpk(gv[2], gv[3]);
                *(SC_LAS u32x2*)(lds + L_G + l * 128 + (((s0 >> 3) ^ (l & 7)) << 4) + (s0 & 7) * 2) = w;
            }
            {
                const int pt = st, lrow = 16 * lt + fr, prow = 16 * pt + fr;
                f32x4 acc = {0.f, 0.f, 0.f, 0.f};
#pragma unroll
                for (int kk = 0; kk < 4; ++kk) {
                    const int chk = 4 * kk + fq;
                    const bf16x8 a = *(const SC_LAS bf16x8*)(lds + L_C + lrow * 256 + ((chk ^ (lrow & 15)) << 4));
                    const bf16x8 bb = *(const SC_LAS bf16x8*)(lds + L_H + prow * 256 + ((chk ^ (prow & 15)) << 4));
                    acc = __builtin_amdgcn_mfma_f32_16x16x32_bf16(a, bb, acc, 0, 0, 0);
                }
                yo[j] = acc;
            }
        }
        __syncthreads();
#pragma unroll
        for (int j = 0; j < 2; ++j) {
            const int tile = wid * 2 + j, lt = tile >> 2, pt = tile & 3;
            const int lrow = 16 * lt + fr, prow = 16 * pt + fr;
            f32x4 acc = {0.f, 0.f, 0.f, 0.f};
#pragma unroll
            for (int kk = 0; kk < 2; ++kk) {
                const int chk = 4 * kk + fq;
                const bf16x8 a = *(const SC_LAS bf16x8*)(lds + L_G + lrow * 128 + ((chk ^ (lrow & 7)) << 4));
                const SC_LAS char* bp = lds + L_XD + (pt >> 1) * 4096 + (2 * kk + (fq >> 1)) * 1024 + (fq & 1) * 512 + ((lane & 15) >> 2) * 64 + ((pt & 1) * 16 + (lane & 3) * 4) * 2;
                const s16x4 b0 = vtr(bp), b1 = vtr(bp + 256);
                const bf16x8 bb = {b0[0], b0[1], b0[2], b0[3], b1[0], b1[1], b1[2], b1[3]};
                acc = __builtin_amdgcn_mfma_f32_16x16x32_bf16(a, bb, acc, 0, 0, 0);
            }
#pragma unroll
            for (int e = 0; e < 4; ++e) { const int l = 16 * lt + 4 * fq + e; ((SC_LAS float*)(lds + L_Y))[l * 68 + 16 * pt + fr] = acc[e] + s_ea[l] * yo[j][e]; }
        }
        {
            const float cd = __expf(s_acs[63]);
#pragma unroll
            for (int r = 0; r < 16; ++r) hacc[r] *= cd;
            const int prow = 32 * ph + r32;
            const int tb = ((lane >> 4) & 1) * 32 + (lane & 3) * 8 + (4 * hi + ((lane & 15) >> 2)) * 64;
#pragma unroll
            for (int ks = 0; ks < 4; ++ks) {
                const s16x4 a0 = vtr(lds + L_BD + nq * 4096 + ks * 1024 + tb), a1 = vtr(lds + L_BD + nq * 4096 + ks * 1024 + 512 + tb);
                const s16x4 b0 = vtr(lds + L_XD + ph * 4096 + ks * 1024 + tb), b1 = vtr(lds + L_XD + ph * 4096 + ks * 1024 + 512 + tb);
                const bf16x8 a = {a0[0], a0[1], a0[2], a0[3], a1[0], a1[1], a1[2], a1[3]};
                const bf16x8 bb = {b0[0], b0[1], b0[2], b0[3], b1[0], b1[1], b1[2], b1[3]};
                hacc = __builtin_amdgcn_mfma_f32_32x32x16_bf16(a, bb, hacc, 0, 0, 0);
            }
#pragma unroll
            for (int q4 = 0; q4 < 4; ++q4) {
                const int n0 = 32 * nq + 8 * q4 + 4 * hi;
                u32x2 w; w.x = cvtpk(hacc[4 * q4 + 0], hacc[4 * q4 + 1]); w.y = cvtpk(hacc[4 * q4 + 2], hacc[4 * q4 + 3]);
                *(SC_LAS u32x2*)(lds + L_H + prow * 256 + (((n0 >> 3) ^ (prow & 15)) << 4) + (n0 & 7) * 2) = w;
            }
        }
        __syncthreads();
        {
            const SC_LAS float* yr = (const SC_LAS float*)(lds + L_Y) + orow * 68 + ocg * 8;
            const f32x4 y0 = *(const SC_LAS f32x4*)yr, y1 = *(const SC_LAS f32x4*)(yr + 4);
            const u32x4 xs = *(const SC_LAS u32x4*)(lds + L_X + orow * 128 + ocg * 16);
            float yv[8];
#pragma unroll
            for (int i = 0; i < 4; ++i) {
                const float xlo = __builtin_bit_cast(float, xs[i] << 16), xhi = __builtin_bit_cast(float, xs[i] & 0xffff0000u);
                const float zlo = __builtin_bit_cast(float, zreg[i] << 16), zhi = __builtin_bit_cast(float, zreg[i] & 0xffff0000u);
                const float ya = (i < 2) ? y0[2 * i] : y1[2 * i - 4], yb = (i < 2) ? y0[2 * i + 1] : y1[2 * i - 3];
                yv[2 * i] = (ya + dsk * xlo) * silu_fast(zlo); yv[2 * i + 1] = (yb + dsk * xhi) * silu_fast(zhi);
            }
            float ss = 0.f;
#pragma unroll
            for (int i = 0; i < 8; ++i) ss += yv[i] * yv[i];
            ss += __shfl_xor(ss, 1); ss += __shfl_xor(ss, 2); ss += __shfl_xor(ss, 4);
            if (ocg == 0) P.ssqp[(rowb + t0 + orow) * 32 + h] = ss;
            u32x4 w; w.x = cvtpk(yv[0], yv[1]); w.y = cvtpk(yv[2], yv[3]); w.z = cvtpk(yv[4], yv[5]); w.w = cvtpk(yv[6], yv[7]);
            *(u32x4*)zp = w;
        }
    }
    __syncthreads();
}
}
namespace mk {
#define GAS __attribute__((address_space(1)))
#define LAS __attribute__((address_space(3)))
typedef unsigned short bf16;
typedef unsigned v4u __attribute__((ext_vector_type(4)));
typedef float f32x4 __attribute__((ext_vector_type(4)));
typedef GAS unsigned gu32;
#define RLX_AGENT __ATOMIC_RELAXED, __HIP_MEMORY_SCOPE_AGENT
constexpr int NWAVES = 8;
constexpr int M = 16384, D = 1024, SEQ = 2048, NB = 8;
constexpr int SSD_NP = 5376, SSD_IN = 5152, SSD_DI = 2048, SSD_LD = 5120;
constexpr int AT_IN = 3072, DFF = 2816;
constexpr size_t MiB = 1u << 20;
constexpr size_t WS_CTL = 0, CTL_ZERO_BYTES = 64 * 1024;
constexpr size_t WS_CONST = 64 * 1024;
constexpr size_t WS_SSQ = 1 * MiB;
constexpr size_t WS_ROPE = 2 * MiB;
constexpr size_t WS_DT = 3 * MiB;
constexpr size_t WS_SSQP = 5 * MiB;
constexpr size_t WS_W = 7 * MiB;
constexpr size_t W_SSD_IN = 0, W_SSD_IN_SZ = (size_t)SSD_NP * D * 2;
constexpr size_t W_SSD_OUT = W_SSD_IN + 2 * W_SSD_IN_SZ, W_SSD_OUT_SZ = (size_t)D * SSD_DI * 2;
constexpr size_t W_AT_IN = W_SSD_OUT + 2 * W_SSD_OUT_SZ, W_AT_IN_SZ = (size_t)AT_IN * D * 2;
constexpr size_t W_AT_OUT = W_AT_IN + 2 * W_AT_IN_SZ, W_AT_OUT_SZ = (size_t)D * D * 2;
constexpr size_t W_UP = W_AT_OUT + 2 * W_AT_OUT_SZ, W_UP_SZ = (size_t)2 * DFF * D * 2;
constexpr size_t W_DOWN = W_UP + 4 * W_UP_SZ, W_DOWN_SZ = (size_t)D * DFF * 2;
constexpr size_t W_TOTAL = W_DOWN + 4 * W_DOWN_SZ;
constexpr size_t WS_XB = ((WS_W + W_TOTAL + MiB - 1) / MiB) * MiB;
constexpr size_t XB_PAD_FRONT = 2 * D * 2, XB_BYTES = (size_t)(M + 256) * D * 2;
constexpr size_t WS_BIG = ((WS_XB + XB_BYTES + MiB - 1) / MiB) * MiB;
constexpr size_t BIG_BYTES = (size_t)M * SSD_LD * 2;
constexpr size_t WS_DBG = WS_BIG + BIG_BYTES;
constexpr size_t WS_END = WS_DBG;
static_assert(WS_END <= 352 * MiB, "workspace map exceeds the guaranteed 352 MiB");
constexpr int CW_BAR = 1024;
constexpr int RING_BYTES = 131072, EPI_OFF = RING_BYTES, EPI_BYTES = 8192, MISC_OFF = EPI_OFF + EPI_BYTES;
constexpr int LDS_BYTES = 147456;
static_assert(MISC_OFF + 1024 <= LDS_BYTES && attn::LDS_BYTES <= RING_BYTES && scan::LDS_BYTES <= RING_BYTES, "LDS map");

#define LDS_WAIT() asm volatile("s_waitcnt lgkmcnt(0)" ::: "memory")
__device__ __forceinline__ unsigned f2bf(float f) { unsigned u = __builtin_bit_cast(unsigned, f); return (u + 0x7fffu + ((u >> 16) & 1u)) >> 16; }
__device__ __forceinline__ unsigned pk2(float lo, float hi) { return f2bf(lo) | (f2bf(hi) << 16); }

#define XB_TMO      128
#define XB_XCNT(j)  (256  + 64 * (j))
#define XB_XSUB(j)  (1280 + 64 * (j))
#define XB_XGEN(j)  (2304 + 64 * (j))
#define XB_TOP      3328
#define XB_TOPGEN   3392
#define XCD_BAR_WORDS 3456
#define XB_SPIN_CAP (1u << 20)
__device__ __forceinline__ unsigned xb_ld(unsigned* p)              { return __hip_atomic_load(p, __ATOMIC_RELAXED, __HIP_MEMORY_SCOPE_AGENT); }
__device__ __forceinline__ unsigned xb_add(unsigned* p, unsigned v) { return __hip_atomic_fetch_add(p, v, __ATOMIC_RELAXED, __HIP_MEMORY_SCOPE_AGENT); }
__device__ __forceinline__ unsigned xb_xcc_id() { return (unsigned)__builtin_amdgcn_s_getreg((3 << 11) | 20) & 0xFu; }
#define XB_SPIN(cond, bar) do { unsigned _sp = 0; while (cond) { __builtin_amdgcn_s_sleep(1); \
    if ((++_sp & 255u) == 0u) { if (xb_ld(&(bar)[XB_TMO])) break; if (_sp > XB_SPIN_CAP) { atomicAdd(&(bar)[XB_TMO], 1u); break; } } } } while (0)
struct XcdBarrier { unsigned* bar; unsigned x; volatile LAS unsigned* st; };
__device__ __forceinline__ XcdBarrier xcd_barrier_post(unsigned* bar, volatile LAS unsigned* st) {
    XcdBarrier b; b.bar = bar; b.x = xb_xcc_id(); b.st = st;
    if (threadIdx.x == 0) (void)xb_add(&bar[XB_XCNT(b.x)], 1u);
    return b;
}
__device__ __forceinline__ void xcd_barrier_complete(unsigned* bar, unsigned x, unsigned& nloc, unsigned& nx) {
    const unsigned G = gridDim.x * gridDim.y * gridDim.z;
    unsigned sum, cnt, mine, sp = 0u;
    for (;;) {
        sum = 0u; cnt = 0u; mine = 0u;
#pragma unroll
        for (unsigned j = 0; j < 16; ++j) { const unsigned c = xb_ld(&bar[XB_XCNT(j)]); sum += c; cnt += (c > 0u) ? 1u : 0u; mine = (j == x) ? c : mine; }
        if (sum == G) break;
        __builtin_amdgcn_s_sleep(1);
        if ((++sp & 255u) == 0u) { if (xb_ld(&bar[XB_TMO])) break; if (sp > XB_SPIN_CAP) { atomicAdd(&bar[XB_TMO], 1u); break; } }
    }
    nloc = mine > 0u ? mine : 1u; nx = cnt > 0u ? cnt : 1u;
}
__device__ __forceinline__ void xcd_barrier(const XcdBarrier& b) {
    asm volatile("s_waitcnt vmcnt(0)" ::: "memory");
    __syncthreads();
    if (threadIdx.x == 0) {
        unsigned* bar = b.bar; asm volatile("" : "+s"(bar));
        __builtin_amdgcn_s_waitcnt(0);
        unsigned nloc = b.st[0], nx = b.st[1];
        if (nloc == 0u) { xcd_barrier_complete(bar, b.x, nloc, nx); b.st[0] = nloc; b.st[1] = nx; }
        const unsigned old = xb_add(&bar[XB_XSUB(b.x)], 1u);
        const unsigned gen = old / nloc;
        if (old + 1u == (gen + 1u) * nloc) {
            __builtin_amdgcn_fence(__ATOMIC_RELEASE, "agent");
            asm volatile("s_waitcnt vmcnt(0)" ::: "memory");
            const unsigned og = xb_add(&bar[XB_TOP], 1u);
            const unsigned tg = og / nx;
            if (og + 1u == (tg + 1u) * nx) xb_add(&bar[XB_TOPGEN], 1u);
            else XB_SPIN(xb_ld(&bar[XB_TOPGEN]) == tg, bar);
            __builtin_amdgcn_fence(__ATOMIC_ACQUIRE, "agent");
            xb_add(&bar[XB_XGEN(b.x)], 1u);
            asm volatile("s_waitcnt vmcnt(0)" ::: "memory");
        } else {
            XB_SPIN(xb_ld(&bar[XB_XGEN(b.x)]) == gen, bar);
            __builtin_amdgcn_fence(__ATOMIC_ACQUIRE, "agent");
            asm volatile("s_waitcnt vmcnt(0)" ::: "memory");
        }
    }
    __syncthreads();
}

__device__ __forceinline__ unsigned long long ldarg(LAS unsigned long long* AP, int i) {
    asm volatile("" : "+s"(i));
    const unsigned long long v = AP[i];
    return ((unsigned long long)(unsigned)__builtin_amdgcn_readfirstlane((int)(v >> 32)) << 32) | (unsigned long long)(unsigned)__builtin_amdgcn_readfirstlane((int)v);
}
struct Args { const void* in[25]; float* out; unsigned char* ws; int ph_lo, ph_hi; int dbg, pad; };

__device__ __forceinline__ float wave_sum(float v) {
#pragma unroll
    for (int o = 1; o < 64; o <<= 1) v += __shfl_xor(v, o);
    return v;
}
template <class RowMap>
__device__ __forceinline__ void transpose_item(const float* W, int K, int N, const float* gain, int gmask, float gscale, bf16* WT, const RowMap& rm, LAS float* scr, int item, int lane) {
    const int nblk = N / 32, kb = item / nblk, nb = item % nblk, k0 = 64 * kb, n0 = 32 * nb;
#pragma unroll 8
    for (int i = 0; i < 32; ++i) { const int kk = 2 * i + (lane >> 5); const float gv = gain ? gain[(k0 + kk) & gmask] * gscale : 1.0f; scr[kk * 33 + (lane & 31)] = W[(size_t)(k0 + kk) * N + n0 + (lane & 31)] * gv; }
    LDS_WAIT(); asm volatile("" ::: "memory");
    const int c = lane & 7;
#pragma unroll
    for (int j = 0; j < 4; ++j) { const int n = (lane >> 3) + 8 * j; const LAS float* s = scr + (8 * c) * 33 + n;
        v4u o; o.x = pk2(s[0 * 33], s[1 * 33]); o.y = pk2(s[2 * 33], s[3 * 33]); o.z = pk2(s[4 * 33], s[5 * 33]); o.w = pk2(s[6 * 33], s[7 * 33]);
        *(GAS v4u*)(WT + (size_t)rm(n0 + n) * K + k0 + 8 * c) = o; }
    LDS_WAIT(); asm volatile("" ::: "memory");
}
struct RowId { __device__ __forceinline__ int operator()(int n) const { return n; } };
struct RowUp { __device__ __forceinline__ int operator()(int n) const { const int u = n >= DFF, ch = u ? n - DFF : n; return (ch >> 7) * 256 + u * 128 + (ch & 127); } };

__global__ void __launch_bounds__(NWAVES * 64, 2) mega_fwd(Args args) {
    extern __shared__ __attribute__((aligned(16))) unsigned char lds_raw[];
    LAS unsigned char* lds = (LAS unsigned char*)lds_raw;
    volatile LAS unsigned* MISC = (volatile LAS unsigned*)(lds + MISC_OFF);
    const int G = gridDim.x; const int bx = blockIdx.x; const int vcu = (G % 8 == 0) ? (bx % 8) * (G / 8) + bx / 8 : bx;
    gu32* ctl = (gu32*)(args.ws + WS_CTL);
    if (threadIdx.x < 64) MISC[threadIdx.x] = 0u;
    __syncthreads();
    XcdBarrier bar = xcd_barrier_post((unsigned*)ctl + CW_BAR, MISC + 8);
#define GRID_BAR() xcd_barrier(bar)
    LAS unsigned long long* AP = (LAS unsigned long long*)(lds + MISC_OFF + 256);
    if (threadIdx.x < 27) AP[threadIdx.x] = ((const unsigned long long*)&args)[threadIdx.x];
    __syncthreads();
#define ARGP(T, i) ((T)(GAS void*)ldarg(AP, i))
#define x_in   ARGP(const float*, 0)
#define pos    ARGP(const int*, 1)
#define nmg    ARGP(const float*, 2)
#define nfg    ARGP(const float*, 3)
#define s_inw  ARGP(const float*, 4)
#define s_cw   ARGP(const float*, 5)
#define s_cb   ARGP(const float*, 6)
#define s_dtb  ARGP(const float*, 7)
#define s_alog ARGP(const float*, 8)
#define s_d    ARGP(const float*, 9)
#define s_ng   ARGP(const float*, 10)
#define s_ow   ARGP(const float*, 11)
#define a_inw  ARGP(const float*, 12)
#define a_qg   ARGP(const float*, 13)
#define a_kg   ARGP(const float*, 14)
#define a_lq1  ARGP(const float*, 15)
#define a_lk1  ARGP(const float*, 16)
#define a_lq2  ARGP(const float*, 17)
#define a_lk2  ARGP(const float*, 18)
#define a_sg   ARGP(const float*, 19)
#define a_ow   ARGP(const float*, 20)
#define f_uw   ARGP(const float*, 21)
#define f_cw   ARGP(const float*, 22)
#define f_cb   ARGP(const float*, 23)
#define f_dw   ARGP(const float*, 24)
#define xout   ARGP(float*, 25)
#define ws     ARGP(unsigned char*, 26)
#define cst    ((float*)(ws + WS_CONST))
#define SSQ    ((float*)(ws + WS_SSQ))
#define ROPE   ((float*)(ws + WS_ROPE))
#define DT     ((float*)(ws + WS_DT))
#define SSQP   ((float*)(ws + WS_SSQP))
#define Wb     ((bf16*)(ws + WS_W))
#define XB     ((bf16*)(ws + WS_XB + XB_PAD_FRONT))
#define BIG    ((bf16*)(ws + WS_BIG))
    const int lo = args.ph_lo, hi = args.ph_hi;
    int phase = 0;
#define IN_PHASE() (phase >= lo && phase < hi)
#define END_PHASE() do { if (IN_PHASE() && phase + 1 < hi) GRID_BAR(); ++phase; } while (0)

    if (IN_PHASE()) {
        int tid = threadIdx.x; asm volatile("" : "+v"(tid));
        const int lane = tid & 63, wave = __builtin_amdgcn_readfirstlane(tid >> 6);
        LAS float* scr = (LAS float*)(lds + wave * 16384);
        const int gw = vcu * NWAVES + wave, NGW = G * NWAVES;
        constexpr int I_SI = (D / 64) * (SSD_IN / 32), I_SO = (SSD_DI / 64) * (D / 32), I_AI = (D / 64) * (AT_IN / 32), I_AO = (D / 64) * (D / 32), I_UP = (D / 64) * (2 * DFF / 32), I_DN = (DFF / 64) * (D / 32);
        constexpr int NITEMS = 2 * I_SI + 2 * I_SO + 2 * I_AI + 2 * I_AO + 4 * I_UP + 4 * I_DN;
        for (int it = gw; it < NITEMS; it += NGW) {
            int r = it;
            if (r < 2 * I_SI) { const int j = r / I_SI; transpose_item(s_inw + (size_t)j * D * SSD_IN, D, SSD_IN, nmg + (2 * j) * D, 1023, 1.0f, (bf16*)((char*)Wb + W_SSD_IN + j * W_SSD_IN_SZ), RowId(), scr, r % I_SI, lane); continue; } r -= 2 * I_SI;
            if (r < 2 * I_SO) { const int j = r / I_SO; transpose_item(s_ow + (size_t)j * SSD_DI * D, SSD_DI, D, s_ng + j * SSD_DI, 2047, 1.0f, (bf16*)((char*)Wb + W_SSD_OUT + j * W_SSD_OUT_SZ), RowId(), scr, r % I_SO, lane); continue; } r -= 2 * I_SO;
            if (r < 2 * I_AI) { const int j = r / I_AI; transpose_item(a_inw + (size_t)j * D * AT_IN, D, AT_IN, nmg + (2 * j + 1) * D, 1023, 1.0f, (bf16*)((char*)Wb + W_AT_IN + j * W_AT_IN_SZ), RowId(), scr, r % I_AI, lane); continue; } r -= 2 * I_AI;
            if (r < 2 * I_AO) { const int j = r / I_AO; const float li = 0.8f - 0.6f * expf(-0.3f * (float)(2 * j + 1));
                transpose_item(a_ow + (size_t)j * D * D, D, D, a_sg + j * 128, 127, 1.0f - li, (bf16*)((char*)Wb + W_AT_OUT + j * W_AT_OUT_SZ), RowId(), scr, r % I_AO, lane); continue; } r -= 2 * I_AO;
            if (r < 4 * I_UP) { const int j = r / I_UP; transpose_item(f_uw + (size_t)j * D * 2 * DFF, D, 2 * DFF, nfg + j * D, 1023, 1.0f, (bf16*)((char*)Wb + W_UP + j * W_UP_SZ), RowUp(), scr, r % I_UP, lane); continue; } r -= 4 * I_UP;
            { const int j = r / I_DN; transpose_item(f_dw + (size_t)j * DFF * D, DFF, D, nullptr, 0, 1.0f, (bf16*)((char*)Wb + W_DOWN + j * W_DOWN_SZ), RowId(), scr, r % I_DN, lane); }
        }
        for (int j = 0; j < 2; ++j) { v4u* p = (v4u*)((char*)Wb + W_SSD_IN + j * W_SSD_IN_SZ + (size_t)SSD_IN * D * 2); const int n16 = (SSD_NP - SSD_IN) * D * 2 / 16;
            for (int i = vcu * 512 + tid; i < n16; i += G * 512) p[i] = (v4u){0u, 0u, 0u, 0u}; }
        { v4u* p = (v4u*)(ws + WS_XB); for (int i = vcu * 512 + tid; i < (int)(XB_PAD_FRONT / 16); i += G * 512) p[i] = (v4u){0u, 0u, 0u, 0u};
          v4u* q = (v4u*)((char*)XB + (size_t)M * D * 2); for (int i = vcu * 512 + tid; i < 254 * D * 2 / 16; i += G * 512) q[i] = (v4u){0u, 0u, 0u, 0u}; }
        for (int m = gw; m < M; m += NGW) {
            const f32x4* xr = (const f32x4*)(x_in + (size_t)m * D) + lane; float s = 0.f;
            unsigned long long* o8 = (unsigned long long*)(XB + (size_t)m * D) + lane;
#pragma unroll
            for (int j = 0; j < 4; ++j) { const f32x4 v = xr[64 * j]; s += (v[0] * v[0] + v[1] * v[1]) + (v[2] * v[2] + v[3] * v[3]); o8[64 * j] = (unsigned long long)pk2(v[0], v[1]) | ((unsigned long long)pk2(v[2], v[3]) << 32); }
            s = wave_sum(s);
            if (lane < 4) SSQ[(size_t)m * 4 + lane] = (lane == 0) ? s : 0.f;
            if (lane >= 16 && lane < 32) { const int i = lane & 7; const float invf = powf(500000.0f, -(float)(2 * i) / 16.0f); const float ang = (float)pos[m] * invf; ROPE[(size_t)m * 16 + (lane - 16)] = (lane < 24) ? cosf(ang) : sinf(ang); }
        }
        if (bx == 0 && wave == 0) {
            for (int j = 0; j < 2; ++j) {
                float mq = fabsf(a_qg[j * 64 + lane]), mkk = fabsf(a_kg[j * 64 + lane]);
                float d1 = a_lq1[j * 64 + lane] * a_lk1[j * 64 + lane], d2 = a_lq2[j * 64 + lane] * a_lk2[j * 64 + lane];
#pragma unroll
                for (int o = 1; o < 64; o <<= 1) { mq = fmaxf(mq, __shfl_xor(mq, o)); mkk = fmaxf(mkk, __shfl_xor(mkk, o)); d1 += __shfl_xor(d1, o); d2 += __shfl_xor(d2, o); }
                const float li = 0.8f - 0.6f * expf(-0.3f * (float)(2 * j + 1));
                if (lane == 0) { cst[j] = mq * mkk * 64.0f * 0.125f * 1.4426950408889634f * 1.002f + 0.01f; cst[2 + j] = expf(d1) - expf(d2) + li; }
            }
        }
    }
    END_PHASE();

    for (int layer = 0; layer < 4; ++layer) {
        const int j = layer >> 1;
        const float* xsrc = (layer == 0) ? x_in : xout;
        if ((layer & 1) == 0) {
            if (IN_PHASE()) {
                pg8::Gemm g{XB, (const bf16*)((const char*)Wb + W_SSD_IN + j * W_SSD_IN_SZ), D, D, 256, 0};
                pg8::StaticOrder S; S.init(M / 256, SSD_NP / 256, G, bx);
                epi::EpiSsdIn E{BIG, DT, s_dtb + j * 32, SSQ};
                pg8::gemm_phase(lds, lds + EPI_OFF, g, S, E);
            }
            END_PHASE();
            if (IN_PHASE()) {
                scan::Params sp{BIG, DT, s_cw + (size_t)j * 4 * 3072, s_cb + (size_t)j * 3072, s_alog + j * 32, s_d + j * 32, SSQP};
                for (int u = vcu; u < NB * 32; u += G) scan::unit(sp, u >> 5, u & 31, (LAS char*)lds);
            }
            END_PHASE();
            if (IN_PHASE()) {
                int tid = threadIdx.x; asm volatile("" : "+v"(tid));
                const int nitems = M * 256;
                for (int i = (vcu * 512 + tid); i < nitems; i += G * 512) {
                    const int row = i >> 8, c16 = i & 255, grp = c16 >> 6;
                    const f32x4* sp4 = (const f32x4*)(SSQP + (size_t)row * 32 + grp * 8);
                    const f32x4 a = sp4[0], b = sp4[1];
                    const float s = ((a[0] + a[1]) + (a[2] + a[3])) + ((b[0] + b[1]) + (b[2] + b[3]));
                    const float rs = 1.0f / sqrtf(s * (1.0f / 512.0f) + 1e-6f);
                    v4u* p = (v4u*)(BIG + (size_t)row * SSD_LD + c16 * 8);
                    v4u v = *p;
#pragma unroll
                    for (int e = 0; e < 4; ++e) { const float lo_ = __builtin_bit_cast(float, v[e] << 16) * rs, hi_ = __builtin_bit_cast(float, v[e] & 0xffff0000u) * rs; v[e] = pk2(lo_, hi_); }
                    *p = v;
                }
            }
            END_PHASE();
            if (IN_PHASE()) {
                pg8::Gemm g{BIG, (const bf16*)((const char*)Wb + W_SSD_OUT + j * W_SSD_OUT_SZ), SSD_LD, SSD_DI, 256, 0};
                pg8::StaticOrder S; S.init(M / 256, D / 256, G, bx);
                epi::EpiResidual E{xsrc, xout, XB, SSQ};
                pg8::gemm_phase(lds, lds + EPI_OFF, g, S, E);
            }
            END_PHASE();
        } else {
            if (IN_PHASE()) {
                pg8::Gemm g{XB, (const bf16*)((const char*)Wb + W_AT_IN + j * W_AT_IN_SZ), D, D, 256, 0};
                pg8::StaticOrder S; S.init(M / 256, AT_IN / 256, G, bx);
                epi::EpiQKV E{BIG, SSQ, a_qg + j * 64, a_kg + j * 64, ROPE};
                pg8::gemm_phase(lds, lds + EPI_OFF, g, S, E);
            }
            END_PHASE();
            if (IN_PHASE()) {
                attn::Params ap{BIG, cst[j], cst[2 + j], 0.f};
                for (int pi = vcu; pi < 512; pi += G) {
                    const int bh = pi >> 3, s = pi & 7;
                    attn::unit(ap, bh >> 3, bh & 7, s, (LAS char*)lds);
                    attn::unit(ap, bh >> 3, bh & 7, 15 - s, (LAS char*)lds);
                }
            }
            END_PHASE();
            if (IN_PHASE()) {
                pg8::Gemm g{BIG, (const bf16*)((const char*)Wb + W_AT_OUT + j * W_AT_OUT_SZ), AT_IN, D, 256, 0};
                pg8::StaticOrder S; S.init(M / 256, D / 256, G, bx);
                epi::EpiResidual E{xsrc, xout, XB, SSQ};
                pg8::gemm_phase(lds, lds + EPI_OFF, g, S, E);
            }
            END_PHASE();
        }
        if (IN_PHASE()) {
            pg8::Gemm g{XB, (const bf16*)((const char*)Wb + W_UP + layer * W_UP_SZ), D, D, 254, -2};
            pg8::StaticOrder S; S.init(65, 2 * DFF / 256, G, bx);
            epi::EpiConvGate E{BIG, SSQ, f_cw + (size_t)layer * 3 * 2 * DFF, f_cb + (size_t)layer * 2 * DFF};
            pg8::gemm_phase(lds, lds + EPI_OFF, g, S, E);
        }
        END_PHASE();
        if (IN_PHASE()) {
            pg8::Gemm g{BIG, (const bf16*)((const char*)Wb + W_DOWN + layer * W_DOWN_SZ), DFF, DFF, 256, 0};
            pg8::StaticOrder S; S.init(M / 256, D / 256, G, bx);
            epi::EpiResidual E{xout, xout, XB, SSQ};
            pg8::gemm_phase(lds, lds + EPI_OFF, g, S, E);
        }
        END_PHASE();
    }
}
#undef x_in
#undef pos
#undef nmg
#undef nfg
#undef s_inw
#undef s_cw
#undef s_cb
#undef s_dtb
#undef s_alog
#undef s_d
#undef s_ng
#undef s_ow
#undef a_inw
#undef a_qg
#undef a_kg
#undef a_lq1
#undef a_lk1
#undef a_lq2
#undef a_lk2
#undef a_sg
#undef a_ow
#undef f_uw
#undef f_cw
#undef f_cb
#undef f_dw
#undef xout
#undef ws
#undef cst
#undef SSQ
#undef ROPE
#undef DT
#undef SSQP
#undef Wb
#undef XB
#undef BIG
#undef ARGP
constexpr int N_PHASES = 1 + 2 * 6 + 2 * 5;

static int g_grid = 0;
static void launch(void* const* d_in, float* d_out, void* d_ws, int ph_lo, int ph_hi, hipStream_t stream) {
    if (g_grid == 0) {
        int dev = 0, cus = 0;
        if (hipGetDevice(&dev) != hipSuccess || hipDeviceGetAttribute(&cus, hipDeviceAttributeMultiprocessorCount, dev) != hipSuccess) { fprintf(stderr, "device query failed\n"); g_grid = -1; return; }
        if (hipFuncSetAttribute((const void*)mega_fwd, hipFuncAttributeMaxDynamicSharedMemorySize, LDS_BYTES) != hipSuccess) { fprintf(stderr, "hipFuncSetAttribute failed\n"); g_grid = -1; return; }
        int per_cu = 0;
        (void)hipOccupancyMaxActiveBlocksPerMultiprocessor(&per_cu, (const void*)mega_fwd, NWAVES * 64, LDS_BYTES);
        (void)hipGetLastError();
        g_grid = cus;
        fprintf(stderr, "mega_fwd: %d CUs, occupancy query %d per CU\n", cus, per_cu);
    }
    if (g_grid < 0) return;
    (void)hipMemsetAsync((char*)d_ws + WS_CTL, 0, CTL_ZERO_BYTES, stream);
    Args a{};
    for (int i = 0; i < 25; ++i) a.in[i] = d_in[i];
    a.out = d_out; a.ws = (unsigned char*)d_ws; a.ph_lo = ph_lo; a.ph_hi = ph_hi;
    void* params[] = {&a};
    hipError_t e = hipLaunchCooperativeKernel((const void*)mega_fwd, dim3(g_grid), dim3(NWAVES * 64), params, LDS_BYTES, stream);
    if (e != hipSuccess) fprintf(stderr, "cooperative launch failed: %s (grid %d)\n", hipGetErrorString(e), g_grid);
}
}
extern "C" void kernel_launch(void* const* d_in, const int* in_sizes, int n_in, void* d_out, int out_size, void* d_ws, size_t ws_size, hipStream_t stream) {
    (void)in_sizes; (void)n_in; (void)out_size; (void)ws_size;
    mk::launch(d_in, (float*)d_out, d_ws, 0, mk::N_PHASES, stream);
}
```

```cpp
#include <hip/hip_runtime.h>
#include <stdint.h>
#include <math.h>
#include <cstdio>
namespace pg8 {
#define PG8_LAS __attribute__((address_space(3)))
typedef unsigned short bf16_t;
typedef short bf16x8 __attribute__((ext_vector_type(8)));
typedef float f32x4 __attribute__((ext_vector_type(4)));
typedef unsigned u32x4 __attribute__((ext_vector_type(4)));
typedef unsigned u32x2 __attribute__((ext_vector_type(2)));
constexpr int BM = 256, BK = 64, HALF = 128, HTB = HALF * BK * 2  , STAGE_BYTES = 8 * HTB, NXCD = 8, WGM = 8;

__host__ __device__ __forceinline__ int lds_byte(int r, int c) { const int st = (r >> 4) * 2 + (c >> 5), rr = r & 15, cc = c & 31, ob = rr * 64 + cc * 2; return st * 1024 + (ob ^ (((ob >> 9) & 1) << 5)); }
__host__ __device__ __forceinline__ void stage_rc(int b, int& R, int& C) { const int st = b / 1024, sb = b % 1024, swz = sb ^ (((sb >> 9) & 1) << 5); R = (st >> 1) * 16 + swz / 64; C = (st & 1) * 32 + (swz % 64) / 2; }
__host__ __device__ __forceinline__ int perm32(int rho) { const int n = rho >> 4, i = rho & 15; return 8 * (i >> 2) + 4 * n + (i & 3); }

struct Unit { int pm, pn; };
struct Gemm { const bf16_t* A; const bf16_t* Bt; int lda, K, a_stride, a_off; };

struct StaticOrder {
    int nM, nN, nwg, G, c;
    __host__ __device__ void init(int nM_, int nN_, int G_, int c_) { nM = nM_; nN = nN_; nwg = nM * nN; G = G_; c = c_; }
    __host__ __device__ bool next(int i, Unit& u) const {
        const long L = (long)i * G + c; if (L >= nwg) return false;
        int wgid = (int)L; { const int q = nwg / NXCD, r = nwg % NXCD, xcd = wgid % NXCD, off = wgid / NXCD; wgid = (xcd < r ? xcd * (q + 1) : r * (q + 1) + (xcd - r) * q) + off; }
        const int nig = WGM * nN, gid = wgid / nig, fm = gid * WGM, gsz = (nM - fm) < WGM ? (nM - fm) : WGM;
        u.pm = fm + ((wgid % nig) % gsz); u.pn = (wgid % nig) / gsz; return true;
    }
};

__device__ __forceinline__ unsigned cvt_pk_bf16(float lo, float hi) { unsigned r; asm volatile("v_cvt_pk_bf16_f32 %0, %1, %2" : "=v"(r) : "v"(lo), "v"(hi)); return r; }

template <class Epi, class Sched>
__device__ __forceinline__ void gemm_phase(PG8_LAS unsigned char* lds, PG8_LAS unsigned char* elds, const Gemm g, const Sched& S, const Epi& E) {
    int tid = threadIdx.x; asm volatile("" : "+v"(tid));
    const int wid = __builtin_amdgcn_readfirstlane(tid >> 6), lane = tid & 63, wr = wid >> 2, wc = wid & 3, fr = lane & 15, fq = lane >> 4;
    const int K = g.K, nt = K / BK, lda = g.lda;
    unsigned voffA[2], voffB[2]; int aoff, boff;
#define PG8_LANECONST() do { int t_ = threadIdx.x; asm volatile("" : "+v"(t_)); const int fr_ = t_ & 15, fq_ = (t_ >> 4) & 3; \
        _Pragma("unroll") for (int i = 0; i < 2; ++i) { int R, C; stage_rc(t_ * 16 + i * 8192, R, C); const int Rb = Epi::PERM ? ((R & ~31) + perm32(R & 31)) : R; \
            voffA[i] = (unsigned)(R * lda + C) * 2u; voffB[i] = (unsigned)(Rb * K + C) * 2u; } \
        aoff = lds_byte(wr * 64 + fr_, fq_ * 8); boff = lds_byte(wc * 32 + fr_, fq_ * 8); } while (0)
    PG8_LANECONST();
    const size_t kstep = (size_t)(BK * 2);
    const size_t hstepA = (size_t)HALF * lda * 2, hstepB = (size_t)HALF * K * 2;
    const size_t tstepB = 2 * hstepB;
    const unsigned ldsw = (unsigned)wid * 1024u;
#define PG8_SA(b, h) (((b) * 2 + (h)) * HTB)
#define PG8_SB(b, h) ((4 + (b) * 2 + (h)) * HTB)
#define PG8_STAGE(bufoff, gbase, voff) do { _Pragma("unroll") for (int _i = 0; _i < 2; ++_i) \
        __builtin_amdgcn_global_load_lds((const unsigned*)((const char*)(gbase) + (voff)[_i]), (PG8_LAS unsigned*)(lds + (bufoff) + ldsw + _i * 8192), 16, 0, 0); } while (0)
#define PG8_LDA(dst, b, h) do { _Pragma("unroll") for (int m = 0; m < 4; ++m) _Pragma("unroll") for (int k = 0; k < 2; ++k) dst[m][k] = *(const PG8_LAS bf16x8*)(lds + PG8_SA(b, h) + aoff + m * 2048 + k * 1024); } while (0)
#define PG8_LDB(dst, b, h) do { _Pragma("unroll") for (int n = 0; n < 2; ++n) _Pragma("unroll") for (int k = 0; k < 2; ++k) dst[n][k] = *(const PG8_LAS bf16x8*)(lds + PG8_SB(b, h) + boff + n * 2048 + k * 1024); } while (0)
#define PG8_MMA(ai, bj, At, Bt) do { __builtin_amdgcn_s_setprio(1); _Pragma("unroll") for (int m = 0; m < 4; ++m) _Pragma("unroll") for (int n = 0; n < 2; ++n) _Pragma("unroll") for (int k = 0; k < 2; ++k) \
        acc[ai][bj][m][n] = __builtin_amdgcn_mfma_f32_16x16x32_bf16(Bt[n][k], At[m][k], acc[ai][bj][m][n], 0, 0, 0); __builtin_amdgcn_s_setprio(0); } while (0)
#define PG8_WAIT_V(n) asm volatile("s_waitcnt vmcnt(" #n ")" ::: "memory")
#define PG8_WAIT_L(n) asm volatile("s_waitcnt lgkmcnt(" #n ")" ::: "memory")
#define PG8_BAR __builtin_amdgcn_s_barrier()
#define PG8_SCHED __builtin_amdgcn_sched_barrier(0)
    Unit cur, nxt; int ui = 0;
    if (!S.next(0, cur)) return;
    float zf = 0.f; asm volatile("" : "+v"(zf));
    f32x4 acc[2][2][4][2];
#pragma unroll
    for (int a = 0; a < 2; ++a)
#pragma unroll
        for (int b = 0; b < 2; ++b)
#pragma unroll
            for (int m = 0; m < 4; ++m)
#pragma unroll
                for (int n = 0; n < 2; ++n) acc[a][b][m][n] = (f32x4){zf, zf, zf, zf};
    bf16x8 At[4][2], B0[2][2], B1[2][2];
    const char* cA = (const char*)g.A + ((long)cur.pm * g.a_stride + g.a_off) * (long)lda * 2; const char* cB = (const char*)g.Bt + (size_t)cur.pn * tstepB;
    PG8_STAGE(PG8_SB(0, 0), cB, voffB); PG8_STAGE(PG8_SB(0, 1), cB + hstepB, voffB); PG8_STAGE(PG8_SA(0, 0), cA, voffA); PG8_STAGE(PG8_SA(0, 1), cA + hstepA, voffA);
    if (wr == 1) PG8_BAR;
    PG8_WAIT_V(2); PG8_BAR;
    PG8_STAGE(PG8_SB(1, 0), cB + kstep, voffB); PG8_STAGE(PG8_SA(1, 0), cA + kstep, voffA); PG8_STAGE(PG8_SB(1, 1), cB + hstepB + kstep, voffB);
    PG8_WAIT_V(6); PG8_BAR;
    for (;;) {
        const bool has_next = S.next(ui + 1, nxt);
        const char* nA = has_next ? (const char*)g.A + ((long)nxt.pm * g.a_stride + g.a_off) * (long)lda * 2 : cA; const char* nB = has_next ? (const char*)g.Bt + (size_t)nxt.pn * tstepB : cB;
        for (int t = 0; t < nt; t += 2) {
            const bool last = (t == nt - 2);
            const char* a1 = cA + (size_t)(t + 1) * kstep;
            const char* a2 = last ? nA : cA + (size_t)(t + 2) * kstep; const char* b2 = last ? nB : cB + (size_t)(t + 2) * kstep;
            const char* a3 = a2 + kstep; const char* b3 = b2 + kstep;
            PG8_LDB(B0, 0, 0); PG8_LDB(B1, 0, 1); PG8_SCHED; PG8_LDA(At, 0, 0); PG8_STAGE(PG8_SA(1, 1), a1 + hstepA, voffA);
            PG8_WAIT_V(8); PG8_WAIT_L(0); PG8_BAR; PG8_MMA(0, 0, At, B0); PG8_MMA(0, 1, At, B1); PG8_BAR; PG8_SCHED;
            PG8_LDA(At, 0, 1); PG8_STAGE(PG8_SB(0, 0), b2, voffB); PG8_STAGE(PG8_SB(0, 1), b2 + hstepB, voffB); PG8_STAGE(PG8_SA(0, 0), a2, voffA);
            PG8_WAIT_V(8); PG8_WAIT_L(0); PG8_BAR; PG8_MMA(1, 0, At, B0); PG8_MMA(1, 1, At, B1); PG8_BAR; PG8_SCHED;
            PG8_LDB(B0, 1, 0); PG8_LDB(B1, 1, 1); PG8_SCHED; PG8_LDA(At, 1, 0); PG8_STAGE(PG8_SA(0, 1), a2 + hstepA, voffA);
            PG8_WAIT_V(8); PG8_WAIT_L(0); PG8_BAR; PG8_MMA(0, 0, At, B0); PG8_MMA(0, 1, At, B1); PG8_BAR; PG8_SCHED;
            PG8_LDA(At, 1, 1); PG8_STAGE(PG8_SB(1, 0), b3, voffB); PG8_STAGE(PG8_SB(1, 1), b3 + hstepB, voffB); PG8_STAGE(PG8_SA(1, 0), a3, voffA);
            PG8_WAIT_V(8); PG8_WAIT_L(0); PG8_BAR; PG8_MMA(1, 0, At, B0); PG8_MMA(1, 1, At, B1); PG8_BAR; PG8_SCHED;
        }
        if (wr == 0) PG8_BAR;
        E(acc, cur, wr, wc, elds);
        if (!has_next) break;
#pragma unroll
        for (int a = 0; a < 2; ++a)
#pragma unroll
            for (int b = 0; b < 2; ++b)
#pragma unroll
                for (int m = 0; m < 4; ++m)
#pragma unroll
                    for (int n = 0; n < 2; ++n) acc[a][b][m][n] = (f32x4){zf, zf, zf, zf};
        cur = nxt; cA = nA; cB = nB; ++ui;
        PG8_LANECONST();
        if (wr == 1) PG8_BAR;
    }
    PG8_WAIT_V(0);
    PG8_BAR;
#undef PG8_LANECONST
#undef PG8_SA
#undef PG8_SB
#undef PG8_STAGE
#undef PG8_LDA
#undef PG8_LDB
#undef PG8_MMA
}
}
namespace epi {
using pg8::f32x4; using pg8::u32x4; using pg8::u32x2; using pg8::bf16_t; using pg8::Unit; using pg8::cvt_pk_bf16;
constexpr int MROWS = 16384, DMODEL = 1024;
constexpr float EPS = 1e-6f;
#define EPI_LAS __attribute__((address_space(3)))

__device__ __forceinline__ float row_rstd(const float* ssq, int row) {
    const f32x4 a = *(const f32x4*)(ssq + (size_t)row * 4);
    const float s = (a[0] + a[1]) + (a[2] + a[3]);
    return 1.0f / sqrtf(s * (1.0f / DMODEL) + EPS);
}
__device__ __forceinline__ void rstd8(const float* ssq, int row0, bool clamp, float (&rs)[2][4]) {
    f32x4 p[2][4];
#pragma unroll
    for (int ai = 0; ai < 2; ++ai)
#pragma unroll
        for (int m = 0; m < 4; ++m) { int row = row0 + ai * 128 + m * 16; if (clamp) row = row < 0 ? 0 : (row >= MROWS ? MROWS - 1 : row); p[ai][m] = *(const f32x4*)(ssq + (size_t)row * 4); }
#pragma unroll
    for (int ai = 0; ai < 2; ++ai)
#pragma unroll
        for (int m = 0; m < 4; ++m) { const f32x4 a = p[ai][m]; rs[ai][m] = 1.0f / sqrtf(((a[0] + a[1]) + (a[2] + a[3])) * (1.0f / DMODEL) + EPS); }
}
template <int CTRL> __device__ __forceinline__ float dppf(float old, float src) {
    return __builtin_bit_cast(float, __builtin_amdgcn_update_dpp(__builtin_bit_cast(int, old), __builtin_bit_cast(int, src), CTRL, 0xF, 0xF, false));
}
template <int CTRL> __device__ __forceinline__ float dppz(float src) {
    return __builtin_bit_cast(float, __builtin_amdgcn_update_dpp(0, __builtin_bit_cast(int, src), CTRL, 0xF, 0xF, true));
}
__device__ __forceinline__ float silu_fast(float v) { return v * __builtin_amdgcn_rcpf(1.0f + __builtin_amdgcn_exp2f(-1.4426950408889634f * v)); }

struct EpiResidual {
    static constexpr bool PERM = false;
    const float* xin; float* xout; bf16_t* xb; float* ssq; int dry;
    __device__ __forceinline__ void operator()(f32x4 (&acc)[2][2][4][2], const Unit& u, int wr, int wc, EPI_LAS unsigned char* elds) const {
        int fr, fq; { int t_ = threadIdx.x; asm volatile("" : "+v"(t_)); fr = t_ & 15; fq = (t_ >> 4) & 3; }
        EPI_LAS float* P = (EPI_LAS float*)elds;
        const int col0 = u.pn * 256 + wc * 32 + 4 * fq;
#pragma unroll
        for (int ai = 0; ai < 2; ++ai) {
            f32x4 xv[4][2][2];
#pragma unroll
            for (int m = 0; m < 4; ++m)
#pragma unroll
                for (int bj = 0; bj < 2; ++bj)
#pragma unroll
                    for (int n = 0; n < 2; ++n) xv[m][bj][n] = *(const f32x4*)(xin + (size_t)(u.pm * 256 + ai * 128 + wr * 64 + m * 16 + fr) * DMODEL + col0 + bj * 128 + n * 16);
#pragma unroll
            for (int m = 0; m < 4; ++m) {
                const int row = u.pm * 256 + ai * 128 + wr * 64 + m * 16 + fr;
                const size_t off = (size_t)row * DMODEL + col0;
                float s = 0.f;
#pragma unroll
                for (int bj = 0; bj < 2; ++bj)
#pragma unroll
                    for (int n = 0; n < 2; ++n) {
                        const size_t o = off + bj * 128 + n * 16;
                        const f32x4 v = xv[m][bj][n] + acc[ai][bj][m][n];
                        if (!dry) *(f32x4*)(xout + o) = v;
                        u32x2 w; w.x = cvt_pk_bf16(v[0], v[1]); w.y = cvt_pk_bf16(v[2], v[3]);
                        *(u32x2*)(xb + o) = w;
                        s += (v[0] * v[0] + v[1] * v[1]) + (v[2] * v[2] + v[3] * v[3]);
                    }
                s += __shfl_xor(s, 16); s += __shfl_xor(s, 32);
                if (fq == 0) P[(ai * 128 + wr * 64 + m * 16 + fr) * 4 + wc] = s;
            }
            asm volatile("" ::: "memory");
        }
        asm volatile("s_waitcnt lgkmcnt(0)" ::: "memory"); __builtin_amdgcn_s_barrier(); asm volatile("" ::: "memory");
        { const int t = (wr * 4 + wc) * 64 + fq * 16 + fr; if (t < 256) { const f32x4 p = *(const EPI_LAS f32x4*)(P + t * 4); ssq[(size_t)(u.pm * 256 + t) * 4 + u.pn] = (p[0] + p[1]) + (p[2] + p[3]); } }
        asm volatile("s_waitcnt lgkmcnt(0)" ::: "memory"); __builtin_amdgcn_s_barrier(); asm volatile("" ::: "memory");
    }
};

struct EpiSsdIn {
    static constexpr bool PERM = true;
    bf16_t* proj; float* dt; const float* dtbias; const float* ssq;
    __device__ __forceinline__ void operator()(f32x4 (&acc)[2][2][4][2], const Unit& u, int wr, int wc, EPI_LAS unsigned char*) const {
        int fr, fq; { int t_ = threadIdx.x; asm volatile("" : "+v"(t_)); fr = t_ & 15; fq = (t_ >> 4) & 3; }
        float rsv[2][4]; rstd8(ssq, u.pm * 256 + wr * 64 + fr, false, rsv);
#pragma unroll
        for (int ai = 0; ai < 2; ++ai)
#pragma unroll
            for (int m = 0; m < 4; ++m) {
                const int row = u.pm * 256 + ai * 128 + wr * 64 + m * 16 + fr;
                const float rs = rsv[ai][m];
                if (u.pn < 20) {
#pragma unroll
                    for (int bj = 0; bj < 2; ++bj) {
                        const f32x4 v0 = acc[ai][bj][m][0] * rs, v1 = acc[ai][bj][m][1] * rs;
                        u32x4 w; w.x = cvt_pk_bf16(v0[0], v0[1]); w.y = cvt_pk_bf16(v0[2], v0[3]); w.z = cvt_pk_bf16(v1[0], v1[1]); w.w = cvt_pk_bf16(v1[2], v1[3]);
                        *(u32x4*)(proj + (size_t)row * 5120 + u.pn * 256 + bj * 128 + wc * 32 + 8 * fq) = w;
                    }
                } else if (wc == 0) {
#pragma unroll
                    for (int n = 0; n < 2; ++n) {
                        const int c = 8 * fq + 4 * n;
                        const f32x4 b = *(const f32x4*)(dtbias + c);
                        f32x4 v = acc[ai][0][m][n] * rs + b, o;
#pragma unroll
                        for (int e = 0; e < 4; ++e) o[e] = fmaxf(v[e], 0.f) + log1pf(expf(-fabsf(v[e])));
                        *(f32x4*)(dt + (size_t)row * 32 + c) = o;
                    }
                }
            }
    }
};

struct EpiQKV {
    static constexpr bool PERM = true;
    bf16_t* proj; const float* ssq; const float* qg; const float* kg; const float* rope;
    __device__ __forceinline__ void operator()(f32x4 (&acc)[2][2][4][2], const Unit& u, int wr, int wc, EPI_LAS unsigned char* elds) const {
        int fr, fq; { int t_ = threadIdx.x; asm volatile("" : "+v"(t_)); fr = t_ & 15; fq = (t_ >> 4) & 3; }
        EPI_LAS float* P = (EPI_LAS float*)elds;
        const bool isqk = u.pn < 8;
        float rsv[2][4]; rstd8(ssq, u.pm * 256 + wr * 64 + fr, false, rsv);
#pragma unroll
        for (int ai = 0; ai < 2; ++ai)
#pragma unroll
            for (int m = 0; m < 4; ++m) {
                const int trow = ai * 128 + wr * 64 + m * 16 + fr;
                const float rs = rsv[ai][m];
#pragma unroll
                for (int bj = 0; bj < 2; ++bj) {
                    acc[ai][bj][m][0] *= rs; acc[ai][bj][m][1] *= rs;
                    if (isqk) {
                        const f32x4 a = acc[ai][bj][m][0], b = acc[ai][bj][m][1];
                        float s = ((a[0] * a[0] + a[1] * a[1]) + (a[2] * a[2] + a[3] * a[3])) + ((b[0] * b[0] + b[1] * b[1]) + (b[2] * b[2] + b[3] * b[3]));
                        s += __shfl_xor(s, 16); s += __shfl_xor(s, 32);
                        if (fq == 0) P[trow * 8 + bj * 4 + wc] = s;
                    }
                }
            }
        if (isqk) {
            asm volatile("s_waitcnt lgkmcnt(0)" ::: "memory"); __builtin_amdgcn_s_barrier(); asm volatile("" ::: "memory");
            const float* g = (u.pn < 4) ? qg : kg;
            const int d0 = 32 * (wc & 1) + 8 * fq;
            const f32x4 g0 = *(const f32x4*)(g + d0), g1 = *(const f32x4*)(g + d0 + 4);
            const float qs = (u.pn < 4) ? (1.4426950408889634f * 0.125f) : 1.0f;
            const bool dorope = (wc & 1) == 0;
#pragma unroll
            for (int ai = 0; ai < 2; ++ai)
#pragma unroll
                for (int m = 0; m < 4; ++m) {
                    const int trow = ai * 128 + wr * 64 + m * 16 + fr;
                    const int row = u.pm * 256 + trow;
                    f32x4 c0 = {1.f, 1.f, 1.f, 1.f}, c1 = c0, s0 = {0.f, 0.f, 0.f, 0.f}, s1 = s0;
                    if (dorope && fq < 2) {
                        const f32x4* rp = (const f32x4*)(rope + (size_t)row * 16);
                        c0 = rp[0]; c1 = rp[1]; s0 = rp[2]; s1 = rp[3];
                        if (fq == 0) { s0 = -s0; s1 = -s1; }
                    }
#pragma unroll
                    for (int bj = 0; bj < 2; ++bj) {
                        const float tot = P[trow * 8 + bj * 4 + wc] + P[trow * 8 + bj * 4 + (wc ^ 1)];
                        const float nr = qs / sqrtf(tot * (1.0f / 64.0f) + EPS);
                        f32x4 v0 = acc[ai][bj][m][0] * g0 * nr, v1 = acc[ai][bj][m][1] * g1 * nr;
                        if (dorope) {
                            f32x4 o0, o1;
#pragma unroll
                            for (int e = 0; e < 4; ++e) { o0[e] = __shfl_xor(v0[e], 16); o1[e] = __shfl_xor(v1[e], 16); }
                            v0 = v0 * c0 + o0 * s0; v1 = v1 * c1 + o1 * s1;
                        }
                        u32x4 w; w.x = cvt_pk_bf16(v0[0], v0[1]); w.y = cvt_pk_bf16(v0[2], v0[3]); w.z = cvt_pk_bf16(v1[0], v1[1]); w.w = cvt_pk_bf16(v1[2], v1[3]);
                        *(u32x4*)(proj + (size_t)row * 3072 + u.pn * 256 + bj * 128 + wc * 32 + 8 * fq) = w;
                    }
                    asm volatile("" ::: "memory");
                }
            asm volatile("s_waitcnt lgkmcnt(0)" ::: "memory"); __builtin_amdgcn_s_barrier(); asm volatile("" ::: "memory");
        } else {
#pragma unroll
            for (int ai = 0; ai < 2; ++ai)
#pragma unroll
                for (int m = 0; m < 4; ++m) {
                    const int row = u.pm * 256 + ai * 128 + wr * 64 + m * 16 + fr;
#pragma unroll
                    for (int bj = 0; bj < 2; ++bj) {
                        const f32x4 v0 = acc[ai][bj][m][0], v1 = acc[ai][bj][m][1];
                        u32x4 w; w.x = cvt_pk_bf16(v0[0], v0[1]); w.y = cvt_pk_bf16(v0[2], v0[3]); w.z = cvt_pk_bf16(v1[0], v1[1]); w.w = cvt_pk_bf16(v1[2], v1[3]);
                        *(u32x4*)(proj + (size_t)row * 3072 + u.pn * 256 + bj * 128 + wc * 32 + 8 * fq) = w;
                    }
                }
        }
    }
};

struct EpiSsdConv {
    static constexpr bool PERM = true;
    bf16_t* zp; bf16_t* xbc; float* dt; const float* ssq; const float* cp;
    template <bool MASK>
    __device__ __forceinline__ void conv_body(f32x4 (&acc)[2][2][4][2], const Unit& u, int wr, int wc, int fr, int fq, const EPI_LAS f32x4* hb, int R0) const {
        constexpr int NP = 5376;
        bf16_t* const obase = (u.pn < 8) ? zp + u.pn * 256 : xbc + (u.pn - 8) * 256;
        const int old_ = (u.pn < 8) ? 2048 : 3072;
#pragma unroll
        for (int bj = 0; bj < 2; ++bj) {
            u32x2 keep[2][4];
#pragma unroll
            for (int n = 0; n < 2; ++n) {
                const int tc = bj * 128 + wc * 32 + 8 * fq + 4 * n, col = u.pn * 256 + tc;
                const f32x4 bb = *(const f32x4*)(cp + col), w0 = *(const f32x4*)(cp + NP + col), w1 = *(const f32x4*)(cp + 2 * NP + col), w2 = *(const f32x4*)(cp + 3 * NP + col), w3 = *(const f32x4*)(cp + 4 * NP + col);
#pragma unroll
                for (int ai = 0; ai < 2; ++ai) {
                    f32x4 pv = {0.f, 0.f, 0.f, 0.f};
                    const int pwr = wr ^ 1, pai = (wr == 1) ? ai : ai - 1;
                    if (pai >= 0 && fr >= 13) pv = hb[((((pwr * 2 + pai) * 4 + wc) * 3 + (fr - 13)) * 4 + fq) * 4 + bj * 2 + n];
#pragma unroll
                    for (int m = 0; m < 4; ++m) {
                        const int trow = ai * 128 + wr * 64 + m * 16 + fr, row = R0 + trow;
                        const f32x4 cv = acc[ai][bj][m][n];
                        const f32x4 qv = (m == 0) ? pv : acc[ai][bj][m - 1][n];
                        bool k1 = true, k2 = true, k3 = true;
                        if (MASK) { const int ts = row & 2047; k1 = ts >= 1; k2 = ts >= 2; k3 = ts >= 3; }
                        float o[4];
#pragma unroll
                        for (int e = 0; e < 4; ++e) {
                            float x1 = dppf<0x111>(dppf<0x121>(0.f, qv[e]), cv[e]);
                            float x2 = dppf<0x112>(dppf<0x122>(0.f, qv[e]), cv[e]);
                            float x3 = dppf<0x113>(dppf<0x123>(0.f, qv[e]), cv[e]);
                            if (MASK) { x1 = k1 ? x1 : 0.f; x2 = k2 ? x2 : 0.f; x3 = k3 ? x3 : 0.f; }
                            o[e] = bb[e] + w0[e] * x3 + w1[e] * x2 + w2[e] * x1 + w3[e] * cv[e];
                        }
                        const bool valid = trow >= 3 && row < MROWS;
#pragma unroll
                        for (int e = 0; e < 4; ++e) o[e] = silu_fast(o[e]);
                        if (n == 0) { keep[ai][m].x = cvt_pk_bf16(o[0], o[1]); keep[ai][m].y = cvt_pk_bf16(o[2], o[3]); }
                        else if (valid) {
                            u32x4 w; w.x = keep[ai][m].x; w.y = keep[ai][m].y; w.z = cvt_pk_bf16(o[0], o[1]); w.w = cvt_pk_bf16(o[2], o[3]);
                            *(u32x4*)(obase + (size_t)row * old_ + tc - 4) = w;
                        }
                        asm volatile("" ::: "memory");
                    }
                }
            }
        }
    }
    __device__ __forceinline__ void operator()(f32x4 (&acc)[2][2][4][2], const Unit& u, int wr, int wc, EPI_LAS unsigned char* elds) const {
        int fr, fq; { int t_ = threadIdx.x; asm volatile("" : "+v"(t_)); fr = t_ & 15; fq = (t_ >> 4) & 3; }
        const int R0 = u.pm * 253 - 3;
        EPI_LAS f32x4* hb = (EPI_LAS f32x4*)elds;
        { float rsv[2][4]; rstd8(ssq, R0 + wr * 64 + fr, true, rsv);
#pragma unroll
          for (int ai = 0; ai < 2; ++ai)
#pragma unroll
            for (int m = 0; m < 4; ++m)
#pragma unroll
                for (int bj = 0; bj < 2; ++bj) { acc[ai][bj][m][0] *= rsv[ai][m]; acc[ai][bj][m][1] *= rsv[ai][m]; } }
        if (u.pn == 20) {
            if (wc == 0) {
#pragma unroll
                for (int ai = 0; ai < 2; ++ai)
#pragma unroll
                    for (int m = 0; m < 4; ++m) {
                        const int trow = ai * 128 + wr * 64 + m * 16 + fr, row = R0 + trow;
                        if (trow >= 3 && row < MROWS) {
#pragma unroll
                            for (int n = 0; n < 2; ++n) {
                                const int c = 8 * fq + 4 * n;
                                const f32x4 b = *(const f32x4*)(cp + 20 * 256 + c);
                                f32x4 v = acc[ai][0][m][n] + b, o;
#pragma unroll
                                for (int e = 0; e < 4; ++e) o[e] = fmaxf(v[e], 0.f) + log1pf(expf(-fabsf(v[e])));
                                *(f32x4*)(dt + (size_t)row * 32 + c) = o;
                            }
                        }
                    }
            }
            return;
        }
        if (fr >= 13) {
#pragma unroll
            for (int ai = 0; ai < 2; ++ai) {
                const int idx = ((((wr * 2 + ai) * 4 + wc) * 3 + (fr - 13)) * 4 + fq) * 4;
                hb[idx + 0] = acc[ai][0][3][0]; hb[idx + 1] = acc[ai][0][3][1]; hb[idx + 2] = acc[ai][1][3][0]; hb[idx + 3] = acc[ai][1][3][1];
            }
        }
        asm volatile("s_waitcnt lgkmcnt(0)" ::: "memory"); __builtin_amdgcn_s_barrier(); asm volatile("" ::: "memory");
        const int tf = (u.pm * 253) & 2047;
        if (tf <= 2 || tf + 252 >= 2048) conv_body<true>(acc, u, wr, wc, fr, fq, hb, R0); else conv_body<false>(acc, u, wr, wc, fr, fq, hb, R0);
        asm volatile("s_waitcnt lgkmcnt(0)" ::: "memory"); __builtin_amdgcn_s_barrier(); asm volatile("" ::: "memory");
    }
};

struct EpiConvGate {
    static constexpr bool PERM = true;
    bf16_t* H; const float* ssq; const float* cw; const float* cb;
    template <bool MASK>
    __device__ __forceinline__ void body(f32x4 (&acc)[2][2][4][2], const Unit& u, int wr, int wc, int fr, int fq, const EPI_LAS f32x4* hb, int R0) const {
        constexpr int DFF = 2816;
        u32x2 keep[2][4];
#pragma unroll
        for (int n = 0; n < 2; ++n) {
            const int ch = u.pn * 128 + wc * 32 + 8 * fq + 4 * n;
            const f32x4 bg = *(const f32x4*)(cb + ch), bu = *(const f32x4*)(cb + DFF + ch);
            const f32x4 w0g = *(const f32x4*)(cw + ch), w1g = *(const f32x4*)(cw + 2 * DFF + ch), w2g = *(const f32x4*)(cw + 4 * DFF + ch);
            const f32x4 w0u = *(const f32x4*)(cw + DFF + ch), w1u = *(const f32x4*)(cw + 3 * DFF + ch), w2u = *(const f32x4*)(cw + 5 * DFF + ch);
#pragma unroll
            for (int ai = 0; ai < 2; ++ai) {
                f32x4 pg = {0.f, 0.f, 0.f, 0.f}, pu = pg;
                const int pwr = wr ^ 1, pai = (wr == 1) ? ai : ai - 1;
                if (pai >= 0 && fr >= 14) {
                    const int idx = ((((pwr * 2 + pai) * 4 + wc) * 2 + (fr - 14)) * 4 + fq) * 4;
                    pg = hb[idx + 0 + n]; pu = hb[idx + 2 + n];
                }
#pragma unroll
                for (int m = 0; m < 4; ++m) {
                    const int trow = ai * 128 + wr * 64 + m * 16 + fr, row = R0 + trow;
                    const f32x4 cg = acc[ai][0][m][n], cu = acc[ai][1][m][n];
                    const f32x4 qg_ = (m == 0) ? pg : acc[ai][0][m - 1][n], qu_ = (m == 0) ? pu : acc[ai][1][m - 1][n];
                    bool k1 = true, k2 = true;
                    if (MASK) { const int ts = row & 2047; k1 = ts >= 1; k2 = ts >= 2; }
                    float o[4];
#pragma unroll
                    for (int e = 0; e < 4; ++e) {
                        float g1 = dppf<0x111>(dppf<0x121>(0.f, qg_[e]), cg[e]);
                        float g2 = dppf<0x112>(dppf<0x122>(0.f, qg_[e]), cg[e]);
                        float u1 = dppf<0x111>(dppf<0x121>(0.f, qu_[e]), cu[e]);
                        float u2 = dppf<0x112>(dppf<0x122>(0.f, qu_[e]), cu[e]);
                        if (MASK) { g1 = k1 ? g1 : 0.f; u1 = k1 ? u1 : 0.f; g2 = k2 ? g2 : 0.f; u2 = k2 ? u2 : 0.f; }
                        const float gv = bg[e] + w0g[e] * g2 + w1g[e] * g1 + w2g[e] * cg[e];
                        const float uv = bu[e] + w0u[e] * u2 + w1u[e] * u1 + w2u[e] * cu[e];
                        o[e] = silu_fast(gv) * uv;
                    }
                    if (n == 0) { keep[ai][m].x = cvt_pk_bf16(o[0], o[1]); keep[ai][m].y = cvt_pk_bf16(o[2], o[3]); }
                    else if (trow >= 2 && row < MROWS) {
                        u32x4 w; w.x = keep[ai][m].x; w.y = keep[ai][m].y; w.z = cvt_pk_bf16(o[0], o[1]); w.w = cvt_pk_bf16(o[2], o[3]);
                        *(u32x4*)(H + (size_t)row * DFF + ch - 4) = w;
                    }
                    asm volatile("" ::: "memory");
                }
            }
        }
    }
    __device__ __forceinline__ void operator()(f32x4 (&acc)[2][2][4][2], const Unit& u, int wr, int wc, EPI_LAS unsigned char* elds) const {
        int fr, fq; { int t_ = threadIdx.x; asm volatile("" : "+v"(t_)); fr = t_ & 15; fq = (t_ >> 4) & 3; }
        const int R0 = u.pm * 254 - 2;
        EPI_LAS f32x4* hb = (EPI_LAS f32x4*)elds;
        { float rsv[2][4]; rstd8(ssq, R0 + wr * 64 + fr, true, rsv);
#pragma unroll
          for (int ai = 0; ai < 2; ++ai)
#pragma unroll
            for (int m = 0; m < 4; ++m)
#pragma unroll
                for (int bj = 0; bj < 2; ++bj) { acc[ai][bj][m][0] *= rsv[ai][m]; acc[ai][bj][m][1] *= rsv[ai][m]; } }
        if (fr >= 14) {
#pragma unroll
            for (int ai = 0; ai < 2; ++ai) {
                const int idx = ((((wr * 2 + ai) * 4 + wc) * 2 + (fr - 14)) * 4 + fq) * 4;
                hb[idx + 0] = acc[ai][0][3][0]; hb[idx + 1] = acc[ai][0][3][1]; hb[idx + 2] = acc[ai][1][3][0]; hb[idx + 3] = acc[ai][1][3][1];
            }
        }
        asm volatile("s_waitcnt lgkmcnt(0)" ::: "memory"); __builtin_amdgcn_s_barrier(); asm volatile("" ::: "memory");
        const int tf = (u.pm * 254) & 2047;
        if (tf <= 1 || tf + 253 >= 2048) body<true>(acc, u, wr, wc, fr, fq, hb, R0); else body<false>(acc, u, wr, wc, fr, fq, hb, R0);
        asm volatile("s_waitcnt lgkmcnt(0)" ::: "memory"); __builtin_amdgcn_s_barrier(); asm volatile("" ::: "memory");
    }
};
}
namespace attn {
using pg8::bf16_t; using pg8::bf16x8; using pg8::f32x4; using pg8::u32x4;
typedef float f32x16 __attribute__((ext_vector_type(16)));
typedef short s16x4 __attribute__((ext_vector_type(4)));
#define AT_LAS __attribute__((address_space(3)))
constexpr int LD = 3072, SEQ = 2048;
constexpr int KT_BYTES = 16384, VT_BYTES = 16384, STG = KT_BYTES + VT_BYTES;
constexpr int L_X = 0;
constexpr int L_WSF = 2 * STG;
constexpr int L_OST = L_WSF + 8 * 256;
constexpr int LDS_BYTES = L_OST + 4 * 8192;
__device__ __forceinline__ int crow(int r, int hi) { return (r & 3) + 8 * (r >> 2) + 4 * hi; }
__device__ __forceinline__ unsigned cvtpk(float lo, float hi) { typedef float f2 __attribute__((ext_vector_type(2))); typedef __bf16 b2 __attribute__((ext_vector_type(2))); f2 v = {lo, hi}; b2 b = __builtin_convertvector(v, b2); return __builtin_bit_cast(unsigned, b); }
__device__ __forceinline__ s16x4 vtr(const AT_LAS char* p) { typedef short v4 __attribute__((ext_vector_type(4))); return __builtin_bit_cast(s16x4, __builtin_amdgcn_ds_read_tr16_b64_v4i16((AT_LAS v4*)p)); }

struct Params { bf16_t* qkv; float mb; float lam; int dry; };

__device__ __forceinline__ void unit(const Params& P, int b, int h, int blk, AT_LAS char* lds) {
    int tid = threadIdx.x; asm volatile("" : "+v"(tid));
    const int lane = tid & 63, r32 = lane & 31, hi = lane >> 5;
    const int wid = __builtin_amdgcn_readfirstlane(tid >> 6), comp = wid >> 2, w4 = wid & 3;
    const size_t rowb = (size_t)b * SEQ;
    const int q0 = blk * 128;
    const int nt = 2 * blk + 2, my_nt = 2 * blk + (w4 >> 1) + 1;
    const bf16_t* Kg = P.qkv + rowb * LD + 1024 + h * 128;
    const bf16_t* Vg = P.qkv + rowb * LD + 2048 + h * 128;
    u32x4 kreg[2], vreg[2];
    int kdst[2], vdst[2];
#pragma unroll
    for (int i = 0; i < 2; ++i) {
        const int p = tid + 512 * i, key = p >> 4, c16 = p & 15;
        kdst[i] = key * 256 + ((c16 ^ (key & 15)) << 4);
        vdst[i] = KT_BYTES + (c16 >> 2) * 4096 + (key >> 4) * 1024 + ((key >> 3) & 1) * 512 + (key & 7) * 64 + (c16 & 3) * 16;
    }
#define AT_LOAD(t) do { _Pragma("unroll") for (int i = 0; i < 2; ++i) { const int p = tid + 512 * i, key = p >> 4, c16 = p & 15; const size_t go = (size_t)((t) * 64 + key) * LD + c16 * 8; \
        kreg[i] = *(const u32x4*)(Kg + go); vreg[i] = *(const u32x4*)(Vg + go); } } while (0)
#define AT_STORE(s) do { _Pragma("unroll") for (int i = 0; i < 2; ++i) { *(AT_LAS u32x4*)(lds + (s) * STG + kdst[i]) = kreg[i]; *(AT_LAS u32x4*)(lds + (s) * STG + vdst[i]) = vreg[i]; } } while (0)
    AT_LOAD(0);
    bf16x8 qr[4];
    {
        const bf16_t* Qw = P.qkv + (rowb + q0 + w4 * 32 + r32) * LD + h * 128 + comp * 64 + hi * 8;
#pragma unroll
        for (int d0 = 0; d0 < 4; ++d0) qr[d0] = *(const bf16x8*)(Qw + d0 * 16);
    }
    AT_STORE(0);
    __syncthreads();
    f32x16 o[4];
#pragma unroll
    for (int i = 0; i < 4; ++i)
#pragma unroll
        for (int r = 0; r < 16; ++r) o[i][r] = 0.f;
    float lsum = 0.f;
    f32x16 negm;
#pragma unroll
    for (int r = 0; r < 16; ++r) negm[r] = -P.mb;
    const int kbase = r32 * 256, ksw = r32 & 15;
    const int vbase = KT_BYTES + ((lane >> 4) & 1) * 32 + (lane & 3) * 8 + (4 * hi + ((lane & 15) >> 2)) * 64;
    for (int t = 0; t < nt; ++t) {
        const int s = t & 1;
        if (t + 1 < nt) AT_LOAD(t + 1);
        if (t < my_nt) {
            const AT_LAS char* st = lds + s * STG;
            f32x16 p0 = negm, p1 = negm;
#pragma unroll
            for (int d0 = 0; d0 < 4; ++d0) {
                const int ch = comp * 8 + 2 * d0 + hi;
                const bf16x8 k0 = *(const AT_LAS bf16x8*)(st + kbase + ((ch ^ ksw) << 4));
                const bf16x8 k1 = *(const AT_LAS bf16x8*)(st + kbase + 32 * 256 + ((ch ^ ksw) << 4));
                p0 = __builtin_amdgcn_mfma_f32_32x32x16_bf16(k0, qr[d0], p0, 0, 0, 0);
                p1 = __builtin_amdgcn_mfma_f32_32x32x16_bf16(k1, qr[d0], p1, 0, 0, 0);
            }
            float sacc = 0.f;
#pragma unroll
            for (int r = 0; r < 16; ++r) { p0[r] = __builtin_amdgcn_exp2f(p0[r]); p1[r] = __builtin_amdgcn_exp2f(p1[r]); sacc += p0[r] + p1[r]; }
            lsum += sacc;
            u32x4 pw[4];
#pragma unroll
            for (int j = 0; j < 4; ++j) { pw[0][j] = cvtpk(p0[2 * j], p0[2 * j + 1]); pw[1][j] = cvtpk(p0[8 + 2 * j], p0[8 + 2 * j + 1]); pw[2][j] = cvtpk(p1[2 * j], p1[2 * j + 1]); pw[3][j] = cvtpk(p1[8 + 2 * j], p1[8 + 2 * j + 1]); }
#pragma unroll
            for (int bk = 0; bk < 4; ++bk)
#pragma unroll
                for (int ks = 0; ks < 4; ++ks) {
                    const s16x4 lo = vtr(st + vbase + bk * 4096 + ks * 1024), hh = vtr(st + vbase + bk * 4096 + ks * 1024 + 512);
                    const bf16x8 vf = {lo[0], lo[1], lo[2], lo[3], hh[0], hh[1], hh[2], hh[3]};
                    o[bk] = __builtin_amdgcn_mfma_f32_32x32x16_bf16(__builtin_bit_cast(bf16x8, pw[ks]), vf, o[bk], 0, 0, 0);
                }
        }
        if (t + 1 < nt) AT_STORE(s ^ 1);
        __syncthreads();
    }
    lsum += __shfl_xor(lsum, 32);
    AT_LAS float* wsf = (AT_LAS float*)(lds + L_WSF) + wid * 64;
    if (hi == 0) wsf[r32] = lsum;
    asm volatile("s_waitcnt lgkmcnt(0)" ::: "memory");
    float rl[16];
    const float sc = comp ? P.lam : 1.0f;
#pragma unroll
    for (int r = 0; r < 16; ++r) rl[r] = sc * __builtin_amdgcn_rcpf(wsf[crow(r, hi)]);
    AT_LAS float* X = (AT_LAS float*)(lds + L_X) + w4 * 4096 + lane;
    if (comp == 1) {
#pragma unroll
        for (int bk = 0; bk < 4; ++bk)
#pragma unroll
            for (int r = 0; r < 16; ++r) X[(bk * 16 + r) * 64] = o[bk][r] * rl[r];
    }
    __syncthreads();
    if (comp == 0) {
        float ss[16];
#pragma unroll
        for (int r = 0; r < 16; ++r) ss[r] = 0.f;
#pragma unroll
        for (int bk = 0; bk < 4; ++bk)
#pragma unroll
            for (int r = 0; r < 16; ++r) { const float v = o[bk][r] * rl[r] - X[(bk * 16 + r) * 64]; o[bk][r] = v; ss[r] += v * v; }
#pragma unroll
        for (int r = 0; r < 16; ++r) {
            float s = ss[r];
            s += __shfl_xor(s, 1); s += __shfl_xor(s, 2); s += __shfl_xor(s, 4); s += __shfl_xor(s, 8); s += __shfl_xor(s, 16);
            ss[r] = 1.0f / sqrtf(s * (1.0f / 128.0f) + 1e-6f);
        }
        AT_LAS bf16_t* stg = (AT_LAS bf16_t*)(lds + L_OST) + w4 * 4096;
#pragma unroll
        for (int bk = 0; bk < 4; ++bk)
#pragma unroll
            for (int r = 0; r < 16; ++r) { const float v = o[bk][r] * ss[r]; stg[crow(r, hi) * 128 + bk * 32 + r32] = (bf16_t)(cvtpk(v, 0.f) & 0xffffu); }
        asm volatile("s_waitcnt lgkmcnt(0)" ::: "memory");
        bf16_t* Ow = P.qkv + (rowb + q0 + w4 * 32) * LD + h * 128;
#pragma unroll
        for (int i = 0; i < 8; ++i) { const int row = i * 4 + (lane >> 4), c = lane & 15; const u32x4 v = *(const AT_LAS u32x4*)(stg + row * 128 + c * 8); if (!P.dry) *(u32x4*)(Ow + (size_t)row * LD + c * 8) = v; }
    }
    __syncthreads();
#undef AT_LOAD
#undef AT_STORE
}
}
namespace scan {
using pg8::bf16_t; using pg8::bf16x8; using pg8::f32x4; using pg8::u32x4; using pg8::u32x2;
typedef float f32x16 __attribute__((ext_vector_type(16)));
#define SC_LAS __attribute__((address_space(3)))
constexpr int SEQ = 2048, CH = 64;
constexpr int L_C = 0;
constexpr int L_B = 16384;
constexpr int L_XD = 32768;
constexpr int L_XW = 40960;
constexpr int L_G = 49152;
constexpr int L_H = 57344;
constexpr int L_Y = 73728;
constexpr int L_S = L_Y + 64 * 68 * 4;
constexpr int LDS_BYTES = L_S + 1024;
__device__ __forceinline__ unsigned cvtpk(float lo, float hi) { typedef float f2 __attribute__((ext_vector_type(2))); typedef __bf16 b2 __attribute__((ext_vector_type(2))); f2 v = {lo, hi}; b2 b = __builtin_convertvector(v, b2); return __builtin_bit_cast(unsigned, b); }
typedef short s16x4 __attribute__((ext_vector_type(4)));
__device__ __forceinline__ s16x4 vtr(const SC_LAS char* p) { typedef short v4 __attribute__((ext_vector_type(4))); return __builtin_bit_cast(s16x4, __builtin_amdgcn_ds_read_tr16_b64_v4i16((SC_LAS v4*)p)); }
__device__ __forceinline__ float lo16(unsigned w) { return __builtin_bit_cast(float, w << 16); }
__device__ __forceinline__ float hi16(unsigned w) { return __builtin_bit_cast(float, w & 0xffff0000u); }
__device__ __forceinline__ int img_off(int l) { return (l >> 4) * 1024 + ((l >> 3) & 1) * 512 + (l & 7) * 64; }

struct Params { const bf16_t* xbc; bf16_t* zp; const float* dt; const float* a_log; const float* dskip; float* ssqp; int dry; };

__device__ __forceinline__ void unit(const Params& P, int b, int h, SC_LAS char* lds) {
    int tid = threadIdx.x; asm volatile("" : "+v"(tid));
    const int wid = __builtin_amdgcn_readfirstlane(tid >> 6);
    const int g = h >> 3;
    const size_t rowb = (size_t)b * SEQ;
    SC_LAS float* s_dt = (SC_LAS float*)(lds + L_S); SC_LAS float* s_acs = s_dt + 64; SC_LAS float* s_dec = s_dt + 128; SC_LAS float* s_ea = s_dt + 192;
    const float a_h = -expf(P.a_log[h]), dsk = P.dskip[h];
    unsigned zu = 0u; asm volatile("" : "+v"(zu));
    for (int i = tid; i < 16384 / 16; i += 512) *(SC_LAS u32x4*)(lds + L_H + i * 16) = (u32x4){zu, zu, zu, zu};
    f32x16 hacc;
#pragma unroll
    for (int r = 0; r < 16; ++r) hacc[r] = 0.f;
    const int nq = wid & 3, ph = wid >> 2;
    const int tid0 = tid;
    u32x4 xr, zr, br[2], cr[2]; float dtr = 0.f;
#define SC_LOAD(t0_, XR, ZR) do { const int t_ = tid0; const size_t r1 = rowb + (t0_) + (t_ >> 3); \
        XR = *(const u32x4*)(P.xbc + r1 * 3072 + h * 64 + (t_ & 7) * 8); ZR = *(const u32x4*)(P.zp + r1 * 2048 + h * 64 + (t_ & 7) * 8); \
        _Pragma("unroll") for (int i = 0; i < 2; ++i) { const int p_ = t_ + 512 * i; const size_t r2 = rowb + (t0_) + (p_ >> 4); \
            br[i] = *(const u32x4*)(P.xbc + r2 * 3072 + 2048 + g * 128 + (p_ & 15) * 8); cr[i] = *(const u32x4*)(P.xbc + r2 * 3072 + 2560 + g * 128 + (p_ & 15) * 8); } \
        if (wid == 0) dtr = P.dt[(rowb + (t0_) + (t_ & 63)) * 32 + h]; } while (0)
    SC_LOAD(0, xr, zr);
    for (int c = 0; c < SEQ / CH; ++c) {
        const int t0 = c * CH;
        int tid = tid0; asm volatile("" : "+v"(tid));
        const int lane = tid & 63, r32 = lane & 31, hi = lane >> 5, fr = lane & 15, fq = lane >> 4;
        const int orow = tid >> 3, ocg = tid & 7;
        if (wid == 0) {
            float acs = dtr * a_h;
#pragma unroll
            for (int o = 1; o < 64; o <<= 1) { const float up = __shfl_up(acs, o); if (lane >= o) acs += up; }
            const float last = __shfl(acs, 63);
            s_dt[lane] = dtr; s_acs[lane] = acs; s_dec[lane] = __expf(last - acs); s_ea[lane] = __expf(acs);
        }
        __syncthreads();
        {
            const float d = s_dt[orow], dd = d * s_dec[orow];
            u32x4 w1, w2;
#pragma unroll
            for (int i = 0; i < 4; ++i) { const float a = lo16(xr[i]), bq = hi16(xr[i]); w1[i] = cvtpk(a * d, bq * d); w2[i] = cvtpk(a * dd, bq * dd); }
            const int off = (ocg >> 2) * 4096 + img_off(orow) + (ocg & 3) * 16;
            *(SC_LAS u32x4*)(lds + L_XD + off) = w1; *(SC_LAS u32x4*)(lds + L_XW + off) = w2;
#pragma unroll
            for (int i = 0; i < 2; ++i) { const int p = tid + 512 * i, l = p >> 4, c16 = p & 15;
                *(SC_LAS u32x4*)(lds + L_B + (c16 >> 2) * 4096 + img_off(l) + (c16 & 3) * 16) = br[i];
                *(SC_LAS u32x4*)(lds + L_C + l * 256 + ((c16 ^ (l & 15)) << 4)) = cr[i]; }
        }
        const u32x4 xcur = xr, zcur = zr;
        if (c + 1 < SEQ / CH) SC_LOAD(t0 + CH, xr, zr);
        __syncthreads();
        f32x4 yo[2];
#pragma unroll
        for (int j = 0; j < 2; ++j) {
            const int tile = wid * 2 + j, lt = tile >> 2, st = tile & 3;
            f32x4 cbt = {0.f, 0.f, 0.f, 0.f};
            if (st <= lt) {
                const int srow = 16 * st + fr, lrow = 16 * lt + fr;
#pragma unroll
                for (int kk = 0; kk < 4; ++kk) {
                    const int chk = 4 * kk + fq;
                    const bf16x8 a = *(const SC_LAS bf16x8*)(lds + L_B + (chk >> 2) * 4096 + img_off(srow) + (chk & 3) * 16);
                    const bf16x8 bb = *(const SC_LAS bf16x8*)(lds + L_C + lrow * 256 + ((chk ^ (lrow & 15)) << 4));
                    cbt = __builtin_amdgcn_mfma_f32_16x16x32_bf16(a, bb, cbt, 0, 0, 0);
                }
            }
            {
                const int l = 16 * lt + fr, s0 = 16 * st + 4 * fq;
                const float al = s_acs[l];
                float gv[4];
#pragma unroll
                for (int e = 0; e < 4; ++e) { const int s = s0 + e; gv[e] = (s <= l) ? cbt[e] * __expf(al - s_acs[s]) : 0.f; }
                u32x2 w; w.x = cvtpk(gv[0], gv[1]); w.y = cvtpk(gv[2], gv[3]);
                *(SC_LAS u32x2*)(lds + L_G + l * 128 + (((s0 >> 3) ^ (l & 7)) << 4) + (s0 & 7) * 2) = w;
            }
            {
                const int pt = st, lrow = 16 * lt + fr, prow = 16 * pt + fr;
                f32x4 acc = {0.f, 0.f, 0.f, 0.f};
#pragma unroll
                for (int kk = 0; kk < 4; ++kk) {
                    const int chk = 4 * kk + fq;
                    const bf16x8 a = *(const SC_LAS bf16x8*)(lds + L_C + lrow * 256 + ((chk ^ (lrow & 15)) << 4));
                    const bf16x8 bb = *(const SC_LAS bf16x8*)(lds + L_H + prow * 256 + ((chk ^ (prow & 15)) << 4));
                    acc = __builtin_amdgcn_mfma_f32_16x16x32_bf16(a, bb, acc, 0, 0, 0);
                }
                yo[j] = acc;
            }
        }
        __syncthreads();
#pragma unroll
        for (int j = 0; j < 2; ++j) {
            const int tile = wid * 2 + j, lt = tile >> 2, pt = tile & 3;
            const int lrow = 16 * lt + fr;
            f32x4 acc = {0.f, 0.f, 0.f, 0.f};
#pragma unroll
            for (int kk = 0; kk < 2; ++kk) {
                const int chk = 4 * kk + fq;
                const bf16x8 a = *(const SC_LAS bf16x8*)(lds + L_G + lrow * 128 + ((chk ^ (lrow & 7)) << 4));
                const SC_LAS char* bp = lds + L_XD + (pt >> 1) * 4096 + (2 * kk + (fq >> 1)) * 1024 + (fq & 1) * 512 + ((lane & 15) >> 2) * 64 + ((pt & 1) * 16 + (lane & 3) * 4) * 2;
                const s16x4 b0 = vtr(bp), b1 = vtr(bp + 256);
                const bf16x8 bb = {b0[0], b0[1], b0[2], b0[3], b1[0], b1[1], b1[2], b1[3]};
                acc = __builtin_amdgcn_mfma_f32_16x16x32_bf16(a, bb, acc, 0, 0, 0);
            }
#pragma unroll
            for (int e = 0; e < 4; ++e) { const int l = 16 * lt + 4 * fq + e; ((SC_LAS float*)(lds + L_Y))[l * 68 + 16 * pt + fr] = acc[e] + s_ea[l] * yo[j][e]; }
        }
        {
            const float cd = __expf(s_acs[63]);
#pragma unroll
            for (int r = 0; r < 16; ++r) hacc[r] *= cd;
            const int prow = 32 * ph + r32;
            const int tb = ((lane >> 4) & 1) * 32 + (lane & 3) * 8 + (4 * hi + ((lane & 15) >> 2)) * 64;
#pragma unroll
            for (int ks = 0; ks < 4; ++ks) {
                const s16x4 a0 = vtr(lds + L_B + nq * 4096 + ks * 1024 + tb), a1 = vtr(lds + L_B + nq * 4096 + ks * 1024 + 512 + tb);
                const s16x4 b0 = vtr(lds + L_XW + ph * 4096 + ks * 1024 + tb), b1 = vtr(lds + L_XW + ph * 4096 + ks * 1024 + 512 + tb);
                const bf16x8 a = {a0[0], a0[1], a0[2], a0[3], a1[0], a1[1], a1[2], a1[3]};
                const bf16x8 bb = {b0[0], b0[1], b0[2], b0[3], b1[0], b1[1], b1[2], b1[3]};
                hacc = __builtin_amdgcn_mfma_f32_32x32x16_bf16(a, bb, hacc, 0, 0, 0);
            }
#pragma unroll
            for (int q4 = 0; q4 < 4; ++q4) {
                const int n0 = 32 * nq + 8 * q4 + 4 * hi;
                u32x2 w; w.x = cvtpk(hacc[4 * q4 + 0], hacc[4 * q4 + 1]); w.y = cvtpk(hacc[4 * q4 + 2], hacc[4 * q4 + 3]);
                *(SC_LAS u32x2*)(lds + L_H + prow * 256 + (((n0 >> 3) ^ (prow & 15)) << 4) + (n0 & 7) * 2) = w;
            }
        }
        __syncthreads();
        {
            const SC_LAS float* yr = (const SC_LAS float*)(lds + L_Y) + orow * 68 + ocg * 8;
            const f32x4 y0 = *(const SC_LAS f32x4*)yr, y1 = *(const SC_LAS f32x4*)(yr + 4);
            float yv[8];
#pragma unroll
            for (int i = 0; i < 4; ++i) {
                const float ya = (i < 2) ? y0[2 * i] : y1[2 * i - 4], yb = (i < 2) ? y0[2 * i + 1] : y1[2 * i - 3];
                yv[2 * i] = (ya + dsk * lo16(xcur[i])) * lo16(zcur[i]); yv[2 * i + 1] = (yb + dsk * hi16(xcur[i])) * hi16(zcur[i]);
            }
            float ss = 0.f;
#pragma unroll
            for (int i = 0; i < 8; ++i) ss += yv[i] * yv[i];
            ss += __shfl_xor(ss, 1); ss += __shfl_xor(ss, 2); ss += __shfl_xor(ss, 4);
            if (ocg == 0) P.ssqp[(rowb + t0 + orow) * 32 + h] = ss;
            u32x4 w; w.x = cvtpk(yv[0], yv[1]); w.y = cvtpk(yv[2], yv[3]); w.z = cvtpk(yv[4], yv[5]); w.w = cvtpk(yv[6], yv[7]);
            if (!P.dry) *(u32x4*)(P.zp + (rowb + t0 + orow) * 2048 + h * 64 + ocg * 8) = w;
        }
    }
    __syncthreads();
#undef SC_LOAD
}
}
namespace mk {
#define GAS __attribute__((address_space(1)))
#define LAS __attribute__((address_space(3)))
typedef unsigned short bf16;
typedef unsigned v4u __attribute__((ext_vector_type(4)));
typedef float f32x4 __attribute__((ext_vector_type(4)));
typedef GAS unsigned gu32;
#define RLX_AGENT __ATOMIC_RELAXED, __HIP_MEMORY_SCOPE_AGENT
constexpr int NWAVES = 8;
constexpr int M = 16384, D = 1024, SEQ = 2048, NB = 8;
constexpr int SSD_NP = 5376, SSD_IN = 5152, SSD_DI = 2048, SSD_LD = 5120;
constexpr int AT_IN = 3072, DFF = 2816;
constexpr size_t MiB = 1u << 20;
constexpr size_t WS_CTL = 0, CTL_ZERO_BYTES = 64 * 1024;
constexpr size_t WS_CONST = 64 * 1024;
constexpr size_t WS_SSQ = 1 * MiB;
constexpr size_t WS_ROPE = 2 * MiB;
constexpr size_t WS_DT = 3 * MiB;
constexpr size_t WS_SSQP = 5 * MiB;
constexpr size_t WS_CP = 1 * MiB + 512 * 1024;
constexpr size_t WS_W = 7 * MiB;
constexpr size_t W_SSD_IN = 0, W_SSD_IN_SZ = (size_t)SSD_NP * D * 2;
constexpr size_t W_SSD_OUT = W_SSD_IN + 2 * W_SSD_IN_SZ, W_SSD_OUT_SZ = (size_t)D * SSD_DI * 2;
constexpr size_t W_AT_IN = W_SSD_OUT + 2 * W_SSD_OUT_SZ, W_AT_IN_SZ = (size_t)AT_IN * D * 2;
constexpr size_t W_AT_OUT = W_AT_IN + 2 * W_AT_IN_SZ, W_AT_OUT_SZ = (size_t)D * D * 2;
constexpr size_t W_UP = W_AT_OUT + 2 * W_AT_OUT_SZ, W_UP_SZ = (size_t)2 * DFF * D * 2;
constexpr size_t W_DOWN = W_UP + 4 * W_UP_SZ, W_DOWN_SZ = (size_t)D * DFF * 2;
constexpr size_t W_TOTAL = W_DOWN + 4 * W_DOWN_SZ;
constexpr size_t WS_XB = ((WS_W + W_TOTAL + MiB - 1) / MiB) * MiB;
constexpr size_t XB_PAD_FRONT = 4 * D * 2, XB_BYTES = (size_t)(M + 260) * D * 2;
constexpr size_t WS_BIG = ((WS_XB + XB_BYTES + MiB - 1) / MiB) * MiB;
constexpr size_t BIG_BYTES = (size_t)M * SSD_LD * 2;
constexpr size_t WS_DBG = WS_BIG + BIG_BYTES;
constexpr size_t WS_END = WS_DBG;
static_assert(WS_END <= 352 * MiB, "workspace map exceeds the guaranteed 352 MiB");
constexpr int CW_BAR = 1024;
constexpr int RING_BYTES = 131072, EPI_OFF = RING_BYTES, EPI_BYTES = 16384, MISC_OFF = EPI_OFF + EPI_BYTES;
constexpr int LDS_BYTES = 151552;
static_assert(MISC_OFF + 1024 <= LDS_BYTES && attn::LDS_BYTES <= RING_BYTES && scan::LDS_BYTES <= RING_BYTES, "LDS map");

#define LDS_WAIT() asm volatile("s_waitcnt lgkmcnt(0)" ::: "memory")
__device__ __forceinline__ unsigned f2bf(float f) { unsigned u = __builtin_bit_cast(unsigned, f); return (u + 0x7fffu + ((u >> 16) & 1u)) >> 16; }
__device__ __forceinline__ unsigned pk2(float lo, float hi) { return f2bf(lo) | (f2bf(hi) << 16); }

#define XB_TMO      128
#define XB_XCNT(j)  (256  + 64 * (j))
#define XB_XSUB(j)  (1280 + 64 * (j))
#define XB_XGEN(j)  (2304 + 64 * (j))
#define XB_TOP      3328
#define XB_TOPGEN   3392
#define XCD_BAR_WORDS 3456
#define XB_SPIN_CAP (1u << 20)
__device__ __forceinline__ unsigned xb_ld(unsigned* p)              { return __hip_atomic_load(p, __ATOMIC_RELAXED, __HIP_MEMORY_SCOPE_AGENT); }
__device__ __forceinline__ unsigned xb_add(unsigned* p, unsigned v) { return __hip_atomic_fetch_add(p, v, __ATOMIC_RELAXED, __HIP_MEMORY_SCOPE_AGENT); }
__device__ __forceinline__ unsigned xb_xcc_id() { return (unsigned)__builtin_amdgcn_s_getreg((3 << 11) | 20) & 0xFu; }
#define XB_SPIN(cond, bar) do { unsigned _sp = 0; while (cond) { __builtin_amdgcn_s_sleep(1); \
    if ((++_sp & 255u) == 0u) { if (xb_ld(&(bar)[XB_TMO])) break; if (_sp > XB_SPIN_CAP) { atomicAdd(&(bar)[XB_TMO], 1u); break; } } } } while (0)
struct XcdBarrier { unsigned* bar; unsigned x; volatile LAS unsigned* st; };
__device__ __forceinline__ XcdBarrier xcd_barrier_post(unsigned* bar, volatile LAS unsigned* st) {
    XcdBarrier b; b.bar = bar; b.x = xb_xcc_id(); b.st = st;
    if (threadIdx.x == 0) (void)xb_add(&bar[XB_XCNT(b.x)], 1u);
    return b;
}
__device__ __forceinline__ void xcd_barrier_complete(unsigned* bar, unsigned x, unsigned& nloc, unsigned& nx) {
    const unsigned G = gridDim.x * gridDim.y * gridDim.z;
    unsigned sum, cnt, mine, sp = 0u;
    for (;;) {
        sum = 0u; cnt = 0u; mine = 0u;
#pragma unroll
        for (unsigned j = 0; j < 16; ++j) { const unsigned c = xb_ld(&bar[XB_XCNT(j)]); sum += c; cnt += (c > 0u) ? 1u : 0u; mine = (j == x) ? c : mine; }
        if (sum == G) break;
        __builtin_amdgcn_s_sleep(1);
        if ((++sp & 255u) == 0u) { if (xb_ld(&bar[XB_TMO])) break; if (sp > XB_SPIN_CAP) { atomicAdd(&bar[XB_TMO], 1u); break; } }
    }
    nloc = mine > 0u ? mine : 1u; nx = cnt > 0u ? cnt : 1u;
}
__device__ __forceinline__ void xcd_barrier(const XcdBarrier& b) {
    asm volatile("s_waitcnt vmcnt(0)" ::: "memory");
    __syncthreads();
    if (threadIdx.x == 0) {
        unsigned* bar = b.bar; asm volatile("" : "+s"(bar));
        __builtin_amdgcn_s_waitcnt(0);
        unsigned nloc = b.st[0], nx = b.st[1];
        if (nloc == 0u) { xcd_barrier_complete(bar, b.x, nloc, nx); b.st[0] = nloc; b.st[1] = nx; }
        const unsigned old = xb_add(&bar[XB_XSUB(b.x)], 1u);
        const unsigned gen = old / nloc;
        if (old + 1u == (gen + 1u) * nloc) {
            __builtin_amdgcn_fence(__ATOMIC_RELEASE, "agent");
            asm volatile("s_waitcnt vmcnt(0)" ::: "memory");
            const unsigned og = xb_add(&bar[XB_TOP], 1u);
            const unsigned tg = og / nx;
            if (og + 1u == (tg + 1u) * nx) xb_add(&bar[XB_TOPGEN], 1u);
            else XB_SPIN(xb_ld(&bar[XB_TOPGEN]) == tg, bar);
            __builtin_amdgcn_fence(__ATOMIC_ACQUIRE, "agent");
            xb_add(&bar[XB_XGEN(b.x)], 1u);
            asm volatile("s_waitcnt vmcnt(0)" ::: "memory");
        } else {
            XB_SPIN(xb_ld(&bar[XB_XGEN(b.x)]) == gen, bar);
            __builtin_amdgcn_fence(__ATOMIC_ACQUIRE, "agent");
            asm volatile("s_waitcnt vmcnt(0)" ::: "memory");
        }
    }
    __syncthreads();
}

__device__ __forceinline__ unsigned long long ldarg(LAS unsigned long long* AP, int i) {
    asm volatile("" : "+s"(i));
    const unsigned long long v = AP[i];
    return ((unsigned long long)(unsigned)__builtin_amdgcn_readfirstlane((int)(v >> 32)) << 32) | (unsigned long long)(unsigned)__builtin_amdgcn_readfirstlane((int)v);
}
struct Args { const void* in[25]; float* out; unsigned char* ws; int ph_lo, ph_hi; int dbg, pad; };

__device__ __forceinline__ float wave_sum(float v) {
#pragma unroll
    for (int o = 1; o < 64; o <<= 1) v += __shfl_xor(v, o);
    return v;
}
template <class RowMap>
__device__ __forceinline__ void transpose_item(const float* W, int K, int N, const float* gain, int gmask, float gscale, bf16* WT, const RowMap& rm, LAS float* scr, int item, int lane) {
    const int nblk = N / 32, kb = item / nblk, nb = item % nblk, k0 = 64 * kb, n0 = 32 * nb;
#pragma unroll 8
    for (int i = 0; i < 32; ++i) { const int kk = 2 * i + (lane >> 5); const float gv = gain ? gain[(k0 + kk) & gmask] * gscale : 1.0f; scr[kk * 33 + (lane & 31)] = W[(size_t)(k0 + kk) * N + n0 + (lane & 31)] * gv; }
    LDS_WAIT(); asm volatile("" ::: "memory");
    const int c = lane & 7;
#pragma unroll
    for (int j = 0; j < 4; ++j) { const int n = (lane >> 3) + 8 * j; const LAS float* s = scr + (8 * c) * 33 + n;
        v4u o; o.x = pk2(s[0 * 33], s[1 * 33]); o.y = pk2(s[2 * 33], s[3 * 33]); o.z = pk2(s[4 * 33], s[5 * 33]); o.w = pk2(s[6 * 33], s[7 * 33]);
        *(GAS v4u*)(WT + (size_t)rm(n0 + n) * K + k0 + 8 * c) = o; }
    LDS_WAIT(); asm volatile("" ::: "memory");
}
struct RowId { __device__ __forceinline__ int operator()(int n) const { return n; } };
struct RowUp { __device__ __forceinline__ int operator()(int n) const { const int u = n >= DFF, ch = u ? n - DFF : n; return (ch >> 7) * 256 + u * 128 + (ch & 127); } };

__global__ void __launch_bounds__(NWAVES * 64, 2) mega_fwd(Args args) {
    extern __shared__ __attribute__((aligned(16))) unsigned char lds_raw[];
    LAS unsigned char* lds = (LAS unsigned char*)lds_raw;
    volatile LAS unsigned* MISC = (volatile LAS unsigned*)(lds + MISC_OFF);
    const int G = gridDim.x; const int bx = blockIdx.x; const int vcu = (G % 8 == 0) ? (bx % 8) * (G / 8) + bx / 8 : bx;
    gu32* ctl = (gu32*)(args.ws + WS_CTL);
    if (threadIdx.x < 64) MISC[threadIdx.x] = 0u;
    __syncthreads();
    XcdBarrier bar = xcd_barrier_post((unsigned*)ctl + CW_BAR, MISC + 8);
#define GRID_BAR() xcd_barrier(bar)
    LAS unsigned long long* AP = (LAS unsigned long long*)(lds + MISC_OFF + 256);
    if (threadIdx.x < 27) AP[threadIdx.x] = ((const unsigned long long*)&args)[threadIdx.x];
    __syncthreads();
#define ARGP(T, i) ((T)(GAS void*)ldarg(AP, i))
#define x_in   ARGP(const float*, 0)
#define pos    ARGP(const int*, 1)
#define nmg    ARGP(const float*, 2)
#define nfg    ARGP(const float*, 3)
#define s_inw  ARGP(const float*, 4)
#define s_cw   ARGP(const float*, 5)
#define s_cb   ARGP(const float*, 6)
#define s_dtb  ARGP(const float*, 7)
#define s_alog ARGP(const float*, 8)
#define s_d    ARGP(const float*, 9)
#define s_ng   ARGP(const float*, 10)
#define s_ow   ARGP(const float*, 11)
#define a_inw  ARGP(const float*, 12)
#define a_qg   ARGP(const float*, 13)
#define a_kg   ARGP(const float*, 14)
#define a_lq1  ARGP(const float*, 15)
#define a_lk1  ARGP(const float*, 16)
#define a_lq2  ARGP(const float*, 17)
#define a_lk2  ARGP(const float*, 18)
#define a_sg   ARGP(const float*, 19)
#define a_ow   ARGP(const float*, 20)
#define f_uw   ARGP(const float*, 21)
#define f_cw   ARGP(const float*, 22)
#define f_cb   ARGP(const float*, 23)
#define f_dw   ARGP(const float*, 24)
#define xout   ARGP(float*, 25)
#define ws     ARGP(unsigned char*, 26)
#define cst    ((float*)(ws + WS_CONST))
#define SSQ    ((float*)(ws + WS_SSQ))
#define ROPE   ((float*)(ws + WS_ROPE))
#define DT     ((float*)(ws + WS_DT))
#define SSQP   ((float*)(ws + WS_SSQP))
#define Wb     ((bf16*)(ws + WS_W))
#define XB     ((bf16*)(ws + WS_XB + XB_PAD_FRONT))
#define BIG    ((bf16*)(ws + WS_BIG))
#define CPT    ((float*)(ws + WS_CP))
#define ZPL    ((bf16*)(ws + WS_BIG))
#define XBCPL  ((bf16*)(ws + WS_BIG + (size_t)M * SSD_DI * 2))
    const int lo = args.ph_lo, hi = args.ph_hi;
    int phase = 0;
#define IN_PHASE() (phase >= lo && phase < hi)
#define END_PHASE(ty) do { if (IN_PHASE() && phase + 1 < hi) GRID_BAR(); ++phase; } while (0)
#ifdef PROBE_DUP
#define REP_BEGIN(ty) _Pragma("unroll") for (int rep_ = ((ty) == PROBE_DUP ? 0 : 1); rep_ < 2; ++rep_) { const int dry = (rep_ == 0);
#define REP_END() if (dry) GRID_BAR(); }
#else
#define REP_BEGIN(ty) { const int dry = 0;
#define REP_END() }
#endif

    if (IN_PHASE()) { REP_BEGIN(0)
        int tid = threadIdx.x; asm volatile("" : "+v"(tid));
        const int lane = tid & 63, wave = __builtin_amdgcn_readfirstlane(tid >> 6);
        LAS float* scr = (LAS float*)(lds + wave * 16384);
        const int gw = vcu * NWAVES + wave, NGW = G * NWAVES;
        constexpr int I_SI = (D / 64) * (SSD_IN / 32), I_SO = (SSD_DI / 64) * (D / 32), I_AI = (D / 64) * (AT_IN / 32), I_AO = (D / 64) * (D / 32), I_UP = (D / 64) * (2 * DFF / 32), I_DN = (DFF / 64) * (D / 32);
        constexpr int NITEMS = 2 * I_SI + 2 * I_SO + 2 * I_AI + 2 * I_AO + 4 * I_UP + 4 * I_DN;
        for (int it = gw; it < NITEMS; it += NGW) {
            int r = it;
            if (r < 2 * I_SI) { const int j = r / I_SI; transpose_item(s_inw + (size_t)j * D * SSD_IN, D, SSD_IN, nmg + (2 * j) * D, 1023, 1.0f, (bf16*)((char*)Wb + W_SSD_IN + j * W_SSD_IN_SZ), RowId(), scr, r % I_SI, lane); continue; } r -= 2 * I_SI;
            if (r < 2 * I_SO) { const int j = r / I_SO; transpose_item(s_ow + (size_t)j * SSD_DI * D, SSD_DI, D, s_ng + j * SSD_DI, 2047, 1.0f, (bf16*)((char*)Wb + W_SSD_OUT + j * W_SSD_OUT_SZ), RowId(), scr, r % I_SO, lane); continue; } r -= 2 * I_SO;
            if (r < 2 * I_AI) { const int j = r / I_AI; transpose_item(a_inw + (size_t)j * D * AT_IN, D, AT_IN, nmg + (2 * j + 1) * D, 1023, 1.0f, (bf16*)((char*)Wb + W_AT_IN + j * W_AT_IN_SZ), RowId(), scr, r % I_AI, lane); continue; } r -= 2 * I_AI;
            if (r < 2 * I_AO) { const int j = r / I_AO; const float li = 0.8f - 0.6f * expf(-0.3f * (float)(2 * j + 1));
                transpose_item(a_ow + (size_t)j * D * D, D, D, a_sg + j * 128, 127, 1.0f - li, (bf16*)((char*)Wb + W_AT_OUT + j * W_AT_OUT_SZ), RowId(), scr, r % I_AO, lane); continue; } r -= 2 * I_AO;
            if (r < 4 * I_UP) { const int j = r / I_UP; transpose_item(f_uw + (size_t)j * D * 2 * DFF, D, 2 * DFF, nfg + j * D, 1023, 1.0f, (bf16*)((char*)Wb + W_UP + j * W_UP_SZ), RowUp(), scr, r % I_UP, lane); continue; } r -= 4 * I_UP;
            { const int j = r / I_DN; transpose_item(f_dw + (size_t)j * DFF * D, DFF, D, nullptr, 0, 1.0f, (bf16*)((char*)Wb + W_DOWN + j * W_DOWN_SZ), RowId(), scr, r % I_DN, lane); }
        }
        for (int j = 0; j < 2; ++j) { v4u* p = (v4u*)((char*)Wb + W_SSD_IN + j * W_SSD_IN_SZ + (size_t)SSD_IN * D * 2); const int n16 = (SSD_NP - SSD_IN) * D * 2 / 16;
            for (int i = vcu * 512 + tid; i < n16; i += G * 512) p[i] = (v4u){0u, 0u, 0u, 0u}; }
        { v4u* p = (v4u*)(ws + WS_XB); for (int i = vcu * 512 + tid; i < (int)(XB_PAD_FRONT / 16); i += G * 512) p[i] = (v4u){0u, 0u, 0u, 0u};
          v4u* q = (v4u*)((char*)XB + (size_t)M * D * 2); for (int i = vcu * 512 + tid; i < 256 * D * 2 / 16; i += G * 512) q[i] = (v4u){0u, 0u, 0u, 0u}; }
        for (int m = gw; m < M; m += NGW) {
            const f32x4* xr = (const f32x4*)(x_in + (size_t)m * D) + lane; float s = 0.f;
            unsigned long long* o8 = (unsigned long long*)(XB + (size_t)m * D) + lane;
#pragma unroll
            for (int j = 0; j < 4; ++j) { const f32x4 v = xr[64 * j]; s += (v[0] * v[0] + v[1] * v[1]) + (v[2] * v[2] + v[3] * v[3]); o8[64 * j] = (unsigned long long)pk2(v[0], v[1]) | ((unsigned long long)pk2(v[2], v[3]) << 32); }
            s = wave_sum(s);
            if (lane < 4) SSQ[(size_t)m * 4 + lane] = (lane == 0) ? s : 0.f;
            if (lane >= 16 && lane < 32) { const int i = lane & 7; const float invf = powf(500000.0f, -(float)(2 * i) / 16.0f); const float ang = (float)pos[m] * invf; ROPE[(size_t)m * 16 + (lane - 16)] = (lane < 24) ? cosf(ang) : sinf(ang); }
        }
        for (int i = vcu * 512 + tid; i < 2 * SSD_NP; i += G * 512) {
            const int j = i / SSD_NP, c = i % SSD_NP; float pb = 0.f, p0 = 0.f, p1 = 0.f, p2 = 0.f, p3 = 0.f;
            if (c < 2048) p3 = 1.f;
            else if (c < 5120) { const int ch = c - 2048; const float* w = s_cw + (size_t)j * 4 * 3072; pb = s_cb[(size_t)j * 3072 + ch]; p0 = w[ch]; p1 = w[3072 + ch]; p2 = w[2 * 3072 + ch]; p3 = w[3 * 3072 + ch]; }
            else if (c < 5152) { pb = s_dtb[j * 32 + (c - 5120)]; p3 = 1.f; }
            float* t = CPT + (size_t)j * 5 * SSD_NP; t[c] = pb; t[SSD_NP + c] = p0; t[2 * SSD_NP + c] = p1; t[3 * SSD_NP + c] = p2; t[4 * SSD_NP + c] = p3;
        }
        if (bx == 0 && wave == 0) {
            for (int j = 0; j < 2; ++j) {
                float mq = fabsf(a_qg[j * 64 + lane]), mkk = fabsf(a_kg[j * 64 + lane]);
                float d1 = a_lq1[j * 64 + lane] * a_lk1[j * 64 + lane], d2 = a_lq2[j * 64 + lane] * a_lk2[j * 64 + lane];
#pragma unroll
                for (int o = 1; o < 64; o <<= 1) { mq = fmaxf(mq, __shfl_xor(mq, o)); mkk = fmaxf(mkk, __shfl_xor(mkk, o)); d1 += __shfl_xor(d1, o); d2 += __shfl_xor(d2, o); }
                const float li = 0.8f - 0.6f * expf(-0.3f * (float)(2 * j + 1));
                if (lane == 0) { cst[j] = mq * mkk * 64.0f * 0.125f * 1.4426950408889634f * 1.002f + 0.01f; cst[2 + j] = expf(d1) - expf(d2) + li; }
            }
        }
    REP_END() }
    END_PHASE(0);

    for (int layer = 0; layer < 4; ++layer) {
        const int j = layer >> 1;
        const float* xsrc = (layer == 0) ? x_in : xout;
        if ((layer & 1) == 0) {
            if (IN_PHASE()) { REP_BEGIN(1)
                pg8::Gemm g{XB, (const bf16*)((const char*)Wb + W_SSD_IN + j * W_SSD_IN_SZ), D, D, 253, -3};
                pg8::StaticOrder S; S.init(65, SSD_NP / 256, G, bx);
                epi::EpiSsdConv E{ZPL, XBCPL, DT, SSQ, CPT + (size_t)j * 5 * SSD_NP};
                pg8::gemm_phase(lds, lds + EPI_OFF, g, S, E);
            REP_END() }
            END_PHASE(1);
            if (IN_PHASE()) { REP_BEGIN(2)
                scan::Params sp{XBCPL, ZPL, DT, s_alog + j * 32, s_d + j * 32, SSQP, dry};
                for (int u = vcu; u < NB * 32; u += G) scan::unit(sp, u >> 5, u & 31, (LAS char*)lds);
            REP_END() }
            END_PHASE(2);
            if (IN_PHASE()) { REP_BEGIN(3)
                int tid = threadIdx.x; asm volatile("" : "+v"(tid));
                const int nitems = M * 256;
                for (int i = (vcu * 512 + tid); i < nitems; i += G * 512) {
                    const int row = i >> 8, c16 = i & 255, grp = c16 >> 6;
                    const f32x4* sp4 = (const f32x4*)(SSQP + (size_t)row * 32 + grp * 8);
                    const f32x4 a = sp4[0], b = sp4[1];
                    const float s = ((a[0] + a[1]) + (a[2] + a[3])) + ((b[0] + b[1]) + (b[2] + b[3]));
                    const float rs = 1.0f / sqrtf(s * (1.0f / 512.0f) + 1e-6f);
                    v4u* p = (v4u*)(ZPL + (size_t)row * SSD_DI + c16 * 8);
                    v4u v = *p;
#pragma unroll
                    for (int e = 0; e < 4; ++e) { const float lo_ = __builtin_bit_cast(float, v[e] << 16) * rs, hi_ = __builtin_bit_cast(float, v[e] & 0xffff0000u) * rs; v[e] = pk2(lo_, hi_); }
                    if (!dry) *p = v;
                }
            REP_END() }
            END_PHASE(3);
            if (IN_PHASE()) { REP_BEGIN(4)
                pg8::Gemm g{ZPL, (const bf16*)((const char*)Wb + W_SSD_OUT + j * W_SSD_OUT_SZ), SSD_DI, SSD_DI, 256, 0};
                pg8::StaticOrder S; S.init(M / 256, D / 256, G, bx);
                epi::EpiResidual E{xsrc, xout, XB, SSQ, dry};
                pg8::gemm_phase(lds, lds + EPI_OFF, g, S, E);
            REP_END() }
            END_PHASE(4);
        } else {
            if (IN_PHASE()) { REP_BEGIN(5)
                pg8::Gemm g{XB, (const bf16*)((const char*)Wb + W_AT_IN + j * W_AT_IN_SZ), D, D, 256, 0};
                pg8::StaticOrder S; S.init(M / 256, AT_IN / 256, G, bx);
                epi::EpiQKV E{BIG, SSQ, a_qg + j * 64, a_kg + j * 64, ROPE};
                pg8::gemm_phase(lds, lds + EPI_OFF, g, S, E);
            REP_END() }
            END_PHASE(5);
            if (IN_PHASE()) { REP_BEGIN(6)
                attn::Params ap{BIG, cst[j], cst[2 + j], dry};
                for (int pi = vcu; pi < 512; pi += G) {
                    const int bh = pi >> 3, s = pi & 7;
                    attn::unit(ap, bh >> 3, bh & 7, s, (LAS char*)lds);
                    attn::unit(ap, bh >> 3, bh & 7, 15 - s, (LAS char*)lds);
                }
            REP_END() }
            END_PHASE(6);
            if (IN_PHASE()) { REP_BEGIN(7)
                pg8::Gemm g{BIG, (const bf16*)((const char*)Wb + W_AT_OUT + j * W_AT_OUT_SZ), AT_IN, D, 256, 0};
                pg8::StaticOrder S; S.init(M / 256, D / 256, G, bx);
                epi::EpiResidual E{xsrc, xout, XB, SSQ, dry};
                pg8::gemm_phase(lds, lds + EPI_OFF, g, S, E);
            REP_END() }
            END_PHASE(7);
        }
        if (IN_PHASE()) { REP_BEGIN(8)
            pg8::Gemm g{XB, (const bf16*)((const char*)Wb + W_UP + layer * W_UP_SZ), D, D, 254, -2};
            pg8::StaticOrder S; S.init(65, 2 * DFF / 256, G, bx);
            epi::EpiConvGate E{BIG, SSQ, f_cw + (size_t)layer * 3 * 2 * DFF, f_cb + (size_t)layer * 2 * DFF};
            pg8::gemm_phase(lds, lds + EPI_OFF, g, S, E);
        REP_END() }
        END_PHASE(8);
        if (IN_PHASE()) { REP_BEGIN(9)
            pg8::Gemm g{BIG, (const bf16*)((const char*)Wb + W_DOWN + layer * W_DOWN_SZ), DFF, DFF, 256, 0};
            pg8::StaticOrder S; S.init(M / 256, D / 256, G, bx);
            epi::EpiResidual E{xout, xout, XB, SSQ, dry};
            pg8::gemm_phase(lds, lds + EPI_OFF, g, S, E);
        REP_END() }
        END_PHASE(9);
    }
}
#undef x_in
#undef pos
#undef nmg
#undef nfg
#undef s_inw
#undef s_cw
#undef s_cb
#undef s_dtb
#undef s_alog
#undef s_d
#undef s_ng
#undef s_ow
#undef a_inw
#undef a_qg
#undef a_kg
#undef a_lq1
#undef a_lk1
#undef a_lq2
#undef a_lk2
#undef a_sg
#undef a_ow
#undef f_uw
#undef f_cw
#undef f_cb
#undef f_dw
#undef xout
#undef ws
#undef cst
#undef SSQ
#undef ROPE
#undef DT
#undef SSQP
#undef Wb
#undef XB
#undef BIG
#undef CPT
#undef ZPL
#undef XBCPL
#undef ARGP
constexpr int N_PHASES = 1 + 2 * 6 + 2 * 5;

static int g_grid = 0;
static void launch(void* const* d_in, float* d_out, void* d_ws, int ph_lo, int ph_hi, hipStream_t stream) {
    if (g_grid == 0) {
        int dev = 0, cus = 0;
        if (hipGetDevice(&dev) != hipSuccess || hipDeviceGetAttribute(&cus, hipDeviceAttributeMultiprocessorCount, dev) != hipSuccess) { fprintf(stderr, "device query failed\n"); g_grid = -1; return; }
        if (hipFuncSetAttribute((const void*)mega_fwd, hipFuncAttributeMaxDynamicSharedMemorySize, LDS_BYTES) != hipSuccess) { fprintf(stderr, "hipFuncSetAttribute failed\n"); g_grid = -1; return; }
        int per_cu = 0;
        (void)hipOccupancyMaxActiveBlocksPerMultiprocessor(&per_cu, (const void*)mega_fwd, NWAVES * 64, LDS_BYTES);
        (void)hipGetLastError();
        g_grid = cus;
        fprintf(stderr, "mega_fwd: %d CUs, occupancy query %d per CU\n", cus, per_cu);
    }
    if (g_grid < 0) return;
    (void)hipMemsetAsync((char*)d_ws + WS_CTL, 0, CTL_ZERO_BYTES, stream);
    Args a{};
    for (int i = 0; i < 25; ++i) a.in[i] = d_in[i];
    a.out = d_out; a.ws = (unsigned char*)d_ws; a.ph_lo = ph_lo; a.ph_hi = ph_hi;
    void* params[] = {&a};
    hipError_t e = hipLaunchCooperativeKernel((const void*)mega_fwd, dim3(g_grid), dim3(NWAVES * 64), params, LDS_BYTES, stream);
    if (e != hipSuccess) fprintf(stderr, "cooperative launch failed: %s (grid %d)\n", hipGetErrorString(e), g_grid);
}
}
extern "C" void kernel_launch(void* const* d_in, const int* in_sizes, int n_in, void* d_out, int out_size, void* d_ws, size_t ws_size, hipStream_t stream) {
    (void)in_sizes; (void)n_in; (void)out_size; (void)ws_size;
    mk::launch(d_in, (float*)d_out, d_ws, 0, mk::N_PHASES, stream);
}
```

```cpp
#include <hip/hip_runtime.h>
#include <stdint.h>
#include <math.h>
#include <cstdio>
namespace pg8 {
#define PG8_LAS __attribute__((address_space(3)))
typedef unsigned short bf16_t;
typedef short bf16x8 __attribute__((ext_vector_type(8)));
typedef float f32x4 __attribute__((ext_vector_type(4)));
typedef unsigned u32x4 __attribute__((ext_vector_type(4)));
typedef unsigned u32x2 __attribute__((ext_vector_type(2)));
constexpr int BM = 256, BK = 64, HALF = 128, HTB = HALF * BK * 2  , STAGE_BYTES = 8 * HTB, NXCD = 8, WGM = 8;

__host__ __device__ __forceinline__ int lds_byte(int r, int c) { const int st = (r >> 4) * 2 + (c >> 5), rr = r & 15, cc = c & 31, ob = rr * 64 + cc * 2; return st * 1024 + (ob ^ (((ob >> 9) & 1) << 5)); }
__host__ __device__ __forceinline__ void stage_rc(int b, int& R, int& C) { const int st = b / 1024, sb = b % 1024, swz = sb ^ (((sb >> 9) & 1) << 5); R = (st >> 1) * 16 + swz / 64; C = (st & 1) * 32 + (swz % 64) / 2; }
__host__ __device__ __forceinline__ int perm32(int rho) { const int n = rho >> 4, i = rho & 15; return 8 * (i >> 2) + 4 * n + (i & 3); }

struct Unit { int pm, pn; };
struct Gemm { const bf16_t* A; const bf16_t* Bt; int lda, K, a_stride, a_off; };

struct StaticOrder {
    int nM, nN, nwg, G, c;
    __host__ __device__ void init(int nM_, int nN_, int G_, int c_) { nM = nM_; nN = nN_; nwg = nM * nN; G = G_; c = c_; }
    __host__ __device__ bool next(int i, Unit& u) const {
        const long L = (long)i * G + c; if (L >= nwg) return false;
        int wgid = (int)L; { const int q = nwg / NXCD, r = nwg % NXCD, xcd = wgid % NXCD, off = wgid / NXCD; wgid = (xcd < r ? xcd * (q + 1) : r * (q + 1) + (xcd - r) * q) + off; }
        const int nig = WGM * nN, gid = wgid / nig, fm = gid * WGM, gsz = (nM - fm) < WGM ? (nM - fm) : WGM;
        u.pm = fm + ((wgid % nig) % gsz); u.pn = (wgid % nig) / gsz; return true;
    }
};

__device__ __forceinline__ unsigned cvt_pk_bf16(float lo, float hi) { unsigned r; asm volatile("v_cvt_pk_bf16_f32 %0, %1, %2" : "=v"(r) : "v"(lo), "v"(hi)); return r; }

template <class Epi, class Sched>
__device__ __forceinline__ void gemm_phase(PG8_LAS unsigned char* lds, PG8_LAS unsigned char* elds, const Gemm g, const Sched& S, const Epi& E) {
    int tid = threadIdx.x; asm volatile("" : "+v"(tid));
    const int wid = __builtin_amdgcn_readfirstlane(tid >> 6), lane = tid & 63, wr = wid >> 2, wc = wid & 3, fr = lane & 15, fq = lane >> 4;
    const int K = g.K, nt = K / BK, lda = g.lda;
    unsigned voffA[2], voffB[2]; int aoff, boff;
#define PG8_LANECONST() do { int t_ = threadIdx.x; asm volatile("" : "+v"(t_)); const int fr_ = t_ & 15, fq_ = (t_ >> 4) & 3; \
        _Pragma("unroll") for (int i = 0; i < 2; ++i) { int R, C; stage_rc(t_ * 16 + i * 8192, R, C); const int Rb = Epi::PERM ? ((R & ~31) + perm32(R & 31)) : R; \
            voffA[i] = (unsigned)(R * lda + C) * 2u; voffB[i] = (unsigned)(Rb * K + C) * 2u; } \
        aoff = lds_byte(wr * 64 + fr_, fq_ * 8); boff = lds_byte(wc * 32 + fr_, fq_ * 8); } while (0)
    PG8_LANECONST();
    const size_t kstep = (size_t)(BK * 2);
    const size_t hstepA = (size_t)HALF * lda * 2, hstepB = (size_t)HALF * K * 2;
    const size_t tstepB = 2 * hstepB;
    const unsigned ldsw = (unsigned)wid * 1024u;
#define PG8_SA(b, h) (((b) * 2 + (h)) * HTB)
#define PG8_SB(b, h) ((4 + (b) * 2 + (h)) * HTB)
#define PG8_STAGE(bufoff, gbase, voff) do { _Pragma("unroll") for (int _i = 0; _i < 2; ++_i) \
        __builtin_amdgcn_global_load_lds((const unsigned*)((const char*)(gbase) + (voff)[_i]), (PG8_LAS unsigned*)(lds + (bufoff) + ldsw + _i * 8192), 16, 0, 0); } while (0)
#define PG8_LDA(dst, b, h) do { _Pragma("unroll") for (int m = 0; m < 4; ++m) _Pragma("unroll") for (int k = 0; k < 2; ++k) dst[m][k] = *(const PG8_LAS bf16x8*)(lds + PG8_SA(b, h) + aoff + m * 2048 + k * 1024); } while (0)
#define PG8_LDB(dst, b, h) do { _Pragma("unroll") for (int n = 0; n < 2; ++n) _Pragma("unroll") for (int k = 0; k < 2; ++k) dst[n][k] = *(const PG8_LAS bf16x8*)(lds + PG8_SB(b, h) + boff + n * 2048 + k * 1024); } while (0)
#define PG8_MMA(ai, bj, At, Bt) do { __builtin_amdgcn_s_setprio(1); _Pragma("unroll") for (int m = 0; m < 4; ++m) _Pragma("unroll") for (int n = 0; n < 2; ++n) _Pragma("unroll") for (int k = 0; k < 2; ++k) \
        acc[ai][bj][m][n] = __builtin_amdgcn_mfma_f32_16x16x32_bf16(Bt[n][k], At[m][k], acc[ai][bj][m][n], 0, 0, 0); __builtin_amdgcn_s_setprio(0); } while (0)
#define PG8_WAIT_V(n) asm volatile("s_waitcnt vmcnt(" #n ")" ::: "memory")
#define PG8_WAIT_L(n) asm volatile("s_waitcnt lgkmcnt(" #n ")" ::: "memory")
#define PG8_BAR __builtin_amdgcn_s_barrier()
#define PG8_SCHED __builtin_amdgcn_sched_barrier(0)
    Unit cur, nxt; int ui = 0;
    if (!S.next(0, cur)) return;
    float zf = 0.f; asm volatile("" : "+v"(zf));
    f32x4 acc[2][2][4][2];
#pragma unroll
    for (int a = 0; a < 2; ++a)
#pragma unroll
        for (int b = 0; b < 2; ++b)
#pragma unroll
            for (int m = 0; m < 4; ++m)
#pragma unroll
                for (int n = 0; n < 2; ++n) acc[a][b][m][n] = (f32x4){zf, zf, zf, zf};
    bf16x8 At[4][2], B0[2][2], B1[2][2];
    const char* cA = (const char*)g.A + ((long)cur.pm * g.a_stride + g.a_off) * (long)lda * 2; const char* cB = (const char*)g.Bt + (size_t)cur.pn * tstepB;
    PG8_STAGE(PG8_SB(0, 0), cB, voffB); PG8_STAGE(PG8_SB(0, 1), cB + hstepB, voffB); PG8_STAGE(PG8_SA(0, 0), cA, voffA); PG8_STAGE(PG8_SA(0, 1), cA + hstepA, voffA);
    if (wr == 1) PG8_BAR;
    PG8_WAIT_V(2); PG8_BAR;
    PG8_STAGE(PG8_SB(1, 0), cB + kstep, voffB); PG8_STAGE(PG8_SA(1, 0), cA + kstep, voffA); PG8_STAGE(PG8_SB(1, 1), cB + hstepB + kstep, voffB);
    PG8_WAIT_V(6); PG8_BAR;
    for (;;) {
        const bool has_next = S.next(ui + 1, nxt);
        const char* nA = has_next ? (const char*)g.A + ((long)nxt.pm * g.a_stride + g.a_off) * (long)lda * 2 : cA; const char* nB = has_next ? (const char*)g.Bt + (size_t)nxt.pn * tstepB : cB;
        for (int t = 0; t < nt; t += 2) {
            const bool last = (t == nt - 2);
            const char* a1 = cA + (size_t)(t + 1) * kstep;
            const char* a2 = last ? nA : cA + (size_t)(t + 2) * kstep; const char* b2 = last ? nB : cB + (size_t)(t + 2) * kstep;
            const char* a3 = a2 + kstep; const char* b3 = b2 + kstep;
            PG8_LDB(B0, 0, 0); PG8_LDB(B1, 0, 1); PG8_SCHED; PG8_LDA(At, 0, 0); PG8_STAGE(PG8_SA(1, 1), a1 + hstepA, voffA);
            PG8_WAIT_V(8); PG8_WAIT_L(0); PG8_BAR; PG8_MMA(0, 0, At, B0); PG8_MMA(0, 1, At, B1); PG8_BAR; PG8_SCHED;
            PG8_LDA(At, 0, 1); PG8_STAGE(PG8_SB(0, 0), b2, voffB); PG8_STAGE(PG8_SB(0, 1), b2 + hstepB, voffB); PG8_STAGE(PG8_SA(0, 0), a2, voffA);
            PG8_WAIT_V(8); PG8_WAIT_L(0); PG8_BAR; PG8_MMA(1, 0, At, B0); PG8_MMA(1, 1, At, B1); PG8_BAR; PG8_SCHED;
            PG8_LDB(B0, 1, 0); PG8_LDB(B1, 1, 1); PG8_SCHED; PG8_LDA(At, 1, 0); PG8_STAGE(PG8_SA(0, 1), a2 + hstepA, voffA);
            PG8_WAIT_V(8); PG8_WAIT_L(0); PG8_BAR; PG8_MMA(0, 0, At, B0); PG8_MMA(0, 1, At, B1); PG8_BAR; PG8_SCHED;
            PG8_LDA(At, 1, 1); PG8_STAGE(PG8_SB(1, 0), b3, voffB); PG8_STAGE(PG8_SB(1, 1), b3 + hstepB, voffB); PG8_STAGE(PG8_SA(1, 0), a3, voffA);
            PG8_WAIT_V(8); PG8_WAIT_L(0); PG8_BAR; PG8_MMA(1, 0, At, B0); PG8_MMA(1, 1, At, B1); PG8_BAR; PG8_SCHED;
        }
        if (wr == 0) PG8_BAR;
        E(acc, cur, wr, wc, elds);
        if (!has_next) break;
#pragma unroll
        for (int a = 0; a < 2; ++a)
#pragma unroll
            for (int b = 0; b < 2; ++b)
#pragma unroll
                for (int m = 0; m < 4; ++m)
#pragma unroll
                    for (int n = 0; n < 2; ++n) acc[a][b][m][n] = (f32x4){zf, zf, zf, zf};
        cur = nxt; cA = nA; cB = nB; ++ui;
        PG8_LANECONST();
        if (wr == 1) PG8_BAR;
    }
    PG8_WAIT_V(0);
    PG8_BAR;
#undef PG8_LANECONST
#undef PG8_SA
#undef PG8_SB
#undef PG8_STAGE
#undef PG8_LDA
#undef PG8_LDB
#undef PG8_MMA
}
}
namespace epi {
using pg8::f32x4; using pg8::u32x4; using pg8::u32x2; using pg8::bf16_t; using pg8::Unit; using pg8::cvt_pk_bf16;
constexpr int MROWS = 16384, DMODEL = 1024;
constexpr float EPS = 1e-6f;
#define EPI_LAS __attribute__((address_space(3)))

__device__ __forceinline__ float row_rstd(const float* ssq, int row) {
    const f32x4 a = *(const f32x4*)(ssq + (size_t)row * 4);
    const float s = (a[0] + a[1]) + (a[2] + a[3]);
    return 1.0f / sqrtf(s * (1.0f / DMODEL) + EPS);
}
__device__ __forceinline__ void rstd8(const float* ssq, int row0, bool clamp, float (&rs)[2][4]) {
    f32x4 p[2][4];
#pragma unroll
    for (int ai = 0; ai < 2; ++ai)
#pragma unroll
        for (int m = 0; m < 4; ++m) { int row = row0 + ai * 128 + m * 16; if (clamp) row = row < 0 ? 0 : (row >= MROWS ? MROWS - 1 : row); p[ai][m] = *(const f32x4*)(ssq + (size_t)row * 4); }
#pragma unroll
    for (int ai = 0; ai < 2; ++ai)
#pragma unroll
        for (int m = 0; m < 4; ++m) { const f32x4 a = p[ai][m]; rs[ai][m] = 1.0f / sqrtf(((a[0] + a[1]) + (a[2] + a[3])) * (1.0f / DMODEL) + EPS); }
}
template <int CTRL> __device__ __forceinline__ float dppf(float old, float src) {
    return __builtin_bit_cast(float, __builtin_amdgcn_update_dpp(__builtin_bit_cast(int, old), __builtin_bit_cast(int, src), CTRL, 0xF, 0xF, false));
}
template <int CTRL> __device__ __forceinline__ float dppa(float src) {
    return __builtin_bit_cast(float, __builtin_amdgcn_mov_dpp(__builtin_bit_cast(int, src), CTRL, 0xF, 0xF, true));
}
__device__ __forceinline__ f32x4 silu4(f32x4 v) {
    const f32x4 t = v * (-1.4426950408889634f); f32x4 e;
#pragma unroll
    for (int i = 0; i < 4; ++i) e[i] = __builtin_amdgcn_exp2f(t[i]);
    e = e + 1.0f;
#pragma unroll
    for (int i = 0; i < 4; ++i) e[i] = __builtin_amdgcn_rcpf(e[i]);
    return v * e;
}
template <int CTRL> __device__ __forceinline__ float dppz(float src) {
    return __builtin_bit_cast(float, __builtin_amdgcn_update_dpp(0, __builtin_bit_cast(int, src), CTRL, 0xF, 0xF, true));
}
__device__ __forceinline__ float silu_fast(float v) { return v * __builtin_amdgcn_rcpf(1.0f + __builtin_amdgcn_exp2f(-1.4426950408889634f * v)); }

struct EpiResidual {
    static constexpr bool PERM = false;
    const float* xin; float* xout; bf16_t* xb; float* ssq; int dry;
    __device__ __forceinline__ void operator()(f32x4 (&acc)[2][2][4][2], const Unit& u, int wr, int wc, EPI_LAS unsigned char* elds) const {
        int fr, fq; { int t_ = threadIdx.x; asm volatile("" : "+v"(t_)); fr = t_ & 15; fq = (t_ >> 4) & 3; }
        EPI_LAS float* P = (EPI_LAS float*)elds;
        const int col0 = u.pn * 256 + wc * 32 + 4 * fq;
#pragma unroll
        for (int ai = 0; ai < 2; ++ai) {
            f32x4 xv[4][2][2];
#pragma unroll
            for (int m = 0; m < 4; ++m)
#pragma unroll
                for (int bj = 0; bj < 2; ++bj)
#pragma unroll
                    for (int n = 0; n < 2; ++n) xv[m][bj][n] = *(const f32x4*)(xin + (size_t)(u.pm * 256 + ai * 128 + wr * 64 + m * 16 + fr) * DMODEL + col0 + bj * 128 + n * 16);
#pragma unroll
            for (int m = 0; m < 4; ++m) {
                const int row = u.pm * 256 + ai * 128 + wr * 64 + m * 16 + fr;
                const size_t off = (size_t)row * DMODEL + col0;
                float s = 0.f;
#pragma unroll
                for (int bj = 0; bj < 2; ++bj)
#pragma unroll
                    for (int n = 0; n < 2; ++n) {
                        const size_t o = off + bj * 128 + n * 16;
                        const f32x4 v = xv[m][bj][n] + acc[ai][bj][m][n];
                        if (!dry) *(f32x4*)(xout + o) = v;
                        u32x2 w; w.x = cvt_pk_bf16(v[0], v[1]); w.y = cvt_pk_bf16(v[2], v[3]);
                        *(u32x2*)(xb + o) = w;
                        s += (v[0] * v[0] + v[1] * v[1]) + (v[2] * v[2] + v[3] * v[3]);
                    }
                s += __shfl_xor(s, 16); s += __shfl_xor(s, 32);
                if (fq == 0) P[(ai * 128 + wr * 64 + m * 16 + fr) * 4 + wc] = s;
            }
            asm volatile("" ::: "memory");
        }
        asm volatile("s_waitcnt lgkmcnt(0)" ::: "memory"); __builtin_amdgcn_s_barrier(); asm volatile("" ::: "memory");
        { const int t = (wr * 4 + wc) * 64 + fq * 16 + fr; if (t < 256) { const f32x4 p = *(const EPI_LAS f32x4*)(P + t * 4); ssq[(size_t)(u.pm * 256 + t) * 4 + u.pn] = (p[0] + p[1]) + (p[2] + p[3]); } }
        asm volatile("s_waitcnt lgkmcnt(0)" ::: "memory"); __builtin_amdgcn_s_barrier(); asm volatile("" ::: "memory");
    }
};

struct EpiSsdIn {
    static constexpr bool PERM = true;
    bf16_t* proj; float* dt; const float* dtbias; const float* ssq;
    __device__ __forceinline__ void operator()(f32x4 (&acc)[2][2][4][2], const Unit& u, int wr, int wc, EPI_LAS unsigned char*) const {
        int fr, fq; { int t_ = threadIdx.x; asm volatile("" : "+v"(t_)); fr = t_ & 15; fq = (t_ >> 4) & 3; }
        float rsv[2][4]; rstd8(ssq, u.pm * 256 + wr * 64 + fr, false, rsv);
#pragma unroll
        for (int ai = 0; ai < 2; ++ai)
#pragma unroll
            for (int m = 0; m < 4; ++m) {
                const int row = u.pm * 256 + ai * 128 + wr * 64 + m * 16 + fr;
                const float rs = rsv[ai][m];
                if (u.pn < 20) {
#pragma unroll
                    for (int bj = 0; bj < 2; ++bj) {
                        const f32x4 v0 = acc[ai][bj][m][0] * rs, v1 = acc[ai][bj][m][1] * rs;
                        u32x4 w; w.x = cvt_pk_bf16(v0[0], v0[1]); w.y = cvt_pk_bf16(v0[2], v0[3]); w.z = cvt_pk_bf16(v1[0], v1[1]); w.w = cvt_pk_bf16(v1[2], v1[3]);
                        *(u32x4*)(proj + (size_t)row * 5120 + u.pn * 256 + bj * 128 + wc * 32 + 8 * fq) = w;
                    }
                } else if (wc == 0) {
#pragma unroll
                    for (int n = 0; n < 2; ++n) {
                        const int c = 8 * fq + 4 * n;
                        const f32x4 b = *(const f32x4*)(dtbias + c);
                        f32x4 v = acc[ai][0][m][n] * rs + b, o;
#pragma unroll
                        for (int e = 0; e < 4; ++e) o[e] = fmaxf(v[e], 0.f) + log1pf(expf(-fabsf(v[e])));
                        *(f32x4*)(dt + (size_t)row * 32 + c) = o;
                    }
                }
            }
    }
};

struct EpiQKV {
    static constexpr bool PERM = true;
    bf16_t* proj; const float* ssq; const float* qg; const float* kg; const float* rope;
    __device__ __forceinline__ void operator()(f32x4 (&acc)[2][2][4][2], const Unit& u, int wr, int wc, EPI_LAS unsigned char* elds) const {
        int fr, fq; { int t_ = threadIdx.x; asm volatile("" : "+v"(t_)); fr = t_ & 15; fq = (t_ >> 4) & 3; }
        EPI_LAS float* P = (EPI_LAS float*)elds;
        EPI_LAS f32x4* RT = (EPI_LAS f32x4*)(elds + 8192);
        const bool isqk = u.pn < 8;
        f32x4 rp_[2];
        const int t_id = (wr * 4 + wc) * 64 + fq * 16 + fr;
        if (isqk) {
#pragma unroll
            for (int i = 0; i < 2; ++i) rp_[i] = *(const f32x4*)(rope + (size_t)u.pm * 256 * 16 + (size_t)(t_id * 2 + i) * 4);
        }
        float rsv[2][4]; rstd8(ssq, u.pm * 256 + wr * 64 + fr, false, rsv);
#pragma unroll
        for (int ai = 0; ai < 2; ++ai)
#pragma unroll
            for (int m = 0; m < 4; ++m) {
                const int trow = ai * 128 + wr * 64 + m * 16 + fr;
                const float rs = rsv[ai][m];
#pragma unroll
                for (int bj = 0; bj < 2; ++bj) {
                    acc[ai][bj][m][0] *= rs; acc[ai][bj][m][1] *= rs;
                    if (isqk) {
                        const f32x4 a = acc[ai][bj][m][0], b = acc[ai][bj][m][1];
                        float s = ((a[0] * a[0] + a[1] * a[1]) + (a[2] * a[2] + a[3] * a[3])) + ((b[0] * b[0] + b[1] * b[1]) + (b[2] * b[2] + b[3] * b[3]));
                        s += __shfl_xor(s, 16); s += __shfl_xor(s, 32);
                        if (fq == 0) P[trow * 8 + bj * 4 + wc] = s;
                    }
                }
            }
        if (isqk) { RT[t_id * 2] = rp_[0]; RT[t_id * 2 + 1] = rp_[1]; }
        if (isqk) {
            asm volatile("s_waitcnt lgkmcnt(0)" ::: "memory"); __builtin_amdgcn_s_barrier(); asm volatile("" ::: "memory");
            const float* g = (u.pn < 4) ? qg : kg;
            const int d0 = 32 * (wc & 1) + 8 * fq;
            const f32x4 g0 = *(const f32x4*)(g + d0), g1 = *(const f32x4*)(g + d0 + 4);
            const float qs = (u.pn < 4) ? (1.4426950408889634f * 0.125f) : 1.0f;
            const bool dorope = (wc & 1) == 0;
#pragma unroll
            for (int ai = 0; ai < 2; ++ai)
#pragma unroll
                for (int m = 0; m < 4; ++m) {
                    const int trow = ai * 128 + wr * 64 + m * 16 + fr;
                    const int row = u.pm * 256 + trow;
                    f32x4 c0 = {1.f, 1.f, 1.f, 1.f}, c1 = c0, s0 = {0.f, 0.f, 0.f, 0.f}, s1 = s0;
                    if (dorope && fq < 2) {
                        c0 = RT[trow * 4 + 0]; c1 = RT[trow * 4 + 1]; s0 = RT[trow * 4 + 2]; s1 = RT[trow * 4 + 3];
                        if (fq == 0) { s0 = -s0; s1 = -s1; }
                    }
#pragma unroll
                    for (int bj = 0; bj < 2; ++bj) {
                        const float tot = P[trow * 8 + bj * 4 + wc] + P[trow * 8 + bj * 4 + (wc ^ 1)];
                        const float nr = qs / sqrtf(tot * (1.0f / 64.0f) + EPS);
                        f32x4 v0 = acc[ai][bj][m][0] * g0 * nr, v1 = acc[ai][bj][m][1] * g1 * nr;
                        if (dorope) {
                            f32x4 o0, o1;
#pragma unroll
                            for (int e = 0; e < 4; ++e) { o0[e] = __shfl_xor(v0[e], 16); o1[e] = __shfl_xor(v1[e], 16); }
                            v0 = v0 * c0 + o0 * s0; v1 = v1 * c1 + o1 * s1;
                        }
                        u32x4 w; w.x = cvt_pk_bf16(v0[0], v0[1]); w.y = cvt_pk_bf16(v0[2], v0[3]); w.z = cvt_pk_bf16(v1[0], v1[1]); w.w = cvt_pk_bf16(v1[2], v1[3]);
                        *(u32x4*)(proj + (size_t)row * 3072 + u.pn * 256 + bj * 128 + wc * 32 + 8 * fq) = w;
                    }
                    asm volatile("" ::: "memory");
                }
            asm volatile("s_waitcnt lgkmcnt(0)" ::: "memory"); __builtin_amdgcn_s_barrier(); asm volatile("" ::: "memory");
        } else {
#pragma unroll
            for (int ai = 0; ai < 2; ++ai)
#pragma unroll
                for (int m = 0; m < 4; ++m) {
                    const int row = u.pm * 256 + ai * 128 + wr * 64 + m * 16 + fr;
#pragma unroll
                    for (int bj = 0; bj < 2; ++bj) {
                        const f32x4 v0 = acc[ai][bj][m][0], v1 = acc[ai][bj][m][1];
                        u32x4 w; w.x = cvt_pk_bf16(v0[0], v0[1]); w.y = cvt_pk_bf16(v0[2], v0[3]); w.z = cvt_pk_bf16(v1[0], v1[1]); w.w = cvt_pk_bf16(v1[2], v1[3]);
                        *(u32x4*)(proj + (size_t)row * 3072 + u.pn * 256 + bj * 128 + wc * 32 + 8 * fq) = w;
                    }
                }
        }
    }
};

struct EpiSsdConv {
    static constexpr bool PERM = true;
    bf16_t* zp; bf16_t* xbc; float* dt; const float* ssq; const float* cp;
    template <bool MASK>
    __device__ __forceinline__ void conv_body(f32x4 (&acc)[2][2][4][2], const Unit& u, int wr, int wc, int fr, int fq, const EPI_LAS f32x4* hb, int R0) const {
        bf16_t* const obase = (u.pn < 8) ? zp + u.pn * 256 : xbc + (u.pn - 8) * 256;
        const int old_ = (u.pn < 8) ? 2048 : 3072;
#pragma unroll
        for (int bj = 0; bj < 2; ++bj) {
            u32x2 keep[2][4];
#pragma unroll
            for (int n = 0; n < 2; ++n) {
                const int tc = bj * 128 + wc * 32 + 8 * fq + 4 * n;
                const EPI_LAS float* pt = (const EPI_LAS float*)((const EPI_LAS unsigned char*)hb + 12288) + tc;
                const f32x4 bb = *(const EPI_LAS f32x4*)pt, w0 = *(const EPI_LAS f32x4*)(pt + 256), w1 = *(const EPI_LAS f32x4*)(pt + 512), w2 = *(const EPI_LAS f32x4*)(pt + 768), w3 = *(const EPI_LAS f32x4*)(pt + 1024);
#pragma unroll
                for (int ai = 0; ai < 2; ++ai) {
                    f32x4 pv = {0.f, 0.f, 0.f, 0.f};
                    const int pwr = wr ^ 1, pai = (wr == 1) ? ai : ai - 1;
                    if (pai >= 0 && fr >= 13) pv = hb[((((pwr * 2 + pai) * 4 + wc) * 3 + (fr - 13)) * 4 + fq) * 4 + bj * 2 + n];
#pragma unroll
                    for (int m = 0; m < 4; ++m) {
                        const int trow = ai * 128 + wr * 64 + m * 16 + fr, row = R0 + trow;
                        const f32x4 cv = acc[ai][bj][m][n];
                        const f32x4 qv = (m == 0) ? pv : acc[ai][bj][m - 1][n];
                        bool k1 = true, k2 = true, k3 = true;
                        if (MASK) { const int ts = row & 2047; k1 = ts >= 1; k2 = ts >= 2; k3 = ts >= 3; }
                        f32x4 x1, x2, x3;
#pragma unroll
                        for (int e = 0; e < 4; ++e) {
                            x1[e] = dppf<0x111>(dppa<0x121>(qv[e]), cv[e]);
                            x2[e] = dppf<0x112>(dppa<0x122>(qv[e]), cv[e]);
                            x3[e] = dppf<0x113>(dppa<0x123>(qv[e]), cv[e]);
                            if (MASK) { x1[e] = k1 ? x1[e] : 0.f; x2[e] = k2 ? x2[e] : 0.f; x3[e] = k3 ? x3[e] : 0.f; }
                        }
                        const bool valid = trow >= 3 && row < MROWS;
                        const f32x4 o = silu4(bb + w0 * x3 + w1 * x2 + w2 * x1 + w3 * cv);
                        if (n == 0) { keep[ai][m].x = cvt_pk_bf16(o[0], o[1]); keep[ai][m].y = cvt_pk_bf16(o[2], o[3]); }
                        else if (valid) {
                            u32x4 w; w.x = keep[ai][m].x; w.y = keep[ai][m].y; w.z = cvt_pk_bf16(o[0], o[1]); w.w = cvt_pk_bf16(o[2], o[3]);
                            *(u32x4*)(obase + (size_t)row * old_ + tc - 4) = w;
                        }
                        asm volatile("" ::: "memory");
                    }
                }
            }
        }
    }
    __device__ __forceinline__ void operator()(f32x4 (&acc)[2][2][4][2], const Unit& u, int wr, int wc, EPI_LAS unsigned char* elds) const {
        int fr, fq; { int t_ = threadIdx.x; asm volatile("" : "+v"(t_)); fr = t_ & 15; fq = (t_ >> 4) & 3; }
        const int R0 = u.pm * 253 - 3;
        EPI_LAS f32x4* hb = (EPI_LAS f32x4*)elds;
        const int t_id = (wr * 4 + wc) * 64 + fq * 16 + fr;
        f32x4 pld = {0.f, 0.f, 0.f, 0.f};
        if (t_id < 320) pld = *(const f32x4*)(cp + (size_t)(t_id >> 6) * 5376 + u.pn * 256 + (t_id & 63) * 4);
        { float rsv[2][4]; rstd8(ssq, R0 + wr * 64 + fr, true, rsv);
#pragma unroll
          for (int ai = 0; ai < 2; ++ai)
#pragma unroll
            for (int m = 0; m < 4; ++m)
#pragma unroll
                for (int bj = 0; bj < 2; ++bj) { acc[ai][bj][m][0] *= rsv[ai][m]; acc[ai][bj][m][1] *= rsv[ai][m]; } }
        if (t_id < 320) *(EPI_LAS f32x4*)((EPI_LAS unsigned char*)hb + 12288 + t_id * 16) = pld;
        if (u.pn == 20) {
            if (wc == 0) {
#pragma unroll
                for (int ai = 0; ai < 2; ++ai)
#pragma unroll
                    for (int m = 0; m < 4; ++m) {
                        const int trow = ai * 128 + wr * 64 + m * 16 + fr, row = R0 + trow;
                        if (trow >= 3 && row < MROWS) {
#pragma unroll
                            for (int n = 0; n < 2; ++n) {
                                const int c = 8 * fq + 4 * n;
                                const f32x4 b = *(const f32x4*)(cp + 20 * 256 + c);
                                f32x4 v = acc[ai][0][m][n] + b, o;
#pragma unroll
                                for (int e = 0; e < 4; ++e) o[e] = fmaxf(v[e], 0.f) + log1pf(expf(-fabsf(v[e])));
                                *(f32x4*)(dt + (size_t)row * 32 + c) = o;
                            }
                        }
                    }
            }
            return;
        }
        if (fr >= 13) {
#pragma unroll
            for (int ai = 0; ai < 2; ++ai) {
                const int idx = ((((wr * 2 + ai) * 4 + wc) * 3 + (fr - 13)) * 4 + fq) * 4;
                hb[idx + 0] = acc[ai][0][3][0]; hb[idx + 1] = acc[ai][0][3][1]; hb[idx + 2] = acc[ai][1][3][0]; hb[idx + 3] = acc[ai][1][3][1];
            }
        }
        asm volatile("s_waitcnt lgkmcnt(0)" ::: "memory"); __builtin_amdgcn_s_barrier(); asm volatile("" ::: "memory");
        const int tf = (u.pm * 253) & 2047;
        if (tf <= 2 || tf + 252 >= 2048) conv_body<true>(acc, u, wr, wc, fr, fq, hb, R0); else conv_body<false>(acc, u, wr, wc, fr, fq, hb, R0);
        asm volatile("s_waitcnt lgkmcnt(0)" ::: "memory"); __builtin_amdgcn_s_barrier(); asm volatile("" ::: "memory");
    }
};

struct EpiConvGate {
    static constexpr bool PERM = true;
    bf16_t* H; const float* ssq; const float* cw; const float* cb; int dry;
    template <bool MASK>
    __device__ __forceinline__ void body(f32x4 (&acc)[2][2][4][2], const Unit& u, int wr, int wc, int fr, int fq, const EPI_LAS f32x4* hb, int R0) const {
        constexpr int DFF = 2816;
        u32x2 keep[2][4];
#pragma unroll
        for (int n = 0; n < 2; ++n) {
            const int ch = u.pn * 128 + wc * 32 + 8 * fq + 4 * n;
            const EPI_LAS float* pt = (const EPI_LAS float*)((const EPI_LAS unsigned char*)hb + 8192) + wc * 32 + 8 * fq + 4 * n;
            const f32x4 bg = *(const EPI_LAS f32x4*)pt, bu = *(const EPI_LAS f32x4*)(pt + 128);
            const f32x4 w0g = *(const EPI_LAS f32x4*)(pt + 256), w0u = *(const EPI_LAS f32x4*)(pt + 384), w1g = *(const EPI_LAS f32x4*)(pt + 512), w1u = *(const EPI_LAS f32x4*)(pt + 640), w2g = *(const EPI_LAS f32x4*)(pt + 768), w2u = *(const EPI_LAS f32x4*)(pt + 896);
#pragma unroll
            for (int ai = 0; ai < 2; ++ai) {
                f32x4 pg = {0.f, 0.f, 0.f, 0.f}, pu = pg;
                const int pwr = wr ^ 1, pai = (wr == 1) ? ai : ai - 1;
                if (pai >= 0 && fr >= 14) {
                    const int idx = ((((pwr * 2 + pai) * 4 + wc) * 2 + (fr - 14)) * 4 + fq) * 4;
                    pg = hb[idx + 0 + n]; pu = hb[idx + 2 + n];
                }
#pragma unroll
                for (int m = 0; m < 4; ++m) {
                    const int trow = ai * 128 + wr * 64 + m * 16 + fr, row = R0 + trow;
                    const f32x4 cg = acc[ai][0][m][n], cu = acc[ai][1][m][n];
                    const f32x4 qg_ = (m == 0) ? pg : acc[ai][0][m - 1][n], qu_ = (m == 0) ? pu : acc[ai][1][m - 1][n];
                    bool k1 = true, k2 = true;
                    if (MASK) { const int ts = row & 2047; k1 = ts >= 1; k2 = ts >= 2; }
                    f32x4 g1, g2, u1, u2;
#pragma unroll
                    for (int e = 0; e < 4; ++e) {
                        g1[e] = dppf<0x111>(dppa<0x121>(qg_[e]), cg[e]);
                        g2[e] = dppf<0x112>(dppa<0x122>(qg_[e]), cg[e]);
                        u1[e] = dppf<0x111>(dppa<0x121>(qu_[e]), cu[e]);
                        u2[e] = dppf<0x112>(dppa<0x122>(qu_[e]), cu[e]);
                        if (MASK) { g1[e] = k1 ? g1[e] : 0.f; u1[e] = k1 ? u1[e] : 0.f; g2[e] = k2 ? g2[e] : 0.f; u2[e] = k2 ? u2[e] : 0.f; }
                    }
                    const f32x4 gv = bg + w0g * g2 + w1g * g1 + w2g * cg;
                    const f32x4 uv = bu + w0u * u2 + w1u * u1 + w2u * cu;
                    const f32x4 o = silu4(gv) * uv;
                    if (n == 0) { keep[ai][m].x = cvt_pk_bf16(o[0], o[1]); keep[ai][m].y = cvt_pk_bf16(o[2], o[3]); }
                    else if (trow >= 2 && row < MROWS && !dry) {
                        u32x4 w; w.x = keep[ai][m].x; w.y = keep[ai][m].y; w.z = cvt_pk_bf16(o[0], o[1]); w.w = cvt_pk_bf16(o[2], o[3]);
                        *(u32x4*)(H + (size_t)row * DFF + ch - 4) = w;
                    }
                    asm volatile("" ::: "memory");
                }
            }
        }
    }
    __device__ __forceinline__ void operator()(f32x4 (&acc)[2][2][4][2], const Unit& u, int wr, int wc, EPI_LAS unsigned char* elds) const {
        int fr, fq; { int t_ = threadIdx.x; asm volatile("" : "+v"(t_)); fr = t_ & 15; fq = (t_ >> 4) & 3; }
        const int R0 = u.pm * 254 - 2;
        EPI_LAS f32x4* hb = (EPI_LAS f32x4*)elds;
        const int t_id = (wr * 4 + wc) * 64 + fq * 16 + fr;
        f32x4 pld = {0.f, 0.f, 0.f, 0.f};
        if (t_id < 256) { const int k = t_id >> 5, c = u.pn * 128 + (t_id & 31) * 4; pld = *(const f32x4*)((k < 2 ? cb + k * 2816 : cw + (size_t)(k - 2) * 2816) + c); }
        { float rsv[2][4]; rstd8(ssq, R0 + wr * 64 + fr, true, rsv);
#pragma unroll
          for (int ai = 0; ai < 2; ++ai)
#pragma unroll
            for (int m = 0; m < 4; ++m)
#pragma unroll
                for (int bj = 0; bj < 2; ++bj) { acc[ai][bj][m][0] *= rsv[ai][m]; acc[ai][bj][m][1] *= rsv[ai][m]; } }
        if (t_id < 256) *(EPI_LAS f32x4*)((EPI_LAS unsigned char*)hb + 8192 + t_id * 16) = pld;
        if (fr >= 14) {
#pragma unroll
            for (int ai = 0; ai < 2; ++ai) {
                const int idx = ((((wr * 2 + ai) * 4 + wc) * 2 + (fr - 14)) * 4 + fq) * 4;
                hb[idx + 0] = acc[ai][0][3][0]; hb[idx + 1] = acc[ai][0][3][1]; hb[idx + 2] = acc[ai][1][3][0]; hb[idx + 3] = acc[ai][1][3][1];
            }
        }
        asm volatile("s_waitcnt lgkmcnt(0)" ::: "memory"); __builtin_amdgcn_s_barrier(); asm volatile("" ::: "memory");
        const int tf = (u.pm * 254) & 2047;
        if (dry < 2) { if (tf <= 1 || tf + 253 >= 2048) body<true>(acc, u, wr, wc, fr, fq, hb, R0); else body<false>(acc, u, wr, wc, fr, fq, hb, R0); }
        asm volatile("s_waitcnt lgkmcnt(0)" ::: "memory"); __builtin_amdgcn_s_barrier(); asm volatile("" ::: "memory");
    }
};
}
namespace attn {
using pg8::bf16_t; using pg8::bf16x8; using pg8::f32x4; using pg8::u32x4;
typedef float f32x16 __attribute__((ext_vector_type(16)));
typedef short s16x4 __attribute__((ext_vector_type(4)));
#define AT_LAS __attribute__((address_space(3)))
constexpr int LD = 3072, SEQ = 2048;
constexpr int KT_BYTES = 16384, VT_BYTES = 16384, STG = KT_BYTES + VT_BYTES;
constexpr int L_X = 0;
constexpr int L_WSF = 2 * STG;
constexpr int L_OST = L_WSF + 8 * 256;
constexpr int LDS_BYTES = L_OST + 4 * 8192;
__device__ __forceinline__ int crow(int r, int hi) { return (r & 3) + 8 * (r >> 2) + 4 * hi; }
__device__ __forceinline__ unsigned cvtpk(float lo, float hi) { typedef float f2 __attribute__((ext_vector_type(2))); typedef __bf16 b2 __attribute__((ext_vector_type(2))); f2 v = {lo, hi}; b2 b = __builtin_convertvector(v, b2); return __builtin_bit_cast(unsigned, b); }
__device__ __forceinline__ s16x4 vtr(const AT_LAS char* p) { typedef short v4 __attribute__((ext_vector_type(4))); return __builtin_bit_cast(s16x4, __builtin_amdgcn_ds_read_tr16_b64_v4i16((AT_LAS v4*)p)); }

struct Params { bf16_t* qkv; float mb; float lam; int dry; };

__device__ __forceinline__ void unit(const Params& P, int b, int h, int blk, AT_LAS char* lds) {
    int tid = threadIdx.x; asm volatile("" : "+v"(tid));
    const int lane = tid & 63, r32 = lane & 31, hi = lane >> 5;
    const int wid = __builtin_amdgcn_readfirstlane(tid >> 6), comp = wid >> 2, w4 = wid & 3;
    const size_t rowb = (size_t)b * SEQ;
    const int q0 = blk * 128;
    const int nt = 2 * blk + 2, my_nt = 2 * blk + (w4 >> 1) + 1;
    const bf16_t* Kg = P.qkv + rowb * LD + 1024 + h * 128;
    const bf16_t* Vg = P.qkv + rowb * LD + 2048 + h * 128;
    u32x4 kreg[2], vreg[2];
    int kdst[2], vdst[2];
#pragma unroll
    for (int i = 0; i < 2; ++i) {
        const int p = tid + 512 * i, key = p >> 4, c16 = p & 15;
        kdst[i] = key * 256 + ((c16 ^ (key & 15)) << 4);
        vdst[i] = KT_BYTES + (c16 >> 2) * 4096 + (key >> 4) * 1024 + ((key >> 3) & 1) * 512 + (key & 7) * 64 + (c16 & 3) * 16;
    }
#define AT_LOAD(t) do { _Pragma("unroll") for (int i = 0; i < 2; ++i) { const int p = tid + 512 * i, key = p >> 4, c16 = p & 15; const size_t go = (size_t)((t) * 64 + key) * LD + c16 * 8; \
        kreg[i] = *(const u32x4*)(Kg + go); vreg[i] = *(const u32x4*)(Vg + go); } } while (0)
#define AT_STORE(s) do { _Pragma("unroll") for (int i = 0; i < 2; ++i) { *(AT_LAS u32x4*)(lds + (s) * STG + kdst[i]) = kreg[i]; *(AT_LAS u32x4*)(lds + (s) * STG + vdst[i]) = vreg[i]; } } while (0)
    AT_LOAD(0);
    bf16x8 qr[4];
    {
        const bf16_t* Qw = P.qkv + (rowb + q0 + w4 * 32 + r32) * LD + h * 128 + comp * 64 + hi * 8;
#pragma unroll
        for (int d0 = 0; d0 < 4; ++d0) qr[d0] = *(const bf16x8*)(Qw + d0 * 16);
    }
    AT_STORE(0);
    __syncthreads();
    f32x16 o[4];
#pragma unroll
    for (int i = 0; i < 4; ++i)
#pragma unroll
        for (int r = 0; r < 16; ++r) o[i][r] = 0.f;
    float lsum = 0.f;
    f32x16 negm;
#pragma unroll
    for (int r = 0; r < 16; ++r) negm[r] = -P.mb;
    const int kbase = r32 * 256, ksw = r32 & 15;
    const int vbase = KT_BYTES + ((lane >> 4) & 1) * 32 + (lane & 3) * 8 + (4 * hi + ((lane & 15) >> 2)) * 64;
    for (int t = 0; t < nt; ++t) {
        const int s = t & 1;
        if (t + 1 < nt) AT_LOAD(t + 1);
        if (t < my_nt) {
            const AT_LAS char* st = lds + s * STG;
            f32x16 p0 = negm, p1 = negm;
#pragma unroll
            for (int d0 = 0; d0 < 4; ++d0) {
                const int ch = comp * 8 + 2 * d0 + hi;
                const bf16x8 k0 = *(const AT_LAS bf16x8*)(st + kbase + ((ch ^ ksw) << 4));
                const bf16x8 k1 = *(const AT_LAS bf16x8*)(st + kbase + 32 * 256 + ((ch ^ ksw) << 4));
                p0 = __builtin_amdgcn_mfma_f32_32x32x16_bf16(k0, qr[d0], p0, 0, 0, 0);
                p1 = __builtin_amdgcn_mfma_f32_32x32x16_bf16(k1, qr[d0], p1, 0, 0, 0);
            }
            float sacc = 0.f;
#pragma unroll
            for (int r = 0; r < 16; ++r) { p0[r] = __builtin_amdgcn_exp2f(p0[r]); p1[r] = __builtin_amdgcn_exp2f(p1[r]); sacc += p0[r] + p1[r]; }
            lsum += sacc;
            u32x4 pw[4];
#pragma unroll
            for (int j = 0; j < 4; ++j) { pw[0][j] = cvtpk(p0[2 * j], p0[2 * j + 1]); pw[1][j] = cvtpk(p0[8 + 2 * j], p0[8 + 2 * j + 1]); pw[2][j] = cvtpk(p1[2 * j], p1[2 * j + 1]); pw[3][j] = cvtpk(p1[8 + 2 * j], p1[8 + 2 * j + 1]); }
#pragma unroll
            for (int bk = 0; bk < 4; ++bk)
#pragma unroll
                for (int ks = 0; ks < 4; ++ks) {
                    const s16x4 lo = vtr(st + vbase + bk * 4096 + ks * 1024), hh = vtr(st + vbase + bk * 4096 + ks * 1024 + 512);
                    const bf16x8 vf = {lo[0], lo[1], lo[2], lo[3], hh[0], hh[1], hh[2], hh[3]};
                    o[bk] = __builtin_amdgcn_mfma_f32_32x32x16_bf16(__builtin_bit_cast(bf16x8, pw[ks]), vf, o[bk], 0, 0, 0);
                }
        }
        if (t + 1 < nt) AT_STORE(s ^ 1);
        __syncthreads();
    }
    lsum += __shfl_xor(lsum, 32);
    AT_LAS float* wsf = (AT_LAS float*)(lds + L_WSF) + wid * 64;
    if (hi == 0) wsf[r32] = lsum;
    asm volatile("s_waitcnt lgkmcnt(0)" ::: "memory");
    float rl[16];
    const float sc = comp ? P.lam : 1.0f;
#pragma unroll
    for (int r = 0; r < 16; ++r) rl[r] = sc * __builtin_amdgcn_rcpf(wsf[crow(r, hi)]);
    AT_LAS float* X = (AT_LAS float*)(lds + L_X) + w4 * 4096 + lane;
    if (comp == 1) {
#pragma unroll
        for (int bk = 0; bk < 4; ++bk)
#pragma unroll
            for (int r = 0; r < 16; ++r) X[(bk * 16 + r) * 64] = o[bk][r] * rl[r];
    }
    __syncthreads();
    if (comp == 0) {
        float ss[16];
#pragma unroll
        for (int r = 0; r < 16; ++r) ss[r] = 0.f;
#pragma unroll
        for (int bk = 0; bk < 4; ++bk)
#pragma unroll
            for (int r = 0; r < 16; ++r) { const float v = o[bk][r] * rl[r] - X[(bk * 16 + r) * 64]; o[bk][r] = v; ss[r] += v * v; }
#pragma unroll
        for (int r = 0; r < 16; ++r) {
            float s = ss[r];
            s += __shfl_xor(s, 1); s += __shfl_xor(s, 2); s += __shfl_xor(s, 4); s += __shfl_xor(s, 8); s += __shfl_xor(s, 16);
            ss[r] = 1.0f / sqrtf(s * (1.0f / 128.0f) + 1e-6f);
        }
        AT_LAS bf16_t* stg = (AT_LAS bf16_t*)(lds + L_OST) + w4 * 4096;
#pragma unroll
        for (int bk = 0; bk < 4; ++bk)
#pragma unroll
            for (int r = 0; r < 16; ++r) { const float v = o[bk][r] * ss[r]; stg[crow(r, hi) * 128 + bk * 32 + r32] = (bf16_t)(cvtpk(v, 0.f) & 0xffffu); }
        asm volatile("s_waitcnt lgkmcnt(0)" ::: "memory");
        bf16_t* Ow = P.qkv + (rowb + q0 + w4 * 32) * LD + h * 128;
#pragma unroll
        for (int i = 0; i < 8; ++i) { const int row = i * 4 + (lane >> 4), c = lane & 15; const u32x4 v = *(const AT_LAS u32x4*)(stg + row * 128 + c * 8); if (!P.dry) *(u32x4*)(Ow + (size_t)row * LD + c * 8) = v; }
    }
    __syncthreads();
#undef AT_LOAD
#undef AT_STORE
}
}
namespace scan {
using pg8::bf16_t; using pg8::bf16x8; using pg8::f32x4; using pg8::u32x4; using pg8::u32x2;
typedef float f32x16 __attribute__((ext_vector_type(16)));
#define SC_LAS __attribute__((address_space(3)))
#define SC_BAR() do { asm volatile("s_waitcnt lgkmcnt(0)" ::: "memory"); __builtin_amdgcn_s_barrier(); asm volatile("" ::: "memory"); } while (0)
constexpr int SEQ = 2048, CH = 64;
constexpr int L_C = 0;
constexpr int L_B = 16384;
constexpr int L_XD = 32768;
constexpr int L_XW = 40960;
constexpr int L_G = 49152;
constexpr int L_H = 57344;
constexpr int L_Y = 73728;
constexpr int L_S = L_Y + 64 * 68 * 4;
constexpr int LDS_BYTES = L_S + 32 * 1024;
__device__ __forceinline__ unsigned cvtpk(float lo, float hi) { typedef float f2 __attribute__((ext_vector_type(2))); typedef __bf16 b2 __attribute__((ext_vector_type(2))); f2 v = {lo, hi}; b2 b = __builtin_convertvector(v, b2); return __builtin_bit_cast(unsigned, b); }
typedef short s16x4 __attribute__((ext_vector_type(4)));
__device__ __forceinline__ s16x4 vtr(const SC_LAS char* p) { typedef short v4 __attribute__((ext_vector_type(4))); return __builtin_bit_cast(s16x4, __builtin_amdgcn_ds_read_tr16_b64_v4i16((SC_LAS v4*)p)); }
__device__ __forceinline__ float lo16(unsigned w) { return __builtin_bit_cast(float, w << 16); }
__device__ __forceinline__ float hi16(unsigned w) { return __builtin_bit_cast(float, w & 0xffff0000u); }
__device__ __forceinline__ int img_off(int l) { return (l >> 4) * 1024 + ((l >> 3) & 1) * 512 + (l & 7) * 64; }

struct Params { const bf16_t* xbc; bf16_t* zp; const float* dt; const float* a_log; const float* dskip; float* ssqp; int dry; };

__device__ __forceinline__ void unit(const Params& P, int b, int h, SC_LAS char* lds) {
    int tid = threadIdx.x; asm volatile("" : "+v"(tid));
    const int wid = __builtin_amdgcn_readfirstlane(tid >> 6);
    const int g = h >> 3;
    const size_t rowb = (size_t)b * SEQ;
    const float a_h = -expf(P.a_log[h]), dsk = P.dskip[h];
    unsigned zu = 0u; asm volatile("" : "+v"(zu));
    {
        const int lane_ = tid & 63;
#pragma unroll
        for (int q = 0; q < 4; ++q) {
            const int cc = wid * 4 + q;
            const float dtv = P.dt[(rowb + cc * 64 + lane_) * 32 + h];
            float acs = dtv * a_h;
#pragma unroll
            for (int o = 1; o < 64; o <<= 1) { const float up = __shfl_up(acs, o); if (lane_ >= o) acs += up; }
            const float last = __shfl(acs, 63);
            SC_LAS float* sc = (SC_LAS float*)(lds + L_S) + cc * 256;
            sc[lane_] = dtv; sc[64 + lane_] = acs; sc[128 + lane_] = __expf(last - acs); sc[192 + lane_] = __expf(acs);
        }
    }
    for (int i = tid; i < 16384 / 16; i += 512) *(SC_LAS u32x4*)(lds + L_H + i * 16) = (u32x4){zu, zu, zu, zu};
    f32x16 hacc0, hacc1;
#pragma unroll
    for (int r = 0; r < 16; ++r) { hacc0[r] = 0.f; hacc1[r] = 0.f; }
    const int tid0 = tid;
    u32x4 xr, zr, br[2], cr[2];
#define SC_LOAD(t0_, XR, ZR) do { const int t_ = tid0; const size_t r1 = rowb + (t0_) + (t_ >> 3); \
        XR = *(const u32x4*)(P.xbc + r1 * 3072 + h * 64 + (t_ & 7) * 8); ZR = *(const u32x4*)(P.zp + r1 * 2048 + h * 64 + (t_ & 7) * 8); \
        _Pragma("unroll") for (int i = 0; i < 2; ++i) { const int p_ = t_ + 512 * i; const size_t r2 = rowb + (t0_) + (p_ >> 4); \
            br[i] = *(const u32x4*)(P.xbc + r2 * 3072 + 2048 + g * 128 + (p_ & 15) * 8); cr[i] = *(const u32x4*)(P.xbc + r2 * 3072 + 2560 + g * 128 + (p_ & 15) * 8); } } while (0)
    SC_LOAD(0, xr, zr);
    __syncthreads();
    for (int c = 0; c < SEQ / CH; ++c) {
        const int t0 = c * CH;
        int tid = tid0; asm volatile("" : "+v"(tid));
        const int lane = tid & 63, r32 = lane & 31, hi = lane >> 5, fr = lane & 15, fq = lane >> 4;
        const int orow = tid >> 3, ocg = tid & 7;
        SC_LAS float* s_dt = (SC_LAS float*)(lds + L_S) + c * 256; SC_LAS float* s_acs = s_dt + 64; SC_LAS float* s_dec = s_dt + 128; SC_LAS float* s_ea = s_dt + 192;
        {
            const float d = s_dt[orow], dd = d * s_dec[orow];
            u32x4 w1, w2;
#pragma unroll
            for (int i = 0; i < 4; ++i) { const float a = lo16(xr[i]), bq = hi16(xr[i]); w1[i] = cvtpk(a * d, bq * d); w2[i] = cvtpk(a * dd, bq * dd); }
            const int off = (ocg >> 2) * 4096 + img_off(orow) + (ocg & 3) * 16;
            *(SC_LAS u32x4*)(lds + L_XD + off) = w1; *(SC_LAS u32x4*)(lds + L_XW + off) = w2;
#pragma unroll
            for (int i = 0; i < 2; ++i) { const int p = tid + 512 * i, l = p >> 4, c16 = p & 15;
                *(SC_LAS u32x4*)(lds + L_B + (c16 >> 2) * 4096 + img_off(l) + (c16 & 3) * 16) = br[i];
                *(SC_LAS u32x4*)(lds + L_C + l * 256 + ((c16 ^ (l & 15)) << 4)) = cr[i]; }
        }
        const u32x4 xcur = xr, zcur = zr;
        if (c + 1 < SEQ / CH) SC_LOAD(t0 + CH, xr, zr);
        SC_BAR();
        f32x16 yacc;
#pragma unroll
        for (int r = 0; r < 16; ++r) yacc[r] = 0.f;
        const int yli = (wid >> 1) & 1, ypi = wid & 1;
        if (wid < 3) {
            const int si = (wid == 2) ? 1 : 0, li = (wid == 0) ? 0 : 1;
            const int srow = 32 * si + r32, lrow = 32 * li + r32;
            f32x16 cb;
#pragma unroll
            for (int r = 0; r < 16; ++r) cb[r] = 0.f;
#pragma unroll
            for (int ks = 0; ks < 8; ++ks) {
                const int chk = 2 * ks + hi;
                const bf16x8 a = *(const SC_LAS bf16x8*)(lds + L_B + (chk >> 2) * 4096 + img_off(srow) + (chk & 3) * 16);
                const bf16x8 bb = *(const SC_LAS bf16x8*)(lds + L_C + lrow * 256 + ((chk ^ (lrow & 15)) << 4));
                cb = __builtin_amdgcn_mfma_f32_32x32x16_bf16(a, bb, cb, 0, 0, 0);
            }
            const float al = s_acs[lrow];
#pragma unroll
            for (int q4 = 0; q4 < 4; ++q4) {
                const int s0 = 32 * si + 8 * q4 + 4 * hi;
                float gv[4];
#pragma unroll
                for (int e = 0; e < 4; ++e) { const int sidx = s0 + e; gv[e] = (sidx <= lrow) ? cb[4 * q4 + e] * __expf(al - s_acs[sidx]) : 0.f; }
                u32x2 w; w.x = cvtpk(gv[0], gv[1]); w.y = cvtpk(gv[2], gv[3]);
                *(SC_LAS u32x2*)(lds + L_G + lrow * 128 + (((s0 >> 3) ^ (lrow & 7)) << 4) + (s0 & 7) * 2) = w;
            }
        } else if (wid >= 4) {
            const int lrow = 32 * yli + r32, prow = 32 * ypi + r32;
#pragma unroll
            for (int ks = 0; ks < 8; ++ks) {
                const int chk = 2 * ks + hi;
                const bf16x8 a = *(const SC_LAS bf16x8*)(lds + L_C + lrow * 256 + ((chk ^ (lrow & 15)) << 4));
                const bf16x8 bb = *(const SC_LAS bf16x8*)(lds + L_H + prow * 256 + ((chk ^ (prow & 15)) << 4));
                yacc = __builtin_amdgcn_mfma_f32_32x32x16_bf16(a, bb, yacc, 0, 0, 0);
            }
        }
        SC_BAR();
        if (wid >= 4) {
#pragma unroll
            for (int r = 0; r < 16; ++r) yacc[r] *= s_ea[32 * yli + (r & 3) + 8 * (r >> 2) + 4 * hi];
            const int lrow = 32 * yli + r32;
            const int tbn = ((lane >> 4) & 1) * 32 + (lane & 3) * 8 + hi * 512 + ((lane & 15) >> 2) * 64;
#pragma unroll
            for (int ks = 0; ks < 4; ++ks) {
                if (ks < 2 * (yli + 1)) {
                    const int chk = 2 * ks + hi;
                    const bf16x8 a = *(const SC_LAS bf16x8*)(lds + L_G + lrow * 128 + ((chk ^ (lrow & 7)) << 4));
                    const s16x4 b0 = vtr(lds + L_XD + ypi * 4096 + ks * 1024 + tbn), b1 = vtr(lds + L_XD + ypi * 4096 + ks * 1024 + tbn + 256);
                    const bf16x8 bb = {b0[0], b0[1], b0[2], b0[3], b1[0], b1[1], b1[2], b1[3]};
                    yacc = __builtin_amdgcn_mfma_f32_32x32x16_bf16(a, bb, yacc, 0, 0, 0);
                }
            }
#pragma unroll
            for (int r = 0; r < 16; ++r) ((SC_LAS float*)(lds + L_Y))[(32 * yli + (r & 3) + 8 * (r >> 2) + 4 * hi) * 68 + 32 * ypi + r32] = yacc[r];
        } else {
            const float cd = __expf(s_acs[63]);
#pragma unroll
            for (int r = 0; r < 16; ++r) { hacc0[r] *= cd; hacc1[r] *= cd; }
            const int tb = ((lane >> 4) & 1) * 32 + (lane & 3) * 8 + (4 * hi + ((lane & 15) >> 2)) * 64;
#pragma unroll
            for (int ks = 0; ks < 4; ++ks) {
                const s16x4 a0 = vtr(lds + L_B + wid * 4096 + ks * 1024 + tb), a1 = vtr(lds + L_B + wid * 4096 + ks * 1024 + 512 + tb);
                const s16x4 b0 = vtr(lds + L_XW + ks * 1024 + tb), b1 = vtr(lds + L_XW + ks * 1024 + 512 + tb);
                const s16x4 c0 = vtr(lds + L_XW + 4096 + ks * 1024 + tb), c1 = vtr(lds + L_XW + 4096 + ks * 1024 + 512 + tb);
                const bf16x8 a = {a0[0], a0[1], a0[2], a0[3], a1[0], a1[1], a1[2], a1[3]};
                const bf16x8 bb = {b0[0], b0[1], b0[2], b0[3], b1[0], b1[1], b1[2], b1[3]};
                const bf16x8 cc = {c0[0], c0[1], c0[2], c0[3], c1[0], c1[1], c1[2], c1[3]};
                hacc0 = __builtin_amdgcn_mfma_f32_32x32x16_bf16(a, bb, hacc0, 0, 0, 0);
                hacc1 = __builtin_amdgcn_mfma_f32_32x32x16_bf16(a, cc, hacc1, 0, 0, 0);
            }
#pragma unroll
            for (int q4 = 0; q4 < 4; ++q4) {
                const int n0 = 32 * wid + 8 * q4 + 4 * hi;
                u32x2 w0, w1; w0.x = cvtpk(hacc0[4 * q4 + 0], hacc0[4 * q4 + 1]); w0.y = cvtpk(hacc0[4 * q4 + 2], hacc0[4 * q4 + 3]);
                w1.x = cvtpk(hacc1[4 * q4 + 0], hacc1[4 * q4 + 1]); w1.y = cvtpk(hacc1[4 * q4 + 2], hacc1[4 * q4 + 3]);
                *(SC_LAS u32x2*)(lds + L_H + r32 * 256 + (((n0 >> 3) ^ (r32 & 15)) << 4) + (n0 & 7) * 2) = w0;
                *(SC_LAS u32x2*)(lds + L_H + (32 + r32) * 256 + (((n0 >> 3) ^ (r32 & 15)) << 4) + (n0 & 7) * 2) = w1;
            }
        }
        SC_BAR();
        {
            const SC_LAS float* yr = (const SC_LAS float*)(lds + L_Y) + orow * 68 + ocg * 8;
            const f32x4 y0 = *(const SC_LAS f32x4*)yr, y1 = *(const SC_LAS f32x4*)(yr + 4);
            float yv[8];
#pragma unroll
            for (int i = 0; i < 4; ++i) {
                const float ya = (i < 2) ? y0[2 * i] : y1[2 * i - 4], yb = (i < 2) ? y0[2 * i + 1] : y1[2 * i - 3];
                yv[2 * i] = (ya + dsk * lo16(xcur[i])) * lo16(zcur[i]); yv[2 * i + 1] = (yb + dsk * hi16(xcur[i])) * hi16(zcur[i]);
            }
            float ss = 0.f;
#pragma unroll
            for (int i = 0; i < 8; ++i) ss += yv[i] * yv[i];
            ss += __shfl_xor(ss, 1); ss += __shfl_xor(ss, 2); ss += __shfl_xor(ss, 4);
            if (ocg == 0) P.ssqp[(rowb + t0 + orow) * 32 + h] = ss;
            u32x4 w; w.x = cvtpk(yv[0], yv[1]); w.y = cvtpk(yv[2], yv[3]); w.z = cvtpk(yv[4], yv[5]); w.w = cvtpk(yv[6], yv[7]);
            if (!P.dry) *(u32x4*)(P.zp + (rowb + t0 + orow) * 2048 + h * 64 + ocg * 8) = w;
        }
    }
    __syncthreads();
#undef SC_LOAD
}
}
namespace mk {
#define GAS __attribute__((address_space(1)))
#define LAS __attribute__((address_space(3)))
typedef unsigned short bf16;
typedef unsigned v4u __attribute__((ext_vector_type(4)));
typedef float f32x4 __attribute__((ext_vector_type(4)));
typedef GAS unsigned gu32;
#define RLX_AGENT __ATOMIC_RELAXED, __HIP_MEMORY_SCOPE_AGENT
constexpr int NWAVES = 8;
constexpr int M = 16384, D = 1024, SEQ = 2048, NB = 8;
constexpr int SSD_NP = 5376, SSD_IN = 5152, SSD_DI = 2048, SSD_LD = 5120;
constexpr int AT_IN = 3072, DFF = 2816;
constexpr size_t MiB = 1u << 20;
constexpr size_t WS_CTL = 0, CTL_ZERO_BYTES = 64 * 1024;
constexpr size_t WS_CONST = 64 * 1024;
constexpr size_t WS_SSQ = 1 * MiB;
constexpr size_t WS_ROPE = 2 * MiB;
constexpr size_t WS_DT = 3 * MiB;
constexpr size_t WS_SSQP = 5 * MiB;
constexpr size_t WS_CP = 1 * MiB + 512 * 1024;
constexpr size_t WS_W = 7 * MiB;
constexpr size_t W_SSD_IN = 0, W_SSD_IN_SZ = (size_t)SSD_NP * D * 2;
constexpr size_t W_SSD_OUT = W_SSD_IN + 2 * W_SSD_IN_SZ, W_SSD_OUT_SZ = (size_t)D * SSD_DI * 2;
constexpr size_t W_AT_IN = W_SSD_OUT + 2 * W_SSD_OUT_SZ, W_AT_IN_SZ = (size_t)AT_IN * D * 2;
constexpr size_t W_AT_OUT = W_AT_IN + 2 * W_AT_IN_SZ, W_AT_OUT_SZ = (size_t)D * D * 2;
constexpr size_t W_UP = W_AT_OUT + 2 * W_AT_OUT_SZ, W_UP_SZ = (size_t)2 * DFF * D * 2;
constexpr size_t W_DOWN = W_UP + 4 * W_UP_SZ, W_DOWN_SZ = (size_t)D * DFF * 2;
constexpr size_t W_TOTAL = W_DOWN + 4 * W_DOWN_SZ;
constexpr size_t WS_XB = ((WS_W + W_TOTAL + MiB - 1) / MiB) * MiB;
constexpr size_t XB_PAD_FRONT = 4 * D * 2, XB_BYTES = (size_t)(M + 260) * D * 2;
constexpr size_t WS_BIG = ((WS_XB + XB_BYTES + MiB - 1) / MiB) * MiB;
constexpr size_t BIG_BYTES = (size_t)M * SSD_LD * 2;
constexpr size_t WS_DBG = WS_BIG + BIG_BYTES;
constexpr size_t WS_END = WS_DBG;
static_assert(WS_END <= 352 * MiB, "workspace map exceeds the guaranteed 352 MiB");
constexpr int CW_BAR = 1024;
constexpr int RING_BYTES = 131072, EPI_OFF = RING_BYTES, EPI_BYTES = 26624, MISC_OFF = EPI_OFF + EPI_BYTES;
constexpr int LDS_BYTES = 158720;
static_assert(MISC_OFF + 1024 <= LDS_BYTES && attn::LDS_BYTES <= RING_BYTES && scan::LDS_BYTES <= RING_BYTES, "LDS map");

#define LDS_WAIT() asm volatile("s_waitcnt lgkmcnt(0)" ::: "memory")
__device__ __forceinline__ unsigned f2bf(float f) { unsigned u = __builtin_bit_cast(unsigned, f); return (u + 0x7fffu + ((u >> 16) & 1u)) >> 16; }
__device__ __forceinline__ unsigned pk2(float lo, float hi) { return f2bf(lo) | (f2bf(hi) << 16); }

#define XB_TMO      128
#define XB_XCNT(j)  (256  + 64 * (j))
#define XB_XSUB(j)  (1280 + 64 * (j))
#define XB_XGEN(j)  (2304 + 64 * (j))
#define XB_TOP      3328
#define XB_TOPGEN   3392
#define XCD_BAR_WORDS 3456
#define XB_SPIN_CAP (1u << 20)
__device__ __forceinline__ unsigned xb_ld(unsigned* p)              { return __hip_atomic_load(p, __ATOMIC_RELAXED, __HIP_MEMORY_SCOPE_AGENT); }
__device__ __forceinline__ unsigned xb_add(unsigned* p, unsigned v) { return __hip_atomic_fetch_add(p, v, __ATOMIC_RELAXED, __HIP_MEMORY_SCOPE_AGENT); }
__device__ __forceinline__ unsigned xb_xcc_id() { return (unsigned)__builtin_amdgcn_s_getreg((3 << 11) | 20) & 0xFu; }
#define XB_SPIN(cond, bar) do { unsigned _sp = 0; while (cond) { __builtin_amdgcn_s_sleep(1); \
    if ((++_sp & 255u) == 0u) { if (xb_ld(&(bar)[XB_TMO])) break; if (_sp > XB_SPIN_CAP) { atomicAdd(&(bar)[XB_TMO], 1u); break; } } } } while (0)
struct XcdBarrier { unsigned* bar; unsigned x; volatile LAS unsigned* st; };
__device__ __forceinline__ XcdBarrier xcd_barrier_post(unsigned* bar, volatile LAS unsigned* st) {
    XcdBarrier b; b.bar = bar; b.x = xb_xcc_id(); b.st = st;
    if (threadIdx.x == 0) (void)xb_add(&bar[XB_XCNT(b.x)], 1u);
    return b;
}
__device__ __forceinline__ void xcd_barrier_complete(unsigned* bar, unsigned x, unsigned& nloc, unsigned& nx) {
    const unsigned G = gridDim.x * gridDim.y * gridDim.z;
    unsigned sum, cnt, mine, sp = 0u;
    for (;;) {
        sum = 0u; cnt = 0u; mine = 0u;
#pragma unroll
        for (unsigned j = 0; j < 16; ++j) { const unsigned c = xb_ld(&bar[XB_XCNT(j)]); sum += c; cnt += (c > 0u) ? 1u : 0u; mine = (j == x) ? c : mine; }
        if (sum == G) break;
        __builtin_amdgcn_s_sleep(1);
        if ((++sp & 255u) == 0u) { if (xb_ld(&bar[XB_TMO])) break; if (sp > XB_SPIN_CAP) { atomicAdd(&bar[XB_TMO], 1u); break; } }
    }
    nloc = mine > 0u ? mine : 1u; nx = cnt > 0u ? cnt : 1u;
}
__device__ __forceinline__ void xcd_barrier(const XcdBarrier& b) {
    asm volatile("s_waitcnt vmcnt(0)" ::: "memory");
    __syncthreads();
    if (threadIdx.x == 0) {
        unsigned* bar = b.bar; asm volatile("" : "+s"(bar));
        __builtin_amdgcn_s_waitcnt(0);
        unsigned nloc = b.st[0], nx = b.st[1];
        if (nloc == 0u) { xcd_barrier_complete(bar, b.x, nloc, nx); b.st[0] = nloc; b.st[1] = nx; }
        const unsigned old = xb_add(&bar[XB_XSUB(b.x)], 1u);
        const unsigned gen = old / nloc;
        if (old + 1u == (gen + 1u) * nloc) {
            __builtin_amdgcn_fence(__ATOMIC_RELEASE, "agent");
            asm volatile("s_waitcnt vmcnt(0)" ::: "memory");
            const unsigned og = xb_add(&bar[XB_TOP], 1u);
            const unsigned tg = og / nx;
            if (og + 1u == (tg + 1u) * nx) xb_add(&bar[XB_TOPGEN], 1u);
            else XB_SPIN(xb_ld(&bar[XB_TOPGEN]) == tg, bar);
            __builtin_amdgcn_fence(__ATOMIC_ACQUIRE, "agent");
            xb_add(&bar[XB_XGEN(b.x)], 1u);
            asm volatile("s_waitcnt vmcnt(0)" ::: "memory");
        } else {
            XB_SPIN(xb_ld(&bar[XB_XGEN(b.x)]) == gen, bar);
            __builtin_amdgcn_fence(__ATOMIC_ACQUIRE, "agent");
            asm volatile("s_waitcnt vmcnt(0)" ::: "memory");
        }
    }
    __syncthreads();
}

__device__ __forceinline__ unsigned long long ldarg(LAS unsigned long long* AP, int i) {
    asm volatile("" : "+s"(i));
    const unsigned long long v = AP[i];
    return ((unsigned long long)(unsigned)__builtin_amdgcn_readfirstlane((int)(v >> 32)) << 32) | (unsigned long long)(unsigned)__builtin_amdgcn_readfirstlane((int)v);
}
struct Args { const void* in[25]; float* out; unsigned char* ws; int ph_lo, ph_hi; int dbg, pad; };

__device__ __forceinline__ float wave_sum(float v) {
#pragma unroll
    for (int o = 1; o < 64; o <<= 1) v += __shfl_xor(v, o);
    return v;
}
template <class RowMap>
__device__ __forceinline__ void transpose_item(const float* W, int K, int N, const float* gain, int gmask, float gscale, bf16* WT, const RowMap& rm, LAS float* scr, int item, int lane) {
    const int nblk = N / 32, kb = item / nblk, nb = item % nblk, k0 = 64 * kb, n0 = 32 * nb;
    {
        const int rs = lane >> 3, c4 = lane & 7;
        f32x4 v[8]; float gv[8];
#pragma unroll
        for (int i = 0; i < 8; ++i) { const int kk = 8 * i + rs; v[i] = *(const f32x4*)(W + (size_t)(k0 + kk) * N + n0 + 4 * c4); gv[i] = gain ? gain[(k0 + kk) & gmask] * gscale : 1.0f; }
#pragma unroll
        for (int i = 0; i < 8; ++i) { const int kk = 8 * i + rs; LAS float* d = scr + kk * 33 + 4 * c4; d[0] = v[i][0] * gv[i]; d[1] = v[i][1] * gv[i]; d[2] = v[i][2] * gv[i]; d[3] = v[i][3] * gv[i]; }
    }
    LDS_WAIT(); asm volatile("" ::: "memory");
    const int c = lane & 7;
#pragma unroll
    for (int j = 0; j < 4; ++j) { const int n = (lane >> 3) + 8 * j; const LAS float* s = scr + (8 * c) * 33 + n;
        v4u o; o.x = pk2(s[0 * 33], s[1 * 33]); o.y = pk2(s[2 * 33], s[3 * 33]); o.z = pk2(s[4 * 33], s[5 * 33]); o.w = pk2(s[6 * 33], s[7 * 33]);
        *(GAS v4u*)(WT + (size_t)rm(n0 + n) * K + k0 + 8 * c) = o; }
    LDS_WAIT(); asm volatile("" ::: "memory");
}
struct RowId { __device__ __forceinline__ int operator()(int n) const { return n; } };
struct RowUp { __device__ __forceinline__ int operator()(int n) const { const int u = n >= DFF, ch = u ? n - DFF : n; return (ch >> 7) * 256 + u * 128 + (ch & 127); } };

__global__ void __launch_bounds__(NWAVES * 64, 2) mega_fwd(Args args) {
    extern __shared__ __attribute__((aligned(16))) unsigned char lds_raw[];
    LAS unsigned char* lds = (LAS unsigned char*)lds_raw;
    volatile LAS unsigned* MISC = (volatile LAS unsigned*)(lds + MISC_OFF);
    const int G = gridDim.x; const int bx = blockIdx.x; const int vcu = (G % 8 == 0) ? (bx % 8) * (G / 8) + bx / 8 : bx;
    gu32* ctl = (gu32*)(args.ws + WS_CTL);
    if (threadIdx.x < 64) MISC[threadIdx.x] = 0u;
    __syncthreads();
    XcdBarrier bar = xcd_barrier_post((unsigned*)ctl + CW_BAR, MISC + 8);
#define GRID_BAR() xcd_barrier(bar)
    LAS unsigned long long* AP = (LAS unsigned long long*)(lds + MISC_OFF + 256);
    if (threadIdx.x < 27) AP[threadIdx.x] = ((const unsigned long long*)&args)[threadIdx.x];
    __syncthreads();
#define ARGP(T, i) ((T)(GAS void*)ldarg(AP, i))
#define x_in   ARGP(const float*, 0)
#define pos    ARGP(const int*, 1)
#define nmg    ARGP(const float*, 2)
#define nfg    ARGP(const float*, 3)
#define s_inw  ARGP(const float*, 4)
#define s_cw   ARGP(const float*, 5)
#define s_cb   ARGP(const float*, 6)
#define s_dtb  ARGP(const float*, 7)
#define s_alog ARGP(const float*, 8)
#define s_d    ARGP(const float*, 9)
#define s_ng   ARGP(const float*, 10)
#define s_ow   ARGP(const float*, 11)
#define a_inw  ARGP(const float*, 12)
#define a_qg   ARGP(const float*, 13)
#define a_kg   ARGP(const float*, 14)
#define a_lq1  ARGP(const float*, 15)
#define a_lk1  ARGP(const float*, 16)
#define a_lq2  ARGP(const float*, 17)
#define a_lk2  ARGP(const float*, 18)
#define a_sg   ARGP(const float*, 19)
#define a_ow   ARGP(const float*, 20)
#define f_uw   ARGP(const float*, 21)
#define f_cw   ARGP(const float*, 22)
#define f_cb   ARGP(const float*, 23)
#define f_dw   ARGP(const float*, 24)
#define xout   ARGP(float*, 25)
#define ws     ARGP(unsigned char*, 26)
#define cst    ((float*)(ws + WS_CONST))
#define SSQ    ((float*)(ws + WS_SSQ))
#define ROPE   ((float*)(ws + WS_ROPE))
#define DT     ((float*)(ws + WS_DT))
#define SSQP   ((float*)(ws + WS_SSQP))
#define Wb     ((bf16*)(ws + WS_W))
#define XB     ((bf16*)(ws + WS_XB + XB_PAD_FRONT))
#define BIG    ((bf16*)(ws + WS_BIG))
#define CPT    ((float*)(ws + WS_CP))
#define ZPL    ((bf16*)(ws + WS_BIG))
#define XBCPL  ((bf16*)(ws + WS_BIG + (size_t)M * SSD_DI * 2))
    const int lo = args.ph_lo, hi = args.ph_hi;
    int phase = 0;
#define IN_PHASE() (phase >= lo && phase < hi)
#define END_PHASE(ty) do { if (IN_PHASE() && phase + 1 < hi) GRID_BAR(); ++phase; } while (0)
#ifndef PROBE_EPI_MODE
#define PROBE_EPI_MODE 0
#endif
#ifdef PROBE_DUP
#define REP_BEGIN(ty) _Pragma("unroll") for (int rep_ = ((ty) == PROBE_DUP ? 0 : 1); rep_ < 2; ++rep_) { const int dry = (rep_ == 0);
#define REP_END() if (dry) GRID_BAR(); }
#else
#define REP_BEGIN(ty) { const int dry = 0;
#define REP_END() }
#endif

    if (IN_PHASE()) { REP_BEGIN(0)
        int tid = threadIdx.x; asm volatile("" : "+v"(tid));
        const int lane = tid & 63, wave = __builtin_amdgcn_readfirstlane(tid >> 6);
        LAS float* scr = (LAS float*)(lds + wave * 16384);
        const int gw = vcu * NWAVES + wave, NGW = G * NWAVES;
        constexpr int I_SI = (D / 64) * (SSD_IN / 32), I_SO = (SSD_DI / 64) * (D / 32), I_AI = (D / 64) * (AT_IN / 32), I_AO = (D / 64) * (D / 32), I_UP = (D / 64) * (2 * DFF / 32), I_DN = (DFF / 64) * (D / 32);
        constexpr int NITEMS = 2 * I_SI + 2 * I_SO + 2 * I_AI + 2 * I_AO + 4 * I_UP + 4 * I_DN;
        for (int it = gw; it < NITEMS; it += NGW) {
            int r = it;
            if (r < 2 * I_SI) { const int j = r / I_SI; transpose_item(s_inw + (size_t)j * D * SSD_IN, D, SSD_IN, nmg + (2 * j) * D, 1023, 1.0f, (bf16*)((char*)Wb + W_SSD_IN + j * W_SSD_IN_SZ), RowId(), scr, r % I_SI, lane); continue; } r -= 2 * I_SI;
            if (r < 2 * I_SO) { const int j = r / I_SO; transpose_item(s_ow + (size_t)j * SSD_DI * D, SSD_DI, D, s_ng + j * SSD_DI, 2047, 1.0f, (bf16*)((char*)Wb + W_SSD_OUT + j * W_SSD_OUT_SZ), RowId(), scr, r % I_SO, lane); continue; } r -= 2 * I_SO;
            if (r < 2 * I_AI) { const int j = r / I_AI; transpose_item(a_inw + (size_t)j * D * AT_IN, D, AT_IN, nmg + (2 * j + 1) * D, 1023, 1.0f, (bf16*)((char*)Wb + W_AT_IN + j * W_AT_IN_SZ), RowId(), scr, r % I_AI, lane); continue; } r -= 2 * I_AI;
            if (r < 2 * I_AO) { const int j = r / I_AO; const float li = 0.8f - 0.6f * expf(-0.3f * (float)(2 * j + 1));
                transpose_item(a_ow + (size_t)j * D * D, D, D, a_sg + j * 128, 127, 1.0f - li, (bf16*)((char*)Wb + W_AT_OUT + j * W_AT_OUT_SZ), RowId(), scr, r % I_AO, lane); continue; } r -= 2 * I_AO;
            if (r < 4 * I_UP) { const int j = r / I_UP; transpose_item(f_uw + (size_t)j * D * 2 * DFF, D, 2 * DFF, nfg + j * D, 1023, 1.0f, (bf16*)((char*)Wb + W_UP + j * W_UP_SZ), RowUp(), scr, r % I_UP, lane); continue; } r -= 4 * I_UP;
            { const int j = r / I_DN; transpose_item(f_dw + (size_t)j * DFF * D, DFF, D, nullptr, 0, 1.0f, (bf16*)((char*)Wb + W_DOWN + j * W_DOWN_SZ), RowId(), scr, r % I_DN, lane); }
        }
        for (int j = 0; j < 2; ++j) { v4u* p = (v4u*)((char*)Wb + W_SSD_IN + j * W_SSD_IN_SZ + (size_t)SSD_IN * D * 2); const int n16 = (SSD_NP - SSD_IN) * D * 2 / 16;
            for (int i = vcu * 512 + tid; i < n16; i += G * 512) p[i] = (v4u){0u, 0u, 0u, 0u}; }
        { v4u* p = (v4u*)(ws + WS_XB); for (int i = vcu * 512 + tid; i < (int)(XB_PAD_FRONT / 16); i += G * 512) p[i] = (v4u){0u, 0u, 0u, 0u};
          v4u* q = (v4u*)((char*)XB + (size_t)M * D * 2); for (int i = vcu * 512 + tid; i < 256 * D * 2 / 16; i += G * 512) q[i] = (v4u){0u, 0u, 0u, 0u}; }
        for (int m = gw; m < M; m += NGW) {
            const f32x4* xr = (const f32x4*)(x_in + (size_t)m * D) + lane; float s = 0.f;
            unsigned long long* o8 = (unsigned long long*)(XB + (size_t)m * D) + lane;
#pragma unroll
            for (int j = 0; j < 4; ++j) { const f32x4 v = xr[64 * j]; s += (v[0] * v[0] + v[1] * v[1]) + (v[2] * v[2] + v[3] * v[3]); o8[64 * j] = (unsigned long long)pk2(v[0], v[1]) | ((unsigned long long)pk2(v[2], v[3]) << 32); }
            s = wave_sum(s);
            if (lane < 4) SSQ[(size_t)m * 4 + lane] = (lane == 0) ? s : 0.f;
            if (lane >= 16 && lane < 32) { const int i = lane & 7; const float invf = powf(500000.0f, -(float)(2 * i) / 16.0f); const float ang = (float)pos[m] * invf; ROPE[(size_t)m * 16 + (lane - 16)] = (lane < 24) ? cosf(ang) : sinf(ang); }
        }
        for (int i = vcu * 512 + tid; i < 2 * SSD_NP; i += G * 512) {
            const int j = i / SSD_NP, c = i % SSD_NP; float pb = 0.f, p0 = 0.f, p1 = 0.f, p2 = 0.f, p3 = 0.f;
            if (c < 2048) p3 = 1.f;
            else if (c < 5120) { const int ch = c - 2048; const float* w = s_cw + (size_t)j * 4 * 3072; pb = s_cb[(size_t)j * 3072 + ch]; p0 = w[ch]; p1 = w[3072 + ch]; p2 = w[2 * 3072 + ch]; p3 = w[3 * 3072 + ch]; }
            else if (c < 5152) { pb = s_dtb[j * 32 + (c - 5120)]; p3 = 1.f; }
            float* t = CPT + (size_t)j * 5 * SSD_NP; t[c] = pb; t[SSD_NP + c] = p0; t[2 * SSD_NP + c] = p1; t[3 * SSD_NP + c] = p2; t[4 * SSD_NP + c] = p3;
        }
        if (bx == 0 && wave == 0) {
            for (int j = 0; j < 2; ++j) {
                float mq = fabsf(a_qg[j * 64 + lane]), mkk = fabsf(a_kg[j * 64 + lane]);
                float d1 = a_lq1[j * 64 + lane] * a_lk1[j * 64 + lane], d2 = a_lq2[j * 64 + lane] * a_lk2[j * 64 + lane];
#pragma unroll
                for (int o = 1; o < 64; o <<= 1) { mq = fmaxf(mq, __shfl_xor(mq, o)); mkk = fmaxf(mkk, __shfl_xor(mkk, o)); d1 += __shfl_xor(d1, o); d2 += __shfl_xor(d2, o); }
                const float li = 0.8f - 0.6f * expf(-0.3f * (float)(2 * j + 1));
                if (lane == 0) { cst[j] = mq * mkk * 64.0f * 0.125f * 1.4426950408889634f * 1.002f + 0.01f; cst[2 + j] = expf(d1) - expf(d2) + li; }
            }
        }
    REP_END() }
    END_PHASE(0);

    for (int layer = 0; layer < 4; ++layer) {
        const int j = layer >> 1;
        const float* xsrc = (layer == 0) ? x_in : xout;
        if ((layer & 1) == 0) {
            if (IN_PHASE()) { REP_BEGIN(1)
                pg8::Gemm g{XB, (const bf16*)((const char*)Wb + W_SSD_IN + j * W_SSD_IN_SZ), D, D, 253, -3};
                pg8::StaticOrder S; S.init(65, SSD_NP / 256, G, bx);
                epi::EpiSsdConv E{ZPL, XBCPL, DT, SSQ, CPT + (size_t)j * 5 * SSD_NP};
                pg8::gemm_phase(lds, lds + EPI_OFF, g, S, E);
            REP_END() }
            END_PHASE(1);
            if (IN_PHASE()) { REP_BEGIN(2)
                scan::Params sp{XBCPL, ZPL, DT, s_alog + j * 32, s_d + j * 32, SSQP, dry};
                for (int u = vcu; u < NB * 32; u += G) scan::unit(sp, u >> 5, u & 31, (LAS char*)lds);
            REP_END() }
            END_PHASE(2);
            if (IN_PHASE()) { REP_BEGIN(3)
                int tid = threadIdx.x; asm volatile("" : "+v"(tid));
                const int nitems = M * 256;
                for (int i = (vcu * 512 + tid); i < nitems; i += G * 512) {
                    const int row = i >> 8, c16 = i & 255, grp = c16 >> 6;
                    const f32x4* sp4 = (const f32x4*)(SSQP + (size_t)row * 32 + grp * 8);
                    const f32x4 a = sp4[0], b = sp4[1];
                    const float s = ((a[0] + a[1]) + (a[2] + a[3])) + ((b[0] + b[1]) + (b[2] + b[3]));
                    const float rs = 1.0f / sqrtf(s * (1.0f / 512.0f) + 1e-6f);
                    v4u* p = (v4u*)(ZPL + (size_t)row * SSD_DI + c16 * 8);
                    v4u v = *p;
#pragma unroll
                    for (int e = 0; e < 4; ++e) { const float lo_ = __builtin_bit_cast(float, v[e] << 16) * rs, hi_ = __builtin_bit_cast(float, v[e] & 0xffff0000u) * rs; v[e] = pk2(lo_, hi_); }
                    if (!dry) *p = v;
                }
            REP_END() }
            END_PHASE(3);
            if (IN_PHASE()) { REP_BEGIN(4)
                pg8::Gemm g{ZPL, (const bf16*)((const char*)Wb + W_SSD_OUT + j * W_SSD_OUT_SZ), SSD_DI, SSD_DI, 256, 0};
                pg8::StaticOrder S; S.init(M / 256, D / 256, G, bx);
                epi::EpiResidual E{xsrc, xout, XB, SSQ, dry};
                pg8::gemm_phase(lds, lds + EPI_OFF, g, S, E);
            REP_END() }
            END_PHASE(4);
        } else {
            if (IN_PHASE()) { REP_BEGIN(5)
                pg8::Gemm g{XB, (const bf16*)((const char*)Wb + W_AT_IN + j * W_AT_IN_SZ), D, D, 256, 0};
                pg8::StaticOrder S; S.init(M / 256, AT_IN / 256, G, bx);
                epi::EpiQKV E{BIG, SSQ, a_qg + j * 64, a_kg + j * 64, ROPE};
                pg8::gemm_phase(lds, lds + EPI_OFF, g, S, E);
            REP_END() }
            END_PHASE(5);
            if (IN_PHASE()) { REP_BEGIN(6)
                attn::Params ap{BIG, cst[j], cst[2 + j], dry};
                for (int pi = vcu; pi < 512; pi += G) {
                    const int bh = pi >> 3, s = pi & 7;
                    attn::unit(ap, bh >> 3, bh & 7, s, (LAS char*)lds);
                    attn::unit(ap, bh >> 3, bh & 7, 15 - s, (LAS char*)lds);
                }
            REP_END() }
            END_PHASE(6);
            if (IN_PHASE()) { REP_BEGIN(7)
                pg8::Gemm g{BIG, (const bf16*)((const char*)Wb + W_AT_OUT + j * W_AT_OUT_SZ), AT_IN, D, 256, 0};
                pg8::StaticOrder S; S.init(M / 256, D / 256, G, bx);
                epi::EpiResidual E{xsrc, xout, XB, SSQ, dry};
                pg8::gemm_phase(lds, lds + EPI_OFF, g, S, E);
            REP_END() }
            END_PHASE(7);
        }
        if (IN_PHASE()) { REP_BEGIN(8)
            pg8::Gemm g{XB, (const bf16*)((const char*)Wb + W_UP + layer * W_UP_SZ), D, D, 254, -2};
            pg8::StaticOrder S; S.init(65, 2 * DFF / 256, G, bx);
            epi::EpiConvGate E{BIG, SSQ, f_cw + (size_t)layer * 3 * 2 * DFF, f_cb + (size_t)layer * 2 * DFF, dry * PROBE_EPI_MODE};
            pg8::gemm_phase(lds, lds + EPI_OFF, g, S, E);
        REP_END() }
        END_PHASE(8);
        if (IN_PHASE()) { REP_BEGIN(9)
            pg8::Gemm g{BIG, (const bf16*)((const char*)Wb + W_DOWN + layer * W_DOWN_SZ), DFF, DFF, 256, 0};
            pg8::StaticOrder S; S.init(M / 256, D / 256, G, bx);
            epi::EpiResidual E{xout, xout, XB, SSQ, dry};
            pg8::gemm_phase(lds, lds + EPI_OFF, g, S, E);
        REP_END() }
        END_PHASE(9);
    }
}
#undef x_in
#undef pos
#undef nmg
#undef nfg
#undef s_inw
#undef s_cw
#undef s_cb
#undef s_dtb
#undef s_alog
#undef s_d
#undef s_ng
#undef s_ow
#undef a_inw
#undef a_qg
#undef a_kg
#undef a_lq1
#undef a_lk1
#undef a_lq2
#undef a_lk2
#undef a_sg
#undef a_ow
#undef f_uw
#undef f_cw
#undef f_cb
#undef f_dw
#undef xout
#undef ws
#undef cst
#undef SSQ
#undef ROPE
#undef DT
#undef SSQP
#undef Wb
#undef XB
#undef BIG
#undef CPT
#undef ZPL
#undef XBCPL
#undef ARGP
constexpr int N_PHASES = 1 + 2 * 6 + 2 * 5;

static int g_grid = 0;
static void launch(void* const* d_in, float* d_out, void* d_ws, int ph_lo, int ph_hi, hipStream_t stream) {
    if (g_grid == 0) {
        int dev = 0, cus = 0;
        if (hipGetDevice(&dev) != hipSuccess || hipDeviceGetAttribute(&cus, hipDeviceAttributeMultiprocessorCount, dev) != hipSuccess) { fprintf(stderr, "device query failed\n"); g_grid = -1; return; }
        if (hipFuncSetAttribute((const void*)mega_fwd, hipFuncAttributeMaxDynamicSharedMemorySize, LDS_BYTES) != hipSuccess) { fprintf(stderr, "hipFuncSetAttribute failed\n"); g_grid = -1; return; }
        int per_cu = 0;
        (void)hipOccupancyMaxActiveBlocksPerMultiprocessor(&per_cu, (const void*)mega_fwd, NWAVES * 64, LDS_BYTES);
        (void)hipGetLastError();
        g_grid = cus;
        fprintf(stderr, "mega_fwd: %d CUs, occupancy query %d per CU\n", cus, per_cu);
    }
    if (g_grid < 0) return;
    (void)hipMemsetAsync((char*)d_ws + WS_CTL, 0, CTL_ZERO_BYTES, stream);
    Args a{};
    for (int i = 0; i < 25; ++i) a.in[i] = d_in[i];
    a.out = d_out; a.ws = (unsigned char*)d_ws; a.ph_lo = ph_lo; a.ph_hi = ph_hi;
    void* params[] = {&a};
    hipError_t e = hipLaunchCooperativeKernel((const void*)mega_fwd, dim3(g_grid), dim3(NWAVES * 64), params, LDS_BYTES, stream);
    if (e != hipSuccess) fprintf(stderr, "cooperative launch failed: %s (grid %d)\n", hipGetErrorString(e), g_grid);
}
}
extern "C" void kernel_launch(void* const* d_in, const int* in_sizes, int n_in, void* d_out, int out_size, void* d_ws, size_t ws_size, hipStream_t stream) {
    (void)in_sizes; (void)n_in; (void)out_size; (void)ws_size;
    mk::launch(d_in, (float*)d_out, d_ws, 0, mk::N_PHASES, stream);
}
```

```cpp
#include <hip/hip_runtime.h>
#include <stdint.h>
#include <math.h>
#include <cstdio>
namespace pg8 {
#define PG8_LAS __attribute__((address_space(3)))
typedef unsigned short bf16_t;
typedef short bf16x8 __attribute__((ext_vector_type(8)));
typedef float f32x4 __attribute__((ext_vector_type(4)));
typedef unsigned u32x4 __attribute__((ext_vector_type(4)));
typedef unsigned u32x2 __attribute__((ext_vector_type(2)));
constexpr int BM = 256, BK = 64, HALF = 128, HTB = HALF * BK * 2  , STAGE_BYTES = 8 * HTB, NXCD = 8, WGM = 8;

__host__ __device__ __forceinline__ int lds_byte(int r, int c) { const int st = (r >> 4) * 2 + (c >> 5), rr = r & 15, cc = c & 31, ob = rr * 64 + cc * 2; return st * 1024 + (ob ^ (((ob >> 9) & 1) << 5)); }
__host__ __device__ __forceinline__ void stage_rc(int b, int& R, int& C) { const int st = b / 1024, sb = b % 1024, swz = sb ^ (((sb >> 9) & 1) << 5); R = (st >> 1) * 16 + swz / 64; C = (st & 1) * 32 + (swz % 64) / 2; }
__host__ __device__ __forceinline__ int perm32(int rho) { const int n = rho >> 4, i = rho & 15; return 8 * (i >> 2) + 4 * n + (i & 3); }

struct Unit { int pm, pn; };
struct Gemm { const bf16_t* A; const bf16_t* Bt; int lda, K, a_stride, a_off; };

struct StaticOrder {
    int nM, nN, nwg, G, c;
    __host__ __device__ void init(int nM_, int nN_, int G_, int c_) { nM = nM_; nN = nN_; nwg = nM * nN; G = G_; c = c_; }
    __host__ __device__ bool next(int i, Unit& u) const {
        const long L = (long)i * G + c; if (L >= nwg) return false;
        int wgid = (int)L; { const int q = nwg / NXCD, r = nwg % NXCD, xcd = wgid % NXCD, off = wgid / NXCD; wgid = (xcd < r ? xcd * (q + 1) : r * (q + 1) + (xcd - r) * q) + off; }
        const int nig = WGM * nN, gid = wgid / nig, fm = gid * WGM, gsz = (nM - fm) < WGM ? (nM - fm) : WGM;
        u.pm = fm + ((wgid % nig) % gsz); u.pn = (wgid % nig) / gsz; return true;
    }
};

__device__ __forceinline__ unsigned cvt_pk_bf16(float lo, float hi) { unsigned r; asm volatile("v_cvt_pk_bf16_f32 %0, %1, %2" : "=v"(r) : "v"(lo), "v"(hi)); return r; }

template <class Epi, class Sched>
__device__ __forceinline__ void gemm_phase(PG8_LAS unsigned char* lds, PG8_LAS unsigned char* elds, const Gemm g, const Sched& S, const Epi& E) {
    int tid = threadIdx.x; asm volatile("" : "+v"(tid));
    const int wid = __builtin_amdgcn_readfirstlane(tid >> 6), lane = tid & 63, wr = wid >> 2, wc = wid & 3, fr = lane & 15, fq = lane >> 4;
    const int K = g.K, nt = K / BK, lda = g.lda;
    unsigned voffA[2], voffB[2]; int aoff, boff;
#define PG8_LANECONST() do { int t_ = threadIdx.x; asm volatile("" : "+v"(t_)); const int fr_ = t_ & 15, fq_ = (t_ >> 4) & 3; \
        _Pragma("unroll") for (int i = 0; i < 2; ++i) { int R, C; stage_rc(t_ * 16 + i * 8192, R, C); const int Rb = Epi::PERM ? ((R & ~31) + perm32(R & 31)) : R; \
            const int Ra = Epi::ROWIL ? ((R & ~63) | ((R & 15) << 2) | ((R >> 4) & 3)) : R;     \
            voffA[i] = (unsigned)(Ra * lda + C) * 2u; voffB[i] = (unsigned)(Rb * K + C) * 2u; } \
        aoff = lds_byte(wr * 64 + fr_, fq_ * 8); boff = lds_byte(wc * 32 + fr_, fq_ * 8); } while (0)
    PG8_LANECONST();
    const size_t kstep = (size_t)(BK * 2);
    const size_t hstepA = (size_t)HALF * lda * 2, hstepB = (size_t)HALF * K * 2;
    const size_t tstepB = 2 * hstepB;
    const unsigned ldsw = (unsigned)wid * 1024u;
#define PG8_SA(b, h) (((b) * 2 + (h)) * HTB)
#define PG8_SB(b, h) ((4 + (b) * 2 + (h)) * HTB)
#define PG8_STAGE(bufoff, gbase, voff) do { _Pragma("unroll") for (int _i = 0; _i < 2; ++_i) \
        __builtin_amdgcn_global_load_lds((const unsigned*)((const char*)(gbase) + (voff)[_i]), (PG8_LAS unsigned*)(lds + (bufoff) + ldsw + _i * 8192), 16, 0, 0); } while (0)
#define PG8_LDA(dst, b, h) do { _Pragma("unroll") for (int m = 0; m < 4; ++m) _Pragma("unroll") for (int k = 0; k < 2; ++k) dst[m][k] = *(const PG8_LAS bf16x8*)(lds + PG8_SA(b, h) + aoff + m * 2048 + k * 1024); } while (0)
#define PG8_LDB(dst, b, h) do { _Pragma("unroll") for (int n = 0; n < 2; ++n) _Pragma("unroll") for (int k = 0; k < 2; ++k) dst[n][k] = *(const PG8_LAS bf16x8*)(lds + PG8_SB(b, h) + boff + n * 2048 + k * 1024); } while (0)
#define PG8_MMA(ai, bj, At, Bt) do { __builtin_amdgcn_s_setprio(1); _Pragma("unroll") for (int m = 0; m < 4; ++m) _Pragma("unroll") for (int n = 0; n < 2; ++n) _Pragma("unroll") for (int k = 0; k < 2; ++k) \
        acc[ai][bj][m][n] = __builtin_amdgcn_mfma_f32_16x16x32_bf16(Bt[n][k], At[m][k], acc[ai][bj][m][n], 0, 0, 0); __builtin_amdgcn_s_setprio(0); } while (0)
#define PG8_WAIT_V(n) asm volatile("s_waitcnt vmcnt(" #n ")" ::: "memory")
#define PG8_WAIT_L(n) asm volatile("s_waitcnt lgkmcnt(" #n ")" ::: "memory")
#define PG8_BAR __builtin_amdgcn_s_barrier()
#define PG8_SCHED __builtin_amdgcn_sched_barrier(0)
    Unit cur, nxt; int ui = 0;
    if (!S.next(0, cur)) return;
    if constexpr (Epi::KGROUP) E.unit_begin(cur, elds);
    float zf = 0.f; asm volatile("" : "+v"(zf));
    f32x4 acc[2][2][4][2];
#pragma unroll
    for (int a = 0; a < 2; ++a)
#pragma unroll
        for (int b = 0; b < 2; ++b)
#pragma unroll
            for (int m = 0; m < 4; ++m)
#pragma unroll
                for (int n = 0; n < 2; ++n) acc[a][b][m][n] = (f32x4){zf, zf, zf, zf};
    bf16x8 At[4][2], B0[2][2], B1[2][2];
    const char* cA = (const char*)g.A + ((long)cur.pm * g.a_stride + g.a_off) * (long)lda * 2; const char* cB = (const char*)g.Bt + (size_t)cur.pn * tstepB;
    PG8_STAGE(PG8_SB(0, 0), cB, voffB); PG8_STAGE(PG8_SB(0, 1), cB + hstepB, voffB); PG8_STAGE(PG8_SA(0, 0), cA, voffA); PG8_STAGE(PG8_SA(0, 1), cA + hstepA, voffA);
    if (wr == 1) PG8_BAR;
    PG8_WAIT_V(2); PG8_BAR;
    PG8_STAGE(PG8_SB(1, 0), cB + kstep, voffB); PG8_STAGE(PG8_SA(1, 0), cA + kstep, voffA); PG8_STAGE(PG8_SB(1, 1), cB + hstepB + kstep, voffB);
    PG8_WAIT_V(6); PG8_BAR;
    for (;;) {
        const bool has_next = S.next(ui + 1, nxt);
        const char* nA = has_next ? (const char*)g.A + ((long)nxt.pm * g.a_stride + g.a_off) * (long)lda * 2 : cA; const char* nB = has_next ? (const char*)g.Bt + (size_t)nxt.pn * tstepB : cB;
        for (int t = 0; t < nt; t += 2) {
            const bool last = (t == nt - 2);
            const char* a1 = cA + (size_t)(t + 1) * kstep;
            const char* a2 = last ? nA : cA + (size_t)(t + 2) * kstep; const char* b2 = last ? nB : cB + (size_t)(t + 2) * kstep;
            const char* a3 = a2 + kstep; const char* b3 = b2 + kstep;
            if constexpr (Epi::KGROUP) { if (t > 0 && (t & 7) == 0) E.kgroup(acc, t >> 3, wr, elds); }
            PG8_LDB(B0, 0, 0); PG8_LDB(B1, 0, 1); PG8_SCHED; PG8_LDA(At, 0, 0); PG8_STAGE(PG8_SA(1, 1), a1 + hstepA, voffA);
            PG8_WAIT_V(8); PG8_WAIT_L(0); PG8_BAR; PG8_MMA(0, 0, At, B0); PG8_MMA(0, 1, At, B1); PG8_BAR; PG8_SCHED;
            PG8_LDA(At, 0, 1); PG8_STAGE(PG8_SB(0, 0), b2, voffB); PG8_STAGE(PG8_SB(0, 1), b2 + hstepB, voffB); PG8_STAGE(PG8_SA(0, 0), a2, voffA);
            PG8_WAIT_V(8); PG8_WAIT_L(0); PG8_BAR; PG8_MMA(1, 0, At, B0); PG8_MMA(1, 1, At, B1); PG8_BAR; PG8_SCHED;
            PG8_LDB(B0, 1, 0); PG8_LDB(B1, 1, 1); PG8_SCHED; PG8_LDA(At, 1, 0); PG8_STAGE(PG8_SA(0, 1), a2 + hstepA, voffA);
            PG8_WAIT_V(8); PG8_WAIT_L(0); PG8_BAR; PG8_MMA(0, 0, At, B0); PG8_MMA(0, 1, At, B1); PG8_BAR; PG8_SCHED;
            PG8_LDA(At, 1, 1); PG8_STAGE(PG8_SB(1, 0), b3, voffB); PG8_STAGE(PG8_SB(1, 1), b3 + hstepB, voffB); PG8_STAGE(PG8_SA(1, 0), a3, voffA);
            PG8_WAIT_V(8); PG8_WAIT_L(0); PG8_BAR; PG8_MMA(1, 0, At, B0); PG8_MMA(1, 1, At, B1); PG8_BAR; PG8_SCHED;
        }
        if (wr == 0) PG8_BAR;
        E(acc, cur, wr, wc, elds);
        if (!has_next) break;
#pragma unroll
        for (int a = 0; a < 2; ++a)
#pragma unroll
            for (int b = 0; b < 2; ++b)
#pragma unroll
                for (int m = 0; m < 4; ++m)
#pragma unroll
                    for (int n = 0; n < 2; ++n) acc[a][b][m][n] = (f32x4){zf, zf, zf, zf};
        cur = nxt; cA = nA; cB = nB; ++ui;
        if constexpr (Epi::KGROUP) E.unit_begin(cur, elds);
        PG8_LANECONST();
        if (wr == 1) PG8_BAR;
    }
    PG8_WAIT_V(0);
    PG8_BAR;
#undef PG8_LANECONST
#undef PG8_SA
#undef PG8_SB
#undef PG8_STAGE
#undef PG8_LDA
#undef PG8_LDB
#undef PG8_MMA
}
}
namespace epi {
using pg8::f32x4; using pg8::u32x4; using pg8::u32x2; using pg8::bf16_t; using pg8::Unit; using pg8::cvt_pk_bf16;
constexpr int MROWS = 16384, DMODEL = 1024;
constexpr float EPS = 1e-6f;
#define EPI_LAS __attribute__((address_space(3)))

__device__ __forceinline__ float row_rstd(const float* ssq, int row) {
    const f32x4 a = *(const f32x4*)(ssq + (size_t)row * 4);
    const float s = (a[0] + a[1]) + (a[2] + a[3]);
    return 1.0f / sqrtf(s * (1.0f / DMODEL) + EPS);
}
template <int MSTEP> __device__ __forceinline__ void rstd8(const float* ssq, int row0, bool clamp, float (&rs)[2][4]) {
    f32x4 p[2][4];
#pragma unroll
    for (int ai = 0; ai < 2; ++ai)
#pragma unroll
        for (int m = 0; m < 4; ++m) { int row = row0 + ai * 128 + m * MSTEP; if (clamp) row = row < 0 ? 0 : (row >= MROWS ? MROWS - 1 : row); p[ai][m] = *(const f32x4*)(ssq + (size_t)row * 4); }
#pragma unroll
    for (int ai = 0; ai < 2; ++ai)
#pragma unroll
        for (int m = 0; m < 4; ++m) { const f32x4 a = p[ai][m]; rs[ai][m] = 1.0f / sqrtf(((a[0] + a[1]) + (a[2] + a[3])) * (1.0f / DMODEL) + EPS); }
}
template <int CTRL> __device__ __forceinline__ float dppf(float old, float src) {
    return __builtin_bit_cast(float, __builtin_amdgcn_update_dpp(__builtin_bit_cast(int, old), __builtin_bit_cast(int, src), CTRL, 0xF, 0xF, false));
}
template <int CTRL> __device__ __forceinline__ float dppa(float src) {
    return __builtin_bit_cast(float, __builtin_amdgcn_mov_dpp(__builtin_bit_cast(int, src), CTRL, 0xF, 0xF, true));
}
__device__ __forceinline__ f32x4 silu4(f32x4 v) {
    const f32x4 t = v * (-1.4426950408889634f); f32x4 e;
#pragma unroll
    for (int i = 0; i < 4; ++i) e[i] = __builtin_amdgcn_exp2f(t[i]);
    e = e + 1.0f;
#pragma unroll
    for (int i = 0; i < 4; ++i) e[i] = __builtin_amdgcn_rcpf(e[i]);
    return v * e;
}
template <int CTRL> __device__ __forceinline__ float dppz(float src) {
    return __builtin_bit_cast(float, __builtin_amdgcn_update_dpp(0, __builtin_bit_cast(int, src), CTRL, 0xF, 0xF, true));
}
__device__ __forceinline__ float silu_fast(float v) { return v * __builtin_amdgcn_rcpf(1.0f + __builtin_amdgcn_exp2f(-1.4426950408889634f * v)); }

struct EpiResidual {
    static constexpr bool PERM = false, ROWIL = false, KGROUP = false;
    const float* xin; float* xout; bf16_t* xb; float* ssq; int dry;
    __device__ __forceinline__ void operator()(f32x4 (&acc)[2][2][4][2], const Unit& u, int wr, int wc, EPI_LAS unsigned char* elds) const {
        int fr, fq; { int t_ = threadIdx.x; asm volatile("" : "+v"(t_)); fr = t_ & 15; fq = (t_ >> 4) & 3; }
        EPI_LAS float* P = (EPI_LAS float*)elds;
        const int col0 = u.pn * 256 + wc * 32 + 4 * fq;
#pragma unroll
        for (int ai = 0; ai < 2; ++ai) {
            f32x4 xv[4][2][2];
#pragma unroll
            for (int m = 0; m < 4; ++m)
#pragma unroll
                for (int bj = 0; bj < 2; ++bj)
#pragma unroll
                    for (int n = 0; n < 2; ++n) xv[m][bj][n] = *(const f32x4*)(xin + (size_t)(u.pm * 256 + ai * 128 + wr * 64 + m * 16 + fr) * DMODEL + col0 + bj * 128 + n * 16);
#pragma unroll
            for (int m = 0; m < 4; ++m) {
                const int row = u.pm * 256 + ai * 128 + wr * 64 + m * 16 + fr;
                const size_t off = (size_t)row * DMODEL + col0;
                float s = 0.f;
#pragma unroll
                for (int bj = 0; bj < 2; ++bj)
#pragma unroll
                    for (int n = 0; n < 2; ++n) {
                        const size_t o = off + bj * 128 + n * 16;
                        const f32x4 v = xv[m][bj][n] + acc[ai][bj][m][n];
                        if (!dry) *(f32x4*)(xout + o) = v;
                        u32x2 w; w.x = cvt_pk_bf16(v[0], v[1]); w.y = cvt_pk_bf16(v[2], v[3]);
                        *(u32x2*)(xb + o) = w;
                        s += (v[0] * v[0] + v[1] * v[1]) + (v[2] * v[2] + v[3] * v[3]);
                    }
                s += __shfl_xor(s, 16); s += __shfl_xor(s, 32);
                if (fq == 0) P[(ai * 128 + wr * 64 + m * 16 + fr) * 4 + wc] = s;
            }
            asm volatile("" ::: "memory");
        }
        asm volatile("s_waitcnt lgkmcnt(0)" ::: "memory"); __builtin_amdgcn_s_barrier(); asm volatile("" ::: "memory");
        { const int t = (wr * 4 + wc) * 64 + fq * 16 + fr; if (t < 256) { const f32x4 p = *(const EPI_LAS f32x4*)(P + t * 4); ssq[(size_t)(u.pm * 256 + t) * 4 + u.pn] = (p[0] + p[1]) + (p[2] + p[3]); } }
        asm volatile("s_waitcnt lgkmcnt(0)" ::: "memory"); __builtin_amdgcn_s_barrier(); asm volatile("" ::: "memory");
    }
};

struct EpiResidualG {
    static constexpr bool PERM = false, ROWIL = false, KGROUP = true;
    const float* xin; float* xout; bf16_t* xb; float* ssq; const float* ssqp; int dry;
    __device__ __forceinline__ void unit_begin(const Unit& u, EPI_LAS unsigned char* elds) const {
        int t = threadIdx.x; asm volatile("" : "+v"(t));
        if (t < 256) {
            const f32x4* p = (const f32x4*)(ssqp + (size_t)(u.pm * 256 + t) * 32);
            float r[4];
#pragma unroll
            for (int g = 0; g < 4; ++g) { const f32x4 a = p[2 * g], b = p[2 * g + 1]; r[g] = 1.0f / sqrtf((((a[0] + a[1]) + (a[2] + a[3])) + ((b[0] + b[1]) + (b[2] + b[3]))) * (1.0f / 512.0f) + EPS); }
            *(EPI_LAS f32x4*)(elds + 4096 + t * 16) = (f32x4){r[0] / r[1], r[1] / r[2], r[2] / r[3], r[3]};
        }
    }
    __device__ __forceinline__ void kgroup(f32x4 (&acc)[2][2][4][2], int g, int wr, EPI_LAS unsigned char* elds) const {
        int fr; { int t_ = threadIdx.x; asm volatile("" : "+v"(t_)); fr = t_ & 15; }
        const EPI_LAS float* RG = (const EPI_LAS float*)(elds + 4096) + (g - 1);
#pragma unroll
        for (int ai = 0; ai < 2; ++ai)
#pragma unroll
            for (int m = 0; m < 4; ++m) {
                const float f = RG[(ai * 128 + wr * 64 + m * 16 + fr) * 4];
#pragma unroll
                for (int bj = 0; bj < 2; ++bj) { acc[ai][bj][m][0] *= f; acc[ai][bj][m][1] *= f; }
            }
    }
    __device__ __forceinline__ void operator()(f32x4 (&acc)[2][2][4][2], const Unit& u, int wr, int wc, EPI_LAS unsigned char* elds) const {
        kgroup(acc, 4, wr, elds);
        const EpiResidual R{xin, xout, xb, ssq, dry};
        R(acc, u, wr, wc, elds);
    }
};

struct EpiSsdIn {
    static constexpr bool PERM = true, ROWIL = false, KGROUP = false;
    bf16_t* proj; float* dt; const float* dtbias; const float* ssq;
    __device__ __forceinline__ void operator()(f32x4 (&acc)[2][2][4][2], const Unit& u, int wr, int wc, EPI_LAS unsigned char*) const {
        int fr, fq; { int t_ = threadIdx.x; asm volatile("" : "+v"(t_)); fr = t_ & 15; fq = (t_ >> 4) & 3; }
        float rsv[2][4]; rstd8<16>(ssq, u.pm * 256 + wr * 64 + fr, false, rsv);
#pragma unroll
        for (int ai = 0; ai < 2; ++ai)
#pragma unroll
            for (int m = 0; m < 4; ++m) {
                const int row = u.pm * 256 + ai * 128 + wr * 64 + m * 16 + fr;
                const float rs = rsv[ai][m];
                if (u.pn < 20) {
#pragma unroll
                    for (int bj = 0; bj < 2; ++bj) {
                        const f32x4 v0 = acc[ai][bj][m][0] * rs, v1 = acc[ai][bj][m][1] * rs;
                        u32x4 w; w.x = cvt_pk_bf16(v0[0], v0[1]); w.y = cvt_pk_bf16(v0[2], v0[3]); w.z = cvt_pk_bf16(v1[0], v1[1]); w.w = cvt_pk_bf16(v1[2], v1[3]);
                        *(u32x4*)(proj + (size_t)row * 5120 + u.pn * 256 + bj * 128 + wc * 32 + 8 * fq) = w;
                    }
                } else if (wc == 0) {
#pragma unroll
                    for (int n = 0; n < 2; ++n) {
                        const int c = 8 * fq + 4 * n;
                        const f32x4 b = *(const f32x4*)(dtbias + c);
                        f32x4 v = acc[ai][0][m][n] * rs + b, o;
#pragma unroll
                        for (int e = 0; e < 4; ++e) o[e] = fmaxf(v[e], 0.f) + log1pf(expf(-fabsf(v[e])));
                        *(f32x4*)(dt + (size_t)row * 32 + c) = o;
                    }
                }
            }
    }
};

struct EpiQKV {
    static constexpr bool PERM = true, ROWIL = false, KGROUP = false;
    bf16_t* proj; const float* ssq; const float* qg; const float* kg; const float* rope;
    __device__ __forceinline__ void operator()(f32x4 (&acc)[2][2][4][2], const Unit& u, int wr, int wc, EPI_LAS unsigned char* elds) const {
        int fr, fq; { int t_ = threadIdx.x; asm volatile("" : "+v"(t_)); fr = t_ & 15; fq = (t_ >> 4) & 3; }
        EPI_LAS float* P = (EPI_LAS float*)elds;
        EPI_LAS f32x4* RT = (EPI_LAS f32x4*)(elds + 8192);
        const bool isqk = u.pn < 8;
        f32x4 rp_[2];
        const int t_id = (wr * 4 + wc) * 64 + fq * 16 + fr;
        if (isqk) {
#pragma unroll
            for (int i = 0; i < 2; ++i) rp_[i] = *(const f32x4*)(rope + (size_t)u.pm * 256 * 16 + (size_t)(t_id * 2 + i) * 4);
        }
        float rsv[2][4]; rstd8<16>(ssq, u.pm * 256 + wr * 64 + fr, false, rsv);
#pragma unroll
        for (int ai = 0; ai < 2; ++ai)
#pragma unroll
            for (int m = 0; m < 4; ++m) {
                const int trow = ai * 128 + wr * 64 + m * 16 + fr;
                const float rs = rsv[ai][m];
#pragma unroll
                for (int bj = 0; bj < 2; ++bj) {
                    acc[ai][bj][m][0] *= rs; acc[ai][bj][m][1] *= rs;
                    if (isqk) {
                        const f32x4 a = acc[ai][bj][m][0], b = acc[ai][bj][m][1];
                        float s = ((a[0] * a[0] + a[1] * a[1]) + (a[2] * a[2] + a[3] * a[3])) + ((b[0] * b[0] + b[1] * b[1]) + (b[2] * b[2] + b[3] * b[3]));
                        s += __shfl_xor(s, 16); s += __shfl_xor(s, 32);
                        if (fq == 0) P[trow * 8 + bj * 4 + wc] = s;
                    }
                }
            }
        if (isqk) { RT[t_id * 2] = rp_[0]; RT[t_id * 2 + 1] = rp_[1]; }
        if (isqk) {
            asm volatile("s_waitcnt lgkmcnt(0)" ::: "memory"); __builtin_amdgcn_s_barrier(); asm volatile("" ::: "memory");
            const float* g = (u.pn < 4) ? qg : kg;
            const int d0 = 32 * (wc & 1) + 8 * fq;
            const f32x4 g0 = *(const f32x4*)(g + d0), g1 = *(const f32x4*)(g + d0 + 4);
            const float qs = (u.pn < 4) ? (1.4426950408889634f * 0.125f) : 1.0f;
            const bool dorope = (wc & 1) == 0;
#pragma unroll
            for (int ai = 0; ai < 2; ++ai)
#pragma unroll
                for (int m = 0; m < 4; ++m) {
                    const int trow = ai * 128 + wr * 64 + m * 16 + fr;
                    const int row = u.pm * 256 + trow;
                    f32x4 c0 = {1.f, 1.f, 1.f, 1.f}, c1 = c0, s0 = {0.f, 0.f, 0.f, 0.f}, s1 = s0;
                    if (dorope && fq < 2) {
                        c0 = RT[trow * 4 + 0]; c1 = RT[trow * 4 + 1]; s0 = RT[trow * 4 + 2]; s1 = RT[trow * 4 + 3];
                        if (fq == 0) { s0 = -s0; s1 = -s1; }
                    }
#pragma unroll
                    for (int bj = 0; bj < 2; ++bj) {
                        const float tot = P[trow * 8 + bj * 4 + wc] + P[trow * 8 + bj * 4 + (wc ^ 1)];
                        const float nr = qs / sqrtf(tot * (1.0f / 64.0f) + EPS);
                        f32x4 v0 = acc[ai][bj][m][0] * g0 * nr, v1 = acc[ai][bj][m][1] * g1 * nr;
                        if (dorope) {
                            f32x4 o0, o1;
#pragma unroll
                            for (int e = 0; e < 4; ++e) { o0[e] = __shfl_xor(v0[e], 16); o1[e] = __shfl_xor(v1[e], 16); }
                            v0 = v0 * c0 + o0 * s0; v1 = v1 * c1 + o1 * s1;
                        }
                        u32x4 w; w.x = cvt_pk_bf16(v0[0], v0[1]); w.y = cvt_pk_bf16(v0[2], v0[3]); w.z = cvt_pk_bf16(v1[0], v1[1]); w.w = cvt_pk_bf16(v1[2], v1[3]);
                        *(u32x4*)(proj + (size_t)row * 3072 + u.pn * 256 + bj * 128 + wc * 32 + 8 * fq) = w;
                    }
                    asm volatile("" ::: "memory");
                }
            asm volatile("s_waitcnt lgkmcnt(0)" ::: "memory"); __builtin_amdgcn_s_barrier(); asm volatile("" ::: "memory");
        } else {
#pragma unroll
            for (int ai = 0; ai < 2; ++ai)
#pragma unroll
                for (int m = 0; m < 4; ++m) {
                    const int row = u.pm * 256 + ai * 128 + wr * 64 + m * 16 + fr;
#pragma unroll
                    for (int bj = 0; bj < 2; ++bj) {
                        const f32x4 v0 = acc[ai][bj][m][0], v1 = acc[ai][bj][m][1];
                        u32x4 w; w.x = cvt_pk_bf16(v0[0], v0[1]); w.y = cvt_pk_bf16(v0[2], v0[3]); w.z = cvt_pk_bf16(v1[0], v1[1]); w.w = cvt_pk_bf16(v1[2], v1[3]);
                        *(u32x4*)(proj + (size_t)row * 3072 + u.pn * 256 + bj * 128 + wc * 32 + 8 * fq) = w;
                    }
                }
        }
    }
};

struct EpiSsdConv {
    static constexpr bool PERM = true, ROWIL = true, KGROUP = false;
    bf16_t* zp; bf16_t* xbc; float* dt; const float* ssq; const float* cp;
    template <bool MASK>
    __device__ __forceinline__ void conv_body(f32x4 (&acc)[2][2][4][2], const Unit& u, int wr, int wc, int fr, int fq, const EPI_LAS f32x4* hb, int R0) const {
        bf16_t* const obase = (u.pn < 8) ? zp + u.pn * 256 : xbc + (u.pn - 8) * 256;
        const int old_ = (u.pn < 8) ? 2048 : 3072;
#pragma unroll
        for (int bj = 0; bj < 2; ++bj) {
            u32x2 keep[2][4];
#pragma unroll
            for (int n = 0; n < 2; ++n) {
                const int tc = bj * 128 + wc * 32 + 8 * fq + 4 * n;
                const EPI_LAS float* pt = (const EPI_LAS float*)((const EPI_LAS unsigned char*)hb + 12288) + tc;
                const f32x4 bb = *(const EPI_LAS f32x4*)pt, w0 = *(const EPI_LAS f32x4*)(pt + 256), w1 = *(const EPI_LAS f32x4*)(pt + 512), w2 = *(const EPI_LAS f32x4*)(pt + 768), w3 = *(const EPI_LAS f32x4*)(pt + 1024);
#pragma unroll
                for (int ai = 0; ai < 2; ++ai) {
                    f32x4 h1 = {0.f, 0.f, 0.f, 0.f}, h2 = h1, h3 = h1;
                    const int pwr = wr ^ 1, pai = (wr == 1) ? ai : ai - 1;
                    if (pai >= 0 && fr == 0) { const int idx = (((pwr * 2 + pai) * 4 + wc) * 3 * 4 + fq) * 4 + bj * 2 + n;
                        h1 = hb[idx]; h2 = hb[idx + 16]; h3 = hb[idx + 32]; }
                    const f32x4 v0 = acc[ai][bj][0][n], v1 = acc[ai][bj][1][n], v2 = acc[ai][bj][2][n], v3 = acc[ai][bj][3][n];
                    f32x4 p1, p2, p3;
#pragma unroll
                    for (int e = 0; e < 4; ++e) { p1[e] = dppf<0x111>(h1[e], v1[e]); p2[e] = dppf<0x111>(h2[e], v2[e]); p3[e] = dppf<0x111>(h3[e], v3[e]); }
#pragma unroll
                    for (int m = 0; m < 4; ++m) {
                        const int trow = ai * 128 + wr * 64 + 4 * fr + m, row = R0 + trow;
                        const f32x4 cv = (m == 0) ? v0 : (m == 1) ? v1 : (m == 2) ? v2 : v3;
                        f32x4 x1 = (m == 0) ? p3 : (m == 1) ? v0 : (m == 2) ? v1 : v2;
                        f32x4 x2 = (m == 0) ? p2 : (m == 1) ? p3 : (m == 2) ? v0 : v1;
                        f32x4 x3 = (m == 0) ? p1 : (m == 1) ? p2 : (m == 2) ? p3 : v0;
                        if (MASK) { const int ts = row & 2047; const f32x4 z4 = {0.f, 0.f, 0.f, 0.f}; if (ts < 1) x1 = z4; if (ts < 2) x2 = z4; if (ts < 3) x3 = z4; }
                        const bool valid = trow >= 3 && row < MROWS;
                        const f32x4 o = silu4(bb + w0 * x3 + w1 * x2 + w2 * x1 + w3 * cv);
                        if (n == 0) { keep[ai][m].x = cvt_pk_bf16(o[0], o[1]); keep[ai][m].y = cvt_pk_bf16(o[2], o[3]); }
                        else if (valid) {
                            u32x4 w; w.x = keep[ai][m].x; w.y = keep[ai][m].y; w.z = cvt_pk_bf16(o[0], o[1]); w.w = cvt_pk_bf16(o[2], o[3]);
                            *(u32x4*)(obase + (size_t)row * old_ + tc - 4) = w;
                        }
                    }
                    asm volatile("" ::: "memory");
                }
            }
        }
    }
    __device__ __forceinline__ void operator()(f32x4 (&acc)[2][2][4][2], const Unit& u, int wr, int wc, EPI_LAS unsigned char* elds) const {
        int fr, fq; { int t_ = threadIdx.x; asm volatile("" : "+v"(t_)); fr = t_ & 15; fq = (t_ >> 4) & 3; }
        const int R0 = u.pm * 253 - 3;
        EPI_LAS f32x4* hb = (EPI_LAS f32x4*)elds;
        const int t_id = (wr * 4 + wc) * 64 + fq * 16 + fr;
        f32x4 pld = {0.f, 0.f, 0.f, 0.f};
        if (t_id < 320) pld = *(const f32x4*)(cp + (size_t)(t_id >> 6) * 5376 + u.pn * 256 + (t_id & 63) * 4);
        { float rsv[2][4]; rstd8<1>(ssq, R0 + wr * 64 + 4 * fr, true, rsv);
#pragma unroll
          for (int ai = 0; ai < 2; ++ai)
#pragma unroll
            for (int m = 0; m < 4; ++m)
#pragma unroll
                for (int bj = 0; bj < 2; ++bj) { acc[ai][bj][m][0] *= rsv[ai][m]; acc[ai][bj][m][1] *= rsv[ai][m]; } }
        if (t_id < 320) *(EPI_LAS f32x4*)((EPI_LAS unsigned char*)hb + 12288 + t_id * 16) = pld;
        if (u.pn == 20) {
            if (wc == 0) {
#pragma unroll
                for (int ai = 0; ai < 2; ++ai)
#pragma unroll
                    for (int m = 0; m < 4; ++m) {
                        const int trow = ai * 128 + wr * 64 + 4 * fr + m, row = R0 + trow;
                        if (trow >= 3 && row < MROWS) {
#pragma unroll
                            for (int n = 0; n < 2; ++n) {
                                const int c = 8 * fq + 4 * n;
                                const f32x4 b = *(const f32x4*)(cp + 20 * 256 + c);
                                f32x4 v = acc[ai][0][m][n] + b, o;
#pragma unroll
                                for (int e = 0; e < 4; ++e) o[e] = fmaxf(v[e], 0.f) + log1pf(expf(-fabsf(v[e])));
                                *(f32x4*)(dt + (size_t)row * 32 + c) = o;
                            }
                        }
                    }
            }
            return;
        }
        if (fr == 15) {
#pragma unroll
            for (int ai = 0; ai < 2; ++ai)
#pragma unroll
                for (int m = 1; m < 4; ++m) {
                    const int idx = ((((wr * 2 + ai) * 4 + wc) * 3 + (m - 1)) * 4 + fq) * 4;
                    hb[idx + 0] = acc[ai][0][m][0]; hb[idx + 1] = acc[ai][0][m][1]; hb[idx + 2] = acc[ai][1][m][0]; hb[idx + 3] = acc[ai][1][m][1];
                }
        }
        asm volatile("s_waitcnt lgkmcnt(0)" ::: "memory"); __builtin_amdgcn_s_barrier(); asm volatile("" ::: "memory");
        const int tf = (u.pm * 253) & 2047;
        if (tf <= 2 || tf + 252 >= 2048) conv_body<true>(acc, u, wr, wc, fr, fq, hb, R0); else conv_body<false>(acc, u, wr, wc, fr, fq, hb, R0);
        asm volatile("s_waitcnt lgkmcnt(0)" ::: "memory"); __builtin_amdgcn_s_barrier(); asm volatile("" ::: "memory");
    }
};

struct EpiConvGate {
    static constexpr bool PERM = true, ROWIL = true, KGROUP = false;
    bf16_t* H; const float* ssq; const float* cw; const float* cb; int dry;
    template <bool MASK>
    __device__ __forceinline__ void body(f32x4 (&acc)[2][2][4][2], const Unit& u, int wr, int wc, int fr, int fq, const EPI_LAS f32x4* hb, int R0) const {
        constexpr int DFF = 2816;
        u32x2 keep[2][4];
#pragma unroll
        for (int n = 0; n < 2; ++n) {
            const int ch = u.pn * 128 + wc * 32 + 8 * fq + 4 * n;
            const EPI_LAS float* pt = (const EPI_LAS float*)((const EPI_LAS unsigned char*)hb + 8192) + wc * 32 + 8 * fq + 4 * n;
            const f32x4 bg = *(const EPI_LAS f32x4*)pt, bu = *(const EPI_LAS f32x4*)(pt + 128);
            const f32x4 w0g = *(const EPI_LAS f32x4*)(pt + 256), w0u = *(const EPI_LAS f32x4*)(pt + 384), w1g = *(const EPI_LAS f32x4*)(pt + 512), w1u = *(const EPI_LAS f32x4*)(pt + 640), w2g = *(const EPI_LAS f32x4*)(pt + 768), w2u = *(const EPI_LAS f32x4*)(pt + 896);
#pragma unroll
            for (int ai = 0; ai < 2; ++ai) {
                f32x4 hg2 = {0.f, 0.f, 0.f, 0.f}, hg3 = hg2, hu2 = hg2, hu3 = hg2;
                const int pwr = wr ^ 1, pai = (wr == 1) ? ai : ai - 1;
                if (pai >= 0 && fr == 0) { const int idx = (((pwr * 2 + pai) * 4 + wc) * 2 * 4 + fq) * 4;
                    hg2 = hb[idx + n]; hu2 = hb[idx + 2 + n]; hg3 = hb[idx + 16 + n]; hu3 = hb[idx + 16 + 2 + n]; }
                const f32x4 g0 = acc[ai][0][0][n], g1_ = acc[ai][0][1][n], g2_ = acc[ai][0][2][n], g3_ = acc[ai][0][3][n];
                const f32x4 u0 = acc[ai][1][0][n], u1_ = acc[ai][1][1][n], u2_ = acc[ai][1][2][n], u3_ = acc[ai][1][3][n];
                f32x4 pg2, pg3, pu2, pu3;
#pragma unroll
                for (int e = 0; e < 4; ++e) { pg2[e] = dppf<0x111>(hg2[e], g2_[e]); pg3[e] = dppf<0x111>(hg3[e], g3_[e]); pu2[e] = dppf<0x111>(hu2[e], u2_[e]); pu3[e] = dppf<0x111>(hu3[e], u3_[e]); }
#pragma unroll
                for (int m = 0; m < 4; ++m) {
                    const int trow = ai * 128 + wr * 64 + 4 * fr + m, row = R0 + trow;
                    const f32x4 cg = (m == 0) ? g0 : (m == 1) ? g1_ : (m == 2) ? g2_ : g3_, cu = (m == 0) ? u0 : (m == 1) ? u1_ : (m == 2) ? u2_ : u3_;
                    f32x4 xg1 = (m == 0) ? pg3 : (m == 1) ? g0 : (m == 2) ? g1_ : g2_, xg2 = (m == 0) ? pg2 : (m == 1) ? pg3 : (m == 2) ? g0 : g1_;
                    f32x4 xu1 = (m == 0) ? pu3 : (m == 1) ? u0 : (m == 2) ? u1_ : u2_, xu2 = (m == 0) ? pu2 : (m == 1) ? pu3 : (m == 2) ? u0 : u1_;
                    if (MASK) { const int ts = row & 2047; const f32x4 z4 = {0.f, 0.f, 0.f, 0.f}; if (ts < 1) { xg1 = z4; xu1 = z4; } if (ts < 2) { xg2 = z4; xu2 = z4; } }
                    const f32x4 gv = bg + w0g * xg2 + w1g * xg1 + w2g * cg;
                    const f32x4 uv = bu + w0u * xu2 + w1u * xu1 + w2u * cu;
                    const f32x4 o = silu4(gv) * uv;
                    if (n == 0) { keep[ai][m].x = cvt_pk_bf16(o[0], o[1]); keep[ai][m].y = cvt_pk_bf16(o[2], o[3]); }
                    else if (trow >= 2 && row < MROWS && !dry) {
                        u32x4 w; w.x = keep[ai][m].x; w.y = keep[ai][m].y; w.z = cvt_pk_bf16(o[0], o[1]); w.w = cvt_pk_bf16(o[2], o[3]);
                        *(u32x4*)(H + (size_t)row * DFF + ch - 4) = w;
                    }
                }
                asm volatile("" ::: "memory");
            }
        }
    }
    __device__ __forceinline__ void operator()(f32x4 (&acc)[2][2][4][2], const Unit& u, int wr, int wc, EPI_LAS unsigned char* elds) const {
        int fr, fq; { int t_ = threadIdx.x; asm volatile("" : "+v"(t_)); fr = t_ & 15; fq = (t_ >> 4) & 3; }
        const int R0 = u.pm * 254 - 2;
        EPI_LAS f32x4* hb = (EPI_LAS f32x4*)elds;
        const int t_id = (wr * 4 + wc) * 64 + fq * 16 + fr;
        f32x4 pld = {0.f, 0.f, 0.f, 0.f};
        if (t_id < 256) { const int k = t_id >> 5, c = u.pn * 128 + (t_id & 31) * 4; pld = *(const f32x4*)((k < 2 ? cb + k * 2816 : cw + (size_t)(k - 2) * 2816) + c); }
        { float rsv[2][4]; rstd8<1>(ssq, R0 + wr * 64 + 4 * fr, true, rsv);
#pragma unroll
          for (int ai = 0; ai < 2; ++ai)
#pragma unroll
            for (int m = 0; m < 4; ++m)
#pragma unroll
                for (int bj = 0; bj < 2; ++bj) { acc[ai][bj][m][0] *= rsv[ai][m]; acc[ai][bj][m][1] *= rsv[ai][m]; } }
        if (t_id < 256) *(EPI_LAS f32x4*)((EPI_LAS unsigned char*)hb + 8192 + t_id * 16) = pld;
        if (fr == 15) {
#pragma unroll
            for (int ai = 0; ai < 2; ++ai)
#pragma unroll
                for (int m = 2; m < 4; ++m) {
                    const int idx = ((((wr * 2 + ai) * 4 + wc) * 2 + (m - 2)) * 4 + fq) * 4;
                    hb[idx + 0] = acc[ai][0][m][0]; hb[idx + 1] = acc[ai][0][m][1]; hb[idx + 2] = acc[ai][1][m][0]; hb[idx + 3] = acc[ai][1][m][1];
                }
        }
        asm volatile("s_waitcnt lgkmcnt(0)" ::: "memory"); __builtin_amdgcn_s_barrier(); asm volatile("" ::: "memory");
        const int tf = (u.pm * 254) & 2047;
        if (dry < 2) { if (tf <= 1 || tf + 253 >= 2048) body<true>(acc, u, wr, wc, fr, fq, hb, R0); else body<false>(acc, u, wr, wc, fr, fq, hb, R0); }
        asm volatile("s_waitcnt lgkmcnt(0)" ::: "memory"); __builtin_amdgcn_s_barrier(); asm volatile("" ::: "memory");
    }
};
}
namespace attn {
using pg8::bf16_t; using pg8::bf16x8; using pg8::f32x4; using pg8::u32x4;
typedef float f32x16 __attribute__((ext_vector_type(16)));
typedef short s16x4 __attribute__((ext_vector_type(4)));
#define AT_LAS __attribute__((address_space(3)))
constexpr int LD = 3072, SEQ = 2048;
constexpr int KT_BYTES = 16384, VT_BYTES = 16384, STG = KT_BYTES + VT_BYTES;
constexpr int L_X = 0;
constexpr int L_WSF = 2 * STG;
constexpr int L_OST = L_WSF + 8 * 256;
constexpr int LDS_BYTES = L_OST + 4 * 8192;
__device__ __forceinline__ int crow(int r, int hi) { return (r & 3) + 8 * (r >> 2) + 4 * hi; }
__device__ __forceinline__ unsigned cvtpk(float lo, float hi) { typedef float f2 __attribute__((ext_vector_type(2))); typedef __bf16 b2 __attribute__((ext_vector_type(2))); f2 v = {lo, hi}; b2 b = __builtin_convertvector(v, b2); return __builtin_bit_cast(unsigned, b); }
__device__ __forceinline__ s16x4 vtr(const AT_LAS char* p) { typedef short v4 __attribute__((ext_vector_type(4))); return __builtin_bit_cast(s16x4, __builtin_amdgcn_ds_read_tr16_b64_v4i16((AT_LAS v4*)p)); }

struct Params { bf16_t* qkv; float mb; float lam; int dry; };

__device__ __forceinline__ void unit(const Params& P, int b, int h, int blk, AT_LAS char* lds) {
    int tid = threadIdx.x; asm volatile("" : "+v"(tid));
    const int lane = tid & 63, r32 = lane & 31, hi = lane >> 5;
    const int wid = __builtin_amdgcn_readfirstlane(tid >> 6), comp = wid >> 2, w4 = wid & 3;
    const size_t rowb = (size_t)b * SEQ;
    const int q0 = blk * 128;
    const int nt = 2 * blk + 2, my_nt = 2 * blk + (w4 >> 1) + 1;
    const bf16_t* Kg = P.qkv + rowb * LD + 1024 + h * 128;
    const bf16_t* Vg = P.qkv + rowb * LD + 2048 + h * 128;
    u32x4 kreg[2], vreg[2];
    int kdst[2], vdst[2];
#pragma unroll
    for (int i = 0; i < 2; ++i) {
        const int p = tid + 512 * i, key = p >> 4, c16 = p & 15;
        kdst[i] = key * 256 + ((c16 ^ (key & 15)) << 4);
        vdst[i] = KT_BYTES + (c16 >> 2) * 4096 + (key >> 4) * 1024 + ((key >> 3) & 1) * 512 + (key & 7) * 64 + (c16 & 3) * 16;
    }
#define AT_LOAD(t) do { _Pragma("unroll") for (int i = 0; i < 2; ++i) { const int p = tid + 512 * i, key = p >> 4, c16 = p & 15; const size_t go = (size_t)((t) * 64 + key) * LD + c16 * 8; \
        kreg[i] = *(const u32x4*)(Kg + go); vreg[i] = *(const u32x4*)(Vg + go); } } while (0)
#define AT_STORE(s) do { _Pragma("unroll") for (int i = 0; i < 2; ++i) { *(AT_LAS u32x4*)(lds + (s) * STG + kdst[i]) = kreg[i]; *(AT_LAS u32x4*)(lds + (s) * STG + vdst[i]) = vreg[i]; } } while (0)
    AT_LOAD(0);
    bf16x8 qr[4];
    {
        const bf16_t* Qw = P.qkv + (rowb + q0 + w4 * 32 + r32) * LD + h * 128 + comp * 64 + hi * 8;
#pragma unroll
        for (int d0 = 0; d0 < 4; ++d0) qr[d0] = *(const bf16x8*)(Qw + d0 * 16);
    }
    AT_STORE(0);
    __syncthreads();
    f32x16 o[4];
#pragma unroll
    for (int i = 0; i < 4; ++i)
#pragma unroll
        for (int r = 0; r < 16; ++r) o[i][r] = 0.f;
    float lsum = 0.f;
    f32x16 negm;
#pragma unroll
    for (int r = 0; r < 16; ++r) negm[r] = -P.mb;
    const int kbase = r32 * 256, ksw = r32 & 15;
    const int vbase = KT_BYTES + ((lane >> 4) & 1) * 32 + (lane & 3) * 8 + (4 * hi + ((lane & 15) >> 2)) * 64;
    for (int t = 0; t < nt; ++t) {
        const int s = t & 1;
        if (t + 1 < nt) AT_LOAD(t + 1);
        if (t < my_nt) {
            const AT_LAS char* st = lds + s * STG;
            bf16x8 kf[8];
#pragma unroll
            for (int d0 = 0; d0 < 4; ++d0) {
                const int ch = comp * 8 + 2 * d0 + hi;
                kf[2 * d0] = *(const AT_LAS bf16x8*)(st + kbase + ((ch ^ ksw) << 4));
                kf[2 * d0 + 1] = *(const AT_LAS bf16x8*)(st + kbase + 32 * 256 + ((ch ^ ksw) << 4));
            }
            s16x4 vlo[2][4], vhi[2][4];
#define AT_VLOAD(bk, buf) do { _Pragma("unroll") for (int ks = 0; ks < 4; ++ks) { vlo[buf][ks] = vtr(st + vbase + (bk) * 4096 + ks * 1024); vhi[buf][ks] = vtr(st + vbase + (bk) * 4096 + ks * 1024 + 512); } } while (0)
            AT_VLOAD(0, 0);
            __builtin_amdgcn_sched_barrier(0);
            f32x16 p0 = negm, p1 = negm;
#pragma unroll
            for (int d0 = 0; d0 < 4; ++d0) {
                p0 = __builtin_amdgcn_mfma_f32_32x32x16_bf16(kf[2 * d0], qr[d0], p0, 0, 0, 0);
                p1 = __builtin_amdgcn_mfma_f32_32x32x16_bf16(kf[2 * d0 + 1], qr[d0], p1, 0, 0, 0);
            }
            __builtin_amdgcn_sched_barrier(0);
            AT_VLOAD(1, 1);
            __builtin_amdgcn_sched_barrier(0);
            float sacc0 = 0.f, sacc1 = 0.f;
#pragma unroll
            for (int r = 0; r < 16; ++r) { p0[r] = __builtin_amdgcn_exp2f(p0[r]); p1[r] = __builtin_amdgcn_exp2f(p1[r]); sacc0 += p0[r]; sacc1 += p1[r]; }
            lsum += sacc0 + sacc1;
            u32x4 pw[4];
#pragma unroll
            for (int j = 0; j < 4; ++j) { pw[0][j] = cvtpk(p0[2 * j], p0[2 * j + 1]); pw[1][j] = cvtpk(p0[8 + 2 * j], p0[8 + 2 * j + 1]); pw[2][j] = cvtpk(p1[2 * j], p1[2 * j + 1]); pw[3][j] = cvtpk(p1[8 + 2 * j], p1[8 + 2 * j + 1]); }
#define AT_PV(bk, buf) do { _Pragma("unroll") for (int ks = 0; ks < 4; ++ks) { \
                const bf16x8 vf = {vlo[buf][ks][0], vlo[buf][ks][1], vlo[buf][ks][2], vlo[buf][ks][3], vhi[buf][ks][0], vhi[buf][ks][1], vhi[buf][ks][2], vhi[buf][ks][3]}; \
                o[bk] = __builtin_amdgcn_mfma_f32_32x32x16_bf16(__builtin_bit_cast(bf16x8, pw[ks]), vf, o[bk], 0, 0, 0); } } while (0)
            __builtin_amdgcn_sched_barrier(0);
            AT_PV(0, 0); __builtin_amdgcn_sched_barrier(0); AT_VLOAD(2, 0); __builtin_amdgcn_sched_barrier(0);
            AT_PV(1, 1); __builtin_amdgcn_sched_barrier(0); AT_VLOAD(3, 1); __builtin_amdgcn_sched_barrier(0);
            AT_PV(2, 0);
            AT_PV(3, 1);
#undef AT_VLOAD
#undef AT_PV
        }
        if (t + 1 < nt) AT_STORE(s ^ 1);
        __syncthreads();
    }
    lsum += __shfl_xor(lsum, 32);
    AT_LAS float* wsf = (AT_LAS float*)(lds + L_WSF) + wid * 64;
    if (hi == 0) wsf[r32] = lsum;
    asm volatile("s_waitcnt lgkmcnt(0)" ::: "memory");
    float rl[16];
    const float sc = comp ? P.lam : 1.0f;
#pragma unroll
    for (int r = 0; r < 16; ++r) rl[r] = sc * __builtin_amdgcn_rcpf(wsf[crow(r, hi)]);
    AT_LAS float* X = (AT_LAS float*)(lds + L_X) + w4 * 4096 + lane;
    if (comp == 1) {
#pragma unroll
        for (int bk = 0; bk < 4; ++bk)
#pragma unroll
            for (int r = 0; r < 16; ++r) X[(bk * 16 + r) * 64] = o[bk][r] * rl[r];
    }
    __syncthreads();
    if (comp == 0) {
        float ss[16];
#pragma unroll
        for (int r = 0; r < 16; ++r) ss[r] = 0.f;
#pragma unroll
        for (int bk = 0; bk < 4; ++bk)
#pragma unroll
            for (int r = 0; r < 16; ++r) { const float v = o[bk][r] * rl[r] - X[(bk * 16 + r) * 64]; o[bk][r] = v; ss[r] += v * v; }
#pragma unroll
        for (int r = 0; r < 16; ++r) {
            float s = ss[r];
            s += __shfl_xor(s, 1); s += __shfl_xor(s, 2); s += __shfl_xor(s, 4); s += __shfl_xor(s, 8); s += __shfl_xor(s, 16);
            ss[r] = 1.0f / sqrtf(s * (1.0f / 128.0f) + 1e-6f);
        }
        AT_LAS bf16_t* stg = (AT_LAS bf16_t*)(lds + L_OST) + w4 * 4096;
#pragma unroll
        for (int bk = 0; bk < 4; ++bk)
#pragma unroll
            for (int r = 0; r < 16; ++r) { const float v = o[bk][r] * ss[r]; stg[crow(r, hi) * 128 + bk * 32 + r32] = (bf16_t)(cvtpk(v, 0.f) & 0xffffu); }
        asm volatile("s_waitcnt lgkmcnt(0)" ::: "memory");
        bf16_t* Ow = P.qkv + (rowb + q0 + w4 * 32) * LD + h * 128;
#pragma unroll
        for (int i = 0; i < 8; ++i) { const int row = i * 4 + (lane >> 4), c = lane & 15; const u32x4 v = *(const AT_LAS u32x4*)(stg + row * 128 + c * 8); if (!P.dry) *(u32x4*)(Ow + (size_t)row * LD + c * 8) = v; }
    }
    __syncthreads();
#undef AT_LOAD
#undef AT_STORE
}
}
namespace scan {
using pg8::bf16_t; using pg8::bf16x8; using pg8::f32x4; using pg8::u32x4; using pg8::u32x2;
typedef float f32x16 __attribute__((ext_vector_type(16)));
#define SC_LAS __attribute__((address_space(3)))
#define SC_BAR() do { asm volatile("s_waitcnt lgkmcnt(0)" ::: "memory"); __builtin_amdgcn_s_barrier(); asm volatile("" ::: "memory"); } while (0)
constexpr int SEQ = 2048, CH = 64;
constexpr int L_C = 0;
constexpr int L_B = 16384;
constexpr int L_XD = 32768;
constexpr int L_XW = 40960;
constexpr int L_G = 49152;
constexpr int L_H = 57344;
constexpr int L_Y = 73728;
constexpr int L_S = L_Y + 64 * 68 * 4;
constexpr int LDS_BYTES = L_S + 32 * 1024;
__device__ __forceinline__ unsigned cvtpk(float lo, float hi) { typedef float f2 __attribute__((ext_vector_type(2))); typedef __bf16 b2 __attribute__((ext_vector_type(2))); f2 v = {lo, hi}; b2 b = __builtin_convertvector(v, b2); return __builtin_bit_cast(unsigned, b); }
typedef short s16x4 __attribute__((ext_vector_type(4)));
__device__ __forceinline__ s16x4 vtr(const SC_LAS char* p) { typedef short v4 __attribute__((ext_vector_type(4))); return __builtin_bit_cast(s16x4, __builtin_amdgcn_ds_read_tr16_b64_v4i16((SC_LAS v4*)p)); }
__device__ __forceinline__ float lo16(unsigned w) { return __builtin_bit_cast(float, w << 16); }
__device__ __forceinline__ float hi16(unsigned w) { return __builtin_bit_cast(float, w & 0xffff0000u); }
__device__ __forceinline__ int img_off(int l) { return (l >> 4) * 1024 + ((l >> 3) & 1) * 512 + (l & 7) * 64; }

struct Params { const bf16_t* xbc; bf16_t* zp; const float* dt; const float* a_log; const float* dskip; float* ssqp; int dry; };

__device__ __forceinline__ void unit(const Params& P, int b, int h, SC_LAS char* lds) {
    int tid = threadIdx.x; asm volatile("" : "+v"(tid));
    const int wid = __builtin_amdgcn_readfirstlane(tid >> 6);
    const int g = h >> 3;
    const size_t rowb = (size_t)b * SEQ;
    const float a_h = -expf(P.a_log[h]), dsk = P.dskip[h];
    unsigned zu = 0u; asm volatile("" : "+v"(zu));
    {
        const int lane_ = tid & 63;
#pragma unroll
        for (int q = 0; q < 4; ++q) {
            const int cc = wid * 4 + q;
            const float dtv = P.dt[(rowb + cc * 64 + lane_) * 32 + h];
            float acs = dtv * a_h;
#pragma unroll
            for (int o = 1; o < 64; o <<= 1) { const float up = __shfl_up(acs, o); if (lane_ >= o) acs += up; }
            const float last = __shfl(acs, 63);
            SC_LAS float* sc = (SC_LAS float*)(lds + L_S) + cc * 256;
            sc[lane_] = dtv; sc[64 + lane_] = acs; sc[128 + lane_] = __expf(last - acs); sc[192 + lane_] = __expf(acs);
        }
    }
    for (int i = tid; i < 16384 / 16; i += 512) *(SC_LAS u32x4*)(lds + L_H + i * 16) = (u32x4){zu, zu, zu, zu};
    f32x16 hacc0, hacc1;
#pragma unroll
    for (int r = 0; r < 16; ++r) { hacc0[r] = 0.f; hacc1[r] = 0.f; }
    const int tid0 = tid;
    u32x4 xr, zr, br[2], cr[2];
#define SC_LOAD(t0_, XR, ZR) do { const int t_ = tid0; const size_t r1 = rowb + (t0_) + (t_ >> 3); \
        XR = *(const u32x4*)(P.xbc + r1 * 3072 + h * 64 + (t_ & 7) * 8); ZR = *(const u32x4*)(P.zp + r1 * 2048 + h * 64 + (t_ & 7) * 8); \
        _Pragma("unroll") for (int i = 0; i < 2; ++i) { const int p_ = t_ + 512 * i; const size_t r2 = rowb + (t0_) + (p_ >> 4); \
            br[i] = *(const u32x4*)(P.xbc + r2 * 3072 + 2048 + g * 128 + (p_ & 15) * 8); cr[i] = *(const u32x4*)(P.xbc + r2 * 3072 + 2560 + g * 128 + (p_ & 15) * 8); } } while (0)
    SC_LOAD(0, xr, zr);
    __syncthreads();
    for (int c = 0; c < SEQ / CH; ++c) {
        const int t0 = c * CH;
        int tid = tid0; asm volatile("" : "+v"(tid));
        const int lane = tid & 63, r32 = lane & 31, hi = lane >> 5, fr = lane & 15, fq = lane >> 4;
        const int orow = tid >> 3, ocg = tid & 7;
        SC_LAS float* s_dt = (SC_LAS float*)(lds + L_S) + c * 256; SC_LAS float* s_acs = s_dt + 64; SC_LAS float* s_dec = s_dt + 128; SC_LAS float* s_ea = s_dt + 192;
        {
            const float d = s_dt[orow], dd = d * s_dec[orow];
            u32x4 w1, w2;
#pragma unroll
            for (int i = 0; i < 4; ++i) { const float a = lo16(xr[i]), bq = hi16(xr[i]); w1[i] = cvtpk(a * d, bq * d); w2[i] = cvtpk(a * dd, bq * dd); }
            const int off = (ocg >> 2) * 4096 + img_off(orow) + (ocg & 3) * 16;
            *(SC_LAS u32x4*)(lds + L_XD + off) = w1; *(SC_LAS u32x4*)(lds + L_XW + off) = w2;
#pragma unroll
            for (int i = 0; i < 2; ++i) { const int p = tid + 512 * i, l = p >> 4, c16 = p & 15;
                *(SC_LAS u32x4*)(lds + L_B + (c16 >> 2) * 4096 + img_off(l) + (c16 & 3) * 16) = br[i];
                *(SC_LAS u32x4*)(lds + L_C + l * 256 + ((c16 ^ (l & 15)) << 4)) = cr[i]; }
        }
        const u32x4 xcur = xr, zcur = zr;
        if (c + 1 < SEQ / CH) SC_LOAD(t0 + CH, xr, zr);
        SC_BAR();
        f32x16 yacc;
#pragma unroll
        for (int r = 0; r < 16; ++r) yacc[r] = 0.f;
        const int yli = (wid >> 1) & 1, ypi = wid & 1;
        if (wid < 3) {
            const int si = (wid == 2) ? 1 : 0, li = (wid == 0) ? 0 : 1;
            const int srow = 32 * si + r32, lrow = 32 * li + r32;
            f32x16 cb;
#pragma unroll
            for (int r = 0; r < 16; ++r) cb[r] = 0.f;
            bf16x8 fa[8], fb[8];
#pragma unroll
            for (int ks = 0; ks < 8; ++ks) {
                const int chk = 2 * ks + hi;
                fa[ks] = *(const SC_LAS bf16x8*)(lds + L_B + (chk >> 2) * 4096 + img_off(srow) + (chk & 3) * 16);
                fb[ks] = *(const SC_LAS bf16x8*)(lds + L_C + lrow * 256 + ((chk ^ (lrow & 15)) << 4));
            }
            __builtin_amdgcn_sched_barrier(0);
#pragma unroll
            for (int ks = 0; ks < 8; ++ks) cb = __builtin_amdgcn_mfma_f32_32x32x16_bf16(fa[ks], fb[ks], cb, 0, 0, 0);
            const float al = s_acs[lrow];
#pragma unroll
            for (int q4 = 0; q4 < 4; ++q4) {
                const int s0 = 32 * si + 8 * q4 + 4 * hi;
                float gv[4];
#pragma unroll
                for (int e = 0; e < 4; ++e) { const int sidx = s0 + e; gv[e] = (sidx <= lrow) ? cb[4 * q4 + e] * __expf(al - s_acs[sidx]) : 0.f; }
                u32x2 w; w.x = cvtpk(gv[0], gv[1]); w.y = cvtpk(gv[2], gv[3]);
                *(SC_LAS u32x2*)(lds + L_G + lrow * 128 + (((s0 >> 3) ^ (lrow & 7)) << 4) + (s0 & 7) * 2) = w;
            }
        } else if (wid >= 4) {
            const int lrow = 32 * yli + r32, prow = 32 * ypi + r32;
            bf16x8 fa[8], fb[8];
#pragma unroll
            for (int ks = 0; ks < 8; ++ks) {
                const int chk = 2 * ks + hi;
                fa[ks] = *(const SC_LAS bf16x8*)(lds + L_C + lrow * 256 + ((chk ^ (lrow & 15)) << 4));
                fb[ks] = *(const SC_LAS bf16x8*)(lds + L_H + prow * 256 + ((chk ^ (prow & 15)) << 4));
            }
            __builtin_amdgcn_sched_barrier(0);
#pragma unroll
            for (int ks = 0; ks < 8; ++ks) yacc = __builtin_amdgcn_mfma_f32_32x32x16_bf16(fa[ks], fb[ks], yacc, 0, 0, 0);
        }
        SC_BAR();
        if (wid >= 4) {
#pragma unroll
            for (int r = 0; r < 16; ++r) yacc[r] *= s_ea[32 * yli + (r & 3) + 8 * (r >> 2) + 4 * hi];
            const int lrow = 32 * yli + r32;
            const int tbn = ((lane >> 4) & 1) * 32 + (lane & 3) * 8 + hi * 512 + ((lane & 15) >> 2) * 64;
            bf16x8 ga[4]; s16x4 xb0[4], xb1[4];
#pragma unroll
            for (int ks = 0; ks < 4; ++ks) {
                const int chk = 2 * ks + hi;
                ga[ks] = *(const SC_LAS bf16x8*)(lds + L_G + lrow * 128 + ((chk ^ (lrow & 7)) << 4));
                xb0[ks] = vtr(lds + L_XD + ypi * 4096 + ks * 1024 + tbn); xb1[ks] = vtr(lds + L_XD + ypi * 4096 + ks * 1024 + tbn + 256);
            }
            __builtin_amdgcn_sched_barrier(0);
#pragma unroll
            for (int ks = 0; ks < 4; ++ks) {
                if (ks < 2 * (yli + 1)) {
                    const bf16x8 bb = {xb0[ks][0], xb0[ks][1], xb0[ks][2], xb0[ks][3], xb1[ks][0], xb1[ks][1], xb1[ks][2], xb1[ks][3]};
                    yacc = __builtin_amdgcn_mfma_f32_32x32x16_bf16(ga[ks], bb, yacc, 0, 0, 0);
                }
            }
#pragma unroll
            for (int r = 0; r < 16; ++r) ((SC_LAS float*)(lds + L_Y))[(32 * yli + (r & 3) + 8 * (r >> 2) + 4 * hi) * 68 + 32 * ypi + r32] = yacc[r];
        } else {
            const float cd = __expf(s_acs[63]);
#pragma unroll
            for (int r = 0; r < 16; ++r) { hacc0[r] *= cd; hacc1[r] *= cd; }
            const int tb = ((lane >> 4) & 1) * 32 + (lane & 3) * 8 + (4 * hi + ((lane & 15) >> 2)) * 64;
            s16x4 a0[4], a1[4], b0[4], b1[4], c0[4], c1[4];
#pragma unroll
            for (int ks = 0; ks < 4; ++ks) {
                a0[ks] = vtr(lds + L_B + wid * 4096 + ks * 1024 + tb); a1[ks] = vtr(lds + L_B + wid * 4096 + ks * 1024 + 512 + tb);
                b0[ks] = vtr(lds + L_XW + ks * 1024 + tb); b1[ks] = vtr(lds + L_XW + ks * 1024 + 512 + tb);
                c0[ks] = vtr(lds + L_XW + 4096 + ks * 1024 + tb); c1[ks] = vtr(lds + L_XW + 4096 + ks * 1024 + 512 + tb);
            }
            __builtin_amdgcn_sched_barrier(0);
#pragma unroll
            for (int ks = 0; ks < 4; ++ks) {
                const bf16x8 a = {a0[ks][0], a0[ks][1], a0[ks][2], a0[ks][3], a1[ks][0], a1[ks][1], a1[ks][2], a1[ks][3]};
                const bf16x8 bb = {b0[ks][0], b0[ks][1], b0[ks][2], b0[ks][3], b1[ks][0], b1[ks][1], b1[ks][2], b1[ks][3]};
                const bf16x8 cc = {c0[ks][0], c0[ks][1], c0[ks][2], c0[ks][3], c1[ks][0], c1[ks][1], c1[ks][2], c1[ks][3]};
                hacc0 = __builtin_amdgcn_mfma_f32_32x32x16_bf16(a, bb, hacc0, 0, 0, 0);
                hacc1 = __builtin_amdgcn_mfma_f32_32x32x16_bf16(a, cc, hacc1, 0, 0, 0);
            }
#pragma unroll
            for (int q4 = 0; q4 < 4; ++q4) {
                const int n0 = 32 * wid + 8 * q4 + 4 * hi;
                u32x2 w0, w1; w0.x = cvtpk(hacc0[4 * q4 + 0], hacc0[4 * q4 + 1]); w0.y = cvtpk(hacc0[4 * q4 + 2], hacc0[4 * q4 + 3]);
                w1.x = cvtpk(hacc1[4 * q4 + 0], hacc1[4 * q4 + 1]); w1.y = cvtpk(hacc1[4 * q4 + 2], hacc1[4 * q4 + 3]);
                *(SC_LAS u32x2*)(lds + L_H + r32 * 256 + (((n0 >> 3) ^ (r32 & 15)) << 4) + (n0 & 7) * 2) = w0;
                *(SC_LAS u32x2*)(lds + L_H + (32 + r32) * 256 + (((n0 >> 3) ^ (r32 & 15)) << 4) + (n0 & 7) * 2) = w1;
            }
        }
        SC_BAR();
        {
            const SC_LAS float* yr = (const SC_LAS float*)(lds + L_Y) + orow * 68 + ocg * 8;
            const f32x4 y0 = *(const SC_LAS f32x4*)yr, y1 = *(const SC_LAS f32x4*)(yr + 4);
            float yv[8];
#pragma unroll
            for (int i = 0; i < 4; ++i) {
                const float ya = (i < 2) ? y0[2 * i] : y1[2 * i - 4], yb = (i < 2) ? y0[2 * i + 1] : y1[2 * i - 3];
                yv[2 * i] = (ya + dsk * lo16(xcur[i])) * lo16(zcur[i]); yv[2 * i + 1] = (yb + dsk * hi16(xcur[i])) * hi16(zcur[i]);
            }
            float ss = 0.f;
#pragma unroll
            for (int i = 0; i < 8; ++i) ss += yv[i] * yv[i];
            ss += __shfl_xor(ss, 1); ss += __shfl_xor(ss, 2); ss += __shfl_xor(ss, 4);
            if (ocg == 0) P.ssqp[(rowb + t0 + orow) * 32 + h] = ss;
            u32x4 w; w.x = cvtpk(yv[0], yv[1]); w.y = cvtpk(yv[2], yv[3]); w.z = cvtpk(yv[4], yv[5]); w.w = cvtpk(yv[6], yv[7]);
            if (!P.dry) *(u32x4*)(P.zp + (rowb + t0 + orow) * 2048 + h * 64 + ocg * 8) = w;
        }
    }
    __syncthreads();
#undef SC_LOAD
}
}
namespace mk {
#define GAS __attribute__((address_space(1)))
#define LAS __attribute__((address_space(3)))
typedef unsigned short bf16;
typedef unsigned v4u __attribute__((ext_vector_type(4)));
typedef float f32x4 __attribute__((ext_vector_type(4)));
typedef GAS unsigned gu32;
#define RLX_AGENT __ATOMIC_RELAXED, __HIP_MEMORY_SCOPE_AGENT
constexpr int NWAVES = 8;
constexpr int M = 16384, D = 1024, SEQ = 2048, NB = 8;
constexpr int SSD_NP = 5376, SSD_IN = 5152, SSD_DI = 2048, SSD_LD = 5120;
constexpr int AT_IN = 3072, DFF = 2816;
constexpr size_t MiB = 1u << 20;
constexpr size_t WS_CTL = 0, CTL_ZERO_BYTES = 64 * 1024;
constexpr size_t WS_CONST = 64 * 1024;
constexpr size_t WS_SSQ = 1 * MiB;
constexpr size_t WS_ROPE = 2 * MiB;
constexpr size_t WS_DT = 3 * MiB;
constexpr size_t WS_SSQP = 5 * MiB;
constexpr size_t WS_CP = 1 * MiB + 512 * 1024;
constexpr size_t WS_W = 7 * MiB;
constexpr size_t W_SSD_IN = 0, W_SSD_IN_SZ = (size_t)SSD_NP * D * 2;
constexpr size_t W_SSD_OUT = W_SSD_IN + 2 * W_SSD_IN_SZ, W_SSD_OUT_SZ = (size_t)D * SSD_DI * 2;
constexpr size_t W_AT_IN = W_SSD_OUT + 2 * W_SSD_OUT_SZ, W_AT_IN_SZ = (size_t)AT_IN * D * 2;
constexpr size_t W_AT_OUT = W_AT_IN + 2 * W_AT_IN_SZ, W_AT_OUT_SZ = (size_t)D * D * 2;
constexpr size_t W_UP = W_AT_OUT + 2 * W_AT_OUT_SZ, W_UP_SZ = (size_t)2 * DFF * D * 2;
constexpr size_t W_DOWN = W_UP + 4 * W_UP_SZ, W_DOWN_SZ = (size_t)D * DFF * 2;
constexpr size_t W_TOTAL = W_DOWN + 4 * W_DOWN_SZ;
constexpr size_t WS_XB = ((WS_W + W_TOTAL + MiB - 1) / MiB) * MiB;
constexpr size_t XB_PAD_FRONT = 4 * D * 2, XB_BYTES = (size_t)(M + 260) * D * 2;
constexpr size_t WS_BIG = ((WS_XB + XB_BYTES + MiB - 1) / MiB) * MiB;
constexpr size_t BIG_BYTES = (size_t)M * SSD_LD * 2;
constexpr size_t WS_DBG = WS_BIG + BIG_BYTES;
constexpr size_t WS_END = WS_DBG;
static_assert(WS_END <= 352 * MiB, "workspace map exceeds the guaranteed 352 MiB");
constexpr int CW_BAR = 1024;
constexpr int RING_BYTES = 131072, EPI_OFF = RING_BYTES, EPI_BYTES = 26624, MISC_OFF = EPI_OFF + EPI_BYTES;
constexpr int LDS_BYTES = 158720;
static_assert(MISC_OFF + 1024 <= LDS_BYTES && attn::LDS_BYTES <= RING_BYTES && scan::LDS_BYTES <= RING_BYTES, "LDS map");

#define LDS_WAIT() asm volatile("s_waitcnt lgkmcnt(0)" ::: "memory")
__device__ __forceinline__ unsigned f2bf(float f) { unsigned u = __builtin_bit_cast(unsigned, f); return (u + 0x7fffu + ((u >> 16) & 1u)) >> 16; }
__device__ __forceinline__ unsigned pk2(float lo, float hi) { return f2bf(lo) | (f2bf(hi) << 16); }

#define XB_TMO      128
#define XB_XCNT(j)  (256  + 64 * (j))
#define XB_XSUB(j)  (1280 + 64 * (j))
#define XB_XGEN(j)  (2304 + 64 * (j))
#define XB_TOP      3328
#define XB_TOPGEN   3392
#define XCD_BAR_WORDS 3456
#define XB_SPIN_CAP (1u << 20)
__device__ __forceinline__ unsigned xb_ld(unsigned* p)              { return __hip_atomic_load(p, __ATOMIC_RELAXED, __HIP_MEMORY_SCOPE_AGENT); }
__device__ __forceinline__ unsigned xb_add(unsigned* p, unsigned v) { return __hip_atomic_fetch_add(p, v, __ATOMIC_RELAXED, __HIP_MEMORY_SCOPE_AGENT); }
__device__ __forceinline__ unsigned xb_xcc_id() { return (unsigned)__builtin_amdgcn_s_getreg((3 << 11) | 20) & 0xFu; }
#define XB_SPIN(cond, bar) do { unsigned _sp = 0; while (cond) { __builtin_amdgcn_s_sleep(1); \
    if ((++_sp & 255u) == 0u) { if (xb_ld(&(bar)[XB_TMO])) break; if (_sp > XB_SPIN_CAP) { atomicAdd(&(bar)[XB_TMO], 1u); break; } } } } while (0)
struct XcdBarrier { unsigned* bar; unsigned x; volatile LAS unsigned* st; };
__device__ __forceinline__ XcdBarrier xcd_barrier_post(unsigned* bar, volatile LAS unsigned* st) {
    XcdBarrier b; b.bar = bar; b.x = xb_xcc_id(); b.st = st;
    if (threadIdx.x == 0) (void)xb_add(&bar[XB_XCNT(b.x)], 1u);
    return b;
}
__device__ __forceinline__ void xcd_barrier_complete(unsigned* bar, unsigned x, unsigned& nloc, unsigned& nx) {
    const unsigned G = gridDim.x * gridDim.y * gridDim.z;
    unsigned sum, cnt, mine, sp = 0u;
    for (;;) {
        sum = 0u; cnt = 0u; mine = 0u;
#pragma unroll
        for (unsigned j = 0; j < 16; ++j) { const unsigned c = xb_ld(&bar[XB_XCNT(j)]); sum += c; cnt += (c > 0u) ? 1u : 0u; mine = (j == x) ? c : mine; }
        if (sum == G) break;
        __builtin_amdgcn_s_sleep(1);
        if ((++sp & 255u) == 0u) { if (xb_ld(&bar[XB_TMO])) break; if (sp > XB_SPIN_CAP) { atomicAdd(&bar[XB_TMO], 1u); break; } }
    }
    nloc = mine > 0u ? mine : 1u; nx = cnt > 0u ? cnt : 1u;
}
__device__ __forceinline__ void xcd_barrier(const XcdBarrier& b) {
    asm volatile("s_waitcnt vmcnt(0)" ::: "memory");
    __syncthreads();
    if (threadIdx.x == 0) {
        unsigned* bar = b.bar; asm volatile("" : "+s"(bar));
        __builtin_amdgcn_s_waitcnt(0);
        unsigned nloc = b.st[0], nx = b.st[1];
        if (nloc == 0u) { xcd_barrier_complete(bar, b.x, nloc, nx); b.st[0] = nloc; b.st[1] = nx; }
        const unsigned old = xb_add(&bar[XB_XSUB(b.x)], 1u);
        const unsigned gen = old / nloc;
        if (old + 1u == (gen + 1u) * nloc) {
            __builtin_amdgcn_fence(__ATOMIC_RELEASE, "agent");
            asm volatile("s_waitcnt vmcnt(0)" ::: "memory");
            const unsigned og = xb_add(&bar[XB_TOP], 1u);
            const unsigned tg = og / nx;
            if (og + 1u == (tg + 1u) * nx) xb_add(&bar[XB_TOPGEN], 1u);
            else XB_SPIN(xb_ld(&bar[XB_TOPGEN]) == tg, bar);
            __builtin_amdgcn_fence(__ATOMIC_ACQUIRE, "agent");
            xb_add(&bar[XB_XGEN(b.x)], 1u);
            asm volatile("s_waitcnt vmcnt(0)" ::: "memory");
        } else {
            XB_SPIN(xb_ld(&bar[XB_XGEN(b.x)]) == gen, bar);
            __builtin_amdgcn_fence(__ATOMIC_ACQUIRE, "agent");
            asm volatile("s_waitcnt vmcnt(0)" ::: "memory");
        }
    }
    __syncthreads();
}

__device__ __forceinline__ unsigned long long ldarg(LAS unsigned long long* AP, int i) {
    asm volatile("" : "+s"(i));
    const unsigned long long v = AP[i];
    return ((unsigned long long)(unsigned)__builtin_amdgcn_readfirstlane((int)(v >> 32)) << 32) | (unsigned long long)(unsigned)__builtin_amdgcn_readfirstlane((int)v);
}
struct Args { const void* in[25]; float* out; unsigned char* ws; int ph_lo, ph_hi; int dbg, pad; };

__device__ __forceinline__ float wave_sum(float v) {
#pragma unroll
    for (int o = 1; o < 64; o <<= 1) v += __shfl_xor(v, o);
    return v;
}
template <class RowMap>
__device__ __forceinline__ void transpose_item(const float* W, int K, int N, const float* gain, int gmask, float gscale, bf16* WT, const RowMap& rm, LAS float* scr, int item, int lane) {
    const int nblk = N / 32, kb = item / nblk, nb = item % nblk, k0 = 64 * kb, n0 = 32 * nb;
    {
        const int rs = lane >> 3, c4 = lane & 7;
        f32x4 v[8]; float gv[8];
#pragma unroll
        for (int i = 0; i < 8; ++i) { const int kk = 8 * i + rs; v[i] = *(const f32x4*)(W + (size_t)(k0 + kk) * N + n0 + 4 * c4); gv[i] = gain ? gain[(k0 + kk) & gmask] * gscale : 1.0f; }
#pragma unroll
        for (int i = 0; i < 8; ++i) { const int kk = 8 * i + rs; LAS float* d = scr + kk * 33 + 4 * c4; d[0] = v[i][0] * gv[i]; d[1] = v[i][1] * gv[i]; d[2] = v[i][2] * gv[i]; d[3] = v[i][3] * gv[i]; }
    }
    LDS_WAIT(); asm volatile("" ::: "memory");
    const int c = lane & 7;
#pragma unroll
    for (int j = 0; j < 4; ++j) { const int n = (lane >> 3) + 8 * j; const LAS float* s = scr + (8 * c) * 33 + n;
        v4u o; o.x = pk2(s[0 * 33], s[1 * 33]); o.y = pk2(s[2 * 33], s[3 * 33]); o.z = pk2(s[4 * 33], s[5 * 33]); o.w = pk2(s[6 * 33], s[7 * 33]);
        *(GAS v4u*)(WT + (size_t)rm(n0 + n) * K + k0 + 8 * c) = o; }
    LDS_WAIT(); asm volatile("" ::: "memory");
}
struct RowId { __device__ __forceinline__ int operator()(int n) const { return n; } };
struct RowUp { __device__ __forceinline__ int operator()(int n) const { const int u = n >= DFF, ch = u ? n - DFF : n; return (ch >> 7) * 256 + u * 128 + (ch & 127); } };

__global__ void __launch_bounds__(NWAVES * 64, 2) mega_fwd(Args args) {
    extern __shared__ __attribute__((aligned(16))) unsigned char lds_raw[];
    LAS unsigned char* lds = (LAS unsigned char*)lds_raw;
    volatile LAS unsigned* MISC = (volatile LAS unsigned*)(lds + MISC_OFF);
    const int G = gridDim.x; const int bx = blockIdx.x; const int vcu = (G % 8 == 0) ? (bx % 8) * (G / 8) + bx / 8 : bx;
    gu32* ctl = (gu32*)(args.ws + WS_CTL);
    if (threadIdx.x < 64) MISC[threadIdx.x] = 0u;
    __syncthreads();
    XcdBarrier bar = xcd_barrier_post((unsigned*)ctl + CW_BAR, MISC + 8);
#define GRID_BAR() xcd_barrier(bar)
    LAS unsigned long long* AP = (LAS unsigned long long*)(lds + MISC_OFF + 256);
    if (threadIdx.x < 27) AP[threadIdx.x] = ((const unsigned long long*)&args)[threadIdx.x];
    __syncthreads();
#define ARGP(T, i) ((T)(GAS void*)ldarg(AP, i))
#define x_in   ARGP(const float*, 0)
#define pos    ARGP(const int*, 1)
#define nmg    ARGP(const float*, 2)
#define nfg    ARGP(const float*, 3)
#define s_inw  ARGP(const float*, 4)
#define s_cw   ARGP(const float*, 5)
#define s_cb   ARGP(const float*, 6)
#define s_dtb  ARGP(const float*, 7)
#define s_alog ARGP(const float*, 8)
#define s_d    ARGP(const float*, 9)
#define s_ng   ARGP(const float*, 10)
#define s_ow   ARGP(const float*, 11)
#define a_inw  ARGP(const float*, 12)
#define a_qg   ARGP(const float*, 13)
#define a_kg   ARGP(const float*, 14)
#define a_lq1  ARGP(const float*, 15)
#define a_lk1  ARGP(const float*, 16)
#define a_lq2  ARGP(const float*, 17)
#define a_lk2  ARGP(const float*, 18)
#define a_sg   ARGP(const float*, 19)
#define a_ow   ARGP(const float*, 20)
#define f_uw   ARGP(const float*, 21)
#define f_cw   ARGP(const float*, 22)
#define f_cb   ARGP(const float*, 23)
#define f_dw   ARGP(const float*, 24)
#define xout   ARGP(float*, 25)
#define ws     ARGP(unsigned char*, 26)
#define cst    ((float*)(ws + WS_CONST))
#define SSQ    ((float*)(ws + WS_SSQ))
#define ROPE   ((float*)(ws + WS_ROPE))
#define DT     ((float*)(ws + WS_DT))
#define SSQP   ((float*)(ws + WS_SSQP))
#define Wb     ((bf16*)(ws + WS_W))
#define XB     ((bf16*)(ws + WS_XB + XB_PAD_FRONT))
#define BIG    ((bf16*)(ws + WS_BIG))
#define CPT    ((float*)(ws + WS_CP))
#define ZPL    ((bf16*)(ws + WS_BIG))
#define XBCPL  ((bf16*)(ws + WS_BIG + (size_t)M * SSD_DI * 2))
    const int lo = args.ph_lo, hi = args.ph_hi;
    int phase = 0;
#define IN_PHASE() (phase >= lo && phase < hi)
#define END_PHASE(ty) do { if (IN_PHASE() && phase + 1 < hi) GRID_BAR(); ++phase; } while (0)
#ifndef PROBE_EPI_MODE
#define PROBE_EPI_MODE 0
#endif
#ifdef PROBE_DUP
#define REP_BEGIN(ty) _Pragma("unroll") for (int rep_ = ((ty) == PROBE_DUP ? 0 : 1); rep_ < 2; ++rep_) { const int dry = (rep_ == 0);
#define REP_END() if (dry) GRID_BAR(); }
#else
#define REP_BEGIN(ty) { const int dry = 0;
#define REP_END() }
#endif

    if (IN_PHASE()) { REP_BEGIN(0)
        int tid = threadIdx.x; asm volatile("" : "+v"(tid));
        const int lane = tid & 63, wave = __builtin_amdgcn_readfirstlane(tid >> 6);
        LAS float* scr = (LAS float*)(lds + wave * 16384);
        const int gw = vcu * NWAVES + wave, NGW = G * NWAVES;
        constexpr int I_SI = (D / 64) * (SSD_IN / 32), I_SO = (SSD_DI / 64) * (D / 32), I_AI = (D / 64) * (AT_IN / 32), I_AO = (D / 64) * (D / 32), I_UP = (D / 64) * (2 * DFF / 32), I_DN = (DFF / 64) * (D / 32);
        constexpr int NITEMS = 2 * I_SI + 2 * I_SO + 2 * I_AI + 2 * I_AO + 4 * I_UP + 4 * I_DN;
        for (int it = gw; it < NITEMS; it += NGW) {
            int r = it;
            if (r < 2 * I_SI) { const int j = r / I_SI; transpose_item(s_inw + (size_t)j * D * SSD_IN, D, SSD_IN, nmg + (2 * j) * D, 1023, 1.0f, (bf16*)((char*)Wb + W_SSD_IN + j * W_SSD_IN_SZ), RowId(), scr, r % I_SI, lane); continue; } r -= 2 * I_SI;
            if (r < 2 * I_SO) { const int j = r / I_SO; transpose_item(s_ow + (size_t)j * SSD_DI * D, SSD_DI, D, s_ng + j * SSD_DI, 2047, 1.0f, (bf16*)((char*)Wb + W_SSD_OUT + j * W_SSD_OUT_SZ), RowId(), scr, r % I_SO, lane); continue; } r -= 2 * I_SO;
            if (r < 2 * I_AI) { const int j = r / I_AI; transpose_item(a_inw + (size_t)j * D * AT_IN, D, AT_IN, nmg + (2 * j + 1) * D, 1023, 1.0f, (bf16*)((char*)Wb + W_AT_IN + j * W_AT_IN_SZ), RowId(), scr, r % I_AI, lane); continue; } r -= 2 * I_AI;
            if (r < 2 * I_AO) { const int j = r / I_AO; const float li = 0.8f - 0.6f * expf(-0.3f * (float)(2 * j + 1));
                transpose_item(a_ow + (size_t)j * D * D, D, D, a_sg + j * 128, 127, 1.0f - li, (bf16*)((char*)Wb + W_AT_OUT + j * W_AT_OUT_SZ), RowId(), scr, r % I_AO, lane); continue; } r -= 2 * I_AO;
            if (r < 4 * I_UP) { const int j = r / I_UP; transpose_item(f_uw + (size_t)j * D * 2 * DFF, D, 2 * DFF, nfg + j * D, 1023, 1.0f, (bf16*)((char*)Wb + W_UP + j * W_UP_SZ), RowUp(), scr, r % I_UP, lane); continue; } r -= 4 * I_UP;
            { const int j = r / I_DN; transpose_item(f_dw + (size_t)j * DFF * D, DFF, D, nullptr, 0, 1.0f, (bf16*)((char*)Wb + W_DOWN + j * W_DOWN_SZ), RowId(), scr, r % I_DN, lane); }
        }
        for (int j = 0; j < 2; ++j) { v4u* p = (v4u*)((char*)Wb + W_SSD_IN + j * W_SSD_IN_SZ + (size_t)SSD_IN * D * 2); const int n16 = (SSD_NP - SSD_IN) * D * 2 / 16;
            for (int i = vcu * 512 + tid; i < n16; i += G * 512) p[i] = (v4u){0u, 0u, 0u, 0u}; }
        { v4u* p = (v4u*)(ws + WS_XB); for (int i = vcu * 512 + tid; i < (int)(XB_PAD_FRONT / 16); i += G * 512) p[i] = (v4u){0u, 0u, 0u, 0u};
          v4u* q = (v4u*)((char*)XB + (size_t)M * D * 2); for (int i = vcu * 512 + tid; i < 256 * D * 2 / 16; i += G * 512) q[i] = (v4u){0u, 0u, 0u, 0u}; }
        for (int m = gw; m < M; m += NGW) {
            const f32x4* xr = (const f32x4*)(x_in + (size_t)m * D) + lane; float s = 0.f;
            unsigned long long* o8 = (unsigned long long*)(XB + (size_t)m * D) + lane;
#pragma unroll
            for (int j = 0; j < 4; ++j) { const f32x4 v = xr[64 * j]; s += (v[0] * v[0] + v[1] * v[1]) + (v[2] * v[2] + v[3] * v[3]); o8[64 * j] = (unsigned long long)pk2(v[0], v[1]) | ((unsigned long long)pk2(v[2], v[3]) << 32); }
            s = wave_sum(s);
            if (lane < 4) SSQ[(size_t)m * 4 + lane] = (lane == 0) ? s : 0.f;
            if (lane >= 16 && lane < 32) { const int i = lane & 7; const float invf = powf(500000.0f, -(float)(2 * i) / 16.0f); const float ang = (float)pos[m] * invf; ROPE[(size_t)m * 16 + (lane - 16)] = (lane < 24) ? cosf(ang) : sinf(ang); }
        }
        for (int i = vcu * 512 + tid; i < 2 * SSD_NP; i += G * 512) {
            const int j = i / SSD_NP, c = i % SSD_NP; float pb = 0.f, p0 = 0.f, p1 = 0.f, p2 = 0.f, p3 = 0.f;
            if (c < 2048) p3 = 1.f;
            else if (c < 5120) { const int ch = c - 2048; const float* w = s_cw + (size_t)j * 4 * 3072; pb = s_cb[(size_t)j * 3072 + ch]; p0 = w[ch]; p1 = w[3072 + ch]; p2 = w[2 * 3072 + ch]; p3 = w[3 * 3072 + ch]; }
            else if (c < 5152) { pb = s_dtb[j * 32 + (c - 5120)]; p3 = 1.f; }
            float* t = CPT + (size_t)j * 5 * SSD_NP; t[c] = pb; t[SSD_NP + c] = p0; t[2 * SSD_NP + c] = p1; t[3 * SSD_NP + c] = p2; t[4 * SSD_NP + c] = p3;
        }
        if (bx == 0 && wave == 0) {
            for (int j = 0; j < 2; ++j) {
                float mq = fabsf(a_qg[j * 64 + lane]), mkk = fabsf(a_kg[j * 64 + lane]);
                float d1 = a_lq1[j * 64 + lane] * a_lk1[j * 64 + lane], d2 = a_lq2[j * 64 + lane] * a_lk2[j * 64 + lane];
#pragma unroll
                for (int o = 1; o < 64; o <<= 1) { mq = fmaxf(mq, __shfl_xor(mq, o)); mkk = fmaxf(mkk, __shfl_xor(mkk, o)); d1 += __shfl_xor(d1, o); d2 += __shfl_xor(d2, o); }
                const float li = 0.8f - 0.6f * expf(-0.3f * (float)(2 * j + 1));
                if (lane == 0) { cst[j] = mq * mkk * 64.0f * 0.125f * 1.4426950408889634f * 1.002f + 0.01f; cst[2 + j] = expf(d1) - expf(d2) + li; }
            }
        }
    REP_END() }
    END_PHASE(0);

    for (int layer = 0; layer < 4; ++layer) {
        const int j = layer >> 1;
        const float* xsrc = (layer == 0) ? x_in : xout;
        if ((layer & 1) == 0) {
            if (IN_PHASE()) { REP_BEGIN(1)
                pg8::Gemm g{XB, (const bf16*)((const char*)Wb + W_SSD_IN + j * W_SSD_IN_SZ), D, D, 253, -3};
                pg8::StaticOrder S; S.init(65, SSD_NP / 256, G, bx);
                epi::EpiSsdConv E{ZPL, XBCPL, DT, SSQ, CPT + (size_t)j * 5 * SSD_NP};
                pg8::gemm_phase(lds, lds + EPI_OFF, g, S, E);
            REP_END() }
            END_PHASE(1);
            if (IN_PHASE()) { REP_BEGIN(2)
                scan::Params sp{XBCPL, ZPL, DT, s_alog + j * 32, s_d + j * 32, SSQP, dry};
                for (int u = vcu; u < NB * 32; u += G) scan::unit(sp, u >> 5, u & 31, (LAS char*)lds);
            REP_END() }
            END_PHASE(2);
            if (IN_PHASE()) { REP_BEGIN(4)
                pg8::Gemm g{ZPL, (const bf16*)((const char*)Wb + W_SSD_OUT + j * W_SSD_OUT_SZ), SSD_DI, SSD_DI, 256, 0};
                pg8::StaticOrder S; S.init(M / 256, D / 256, G, bx);
                epi::EpiResidualG E{xsrc, xout, XB, SSQ, SSQP, dry};
                pg8::gemm_phase(lds, lds + EPI_OFF, g, S, E);
            REP_END() }
            END_PHASE(4);
        } else {
            if (IN_PHASE()) { REP_BEGIN(5)
                pg8::Gemm g{XB, (const bf16*)((const char*)Wb + W_AT_IN + j * W_AT_IN_SZ), D, D, 256, 0};
                pg8::StaticOrder S; S.init(M / 256, AT_IN / 256, G, bx);
                epi::EpiQKV E{BIG, SSQ, a_qg + j * 64, a_kg + j * 64, ROPE};
                pg8::gemm_phase(lds, lds + EPI_OFF, g, S, E);
            REP_END() }
            END_PHASE(5);
            if (IN_PHASE()) { REP_BEGIN(6)
                attn::Params ap{BIG, cst[j], cst[2 + j], dry};
                for (int pi = vcu; pi < 512; pi += G) {
                    const int bh = pi >> 3, s = pi & 7;
                    attn::unit(ap, bh >> 3, bh & 7, s, (LAS char*)lds);
                    attn::unit(ap, bh >> 3, bh & 7, 15 - s, (LAS char*)lds);
                }
            REP_END() }
            END_PHASE(6);
            if (IN_PHASE()) { REP_BEGIN(7)
                pg8::Gemm g{BIG, (const bf16*)((const char*)Wb + W_AT_OUT + j * W_AT_OUT_SZ), AT_IN, D, 256, 0};
                pg8::StaticOrder S; S.init(M / 256, D / 256, G, bx);
                epi::EpiResidual E{xsrc, xout, XB, SSQ, dry};
                pg8::gemm_phase(lds, lds + EPI_OFF, g, S, E);
            REP_END() }
            END_PHASE(7);
        }
        if (IN_PHASE()) { REP_BEGIN(8)
            pg8::Gemm g{XB, (const bf16*)((const char*)Wb + W_UP + layer * W_UP_SZ), D, D, 254, -2};
            pg8::StaticOrder S; S.init(65, 2 * DFF / 256, G, bx);
            epi::EpiConvGate E{BIG, SSQ, f_cw + (size_t)layer * 3 * 2 * DFF, f_cb + (size_t)layer * 2 * DFF, dry * PROBE_EPI_MODE};
            pg8::gemm_phase(lds, lds + EPI_OFF, g, S, E);
        REP_END() }
        END_PHASE(8);
        if (IN_PHASE()) { REP_BEGIN(9)
            pg8::Gemm g{BIG, (const bf16*)((const char*)Wb + W_DOWN + layer * W_DOWN_SZ), DFF, DFF, 256, 0};
            pg8::StaticOrder S; S.init(M / 256, D / 256, G, bx);
            epi::EpiResidual E{xout, xout, XB, SSQ, dry};
            pg8::gemm_phase(lds, lds + EPI_OFF, g, S, E);
        REP_END() }
        END_PHASE(9);
    }
#ifdef PROBE_EXTRA_BARS
    for (int i_ = 0; i_ < PROBE_EXTRA_BARS; ++i_) GRID_BAR();
#endif
}
#undef x_in
#undef pos
#undef nmg
#undef nfg
#undef s_inw
#undef s_cw
#undef s_cb
#undef s_dtb
#undef s_alog
#undef s_d
#undef s_ng
#undef s_ow
#undef a_inw
#undef a_qg
#undef a_kg
#undef a_lq1
#undef a_lk1
#undef a_lq2
#undef a_lk2
#undef a_sg
#undef a_ow
#undef f_uw
#undef f_cw
#undef f_cb
#undef f_dw
#undef xout
#undef ws
#undef cst
#undef SSQ
#undef ROPE
#undef DT
#undef SSQP
#undef Wb
#undef XB
#undef BIG
#undef CPT
#undef ZPL
#undef XBCPL
#undef ARGP
constexpr int N_PHASES = 1 + 2 * 5 + 2 * 5;

static int g_grid = 0;
static void launch(void* const* d_in, float* d_out, void* d_ws, int ph_lo, int ph_hi, hipStream_t stream) {
    if (g_grid == 0) {
        int dev = 0, cus = 0;
        if (hipGetDevice(&dev) != hipSuccess || hipDeviceGetAttribute(&cus, hipDeviceAttributeMultiprocessorCount, dev) != hipSuccess) { fprintf(stderr, "device query failed\n"); g_grid = -1; return; }
        if (hipFuncSetAttribute((const void*)mega_fwd, hipFuncAttributeMaxDynamicSharedMemorySize, LDS_BYTES) != hipSuccess) { fprintf(stderr, "hipFuncSetAttribute failed\n"); g_grid = -1; return; }
        int per_cu = 0;
        (void)hipOccupancyMaxActiveBlocksPerMultiprocessor(&per_cu, (const void*)mega_fwd, NWAVES * 64, LDS_BYTES);
        (void)hipGetLastError();
        g_grid = cus;
        fprintf(stderr, "mega_fwd: %d CUs, occupancy query %d per CU\n", cus, per_cu);
    }
    if (g_grid < 0) return;
    (void)hipMemsetAsync((char*)d_ws + WS_CTL, 0, CTL_ZERO_BYTES, stream);
    Args a{};
    for (int i = 0; i < 25; ++i) a.in[i] = d_in[i];
    a.out = d_out; a.ws = (unsigned char*)d_ws; a.ph_lo = ph_lo; a.ph_hi = ph_hi;
    void* params[] = {&a};
    hipError_t e = hipLaunchCooperativeKernel((const void*)mega_fwd, dim3(g_grid), dim3(NWAVES * 64), params, LDS_BYTES, stream);
    if (e != hipSuccess) fprintf(stderr, "cooperative launch failed: %s (grid %d)\n", hipGetErrorString(e), g_grid);
}
}
extern "C" void kernel_launch(void* const* d_in, const int* in_sizes, int n_in, void* d_out, int out_size, void* d_ws, size_t ws_size, hipStream_t stream) {
    (void)in_sizes; (void)n_in; (void)out_size; (void)ws_size;
    mk::launch(d_in, (float*)d_out, d_ws, 0, mk::N_PHASES, stream);
}
```

```cpp
#include <hip/hip_runtime.h>
#include <stdint.h>
#include <math.h>
#include <cstdio>
namespace pg8 {
#define PG8_LAS __attribute__((address_space(3)))
typedef unsigned short bf16_t;
typedef short bf16x8 __attribute__((ext_vector_type(8)));
typedef float f32x4 __attribute__((ext_vector_type(4)));
typedef unsigned u32x4 __attribute__((ext_vector_type(4)));
typedef unsigned u32x2 __attribute__((ext_vector_type(2)));
constexpr int BM = 256, BK = 64, HALF = 128, HTB = HALF * BK * 2  , STAGE_BYTES = 8 * HTB, NXCD = 8, WGM = 8;

__host__ __device__ __forceinline__ int lds_byte(int r, int c) { const int st = (r >> 4) * 2 + (c >> 5), rr = r & 15, cc = c & 31, ob = rr * 64 + cc * 2; return st * 1024 + (ob ^ (((ob >> 9) & 1) << 5)); }
__host__ __device__ __forceinline__ void stage_rc(int b, int& R, int& C) { const int st = b / 1024, sb = b % 1024, swz = sb ^ (((sb >> 9) & 1) << 5); R = (st >> 1) * 16 + swz / 64; C = (st & 1) * 32 + (swz % 64) / 2; }
__host__ __device__ __forceinline__ int perm32(int rho) { const int n = rho >> 4, i = rho & 15; return 8 * (i >> 2) + 4 * n + (i & 3); }

struct Unit { int pm, pn; };
struct Gemm { const bf16_t* A; const bf16_t* Bt; int lda, K, a_stride, a_off; };

struct StaticOrder {
    int nM, nN, nwg, G, c;
    __host__ __device__ void init(int nM_, int nN_, int G_, int c_) { nM = nM_; nN = nN_; nwg = nM * nN; G = G_; c = c_; }
    __host__ __device__ bool next(int i, Unit& u) const {
        const long L = (long)i * G + c; if (L >= nwg) return false;
        int wgid = (int)L; { const int q = nwg / NXCD, r = nwg % NXCD, xcd = wgid % NXCD, off = wgid / NXCD; wgid = (xcd < r ? xcd * (q + 1) : r * (q + 1) + (xcd - r) * q) + off; }
        const int nig = WGM * nN, gid = wgid / nig, fm = gid * WGM, gsz = (nM - fm) < WGM ? (nM - fm) : WGM;
        u.pm = fm + ((wgid % nig) % gsz); u.pn = (wgid % nig) / gsz; return true;
    }
};

__device__ __forceinline__ unsigned cvt_pk_bf16(float lo, float hi) { unsigned r; asm volatile("v_cvt_pk_bf16_f32 %0, %1, %2" : "=v"(r) : "v"(lo), "v"(hi)); return r; }

template <class Epi, class Sched>
__device__ __forceinline__ void gemm_phase(PG8_LAS unsigned char* lds, PG8_LAS unsigned char* elds, const Gemm g, const Sched& S, const Epi& E) {
    int tid = threadIdx.x; asm volatile("" : "+v"(tid));
    const int wid = __builtin_amdgcn_readfirstlane(tid >> 6), lane = tid & 63, wr = wid >> 2, wc = wid & 3, fr = lane & 15, fq = lane >> 4;
    const int K = g.K, nt = K / BK, lda = g.lda;
    unsigned voffA[2], voffB[2]; int aoff, boff;
#define PG8_LANECONST() do { int t_ = threadIdx.x; asm volatile("" : "+v"(t_)); const int fr_ = t_ & 15, fq_ = (t_ >> 4) & 3; \
        _Pragma("unroll") for (int i = 0; i < 2; ++i) { int R, C; stage_rc(t_ * 16 + i * 8192, R, C); const int Rb = Epi::PERM ? ((R & ~31) + perm32(R & 31)) : R; \
            const int Ra = Epi::ROWIL ? ((R & ~63) | ((R & 15) << 2) | ((R >> 4) & 3)) : R;     \
            voffA[i] = (unsigned)(Ra * lda + C) * 2u; voffB[i] = (unsigned)(Rb * K + C) * 2u; } \
        aoff = lds_byte(wr * 64 + fr_, fq_ * 8); boff = lds_byte(wc * 32 + fr_, fq_ * 8); } while (0)
    PG8_LANECONST();
    const size_t kstep = (size_t)(BK * 2);
    const size_t hstepA = (size_t)HALF * lda * 2, hstepB = (size_t)HALF * K * 2;
    const size_t tstepB = 2 * hstepB;
    const unsigned ldsw = (unsigned)wid * 1024u;
#define PG8_SA(b, h) (((b) * 2 + (h)) * HTB)
#define PG8_SB(b, h) ((4 + (b) * 2 + (h)) * HTB)
#define PG8_STAGE(bufoff, gbase, voff) do { _Pragma("unroll") for (int _i = 0; _i < 2; ++_i) \
        __builtin_amdgcn_global_load_lds((const unsigned*)((const char*)(gbase) + (voff)[_i]), (PG8_LAS unsigned*)(lds + (bufoff) + ldsw + _i * 8192), 16, 0, 0); } while (0)
#define PG8_LDA(dst, b, h) do { _Pragma("unroll") for (int m = 0; m < 4; ++m) _Pragma("unroll") for (int k = 0; k < 2; ++k) dst[m][k] = *(const PG8_LAS bf16x8*)(lds + PG8_SA(b, h) + aoff + m * 2048 + k * 1024); } while (0)
#define PG8_LDB(dst, b, h) do { _Pragma("unroll") for (int n = 0; n < 2; ++n) _Pragma("unroll") for (int k = 0; k < 2; ++k) dst[n][k] = *(const PG8_LAS bf16x8*)(lds + PG8_SB(b, h) + boff + n * 2048 + k * 1024); } while (0)
#define PG8_MMA(ai, bj, At, Bt) do { __builtin_amdgcn_s_setprio(1); _Pragma("unroll") for (int m = 0; m < 4; ++m) _Pragma("unroll") for (int n = 0; n < 2; ++n) _Pragma("unroll") for (int k = 0; k < 2; ++k) \
        acc[ai][bj][m][n] = __builtin_amdgcn_mfma_f32_16x16x32_bf16(Bt[n][k], At[m][k], acc[ai][bj][m][n], 0, 0, 0); __builtin_amdgcn_s_setprio(0); } while (0)
#define PG8_WAIT_V(n) asm volatile("s_waitcnt vmcnt(" #n ")" ::: "memory")
#define PG8_WAIT_L(n) asm volatile("s_waitcnt lgkmcnt(" #n ")" ::: "memory")
#define PG8_BAR __builtin_amdgcn_s_barrier()
#define PG8_SCHED __builtin_amdgcn_sched_barrier(0)
    Unit cur, nxt; int ui = 0;
    if (!S.next(0, cur)) return;
    if constexpr (Epi::KGROUP) E.unit_begin(cur, elds);
    float zf = 0.f; asm volatile("" : "+v"(zf));
    f32x4 acc[2][2][4][2];
#pragma unroll
    for (int a = 0; a < 2; ++a)
#pragma unroll
        for (int b = 0; b < 2; ++b)
#pragma unroll
            for (int m = 0; m < 4; ++m)
#pragma unroll
                for (int n = 0; n < 2; ++n) acc[a][b][m][n] = (f32x4){zf, zf, zf, zf};
    bf16x8 At[4][2], B0[2][2], B1[2][2];
    const char* cA = (const char*)g.A + ((long)cur.pm * g.a_stride + g.a_off) * (long)lda * 2; const char* cB = (const char*)g.Bt + (size_t)cur.pn * tstepB;
    PG8_STAGE(PG8_SB(0, 0), cB, voffB); PG8_STAGE(PG8_SB(0, 1), cB + hstepB, voffB); PG8_STAGE(PG8_SA(0, 0), cA, voffA); PG8_STAGE(PG8_SA(0, 1), cA + hstepA, voffA);
    if (wr == 1) PG8_BAR;
    PG8_WAIT_V(2); PG8_BAR;
    PG8_STAGE(PG8_SB(1, 0), cB + kstep, voffB); PG8_STAGE(PG8_SA(1, 0), cA + kstep, voffA); PG8_STAGE(PG8_SB(1, 1), cB + hstepB + kstep, voffB);
    PG8_WAIT_V(6); PG8_BAR;
    for (;;) {
        const bool has_next = S.next(ui + 1, nxt);
        const char* nA = has_next ? (const char*)g.A + ((long)nxt.pm * g.a_stride + g.a_off) * (long)lda * 2 : cA; const char* nB = has_next ? (const char*)g.Bt + (size_t)nxt.pn * tstepB : cB;
        for (int t = 0; t < nt; t += 2) {
            const bool last = (t == nt - 2);
            const char* a1 = cA + (size_t)(t + 1) * kstep;
            const char* a2 = last ? nA : cA + (size_t)(t + 2) * kstep; const char* b2 = last ? nB : cB + (size_t)(t + 2) * kstep;
            const char* a3 = a2 + kstep; const char* b3 = b2 + kstep;
            if constexpr (Epi::KGROUP) { if (t > 0 && (t & 7) == 0) E.kgroup(acc, t >> 3, wr, elds); }
            PG8_LDB(B0, 0, 0); PG8_LDB(B1, 0, 1); PG8_SCHED; PG8_LDA(At, 0, 0); PG8_STAGE(PG8_SA(1, 1), a1 + hstepA, voffA);
            PG8_WAIT_V(8); PG8_WAIT_L(0); PG8_BAR; PG8_MMA(0, 0, At, B0); PG8_MMA(0, 1, At, B1); PG8_BAR; PG8_SCHED;
            PG8_LDA(At, 0, 1); PG8_STAGE(PG8_SB(0, 0), b2, voffB); PG8_STAGE(PG8_SB(0, 1), b2 + hstepB, voffB); PG8_STAGE(PG8_SA(0, 0), a2, voffA);
            PG8_WAIT_V(8); PG8_WAIT_L(0); PG8_BAR; PG8_MMA(1, 0, At, B0); PG8_MMA(1, 1, At, B1); PG8_BAR; PG8_SCHED;
            PG8_LDB(B0, 1, 0); PG8_LDB(B1, 1, 1); PG8_SCHED; PG8_LDA(At, 1, 0); PG8_STAGE(PG8_SA(0, 1), a2 + hstepA, voffA);
            PG8_WAIT_V(8); PG8_WAIT_L(0); PG8_BAR; PG8_MMA(0, 0, At, B0); PG8_MMA(0, 1, At, B1); PG8_BAR; PG8_SCHED;
            PG8_LDA(At, 1, 1); PG8_STAGE(PG8_SB(1, 0), b3, voffB); PG8_STAGE(PG8_SB(1, 1), b3 + hstepB, voffB); PG8_STAGE(PG8_SA(1, 0), a3, voffA);
            PG8_WAIT_V(8); PG8_WAIT_L(0); PG8_BAR; PG8_MMA(1, 0, At, B0); PG8_MMA(1, 1, At, B1); PG8_BAR; PG8_SCHED;
        }
        if (wr == 0) PG8_BAR;
        E(acc, cur, wr, wc, elds);
        if (!has_next) break;
#pragma unroll
        for (int a = 0; a < 2; ++a)
#pragma unroll
            for (int b = 0; b < 2; ++b)
#pragma unroll
                for (int m = 0; m < 4; ++m)
#pragma unroll
                    for (int n = 0; n < 2; ++n) acc[a][b][m][n] = (f32x4){zf, zf, zf, zf};
        cur = nxt; cA = nA; cB = nB; ++ui;
        if constexpr (Epi::KGROUP) E.unit_begin(cur, elds);
        PG8_LANECONST();
        if (wr == 1) PG8_BAR;
    }
    PG8_WAIT_V(0);
    PG8_BAR;
#undef PG8_LANECONST
#undef PG8_SA
#undef PG8_SB
#undef PG8_STAGE
#undef PG8_LDA
#undef PG8_LDB
#undef PG8_MMA
}
}
namespace epi {
using pg8::f32x4; using pg8::u32x4; using pg8::u32x2; using pg8::bf16_t; using pg8::Unit; using pg8::cvt_pk_bf16;
constexpr int MROWS = 16384, DMODEL = 1024;
constexpr float EPS = 1e-6f;
#define EPI_LAS __attribute__((address_space(3)))

__device__ __forceinline__ float row_rstd(const float* ssq, int row) {
    const f32x4 a = *(const f32x4*)(ssq + (size_t)row * 4);
    const float s = (a[0] + a[1]) + (a[2] + a[3]);
    return 1.0f / sqrtf(s * (1.0f / DMODEL) + EPS);
}
template <int MSTEP> __device__ __forceinline__ void rstd8(const float* ssq, int row0, bool clamp, float (&rs)[2][4]) {
    f32x4 p[2][4];
#pragma unroll
    for (int ai = 0; ai < 2; ++ai)
#pragma unroll
        for (int m = 0; m < 4; ++m) { int row = row0 + ai * 128 + m * MSTEP; if (clamp) row = row < 0 ? 0 : (row >= MROWS ? MROWS - 1 : row); p[ai][m] = *(const f32x4*)(ssq + (size_t)row * 4); }
#pragma unroll
    for (int ai = 0; ai < 2; ++ai)
#pragma unroll
        for (int m = 0; m < 4; ++m) { const f32x4 a = p[ai][m]; rs[ai][m] = 1.0f / sqrtf(((a[0] + a[1]) + (a[2] + a[3])) * (1.0f / DMODEL) + EPS); }
}
template <int CTRL> __device__ __forceinline__ float dppf(float old, float src) {
    return __builtin_bit_cast(float, __builtin_amdgcn_update_dpp(__builtin_bit_cast(int, old), __builtin_bit_cast(int, src), CTRL, 0xF, 0xF, false));
}
template <int CTRL> __device__ __forceinline__ float dppa(float src) {
    return __builtin_bit_cast(float, __builtin_amdgcn_mov_dpp(__builtin_bit_cast(int, src), CTRL, 0xF, 0xF, true));
}
__device__ __forceinline__ f32x4 silu4(f32x4 v) {
    const f32x4 t = v * (-1.4426950408889634f); f32x4 e;
#pragma unroll
    for (int i = 0; i < 4; ++i) e[i] = __builtin_amdgcn_exp2f(t[i]);
    e = e + 1.0f;
#pragma unroll
    for (int i = 0; i < 4; ++i) e[i] = __builtin_amdgcn_rcpf(e[i]);
    return v * e;
}
template <int CTRL> __device__ __forceinline__ float dppz(float src) {
    return __builtin_bit_cast(float, __builtin_amdgcn_update_dpp(0, __builtin_bit_cast(int, src), CTRL, 0xF, 0xF, true));
}
__device__ __forceinline__ float silu_fast(float v) { return v * __builtin_amdgcn_rcpf(1.0f + __builtin_amdgcn_exp2f(-1.4426950408889634f * v)); }

struct EpiResidual {
    static constexpr bool PERM = false, ROWIL = false, KGROUP = false;
    const float* xin; float* xout; bf16_t* xb; float* ssq; int dry;
    __device__ __forceinline__ void operator()(f32x4 (&acc)[2][2][4][2], const Unit& u, int wr, int wc, EPI_LAS unsigned char* elds) const {
        int fr, fq; { int t_ = threadIdx.x; asm volatile("" : "+v"(t_)); fr = t_ & 15; fq = (t_ >> 4) & 3; }
        EPI_LAS float* P = (EPI_LAS float*)elds;
        const int col0 = u.pn * 256 + wc * 32 + 4 * fq;
#pragma unroll
        for (int ai = 0; ai < 2; ++ai) {
            f32x4 xv[4][2][2];
#pragma unroll
            for (int m = 0; m < 4; ++m)
#pragma unroll
                for (int bj = 0; bj < 2; ++bj)
#pragma unroll
                    for (int n = 0; n < 2; ++n) xv[m][bj][n] = *(const f32x4*)(xin + (size_t)(u.pm * 256 + ai * 128 + wr * 64 + m * 16 + fr) * DMODEL + col0 + bj * 128 + n * 16);
#pragma unroll
            for (int m = 0; m < 4; ++m) {
                const int row = u.pm * 256 + ai * 128 + wr * 64 + m * 16 + fr;
                const size_t off = (size_t)row * DMODEL + col0;
                float s = 0.f;
#pragma unroll
                for (int bj = 0; bj < 2; ++bj)
#pragma unroll
                    for (int n = 0; n < 2; ++n) {
                        const size_t o = off + bj * 128 + n * 16;
                        const f32x4 v = xv[m][bj][n] + acc[ai][bj][m][n];
                        if (!dry) *(f32x4*)(xout + o) = v;
                        u32x2 w; w.x = cvt_pk_bf16(v[0], v[1]); w.y = cvt_pk_bf16(v[2], v[3]);
                        *(u32x2*)(xb + o) = w;
                        s += (v[0] * v[0] + v[1] * v[1]) + (v[2] * v[2] + v[3] * v[3]);
                    }
                s += __shfl_xor(s, 16); s += __shfl_xor(s, 32);
                if (fq == 0) P[(ai * 128 + wr * 64 + m * 16 + fr) * 4 + wc] = s;
            }
            asm volatile("" ::: "memory");
        }
        asm volatile("s_waitcnt lgkmcnt(0)" ::: "memory"); __builtin_amdgcn_s_barrier(); asm volatile("" ::: "memory");
        { const int t = (wr * 4 + wc) * 64 + fq * 16 + fr; if (t < 256) { const f32x4 p = *(const EPI_LAS f32x4*)(P + t * 4); ssq[(size_t)(u.pm * 256 + t) * 4 + u.pn] = (p[0] + p[1]) + (p[2] + p[3]); } }
        asm volatile("s_waitcnt lgkmcnt(0)" ::: "memory"); __builtin_amdgcn_s_barrier(); asm volatile("" ::: "memory");
    }
};

struct EpiResidualG {
    static constexpr bool PERM = false, ROWIL = false, KGROUP = true;
    const float* xin; float* xout; bf16_t* xb; float* ssq; const float* ssqp; int dry;
    __device__ __forceinline__ void unit_begin(const Unit& u, EPI_LAS unsigned char* elds) const {
        int t = threadIdx.x; asm volatile("" : "+v"(t));
        if (t < 256) {
            const f32x4* p = (const f32x4*)(ssqp + (size_t)(u.pm * 256 + t) * 32);
            float r[4];
#pragma unroll
            for (int g = 0; g < 4; ++g) { const f32x4 a = p[2 * g], b = p[2 * g + 1]; r[g] = 1.0f / sqrtf((((a[0] + a[1]) + (a[2] + a[3])) + ((b[0] + b[1]) + (b[2] + b[3]))) * (1.0f / 512.0f) + EPS); }
            *(EPI_LAS f32x4*)(elds + 4096 + t * 16) = (f32x4){r[0] / r[1], r[1] / r[2], r[2] / r[3], r[3]};
        }
    }
    __device__ __forceinline__ void kgroup(f32x4 (&acc)[2][2][4][2], int g, int wr, EPI_LAS unsigned char* elds) const {
        int fr; { int t_ = threadIdx.x; asm volatile("" : "+v"(t_)); fr = t_ & 15; }
        const EPI_LAS float* RG = (const EPI_LAS float*)(elds + 4096) + (g - 1);
#pragma unroll
        for (int ai = 0; ai < 2; ++ai)
#pragma unroll
            for (int m = 0; m < 4; ++m) {
                const float f = RG[(ai * 128 + wr * 64 + m * 16 + fr) * 4];
#pragma unroll
                for (int bj = 0; bj < 2; ++bj) { acc[ai][bj][m][0] *= f; acc[ai][bj][m][1] *= f; }
            }
    }
    __device__ __forceinline__ void operator()(f32x4 (&acc)[2][2][4][2], const Unit& u, int wr, int wc, EPI_LAS unsigned char* elds) const {
        kgroup(acc, 4, wr, elds);
        const EpiResidual R{xin, xout, xb, ssq, dry};
        R(acc, u, wr, wc, elds);
    }
};

struct EpiSsdIn {
    static constexpr bool PERM = true, ROWIL = false, KGROUP = false;
    bf16_t* proj; float* dt; const float* dtbias; const float* ssq;
    __device__ __forceinline__ void operator()(f32x4 (&acc)[2][2][4][2], const Unit& u, int wr, int wc, EPI_LAS unsigned char*) const {
        int fr, fq; { int t_ = threadIdx.x; asm volatile("" : "+v"(t_)); fr = t_ & 15; fq = (t_ >> 4) & 3; }
        float rsv[2][4]; rstd8<16>(ssq, u.pm * 256 + wr * 64 + fr, false, rsv);
#pragma unroll
        for (int ai = 0; ai < 2; ++ai)
#pragma unroll
            for (int m = 0; m < 4; ++m) {
                const int row = u.pm * 256 + ai * 128 + wr * 64 + m * 16 + fr;
                const float rs = rsv[ai][m];
                if (u.pn < 20) {
#pragma unroll
                    for (int bj = 0; bj < 2; ++bj) {
                        const f32x4 v0 = acc[ai][bj][m][0] * rs, v1 = acc[ai][bj][m][1] * rs;
                        u32x4 w; w.x = cvt_pk_bf16(v0[0], v0[1]); w.y = cvt_pk_bf16(v0[2], v0[3]); w.z = cvt_pk_bf16(v1[0], v1[1]); w.w = cvt_pk_bf16(v1[2], v1[3]);
                        *(u32x4*)(proj + (size_t)row * 5120 + u.pn * 256 + bj * 128 + wc * 32 + 8 * fq) = w;
                    }
                } else if (wc == 0) {
#pragma unroll
                    for (int n = 0; n < 2; ++n) {
                        const int c = 8 * fq + 4 * n;
                        const f32x4 b = *(const f32x4*)(dtbias + c);
                        f32x4 v = acc[ai][0][m][n] * rs + b, o;
#pragma unroll
                        for (int e = 0; e < 4; ++e) o[e] = fmaxf(v[e], 0.f) + log1pf(expf(-fabsf(v[e])));
                        *(f32x4*)(dt + (size_t)row * 32 + c) = o;
                    }
                }
            }
    }
};

struct EpiQKV {
    static constexpr bool PERM = true, ROWIL = false, KGROUP = false;
    bf16_t* proj; const float* ssq; const float* qg; const float* kg; const float* rope;
    __device__ __forceinline__ void operator()(f32x4 (&acc)[2][2][4][2], const Unit& u, int wr, int wc, EPI_LAS unsigned char* elds) const {
        int fr, fq; { int t_ = threadIdx.x; asm volatile("" : "+v"(t_)); fr = t_ & 15; fq = (t_ >> 4) & 3; }
        EPI_LAS float* P = (EPI_LAS float*)elds;
        EPI_LAS f32x4* RT = (EPI_LAS f32x4*)(elds + 8192);
        const bool isqk = u.pn < 8;
        f32x4 rp_[2];
        const int t_id = (wr * 4 + wc) * 64 + fq * 16 + fr;
        if (isqk) {
#pragma unroll
            for (int i = 0; i < 2; ++i) rp_[i] = *(const f32x4*)(rope + (size_t)u.pm * 256 * 16 + (size_t)(t_id * 2 + i) * 4);
        }
        float rsv[2][4]; rstd8<16>(ssq, u.pm * 256 + wr * 64 + fr, false, rsv);
#pragma unroll
        for (int ai = 0; ai < 2; ++ai)
#pragma unroll
            for (int m = 0; m < 4; ++m) {
                const int trow = ai * 128 + wr * 64 + m * 16 + fr;
                const float rs = rsv[ai][m];
#pragma unroll
                for (int bj = 0; bj < 2; ++bj) {
                    acc[ai][bj][m][0] *= rs; acc[ai][bj][m][1] *= rs;
                    if (isqk) {
                        const f32x4 a = acc[ai][bj][m][0], b = acc[ai][bj][m][1];
                        float s = ((a[0] * a[0] + a[1] * a[1]) + (a[2] * a[2] + a[3] * a[3])) + ((b[0] * b[0] + b[1] * b[1]) + (b[2] * b[2] + b[3] * b[3]));
                        s += __shfl_xor(s, 16); s += __shfl_xor(s, 32);
                        if (fq == 0) P[trow * 8 + bj * 4 + wc] = s;
                    }
                }
            }
        if (isqk) { RT[t_id * 2] = rp_[0]; RT[t_id * 2 + 1] = rp_[1]; }
        if (isqk) {
            asm volatile("s_waitcnt lgkmcnt(0)" ::: "memory"); __builtin_amdgcn_s_barrier(); asm volatile("" ::: "memory");
            const float* g = (u.pn < 4) ? qg : kg;
            const int d0 = 32 * (wc & 1) + 8 * fq;
            const f32x4 g0 = *(const f32x4*)(g + d0), g1 = *(const f32x4*)(g + d0 + 4);
            const float qs = (u.pn < 4) ? (1.4426950408889634f * 0.125f) : 1.0f;
            const bool dorope = (wc & 1) == 0;
#pragma unroll
            for (int ai = 0; ai < 2; ++ai)
#pragma unroll
                for (int m = 0; m < 4; ++m) {
                    const int trow = ai * 128 + wr * 64 + m * 16 + fr;
                    const int row = u.pm * 256 + trow;
                    f32x4 c0 = {1.f, 1.f, 1.f, 1.f}, c1 = c0, s0 = {0.f, 0.f, 0.f, 0.f}, s1 = s0;
                    if (dorope && fq < 2) {
                        c0 = RT[trow * 4 + 0]; c1 = RT[trow * 4 + 1]; s0 = RT[trow * 4 + 2]; s1 = RT[trow * 4 + 3];
                        if (fq == 0) { s0 = -s0; s1 = -s1; }
                    }
#pragma unroll
                    for (int bj = 0; bj < 2; ++bj) {
                        const float tot = P[trow * 8 + bj * 4 + wc] + P[trow * 8 + bj * 4 + (wc ^ 1)];
                        const float nr = qs / sqrtf(tot * (1.0f / 64.0f) + EPS);
                        f32x4 v0 = acc[ai][bj][m][0] * g0 * nr, v1 = acc[ai][bj][m][1] * g1 * nr;
                        if (dorope) {
                            f32x4 o0, o1;
#pragma unroll
                            for (int e = 0; e < 4; ++e) { o0[e] = __shfl_xor(v0[e], 16); o1[e] = __shfl_xor(v1[e], 16); }
                            v0 = v0 * c0 + o0 * s0; v1 = v1 * c1 + o1 * s1;
                        }
                        u32x4 w; w.x = cvt_pk_bf16(v0[0], v0[1]); w.y = cvt_pk_bf16(v0[2], v0[3]); w.z = cvt_pk_bf16(v1[0], v1[1]); w.w = cvt_pk_bf16(v1[2], v1[3]);
                        *(u32x4*)(proj + (size_t)row * 3072 + u.pn * 256 + bj * 128 + wc * 32 + 8 * fq) = w;
                    }
                    asm volatile("" ::: "memory");
                }
            asm volatile("s_waitcnt lgkmcnt(0)" ::: "memory"); __builtin_amdgcn_s_barrier(); asm volatile("" ::: "memory");
        } else {
#pragma unroll
            for (int ai = 0; ai < 2; ++ai)
#pragma unroll
                for (int m = 0; m < 4; ++m) {
                    const int row = u.pm * 256 + ai * 128 + wr * 64 + m * 16 + fr;
#pragma unroll
                    for (int bj = 0; bj < 2; ++bj) {
                        const f32x4 v0 = acc[ai][bj][m][0], v1 = acc[ai][bj][m][1];
                        u32x4 w; w.x = cvt_pk_bf16(v0[0], v0[1]); w.y = cvt_pk_bf16(v0[2], v0[3]); w.z = cvt_pk_bf16(v1[0], v1[1]); w.w = cvt_pk_bf16(v1[2], v1[3]);
                        *(u32x4*)(proj + (size_t)row * 3072 + u.pn * 256 + bj * 128 + wc * 32 + 8 * fq) = w;
                    }
                }
        }
    }
};

struct EpiSsdConv {
    static constexpr bool PERM = true, ROWIL = true, KGROUP = false;
    bf16_t* zp; bf16_t* xbc; float* dt; const float* ssq; const float* cp;
    template <bool MASK>
    __device__ __forceinline__ void conv_body(f32x4 (&acc)[2][2][4][2], const Unit& u, int wr, int wc, int fr, int fq, const EPI_LAS f32x4* hb, int R0) const {
        bf16_t* const obase = (u.pn < 8) ? zp + u.pn * 256 : xbc + (u.pn - 8) * 256;
        const int old_ = (u.pn < 8) ? 2048 : 3072;
#pragma unroll
        for (int bj = 0; bj < 2; ++bj) {
            u32x2 keep[2][4];
#pragma unroll
            for (int n = 0; n < 2; ++n) {
                const int tc = bj * 128 + wc * 32 + 8 * fq + 4 * n;
                const EPI_LAS float* pt = (const EPI_LAS float*)((const EPI_LAS unsigned char*)hb + 12288) + tc;
                const f32x4 bb = *(const EPI_LAS f32x4*)pt, w0 = *(const EPI_LAS f32x4*)(pt + 256), w1 = *(const EPI_LAS f32x4*)(pt + 512), w2 = *(const EPI_LAS f32x4*)(pt + 768), w3 = *(const EPI_LAS f32x4*)(pt + 1024);
#pragma unroll
                for (int ai = 0; ai < 2; ++ai) {
                    f32x4 h1 = {0.f, 0.f, 0.f, 0.f}, h2 = h1, h3 = h1;
                    const int pwr = wr ^ 1, pai = (wr == 1) ? ai : ai - 1;
                    if (pai >= 0 && fr == 0) { const int idx = (((pwr * 2 + pai) * 4 + wc) * 3 * 4 + fq) * 4 + bj * 2 + n;
                        h1 = hb[idx]; h2 = hb[idx + 16]; h3 = hb[idx + 32]; }
                    const f32x4 v0 = acc[ai][bj][0][n], v1 = acc[ai][bj][1][n], v2 = acc[ai][bj][2][n], v3 = acc[ai][bj][3][n];
                    f32x4 p1, p2, p3;
#pragma unroll
                    for (int e = 0; e < 4; ++e) { p1[e] = dppf<0x111>(h1[e], v1[e]); p2[e] = dppf<0x111>(h2[e], v2[e]); p3[e] = dppf<0x111>(h3[e], v3[e]); }
#pragma unroll
                    for (int m = 0; m < 4; ++m) {
                        const int trow = ai * 128 + wr * 64 + 4 * fr + m, row = R0 + trow;
                        const f32x4 cv = (m == 0) ? v0 : (m == 1) ? v1 : (m == 2) ? v2 : v3;
                        f32x4 x1 = (m == 0) ? p3 : (m == 1) ? v0 : (m == 2) ? v1 : v2;
                        f32x4 x2 = (m == 0) ? p2 : (m == 1) ? p3 : (m == 2) ? v0 : v1;
                        f32x4 x3 = (m == 0) ? p1 : (m == 1) ? p2 : (m == 2) ? p3 : v0;
                        if (MASK) { const int ts = row & 2047; const f32x4 z4 = {0.f, 0.f, 0.f, 0.f}; if (ts < 1) x1 = z4; if (ts < 2) x2 = z4; if (ts < 3) x3 = z4; }
                        const bool valid = trow >= 3 && row < MROWS;
                        const f32x4 o = silu4(bb + w0 * x3 + w1 * x2 + w2 * x1 + w3 * cv);
                        if (n == 0) { keep[ai][m].x = cvt_pk_bf16(o[0], o[1]); keep[ai][m].y = cvt_pk_bf16(o[2], o[3]); }
                        else if (valid) {
                            u32x4 w; w.x = keep[ai][m].x; w.y = keep[ai][m].y; w.z = cvt_pk_bf16(o[0], o[1]); w.w = cvt_pk_bf16(o[2], o[3]);
                            *(u32x4*)(obase + (size_t)row * old_ + tc - 4) = w;
                        }
                    }
                    asm volatile("" ::: "memory");
                }
            }
        }
    }
    __device__ __forceinline__ void operator()(f32x4 (&acc)[2][2][4][2], const Unit& u, int wr, int wc, EPI_LAS unsigned char* elds) const {
        int fr, fq; { int t_ = threadIdx.x; asm volatile("" : "+v"(t_)); fr = t_ & 15; fq = (t_ >> 4) & 3; }
        const int R0 = u.pm * 253 - 3;
        EPI_LAS f32x4* hb = (EPI_LAS f32x4*)elds;
        const int t_id = (wr * 4 + wc) * 64 + fq * 16 + fr;
        f32x4 pld = {0.f, 0.f, 0.f, 0.f};
        if (t_id < 320) pld = *(const f32x4*)(cp + (size_t)(t_id >> 6) * 5376 + u.pn * 256 + (t_id & 63) * 4);
        { float rsv[2][4]; rstd8<1>(ssq, R0 + wr * 64 + 4 * fr, true, rsv);
#pragma unroll
          for (int ai = 0; ai < 2; ++ai)
#pragma unroll
            for (int m = 0; m < 4; ++m)
#pragma unroll
                for (int bj = 0; bj < 2; ++bj) { acc[ai][bj][m][0] *= rsv[ai][m]; acc[ai][bj][m][1] *= rsv[ai][m]; } }
        if (t_id < 320) *(EPI_LAS f32x4*)((EPI_LAS unsigned char*)hb + 12288 + t_id * 16) = pld;
        if (u.pn == 20) {
            if (wc == 0) {
#pragma unroll
                for (int ai = 0; ai < 2; ++ai)
#pragma unroll
                    for (int m = 0; m < 4; ++m) {
                        const int trow = ai * 128 + wr * 64 + 4 * fr + m, row = R0 + trow;
                        if (trow >= 3 && row < MROWS) {
#pragma unroll
                            for (int n = 0; n < 2; ++n) {
                                const int c = 8 * fq + 4 * n;
                                const f32x4 b = *(const f32x4*)(cp + 20 * 256 + c);
                                f32x4 v = acc[ai][0][m][n] + b, o;
#pragma unroll
                                for (int e = 0; e < 4; ++e) o[e] = fmaxf(v[e], 0.f) + log1pf(expf(-fabsf(v[e])));
                                *(f32x4*)(dt + (size_t)row * 32 + c) = o;
                            }
                        }
                    }
            }
            return;
        }
        if (fr == 15) {
#pragma unroll
            for (int ai = 0; ai < 2; ++ai)
#pragma unroll
                for (int m = 1; m < 4; ++m) {
                    const int idx = ((((wr * 2 + ai) * 4 + wc) * 3 + (m - 1)) * 4 + fq) * 4;
                    hb[idx + 0] = acc[ai][0][m][0]; hb[idx + 1] = acc[ai][0][m][1]; hb[idx + 2] = acc[ai][1][m][0]; hb[idx + 3] = acc[ai][1][m][1];
                }
        }
        asm volatile("s_waitcnt lgkmcnt(0)" ::: "memory"); __builtin_amdgcn_s_barrier(); asm volatile("" ::: "memory");
        const int tf = (u.pm * 253) & 2047;
        if (tf <= 2 || tf + 252 >= 2048) conv_body<true>(acc, u, wr, wc, fr, fq, hb, R0); else conv_body<false>(acc, u, wr, wc, fr, fq, hb, R0);
        asm volatile("s_waitcnt lgkmcnt(0)" ::: "memory"); __builtin_amdgcn_s_barrier(); asm volatile("" ::: "memory");
    }
};

struct EpiConvGate {
    static constexpr bool PERM = true, ROWIL = true, KGROUP = false;
    bf16_t* H; const float* ssq; const float* cw; const float* cb; int dry;
    template <bool MASK>
    __device__ __forceinline__ void body(f32x4 (&acc)[2][2][4][2], const Unit& u, int wr, int wc, int fr, int fq, const EPI_LAS f32x4* hb, int R0) const {
        constexpr int DFF = 2816;
        u32x2 keep[2][4];
#pragma unroll
        for (int n = 0; n < 2; ++n) {
            const int ch = u.pn * 128 + wc * 32 + 8 * fq + 4 * n;
            const EPI_LAS float* pt = (const EPI_LAS float*)((const EPI_LAS unsigned char*)hb + 8192) + wc * 32 + 8 * fq + 4 * n;
            const f32x4 bg = *(const EPI_LAS f32x4*)pt, bu = *(const EPI_LAS f32x4*)(pt + 128);
            const f32x4 w0g = *(const EPI_LAS f32x4*)(pt + 256), w0u = *(const EPI_LAS f32x4*)(pt + 384), w1g = *(const EPI_LAS f32x4*)(pt + 512), w1u = *(const EPI_LAS f32x4*)(pt + 640), w2g = *(const EPI_LAS f32x4*)(pt + 768), w2u = *(const EPI_LAS f32x4*)(pt + 896);
#pragma unroll
            for (int ai = 0; ai < 2; ++ai) {
                f32x4 hg2 = {0.f, 0.f, 0.f, 0.f}, hg3 = hg2, hu2 = hg2, hu3 = hg2;
                const int pwr = wr ^ 1, pai = (wr == 1) ? ai : ai - 1;
                if (pai >= 0 && fr == 0) { const int idx = (((pwr * 2 + pai) * 4 + wc) * 2 * 4 + fq) * 4;
                    hg2 = hb[idx + n]; hu2 = hb[idx + 2 + n]; hg3 = hb[idx + 16 + n]; hu3 = hb[idx + 16 + 2 + n]; }
                const f32x4 g0 = acc[ai][0][0][n], g1_ = acc[ai][0][1][n], g2_ = acc[ai][0][2][n], g3_ = acc[ai][0][3][n];
                const f32x4 u0 = acc[ai][1][0][n], u1_ = acc[ai][1][1][n], u2_ = acc[ai][1][2][n], u3_ = acc[ai][1][3][n];
                f32x4 pg2, pg3, pu2, pu3;
#pragma unroll
                for (int e = 0; e < 4; ++e) { pg2[e] = dppf<0x111>(hg2[e], g2_[e]); pg3[e] = dppf<0x111>(hg3[e], g3_[e]); pu2[e] = dppf<0x111>(hu2[e], u2_[e]); pu3[e] = dppf<0x111>(hu3[e], u3_[e]); }
#pragma unroll
                for (int m = 0; m < 4; ++m) {
                    const int trow = ai * 128 + wr * 64 + 4 * fr + m, row = R0 + trow;
                    const f32x4 cg = (m == 0) ? g0 : (m == 1) ? g1_ : (m == 2) ? g2_ : g3_, cu = (m == 0) ? u0 : (m == 1) ? u1_ : (m == 2) ? u2_ : u3_;
                    f32x4 xg1 = (m == 0) ? pg3 : (m == 1) ? g0 : (m == 2) ? g1_ : g2_, xg2 = (m == 0) ? pg2 : (m == 1) ? pg3 : (m == 2) ? g0 : g1_;
                    f32x4 xu1 = (m == 0) ? pu3 : (m == 1) ? u0 : (m == 2) ? u1_ : u2_, xu2 = (m == 0) ? pu2 : (m == 1) ? pu3 : (m == 2) ? u0 : u1_;
                    if (MASK) { const int ts = row & 2047; const f32x4 z4 = {0.f, 0.f, 0.f, 0.f}; if (ts < 1) { xg1 = z4; xu1 = z4; } if (ts < 2) { xg2 = z4; xu2 = z4; } }
                    const f32x4 gv = bg + w0g * xg2 + w1g * xg1 + w2g * cg;
                    const f32x4 uv = bu + w0u * xu2 + w1u * xu1 + w2u * cu;
                    const f32x4 o = silu4(gv) * uv;
                    if (n == 0) { keep[ai][m].x = cvt_pk_bf16(o[0], o[1]); keep[ai][m].y = cvt_pk_bf16(o[2], o[3]); }
                    else if (trow >= 2 && row < MROWS && !dry) {
                        u32x4 w; w.x = keep[ai][m].x; w.y = keep[ai][m].y; w.z = cvt_pk_bf16(o[0], o[1]); w.w = cvt_pk_bf16(o[2], o[3]);
                        *(u32x4*)(H + (size_t)row * DFF + ch - 4) = w;
                    }
                }
                asm volatile("" ::: "memory");
            }
        }
    }
    __device__ __forceinline__ void operator()(f32x4 (&acc)[2][2][4][2], const Unit& u, int wr, int wc, EPI_LAS unsigned char* elds) const {
        int fr, fq; { int t_ = threadIdx.x; asm volatile("" : "+v"(t_)); fr = t_ & 15; fq = (t_ >> 4) & 3; }
        const int R0 = u.pm * 254 - 2;
        EPI_LAS f32x4* hb = (EPI_LAS f32x4*)elds;
        const int t_id = (wr * 4 + wc) * 64 + fq * 16 + fr;
        f32x4 pld = {0.f, 0.f, 0.f, 0.f};
        if (t_id < 256) { const int k = t_id >> 5, c = u.pn * 128 + (t_id & 31) * 4; pld = *(const f32x4*)((k < 2 ? cb + k * 2816 : cw + (size_t)(k - 2) * 2816) + c); }
        { float rsv[2][4]; rstd8<1>(ssq, R0 + wr * 64 + 4 * fr, true, rsv);
#pragma unroll
          for (int ai = 0; ai < 2; ++ai)
#pragma unroll
            for (int m = 0; m < 4; ++m)
#pragma unroll
                for (int bj = 0; bj < 2; ++bj) { acc[ai][bj][m][0] *= rsv[ai][m]; acc[ai][bj][m][1] *= rsv[ai][m]; } }
        if (t_id < 256) *(EPI_LAS f32x4*)((EPI_LAS unsigned char*)hb + 8192 + t_id * 16) = pld;
        if (fr == 15) {
#pragma unroll
            for (int ai = 0; ai < 2; ++ai)
#pragma unroll
                for (int m = 2; m < 4; ++m) {
                    const int idx = ((((wr * 2 + ai) * 4 + wc) * 2 + (m - 2)) * 4 + fq) * 4;
                    hb[idx + 0] = acc[ai][0][m][0]; hb[idx + 1] = acc[ai][0][m][1]; hb[idx + 2] = acc[ai][1][m][0]; hb[idx + 3] = acc[ai][1][m][1];
                }
        }
        asm volatile("s_waitcnt lgkmcnt(0)" ::: "memory"); __builtin_amdgcn_s_barrier(); asm volatile("" ::: "memory");
        const int tf = (u.pm * 254) & 2047;
        if (dry < 2) { if (tf <= 1 || tf + 253 >= 2048) body<true>(acc, u, wr, wc, fr, fq, hb, R0); else body<false>(acc, u, wr, wc, fr, fq, hb, R0); }
        asm volatile("s_waitcnt lgkmcnt(0)" ::: "memory"); __builtin_amdgcn_s_barrier(); asm volatile("" ::: "memory");
    }
};
}
namespace attn {
using pg8::bf16_t; using pg8::bf16x8; using pg8::f32x4; using pg8::u32x4;
typedef float f32x16 __attribute__((ext_vector_type(16)));
typedef short s16x4 __attribute__((ext_vector_type(4)));
#define AT_LAS __attribute__((address_space(3)))
constexpr int LD = 3072, SEQ = 2048;
constexpr int KT_BYTES = 16384, VT_BYTES = 16384, STG = KT_BYTES + VT_BYTES;
constexpr int L_X = 0;
constexpr int L_WSF = 2 * STG;
constexpr int L_OST = L_WSF + 8 * 256;
constexpr int LDS_BYTES = L_OST + 4 * 8192;
__device__ __forceinline__ int crow(int r, int hi) { return (r & 3) + 8 * (r >> 2) + 4 * hi; }
__device__ __forceinline__ unsigned cvtpk(float lo, float hi) { typedef float f2 __attribute__((ext_vector_type(2))); typedef __bf16 b2 __attribute__((ext_vector_type(2))); f2 v = {lo, hi}; b2 b = __builtin_convertvector(v, b2); return __builtin_bit_cast(unsigned, b); }
__device__ __forceinline__ s16x4 vtr(const AT_LAS char* p) { typedef short v4 __attribute__((ext_vector_type(4))); return __builtin_bit_cast(s16x4, __builtin_amdgcn_ds_read_tr16_b64_v4i16((AT_LAS v4*)p)); }

struct Params { bf16_t* qkv; float mb; float lam; int dry; };

__device__ __forceinline__ void unit(const Params& P, int b, int h, int blk, AT_LAS char* lds) {
    int tid = threadIdx.x; asm volatile("" : "+v"(tid));
    const int lane = tid & 63, r32 = lane & 31, hi = lane >> 5;
    const int wid = __builtin_amdgcn_readfirstlane(tid >> 6), comp = wid >> 2, w4 = wid & 3;
    const size_t rowb = (size_t)b * SEQ;
    const int q0 = blk * 128;
    const int nt = 2 * blk + 2, my_nt = 2 * blk + (w4 >> 1) + 1;
    const bf16_t* Kg = P.qkv + rowb * LD + 1024 + h * 128;
    const bf16_t* Vg = P.qkv + rowb * LD + 2048 + h * 128;
    u32x4 kreg[2], vreg[2];
    int kdst[2], vdst[2];
#pragma unroll
    for (int i = 0; i < 2; ++i) {
        const int p = tid + 512 * i, key = p >> 4, c16 = p & 15;
        kdst[i] = key * 256 + ((c16 ^ (key & 15)) << 4);
        vdst[i] = KT_BYTES + (c16 >> 2) * 4096 + (key >> 4) * 1024 + ((key >> 3) & 1) * 512 + (key & 7) * 64 + (c16 & 3) * 16;
    }
#define AT_LOAD(t) do { _Pragma("unroll") for (int i = 0; i < 2; ++i) { const int p = tid + 512 * i, key = p >> 4, c16 = p & 15; const size_t go = (size_t)((t) * 64 + key) * LD + c16 * 8; \
        kreg[i] = *(const u32x4*)(Kg + go); vreg[i] = *(const u32x4*)(Vg + go); } } while (0)
#define AT_STORE(s) do { _Pragma("unroll") for (int i = 0; i < 2; ++i) { *(AT_LAS u32x4*)(lds + (s) * STG + kdst[i]) = kreg[i]; *(AT_LAS u32x4*)(lds + (s) * STG + vdst[i]) = vreg[i]; } } while (0)
    AT_LOAD(0);
    bf16x8 qr[4];
    {
        const bf16_t* Qw = P.qkv + (rowb + q0 + w4 * 32 + r32) * LD + h * 128 + comp * 64 + hi * 8;
#pragma unroll
        for (int d0 = 0; d0 < 4; ++d0) qr[d0] = *(const bf16x8*)(Qw + d0 * 16);
    }
    AT_STORE(0);
    __syncthreads();
    f32x16 o[4];
#pragma unroll
    for (int i = 0; i < 4; ++i)
#pragma unroll
        for (int r = 0; r < 16; ++r) o[i][r] = 0.f;
    float lsum = 0.f;
    f32x16 negm;
#pragma unroll
    for (int r = 0; r < 16; ++r) negm[r] = -P.mb;
    const int kbase = r32 * 256, ksw = r32 & 15;
    const int vbase = KT_BYTES + ((lane >> 4) & 1) * 32 + (lane & 3) * 8 + (4 * hi + ((lane & 15) >> 2)) * 64;
    for (int t = 0; t < nt; ++t) {
        const int s = t & 1;
        if (t + 1 < nt) AT_LOAD(t + 1);
        if (t < my_nt) {
            const AT_LAS char* st = lds + s * STG;
            bf16x8 kf[8];
#pragma unroll
            for (int d0 = 0; d0 < 4; ++d0) {
                const int ch = comp * 8 + 2 * d0 + hi;
                kf[2 * d0] = *(const AT_LAS bf16x8*)(st + kbase + ((ch ^ ksw) << 4));
                kf[2 * d0 + 1] = *(const AT_LAS bf16x8*)(st + kbase + 32 * 256 + ((ch ^ ksw) << 4));
            }
            s16x4 vlo[2][4], vhi[2][4];
#define AT_VLOAD(bk, buf) do { _Pragma("unroll") for (int ks = 0; ks < 4; ++ks) { vlo[buf][ks] = vtr(st + vbase + (bk) * 4096 + ks * 1024); vhi[buf][ks] = vtr(st + vbase + (bk) * 4096 + ks * 1024 + 512); } } while (0)
            AT_VLOAD(0, 0);
            __builtin_amdgcn_sched_barrier(0);
            f32x16 p0 = negm, p1 = negm;
#pragma unroll
            for (int d0 = 0; d0 < 4; ++d0) {
                p0 = __builtin_amdgcn_mfma_f32_32x32x16_bf16(kf[2 * d0], qr[d0], p0, 0, 0, 0);
                p1 = __builtin_amdgcn_mfma_f32_32x32x16_bf16(kf[2 * d0 + 1], qr[d0], p1, 0, 0, 0);
            }
            __builtin_amdgcn_sched_barrier(0);
            AT_VLOAD(1, 1);
            __builtin_amdgcn_sched_barrier(0);
            float sacc0 = 0.f, sacc1 = 0.f;
#pragma unroll
            for (int r = 0; r < 16; ++r) { p0[r] = __builtin_amdgcn_exp2f(p0[r]); p1[r] = __builtin_amdgcn_exp2f(p1[r]); sacc0 += p0[r]; sacc1 += p1[r]; }
            lsum += sacc0 + sacc1;
            u32x4 pw[4];
#pragma unroll
            for (int j = 0; j < 4; ++j) { pw[0][j] = cvtpk(p0[2 * j], p0[2 * j + 1]); pw[1][j] = cvtpk(p0[8 + 2 * j], p0[8 + 2 * j + 1]); pw[2][j] = cvtpk(p1[2 * j], p1[2 * j + 1]); pw[3][j] = cvtpk(p1[8 + 2 * j], p1[8 + 2 * j + 1]); }
#define AT_PV(bk, buf) do { _Pragma("unroll") for (int ks = 0; ks < 4; ++ks) { \
                const bf16x8 vf = {vlo[buf][ks][0], vlo[buf][ks][1], vlo[buf][ks][2], vlo[buf][ks][3], vhi[buf][ks][0], vhi[buf][ks][1], vhi[buf][ks][2], vhi[buf][ks][3]}; \
                o[bk] = __builtin_amdgcn_mfma_f32_32x32x16_bf16(__builtin_bit_cast(bf16x8, pw[ks]), vf, o[bk], 0, 0, 0); } } while (0)
            __builtin_amdgcn_sched_barrier(0);
            AT_PV(0, 0); __builtin_amdgcn_sched_barrier(0); AT_VLOAD(2, 0); __builtin_amdgcn_sched_barrier(0);
            AT_PV(1, 1); __builtin_amdgcn_sched_barrier(0); AT_VLOAD(3, 1); __builtin_amdgcn_sched_barrier(0);
            AT_PV(2, 0);
            AT_PV(3, 1);
#undef AT_VLOAD
#undef AT_PV
        }
        if (t + 1 < nt) AT_STORE(s ^ 1);
        __syncthreads();
    }
    lsum += __shfl_xor(lsum, 32);
    AT_LAS float* wsf = (AT_LAS float*)(lds + L_WSF) + wid * 64;
    if (hi == 0) wsf[r32] = lsum;
    asm volatile("s_waitcnt lgkmcnt(0)" ::: "memory");
    float rl[16];
    const float sc = comp ? P.lam : 1.0f;
#pragma unroll
    for (int r = 0; r < 16; ++r) rl[r] = sc * __builtin_amdgcn_rcpf(wsf[crow(r, hi)]);
    AT_LAS float* X = (AT_LAS float*)(lds + L_X) + w4 * 4096 + lane;
    if (comp == 1) {
#pragma unroll
        for (int bk = 0; bk < 4; ++bk)
#pragma unroll
            for (int r = 0; r < 16; ++r) X[(bk * 16 + r) * 64] = o[bk][r] * rl[r];
    }
    __syncthreads();
    if (comp == 0) {
        float ss[16];
#pragma unroll
        for (int r = 0; r < 16; ++r) ss[r] = 0.f;
#pragma unroll
        for (int bk = 0; bk < 4; ++bk)
#pragma unroll
            for (int r = 0; r < 16; ++r) { const float v = o[bk][r] * rl[r] - X[(bk * 16 + r) * 64]; o[bk][r] = v; ss[r] += v * v; }
#pragma unroll
        for (int r = 0; r < 16; ++r) {
            float s = ss[r];
            s += __shfl_xor(s, 1); s += __shfl_xor(s, 2); s += __shfl_xor(s, 4); s += __shfl_xor(s, 8); s += __shfl_xor(s, 16);
            ss[r] = 1.0f / sqrtf(s * (1.0f / 128.0f) + 1e-6f);
        }
        AT_LAS bf16_t* stg = (AT_LAS bf16_t*)(lds + L_OST) + w4 * 4096;
#pragma unroll
        for (int bk = 0; bk < 4; ++bk)
#pragma unroll
            for (int r = 0; r < 16; ++r) { const float v = o[bk][r] * ss[r]; stg[crow(r, hi) * 128 + bk * 32 + r32] = (bf16_t)(cvtpk(v, 0.f) & 0xffffu); }
        asm volatile("s_waitcnt lgkmcnt(0)" ::: "memory");
        bf16_t* Ow = P.qkv + (rowb + q0 + w4 * 32) * LD + h * 128;
#pragma unroll
        for (int i = 0; i < 8; ++i) { const int row = i * 4 + (lane >> 4), c = lane & 15; const u32x4 v = *(const AT_LAS u32x4*)(stg + row * 128 + c * 8); if (!P.dry) *(u32x4*)(Ow + (size_t)row * LD + c * 8) = v; }
    }
    __syncthreads();
#undef AT_LOAD
#undef AT_STORE
}
}
namespace scan {
using pg8::bf16_t; using pg8::bf16x8; using pg8::f32x4; using pg8::u32x4; using pg8::u32x2;
typedef float f32x16 __attribute__((ext_vector_type(16)));
#define SC_LAS __attribute__((address_space(3)))
#define SC_BAR() do { asm volatile("s_waitcnt lgkmcnt(0)" ::: "memory"); __builtin_amdgcn_s_barrier(); asm volatile("" ::: "memory"); } while (0)
constexpr int SEQ = 2048, CH = 64;
constexpr int L_C = 0;
constexpr int L_B = 16384;
constexpr int L_XD = 32768;
constexpr int L_XW = 40960;
constexpr int L_G = 49152;
constexpr int L_H = 57344;
constexpr int L_Y = 73728;
constexpr int L_S = L_Y + 64 * 68 * 4;
constexpr int LDS_BYTES = L_S + 32 * 1024;
__device__ __forceinline__ unsigned cvtpk(float lo, float hi) { typedef float f2 __attribute__((ext_vector_type(2))); typedef __bf16 b2 __attribute__((ext_vector_type(2))); f2 v = {lo, hi}; b2 b = __builtin_convertvector(v, b2); return __builtin_bit_cast(unsigned, b); }
typedef short s16x4 __attribute__((ext_vector_type(4)));
__device__ __forceinline__ s16x4 vtr(const SC_LAS char* p) { typedef short v4 __attribute__((ext_vector_type(4))); return __builtin_bit_cast(s16x4, __builtin_amdgcn_ds_read_tr16_b64_v4i16((SC_LAS v4*)p)); }
__device__ __forceinline__ float lo16(unsigned w) { return __builtin_bit_cast(float, w << 16); }
__device__ __forceinline__ float hi16(unsigned w) { return __builtin_bit_cast(float, w & 0xffff0000u); }
__device__ __forceinline__ int img_off(int l) { return (l >> 4) * 1024 + ((l >> 3) & 1) * 512 + (l & 7) * 64; }

struct Params { const bf16_t* xbc; bf16_t* zp; const float* dt; const float* a_log; const float* dskip; float* ssqp; int dry; };

__device__ __forceinline__ void unit(const Params& P, int b, int h, SC_LAS char* lds) {
    int tid = threadIdx.x; asm volatile("" : "+v"(tid));
    const int wid = __builtin_amdgcn_readfirstlane(tid >> 6);
    const int g = h >> 3;
    const size_t rowb = (size_t)b * SEQ;
    const float a_h = -expf(P.a_log[h]), dsk = P.dskip[h];
    unsigned zu = 0u; asm volatile("" : "+v"(zu));
    {
        const int lane_ = tid & 63;
#pragma unroll
        for (int q = 0; q < 4; ++q) {
            const int cc = wid * 4 + q;
            const float dtv = P.dt[(rowb + cc * 64 + lane_) * 32 + h];
            float acs = dtv * a_h;
#pragma unroll
            for (int o = 1; o < 64; o <<= 1) { const float up = __shfl_up(acs, o); if (lane_ >= o) acs += up; }
            const float last = __shfl(acs, 63);
            SC_LAS float* sc = (SC_LAS float*)(lds + L_S) + cc * 256;
            sc[lane_] = dtv; sc[64 + lane_] = acs; sc[128 + lane_] = __expf(last - acs); sc[192 + lane_] = __expf(acs);
        }
    }
    for (int i = tid; i < 16384 / 16; i += 512) *(SC_LAS u32x4*)(lds + L_H + i * 16) = (u32x4){zu, zu, zu, zu};
    f32x16 hacc0, hacc1;
#pragma unroll
    for (int r = 0; r < 16; ++r) { hacc0[r] = 0.f; hacc1[r] = 0.f; }
    const int tid0 = tid;
    u32x4 xr, zr, br[2], cr[2];
#define SC_LOAD(t0_, XR, ZR) do { const int t_ = tid0; const size_t r1 = rowb + (t0_) + (t_ >> 3); \
        XR = *(const u32x4*)(P.xbc + r1 * 3072 + h * 64 + (t_ & 7) * 8); ZR = *(const u32x4*)(P.zp + r1 * 2048 + h * 64 + (t_ & 7) * 8); \
        _Pragma("unroll") for (int i = 0; i < 2; ++i) { const int p_ = t_ + 512 * i; const size_t r2 = rowb + (t0_) + (p_ >> 4); \
            br[i] = *(const u32x4*)(P.xbc + r2 * 3072 + 2048 + g * 128 + (p_ & 15) * 8); cr[i] = *(const u32x4*)(P.xbc + r2 * 3072 + 2560 + g * 128 + (p_ & 15) * 8); } } while (0)
    SC_LOAD(0, xr, zr);
    __syncthreads();
    for (int c = 0; c < SEQ / CH; ++c) {
        const int t0 = c * CH;
        int tid = tid0; asm volatile("" : "+v"(tid));
        const int lane = tid & 63, r32 = lane & 31, hi = lane >> 5, fr = lane & 15, fq = lane >> 4;
        const int orow = tid >> 3, ocg = tid & 7;
        SC_LAS float* s_dt = (SC_LAS float*)(lds + L_S) + c * 256; SC_LAS float* s_acs = s_dt + 64; SC_LAS float* s_dec = s_dt + 128; SC_LAS float* s_ea = s_dt + 192;
        {
            const float d = s_dt[orow], dd = d * s_dec[orow];
            u32x4 w1, w2;
#pragma unroll
            for (int i = 0; i < 4; ++i) { const float a = lo16(xr[i]), bq = hi16(xr[i]); w1[i] = cvtpk(a * d, bq * d); w2[i] = cvtpk(a * dd, bq * dd); }
            const int off = (ocg >> 2) * 4096 + img_off(orow) + (ocg & 3) * 16;
            *(SC_LAS u32x4*)(lds + L_XD + off) = w1; *(SC_LAS u32x4*)(lds + L_XW + off) = w2;
#pragma unroll
            for (int i = 0; i < 2; ++i) { const int p = tid + 512 * i, l = p >> 4, c16 = p & 15;
                *(SC_LAS u32x4*)(lds + L_B + (c16 >> 2) * 4096 + img_off(l) + (c16 & 3) * 16) = br[i];
                *(SC_LAS u32x4*)(lds + L_C + l * 256 + ((c16 ^ (l & 15)) << 4)) = cr[i]; }
        }
        const u32x4 xcur = xr, zcur = zr;
        if (c + 1 < SEQ / CH) SC_LOAD(t0 + CH, xr, zr);
        SC_BAR();
        f32x16 yacc;
#pragma unroll
        for (int r = 0; r < 16; ++r) yacc[r] = 0.f;
        const int yli = (wid >> 1) & 1, ypi = wid & 1;
        if (wid < 3) {
            const int si = (wid == 2) ? 1 : 0, li = (wid == 0) ? 0 : 1;
            const int srow = 32 * si + r32, lrow = 32 * li + r32;
            f32x16 cb;
#pragma unroll
            for (int r = 0; r < 16; ++r) cb[r] = 0.f;
            bf16x8 fa[8], fb[8];
#pragma unroll
            for (int ks = 0; ks < 8; ++ks) {
                const int chk = 2 * ks + hi;
                fa[ks] = *(const SC_LAS bf16x8*)(lds + L_B + (chk >> 2) * 4096 + img_off(srow) + (chk & 3) * 16);
                fb[ks] = *(const SC_LAS bf16x8*)(lds + L_C + lrow * 256 + ((chk ^ (lrow & 15)) << 4));
            }
            __builtin_amdgcn_sched_barrier(0);
#pragma unroll
            for (int ks = 0; ks < 8; ++ks) cb = __builtin_amdgcn_mfma_f32_32x32x16_bf16(fa[ks], fb[ks], cb, 0, 0, 0);
            const float al = s_acs[lrow];
#pragma unroll
            for (int q4 = 0; q4 < 4; ++q4) {
                const int s0 = 32 * si + 8 * q4 + 4 * hi;
                float gv[4];
#pragma unroll
                for (int e = 0; e < 4; ++e) { const int sidx = s0 + e; gv[e] = (sidx <= lrow) ? cb[4 * q4 + e] * __expf(al - s_acs[sidx]) : 0.f; }
                u32x2 w; w.x = cvtpk(gv[0], gv[1]); w.y = cvtpk(gv[2], gv[3]);
                *(SC_LAS u32x2*)(lds + L_G + lrow * 128 + (((s0 >> 3) ^ (lrow & 7)) << 4) + (s0 & 7) * 2) = w;
            }
        } else if (wid >= 4) {
            const int lrow = 32 * yli + r32, prow = 32 * ypi + r32;
            bf16x8 fa[8], fb[8];
#pragma unroll
            for (int ks = 0; ks < 8; ++ks) {
                const int chk = 2 * ks + hi;
                fa[ks] = *(const SC_LAS bf16x8*)(lds + L_C + lrow * 256 + ((chk ^ (lrow & 15)) << 4));
                fb[ks] = *(const SC_LAS bf16x8*)(lds + L_H + prow * 256 + ((chk ^ (prow & 15)) << 4));
            }
            __builtin_amdgcn_sched_barrier(0);
#pragma unroll
            for (int ks = 0; ks < 8; ++ks) yacc = __builtin_amdgcn_mfma_f32_32x32x16_bf16(fa[ks], fb[ks], yacc, 0, 0, 0);
        }
        SC_BAR();
        if (wid >= 4) {
#pragma unroll
            for (int r = 0; r < 16; ++r) yacc[r] *= s_ea[32 * yli + (r & 3) + 8 * (r >> 2) + 4 * hi];
            const int lrow = 32 * yli + r32;
            const int tbn = ((lane >> 4) & 1) * 32 + (lane & 3) * 8 + hi * 512 + ((lane & 15) >> 2) * 64;
            bf16x8 ga[4]; s16x4 xb0[4], xb1[4];
#pragma unroll
            for (int ks = 0; ks < 4; ++ks) {
                const int chk = 2 * ks + hi;
                ga[ks] = *(const SC_LAS bf16x8*)(lds + L_G + lrow * 128 + ((chk ^ (lrow & 7)) << 4));
                xb0[ks] = vtr(lds + L_XD + ypi * 4096 + ks * 1024 + tbn); xb1[ks] = vtr(lds + L_XD + ypi * 4096 + ks * 1024 + tbn + 256);
            }
            __builtin_amdgcn_sched_barrier(0);
#pragma unroll
            for (int ks = 0; ks < 4; ++ks) {
                if (ks < 2 * (yli + 1)) {
                    const bf16x8 bb = {xb0[ks][0], xb0[ks][1], xb0[ks][2], xb0[ks][3], xb1[ks][0], xb1[ks][1], xb1[ks][2], xb1[ks][3]};
                    yacc = __builtin_amdgcn_mfma_f32_32x32x16_bf16(ga[ks], bb, yacc, 0, 0, 0);
                }
            }
#pragma unroll
            for (int r = 0; r < 16; ++r) ((SC_LAS float*)(lds + L_Y))[(32 * yli + (r & 3) + 8 * (r >> 2) + 4 * hi) * 68 + 32 * ypi + r32] = yacc[r];
        } else {
            const float cd = __expf(s_acs[63]);
#pragma unroll
            for (int r = 0; r < 16; ++r) { hacc0[r] *= cd; hacc1[r] *= cd; }
            const int tb = ((lane >> 4) & 1) * 32 + (lane & 3) * 8 + (4 * hi + ((lane & 15) >> 2)) * 64;
            s16x4 a0[4], a1[4], b0[4], b1[4], c0[4], c1[4];
#pragma unroll
            for (int ks = 0; ks < 4; ++ks) {
                a0[ks] = vtr(lds + L_B + wid * 4096 + ks * 1024 + tb); a1[ks] = vtr(lds + L_B + wid * 4096 + ks * 1024 + 512 + tb);
                b0[ks] = vtr(lds + L_XW + ks * 1024 + tb); b1[ks] = vtr(lds + L_XW + ks * 1024 + 512 + tb);
                c0[ks] = vtr(lds + L_XW + 4096 + ks * 1024 + tb); c1[ks] = vtr(lds + L_XW + 4096 + ks * 1024 + 512 + tb);
            }
            __builtin_amdgcn_sched_barrier(0);
#pragma unroll
            for (int ks = 0; ks < 4; ++ks) {
                const bf16x8 a = {a0[ks][0], a0[ks][1], a0[ks][2], a0[ks][3], a1[ks][0], a1[ks][1], a1[ks][2], a1[ks][3]};
                const bf16x8 bb = {b0[ks][0], b0[ks][1], b0[ks][2], b0[ks][3], b1[ks][0], b1[ks][1], b1[ks][2], b1[ks][3]};
                const bf16x8 cc = {c0[ks][0], c0[ks][1], c0[ks][2], c0[ks][3], c1[ks][0], c1[ks][1], c1[ks][2], c1[ks][3]};
                hacc0 = __builtin_amdgcn_mfma_f32_32x32x16_bf16(a, bb, hacc0, 0, 0, 0);
                hacc1 = __builtin_amdgcn_mfma_f32_32x32x16_bf16(a, cc, hacc1, 0, 0, 0);
            }
#pragma unroll
            for (int q4 = 0; q4 < 4; ++q4) {
                const int n0 = 32 * wid + 8 * q4 + 4 * hi;
                u32x2 w0, w1; w0.x = cvtpk(hacc0[4 * q4 + 0], hacc0[4 * q4 + 1]); w0.y = cvtpk(hacc0[4 * q4 + 2], hacc0[4 * q4 + 3]);
                w1.x = cvtpk(hacc1[4 * q4 + 0], hacc1[4 * q4 + 1]); w1.y = cvtpk(hacc1[4 * q4 + 2], hacc1[4 * q4 + 3]);
                *(SC_LAS u32x2*)(lds + L_H + r32 * 256 + (((n0 >> 3) ^ (r32 & 15)) << 4) + (n0 & 7) * 2) = w0;
                *(SC_LAS u32x2*)(lds + L_H + (32 + r32) * 256 + (((n0 >> 3) ^ (r32 & 15)) << 4) + (n0 & 7) * 2) = w1;
            }
        }
        SC_BAR();
        {
            const SC_LAS float* yr = (const SC_LAS float*)(lds + L_Y) + orow * 68 + ocg * 8;
            const f32x4 y0 = *(const SC_LAS f32x4*)yr, y1 = *(const SC_LAS f32x4*)(yr + 4);
            float yv[8];
#pragma unroll
            for (int i = 0; i < 4; ++i) {
                const float ya = (i < 2) ? y0[2 * i] : y1[2 * i - 4], yb = (i < 2) ? y0[2 * i + 1] : y1[2 * i - 3];
                yv[2 * i] = (ya + dsk * lo16(xcur[i])) * lo16(zcur[i]); yv[2 * i + 1] = (yb + dsk * hi16(xcur[i])) * hi16(zcur[i]);
            }
            float ss = 0.f;
#pragma unroll
            for (int i = 0; i < 8; ++i) ss += yv[i] * yv[i];
            ss += __shfl_xor(ss, 1); ss += __shfl_xor(ss, 2); ss += __shfl_xor(ss, 4);
            if (ocg == 0) P.ssqp[(rowb + t0 + orow) * 32 + h] = ss;
            u32x4 w; w.x = cvtpk(yv[0], yv[1]); w.y = cvtpk(yv[2], yv[3]); w.z = cvtpk(yv[4], yv[5]); w.w = cvtpk(yv[6], yv[7]);
            if (!P.dry) *(u32x4*)(P.zp + (rowb + t0 + orow) * 2048 + h * 64 + ocg * 8) = w;
        }
    }
    __syncthreads();
#undef SC_LOAD
}
}
namespace mk {
#define GAS __attribute__((address_space(1)))
#define LAS __attribute__((address_space(3)))
typedef unsigned short bf16;
typedef unsigned v4u __attribute__((ext_vector_type(4)));
typedef float f32x4 __attribute__((ext_vector_type(4)));
typedef GAS unsigned gu32;
#define RLX_AGENT __ATOMIC_RELAXED, __HIP_MEMORY_SCOPE_AGENT
constexpr int NWAVES = 8;
constexpr int M = 16384, D = 1024, SEQ = 2048, NB = 8;
constexpr int SSD_NP = 5376, SSD_IN = 5152, SSD_DI = 2048, SSD_LD = 5120;
constexpr int AT_IN = 3072, DFF = 2816;
constexpr size_t MiB = 1u << 20;
constexpr size_t WS_CTL = 0, CTL_ZERO_BYTES = 64 * 1024;
constexpr size_t WS_CONST = 64 * 1024;
constexpr size_t WS_SSQ = 1 * MiB;
constexpr size_t WS_ROPE = 2 * MiB;
constexpr size_t WS_DT = 3 * MiB;
constexpr size_t WS_SSQP = 5 * MiB;
constexpr size_t WS_CP = 1 * MiB + 512 * 1024;
constexpr size_t WS_W = 7 * MiB;
constexpr size_t W_SSD_IN = 0, W_SSD_IN_SZ = (size_t)SSD_NP * D * 2;
constexpr size_t W_SSD_OUT = W_SSD_IN + 2 * W_SSD_IN_SZ, W_SSD_OUT_SZ = (size_t)D * SSD_DI * 2;
constexpr size_t W_AT_IN = W_SSD_OUT + 2 * W_SSD_OUT_SZ, W_AT_IN_SZ = (size_t)AT_IN * D * 2;
constexpr size_t W_AT_OUT = W_AT_IN + 2 * W_AT_IN_SZ, W_AT_OUT_SZ = (size_t)D * D * 2;
constexpr size_t W_UP = W_AT_OUT + 2 * W_AT_OUT_SZ, W_UP_SZ = (size_t)2 * DFF * D * 2;
constexpr size_t W_DOWN = W_UP + 4 * W_UP_SZ, W_DOWN_SZ = (size_t)D * DFF * 2;
constexpr size_t W_TOTAL = W_DOWN + 4 * W_DOWN_SZ;
constexpr size_t WS_XB = ((WS_W + W_TOTAL + MiB - 1) / MiB) * MiB;
constexpr size_t XB_PAD_FRONT = 4 * D * 2, XB_BYTES = (size_t)(M + 260) * D * 2;
constexpr size_t WS_BIG = ((WS_XB + XB_BYTES + MiB - 1) / MiB) * MiB;
constexpr size_t BIG_BYTES = (size_t)M * SSD_LD * 2;
constexpr size_t WS_DBG = WS_BIG + BIG_BYTES;
constexpr size_t WS_END = WS_DBG;
static_assert(WS_END <= 352 * MiB, "workspace map exceeds the guaranteed 352 MiB");
constexpr int CW_BAR = 1024;
constexpr int RING_BYTES = 131072, EPI_OFF = RING_BYTES, EPI_BYTES = 26624, MISC_OFF = EPI_OFF + EPI_BYTES;
constexpr int LDS_BYTES = 158720;
static_assert(MISC_OFF + 1024 <= LDS_BYTES && attn::LDS_BYTES <= RING_BYTES && scan::LDS_BYTES <= RING_BYTES, "LDS map");

#define LDS_WAIT() asm volatile("s_waitcnt lgkmcnt(0)" ::: "memory")
__device__ __forceinline__ unsigned f2bf(float f) { unsigned u = __builtin_bit_cast(unsigned, f); return (u + 0x7fffu + ((u >> 16) & 1u)) >> 16; }
__device__ __forceinline__ unsigned pk2(float lo, float hi) { return f2bf(lo) | (f2bf(hi) << 16); }

#define XB_TMO      128
#define XB_XCNT(j)  (256  + 64 * (j))
#define XB_XSUB(j)  (1280 + 64 * (j))
#define XB_XGEN(j)  (2304 + 64 * (j))
#define XB_TOP      3328
#define XB_TOPGEN   3392
#define XCD_BAR_WORDS 3456
#define XB_SPIN_CAP (1u << 20)
__device__ __forceinline__ unsigned xb_ld(unsigned* p)              { return __hip_atomic_load(p, __ATOMIC_RELAXED, __HIP_MEMORY_SCOPE_AGENT); }
__device__ __forceinline__ unsigned xb_add(unsigned* p, unsigned v) { return __hip_atomic_fetch_add(p, v, __ATOMIC_RELAXED, __HIP_MEMORY_SCOPE_AGENT); }
__device__ __forceinline__ unsigned xb_xcc_id() { return (unsigned)__builtin_amdgcn_s_getreg((3 << 11) | 20) & 0xFu; }
#define XB_SPIN(cond, bar) do { unsigned _sp = 0; while (cond) { __builtin_amdgcn_s_sleep(1); \
    if ((++_sp & 255u) == 0u) { if (xb_ld(&(bar)[XB_TMO])) break; if (_sp > XB_SPIN_CAP) { atomicAdd(&(bar)[XB_TMO], 1u); break; } } } } while (0)
struct XcdBarrier { unsigned* bar; unsigned x; volatile LAS unsigned* st; };
__device__ __forceinline__ XcdBarrier xcd_barrier_post(unsigned* bar, volatile LAS unsigned* st) {
    XcdBarrier b; b.bar = bar; b.x = xb_xcc_id(); b.st = st;
    if (threadIdx.x == 0) (void)xb_add(&bar[XB_XCNT(b.x)], 1u);
    return b;
}
__device__ __forceinline__ void xcd_barrier_complete(unsigned* bar, unsigned x, unsigned& nloc, unsigned& nx) {
    const unsigned G = gridDim.x * gridDim.y * gridDim.z;
    unsigned sum, cnt, mine, sp = 0u;
    for (;;) {
        sum = 0u; cnt = 0u; mine = 0u;
#pragma unroll
        for (unsigned j = 0; j < 16; ++j) { const unsigned c = xb_ld(&bar[XB_XCNT(j)]); sum += c; cnt += (c > 0u) ? 1u : 0u; mine = (j == x) ? c : mine; }
        if (sum == G) break;
        __builtin_amdgcn_s_sleep(1);
        if ((++sp & 255u) == 0u) { if (xb_ld(&bar[XB_TMO])) break; if (sp > XB_SPIN_CAP) { atomicAdd(&bar[XB_TMO], 1u); break; } }
    }
    nloc = mine > 0u ? mine : 1u; nx = cnt > 0u ? cnt : 1u;
}
__device__ __forceinline__ void xcd_barrier(const XcdBarrier& b) {
    asm volatile("s_waitcnt vmcnt(0)" ::: "memory");
    __syncthreads();
    if (threadIdx.x == 0) {
        unsigned* bar = b.bar; asm volatile("" : "+s"(bar));
        __builtin_amdgcn_s_waitcnt(0);
        unsigned nloc = b.st[0], nx = b.st[1];
        if (nloc == 0u) { xcd_barrier_complete(bar, b.x, nloc, nx); b.st[0] = nloc; b.st[1] = nx; }
        const unsigned old = xb_add(&bar[XB_XSUB(b.x)], 1u);
        const unsigned gen = old / nloc;
        if (old + 1u == (gen + 1u) * nloc) {
            __builtin_amdgcn_fence(__ATOMIC_RELEASE, "agent");
            asm volatile("s_waitcnt vmcnt(0)" ::: "memory");
            const unsigned og = xb_add(&bar[XB_TOP], 1u);
            const unsigned tg = og / nx;
            if (og + 1u == (tg + 1u) * nx) xb_add(&bar[XB_TOPGEN], 1u);
            else XB_SPIN(xb_ld(&bar[XB_TOPGEN]) == tg, bar);
            __builtin_amdgcn_fence(__ATOMIC_ACQUIRE, "agent");
            xb_add(&bar[XB_XGEN(b.x)], 1u);
            asm volatile("s_waitcnt vmcnt(0)" ::: "memory");
        } else {
            XB_SPIN(xb_ld(&bar[XB_XGEN(b.x)]) == gen, bar);
            __builtin_amdgcn_fence(__ATOMIC_ACQUIRE, "agent");
            asm volatile("s_waitcnt vmcnt(0)" ::: "memory");
        }
    }
    __syncthreads();
}

__device__ __forceinline__ unsigned long long ldarg(LAS unsigned long long* AP, int i) {
    asm volatile("" : "+s"(i));
    const unsigned long long v = AP[i];
    return ((unsigned long long)(unsigned)__builtin_amdgcn_readfirstlane((int)(v >> 32)) << 32) | (unsigned long long)(unsigned)__builtin_amdgcn_readfirstlane((int)v);
}
struct Args { const void* in[25]; float* out; unsigned char* ws; int ph_lo, ph_hi; int dbg, pad; };

__device__ __forceinline__ float wave_sum(float v) {
#pragma unroll
    for (int o = 1; o < 64; o <<= 1) v += __shfl_xor(v, o);
    return v;
}
template <class RowMap>
__device__ __forceinline__ void transpose_item(const float* W, int K, int N, const float* gain, int gmask, float gscale, bf16* WT, const RowMap& rm, LAS float* scr, int item, int item2, int lane) {
    const int nblk = N / 32, rs = lane >> 3, c4 = lane & 7, c = lane & 7;
    f32x4 va[8], vb[8]; float ga[8], gb[8];
    const int kA = 64 * (item / nblk), nA = 32 * (item % nblk);
    const int it2 = item2 < 0 ? item : item2; const int kB = 64 * (it2 / nblk), nB = 32 * (it2 % nblk);
#pragma unroll
    for (int i = 0; i < 8; ++i) { const int kk = 8 * i + rs; va[i] = *(const f32x4*)(W + (size_t)(kA + kk) * N + nA + 4 * c4); ga[i] = gain ? gain[(kA + kk) & gmask] * gscale : 1.0f; }
    if (item2 >= 0) {
#pragma unroll
        for (int i = 0; i < 8; ++i) { const int kk = 8 * i + rs; vb[i] = *(const f32x4*)(W + (size_t)(kB + kk) * N + nB + 4 * c4); gb[i] = gain ? gain[(kB + kk) & gmask] * gscale : 1.0f; }
    }
#pragma unroll
    for (int h = 0; h < 2; ++h) {
        if (h == 1 && item2 < 0) break;
        const int k0 = h ? kB : kA, n0 = h ? nB : nA;
#pragma unroll
        for (int i = 0; i < 8; ++i) { const int kk = 8 * i + rs; LAS float* d = scr + kk * 33 + 4 * c4; const f32x4 v = h ? vb[i] : va[i]; const float g = h ? gb[i] : ga[i]; d[0] = v[0] * g; d[1] = v[1] * g; d[2] = v[2] * g; d[3] = v[3] * g; }
        LDS_WAIT(); asm volatile("" ::: "memory");
#pragma unroll
        for (int j = 0; j < 4; ++j) { const int n = (lane >> 3) + 8 * j; const LAS float* sp = scr + (8 * c) * 33 + n;
            v4u o; o.x = pk2(sp[0 * 33], sp[1 * 33]); o.y = pk2(sp[2 * 33], sp[3 * 33]); o.z = pk2(sp[4 * 33], sp[5 * 33]); o.w = pk2(sp[6 * 33], sp[7 * 33]);
            *(GAS v4u*)(WT + (size_t)rm(n0 + n) * K + k0 + 8 * c) = o; }
        LDS_WAIT(); asm volatile("" ::: "memory");
    }
}
struct RowId { __device__ __forceinline__ int operator()(int n) const { return n; } };
struct RowUp { __device__ __forceinline__ int operator()(int n) const { const int u = n >= DFF, ch = u ? n - DFF : n; return (ch >> 7) * 256 + u * 128 + (ch & 127); } };

__global__ void __launch_bounds__(NWAVES * 64, 2) mega_fwd(Args args) {
    extern __shared__ __attribute__((aligned(16))) unsigned char lds_raw[];
    LAS unsigned char* lds = (LAS unsigned char*)lds_raw;
    volatile LAS unsigned* MISC = (volatile LAS unsigned*)(lds + MISC_OFF);
    const int G = gridDim.x; const int bx = blockIdx.x; const int vcu = (G % 8 == 0) ? (bx % 8) * (G / 8) + bx / 8 : bx;
    gu32* ctl = (gu32*)(args.ws + WS_CTL);
    if (threadIdx.x < 64) MISC[threadIdx.x] = 0u;
    __syncthreads();
    XcdBarrier bar = xcd_barrier_post((unsigned*)ctl + CW_BAR, MISC + 8);
#define GRID_BAR() xcd_barrier(bar)
    LAS unsigned long long* AP = (LAS unsigned long long*)(lds + MISC_OFF + 256);
    if (threadIdx.x < 27) AP[threadIdx.x] = ((const unsigned long long*)&args)[threadIdx.x];
    __syncthreads();
#define ARGP(T, i) ((T)(GAS void*)ldarg(AP, i))
#define x_in   ARGP(const float*, 0)
#define pos    ARGP(const int*, 1)
#define nmg    ARGP(const float*, 2)
#define nfg    ARGP(const float*, 3)
#define s_inw  ARGP(const float*, 4)
#define s_cw   ARGP(const float*, 5)
#define s_cb   ARGP(const float*, 6)
#define s_dtb  ARGP(const float*, 7)
#define s_alog ARGP(const float*, 8)
#define s_d    ARGP(const float*, 9)
#define s_ng   ARGP(const float*, 10)
#define s_ow   ARGP(const float*, 11)
#define a_inw  ARGP(const float*, 12)
#define a_qg   ARGP(const float*, 13)
#define a_kg   ARGP(const float*, 14)
#define a_lq1  ARGP(const float*, 15)
#define a_lk1  ARGP(const float*, 16)
#define a_lq2  ARGP(const float*, 17)
#define a_lk2  ARGP(const float*, 18)
#define a_sg   ARGP(const float*, 19)
#define a_ow   ARGP(const float*, 20)
#define f_uw   ARGP(const float*, 21)
#define f_cw   ARGP(const float*, 22)
#define f_cb   ARGP(const float*, 23)
#define f_dw   ARGP(const float*, 24)
#define xout   ARGP(float*, 25)
#define ws     ARGP(unsigned char*, 26)
#define cst    ((float*)(ws + WS_CONST))
#define SSQ    ((float*)(ws + WS_SSQ))
#define ROPE   ((float*)(ws + WS_ROPE))
#define DT     ((float*)(ws + WS_DT))
#define SSQP   ((float*)(ws + WS_SSQP))
#define Wb     ((bf16*)(ws + WS_W))
#define XB     ((bf16*)(ws + WS_XB + XB_PAD_FRONT))
#define BIG    ((bf16*)(ws + WS_BIG))
#define CPT    ((float*)(ws + WS_CP))
#define ZPL    ((bf16*)(ws + WS_BIG))
#define XBCPL  ((bf16*)(ws + WS_BIG + (size_t)M * SSD_DI * 2))
#define CONV_MATRIX(kind_, idx_, worker_, nworkers_) do { \
        int tid_ = threadIdx.x; asm volatile("" : "+v"(tid_)); const int lane_ = tid_ & 63, wave_ = __builtin_amdgcn_readfirstlane(tid_ >> 6); \
        LAS float* scr_ = (LAS float*)(lds + wave_ * 16384); const int j_ = (idx_); \
        constexpr int I_SI = (D / 64) * (SSD_IN / 32), I_SO = (SSD_DI / 64) * (D / 32), I_AI = (D / 64) * (AT_IN / 32), I_AO = (D / 64) * (D / 32), I_UP = (D / 64) * (2 * DFF / 32), I_DN = (DFF / 64) * (D / 32); \
        if ((kind_) == 0) { for (int it = (worker_); it < I_SI; it += 2 * (nworkers_)) transpose_item(s_inw + (size_t)j_ * D * SSD_IN, D, SSD_IN, nmg + (2 * j_) * D, 1023, 1.0f, (bf16*)((char*)Wb + W_SSD_IN + j_ * W_SSD_IN_SZ), RowId(), scr_, it, (it + (nworkers_) < I_SI) ? it + (nworkers_) : -1, lane_); \
            v4u* p_ = (v4u*)((char*)Wb + W_SSD_IN + j_ * W_SSD_IN_SZ + (size_t)SSD_IN * D * 2); const int n16_ = (SSD_NP - SSD_IN) * D * 2 / 16; \
            unsigned z_ = 0u; asm volatile("" : "+v"(z_)); for (int i = (worker_) * 64 + lane_; i < n16_; i += (nworkers_) * 64) p_[i] = (v4u){z_, z_, z_, z_}; } \
        else if ((kind_) == 1) { for (int it = (worker_); it < I_SO; it += 2 * (nworkers_)) transpose_item(s_ow + (size_t)j_ * SSD_DI * D, SSD_DI, D, s_ng + j_ * SSD_DI, 2047, 1.0f, (bf16*)((char*)Wb + W_SSD_OUT + j_ * W_SSD_OUT_SZ), RowId(), scr_, it, (it + (nworkers_) < I_SO) ? it + (nworkers_) : -1, lane_); } \
        else if ((kind_) == 2) { for (int it = (worker_); it < I_AI; it += 2 * (nworkers_)) transpose_item(a_inw + (size_t)j_ * D * AT_IN, D, AT_IN, nmg + (2 * j_ + 1) * D, 1023, 1.0f, (bf16*)((char*)Wb + W_AT_IN + j_ * W_AT_IN_SZ), RowId(), scr_, it, (it + (nworkers_) < I_AI) ? it + (nworkers_) : -1, lane_); } \
        else if ((kind_) == 3) { const float li_ = 0.8f - 0.6f * expf(-0.3f * (float)(2 * j_ + 1)); \
            for (int it = (worker_); it < I_AO; it += 2 * (nworkers_)) transpose_item(a_ow + (size_t)j_ * D * D, D, D, a_sg + j_ * 128, 127, 1.0f - li_, (bf16*)((char*)Wb + W_AT_OUT + j_ * W_AT_OUT_SZ), RowId(), scr_, it, (it + (nworkers_) < I_AO) ? it + (nworkers_) : -1, lane_); } \
        else if ((kind_) == 4) { for (int it = (worker_); it < I_UP; it += 2 * (nworkers_)) transpose_item(f_uw + (size_t)j_ * D * 2 * DFF, D, 2 * DFF, nfg + j_ * D, 1023, 1.0f, (bf16*)((char*)Wb + W_UP + j_ * W_UP_SZ), RowUp(), scr_, it, (it + (nworkers_) < I_UP) ? it + (nworkers_) : -1, lane_); } \
        else { for (int it = (worker_); it < I_DN; it += 2 * (nworkers_)) transpose_item(f_dw + (size_t)j_ * DFF * D, DFF, D, nullptr, 0, 1.0f, (bf16*)((char*)Wb + W_DOWN + j_ * W_DOWN_SZ), RowId(), scr_, it, (it + (nworkers_) < I_DN) ? it + (nworkers_) : -1, lane_); } \
    } while (0)
#define RUN_FILL(fid_, nwg_) do { const int idle0_ = (nwg_) % G; if (bx >= idle0_ && idle0_ > 0) { \
        const int wk_ = (bx - idle0_) * NWAVES + __builtin_amdgcn_readfirstlane((int)threadIdx.x >> 6), nwk_ = (G - idle0_) * NWAVES; \
          \
        unsigned long long code_ = (fid_) == 0 ? 0xff3020504010ull : (fid_) == 1 ? 0xff5141ull : (fid_) == 2 ? 0xff1101ull : (fid_) == 3 ? 0xff31215242ull : 0xff5343ull; \
        for (;;) { const int e_ = (int)(code_ & 0xffu); if (e_ == 0xff) break; code_ >>= 8; CONV_MATRIX(e_ >> 4, e_ & 15, wk_, nwk_); } } } while (0)
    const int lo = args.ph_lo, hi = args.ph_hi;
    int phase = 0;
#define IN_PHASE() (phase >= lo && phase < hi)
#define END_PHASE(ty) do { if (IN_PHASE() && phase + 1 < hi) GRID_BAR(); ++phase; } while (0)
#ifndef PROBE_EPI_MODE
#define PROBE_EPI_MODE 0
#endif
#ifdef PROBE_DUP
#define REP_BEGIN(ty) _Pragma("unroll") for (int rep_ = ((ty) == PROBE_DUP ? 0 : 1); rep_ < 2; ++rep_) { const int dry = (rep_ == 0);
#define REP_END() if (dry) GRID_BAR(); }
#else
#define REP_BEGIN(ty) { const int dry = 0;
#define REP_END() }
#endif

    if (IN_PHASE()) { REP_BEGIN(0)
        int tid = threadIdx.x; asm volatile("" : "+v"(tid));
        const int lane = tid & 63, wave = __builtin_amdgcn_readfirstlane(tid >> 6);
        LAS float* scr = (LAS float*)(lds + wave * 16384);
        const int gw = vcu * NWAVES + wave, NGW = G * NWAVES;
        CONV_MATRIX(0, 0, gw, NGW);
        { unsigned z_ = 0u; asm volatile("" : "+v"(z_));
          v4u* p = (v4u*)(ws + WS_XB); for (int i = vcu * 512 + tid; i < (int)(XB_PAD_FRONT / 16); i += G * 512) p[i] = (v4u){z_, z_, z_, z_};
          v4u* q = (v4u*)((char*)XB + (size_t)M * D * 2); for (int i = vcu * 512 + tid; i < 256 * D * 2 / 16; i += G * 512) q[i] = (v4u){z_, z_, z_, z_}; }
        for (int m = gw; m < M; m += NGW) {
            const f32x4* xr = (const f32x4*)(x_in + (size_t)m * D) + lane; float s = 0.f;
            unsigned long long* o8 = (unsigned long long*)(XB + (size_t)m * D) + lane;
#pragma unroll
            for (int j = 0; j < 4; ++j) { const f32x4 v = xr[64 * j]; s += (v[0] * v[0] + v[1] * v[1]) + (v[2] * v[2] + v[3] * v[3]); o8[64 * j] = (unsigned long long)pk2(v[0], v[1]) | ((unsigned long long)pk2(v[2], v[3]) << 32); }
            s = wave_sum(s);
            if (lane < 4) SSQ[(size_t)m * 4 + lane] = (lane == 0) ? s : 0.f;
            if (lane >= 16 && lane < 32) { const int i = lane & 7; const float invf = powf(500000.0f, -(float)(2 * i) / 16.0f); const float ang = (float)pos[m] * invf; ROPE[(size_t)m * 16 + (lane - 16)] = (lane < 24) ? cosf(ang) : sinf(ang); }
        }
        for (int i = vcu * 512 + tid; i < 2 * SSD_NP; i += G * 512) {
            const int j = i / SSD_NP, c = i % SSD_NP; float pb = 0.f, p0 = 0.f, p1 = 0.f, p2 = 0.f, p3 = 0.f;
            if (c < 2048) p3 = 1.f;
            else if (c < 5120) { const int ch = c - 2048; const float* w = s_cw + (size_t)j * 4 * 3072; pb = s_cb[(size_t)j * 3072 + ch]; p0 = w[ch]; p1 = w[3072 + ch]; p2 = w[2 * 3072 + ch]; p3 = w[3 * 3072 + ch]; }
            else if (c < 5152) { pb = s_dtb[j * 32 + (c - 5120)]; p3 = 1.f; }
            float* t = CPT + (size_t)j * 5 * SSD_NP; t[c] = pb; t[SSD_NP + c] = p0; t[2 * SSD_NP + c] = p1; t[3 * SSD_NP + c] = p2; t[4 * SSD_NP + c] = p3;
        }
        if (bx == 0 && wave == 0) {
            for (int j = 0; j < 2; ++j) {
                float mq = fabsf(a_qg[j * 64 + lane]), mkk = fabsf(a_kg[j * 64 + lane]);
                float d1 = a_lq1[j * 64 + lane] * a_lk1[j * 64 + lane], d2 = a_lq2[j * 64 + lane] * a_lk2[j * 64 + lane];
#pragma unroll
                for (int o = 1; o < 64; o <<= 1) { mq = fmaxf(mq, __shfl_xor(mq, o)); mkk = fmaxf(mkk, __shfl_xor(mkk, o)); d1 += __shfl_xor(d1, o); d2 += __shfl_xor(d2, o); }
                const float li = 0.8f - 0.6f * expf(-0.3f * (float)(2 * j + 1));
                if (lane == 0) { cst[j] = mq * mkk * 64.0f * 0.125f * 1.4426950408889634f * 1.002f + 0.01f; cst[2 + j] = expf(d1) - expf(d2) + li; }
            }
        }
    REP_END() }
    END_PHASE(0);

    for (int layer = 0; layer < 4; ++layer) {
        const int j = layer >> 1;
        const float* xsrc = (layer == 0) ? x_in : xout;
        if ((layer & 1) == 0) {
            if (IN_PHASE()) { REP_BEGIN(1)
                pg8::Gemm g{XB, (const bf16*)((const char*)Wb + W_SSD_IN + j * W_SSD_IN_SZ), D, D, 253, -3};
                pg8::StaticOrder S; S.init(65, SSD_NP / 256, G, bx);
                epi::EpiSsdConv E{ZPL, XBCPL, DT, SSQ, CPT + (size_t)j * 5 * SSD_NP};
                pg8::gemm_phase(lds, lds + EPI_OFF, g, S, E);
                RUN_FILL(layer == 0 ? 0 : 3, 65 * (SSD_NP / 256));
            REP_END() }
            END_PHASE(1);
            if (IN_PHASE()) { REP_BEGIN(2)
                scan::Params sp{XBCPL, ZPL, DT, s_alog + j * 32, s_d + j * 32, SSQP, dry};
                for (int u = vcu; u < NB * 32; u += G) scan::unit(sp, u >> 5, u & 31, (LAS char*)lds);
            REP_END() }
            END_PHASE(2);
            if (IN_PHASE()) { REP_BEGIN(4)
                pg8::Gemm g{ZPL, (const bf16*)((const char*)Wb + W_SSD_OUT + j * W_SSD_OUT_SZ), SSD_DI, SSD_DI, 256, 0};
                pg8::StaticOrder S; S.init(M / 256, D / 256, G, bx);
                epi::EpiResidualG E{xsrc, xout, XB, SSQ, SSQP, dry};
                pg8::gemm_phase(lds, lds + EPI_OFF, g, S, E);
            REP_END() }
            END_PHASE(4);
        } else {
            if (IN_PHASE()) { REP_BEGIN(5)
                pg8::Gemm g{XB, (const bf16*)((const char*)Wb + W_AT_IN + j * W_AT_IN_SZ), D, D, 256, 0};
                pg8::StaticOrder S; S.init(M / 256, AT_IN / 256, G, bx);
                epi::EpiQKV E{BIG, SSQ, a_qg + j * 64, a_kg + j * 64, ROPE};
                pg8::gemm_phase(lds, lds + EPI_OFF, g, S, E);
            REP_END() }
            END_PHASE(5);
            if (IN_PHASE()) { REP_BEGIN(6)
                attn::Params ap{BIG, cst[j], cst[2 + j], dry};
                for (int pi = vcu; pi < 512; pi += G) {
                    const int bh = pi >> 3, s = pi & 7;
                    attn::unit(ap, bh >> 3, bh & 7, s, (LAS char*)lds);
                    attn::unit(ap, bh >> 3, bh & 7, 15 - s, (LAS char*)lds);
                }
            REP_END() }
            END_PHASE(6);
            if (IN_PHASE()) { REP_BEGIN(7)
                pg8::Gemm g{BIG, (const bf16*)((const char*)Wb + W_AT_OUT + j * W_AT_OUT_SZ), AT_IN, D, 256, 0};
                pg8::StaticOrder S; S.init(M / 256, D / 256, G, bx);
                epi::EpiResidual E{xsrc, xout, XB, SSQ, dry};
                pg8::gemm_phase(lds, lds + EPI_OFF, g, S, E);
            REP_END() }
            END_PHASE(7);
        }
        if (IN_PHASE()) { REP_BEGIN(8)
            pg8::Gemm g{XB, (const bf16*)((const char*)Wb + W_UP + layer * W_UP_SZ), D, D, 254, -2};
            pg8::StaticOrder S; S.init(65, 2 * DFF / 256, G, bx);
            epi::EpiConvGate E{BIG, SSQ, f_cw + (size_t)layer * 3 * 2 * DFF, f_cb + (size_t)layer * 2 * DFF, dry * PROBE_EPI_MODE};
            pg8::gemm_phase(lds, lds + EPI_OFF, g, S, E);
            if (layer < 3) RUN_FILL(layer == 0 ? 1 : (layer == 1 ? 2 : 4), 65 * (2 * DFF / 256));
        REP_END() }
        END_PHASE(8);
        if (IN_PHASE()) { REP_BEGIN(9)
            pg8::Gemm g{BIG, (const bf16*)((const char*)Wb + W_DOWN + layer * W_DOWN_SZ), DFF, DFF, 256, 0};
            pg8::StaticOrder S; S.init(M / 256, D / 256, G, bx);
            epi::EpiResidual E{xout, xout, XB, SSQ, dry};
            pg8::gemm_phase(lds, lds + EPI_OFF, g, S, E);
        REP_END() }
        END_PHASE(9);
    }
#ifdef PROBE_EXTRA_BARS
    for (int i_ = 0; i_ < PROBE_EXTRA_BARS; ++i_) GRID_BAR();
#endif
}
#undef CONV_MATRIX
#undef RUN_FILL
#undef x_in
#undef pos
#undef nmg
#undef nfg
#undef s_inw
#undef s_cw
#undef s_cb
#undef s_dtb
#undef s_alog
#undef s_d
#undef s_ng
#undef s_ow
#undef a_inw
#undef a_qg
#undef a_kg
#undef a_lq1
#undef a_lk1
#undef a_lq2
#undef a_lk2
#undef a_sg
#undef a_ow
#undef f_uw
#undef f_cw
#undef f_cb
#undef f_dw
#undef xout
#undef ws
#undef cst
#undef SSQ
#undef ROPE
#undef DT
#undef SSQP
#undef Wb
#undef XB
#undef BIG
#undef CPT
#undef ZPL
#undef XBCPL
#undef ARGP
constexpr int N_PHASES = 1 + 2 * 5 + 2 * 5;

static int g_grid = 0;
static void launch(void* const* d_in, float* d_out, void* d_ws, int ph_lo, int ph_hi, hipStream_t stream) {
    if (g_grid == 0) {
        int dev = 0, cus = 0;
        if (hipGetDevice(&dev) != hipSuccess || hipDeviceGetAttribute(&cus, hipDeviceAttributeMultiprocessorCount, dev) != hipSuccess) { fprintf(stderr, "device query failed\n"); g_grid = -1; return; }
        if (hipFuncSetAttribute((const void*)mega_fwd, hipFuncAttributeMaxDynamicSharedMemorySize, LDS_BYTES) != hipSuccess) { fprintf(stderr, "hipFuncSetAttribute failed\n"); g_grid = -1; return; }
        int per_cu = 0;
        (void)hipOccupancyMaxActiveBlocksPerMultiprocessor(&per_cu, (const void*)mega_fwd, NWAVES * 64, LDS_BYTES);
        (void)hipGetLastError();
        g_grid = cus;
        fprintf(stderr, "mega_fwd: %d CUs, occupancy query %d per CU\n", cus, per_cu);
    }
    if (g_grid < 0) return;
    (void)hipMemsetAsync((char*)d_ws + WS_CTL, 0, CTL_ZERO_BYTES, stream);
    Args a{};
    for (int i = 0; i < 25; ++i) a.in[i] = d_in[i];
    a.out = d_out; a.ws = (unsigned char*)d_ws; a.ph_lo = ph_lo; a.ph_hi = ph_hi;
    void* params[] = {&a};
    hipError_t e = hipLaunchCooperativeKernel((const void*)mega_fwd, dim3(g_grid), dim3(NWAVES * 64), params, LDS_BYTES, stream);
    if (e != hipSuccess) fprintf(stderr, "cooperative launch failed: %s (grid %d)\n", hipGetErrorString(e), g_grid);
}
}
extern "C" void kernel_launch(void* const* d_in, const int* in_sizes, int n_in, void* d_out, int out_size, void* d_ws, size_t ws_size, hipStream_t stream) {
    (void)in_sizes; (void)n_in; (void)out_size; (void)ws_size;
    mk::launch(d_in, (float*)d_out, d_ws, 0, mk::N_PHASES, stream);
}
```

```cpp
#include <hip/hip_runtime.h>
#include <stdint.h>
#include <math.h>
#include <cstdio>
__device__ __forceinline__ int hw_lane_() { unsigned m = ~0u; asm volatile("" : "+s"(m)); return (int)__builtin_amdgcn_mbcnt_hi(m, __builtin_amdgcn_mbcnt_lo(m, 0u)); }
#define HW_LANE() hw_lane_()
namespace pg8 {
#define PG8_LAS __attribute__((address_space(3)))
typedef unsigned short bf16_t;
typedef short bf16x8 __attribute__((ext_vector_type(8)));
typedef float f32x4 __attribute__((ext_vector_type(4)));
typedef unsigned u32x4 __attribute__((ext_vector_type(4)));
typedef unsigned u32x2 __attribute__((ext_vector_type(2)));
constexpr int BM = 256, BK = 64, HALF = 128, HTB = HALF * BK * 2  , STAGE_BYTES = 8 * HTB, NXCD = 8, WGM = 8;

__host__ __device__ __forceinline__ int lds_byte(int r, int c) { const int st = (r >> 4) * 2 + (c >> 5), rr = r & 15, cc = c & 31, ob = rr * 64 + cc * 2; return st * 1024 + (ob ^ (((ob >> 9) & 1) << 5)); }
__host__ __device__ __forceinline__ void stage_rc(int b, int& R, int& C) { const int st = b / 1024, sb = b % 1024, swz = sb ^ (((sb >> 9) & 1) << 5); R = (st >> 1) * 16 + swz / 64; C = (st & 1) * 32 + (swz % 64) / 2; }
__host__ __device__ __forceinline__ int perm32(int rho) { const int n = rho >> 4, i = rho & 15; return 8 * (i >> 2) + 4 * n + (i & 3); }

struct Unit { int pm, pn; };
struct Gemm { const bf16_t* A; const bf16_t* Bt; int lda, K, a_stride, a_off; };

struct StaticOrder {
    int nM, nN, nwg, G, c;
    __host__ __device__ void init(int nM_, int nN_, int G_, int c_) { nM = nM_; nN = nN_; nwg = nM * nN; G = G_; c = c_; }
    __host__ __device__ bool next(int i, Unit& u) const {
        const long L = (long)i * G + c; if (L >= nwg) return false;
        int wgid = (int)L; { const int q = nwg / NXCD, r = nwg % NXCD, xcd = wgid % NXCD, off = wgid / NXCD; wgid = (xcd < r ? xcd * (q + 1) : r * (q + 1) + (xcd - r) * q) + off; }
        const int nig = WGM * nN, gid = wgid / nig, fm = gid * WGM, gsz = (nM - fm) < WGM ? (nM - fm) : WGM;
        u.pm = fm + ((wgid % nig) % gsz); u.pn = (wgid % nig) / gsz; return true;
    }
};

__device__ __forceinline__ unsigned cvt_pk_bf16(float lo, float hi) { unsigned r; asm volatile("v_cvt_pk_bf16_f32 %0, %1, %2" : "=v"(r) : "v"(lo), "v"(hi)); return r; }

template <class Epi, class Sched>
__device__ __forceinline__ void gemm_phase(PG8_LAS unsigned char* lds, PG8_LAS unsigned char* elds, const Gemm g, const Sched& S, const Epi& E, const int wave_s) {
    int tid = wave_s * 64 + HW_LANE(); asm volatile("" : "+v"(tid));
    const int wid = __builtin_amdgcn_readfirstlane(tid >> 6), lane = tid & 63, wr = wid >> 2, wc = wid & 3, fr = lane & 15, fq = lane >> 4;
    const int K = g.K, nt = K / BK, lda = g.lda;
    unsigned voffA[2], voffB[2]; int aoff, boff;
#define PG8_LANECONST() do { int t_ = wave_s * 64 + HW_LANE(); asm volatile("" : "+v"(t_)); const int fr_ = t_ & 15, fq_ = (t_ >> 4) & 3; \
        _Pragma("unroll") for (int i = 0; i < 2; ++i) { int R, C; stage_rc(t_ * 16 + i * 8192, R, C); const int Rb = Epi::PERM ? ((R & ~31) + perm32(R & 31)) : R; \
            const int Ra = Epi::ROWIL ? ((R & ~63) | ((R & 15) << 2) | ((R >> 4) & 3)) : R;     \
            voffA[i] = (unsigned)(Ra * lda + C) * 2u; voffB[i] = (unsigned)(Rb * K + C) * 2u; } \
        aoff = lds_byte(wr * 64 + fr_, fq_ * 8); boff = lds_byte(wc * 32 + fr_, fq_ * 8); } while (0)
    PG8_LANECONST();
    const size_t kstep = (size_t)(BK * 2);
    const size_t hstepA = (size_t)HALF * lda * 2, hstepB = (size_t)HALF * K * 2;
    const size_t tstepB = 2 * hstepB;
    const unsigned ldsw = (unsigned)wid * 1024u;
#define PG8_SA(b, h) (((b) * 2 + (h)) * HTB)
#define PG8_SB(b, h) ((4 + (b) * 2 + (h)) * HTB)
#define PG8_STAGE(bufoff, gbase, voff) do { _Pragma("unroll") for (int _i = 0; _i < 2; ++_i) \
        __builtin_amdgcn_global_load_lds((const unsigned*)((const char*)(gbase) + (voff)[_i]), (PG8_LAS unsigned*)(lds + (bufoff) + ldsw + _i * 8192), 16, 0, 0); } while (0)
#define PG8_LDA(dst, b, h) do { _Pragma("unroll") for (int m = 0; m < 4; ++m) _Pragma("unroll") for (int k = 0; k < 2; ++k) dst[m][k] = *(const PG8_LAS bf16x8*)(lds + PG8_SA(b, h) + aoff + m * 2048 + k * 1024); } while (0)
#define PG8_LDB(dst, b, h) do { _Pragma("unroll") for (int n = 0; n < 2; ++n) _Pragma("unroll") for (int k = 0; k < 2; ++k) dst[n][k] = *(const PG8_LAS bf16x8*)(lds + PG8_SB(b, h) + boff + n * 2048 + k * 1024); } while (0)
#define PG8_MMA(ai, bj, At, Bt) do { __builtin_amdgcn_s_setprio(1); _Pragma("unroll") for (int m = 0; m < 4; ++m) _Pragma("unroll") for (int n = 0; n < 2; ++n) _Pragma("unroll") for (int k = 0; k < 2; ++k) \
        acc[ai][bj][m][n] = __builtin_amdgcn_mfma_f32_16x16x32_bf16(Bt[n][k], At[m][k], acc[ai][bj][m][n], 0, 0, 0); __builtin_amdgcn_s_setprio(0); } while (0)
#define PG8_WAIT_V(n) asm volatile("s_waitcnt vmcnt(" #n ")" ::: "memory")
#define PG8_WAIT_L(n) asm volatile("s_waitcnt lgkmcnt(" #n ")" ::: "memory")
#define PG8_BAR __builtin_amdgcn_s_barrier()
#define PG8_SCHED __builtin_amdgcn_sched_barrier(0)
    Unit cur, nxt; int ui = 0;
    if (!S.next(0, cur)) return;
    if constexpr (Epi::KGROUP) E.unit_begin(cur, elds, wave_s);
    float zf = 0.f; if constexpr (!Epi::KGROUP) asm volatile("" : "+v"(zf));
    f32x4 acc[2][2][4][2];
#pragma unroll
    for (int a = 0; a < 2; ++a)
#pragma unroll
        for (int b = 0; b < 2; ++b)
#pragma unroll
            for (int m = 0; m < 4; ++m)
#pragma unroll
                for (int n = 0; n < 2; ++n) acc[a][b][m][n] = (f32x4){zf, zf, zf, zf};
    bf16x8 At[4][2], B0[2][2], B1[2][2];
    const char* cA = (const char*)g.A + ((long)cur.pm * g.a_stride + g.a_off) * (long)lda * 2; const char* cB = (const char*)g.Bt + (size_t)cur.pn * tstepB;
    PG8_STAGE(PG8_SB(0, 0), cB, voffB); PG8_STAGE(PG8_SB(0, 1), cB + hstepB, voffB); PG8_STAGE(PG8_SA(0, 0), cA, voffA); PG8_STAGE(PG8_SA(0, 1), cA + hstepA, voffA);
    if (wr == 1) PG8_BAR;
    PG8_WAIT_V(2); PG8_BAR;
    PG8_STAGE(PG8_SB(1, 0), cB + kstep, voffB); PG8_STAGE(PG8_SA(1, 0), cA + kstep, voffA); PG8_STAGE(PG8_SB(1, 1), cB + hstepB + kstep, voffB);
    PG8_WAIT_V(6); PG8_BAR;
    for (;;) {
        const bool has_next = S.next(ui + 1, nxt);
        const char* nA = has_next ? (const char*)g.A + ((long)nxt.pm * g.a_stride + g.a_off) * (long)lda * 2 : cA; const char* nB = has_next ? (const char*)g.Bt + (size_t)nxt.pn * tstepB : cB;
        for (int t = 0; t < nt; t += 2) {
            const bool last = (t == nt - 2);
            const char* a1 = cA + (size_t)(t + 1) * kstep;
            const char* a2 = last ? nA : cA + (size_t)(t + 2) * kstep; const char* b2 = last ? nB : cB + (size_t)(t + 2) * kstep;
            const char* a3 = a2 + kstep; const char* b3 = b2 + kstep;
            if constexpr (Epi::KGROUP) { if (t > 0 && (t & 7) == 0) E.kgroup(acc, t >> 3, wr, elds); }
            PG8_LDB(B0, 0, 0); PG8_LDB(B1, 0, 1); PG8_SCHED; PG8_LDA(At, 0, 0); PG8_STAGE(PG8_SA(1, 1), a1 + hstepA, voffA);
            PG8_WAIT_V(8); PG8_WAIT_L(0); PG8_BAR; PG8_MMA(0, 0, At, B0); PG8_MMA(0, 1, At, B1); PG8_BAR; PG8_SCHED;
            PG8_LDA(At, 0, 1); PG8_STAGE(PG8_SB(0, 0), b2, voffB); PG8_STAGE(PG8_SB(0, 1), b2 + hstepB, voffB); PG8_STAGE(PG8_SA(0, 0), a2, voffA);
            PG8_WAIT_V(8); PG8_WAIT_L(0); PG8_BAR; PG8_MMA(1, 0, At, B0); PG8_MMA(1, 1, At, B1); PG8_BAR; PG8_SCHED;
            PG8_LDB(B0, 1, 0); PG8_LDB(B1, 1, 1); PG8_SCHED; PG8_LDA(At, 1, 0); PG8_STAGE(PG8_SA(0, 1), a2 + hstepA, voffA);
            PG8_WAIT_V(8); PG8_WAIT_L(0); PG8_BAR; PG8_MMA(0, 0, At, B0); PG8_MMA(0, 1, At, B1); PG8_BAR; PG8_SCHED;
            PG8_LDA(At, 1, 1); PG8_STAGE(PG8_SB(1, 0), b3, voffB); PG8_STAGE(PG8_SB(1, 1), b3 + hstepB, voffB); PG8_STAGE(PG8_SA(1, 0), a3, voffA);
            PG8_WAIT_V(8); PG8_WAIT_L(0); PG8_BAR; PG8_MMA(1, 0, At, B0); PG8_MMA(1, 1, At, B1); PG8_BAR; PG8_SCHED;
        }
        if (wr == 0) PG8_BAR;
        E(acc, cur, wr, wc, elds);
        if (!has_next) break;
#pragma unroll
        for (int a = 0; a < 2; ++a)
#pragma unroll
            for (int b = 0; b < 2; ++b)
#pragma unroll
                for (int m = 0; m < 4; ++m)
#pragma unroll
                    for (int n = 0; n < 2; ++n) acc[a][b][m][n] = (f32x4){zf, zf, zf, zf};
        cur = nxt; cA = nA; cB = nB; ++ui;
        if constexpr (Epi::KGROUP) E.unit_begin(cur, elds, wave_s);
        PG8_LANECONST();
        if (wr == 1) PG8_BAR;
    }
    PG8_WAIT_V(0);
    PG8_BAR;
#undef PG8_LANECONST
#undef PG8_SA
#undef PG8_SB
#undef PG8_STAGE
#undef PG8_LDA
#undef PG8_LDB
#undef PG8_MMA
}
}
namespace epi {
using pg8::f32x4; using pg8::u32x4; using pg8::u32x2; using pg8::bf16_t; using pg8::Unit; using pg8::cvt_pk_bf16;
constexpr int MROWS = 16384, DMODEL = 1024;
constexpr float EPS = 1e-6f;
#define EPI_LAS __attribute__((address_space(3)))

__device__ __forceinline__ float row_rstd(const float* ssq, int row) {
    const f32x4 a = *(const f32x4*)(ssq + (size_t)row * 4);
    const float s = (a[0] + a[1]) + (a[2] + a[3]);
    return 1.0f / sqrtf(s * (1.0f / DMODEL) + EPS);
}
template <int MSTEP> __device__ __forceinline__ void rstd8(const float* ssq, int row0, bool clamp, float (&rs)[2][4]) {
    f32x4 p[2][4];
#pragma unroll
    for (int ai = 0; ai < 2; ++ai)
#pragma unroll
        for (int m = 0; m < 4; ++m) { int row = row0 + ai * 128 + m * MSTEP; if (clamp) row = row < 0 ? 0 : (row >= MROWS ? MROWS - 1 : row); p[ai][m] = *(const f32x4*)(ssq + (size_t)row * 4); }
#pragma unroll
    for (int ai = 0; ai < 2; ++ai)
#pragma unroll
        for (int m = 0; m < 4; ++m) { const f32x4 a = p[ai][m]; rs[ai][m] = 1.0f / sqrtf(((a[0] + a[1]) + (a[2] + a[3])) * (1.0f / DMODEL) + EPS); }
}
template <int CTRL> __device__ __forceinline__ float dppf(float old, float src) {
    return __builtin_bit_cast(float, __builtin_amdgcn_update_dpp(__builtin_bit_cast(int, old), __builtin_bit_cast(int, src), CTRL, 0xF, 0xF, false));
}
template <int CTRL> __device__ __forceinline__ float dppa(float src) {
    return __builtin_bit_cast(float, __builtin_amdgcn_mov_dpp(__builtin_bit_cast(int, src), CTRL, 0xF, 0xF, true));
}
__device__ __forceinline__ f32x4 silu4(f32x4 v) {
    const f32x4 t = v * (-1.4426950408889634f); f32x4 e;
#pragma unroll
    for (int i = 0; i < 4; ++i) e[i] = __builtin_amdgcn_exp2f(t[i]);
    e = e + 1.0f;
#pragma unroll
    for (int i = 0; i < 4; ++i) e[i] = __builtin_amdgcn_rcpf(e[i]);
    return v * e;
}
template <int CTRL> __device__ __forceinline__ float dppz(float src) {
    return __builtin_bit_cast(float, __builtin_amdgcn_update_dpp(0, __builtin_bit_cast(int, src), CTRL, 0xF, 0xF, true));
}
__device__ __forceinline__ float silu_fast(float v) { return v * __builtin_amdgcn_rcpf(1.0f + __builtin_amdgcn_exp2f(-1.4426950408889634f * v)); }

template <int MODE  > struct EpiResidual {
    static constexpr bool PERM = true, ROWIL = false, KGROUP = false;
    const float* xin_f32; float* xout_f32; bf16_t* xh; bf16_t* xl; float* ssq; int dry;
    __device__ __forceinline__ void operator()(f32x4 (&acc)[2][2][4][2], const Unit& u, int wr, int wc, EPI_LAS unsigned char* elds) const {
        int fr, fq; { int t_ = HW_LANE(); asm volatile("" : "+v"(t_)); fr = t_ & 15; fq = (t_ >> 4) & 3; }
        EPI_LAS float* P = (EPI_LAS float*)elds;
        const int col0 = u.pn * 256 + wc * 32 + 8 * fq;
#pragma unroll
        for (int ai = 0; ai < 2; ++ai) {
            u32x4 xa[4][2], xb_[4][2];
#pragma unroll
            for (int m = 0; m < 4; ++m)
#pragma unroll
                for (int bj = 0; bj < 2; ++bj) {
                    const size_t o = (size_t)(u.pm * 256 + ai * 128 + wr * 64 + m * 16 + fr) * DMODEL + col0 + bj * 128;
                    if (MODE == 1) { xa[m][bj] = *(const u32x4*)(xin_f32 + o); xb_[m][bj] = *(const u32x4*)(xin_f32 + o + 4); }
                    else { xa[m][bj] = *(const u32x4*)(xh + o); xb_[m][bj] = *(const u32x4*)(xl + o); }
                }
#pragma unroll
            for (int m = 0; m < 4; ++m) {
                const int row = u.pm * 256 + ai * 128 + wr * 64 + m * 16 + fr;
                float s = 0.f;
#pragma unroll
                for (int bj = 0; bj < 2; ++bj) {
                    const size_t o = (size_t)row * DMODEL + col0 + bj * 128;
                    f32x4 v0, v1;
                    if (MODE == 1) { v0 = __builtin_bit_cast(f32x4, xa[m][bj]); v1 = __builtin_bit_cast(f32x4, xb_[m][bj]); }
                    else {
#pragma unroll
                        for (int i = 0; i < 2; ++i) {
                            v0[2 * i] = __builtin_bit_cast(float, xa[m][bj][i] << 16) + __builtin_bit_cast(float, xb_[m][bj][i] << 16);
                            v0[2 * i + 1] = __builtin_bit_cast(float, xa[m][bj][i] & 0xffff0000u) + __builtin_bit_cast(float, xb_[m][bj][i] & 0xffff0000u);
                            v1[2 * i] = __builtin_bit_cast(float, xa[m][bj][2 + i] << 16) + __builtin_bit_cast(float, xb_[m][bj][2 + i] << 16);
                            v1[2 * i + 1] = __builtin_bit_cast(float, xa[m][bj][2 + i] & 0xffff0000u) + __builtin_bit_cast(float, xb_[m][bj][2 + i] & 0xffff0000u);
                        }
                    }
                    v0 = v0 + acc[ai][bj][m][0]; v1 = v1 + acc[ai][bj][m][1];
                    s += ((v0[0] * v0[0] + v0[1] * v0[1]) + (v0[2] * v0[2] + v0[3] * v0[3])) + ((v1[0] * v1[0] + v1[1] * v1[1]) + (v1[2] * v1[2] + v1[3] * v1[3]));
                    if (MODE == 2) { if (!dry) { *(f32x4*)(xout_f32 + o) = v0; *(f32x4*)(xout_f32 + o + 4) = v1; } }
                    else {
                        u32x4 h; h.x = cvt_pk_bf16(v0[0], v0[1]); h.y = cvt_pk_bf16(v0[2], v0[3]); h.z = cvt_pk_bf16(v1[0], v1[1]); h.w = cvt_pk_bf16(v1[2], v1[3]);
                        u32x4 l;
                        l.x = cvt_pk_bf16(v0[0] - __builtin_bit_cast(float, h.x << 16), v0[1] - __builtin_bit_cast(float, h.x & 0xffff0000u));
                        l.y = cvt_pk_bf16(v0[2] - __builtin_bit_cast(float, h.y << 16), v0[3] - __builtin_bit_cast(float, h.y & 0xffff0000u));
                        l.z = cvt_pk_bf16(v1[0] - __builtin_bit_cast(float, h.z << 16), v1[1] - __builtin_bit_cast(float, h.z & 0xffff0000u));
                        l.w = cvt_pk_bf16(v1[2] - __builtin_bit_cast(float, h.w << 16), v1[3] - __builtin_bit_cast(float, h.w & 0xffff0000u));
                        if (!dry) { *(u32x4*)(xh + o) = h; *(u32x4*)(xl + o) = l; }
                    }
                }
                s += __shfl_xor(s, 16); s += __shfl_xor(s, 32);
                if (fq == 0) P[(ai * 128 + wr * 64 + m * 16 + fr) * 4 + wc] = s;
            }
            asm volatile("" ::: "memory");
        }
        asm volatile("s_waitcnt lgkmcnt(0)" ::: "memory"); __builtin_amdgcn_s_barrier(); asm volatile("" ::: "memory");
        { const int t = (wr * 4 + wc) * 64 + fq * 16 + fr; if (t < 256) { const f32x4 p = *(const EPI_LAS f32x4*)(P + t * 4); ssq[(size_t)(u.pm * 256 + t) * 4 + u.pn] = (p[0] + p[1]) + (p[2] + p[3]); } }
        asm volatile("s_waitcnt lgkmcnt(0)" ::: "memory"); __builtin_amdgcn_s_barrier(); asm volatile("" ::: "memory");
    }
};

template <int MODE> struct EpiResidualG {
    static constexpr bool PERM = true, ROWIL = false, KGROUP = true;
    const float* xin_f32; bf16_t* xh; bf16_t* xl; float* ssq; const float* ssqp; int dry;
    __device__ __forceinline__ void unit_begin(const Unit& u, EPI_LAS unsigned char* elds, int wave_s) const {
        int t = wave_s * 64 + HW_LANE(); asm volatile("" : "+v"(t));
        if (t < 256) {
            const f32x4* p = (const f32x4*)(ssqp + (size_t)(u.pm * 256 + t) * 32);
            float r[4];
#pragma unroll
            for (int g = 0; g < 4; ++g) { const f32x4 a = p[2 * g], b = p[2 * g + 1]; r[g] = 1.0f / sqrtf((((a[0] + a[1]) + (a[2] + a[3])) + ((b[0] + b[1]) + (b[2] + b[3]))) * (1.0f / 512.0f) + EPS); }
            *(EPI_LAS f32x4*)(elds + 4096 + t * 16) = (f32x4){r[0] / r[1], r[1] / r[2], r[2] / r[3], r[3]};
        }
    }
    __device__ __forceinline__ void kgroup(f32x4 (&acc)[2][2][4][2], int g, int wr, EPI_LAS unsigned char* elds) const {
        int fr; { int t_ = HW_LANE(); asm volatile("" : "+v"(t_)); fr = t_ & 15; }
        const EPI_LAS float* RG = (const EPI_LAS float*)(elds + 4096) + (g - 1);
#pragma unroll
        for (int ai = 0; ai < 2; ++ai)
#pragma unroll
            for (int m = 0; m < 4; ++m) {
                const float f = RG[(ai * 128 + wr * 64 + m * 16 + fr) * 4];
#pragma unroll
                for (int bj = 0; bj < 2; ++bj) { acc[ai][bj][m][0] *= f; acc[ai][bj][m][1] *= f; }
            }
    }
    __device__ __forceinline__ void operator()(f32x4 (&acc)[2][2][4][2], const Unit& u, int wr, int wc, EPI_LAS unsigned char* elds) const {
        kgroup(acc, 4, wr, elds);
        const EpiResidual<MODE> R{xin_f32, nullptr, xh, xl, ssq, dry};
        R(acc, u, wr, wc, elds);
    }
};

struct EpiSsdIn {
    static constexpr bool PERM = true, ROWIL = false, KGROUP = false;
    bf16_t* proj; float* dt; const float* dtbias; const float* ssq;
    __device__ __forceinline__ void operator()(f32x4 (&acc)[2][2][4][2], const Unit& u, int wr, int wc, EPI_LAS unsigned char*) const {
        int fr, fq; { int t_ = HW_LANE(); asm volatile("" : "+v"(t_)); fr = t_ & 15; fq = (t_ >> 4) & 3; }
        float rsv[2][4]; rstd8<16>(ssq, u.pm * 256 + wr * 64 + fr, false, rsv);
#pragma unroll
        for (int ai = 0; ai < 2; ++ai)
#pragma unroll
            for (int m = 0; m < 4; ++m) {
                const int row = u.pm * 256 + ai * 128 + wr * 64 + m * 16 + fr;
                const float rs = rsv[ai][m];
                if (u.pn < 20) {
#pragma unroll
                    for (int bj = 0; bj < 2; ++bj) {
                        const f32x4 v0 = acc[ai][bj][m][0] * rs, v1 = acc[ai][bj][m][1] * rs;
                        u32x4 w; w.x = cvt_pk_bf16(v0[0], v0[1]); w.y = cvt_pk_bf16(v0[2], v0[3]); w.z = cvt_pk_bf16(v1[0], v1[1]); w.w = cvt_pk_bf16(v1[2], v1[3]);
                        *(u32x4*)(proj + (size_t)row * 5120 + u.pn * 256 + bj * 128 + wc * 32 + 8 * fq) = w;
                    }
                } else if (wc == 0) {
#pragma unroll
                    for (int n = 0; n < 2; ++n) {
                        const int c = 8 * fq + 4 * n;
                        const f32x4 b = *(const f32x4*)(dtbias + c);
                        f32x4 v = acc[ai][0][m][n] * rs + b, o;
#pragma unroll
                        for (int e = 0; e < 4; ++e) o[e] = fmaxf(v[e], 0.f) + log1pf(expf(-fabsf(v[e])));
                        *(f32x4*)(dt + (size_t)row * 32 + c) = o;
                    }
                }
            }
    }
};

struct EpiQKV {
    static constexpr bool PERM = true, ROWIL = false, KGROUP = false;
    bf16_t* proj; const float* ssq; const float* qg; const float* kg; const float* rope;
    __device__ __forceinline__ void operator()(f32x4 (&acc)[2][2][4][2], const Unit& u, int wr, int wc, EPI_LAS unsigned char* elds) const {
        int fr, fq; { int t_ = HW_LANE(); asm volatile("" : "+v"(t_)); fr = t_ & 15; fq = (t_ >> 4) & 3; }
        EPI_LAS float* P = (EPI_LAS float*)elds;
        EPI_LAS f32x4* RT = (EPI_LAS f32x4*)(elds + 8192);
        const bool isqk = u.pn < 8;
        f32x4 rp_[2];
        const int t_id = (wr * 4 + wc) * 64 + fq * 16 + fr;
        if (isqk) {
#pragma unroll
            for (int i = 0; i < 2; ++i) rp_[i] = *(const f32x4*)(rope + (size_t)u.pm * 256 * 16 + (size_t)(t_id * 2 + i) * 4);
        }
        float rsv[2][4]; rstd8<16>(ssq, u.pm * 256 + wr * 64 + fr, false, rsv);
#pragma unroll
        for (int ai = 0; ai < 2; ++ai)
#pragma unroll
            for (int m = 0; m < 4; ++m) {
                const int trow = ai * 128 + wr * 64 + m * 16 + fr;
                const float rs = rsv[ai][m];
#pragma unroll
                for (int bj = 0; bj < 2; ++bj) {
                    acc[ai][bj][m][0] *= rs; acc[ai][bj][m][1] *= rs;
                    if (isqk) {
                        const f32x4 a = acc[ai][bj][m][0], b = acc[ai][bj][m][1];
                        float s = ((a[0] * a[0] + a[1] * a[1]) + (a[2] * a[2] + a[3] * a[3])) + ((b[0] * b[0] + b[1] * b[1]) + (b[2] * b[2] + b[3] * b[3]));
                        s += __shfl_xor(s, 16); s += __shfl_xor(s, 32);
                        if (fq == 0) P[trow * 8 + bj * 4 + wc] = s;
                    }
                }
            }
        if (isqk) { RT[t_id * 2] = rp_[0]; RT[t_id * 2 + 1] = rp_[1]; }
        if (isqk) {
            asm volatile("s_waitcnt lgkmcnt(0)" ::: "memory"); __builtin_amdgcn_s_barrier(); asm volatile("" ::: "memory");
            const float* g = (u.pn < 4) ? qg : kg;
            const int d0 = 32 * (wc & 1) + 8 * fq;
            const f32x4 g0 = *(const f32x4*)(g + d0), g1 = *(const f32x4*)(g + d0 + 4);
            const float qs = (u.pn < 4) ? (1.4426950408889634f * 0.125f) : 1.0f;
            const bool dorope = (wc & 1) == 0;
#pragma unroll
            for (int ai = 0; ai < 2; ++ai)
#pragma unroll
                for (int m = 0; m < 4; ++m) {
                    const int trow = ai * 128 + wr * 64 + m * 16 + fr;
                    const int row = u.pm * 256 + trow;
                    f32x4 c0 = {1.f, 1.f, 1.f, 1.f}, c1 = c0, s0 = {0.f, 0.f, 0.f, 0.f}, s1 = s0;
                    if (dorope && fq < 2) {
                        c0 = RT[trow * 4 + 0]; c1 = RT[trow * 4 + 1]; s0 = RT[trow * 4 + 2]; s1 = RT[trow * 4 + 3];
                        if (fq == 0) { s0 = -s0; s1 = -s1; }
                    }
#pragma unroll
                    for (int bj = 0; bj < 2; ++bj) {
                        const float tot = P[trow * 8 + bj * 4 + wc] + P[trow * 8 + bj * 4 + (wc ^ 1)];
                        const float nr = qs / sqrtf(tot * (1.0f / 64.0f) + EPS);
                        f32x4 v0 = acc[ai][bj][m][0] * g0 * nr, v1 = acc[ai][bj][m][1] * g1 * nr;
                        if (dorope) {
                            f32x4 o0, o1;
#pragma unroll
                            for (int e = 0; e < 4; ++e) { o0[e] = __shfl_xor(v0[e], 16); o1[e] = __shfl_xor(v1[e], 16); }
                            v0 = v0 * c0 + o0 * s0; v1 = v1 * c1 + o1 * s1;
                        }
                        u32x4 w; w.x = cvt_pk_bf16(v0[0], v0[1]); w.y = cvt_pk_bf16(v0[2], v0[3]); w.z = cvt_pk_bf16(v1[0], v1[1]); w.w = cvt_pk_bf16(v1[2], v1[3]);
                        *(u32x4*)(proj + (size_t)row * 3072 + u.pn * 256 + bj * 128 + wc * 32 + 8 * fq) = w;
                    }
                    asm volatile("" ::: "memory");
                }
            asm volatile("s_waitcnt lgkmcnt(0)" ::: "memory"); __builtin_amdgcn_s_barrier(); asm volatile("" ::: "memory");
        } else {
#pragma unroll
            for (int ai = 0; ai < 2; ++ai)
#pragma unroll
                for (int m = 0; m < 4; ++m) {
                    const int row = u.pm * 256 + ai * 128 + wr * 64 + m * 16 + fr;
#pragma unroll
                    for (int bj = 0; bj < 2; ++bj) {
                        const f32x4 v0 = acc[ai][bj][m][0], v1 = acc[ai][bj][m][1];
                        u32x4 w; w.x = cvt_pk_bf16(v0[0], v0[1]); w.y = cvt_pk_bf16(v0[2], v0[3]); w.z = cvt_pk_bf16(v1[0], v1[1]); w.w = cvt_pk_bf16(v1[2], v1[3]);
                        *(u32x4*)(proj + (size_t)row * 3072 + u.pn * 256 + bj * 128 + wc * 32 + 8 * fq) = w;
                    }
                }
        }
    }
};

struct EpiSsdConv {
    static constexpr bool PERM = true, ROWIL = true, KGROUP = false;
    bf16_t* zp; bf16_t* xbc; float* dt; const float* ssq; const float* cp;
    template <bool MASK>
    __device__ __forceinline__ void conv_body(f32x4 (&acc)[2][2][4][2], const Unit& u, int wr, int wc, int fr, int fq, const EPI_LAS f32x4* hb, int R0) const {
        bf16_t* const obase = (u.pn < 8) ? zp + u.pn * 256 : xbc + (u.pn - 8) * 256;
        const int old_ = (u.pn < 8) ? 2048 : 3072;
#pragma unroll
        for (int bj = 0; bj < 2; ++bj) {
            u32x2 keep[2][4];
#pragma unroll
            for (int n = 0; n < 2; ++n) {
                const int tc = bj * 128 + wc * 32 + 8 * fq + 4 * n;
                const EPI_LAS float* pt = (const EPI_LAS float*)((const EPI_LAS unsigned char*)hb + 12288) + tc;
                const f32x4 bb = *(const EPI_LAS f32x4*)pt, w0 = *(const EPI_LAS f32x4*)(pt + 256), w1 = *(const EPI_LAS f32x4*)(pt + 512), w2 = *(const EPI_LAS f32x4*)(pt + 768), w3 = *(const EPI_LAS f32x4*)(pt + 1024);
#pragma unroll
                for (int ai = 0; ai < 2; ++ai) {
                    f32x4 h1 = {0.f, 0.f, 0.f, 0.f}, h2 = h1, h3 = h1;
                    const int pwr = wr ^ 1, pai = (wr == 1) ? ai : ai - 1;
                    if (pai >= 0 && fr == 0) { const int idx = (((pwr * 2 + pai) * 4 + wc) * 3 * 4 + fq) * 4 + bj * 2 + n;
                        h1 = hb[idx]; h2 = hb[idx + 16]; h3 = hb[idx + 32]; }
                    const f32x4 v0 = acc[ai][bj][0][n], v1 = acc[ai][bj][1][n], v2 = acc[ai][bj][2][n], v3 = acc[ai][bj][3][n];
                    f32x4 p1, p2, p3;
#pragma unroll
                    for (int e = 0; e < 4; ++e) { p1[e] = dppf<0x111>(h1[e], v1[e]); p2[e] = dppf<0x111>(h2[e], v2[e]); p3[e] = dppf<0x111>(h3[e], v3[e]); }
#pragma unroll
                    for (int m = 0; m < 4; ++m) {
                        const int trow = ai * 128 + wr * 64 + 4 * fr + m, row = R0 + trow;
                        const f32x4 cv = (m == 0) ? v0 : (m == 1) ? v1 : (m == 2) ? v2 : v3;
                        f32x4 x1 = (m == 0) ? p3 : (m == 1) ? v0 : (m == 2) ? v1 : v2;
                        f32x4 x2 = (m == 0) ? p2 : (m == 1) ? p3 : (m == 2) ? v0 : v1;
                        f32x4 x3 = (m == 0) ? p1 : (m == 1) ? p2 : (m == 2) ? p3 : v0;
                        if (MASK) { const int ts = row & 2047; const f32x4 z4 = {0.f, 0.f, 0.f, 0.f}; if (ts < 1) x1 = z4; if (ts < 2) x2 = z4; if (ts < 3) x3 = z4; }
                        const bool valid = trow >= 3 && row < MROWS;
                        const f32x4 o = silu4(bb + w0 * x3 + w1 * x2 + w2 * x1 + w3 * cv);
                        if (n == 0) { keep[ai][m].x = cvt_pk_bf16(o[0], o[1]); keep[ai][m].y = cvt_pk_bf16(o[2], o[3]); }
                        else if (valid) {
                            u32x4 w; w.x = keep[ai][m].x; w.y = keep[ai][m].y; w.z = cvt_pk_bf16(o[0], o[1]); w.w = cvt_pk_bf16(o[2], o[3]);
                            *(u32x4*)(obase + (size_t)row * old_ + tc - 4) = w;
                        }
                    }
                    asm volatile("" ::: "memory");
                }
            }
        }
    }
    __device__ __forceinline__ void operator()(f32x4 (&acc)[2][2][4][2], const Unit& u, int wr, int wc, EPI_LAS unsigned char* elds) const {
        int fr, fq; { int t_ = HW_LANE(); asm volatile("" : "+v"(t_)); fr = t_ & 15; fq = (t_ >> 4) & 3; }
        const int R0 = u.pm * 253 - 3;
        EPI_LAS f32x4* hb = (EPI_LAS f32x4*)elds;
        const int t_id = (wr * 4 + wc) * 64 + fq * 16 + fr;
        f32x4 pld = {0.f, 0.f, 0.f, 0.f};
        if (t_id < 320) pld = *(const f32x4*)(cp + (size_t)(t_id >> 6) * 5376 + u.pn * 256 + (t_id & 63) * 4);
        { float rsv[2][4]; rstd8<1>(ssq, R0 + wr * 64 + 4 * fr, true, rsv);
#pragma unroll
          for (int ai = 0; ai < 2; ++ai)
#pragma unroll
            for (int m = 0; m < 4; ++m)
#pragma unroll
                for (int bj = 0; bj < 2; ++bj) { acc[ai][bj][m][0] *= rsv[ai][m]; acc[ai][bj][m][1] *= rsv[ai][m]; } }
        if (t_id < 320) *(EPI_LAS f32x4*)((EPI_LAS unsigned char*)hb + 12288 + t_id * 16) = pld;
        if (u.pn == 20) {
            if (wc == 0) {
#pragma unroll
                for (int ai = 0; ai < 2; ++ai)
#pragma unroll
                    for (int m = 0; m < 4; ++m) {
                        const int trow = ai * 128 + wr * 64 + 4 * fr + m, row = R0 + trow;
                        if (trow >= 3 && row < MROWS) {
#pragma unroll
                            for (int n = 0; n < 2; ++n) {
                                const int c = 8 * fq + 4 * n;
                                const f32x4 b = *(const f32x4*)(cp + 20 * 256 + c);
                                f32x4 v = acc[ai][0][m][n] + b, o;
#pragma unroll
                                for (int e = 0; e < 4; ++e) o[e] = fmaxf(v[e], 0.f) + log1pf(expf(-fabsf(v[e])));
                                *(f32x4*)(dt + (size_t)row * 32 + c) = o;
                            }
                        }
                    }
            }
            return;
        }
        if (fr == 15) {
#pragma unroll
            for (int ai = 0; ai < 2; ++ai)
#pragma unroll
                for (int m = 1; m < 4; ++m) {
                    const int idx = ((((wr * 2 + ai) * 4 + wc) * 3 + (m - 1)) * 4 + fq) * 4;
                    hb[idx + 0] = acc[ai][0][m][0]; hb[idx + 1] = acc[ai][0][m][1]; hb[idx + 2] = acc[ai][1][m][0]; hb[idx + 3] = acc[ai][1][m][1];
                }
        }
        asm volatile("s_waitcnt lgkmcnt(0)" ::: "memory"); __builtin_amdgcn_s_barrier(); asm volatile("" ::: "memory");
        const int tf = (u.pm * 253) & 2047;
        if (tf <= 2 || tf + 252 >= 2048) conv_body<true>(acc, u, wr, wc, fr, fq, hb, R0); else conv_body<false>(acc, u, wr, wc, fr, fq, hb, R0);
        asm volatile("s_waitcnt lgkmcnt(0)" ::: "memory"); __builtin_amdgcn_s_barrier(); asm volatile("" ::: "memory");
    }
};

struct EpiConvGate {
    static constexpr bool PERM = true, ROWIL = true, KGROUP = false;
    bf16_t* H; const float* ssq; const float* cw; const float* cb; int dry;
    template <bool MASK>
    __device__ __forceinline__ void body(f32x4 (&acc)[2][2][4][2], const Unit& u, int wr, int wc, int fr, int fq, const EPI_LAS f32x4* hb, int R0) const {
        constexpr int DFF = 2816;
        u32x2 keep[2][4];
#pragma unroll
        for (int n = 0; n < 2; ++n) {
            const int ch = u.pn * 128 + wc * 32 + 8 * fq + 4 * n;
            const EPI_LAS float* pt = (const EPI_LAS float*)((const EPI_LAS unsigned char*)hb + 8192) + wc * 32 + 8 * fq + 4 * n;
            const f32x4 bg = *(const EPI_LAS f32x4*)pt, bu = *(const EPI_LAS f32x4*)(pt + 128);
            const f32x4 w0g = *(const EPI_LAS f32x4*)(pt + 256), w0u = *(const EPI_LAS f32x4*)(pt + 384), w1g = *(const EPI_LAS f32x4*)(pt + 512), w1u = *(const EPI_LAS f32x4*)(pt + 640), w2g = *(const EPI_LAS f32x4*)(pt + 768), w2u = *(const EPI_LAS f32x4*)(pt + 896);
#pragma unroll
            for (int ai = 0; ai < 2; ++ai) {
                f32x4 hg2 = {0.f, 0.f, 0.f, 0.f}, hg3 = hg2, hu2 = hg2, hu3 = hg2;
                const int pwr = wr ^ 1, pai = (wr == 1) ? ai : ai - 1;
                if (pai >= 0 && fr == 0) { const int idx = (((pwr * 2 + pai) * 4 + wc) * 2 * 4 + fq) * 4;
                    hg2 = hb[idx + n]; hu2 = hb[idx + 2 + n]; hg3 = hb[idx + 16 + n]; hu3 = hb[idx + 16 + 2 + n]; }
                const f32x4 g0 = acc[ai][0][0][n], g1_ = acc[ai][0][1][n], g2_ = acc[ai][0][2][n], g3_ = acc[ai][0][3][n];
                const f32x4 u0 = acc[ai][1][0][n], u1_ = acc[ai][1][1][n], u2_ = acc[ai][1][2][n], u3_ = acc[ai][1][3][n];
                f32x4 pg2, pg3, pu2, pu3;
#pragma unroll
                for (int e = 0; e < 4; ++e) { pg2[e] = dppf<0x111>(hg2[e], g2_[e]); pg3[e] = dppf<0x111>(hg3[e], g3_[e]); pu2[e] = dppf<0x111>(hu2[e], u2_[e]); pu3[e] = dppf<0x111>(hu3[e], u3_[e]); }
#pragma unroll
                for (int m = 0; m < 4; ++m) {
                    const int trow = ai * 128 + wr * 64 + 4 * fr + m, row = R0 + trow;
                    const f32x4 cg = (m == 0) ? g0 : (m == 1) ? g1_ : (m == 2) ? g2_ : g3_, cu = (m == 0) ? u0 : (m == 1) ? u1_ : (m == 2) ? u2_ : u3_;
                    f32x4 xg1 = (m == 0) ? pg3 : (m == 1) ? g0 : (m == 2) ? g1_ : g2_, xg2 = (m == 0) ? pg2 : (m == 1) ? pg3 : (m == 2) ? g0 : g1_;
                    f32x4 xu1 = (m == 0) ? pu3 : (m == 1) ? u0 : (m == 2) ? u1_ : u2_, xu2 = (m == 0) ? pu2 : (m == 1) ? pu3 : (m == 2) ? u0 : u1_;
                    if (MASK) { const int ts = row & 2047; const f32x4 z4 = {0.f, 0.f, 0.f, 0.f}; if (ts < 1) { xg1 = z4; xu1 = z4; } if (ts < 2) { xg2 = z4; xu2 = z4; } }
                    const f32x4 gv = bg + w0g * xg2 + w1g * xg1 + w2g * cg;
                    const f32x4 uv = bu + w0u * xu2 + w1u * xu1 + w2u * cu;
                    const f32x4 o = silu4(gv) * uv;
                    if (n == 0) { keep[ai][m].x = cvt_pk_bf16(o[0], o[1]); keep[ai][m].y = cvt_pk_bf16(o[2], o[3]); }
                    else if (trow >= 2 && row < MROWS) {
                        u32x4 w; w.x = keep[ai][m].x; w.y = keep[ai][m].y; w.z = cvt_pk_bf16(o[0], o[1]); w.w = cvt_pk_bf16(o[2], o[3]);
                        asm volatile("" :: "v"(w.x), "v"(w.y), "v"(w.z), "v"(w.w));
                        if (!dry) *(u32x4*)(H + (size_t)row * DFF + ch - 4) = w;
                    }
                }
                asm volatile("" ::: "memory");
            }
        }
    }
    __device__ __forceinline__ void operator()(f32x4 (&acc)[2][2][4][2], const Unit& u, int wr, int wc, EPI_LAS unsigned char* elds) const {
        int fr, fq; { int t_ = HW_LANE(); asm volatile("" : "+v"(t_)); fr = t_ & 15; fq = (t_ >> 4) & 3; }
        const int R0 = u.pm * 254 - 2;
        EPI_LAS f32x4* hb = (EPI_LAS f32x4*)elds;
        const int t_id = (wr * 4 + wc) * 64 + fq * 16 + fr;
        f32x4 pld = {0.f, 0.f, 0.f, 0.f};
        if (t_id < 256) { const int k = t_id >> 5, c = u.pn * 128 + (t_id & 31) * 4; pld = *(const f32x4*)((k < 2 ? cb + k * 2816 : cw + (size_t)(k - 2) * 2816) + c); }
        { float rsv[2][4]; rstd8<1>(ssq, R0 + wr * 64 + 4 * fr, true, rsv);
#pragma unroll
          for (int ai = 0; ai < 2; ++ai)
#pragma unroll
            for (int m = 0; m < 4; ++m)
#pragma unroll
                for (int bj = 0; bj < 2; ++bj) { acc[ai][bj][m][0] *= rsv[ai][m]; acc[ai][bj][m][1] *= rsv[ai][m]; } }
        if (t_id < 256) *(EPI_LAS f32x4*)((EPI_LAS unsigned char*)hb + 8192 + t_id * 16) = pld;
        if (fr == 15) {
#pragma unroll
            for (int ai = 0; ai < 2; ++ai)
#pragma unroll
                for (int m = 2; m < 4; ++m) {
                    const int idx = ((((wr * 2 + ai) * 4 + wc) * 2 + (m - 2)) * 4 + fq) * 4;
                    hb[idx + 0] = acc[ai][0][m][0]; hb[idx + 1] = acc[ai][0][m][1]; hb[idx + 2] = acc[ai][1][m][0]; hb[idx + 3] = acc[ai][1][m][1];
                }
        }
        asm volatile("s_waitcnt lgkmcnt(0)" ::: "memory"); __builtin_amdgcn_s_barrier(); asm volatile("" ::: "memory");
        const int tf = (u.pm * 254) & 2047;
        if (dry < 2) { if (tf <= 1 || tf + 253 >= 2048) body<true>(acc, u, wr, wc, fr, fq, hb, R0); else body<false>(acc, u, wr, wc, fr, fq, hb, R0); }
        asm volatile("s_waitcnt lgkmcnt(0)" ::: "memory"); __builtin_amdgcn_s_barrier(); asm volatile("" ::: "memory");
    }
};
}
namespace attn {
using pg8::bf16_t; using pg8::bf16x8; using pg8::f32x4; using pg8::u32x4;
typedef float f32x16 __attribute__((ext_vector_type(16)));
typedef short s16x4 __attribute__((ext_vector_type(4)));
#define AT_LAS __attribute__((address_space(3)))
constexpr int LD = 3072, SEQ = 2048;
constexpr int KT_BYTES = 16384, VT_BYTES = 16384, STG = KT_BYTES + VT_BYTES;
constexpr int L_X = 0;
constexpr int L_WSF = 2 * STG;
constexpr int L_OST = L_WSF + 8 * 256;
constexpr int LDS_BYTES = L_OST + 4 * 8192;
__device__ __forceinline__ int crow(int r, int hi) { return (r & 3) + 8 * (r >> 2) + 4 * hi; }
__device__ __forceinline__ unsigned cvtpk(float lo, float hi) { typedef float f2 __attribute__((ext_vector_type(2))); typedef __bf16 b2 __attribute__((ext_vector_type(2))); f2 v = {lo, hi}; b2 b = __builtin_convertvector(v, b2); return __builtin_bit_cast(unsigned, b); }
__device__ __forceinline__ s16x4 vtr(const AT_LAS char* p) { typedef short v4 __attribute__((ext_vector_type(4))); return __builtin_bit_cast(s16x4, __builtin_amdgcn_ds_read_tr16_b64_v4i16((AT_LAS v4*)p)); }

struct Params { bf16_t* qkv; float mb; float lam; int dry; };

__device__ __forceinline__ void unit(const Params& P, int b, int h, int blk, AT_LAS char* lds, const int wave_s) {
    int tid = wave_s * 64 + HW_LANE(); asm volatile("" : "+v"(tid));
    const int lane = tid & 63, r32 = lane & 31, hi = lane >> 5;
    const int wid = __builtin_amdgcn_readfirstlane(tid >> 6), comp = wid >> 2, w4 = wid & 3;
    const size_t rowb = (size_t)b * SEQ;
    const int q0 = blk * 128;
    const int nt = 2 * blk + 2, my_nt = 2 * blk + (w4 >> 1) + 1;
    const bf16_t* Kg = P.qkv + rowb * LD + 1024 + h * 128;
    const bf16_t* Vg = P.qkv + rowb * LD + 2048 + h * 128;
    u32x4 kreg[2], vreg[2];
    int kdst[2], vdst[2];
#pragma unroll
    for (int i = 0; i < 2; ++i) {
        const int p = tid + 512 * i, key = p >> 4, c16 = p & 15;
        kdst[i] = key * 256 + ((c16 ^ (key & 15)) << 4);
        vdst[i] = KT_BYTES + (c16 >> 2) * 4096 + (key >> 4) * 1024 + ((key >> 3) & 1) * 512 + (key & 7) * 64 + (c16 & 3) * 16;
    }
#define AT_LOAD(t) do { _Pragma("unroll") for (int i = 0; i < 2; ++i) { const int p = tid + 512 * i, key = p >> 4, c16 = p & 15; const size_t go = (size_t)((t) * 64 + key) * LD + c16 * 8; \
        kreg[i] = *(const u32x4*)(Kg + go); vreg[i] = *(const u32x4*)(Vg + go); } } while (0)
#define AT_STORE(s) do { _Pragma("unroll") for (int i = 0; i < 2; ++i) { *(AT_LAS u32x4*)(lds + (s) * STG + kdst[i]) = kreg[i]; *(AT_LAS u32x4*)(lds + (s) * STG + vdst[i]) = vreg[i]; } } while (0)
    AT_LOAD(0);
    bf16x8 qr[4];
    {
        const bf16_t* Qw = P.qkv + (rowb + q0 + w4 * 32 + r32) * LD + h * 128 + comp * 64 + hi * 8;
#pragma unroll
        for (int d0 = 0; d0 < 4; ++d0) qr[d0] = *(const bf16x8*)(Qw + d0 * 16);
    }
    AT_STORE(0);
    __syncthreads();
    f32x16 o[4];
#pragma unroll
    for (int i = 0; i < 4; ++i)
#pragma unroll
        for (int r = 0; r < 16; ++r) o[i][r] = 0.f;
    float lsum = 0.f;
    f32x16 negm;
#pragma unroll
    for (int r = 0; r < 16; ++r) negm[r] = -P.mb;
    const int kbase = r32 * 256, ksw = r32 & 15;
    const int vbase = KT_BYTES + ((lane >> 4) & 1) * 32 + (lane & 3) * 8 + (4 * hi + ((lane & 15) >> 2)) * 64;
    for (int t = 0; t < nt; ++t) {
        const int s = t & 1;
        if (t + 1 < nt) AT_LOAD(t + 1);
        if (t < my_nt) {
            const AT_LAS char* st = lds + s * STG;
            bf16x8 kf[8];
#pragma unroll
            for (int d0 = 0; d0 < 4; ++d0) {
                const int ch = comp * 8 + 2 * d0 + hi;
                kf[2 * d0] = *(const AT_LAS bf16x8*)(st + kbase + ((ch ^ ksw) << 4));
                kf[2 * d0 + 1] = *(const AT_LAS bf16x8*)(st + kbase + 32 * 256 + ((ch ^ ksw) << 4));
            }
            s16x4 vlo[2][4], vhi[2][4];
#define AT_VLOAD(bk, buf) do { _Pragma("unroll") for (int ks = 0; ks < 4; ++ks) { vlo[buf][ks] = vtr(st + vbase + (bk) * 4096 + ks * 1024); vhi[buf][ks] = vtr(st + vbase + (bk) * 4096 + ks * 1024 + 512); } } while (0)
            AT_VLOAD(0, 0);
            __builtin_amdgcn_sched_barrier(0);
            f32x16 p0 = negm, p1 = negm;
#pragma unroll
            for (int d0 = 0; d0 < 4; ++d0) {
                p0 = __builtin_amdgcn_mfma_f32_32x32x16_bf16(kf[2 * d0], qr[d0], p0, 0, 0, 0);
                p1 = __builtin_amdgcn_mfma_f32_32x32x16_bf16(kf[2 * d0 + 1], qr[d0], p1, 0, 0, 0);
            }
            __builtin_amdgcn_sched_barrier(0);
            AT_VLOAD(1, 1);
            __builtin_amdgcn_sched_barrier(0);
            float sacc0 = 0.f, sacc1 = 0.f;
#pragma unroll
            for (int r = 0; r < 16; ++r) { p0[r] = __builtin_amdgcn_exp2f(p0[r]); p1[r] = __builtin_amdgcn_exp2f(p1[r]); sacc0 += p0[r]; sacc1 += p1[r]; }
            lsum += sacc0 + sacc1;
            u32x4 pw[4];
#pragma unroll
            for (int j = 0; j < 4; ++j) { pw[0][j] = cvtpk(p0[2 * j], p0[2 * j + 1]); pw[1][j] = cvtpk(p0[8 + 2 * j], p0[8 + 2 * j + 1]); pw[2][j] = cvtpk(p1[2 * j], p1[2 * j + 1]); pw[3][j] = cvtpk(p1[8 + 2 * j], p1[8 + 2 * j + 1]); }
#define AT_PV(bk, buf) do { _Pragma("unroll") for (int ks = 0; ks < 4; ++ks) { \
                const bf16x8 vf = {vlo[buf][ks][0], vlo[buf][ks][1], vlo[buf][ks][2], vlo[buf][ks][3], vhi[buf][ks][0], vhi[buf][ks][1], vhi[buf][ks][2], vhi[buf][ks][3]}; \
                o[bk] = __builtin_amdgcn_mfma_f32_32x32x16_bf16(__builtin_bit_cast(bf16x8, pw[ks]), vf, o[bk], 0, 0, 0); } } while (0)
            __builtin_amdgcn_sched_barrier(0);
            AT_PV(0, 0); __builtin_amdgcn_sched_barrier(0); AT_VLOAD(2, 0); __builtin_amdgcn_sched_barrier(0);
            AT_PV(1, 1); __builtin_amdgcn_sched_barrier(0); AT_VLOAD(3, 1); __builtin_amdgcn_sched_barrier(0);
            AT_PV(2, 0);
            AT_PV(3, 1);
#undef AT_VLOAD
#undef AT_PV
        }
        if (t + 1 < nt) AT_STORE(s ^ 1);
        __syncthreads();
    }
    lsum += __shfl_xor(lsum, 32);
    AT_LAS float* wsf = (AT_LAS float*)(lds + L_WSF) + wid * 64;
    if (hi == 0) wsf[r32] = lsum;
    asm volatile("s_waitcnt lgkmcnt(0)" ::: "memory");
    float rl[16];
    const float sc = comp ? P.lam : 1.0f;
#pragma unroll
    for (int r = 0; r < 16; ++r) rl[r] = sc * __builtin_amdgcn_rcpf(wsf[crow(r, hi)]);
    AT_LAS float* X = (AT_LAS float*)(lds + L_X) + w4 * 4096 + lane;
    if (comp == 1) {
#pragma unroll
        for (int bk = 0; bk < 4; ++bk)
#pragma unroll
            for (int r = 0; r < 16; ++r) X[(bk * 16 + r) * 64] = o[bk][r] * rl[r];
    }
    __syncthreads();
    if (comp == 0) {
        float ss[16];
#pragma unroll
        for (int r = 0; r < 16; ++r) ss[r] = 0.f;
#pragma unroll
        for (int bk = 0; bk < 4; ++bk)
#pragma unroll
            for (int r = 0; r < 16; ++r) { const float v = o[bk][r] * rl[r] - X[(bk * 16 + r) * 64]; o[bk][r] = v; ss[r] += v * v; }
#pragma unroll
        for (int r = 0; r < 16; ++r) {
            float s = ss[r];
            s += __shfl_xor(s, 1); s += __shfl_xor(s, 2); s += __shfl_xor(s, 4); s += __shfl_xor(s, 8); s += __shfl_xor(s, 16);
            ss[r] = 1.0f / sqrtf(s * (1.0f / 128.0f) + 1e-6f);
        }
        AT_LAS bf16_t* stg = (AT_LAS bf16_t*)(lds + L_OST) + w4 * 4096;
#pragma unroll
        for (int bk = 0; bk < 4; ++bk)
#pragma unroll
            for (int r = 0; r < 16; ++r) { const float v = o[bk][r] * ss[r]; stg[crow(r, hi) * 128 + bk * 32 + r32] = (bf16_t)(cvtpk(v, 0.f) & 0xffffu); }
        asm volatile("s_waitcnt lgkmcnt(0)" ::: "memory");
        bf16_t* Ow = P.qkv + (rowb + q0 + w4 * 32) * LD + h * 128;
#pragma unroll
        for (int i = 0; i < 8; ++i) { const int row = i * 4 + (lane >> 4), c = lane & 15; const u32x4 v = *(const AT_LAS u32x4*)(stg + row * 128 + c * 8); if (!P.dry) *(u32x4*)(Ow + (size_t)row * LD + c * 8) = v; }
    }
    __syncthreads();
#undef AT_LOAD
#undef AT_STORE
}
}
namespace scan {
using pg8::bf16_t; using pg8::bf16x8; using pg8::f32x4; using pg8::u32x4; using pg8::u32x2;
typedef float f32x16 __attribute__((ext_vector_type(16)));
#define SC_LAS __attribute__((address_space(3)))
#define SC_BAR() do { asm volatile("s_waitcnt lgkmcnt(0)" ::: "memory"); __builtin_amdgcn_s_barrier(); asm volatile("" ::: "memory"); } while (0)
constexpr int SEQ = 2048, CH = 64;
constexpr int L_C = 0;
constexpr int L_B = 16384;
constexpr int L_XD = 32768;
constexpr int L_XW = 40960;
constexpr int L_G = 49152;
constexpr int L_H = 57344;
constexpr int L_Y = 73728;
constexpr int L_S = L_Y + 64 * 68 * 4;
constexpr int LDS_BYTES = L_S + 32 * 1024;
__device__ __forceinline__ unsigned cvtpk(float lo, float hi) { typedef float f2 __attribute__((ext_vector_type(2))); typedef __bf16 b2 __attribute__((ext_vector_type(2))); f2 v = {lo, hi}; b2 b = __builtin_convertvector(v, b2); return __builtin_bit_cast(unsigned, b); }
typedef short s16x4 __attribute__((ext_vector_type(4)));
__device__ __forceinline__ s16x4 vtr(const SC_LAS char* p) { typedef short v4 __attribute__((ext_vector_type(4))); return __builtin_bit_cast(s16x4, __builtin_amdgcn_ds_read_tr16_b64_v4i16((SC_LAS v4*)p)); }
__device__ __forceinline__ float lo16(unsigned w) { return __builtin_bit_cast(float, w << 16); }
__device__ __forceinline__ float hi16(unsigned w) { return __builtin_bit_cast(float, w & 0xffff0000u); }
__device__ __forceinline__ int img_off(int l) { return (l >> 4) * 1024 + ((l >> 3) & 1) * 512 + (l & 7) * 64; }

struct Params { const bf16_t* xbc; bf16_t* zp; const float* dt; const float* a_log; const float* dskip; float* ssqp; int dry; };

__device__ __forceinline__ void unit(const Params& P, int b, int h, SC_LAS char* lds, const int wave_s) {
    int tid = wave_s * 64 + HW_LANE(); asm volatile("" : "+v"(tid));
    const int wid = __builtin_amdgcn_readfirstlane(tid >> 6);
    const int g = h >> 3;
    const size_t rowb = (size_t)b * SEQ;
    const float a_h = -expf(P.a_log[h]), dsk = P.dskip[h];
    unsigned zu = 0u; asm volatile("" : "+v"(zu));
    {
        const int lane_ = tid & 63;
#pragma unroll
        for (int q = 0; q < 4; ++q) {
            const int cc = wid * 4 + q;
            const float dtv = P.dt[(rowb + cc * 64 + lane_) * 32 + h];
            float acs = dtv * a_h;
#pragma unroll
            for (int o = 1; o < 64; o <<= 1) { const float up = __shfl_up(acs, o); if (lane_ >= o) acs += up; }
            const float last = __shfl(acs, 63);
            SC_LAS float* sc = (SC_LAS float*)(lds + L_S) + cc * 256;
            sc[lane_] = dtv; sc[64 + lane_] = acs; sc[128 + lane_] = __expf(last - acs); sc[192 + lane_] = __expf(acs);
        }
    }
    for (int i = tid; i < 16384 / 16; i += 512) *(SC_LAS u32x4*)(lds + L_H + i * 16) = (u32x4){zu, zu, zu, zu};
    f32x16 hacc0, hacc1;
#pragma unroll
    for (int r = 0; r < 16; ++r) { hacc0[r] = 0.f; hacc1[r] = 0.f; }
    const int tid0 = tid;
    u32x4 xr, zr, br[2], cr[2];
#define SC_LOAD(t0_, XR, ZR) do { const int t_ = tid0; const size_t r1 = rowb + (t0_) + (t_ >> 3); \
        XR = *(const u32x4*)(P.xbc + r1 * 3072 + h * 64 + (t_ & 7) * 8); ZR = *(const u32x4*)(P.zp + r1 * 2048 + h * 64 + (t_ & 7) * 8); \
        _Pragma("unroll") for (int i = 0; i < 2; ++i) { const int p_ = t_ + 512 * i; const size_t r2 = rowb + (t0_) + (p_ >> 4); \
            br[i] = *(const u32x4*)(P.xbc + r2 * 3072 + 2048 + g * 128 + (p_ & 15) * 8); cr[i] = *(const u32x4*)(P.xbc + r2 * 3072 + 2560 + g * 128 + (p_ & 15) * 8); } } while (0)
    SC_LOAD(0, xr, zr);
    __syncthreads();
    for (int c = 0; c < SEQ / CH; ++c) {
        const int t0 = c * CH;
        int tid = tid0; asm volatile("" : "+v"(tid));
        const int lane = tid & 63, r32 = lane & 31, hi = lane >> 5, fr = lane & 15, fq = lane >> 4;
        const int orow = tid >> 3, ocg = tid & 7;
        SC_LAS float* s_dt = (SC_LAS float*)(lds + L_S) + c * 256; SC_LAS float* s_acs = s_dt + 64; SC_LAS float* s_dec = s_dt + 128; SC_LAS float* s_ea = s_dt + 192;
        {
            const float d = s_dt[orow], dd = d * s_dec[orow];
            u32x4 w1, w2;
#pragma unroll
            for (int i = 0; i < 4; ++i) { const float a = lo16(xr[i]), bq = hi16(xr[i]); w1[i] = cvtpk(a * d, bq * d); w2[i] = cvtpk(a * dd, bq * dd); }
            const int off = (ocg >> 2) * 4096 + img_off(orow) + (ocg & 3) * 16;
            *(SC_LAS u32x4*)(lds + L_XD + off) = w1; *(SC_LAS u32x4*)(lds + L_XW + off) = w2;
#pragma unroll
            for (int i = 0; i < 2; ++i) { const int p = tid + 512 * i, l = p >> 4, c16 = p & 15;
                *(SC_LAS u32x4*)(lds + L_B + (c16 >> 2) * 4096 + img_off(l) + (c16 & 3) * 16) = br[i];
                *(SC_LAS u32x4*)(lds + L_C + l * 256 + ((c16 ^ (l & 15)) << 4)) = cr[i]; }
        }
        const u32x4 xcur = xr, zcur = zr;
        if (c + 1 < SEQ / CH) SC_LOAD(t0 + CH, xr, zr);
        SC_BAR();
        f32x16 yacc;
#pragma unroll
        for (int r = 0; r < 16; ++r) yacc[r] = 0.f;
        const int yli = (wid >> 1) & 1, ypi = wid & 1;
        if (wid < 3) {
            const int si = (wid == 2) ? 1 : 0, li = (wid == 0) ? 0 : 1;
            const int srow = 32 * si + r32, lrow = 32 * li + r32;
            f32x16 cb;
#pragma unroll
            for (int r = 0; r < 16; ++r) cb[r] = 0.f;
            bf16x8 fa[8], fb[8];
#pragma unroll
            for (int ks = 0; ks < 8; ++ks) {
                const int chk = 2 * ks + hi;
                fa[ks] = *(const SC_LAS bf16x8*)(lds + L_B + (chk >> 2) * 4096 + img_off(srow) + (chk & 3) * 16);
                fb[ks] = *(const SC_LAS bf16x8*)(lds + L_C + lrow * 256 + ((chk ^ (lrow & 15)) << 4));
            }
            __builtin_amdgcn_sched_barrier(0);
#pragma unroll
            for (int ks = 0; ks < 8; ++ks) cb = __builtin_amdgcn_mfma_f32_32x32x16_bf16(fa[ks], fb[ks], cb, 0, 0, 0);
            const float al = s_acs[lrow];
#pragma unroll
            for (int q4 = 0; q4 < 4; ++q4) {
                const int s0 = 32 * si + 8 * q4 + 4 * hi;
                float gv[4];
#pragma unroll
                for (int e = 0; e < 4; ++e) { const int sidx = s0 + e; gv[e] = (sidx <= lrow) ? cb[4 * q4 + e] * __expf(al - s_acs[sidx]) : 0.f; }
                u32x2 w; w.x = cvtpk(gv[0], gv[1]); w.y = cvtpk(gv[2], gv[3]);
                *(SC_LAS u32x2*)(lds + L_G + lrow * 128 + (((s0 >> 3) ^ (lrow & 7)) << 4) + (s0 & 7) * 2) = w;
            }
        } else if (wid >= 4) {
            const int lrow = 32 * yli + r32, prow = 32 * ypi + r32;
            bf16x8 fa[8], fb[8];
#pragma unroll
            for (int ks = 0; ks < 8; ++ks) {
                const int chk = 2 * ks + hi;
                fa[ks] = *(const SC_LAS bf16x8*)(lds + L_C + lrow * 256 + ((chk ^ (lrow & 15)) << 4));
                fb[ks] = *(const SC_LAS bf16x8*)(lds + L_H + prow * 256 + ((chk ^ (prow & 15)) << 4));
            }
            __builtin_amdgcn_sched_barrier(0);
#pragma unroll
            for (int ks = 0; ks < 8; ++ks) yacc = __builtin_amdgcn_mfma_f32_32x32x16_bf16(fa[ks], fb[ks], yacc, 0, 0, 0);
        }
        SC_BAR();
        if (wid >= 4) {
#pragma unroll
            for (int r = 0; r < 16; ++r) yacc[r] *= s_ea[32 * yli + (r & 3) + 8 * (r >> 2) + 4 * hi];
            const int lrow = 32 * yli + r32;
            const int tbn = ((lane >> 4) & 1) * 32 + (lane & 3) * 8 + hi * 512 + ((lane & 15) >> 2) * 64;
            bf16x8 ga[4]; s16x4 xb0[4], xb1[4];
#pragma unroll
            for (int ks = 0; ks < 4; ++ks) {
                const int chk = 2 * ks + hi;
                ga[ks] = *(const SC_LAS bf16x8*)(lds + L_G + lrow * 128 + ((chk ^ (lrow & 7)) << 4));
                xb0[ks] = vtr(lds + L_XD + ypi * 4096 + ks * 1024 + tbn); xb1[ks] = vtr(lds + L_XD + ypi * 4096 + ks * 1024 + tbn + 256);
            }
            __builtin_amdgcn_sched_barrier(0);
#pragma unroll
            for (int ks = 0; ks < 4; ++ks) {
                if (ks < 2 * (yli + 1)) {
                    const bf16x8 bb = {xb0[ks][0], xb0[ks][1], xb0[ks][2], xb0[ks][3], xb1[ks][0], xb1[ks][1], xb1[ks][2], xb1[ks][3]};
                    yacc = __builtin_amdgcn_mfma_f32_32x32x16_bf16(ga[ks], bb, yacc, 0, 0, 0);
                }
            }
#pragma unroll
            for (int r = 0; r < 16; ++r) ((SC_LAS float*)(lds + L_Y))[(32 * yli + (r & 3) + 8 * (r >> 2) + 4 * hi) * 68 + 32 * ypi + r32] = yacc[r];
        } else {
            const float cd = __expf(s_acs[63]);
#pragma unroll
            for (int r = 0; r < 16; ++r) { hacc0[r] *= cd; hacc1[r] *= cd; }
            const int tb = ((lane >> 4) & 1) * 32 + (lane & 3) * 8 + (4 * hi + ((lane & 15) >> 2)) * 64;
            s16x4 a0[4], a1[4], b0[4], b1[4], c0[4], c1[4];
#pragma unroll
            for (int ks = 0; ks < 4; ++ks) {
                a0[ks] = vtr(lds + L_B + wid * 4096 + ks * 1024 + tb); a1[ks] = vtr(lds + L_B + wid * 4096 + ks * 1024 + 512 + tb);
                b0[ks] = vtr(lds + L_XW + ks * 1024 + tb); b1[ks] = vtr(lds + L_XW + ks * 1024 + 512 + tb);
                c0[ks] = vtr(lds + L_XW + 4096 + ks * 1024 + tb); c1[ks] = vtr(lds + L_XW + 4096 + ks * 1024 + 512 + tb);
            }
            __builtin_amdgcn_sched_barrier(0);
#pragma unroll
            for (int ks = 0; ks < 4; ++ks) {
                const bf16x8 a = {a0[ks][0], a0[ks][1], a0[ks][2], a0[ks][3], a1[ks][0], a1[ks][1], a1[ks][2], a1[ks][3]};
                const bf16x8 bb = {b0[ks][0], b0[ks][1], b0[ks][2], b0[ks][3], b1[ks][0], b1[ks][1], b1[ks][2], b1[ks][3]};
                const bf16x8 cc = {c0[ks][0], c0[ks][1], c0[ks][2], c0[ks][3], c1[ks][0], c1[ks][1], c1[ks][2], c1[ks][3]};
                hacc0 = __builtin_amdgcn_mfma_f32_32x32x16_bf16(a, bb, hacc0, 0, 0, 0);
                hacc1 = __builtin_amdgcn_mfma_f32_32x32x16_bf16(a, cc, hacc1, 0, 0, 0);
            }
#pragma unroll
            for (int q4 = 0; q4 < 4; ++q4) {
                const int n0 = 32 * wid + 8 * q4 + 4 * hi;
                u32x2 w0, w1; w0.x = cvtpk(hacc0[4 * q4 + 0], hacc0[4 * q4 + 1]); w0.y = cvtpk(hacc0[4 * q4 + 2], hacc0[4 * q4 + 3]);
                w1.x = cvtpk(hacc1[4 * q4 + 0], hacc1[4 * q4 + 1]); w1.y = cvtpk(hacc1[4 * q4 + 2], hacc1[4 * q4 + 3]);
                *(SC_LAS u32x2*)(lds + L_H + r32 * 256 + (((n0 >> 3) ^ (r32 & 15)) << 4) + (n0 & 7) * 2) = w0;
                *(SC_LAS u32x2*)(lds + L_H + (32 + r32) * 256 + (((n0 >> 3) ^ (r32 & 15)) << 4) + (n0 & 7) * 2) = w1;
            }
        }
        SC_BAR();
        {
            const SC_LAS float* yr = (const SC_LAS float*)(lds + L_Y) + orow * 68 + ocg * 8;
            const f32x4 y0 = *(const SC_LAS f32x4*)yr, y1 = *(const SC_LAS f32x4*)(yr + 4);
            float yv[8];
#pragma unroll
            for (int i = 0; i < 4; ++i) {
                const float ya = (i < 2) ? y0[2 * i] : y1[2 * i - 4], yb = (i < 2) ? y0[2 * i + 1] : y1[2 * i - 3];
                yv[2 * i] = (ya + dsk * lo16(xcur[i])) * lo16(zcur[i]); yv[2 * i + 1] = (yb + dsk * hi16(xcur[i])) * hi16(zcur[i]);
            }
            float ss = 0.f;
#pragma unroll
            for (int i = 0; i < 8; ++i) ss += yv[i] * yv[i];
            ss += __shfl_xor(ss, 1); ss += __shfl_xor(ss, 2); ss += __shfl_xor(ss, 4);
            if (ocg == 0) P.ssqp[(rowb + t0 + orow) * 32 + h] = ss;
            u32x4 w; w.x = cvtpk(yv[0], yv[1]); w.y = cvtpk(yv[2], yv[3]); w.z = cvtpk(yv[4], yv[5]); w.w = cvtpk(yv[6], yv[7]);
            if (!P.dry) *(u32x4*)(P.zp + (rowb + t0 + orow) * 2048 + h * 64 + ocg * 8) = w;
        }
    }
    __syncthreads();
#undef SC_LOAD
}
}
namespace mk {
#define GAS __attribute__((address_space(1)))
#define LAS __attribute__((address_space(3)))
typedef unsigned short bf16;
typedef unsigned v4u __attribute__((ext_vector_type(4)));
typedef float f32x4 __attribute__((ext_vector_type(4)));
typedef GAS unsigned gu32;
#define RLX_AGENT __ATOMIC_RELAXED, __HIP_MEMORY_SCOPE_AGENT
constexpr int NWAVES = 8;
constexpr int M = 16384, D = 1024, SEQ = 2048, NB = 8;
constexpr int SSD_NP = 5376, SSD_IN = 5152, SSD_DI = 2048, SSD_LD = 5120;
constexpr int AT_IN = 3072, DFF = 2816;
constexpr size_t MiB = 1u << 20;
constexpr size_t WS_CTL = 0, CTL_ZERO_BYTES = 64 * 1024;
constexpr size_t WS_CONST = 64 * 1024;
constexpr size_t WS_SSQ = 1 * MiB;
constexpr size_t WS_ROPE = 2 * MiB;
constexpr size_t WS_DT = 3 * MiB;
constexpr size_t WS_SSQP = 5 * MiB;
constexpr size_t WS_CP = 1 * MiB + 512 * 1024;
constexpr size_t WS_W = 7 * MiB;
constexpr size_t W_SSD_IN = 0, W_SSD_IN_SZ = (size_t)SSD_NP * D * 2;
constexpr size_t W_SSD_OUT = W_SSD_IN + 2 * W_SSD_IN_SZ, W_SSD_OUT_SZ = (size_t)D * SSD_DI * 2;
constexpr size_t W_AT_IN = W_SSD_OUT + 2 * W_SSD_OUT_SZ, W_AT_IN_SZ = (size_t)AT_IN * D * 2;
constexpr size_t W_AT_OUT = W_AT_IN + 2 * W_AT_IN_SZ, W_AT_OUT_SZ = (size_t)D * D * 2;
constexpr size_t W_UP = W_AT_OUT + 2 * W_AT_OUT_SZ, W_UP_SZ = (size_t)2 * DFF * D * 2;
constexpr size_t W_DOWN = W_UP + 4 * W_UP_SZ, W_DOWN_SZ = (size_t)D * DFF * 2;
constexpr size_t W_TOTAL = W_DOWN + 4 * W_DOWN_SZ;
constexpr size_t WS_XB = ((WS_W + W_TOTAL + MiB - 1) / MiB) * MiB;
constexpr size_t XB_PAD_FRONT = 4 * D * 2, XB_BYTES = (size_t)(M + 260) * D * 2;
constexpr size_t WS_BIG = ((WS_XB + XB_BYTES + MiB - 1) / MiB) * MiB;
constexpr size_t BIG_BYTES = (size_t)M * SSD_LD * 2;
constexpr size_t WS_DBG = WS_BIG + BIG_BYTES;
constexpr size_t WS_END = WS_DBG + (size_t)M * D * 2;
static_assert(WS_END <= 352 * MiB, "workspace map exceeds the guaranteed 352 MiB");
constexpr int CW_BAR = 1024;
constexpr int RING_BYTES = 131072, EPI_OFF = RING_BYTES, EPI_BYTES = 26624, MISC_OFF = EPI_OFF + EPI_BYTES;
constexpr int LDS_BYTES = 158720;
static_assert(MISC_OFF + 1024 <= LDS_BYTES && attn::LDS_BYTES <= RING_BYTES && scan::LDS_BYTES <= RING_BYTES, "LDS map");

#define LDS_WAIT() asm volatile("s_waitcnt lgkmcnt(0)" ::: "memory")
__device__ __forceinline__ unsigned f2bf(float f) { unsigned u = __builtin_bit_cast(unsigned, f); return (u + 0x7fffu + ((u >> 16) & 1u)) >> 16; }
__device__ __forceinline__ unsigned pk2(float lo, float hi) { return f2bf(lo) | (f2bf(hi) << 16); }

#define XB_TMO      128
#define XB_XCNT(j)  (256  + 64 * (j))
#define XB_XSUB(j)  (1280 + 64 * (j))
#define XB_XGEN(j)  (2304 + 64 * (j))
#define XB_TOP      3328
#define XB_TOPGEN   3392
#define XCD_BAR_WORDS 3456
#define XB_SPIN_CAP (1u << 20)
__device__ __forceinline__ unsigned xb_ld(unsigned* p)              { return __hip_atomic_load(p, __ATOMIC_RELAXED, __HIP_MEMORY_SCOPE_AGENT); }
__device__ __forceinline__ unsigned xb_add(unsigned* p, unsigned v) { return __hip_atomic_fetch_add(p, v, __ATOMIC_RELAXED, __HIP_MEMORY_SCOPE_AGENT); }
__device__ __forceinline__ unsigned xb_xcc_id() { return (unsigned)__builtin_amdgcn_s_getreg((3 << 11) | 20) & 0xFu; }
#define XB_SPIN(cond, bar) do { unsigned _sp = 0; while (cond) { __builtin_amdgcn_s_sleep(1); \
    if ((++_sp & 255u) == 0u) { if (xb_ld(&(bar)[XB_TMO])) break; if (_sp > XB_SPIN_CAP) { atomicAdd(&(bar)[XB_TMO], 1u); break; } } } } while (0)
struct XcdBarrier { unsigned* bar; unsigned x; volatile LAS unsigned* st; };
__device__ __forceinline__ XcdBarrier xcd_barrier_post(unsigned* bar, volatile LAS unsigned* st, bool leader) {
    XcdBarrier b; b.bar = bar; b.x = xb_xcc_id(); b.st = st;
    if (leader) (void)xb_add(&bar[XB_XCNT(b.x)], 1u);
    return b;
}
__device__ __forceinline__ void xcd_barrier_complete(unsigned* bar, unsigned x, unsigned& nloc, unsigned& nx) {
    const unsigned G = gridDim.x * gridDim.y * gridDim.z;
    unsigned sum, cnt, mine, sp = 0u;
    for (;;) {
        sum = 0u; cnt = 0u; mine = 0u;
#pragma unroll
        for (unsigned j = 0; j < 16; ++j) { const unsigned c = xb_ld(&bar[XB_XCNT(j)]); sum += c; cnt += (c > 0u) ? 1u : 0u; mine = (j == x) ? c : mine; }
        if (sum == G) break;
        __builtin_amdgcn_s_sleep(1);
        if ((++sp & 255u) == 0u) { if (xb_ld(&bar[XB_TMO])) break; if (sp > XB_SPIN_CAP) { atomicAdd(&bar[XB_TMO], 1u); break; } }
    }
    nloc = mine > 0u ? mine : 1u; nx = cnt > 0u ? cnt : 1u;
}
__device__ __forceinline__ void xcd_barrier(const XcdBarrier& b, const int wave_s) {
    asm volatile("s_waitcnt vmcnt(0)" ::: "memory");
    __syncthreads();
    if (wave_s == 0 && HW_LANE() == 0) {
        unsigned* bar = b.bar; asm volatile("" : "+s"(bar));
        __builtin_amdgcn_s_waitcnt(0);
        unsigned nloc = b.st[0], nx = b.st[1];
        if (nloc == 0u) { xcd_barrier_complete(bar, b.x, nloc, nx); b.st[0] = nloc; b.st[1] = nx; }
        const unsigned old = xb_add(&bar[XB_XSUB(b.x)], 1u);
        const unsigned gen = old / nloc;
        if (old + 1u == (gen + 1u) * nloc) {
            __builtin_amdgcn_fence(__ATOMIC_RELEASE, "agent");
            asm volatile("s_waitcnt vmcnt(0)" ::: "memory");
            const unsigned og = xb_add(&bar[XB_TOP], 1u);
            const unsigned tg = og / nx;
            if (og + 1u == (tg + 1u) * nx) xb_add(&bar[XB_TOPGEN], 1u);
            else XB_SPIN(xb_ld(&bar[XB_TOPGEN]) == tg, bar);
            __builtin_amdgcn_fence(__ATOMIC_ACQUIRE, "agent");
            xb_add(&bar[XB_XGEN(b.x)], 1u);
            asm volatile("s_waitcnt vmcnt(0)" ::: "memory");
        } else {
            XB_SPIN(xb_ld(&bar[XB_XGEN(b.x)]) == gen, bar);
            __builtin_amdgcn_fence(__ATOMIC_ACQUIRE, "agent");
            asm volatile("s_waitcnt vmcnt(0)" ::: "memory");
        }
    }
    __syncthreads();
}

__device__ __forceinline__ unsigned long long ldarg(LAS unsigned long long* AP, int i) {
    asm volatile("" : "+s"(i));
    const unsigned long long v = AP[i];
    return ((unsigned long long)(unsigned)__builtin_amdgcn_readfirstlane((int)(v >> 32)) << 32) | (unsigned long long)(unsigned)__builtin_amdgcn_readfirstlane((int)v);
}
struct Args { const void* in[25]; float* out; unsigned char* ws; int ph_lo, ph_hi; int dbg, pad; };

__device__ __forceinline__ float wave_sum(float v) {
#pragma unroll
    for (int o = 1; o < 64; o <<= 1) v += __shfl_xor(v, o);
    return v;
}
template <class RowMap>
__device__ __forceinline__ void transpose_item(const float* W, int K, int N, const float* gain, int gmask, float gscale, bf16* WT, const RowMap& rm, LAS float* scr, int item, int item2, int lane) {
    const int nblk = N / 32, rs = lane >> 3, c4 = lane & 7, c = lane & 7;
    f32x4 va[8], vb[8]; float ga[8], gb[8];
    const int kA = 64 * (item / nblk), nA = 32 * (item % nblk);
    const int it2 = item2 < 0 ? item : item2; const int kB = 64 * (it2 / nblk), nB = 32 * (it2 % nblk);
#pragma unroll
    for (int i = 0; i < 8; ++i) { const int kk = 8 * i + rs; va[i] = *(const f32x4*)(W + (size_t)(kA + kk) * N + nA + 4 * c4); ga[i] = gain ? gain[(kA + kk) & gmask] * gscale : 1.0f; }
    if (item2 >= 0) {
#pragma unroll
        for (int i = 0; i < 8; ++i) { const int kk = 8 * i + rs; vb[i] = *(const f32x4*)(W + (size_t)(kB + kk) * N + nB + 4 * c4); gb[i] = gain ? gain[(kB + kk) & gmask] * gscale : 1.0f; }
    }
#pragma unroll
    for (int h = 0; h < 2; ++h) {
        if (h == 1 && item2 < 0) break;
        const int k0 = h ? kB : kA, n0 = h ? nB : nA;
#pragma unroll
        for (int i = 0; i < 8; ++i) { const int kk = 8 * i + rs; LAS float* d = scr + kk * 33 + 4 * c4; const f32x4 v = h ? vb[i] : va[i]; const float g = h ? gb[i] : ga[i]; d[0] = v[0] * g; d[1] = v[1] * g; d[2] = v[2] * g; d[3] = v[3] * g; }
        LDS_WAIT(); asm volatile("" ::: "memory");
#pragma unroll
        for (int j = 0; j < 4; ++j) { const int n = (lane >> 3) + 8 * j; const LAS float* sp = scr + (8 * c) * 33 + n;
            v4u o; o.x = pk2(sp[0 * 33], sp[1 * 33]); o.y = pk2(sp[2 * 33], sp[3 * 33]); o.z = pk2(sp[4 * 33], sp[5 * 33]); o.w = pk2(sp[6 * 33], sp[7 * 33]);
            *(GAS v4u*)(WT + (size_t)rm(n0 + n) * K + k0 + 8 * c) = o; }
        LDS_WAIT(); asm volatile("" ::: "memory");
    }
}
struct RowId { __device__ __forceinline__ int operator()(int n) const { return n; } };
struct RowUp { __device__ __forceinline__ int operator()(int n) const { const int u = n >= DFF, ch = u ? n - DFF : n; return (ch >> 7) * 256 + u * 128 + (ch & 127); } };

__global__ void __launch_bounds__(NWAVES * 64, 2) mega_fwd(Args args) {
    extern __shared__ __attribute__((aligned(16))) unsigned char lds_raw[];
    LAS unsigned char* lds = (LAS unsigned char*)lds_raw;
    volatile LAS unsigned* MISC = (volatile LAS unsigned*)(lds + MISC_OFF);
    const int G = gridDim.x; const int bx = blockIdx.x; const int vcu = (G % 8 == 0) ? (bx % 8) * (G / 8) + bx / 8 : bx;
    gu32* ctl = (gu32*)(args.ws + WS_CTL);
    const int wave_s = __builtin_amdgcn_readfirstlane((int)threadIdx.x >> 6);
    if (wave_s == 0) MISC[HW_LANE()] = 0u;
    __syncthreads();
    XcdBarrier bar = xcd_barrier_post((unsigned*)ctl + CW_BAR, MISC + 8, wave_s == 0 && HW_LANE() == 0);
#define GRID_BAR() xcd_barrier(bar, wave_s)
    LAS unsigned long long* AP = (LAS unsigned long long*)(lds + MISC_OFF + 256);
    if (wave_s == 0 && HW_LANE() < 27) AP[HW_LANE()] = ((const unsigned long long*)&args)[HW_LANE()];
    __syncthreads();
#define ARGP(T, i) ((T)(GAS void*)ldarg(AP, i))
#define x_in   ARGP(const float*, 0)
#define pos    ARGP(const int*, 1)
#define nmg    ARGP(const float*, 2)
#define nfg    ARGP(const float*, 3)
#define s_inw  ARGP(const float*, 4)
#define s_cw   ARGP(const float*, 5)
#define s_cb   ARGP(const float*, 6)
#define s_dtb  ARGP(const float*, 7)
#define s_alog ARGP(const float*, 8)
#define s_d    ARGP(const float*, 9)
#define s_ng   ARGP(const float*, 10)
#define s_ow   ARGP(const float*, 11)
#define a_inw  ARGP(const float*, 12)
#define a_qg   ARGP(const float*, 13)
#define a_kg   ARGP(const float*, 14)
#define a_lq1  ARGP(const float*, 15)
#define a_lk1  ARGP(const float*, 16)
#define a_lq2  ARGP(const float*, 17)
#define a_lk2  ARGP(const float*, 18)
#define a_sg   ARGP(const float*, 19)
#define a_ow   ARGP(const float*, 20)
#define f_uw   ARGP(const float*, 21)
#define f_cw   ARGP(const float*, 22)
#define f_cb   ARGP(const float*, 23)
#define f_dw   ARGP(const float*, 24)
#define xout   ARGP(float*, 25)
#define ws     ARGP(unsigned char*, 26)
#define cst    ((float*)(ws + WS_CONST))
#define SSQ    ((float*)(ws + WS_SSQ))
#define ROPE   ((float*)(ws + WS_ROPE))
#define DT     ((float*)(ws + WS_DT))
#define SSQP   ((float*)(ws + WS_SSQP))
#define Wb     ((bf16*)(ws + WS_W))
#define XB     ((bf16*)(ws + WS_XB + XB_PAD_FRONT))
#define BIG    ((bf16*)(ws + WS_BIG))
#define XLO    ((bf16*)(ws + WS_DBG))
#define CPT    ((float*)(ws + WS_CP))
#define ZPL    ((bf16*)(ws + WS_BIG))
#define XBCPL  ((bf16*)(ws + WS_BIG + (size_t)M * SSD_DI * 2))
#define CONV_MATRIX(kind_, idx_, worker_, nworkers_) do { \
        int tid_ = wave_s * 64 + HW_LANE(); asm volatile("" : "+v"(tid_)); const int lane_ = tid_ & 63, wave_ = wave_s; \
        LAS float* scr_ = (LAS float*)(lds + wave_ * 16384); const int j_ = (idx_); \
        constexpr int I_SI = (D / 64) * (SSD_IN / 32), I_SO = (SSD_DI / 64) * (D / 32), I_AI = (D / 64) * (AT_IN / 32), I_AO = (D / 64) * (D / 32), I_UP = (D / 64) * (2 * DFF / 32), I_DN = (DFF / 64) * (D / 32); \
        if ((kind_) == 0) { for (int it = (worker_); it < I_SI; it += 2 * (nworkers_)) transpose_item(s_inw + (size_t)j_ * D * SSD_IN, D, SSD_IN, nmg + (2 * j_) * D, 1023, 1.0f, (bf16*)((char*)Wb + W_SSD_IN + j_ * W_SSD_IN_SZ), RowId(), scr_, it, (it + (nworkers_) < I_SI) ? it + (nworkers_) : -1, lane_); \
            v4u* p_ = (v4u*)((char*)Wb + W_SSD_IN + j_ * W_SSD_IN_SZ + (size_t)SSD_IN * D * 2); const int n16_ = (SSD_NP - SSD_IN) * D * 2 / 16; \
            unsigned z_ = 0u; asm volatile("" : "+v"(z_)); for (int i = (worker_) * 64 + lane_; i < n16_; i += (nworkers_) * 64) p_[i] = (v4u){z_, z_, z_, z_}; } \
        else if ((kind_) == 1) { for (int it = (worker_); it < I_SO; it += 2 * (nworkers_)) transpose_item(s_ow + (size_t)j_ * SSD_DI * D, SSD_DI, D, s_ng + j_ * SSD_DI, 2047, 1.0f, (bf16*)((char*)Wb + W_SSD_OUT + j_ * W_SSD_OUT_SZ), RowId(), scr_, it, (it + (nworkers_) < I_SO) ? it + (nworkers_) : -1, lane_); } \
        else if ((kind_) == 2) { for (int it = (worker_); it < I_AI; it += 2 * (nworkers_)) transpose_item(a_inw + (size_t)j_ * D * AT_IN, D, AT_IN, nmg + (2 * j_ + 1) * D, 1023, 1.0f, (bf16*)((char*)Wb + W_AT_IN + j_ * W_AT_IN_SZ), RowId(), scr_, it, (it + (nworkers_) < I_AI) ? it + (nworkers_) : -1, lane_); } \
        else if ((kind_) == 3) { const float li_ = 0.8f - 0.6f * expf(-0.3f * (float)(2 * j_ + 1)); \
            for (int it = (worker_); it < I_AO; it += 2 * (nworkers_)) transpose_item(a_ow + (size_t)j_ * D * D, D, D, a_sg + j_ * 128, 127, 1.0f - li_, (bf16*)((char*)Wb + W_AT_OUT + j_ * W_AT_OUT_SZ), RowId(), scr_, it, (it + (nworkers_) < I_AO) ? it + (nworkers_) : -1, lane_); } \
        else if ((kind_) == 4) { for (int it = (worker_); it < I_UP; it += 2 * (nworkers_)) transpose_item(f_uw + (size_t)j_ * D * 2 * DFF, D, 2 * DFF, nfg + j_ * D, 1023, 1.0f, (bf16*)((char*)Wb + W_UP + j_ * W_UP_SZ), RowUp(), scr_, it, (it + (nworkers_) < I_UP) ? it + (nworkers_) : -1, lane_); } \
        else { for (int it = (worker_); it < I_DN; it += 2 * (nworkers_)) transpose_item(f_dw + (size_t)j_ * DFF * D, DFF, D, nullptr, 0, 1.0f, (bf16*)((char*)Wb + W_DOWN + j_ * W_DOWN_SZ), RowId(), scr_, it, (it + (nworkers_) < I_DN) ? it + (nworkers_) : -1, lane_); } \
    } while (0)
#define RUN_FILL(fid_, nwg_, part_) do { const int idle0_ = (nwg_) % G; if (bx >= idle0_ && idle0_ > 0) { \
        const int wk_ = (bx - idle0_) * NWAVES + wave_s, nwk_ = (G - idle0_) * NWAVES; \
          \
        unsigned long long code_ = (part_) == 0 ? ((fid_) == 0 ? 0xff1040ull : (fid_) == 1 ? 0xff51ull : (fid_) == 2 ? 0xff11ull : (fid_) == 3 ? 0xff42ull : 0xff53ull) \
                                                : ((fid_) == 0 ? 0xff302050ull : (fid_) == 1 ? 0xff41ull : (fid_) == 2 ? 0xff01ull : (fid_) == 3 ? 0xff312152ull : 0xff43ull); \
        for (;;) { const int e_ = (int)(code_ & 0xffu); if (e_ == 0xff) break; code_ >>= 8; CONV_MATRIX(e_ >> 4, e_ & 15, wk_, nwk_); } } } while (0)
    const int lo = args.ph_lo, hi = args.ph_hi;
    int phase = 0;
#define IN_PHASE() (phase >= lo && phase < hi)
#define END_PHASE(ty) do { if (IN_PHASE() && phase + 1 < hi) GRID_BAR(); ++phase; } while (0)
#ifndef PROBE_EPI_MODE
#define PROBE_EPI_MODE 0
#endif
#ifdef PROBE_DUP
#define REP_BEGIN(ty) _Pragma("unroll") for (int rep_ = ((ty) == PROBE_DUP ? 0 : 1); rep_ < 2; ++rep_) { const int dry = (rep_ == 0);
#define REP_END() if (dry) GRID_BAR(); }
#else
#define REP_BEGIN(ty) { const int dry = 0;
#define REP_END() }
#endif

    if (IN_PHASE()) { REP_BEGIN(0)
        int tid = wave_s * 64 + HW_LANE(); asm volatile("" : "+v"(tid));
        const int lane = tid & 63, wave = wave_s;
        LAS float* scr = (LAS float*)(lds + wave * 16384);
        const int gw = vcu * NWAVES + wave, NGW = G * NWAVES;
        CONV_MATRIX(0, 0, gw, NGW);
        { unsigned z_ = 0u; asm volatile("" : "+v"(z_));
          v4u* p = (v4u*)(ws + WS_XB); for (int i = vcu * 512 + tid; i < (int)(XB_PAD_FRONT / 16); i += G * 512) p[i] = (v4u){z_, z_, z_, z_};
          v4u* q = (v4u*)((char*)XB + (size_t)M * D * 2); for (int i = vcu * 512 + tid; i < 256 * D * 2 / 16; i += G * 512) q[i] = (v4u){z_, z_, z_, z_}; }
        for (int m = gw; m < M; m += NGW) {
            const f32x4* xr = (const f32x4*)(x_in + (size_t)m * D) + lane; float s = 0.f;
            unsigned long long* o8 = (unsigned long long*)(XB + (size_t)m * D) + lane;
#pragma unroll
            for (int j = 0; j < 4; ++j) { const f32x4 v = xr[64 * j]; s += (v[0] * v[0] + v[1] * v[1]) + (v[2] * v[2] + v[3] * v[3]); o8[64 * j] = (unsigned long long)pk2(v[0], v[1]) | ((unsigned long long)pk2(v[2], v[3]) << 32); }
            s = wave_sum(s);
            if (lane < 4) SSQ[(size_t)m * 4 + lane] = (lane == 0) ? s : 0.f;
            if (lane >= 16 && lane < 32) { const int i = lane & 7; const float invf = powf(500000.0f, -(float)(2 * i) / 16.0f); const float ang = (float)pos[m] * invf; ROPE[(size_t)m * 16 + (lane - 16)] = (lane < 24) ? cosf(ang) : sinf(ang); }
        }
        for (int i = vcu * 512 + tid; i < 2 * SSD_NP; i += G * 512) {
            const int j = i / SSD_NP, c = i % SSD_NP; float pb = 0.f, p0 = 0.f, p1 = 0.f, p2 = 0.f, p3 = 0.f;
            if (c < 2048) p3 = 1.f;
            else if (c < 5120) { const int ch = c - 2048; const float* w = s_cw + (size_t)j * 4 * 3072; pb = s_cb[(size_t)j * 3072 + ch]; p0 = w[ch]; p1 = w[3072 + ch]; p2 = w[2 * 3072 + ch]; p3 = w[3 * 3072 + ch]; }
            else if (c < 5152) { pb = s_dtb[j * 32 + (c - 5120)]; p3 = 1.f; }
            float* t = CPT + (size_t)j * 5 * SSD_NP; t[c] = pb; t[SSD_NP + c] = p0; t[2 * SSD_NP + c] = p1; t[3 * SSD_NP + c] = p2; t[4 * SSD_NP + c] = p3;
        }
        if (bx == 0 && wave == 0) {
            for (int j = 0; j < 2; ++j) {
                float mq = fabsf(a_qg[j * 64 + lane]), mkk = fabsf(a_kg[j * 64 + lane]);
                float d1 = a_lq1[j * 64 + lane] * a_lk1[j * 64 + lane], d2 = a_lq2[j * 64 + lane] * a_lk2[j * 64 + lane];
#pragma unroll
                for (int o = 1; o < 64; o <<= 1) { mq = fmaxf(mq, __shfl_xor(mq, o)); mkk = fmaxf(mkk, __shfl_xor(mkk, o)); d1 += __shfl_xor(d1, o); d2 += __shfl_xor(d2, o); }
                const float li = 0.8f - 0.6f * expf(-0.3f * (float)(2 * j + 1));
                if (lane == 0) { cst[j] = mq * mkk * 64.0f * 0.125f * 1.4426950408889634f * 1.002f + 0.01f; cst[2 + j] = expf(d1) - expf(d2) + li; }
            }
        }
    REP_END() }
    END_PHASE(0);

    for (int layer = 0; layer < 4; ++layer) {
        const int j = layer >> 1;
        if ((layer & 1) == 0) {
            if (IN_PHASE()) { REP_BEGIN(1)
                pg8::Gemm g{XB, (const bf16*)((const char*)Wb + W_SSD_IN + j * W_SSD_IN_SZ), D, D, 253, -3};
                pg8::StaticOrder S; S.init(65, SSD_NP / 256, G, bx);
                epi::EpiSsdConv E{ZPL, XBCPL, DT, SSQ, CPT + (size_t)j * 5 * SSD_NP};
                RUN_FILL(layer == 0 ? 0 : 3, 65 * (SSD_NP / 256), 0); __syncthreads();
                pg8::gemm_phase(lds, lds + EPI_OFF, g, S, E, wave_s);
                RUN_FILL(layer == 0 ? 0 : 3, 65 * (SSD_NP / 256), 1);
            REP_END() }
            END_PHASE(1);
            if (IN_PHASE()) { REP_BEGIN(2)
                scan::Params sp{XBCPL, ZPL, DT, s_alog + j * 32, s_d + j * 32, SSQP, dry};
                for (int u = vcu; u < NB * 32; u += G) scan::unit(sp, u >> 5, u & 31, (LAS char*)lds, wave_s);
            REP_END() }
            END_PHASE(2);
            if (IN_PHASE()) { REP_BEGIN(4)
                pg8::Gemm g{ZPL, (const bf16*)((const char*)Wb + W_SSD_OUT + j * W_SSD_OUT_SZ), SSD_DI, SSD_DI, 256, 0};
                pg8::StaticOrder S; S.init(M / 256, D / 256, G, bx);
                if (layer == 0) { epi::EpiResidualG<1> E{x_in, XB, XLO, SSQ, SSQP, dry}; pg8::gemm_phase(lds, lds + EPI_OFF, g, S, E, wave_s); }
                else { epi::EpiResidualG<0> E{nullptr, XB, XLO, SSQ, SSQP, dry}; pg8::gemm_phase(lds, lds + EPI_OFF, g, S, E, wave_s); }
            REP_END() }
            END_PHASE(4);
        } else {
            if (IN_PHASE()) { REP_BEGIN(5)
                pg8::Gemm g{XB, (const bf16*)((const char*)Wb + W_AT_IN + j * W_AT_IN_SZ), D, D, 256, 0};
                pg8::StaticOrder S; S.init(M / 256, AT_IN / 256, G, bx);
                epi::EpiQKV E{BIG, SSQ, a_qg + j * 64, a_kg + j * 64, ROPE};
                pg8::gemm_phase(lds, lds + EPI_OFF, g, S, E, wave_s);
            REP_END() }
            END_PHASE(5);
            if (IN_PHASE()) { REP_BEGIN(6)
                attn::Params ap{BIG, cst[j], cst[2 + j], dry};
                for (int pi = vcu; pi < 512; pi += G) {
                    const int bh = pi >> 3, s = pi & 7;
                    attn::unit(ap, bh >> 3, bh & 7, s, (LAS char*)lds, wave_s);
                    attn::unit(ap, bh >> 3, bh & 7, 15 - s, (LAS char*)lds, wave_s);
                }
            REP_END() }
            END_PHASE(6);
            if (IN_PHASE()) { REP_BEGIN(7)
                pg8::Gemm g{BIG, (const bf16*)((const char*)Wb + W_AT_OUT + j * W_AT_OUT_SZ), AT_IN, D, 256, 0};
                pg8::StaticOrder S; S.init(M / 256, D / 256, G, bx);
                epi::EpiResidual<0> E{nullptr, nullptr, XB, XLO, SSQ, dry};
                pg8::gemm_phase(lds, lds + EPI_OFF, g, S, E, wave_s);
            REP_END() }
            END_PHASE(7);
        }
        if (IN_PHASE()) { REP_BEGIN(8)
            pg8::Gemm g{XB, (const bf16*)((const char*)Wb + W_UP + layer * W_UP_SZ), D, D, 254, -2};
            pg8::StaticOrder S; S.init(65, 2 * DFF / 256, G, bx);
            epi::EpiConvGate E{BIG, SSQ, f_cw + (size_t)layer * 3 * 2 * DFF, f_cb + (size_t)layer * 2 * DFF, dry * PROBE_EPI_MODE};
            if (layer < 3) { RUN_FILL(layer == 0 ? 1 : (layer == 1 ? 2 : 4), 65 * (2 * DFF / 256), 0); __syncthreads(); }
            pg8::gemm_phase(lds, lds + EPI_OFF, g, S, E, wave_s);
            if (layer < 3) RUN_FILL(layer == 0 ? 1 : (layer == 1 ? 2 : 4), 65 * (2 * DFF / 256), 1);
        REP_END() }
        END_PHASE(8);
        if (IN_PHASE()) { REP_BEGIN(9)
            pg8::Gemm g{BIG, (const bf16*)((const char*)Wb + W_DOWN + layer * W_DOWN_SZ), DFF, DFF, 256, 0};
            pg8::StaticOrder S; S.init(M / 256, D / 256, G, bx);
            if (layer == 3) { epi::EpiResidual<2> E{nullptr, xout, XB, XLO, SSQ, dry}; pg8::gemm_phase(lds, lds + EPI_OFF, g, S, E, wave_s); }
            else { epi::EpiResidual<0> E{nullptr, nullptr, XB, XLO, SSQ, dry}; pg8::gemm_phase(lds, lds + EPI_OFF, g, S, E, wave_s); }
        REP_END() }
        END_PHASE(9);
    }
#ifdef PROBE_EXTRA_BARS
    for (int i_ = 0; i_ < PROBE_EXTRA_BARS; ++i_) GRID_BAR();
#endif
}
#undef CONV_MATRIX
#undef RUN_FILL
#undef x_in
#undef pos
#undef nmg
#undef nfg
#undef s_inw
#undef s_cw
#undef s_cb
#undef s_dtb
#undef s_alog
#undef s_d
#undef s_ng
#undef s_ow
#undef a_inw
#undef a_qg
#undef a_kg
#undef a_lq1
#undef a_lk1
#undef a_lq2
#undef a_lk2
#undef a_sg
#undef a_ow
#undef f_uw
#undef f_cw
#undef f_cb
#undef f_dw
#undef xout
#undef ws
#undef cst
#undef SSQ
#undef ROPE
#undef DT
#undef SSQP
#undef Wb
#undef XB
#undef BIG
#undef XLO
#undef CPT
#undef ZPL
#undef XBCPL
#undef ARGP
constexpr int N_PHASES = 1 + 2 * 5 + 2 * 5;

static int g_grid = 0;
static void launch(void* const* d_in, float* d_out, void* d_ws, int ph_lo, int ph_hi, hipStream_t stream) {
    if (g_grid == 0) {
        int dev = 0, cus = 0;
        if (hipGetDevice(&dev) != hipSuccess || hipDeviceGetAttribute(&cus, hipDeviceAttributeMultiprocessorCount, dev) != hipSuccess) { fprintf(stderr, "device query failed\n"); g_grid = -1; return; }
        if (hipFuncSetAttribute((const void*)mega_fwd, hipFuncAttributeMaxDynamicSharedMemorySize, LDS_BYTES) != hipSuccess) { fprintf(stderr, "hipFuncSetAttribute failed\n"); g_grid = -1; return; }
        int per_cu = 0;
        (void)hipOccupancyMaxActiveBlocksPerMultiprocessor(&per_cu, (const void*)mega_fwd, NWAVES * 64, LDS_BYTES);
        (void)hipGetLastError();
        g_grid = cus;
        fprintf(stderr, "mega_fwd: %d CUs, occupancy query %d per CU\n", cus, per_cu);
    }
    if (g_grid < 0) return;
    (void)hipMemsetAsync((char*)d_ws + WS_CTL, 0, CTL_ZERO_BYTES, stream);
    Args a{};
    for (int i = 0; i < 25; ++i) a.in[i] = d_in[i];
    a.out = d_out; a.ws = (unsigned char*)d_ws; a.ph_lo = ph_lo; a.ph_hi = ph_hi;
    void* params[] = {&a};
    hipError_t e = hipLaunchCooperativeKernel((const void*)mega_fwd, dim3(g_grid), dim3(NWAVES * 64), params, LDS_BYTES, stream);
    if (e != hipSuccess) fprintf(stderr, "cooperative launch failed: %s (grid %d)\n", hipGetErrorString(e), g_grid);
}
}
extern "C" void kernel_launch(void* const* d_in, const int* in_sizes, int n_in, void* d_out, int out_size, void* d_ws, size_t ws_size, hipStream_t stream) {
    (void)in_sizes; (void)n_in; (void)out_size; (void)ws_size;
    mk::launch(d_in, (float*)d_out, d_ws, 0, mk::N_PHASES, stream);
}
```

```cpp
#include <hip/hip_runtime.h>
#include <stdint.h>
#include <math.h>
#include <cstdio>
__device__ __forceinline__ int hw_lane_() { unsigned m = ~0u; asm volatile("" : "+s"(m)); return (int)__builtin_amdgcn_mbcnt_hi(m, __builtin_amdgcn_mbcnt_lo(m, 0u)); }
#define HW_LANE() hw_lane_()
template <int CTRL> __device__ __forceinline__ float xl_dpp(float v) { return __builtin_bit_cast(float, __builtin_amdgcn_mov_dpp(__builtin_bit_cast(int, v), CTRL, 0xF, 0xF, true)); }
__device__ __forceinline__ float xl_swap16_sum(float v) { const auto r = __builtin_amdgcn_permlane16_swap(__builtin_bit_cast(unsigned, v), __builtin_bit_cast(unsigned, v), false, false); const unsigned r0 = r[0], r1 = r[1]; return __builtin_bit_cast(float, r0) + __builtin_bit_cast(float, r1); }
__device__ __forceinline__ float xl_swap32_sum(float v) { const auto r = __builtin_amdgcn_permlane32_swap(__builtin_bit_cast(unsigned, v), __builtin_bit_cast(unsigned, v), false, false); const unsigned r0 = r[0], r1 = r[1]; return __builtin_bit_cast(float, r0) + __builtin_bit_cast(float, r1); }
__device__ __forceinline__ float xl_swap16_max(float v) { const auto r = __builtin_amdgcn_permlane16_swap(__builtin_bit_cast(unsigned, v), __builtin_bit_cast(unsigned, v), false, false); const unsigned r0 = r[0], r1 = r[1]; return fmaxf(__builtin_bit_cast(float, r0), __builtin_bit_cast(float, r1)); }
__device__ __forceinline__ float xl_swap32_max(float v) { const auto r = __builtin_amdgcn_permlane32_swap(__builtin_bit_cast(unsigned, v), __builtin_bit_cast(unsigned, v), false, false); const unsigned r0 = r[0], r1 = r[1]; return fmaxf(__builtin_bit_cast(float, r0), __builtin_bit_cast(float, r1)); }
__device__ __forceinline__ float xl_xor16(float v, bool odd16) { const auto r = __builtin_amdgcn_permlane16_swap(__builtin_bit_cast(unsigned, v), __builtin_bit_cast(unsigned, v), false, false); const unsigned r0 = r[0], r1 = r[1]; return __builtin_bit_cast(float, odd16 ? r0 : r1); }
__device__ __forceinline__ float xl_sum4(float v) { v += xl_dpp<0xB1>(v); v += xl_dpp<0x4E>(v); return v; }
__device__ __forceinline__ float xl_sum8(float v) { v = xl_sum4(v); v += xl_dpp<0x141>(v); return v; }
__device__ __forceinline__ float xl_sum16(float v) { v = xl_sum8(v); v += xl_dpp<0x140>(v); return v; }
__device__ __forceinline__ float xl_sum64(float v) { v = xl_sum16(v); v = xl_swap16_sum(v); return xl_swap32_sum(v); }
__device__ __forceinline__ float xl_max64(float v) { v = fmaxf(v, xl_dpp<0xB1>(v)); v = fmaxf(v, xl_dpp<0x4E>(v)); v = fmaxf(v, xl_dpp<0x141>(v)); v = fmaxf(v, xl_dpp<0x140>(v)); v = xl_swap16_max(v); return xl_swap32_max(v); }
__device__ __forceinline__ float xl_scan64(float v) {
    v += xl_dpp<0x111>(v); v += xl_dpp<0x112>(v); v += xl_dpp<0x114>(v); v += xl_dpp<0x118>(v);
    v += __builtin_bit_cast(float, __builtin_amdgcn_update_dpp(0, __builtin_bit_cast(int, v), 0x142, 0xA, 0xF, false));
    v += __builtin_bit_cast(float, __builtin_amdgcn_update_dpp(0, __builtin_bit_cast(int, v), 0x143, 0xC, 0xF, false));
    return v;
}
#ifndef PG8_SP2
#define PG8_SP2 1
#endif
namespace pg8 {
#define PG8_LAS __attribute__((address_space(3)))
typedef unsigned short bf16_t;
typedef short bf16x8 __attribute__((ext_vector_type(8)));
typedef float f32x4 __attribute__((ext_vector_type(4)));
typedef unsigned u32x4 __attribute__((ext_vector_type(4)));
typedef unsigned u32x2 __attribute__((ext_vector_type(2)));
constexpr int BM = 256, BK = 64, HALF = 128, HTB = HALF * BK * 2  , STAGE_BYTES = 8 * HTB, NXCD = 8, WGM = 8;

__host__ __device__ __forceinline__ int lds_byte(int r, int c) { const int st = (r >> 4) * 2 + (c >> 5), rr = r & 15, cc = c & 31, ob = rr * 64 + cc * 2; return st * 1024 + (ob ^ (((ob >> 9) & 1) << 5)); }
__host__ __device__ __forceinline__ void stage_rc(int b, int& R, int& C) { const int st = b / 1024, sb = b % 1024, swz = sb ^ (((sb >> 9) & 1) << 5); R = (st >> 1) * 16 + swz / 64; C = (st & 1) * 32 + (swz % 64) / 2; }
__host__ __device__ __forceinline__ int perm32(int rho) { const int n = rho >> 4, i = rho & 15; return 8 * (i >> 2) + 4 * n + (i & 3); }

struct Unit { int pm, pn; };
struct Gemm { const bf16_t* A; const bf16_t* Bt; int lda, K, a_stride, a_off; };

struct StaticOrder {
    int nM, nN, nwg, G, c;
    __host__ __device__ void init(int nM_, int nN_, int G_, int c_) { nM = nM_; nN = nN_; nwg = nM * nN; G = G_; c = c_; }
    __host__ __device__ bool next(int i, Unit& u) const {
        const long L = (long)i * G + c; if (L >= nwg) return false;
        int wgid = (int)L; { const int q = nwg / NXCD, r = nwg % NXCD, xcd = wgid % NXCD, off = wgid / NXCD; wgid = (xcd < r ? xcd * (q + 1) : r * (q + 1) + (xcd - r) * q) + off; }
        const int nig = WGM * nN, gid = wgid / nig, fm = gid * WGM, gsz = (nM - fm) < WGM ? (nM - fm) : WGM;
        u.pm = fm + ((wgid % nig) % gsz); u.pn = (wgid % nig) / gsz; return true;
    }
};

__device__ __forceinline__ unsigned cvt_pk_bf16(float lo, float hi) { unsigned r; asm volatile("v_cvt_pk_bf16_f32 %0, %1, %2" : "=v"(r) : "v"(lo), "v"(hi)); return r; }

template <class Epi, class Sched>
__device__ __forceinline__ void gemm_phase(PG8_LAS unsigned char* lds, PG8_LAS unsigned char* elds, const Gemm g, const Sched& S, const Epi& E, const int wave_s) {
    int tid = wave_s * 64 + HW_LANE(); asm volatile("" : "+v"(tid));
    const int wid = __builtin_amdgcn_readfirstlane(tid >> 6), lane = tid & 63, wr = wid >> 2, wc = wid & 3, fr = lane & 15, fq = lane >> 4;
    const int K = g.K, nt = K / BK, lda = g.lda;
    unsigned voffA[2], voffB[2]; int aoff, boff;
#define PG8_LANECONST() do { int t_ = wave_s * 64 + HW_LANE(); asm volatile("" : "+v"(t_)); const int fr_ = t_ & 15, fq_ = (t_ >> 4) & 3; \
        _Pragma("unroll") for (int i = 0; i < 2; ++i) { int R, C; stage_rc(t_ * 16 + i * 8192, R, C); const int Rb = Epi::PERM ? ((R & ~31) + perm32(R & 31)) : R; \
            const int Ra = Epi::ROWIL ? ((R & ~63) | ((R & 15) << 2) | ((R >> 4) & 3)) : R;     \
            voffA[i] = (unsigned)(Ra * lda + C) * 2u; voffB[i] = (unsigned)(Rb * K + C) * 2u; } \
        aoff = lds_byte(wr * 64 + fr_, fq_ * 8); boff = lds_byte(wc * 32 + fr_, fq_ * 8); } while (0)
    PG8_LANECONST();
    const size_t kstep = (size_t)(BK * 2);
    const size_t hstepA = (size_t)HALF * lda * 2, hstepB = (size_t)HALF * K * 2;
    const size_t tstepB = 2 * hstepB;
    const unsigned ldsw = (unsigned)wid * 1024u;
#define PG8_SA(b, h) (((b) * 2 + (h)) * HTB)
#define PG8_SB(b, h) ((4 + (b) * 2 + (h)) * HTB)
#define PG8_STAGE(bufoff, gbase, voff) do { _Pragma("unroll") for (int _i = 0; _i < 2; ++_i) \
        __builtin_amdgcn_global_load_lds((const unsigned*)((const char*)(gbase) + (voff)[_i]), (PG8_LAS unsigned*)(lds + (bufoff) + ldsw + _i * 8192), 16, 0, 0); } while (0)
#define PG8_LDA(dst, b, h) do { _Pragma("unroll") for (int m = 0; m < 4; ++m) _Pragma("unroll") for (int k = 0; k < 2; ++k) dst[m][k] = *(const PG8_LAS bf16x8*)(lds + PG8_SA(b, h) + aoff + m * 2048 + k * 1024); } while (0)
#define PG8_LDB(dst, b, h) do { _Pragma("unroll") for (int n = 0; n < 2; ++n) _Pragma("unroll") for (int k = 0; k < 2; ++k) dst[n][k] = *(const PG8_LAS bf16x8*)(lds + PG8_SB(b, h) + boff + n * 2048 + k * 1024); } while (0)
#define PG8_MMA(ai, bj, At, Bt) do { __builtin_amdgcn_s_setprio(1); _Pragma("unroll") for (int m = 0; m < 4; ++m) _Pragma("unroll") for (int n = 0; n < 2; ++n) _Pragma("unroll") for (int k = 0; k < 2; ++k) \
        acc[ai][bj][m][n] = __builtin_amdgcn_mfma_f32_16x16x32_bf16(Bt[n][k], At[m][k], acc[ai][bj][m][n], 0, 0, 0); __builtin_amdgcn_s_setprio(0); } while (0)
#define PG8_WAIT_V(n) asm volatile("s_waitcnt vmcnt(" #n ")" ::: "memory")
#define PG8_WAIT_L(n) asm volatile("s_waitcnt lgkmcnt(" #n ")" ::: "memory")
#define PG8_BAR __builtin_amdgcn_s_barrier()
#define PG8_SCHED __builtin_amdgcn_sched_barrier(0)
    Unit cur, nxt; int ui = 0;
    if (!S.next(0, cur)) return;
    if constexpr (Epi::KGROUP) E.unit_begin(cur, elds, wave_s);
    float zf = 0.f; if constexpr (!Epi::KGROUP) asm volatile("" : "+v"(zf));
    f32x4 acc[2][2][4][2];
#pragma unroll
    for (int a = 0; a < 2; ++a)
#pragma unroll
        for (int b = 0; b < 2; ++b)
#pragma unroll
            for (int m = 0; m < 4; ++m)
#pragma unroll
                for (int n = 0; n < 2; ++n) acc[a][b][m][n] = (f32x4){zf, zf, zf, zf};
    bf16x8 At[4][2], B0[2][2], B1[2][2];
    const char* cA = (const char*)g.A + ((long)cur.pm * g.a_stride + g.a_off) * (long)lda * 2; const char* cB = (const char*)g.Bt + (size_t)cur.pn * tstepB;
#if PG8_SP2
    PG8_STAGE(PG8_SB(0, 0), cB, voffB); PG8_STAGE(PG8_SB(0, 1), cB + hstepB, voffB); PG8_STAGE(PG8_SA(0, 0), cA, voffA); PG8_STAGE(PG8_SA(0, 1), cA + hstepA, voffA);
    if (wr == 1) PG8_BAR;
    PG8_WAIT_V(2); PG8_BAR;
    PG8_STAGE(PG8_SB(1, 0), cB + kstep, voffB); PG8_STAGE(PG8_SA(1, 0), cA + kstep, voffA); PG8_STAGE(PG8_SB(1, 1), cB + hstepB + kstep, voffB);
    PG8_WAIT_V(6); PG8_BAR;
#else
    PG8_STAGE(PG8_SB(0, 0), cB, voffB); PG8_STAGE(PG8_SA(0, 0), cA, voffA); PG8_STAGE(PG8_SB(0, 1), cB + hstepB, voffB); PG8_STAGE(PG8_SA(0, 1), cA + hstepA, voffA);
    if (wr == 1) PG8_BAR;
    PG8_WAIT_V(4); PG8_BAR;
    PG8_STAGE(PG8_SB(1, 0), cB + kstep, voffB); PG8_STAGE(PG8_SA(1, 0), cA + kstep, voffA); PG8_STAGE(PG8_SB(1, 1), cB + hstepB + kstep, voffB);
    PG8_WAIT_V(6); PG8_BAR;
#endif
    for (;;) {
        const bool has_next = S.next(ui + 1, nxt);
        const char* nA = has_next ? (const char*)g.A + ((long)nxt.pm * g.a_stride + g.a_off) * (long)lda * 2 : cA; const char* nB = has_next ? (const char*)g.Bt + (size_t)nxt.pn * tstepB : cB;
        for (int t = 0; t < nt; t += 2) {
            const bool last = (t == nt - 2);
            const char* a1 = cA + (size_t)(t + 1) * kstep;
            const char* a2 = last ? nA : cA + (size_t)(t + 2) * kstep; const char* b2 = last ? nB : cB + (size_t)(t + 2) * kstep;
            const char* a3 = a2 + kstep; const char* b3 = b2 + kstep;
            if constexpr (Epi::KGROUP) { if (t > 0 && (t & 7) == 0) E.kgroup(acc, t >> 3, wr, elds); }
#if PG8_SP2
            PG8_LDB(B0, 0, 0); PG8_LDB(B1, 0, 1); PG8_SCHED; PG8_LDA(At, 0, 0); PG8_STAGE(PG8_SA(1, 1), a1 + hstepA, voffA);
            PG8_WAIT_V(8); PG8_WAIT_L(0); PG8_BAR; PG8_MMA(0, 0, At, B0); PG8_MMA(0, 1, At, B1); PG8_BAR; PG8_SCHED;
            PG8_LDA(At, 0, 1); PG8_STAGE(PG8_SB(0, 0), b2, voffB); PG8_STAGE(PG8_SB(0, 1), b2 + hstepB, voffB); PG8_STAGE(PG8_SA(0, 0), a2, voffA);
            PG8_WAIT_V(8); PG8_WAIT_L(0); PG8_BAR; PG8_MMA(1, 0, At, B0); PG8_MMA(1, 1, At, B1); PG8_BAR; PG8_SCHED;
            PG8_LDB(B0, 1, 0); PG8_LDB(B1, 1, 1); PG8_SCHED; PG8_LDA(At, 1, 0); PG8_STAGE(PG8_SA(0, 1), a2 + hstepA, voffA);
            PG8_WAIT_V(8); PG8_WAIT_L(0); PG8_BAR; PG8_MMA(0, 0, At, B0); PG8_MMA(0, 1, At, B1); PG8_BAR; PG8_SCHED;
            PG8_LDA(At, 1, 1); PG8_STAGE(PG8_SB(1, 0), b3, voffB); PG8_STAGE(PG8_SB(1, 1), b3 + hstepB, voffB); PG8_STAGE(PG8_SA(1, 0), a3, voffA);
            PG8_WAIT_V(8); PG8_WAIT_L(0); PG8_BAR; PG8_MMA(1, 0, At, B0); PG8_MMA(1, 1, At, B1); PG8_BAR; PG8_SCHED;
#else
            PG8_LDB(B0, 0, 0); PG8_SCHED; PG8_LDA(At, 0, 0); PG8_STAGE(PG8_SA(1, 1), a1 + hstepA, voffA);
            PG8_WAIT_L(8); PG8_BAR; PG8_WAIT_L(0); PG8_MMA(0, 0, At, B0); PG8_BAR; PG8_SCHED;
            PG8_LDB(B1, 0, 1); PG8_STAGE(PG8_SB(0, 0), b2, voffB);
            PG8_BAR; PG8_WAIT_L(0); PG8_MMA(0, 1, At, B1); PG8_BAR;
            PG8_LDA(At, 0, 1); PG8_STAGE(PG8_SA(0, 0), a2, voffA);
            PG8_BAR; PG8_WAIT_L(0); PG8_MMA(1, 0, At, B0); PG8_BAR; PG8_SCHED;
            PG8_STAGE(PG8_SB(0, 1), b2 + hstepB, voffB);
            PG8_WAIT_V(6); PG8_BAR; PG8_MMA(1, 1, At, B1); PG8_BAR;
            PG8_LDB(B0, 1, 0); PG8_SCHED; PG8_LDA(At, 1, 0); PG8_STAGE(PG8_SA(0, 1), a2 + hstepA, voffA);
            PG8_WAIT_L(8); PG8_BAR; PG8_WAIT_L(0); PG8_MMA(0, 0, At, B0); PG8_BAR; PG8_SCHED;
            PG8_LDB(B1, 1, 1); PG8_STAGE(PG8_SB(1, 0), b3, voffB);
            PG8_BAR; PG8_WAIT_L(0); PG8_MMA(0, 1, At, B1); PG8_BAR;
            PG8_LDA(At, 1, 1); PG8_STAGE(PG8_SA(1, 0), a3, voffA);
            PG8_BAR; PG8_WAIT_L(0); PG8_MMA(1, 0, At, B0); PG8_BAR; PG8_SCHED;
            PG8_STAGE(PG8_SB(1, 1), b3 + hstepB, voffB);
            PG8_WAIT_V(6); PG8_BAR; PG8_MMA(1, 1, At, B1); PG8_BAR;
#endif
        }
        if (wr == 0) PG8_BAR;
        E(acc, cur, wr, wc, elds);
        if (!has_next) break;
#pragma unroll
        for (int a = 0; a < 2; ++a)
#pragma unroll
            for (int b = 0; b < 2; ++b)
#pragma unroll
                for (int m = 0; m < 4; ++m)
#pragma unroll
                    for (int n = 0; n < 2; ++n) acc[a][b][m][n] = (f32x4){zf, zf, zf, zf};
        cur = nxt; cA = nA; cB = nB; ++ui;
        if constexpr (Epi::KGROUP) E.unit_begin(cur, elds, wave_s);
        PG8_LANECONST();
        if (wr == 1) PG8_BAR;
    }
    PG8_WAIT_V(0);
    PG8_BAR;
#undef PG8_LANECONST
#undef PG8_SA
#undef PG8_SB
#undef PG8_STAGE
#undef PG8_LDA
#undef PG8_LDB
#undef PG8_MMA
}
}
namespace epi {
using pg8::f32x4; using pg8::u32x4; using pg8::u32x2; using pg8::bf16_t; using pg8::Unit; using pg8::cvt_pk_bf16;
constexpr int MROWS = 16384, DMODEL = 1024;
constexpr float EPS = 1e-6f;
#define EPI_LAS __attribute__((address_space(3)))

__device__ __forceinline__ float row_rstd(const float* ssq, int row) {
    const f32x4 a = *(const f32x4*)(ssq + (size_t)row * 4);
    const float s = (a[0] + a[1]) + (a[2] + a[3]);
    return 1.0f / sqrtf(s * (1.0f / DMODEL) + EPS);
}
template <int MSTEP> __device__ __forceinline__ void rstd8(const float* ssq, int row0, bool clamp, float (&rs)[2][4]) {
    f32x4 p[2][4];
#pragma unroll
    for (int ai = 0; ai < 2; ++ai)
#pragma unroll
        for (int m = 0; m < 4; ++m) { int row = row0 + ai * 128 + m * MSTEP; if (clamp) row = row < 0 ? 0 : (row >= MROWS ? MROWS - 1 : row); p[ai][m] = *(const f32x4*)(ssq + (size_t)row * 4); }
#pragma unroll
    for (int ai = 0; ai < 2; ++ai)
#pragma unroll
        for (int m = 0; m < 4; ++m) { const f32x4 a = p[ai][m]; rs[ai][m] = 1.0f / sqrtf(((a[0] + a[1]) + (a[2] + a[3])) * (1.0f / DMODEL) + EPS); }
}
template <int CTRL> __device__ __forceinline__ float dppf(float old, float src) {
    return __builtin_bit_cast(float, __builtin_amdgcn_update_dpp(__builtin_bit_cast(int, old), __builtin_bit_cast(int, src), CTRL, 0xF, 0xF, false));
}
template <int CTRL> __device__ __forceinline__ float dppa(float src) {
    return __builtin_bit_cast(float, __builtin_amdgcn_mov_dpp(__builtin_bit_cast(int, src), CTRL, 0xF, 0xF, true));
}
__device__ __forceinline__ f32x4 silu4(f32x4 v) {
    const f32x4 t = v * (-1.4426950408889634f); f32x4 e;
#pragma unroll
    for (int i = 0; i < 4; ++i) e[i] = __builtin_amdgcn_exp2f(t[i]);
    e = e + 1.0f;
#pragma unroll
    for (int i = 0; i < 4; ++i) e[i] = __builtin_amdgcn_rcpf(e[i]);
    return v * e;
}
template <int CTRL> __device__ __forceinline__ float dppz(float src) {
    return __builtin_bit_cast(float, __builtin_amdgcn_update_dpp(0, __builtin_bit_cast(int, src), CTRL, 0xF, 0xF, true));
}
__device__ __forceinline__ float silu_fast(float v) { return v * __builtin_amdgcn_rcpf(1.0f + __builtin_amdgcn_exp2f(-1.4426950408889634f * v)); }

#ifndef RES_LO
#define RES_LO 1
#endif
template <int MODE  > struct EpiResidual {
    static constexpr bool PERM = true, ROWIL = false, KGROUP = false;
    const float* xin_f32; float* xout_f32; bf16_t* xh; bf16_t* xl; float* ssq; int dry;
    __device__ __forceinline__ void operator()(f32x4 (&acc)[2][2][4][2], const Unit& u, int wr, int wc, EPI_LAS unsigned char* elds) const {
        int fr, fq; { int t_ = HW_LANE(); asm volatile("" : "+v"(t_)); fr = t_ & 15; fq = (t_ >> 4) & 3; }
        EPI_LAS float* P = (EPI_LAS float*)elds;
        const int col0 = u.pn * 256 + wc * 32 + 8 * fq;
#pragma unroll
        for (int ai = 0; ai < 2; ++ai) {
            u32x4 xa[4][2], xb_[4][2];
#pragma unroll
            for (int m = 0; m < 4; ++m)
#pragma unroll
                for (int bj = 0; bj < 2; ++bj) {
                    const size_t o = (size_t)(u.pm * 256 + ai * 128 + wr * 64 + m * 16 + fr) * DMODEL + col0 + bj * 128;
                    if (MODE == 1) { xa[m][bj] = *(const u32x4*)(xin_f32 + o); xb_[m][bj] = *(const u32x4*)(xin_f32 + o + 4); }
                    else { xa[m][bj] = *(const u32x4*)(xh + o); xb_[m][bj] = RES_LO ? *(const u32x4*)(xl + o) : (u32x4){0u, 0u, 0u, 0u}; }
                }
#pragma unroll
            for (int m = 0; m < 4; ++m) {
                const int row = u.pm * 256 + ai * 128 + wr * 64 + m * 16 + fr;
                float s = 0.f;
#pragma unroll
                for (int bj = 0; bj < 2; ++bj) {
                    const size_t o = (size_t)row * DMODEL + col0 + bj * 128;
                    f32x4 v0, v1;
                    if (MODE == 1) { v0 = __builtin_bit_cast(f32x4, xa[m][bj]); v1 = __builtin_bit_cast(f32x4, xb_[m][bj]); }
                    else {
#pragma unroll
                        for (int i = 0; i < 2; ++i) {
                            v0[2 * i] = __builtin_bit_cast(float, xa[m][bj][i] << 16) + __builtin_bit_cast(float, xb_[m][bj][i] << 16);
                            v0[2 * i + 1] = __builtin_bit_cast(float, xa[m][bj][i] & 0xffff0000u) + __builtin_bit_cast(float, xb_[m][bj][i] & 0xffff0000u);
                            v1[2 * i] = __builtin_bit_cast(float, xa[m][bj][2 + i] << 16) + __builtin_bit_cast(float, xb_[m][bj][2 + i] << 16);
                            v1[2 * i + 1] = __builtin_bit_cast(float, xa[m][bj][2 + i] & 0xffff0000u) + __builtin_bit_cast(float, xb_[m][bj][2 + i] & 0xffff0000u);
                        }
                    }
                    v0 = v0 + acc[ai][bj][m][0]; v1 = v1 + acc[ai][bj][m][1];
                    s += ((v0[0] * v0[0] + v0[1] * v0[1]) + (v0[2] * v0[2] + v0[3] * v0[3])) + ((v1[0] * v1[0] + v1[1] * v1[1]) + (v1[2] * v1[2] + v1[3] * v1[3]));
                    if (MODE == 2) { if (!dry) { *(f32x4*)(xout_f32 + o) = v0; *(f32x4*)(xout_f32 + o + 4) = v1; } }
                    else {
                        u32x4 h; h.x = cvt_pk_bf16(v0[0], v0[1]); h.y = cvt_pk_bf16(v0[2], v0[3]); h.z = cvt_pk_bf16(v1[0], v1[1]); h.w = cvt_pk_bf16(v1[2], v1[3]);
                        u32x4 l;
                        l.x = cvt_pk_bf16(v0[0] - __builtin_bit_cast(float, h.x << 16), v0[1] - __builtin_bit_cast(float, h.x & 0xffff0000u));
                        l.y = cvt_pk_bf16(v0[2] - __builtin_bit_cast(float, h.y << 16), v0[3] - __builtin_bit_cast(float, h.y & 0xffff0000u));
                        l.z = cvt_pk_bf16(v1[0] - __builtin_bit_cast(float, h.z << 16), v1[1] - __builtin_bit_cast(float, h.z & 0xffff0000u));
                        l.w = cvt_pk_bf16(v1[2] - __builtin_bit_cast(float, h.w << 16), v1[3] - __builtin_bit_cast(float, h.w & 0xffff0000u));
                        if (!dry) { *(u32x4*)(xh + o) = h; if (RES_LO) *(u32x4*)(xl + o) = l; }
                    }
                }
                s = xl_swap32_sum(xl_swap16_sum(s));
                if (fq == 0) P[(ai * 128 + wr * 64 + m * 16 + fr) * 4 + wc] = s;
            }
            asm volatile("" ::: "memory");
        }
        asm volatile("s_waitcnt lgkmcnt(0)" ::: "memory"); __builtin_amdgcn_s_barrier(); asm volatile("" ::: "memory");
        { const int t = (wr * 4 + wc) * 64 + fq * 16 + fr; if (t < 256) { const f32x4 p = *(const EPI_LAS f32x4*)(P + t * 4); ssq[(size_t)(u.pm * 256 + t) * 4 + u.pn] = (p[0] + p[1]) + (p[2] + p[3]); } }
        asm volatile("s_waitcnt lgkmcnt(0)" ::: "memory"); __builtin_amdgcn_s_barrier(); asm volatile("" ::: "memory");
    }
};

template <int MODE> struct EpiResidualG {
    static constexpr bool PERM = true, ROWIL = false, KGROUP = true;
    const float* xin_f32; bf16_t* xh; bf16_t* xl; float* ssq; const float* ssqp; int dry;
    __device__ __forceinline__ void unit_begin(const Unit& u, EPI_LAS unsigned char* elds, int wave_s) const {
        int t = wave_s * 64 + HW_LANE(); asm volatile("" : "+v"(t));
        if (t < 256) {
            const f32x4* p = (const f32x4*)(ssqp + (size_t)(u.pm * 256 + t) * 32);
            float r[4];
#pragma unroll
            for (int g = 0; g < 4; ++g) { const f32x4 a = p[2 * g], b = p[2 * g + 1]; r[g] = 1.0f / sqrtf((((a[0] + a[1]) + (a[2] + a[3])) + ((b[0] + b[1]) + (b[2] + b[3]))) * (1.0f / 512.0f) + EPS); }
            *(EPI_LAS f32x4*)(elds + 4096 + t * 16) = (f32x4){r[0] / r[1], r[1] / r[2], r[2] / r[3], r[3]};
        }
    }
    __device__ __forceinline__ void kgroup(f32x4 (&acc)[2][2][4][2], int g, int wr, EPI_LAS unsigned char* elds) const {
        int fr; { int t_ = HW_LANE(); asm volatile("" : "+v"(t_)); fr = t_ & 15; }
        const EPI_LAS float* RG = (const EPI_LAS float*)(elds + 4096) + (g - 1);
#pragma unroll
        for (int ai = 0; ai < 2; ++ai)
#pragma unroll
            for (int m = 0; m < 4; ++m) {
                const float f = RG[(ai * 128 + wr * 64 + m * 16 + fr) * 4];
#pragma unroll
                for (int bj = 0; bj < 2; ++bj) { acc[ai][bj][m][0] *= f; acc[ai][bj][m][1] *= f; }
            }
    }
    __device__ __forceinline__ void operator()(f32x4 (&acc)[2][2][4][2], const Unit& u, int wr, int wc, EPI_LAS unsigned char* elds) const {
        kgroup(acc, 4, wr, elds);
        const EpiResidual<MODE> R{xin_f32, nullptr, xh, xl, ssq, dry};
        R(acc, u, wr, wc, elds);
    }
};

struct EpiSsdIn {
    static constexpr bool PERM = true, ROWIL = false, KGROUP = false;
    bf16_t* proj; float* dt; const float* dtbias; const float* ssq;
    __device__ __forceinline__ void operator()(f32x4 (&acc)[2][2][4][2], const Unit& u, int wr, int wc, EPI_LAS unsigned char*) const {
        int fr, fq; { int t_ = HW_LANE(); asm volatile("" : "+v"(t_)); fr = t_ & 15; fq = (t_ >> 4) & 3; }
        float rsv[2][4]; rstd8<16>(ssq, u.pm * 256 + wr * 64 + fr, false, rsv);
#pragma unroll
        for (int ai = 0; ai < 2; ++ai)
#pragma unroll
            for (int m = 0; m < 4; ++m) {
                const int row = u.pm * 256 + ai * 128 + wr * 64 + m * 16 + fr;
                const float rs = rsv[ai][m];
                if (u.pn < 20) {
#pragma unroll
                    for (int bj = 0; bj < 2; ++bj) {
                        const f32x4 v0 = acc[ai][bj][m][0] * rs, v1 = acc[ai][bj][m][1] * rs;
                        u32x4 w; w.x = cvt_pk_bf16(v0[0], v0[1]); w.y = cvt_pk_bf16(v0[2], v0[3]); w.z = cvt_pk_bf16(v1[0], v1[1]); w.w = cvt_pk_bf16(v1[2], v1[3]);
                        *(u32x4*)(proj + (size_t)row * 5120 + u.pn * 256 + bj * 128 + wc * 32 + 8 * fq) = w;
                    }
                } else if (wc == 0) {
#pragma unroll
                    for (int n = 0; n < 2; ++n) {
                        const int c = 8 * fq + 4 * n;
                        const f32x4 b = *(const f32x4*)(dtbias + c);
                        f32x4 v = acc[ai][0][m][n] * rs + b, o;
#pragma unroll
                        for (int e = 0; e < 4; ++e) o[e] = fmaxf(v[e], 0.f) + log1pf(expf(-fabsf(v[e])));
                        *(f32x4*)(dt + (size_t)row * 32 + c) = o;
                    }
                }
            }
    }
};

struct EpiQKV {
    static constexpr bool PERM = true, ROWIL = false, KGROUP = false;
    bf16_t* proj; const float* ssq; const float* qg; const float* kg; const float* rope;
    __device__ __forceinline__ void operator()(f32x4 (&acc)[2][2][4][2], const Unit& u, int wr, int wc, EPI_LAS unsigned char* elds) const {
        int fr, fq; { int t_ = HW_LANE(); asm volatile("" : "+v"(t_)); fr = t_ & 15; fq = (t_ >> 4) & 3; }
        EPI_LAS float* P = (EPI_LAS float*)elds;
        EPI_LAS f32x4* RT = (EPI_LAS f32x4*)(elds + 8192);
        const bool isqk = u.pn < 8;
        f32x4 rp_[2];
        const int t_id = (wr * 4 + wc) * 64 + fq * 16 + fr;
        if (isqk) {
#pragma unroll
            for (int i = 0; i < 2; ++i) rp_[i] = *(const f32x4*)(rope + (size_t)u.pm * 256 * 16 + (size_t)(t_id * 2 + i) * 4);
        }
        float rsv[2][4]; rstd8<16>(ssq, u.pm * 256 + wr * 64 + fr, false, rsv);
#pragma unroll
        for (int ai = 0; ai < 2; ++ai)
#pragma unroll
            for (int m = 0; m < 4; ++m) {
                const int trow = ai * 128 + wr * 64 + m * 16 + fr;
                const float rs = rsv[ai][m];
#pragma unroll
                for (int bj = 0; bj < 2; ++bj) {
                    acc[ai][bj][m][0] *= rs; acc[ai][bj][m][1] *= rs;
                    if (isqk) {
                        const f32x4 a = acc[ai][bj][m][0], b = acc[ai][bj][m][1];
                        float s = ((a[0] * a[0] + a[1] * a[1]) + (a[2] * a[2] + a[3] * a[3])) + ((b[0] * b[0] + b[1] * b[1]) + (b[2] * b[2] + b[3] * b[3]));
                        s = xl_swap32_sum(xl_swap16_sum(s));
                        if (fq == 0) P[trow * 8 + bj * 4 + wc] = s;
                    }
                }
            }
        if (isqk) { RT[t_id * 2] = rp_[0]; RT[t_id * 2 + 1] = rp_[1]; }
        if (isqk) {
            asm volatile("s_waitcnt lgkmcnt(0)" ::: "memory"); __builtin_amdgcn_s_barrier(); asm volatile("" ::: "memory");
            const float* g = (u.pn < 4) ? qg : kg;
            const int d0 = 32 * (wc & 1) + 8 * fq;
            const f32x4 g0 = *(const f32x4*)(g + d0), g1 = *(const f32x4*)(g + d0 + 4);
            const float qs = (u.pn < 4) ? (1.4426950408889634f * 0.125f) : 1.0f;
            const bool dorope = (wc & 1) == 0;
#pragma unroll
            for (int ai = 0; ai < 2; ++ai)
#pragma unroll
                for (int m = 0; m < 4; ++m) {
                    const int trow = ai * 128 + wr * 64 + m * 16 + fr;
                    const int row = u.pm * 256 + trow;
                    f32x4 c0 = {1.f, 1.f, 1.f, 1.f}, c1 = c0, s0 = {0.f, 0.f, 0.f, 0.f}, s1 = s0;
                    if (dorope && fq < 2) {
                        c0 = RT[trow * 4 + 0]; c1 = RT[trow * 4 + 1]; s0 = RT[trow * 4 + 2]; s1 = RT[trow * 4 + 3];
                        if (fq == 0) { s0 = -s0; s1 = -s1; }
                    }
#pragma unroll
                    for (int bj = 0; bj < 2; ++bj) {
                        const float tot = P[trow * 8 + bj * 4 + wc] + P[trow * 8 + bj * 4 + (wc ^ 1)];
                        const float nr = qs / sqrtf(tot * (1.0f / 64.0f) + EPS);
                        f32x4 v0 = acc[ai][bj][m][0] * g0 * nr, v1 = acc[ai][bj][m][1] * g1 * nr;
                        if (dorope) {
                            f32x4 o0, o1;
#pragma unroll
                            for (int e = 0; e < 4; ++e) { o0[e] = xl_xor16(v0[e], (fq & 1) != 0); o1[e] = xl_xor16(v1[e], (fq & 1) != 0); }
                            v0 = v0 * c0 + o0 * s0; v1 = v1 * c1 + o1 * s1;
                        }
                        u32x4 w; w.x = cvt_pk_bf16(v0[0], v0[1]); w.y = cvt_pk_bf16(v0[2], v0[3]); w.z = cvt_pk_bf16(v1[0], v1[1]); w.w = cvt_pk_bf16(v1[2], v1[3]);
                        *(u32x4*)(proj + (size_t)row * 3072 + u.pn * 256 + bj * 128 + wc * 32 + 8 * fq) = w;
                    }
                    asm volatile("" ::: "memory");
                }
            asm volatile("s_waitcnt lgkmcnt(0)" ::: "memory"); __builtin_amdgcn_s_barrier(); asm volatile("" ::: "memory");
        } else {
#pragma unroll
            for (int ai = 0; ai < 2; ++ai)
#pragma unroll
                for (int m = 0; m < 4; ++m) {
                    const int row = u.pm * 256 + ai * 128 + wr * 64 + m * 16 + fr;
#pragma unroll
                    for (int bj = 0; bj < 2; ++bj) {
                        const f32x4 v0 = acc[ai][bj][m][0], v1 = acc[ai][bj][m][1];
                        u32x4 w; w.x = cvt_pk_bf16(v0[0], v0[1]); w.y = cvt_pk_bf16(v0[2], v0[3]); w.z = cvt_pk_bf16(v1[0], v1[1]); w.w = cvt_pk_bf16(v1[2], v1[3]);
                        *(u32x4*)(proj + (size_t)row * 3072 + u.pn * 256 + bj * 128 + wc * 32 + 8 * fq) = w;
                    }
                }
        }
    }
};

struct EpiSsdConv {
    static constexpr bool PERM = true, ROWIL = true, KGROUP = false;
    bf16_t* zp; bf16_t* xbc; float* dt; const float* ssq; const float* cp;
    template <bool MASK>
    __device__ __forceinline__ void conv_body(f32x4 (&acc)[2][2][4][2], const Unit& u, int wr, int wc, int fr, int fq, const EPI_LAS f32x4* hb, int R0) const {
        bf16_t* const obase = (u.pn < 8) ? zp + u.pn * 256 : xbc + (u.pn - 8) * 256;
        const int old_ = (u.pn < 8) ? 2048 : 3072;
#pragma unroll
        for (int bj = 0; bj < 2; ++bj) {
            u32x2 keep[2][4];
#pragma unroll
            for (int n = 0; n < 2; ++n) {
                const int tc = bj * 128 + wc * 32 + 8 * fq + 4 * n;
                const EPI_LAS float* pt = (const EPI_LAS float*)((const EPI_LAS unsigned char*)hb + 12288) + tc;
                const f32x4 bb = *(const EPI_LAS f32x4*)pt, w0 = *(const EPI_LAS f32x4*)(pt + 256), w1 = *(const EPI_LAS f32x4*)(pt + 512), w2 = *(const EPI_LAS f32x4*)(pt + 768), w3 = *(const EPI_LAS f32x4*)(pt + 1024);
#pragma unroll
                for (int ai = 0; ai < 2; ++ai) {
                    f32x4 h1 = {0.f, 0.f, 0.f, 0.f}, h2 = h1, h3 = h1;
                    const int pwr = wr ^ 1, pai = (wr == 1) ? ai : ai - 1;
                    if (pai >= 0 && fr == 0) { const int idx = (((pwr * 2 + pai) * 4 + wc) * 3 * 4 + fq) * 4 + bj * 2 + n;
                        h1 = hb[idx]; h2 = hb[idx + 16]; h3 = hb[idx + 32]; }
                    const f32x4 v0 = acc[ai][bj][0][n], v1 = acc[ai][bj][1][n], v2 = acc[ai][bj][2][n], v3 = acc[ai][bj][3][n];
                    f32x4 p1, p2, p3;
#pragma unroll
                    for (int e = 0; e < 4; ++e) { p1[e] = dppf<0x111>(h1[e], v1[e]); p2[e] = dppf<0x111>(h2[e], v2[e]); p3[e] = dppf<0x111>(h3[e], v3[e]); }
#pragma unroll
                    for (int m = 0; m < 4; ++m) {
                        const int trow = ai * 128 + wr * 64 + 4 * fr + m, row = R0 + trow;
                        const f32x4 cv = (m == 0) ? v0 : (m == 1) ? v1 : (m == 2) ? v2 : v3;
                        f32x4 x1 = (m == 0) ? p3 : (m == 1) ? v0 : (m == 2) ? v1 : v2;
                        f32x4 x2 = (m == 0) ? p2 : (m == 1) ? p3 : (m == 2) ? v0 : v1;
                        f32x4 x3 = (m == 0) ? p1 : (m == 1) ? p2 : (m == 2) ? p3 : v0;
                        if (MASK) { const int ts = row & 2047; const f32x4 z4 = {0.f, 0.f, 0.f, 0.f}; if (ts < 1) x1 = z4; if (ts < 2) x2 = z4; if (ts < 3) x3 = z4; }
                        const bool valid = trow >= 3 && row < MROWS;
                        const f32x4 o = silu4(bb + w0 * x3 + w1 * x2 + w2 * x1 + w3 * cv);
                        if (n == 0) { keep[ai][m].x = cvt_pk_bf16(o[0], o[1]); keep[ai][m].y = cvt_pk_bf16(o[2], o[3]); }
                        else if (valid) {
                            u32x4 w; w.x = keep[ai][m].x; w.y = keep[ai][m].y; w.z = cvt_pk_bf16(o[0], o[1]); w.w = cvt_pk_bf16(o[2], o[3]);
                            *(u32x4*)(obase + (size_t)row * old_ + tc - 4) = w;
                        }
                    }
                    asm volatile("" ::: "memory");
                }
            }
        }
    }
    __device__ __forceinline__ void operator()(f32x4 (&acc)[2][2][4][2], const Unit& u, int wr, int wc, EPI_LAS unsigned char* elds) const {
        int fr, fq; { int t_ = HW_LANE(); asm volatile("" : "+v"(t_)); fr = t_ & 15; fq = (t_ >> 4) & 3; }
        const int R0 = u.pm * 253 - 3;
        EPI_LAS f32x4* hb = (EPI_LAS f32x4*)elds;
        const int t_id = (wr * 4 + wc) * 64 + fq * 16 + fr;
        f32x4 pld = {0.f, 0.f, 0.f, 0.f};
        if (t_id < 320) pld = *(const f32x4*)(cp + (size_t)(t_id >> 6) * 5376 + u.pn * 256 + (t_id & 63) * 4);
        { float rsv[2][4]; rstd8<1>(ssq, R0 + wr * 64 + 4 * fr, true, rsv);
#pragma unroll
          for (int ai = 0; ai < 2; ++ai)
#pragma unroll
            for (int m = 0; m < 4; ++m)
#pragma unroll
                for (int bj = 0; bj < 2; ++bj) { acc[ai][bj][m][0] *= rsv[ai][m]; acc[ai][bj][m][1] *= rsv[ai][m]; } }
        if (t_id < 320) *(EPI_LAS f32x4*)((EPI_LAS unsigned char*)hb + 12288 + t_id * 16) = pld;
        if (u.pn == 20) {
            if (wc == 0) {
#pragma unroll
                for (int ai = 0; ai < 2; ++ai)
#pragma unroll
                    for (int m = 0; m < 4; ++m) {
                        const int trow = ai * 128 + wr * 64 + 4 * fr + m, row = R0 + trow;
                        if (trow >= 3 && row < MROWS) {
#pragma unroll
                            for (int n = 0; n < 2; ++n) {
                                const int c = 8 * fq + 4 * n;
                                const f32x4 b = *(const f32x4*)(cp + 20 * 256 + c);
                                f32x4 v = acc[ai][0][m][n] + b, o;
#pragma unroll
                                for (int e = 0; e < 4; ++e) o[e] = fmaxf(v[e], 0.f) + log1pf(expf(-fabsf(v[e])));
                                *(f32x4*)(dt + (size_t)row * 32 + c) = o;
                            }
                        }
                    }
            }
            return;
        }
        if (fr == 15) {
#pragma unroll
            for (int ai = 0; ai < 2; ++ai)
#pragma unroll
                for (int m = 1; m < 4; ++m) {
                    const int idx = ((((wr * 2 + ai) * 4 + wc) * 3 + (m - 1)) * 4 + fq) * 4;
                    hb[idx + 0] = acc[ai][0][m][0]; hb[idx + 1] = acc[ai][0][m][1]; hb[idx + 2] = acc[ai][1][m][0]; hb[idx + 3] = acc[ai][1][m][1];
                }
        }
        asm volatile("s_waitcnt lgkmcnt(0)" ::: "memory"); __builtin_amdgcn_s_barrier(); asm volatile("" ::: "memory");
        const int tf = (u.pm * 253) & 2047;
        if (tf <= 2 || tf + 252 >= 2048) conv_body<true>(acc, u, wr, wc, fr, fq, hb, R0); else conv_body<false>(acc, u, wr, wc, fr, fq, hb, R0);
        asm volatile("s_waitcnt lgkmcnt(0)" ::: "memory"); __builtin_amdgcn_s_barrier(); asm volatile("" ::: "memory");
    }
};

struct EpiConvGate {
    static constexpr bool PERM = true, ROWIL = true, KGROUP = false;
    bf16_t* H; const float* ssq; const float* cw; const float* cb; int dry;
    template <bool MASK>
    __device__ __forceinline__ void body(f32x4 (&acc)[2][2][4][2], const Unit& u, int wr, int wc, int fr, int fq, const EPI_LAS f32x4* hb, int R0) const {
        constexpr int DFF = 2816;
        u32x2 keep[2][4];
#pragma unroll
        for (int n = 0; n < 2; ++n) {
            const int ch = u.pn * 128 + wc * 32 + 8 * fq + 4 * n;
            const EPI_LAS float* pt = (const EPI_LAS float*)((const EPI_LAS unsigned char*)hb + 8192) + wc * 32 + 8 * fq + 4 * n;
            const f32x4 bg = *(const EPI_LAS f32x4*)pt, bu = *(const EPI_LAS f32x4*)(pt + 128);
            const f32x4 w0g = *(const EPI_LAS f32x4*)(pt + 256), w0u = *(const EPI_LAS f32x4*)(pt + 384), w1g = *(const EPI_LAS f32x4*)(pt + 512), w1u = *(const EPI_LAS f32x4*)(pt + 640), w2g = *(const EPI_LAS f32x4*)(pt + 768), w2u = *(const EPI_LAS f32x4*)(pt + 896);
#pragma unroll
            for (int ai = 0; ai < 2; ++ai) {
                f32x4 hg2 = {0.f, 0.f, 0.f, 0.f}, hg3 = hg2, hu2 = hg2, hu3 = hg2;
                const int pwr = wr ^ 1, pai = (wr == 1) ? ai : ai - 1;
                if (pai >= 0 && fr == 0) { const int idx = (((pwr * 2 + pai) * 4 + wc) * 2 * 4 + fq) * 4;
                    hg2 = hb[idx + n]; hu2 = hb[idx + 2 + n]; hg3 = hb[idx + 16 + n]; hu3 = hb[idx + 16 + 2 + n]; }
                const f32x4 g0 = acc[ai][0][0][n], g1_ = acc[ai][0][1][n], g2_ = acc[ai][0][2][n], g3_ = acc[ai][0][3][n];
                const f32x4 u0 = acc[ai][1][0][n], u1_ = acc[ai][1][1][n], u2_ = acc[ai][1][2][n], u3_ = acc[ai][1][3][n];
                f32x4 pg2, pg3, pu2, pu3;
#pragma unroll
                for (int e = 0; e < 4; ++e) { pg2[e] = dppf<0x111>(hg2[e], g2_[e]); pg3[e] = dppf<0x111>(hg3[e], g3_[e]); pu2[e] = dppf<0x111>(hu2[e], u2_[e]); pu3[e] = dppf<0x111>(hu3[e], u3_[e]); }
#pragma unroll
                for (int m = 0; m < 4; ++m) {
                    const int trow = ai * 128 + wr * 64 + 4 * fr + m, row = R0 + trow;
                    const f32x4 cg = (m == 0) ? g0 : (m == 1) ? g1_ : (m == 2) ? g2_ : g3_, cu = (m == 0) ? u0 : (m == 1) ? u1_ : (m == 2) ? u2_ : u3_;
                    f32x4 xg1 = (m == 0) ? pg3 : (m == 1) ? g0 : (m == 2) ? g1_ : g2_, xg2 = (m == 0) ? pg2 : (m == 1) ? pg3 : (m == 2) ? g0 : g1_;
                    f32x4 xu1 = (m == 0) ? pu3 : (m == 1) ? u0 : (m == 2) ? u1_ : u2_, xu2 = (m == 0) ? pu2 : (m == 1) ? pu3 : (m == 2) ? u0 : u1_;
                    if (MASK) { const int ts = row & 2047; const f32x4 z4 = {0.f, 0.f, 0.f, 0.f}; if (ts < 1) { xg1 = z4; xu1 = z4; } if (ts < 2) { xg2 = z4; xu2 = z4; } }
                    const f32x4 gv = bg + w0g * xg2 + w1g * xg1 + w2g * cg;
                    const f32x4 uv = bu + w0u * xu2 + w1u * xu1 + w2u * cu;
                    const f32x4 o = silu4(gv) * uv;
                    if (n == 0) { keep[ai][m].x = cvt_pk_bf16(o[0], o[1]); keep[ai][m].y = cvt_pk_bf16(o[2], o[3]); }
                    else if (trow >= 2 && row < MROWS) {
                        u32x4 w; w.x = keep[ai][m].x; w.y = keep[ai][m].y; w.z = cvt_pk_bf16(o[0], o[1]); w.w = cvt_pk_bf16(o[2], o[3]);
                        asm volatile("" :: "v"(w.x), "v"(w.y), "v"(w.z), "v"(w.w));
                        if (!dry) *(u32x4*)(H + (size_t)row * DFF + ch - 4) = w;
                    }
                }
                asm volatile("" ::: "memory");
            }
        }
    }
    __device__ __forceinline__ void operator()(f32x4 (&acc)[2][2][4][2], const Unit& u, int wr, int wc, EPI_LAS unsigned char* elds) const {
        int fr, fq; { int t_ = HW_LANE(); asm volatile("" : "+v"(t_)); fr = t_ & 15; fq = (t_ >> 4) & 3; }
        const int R0 = u.pm * 254 - 2;
        EPI_LAS f32x4* hb = (EPI_LAS f32x4*)elds;
        const int t_id = (wr * 4 + wc) * 64 + fq * 16 + fr;
        f32x4 pld = {0.f, 0.f, 0.f, 0.f};
        if (t_id < 256) { const int k = t_id >> 5, c = u.pn * 128 + (t_id & 31) * 4; pld = *(const f32x4*)((k < 2 ? cb + k * 2816 : cw + (size_t)(k - 2) * 2816) + c); }
        { float rsv[2][4]; rstd8<1>(ssq, R0 + wr * 64 + 4 * fr, true, rsv);
#pragma unroll
          for (int ai = 0; ai < 2; ++ai)
#pragma unroll
            for (int m = 0; m < 4; ++m)
#pragma unroll
                for (int bj = 0; bj < 2; ++bj) { acc[ai][bj][m][0] *= rsv[ai][m]; acc[ai][bj][m][1] *= rsv[ai][m]; } }
        if (t_id < 256) *(EPI_LAS f32x4*)((EPI_LAS unsigned char*)hb + 8192 + t_id * 16) = pld;
        if (fr == 15) {
#pragma unroll
            for (int ai = 0; ai < 2; ++ai)
#pragma unroll
                for (int m = 2; m < 4; ++m) {
                    const int idx = ((((wr * 2 + ai) * 4 + wc) * 2 + (m - 2)) * 4 + fq) * 4;
                    hb[idx + 0] = acc[ai][0][m][0]; hb[idx + 1] = acc[ai][0][m][1]; hb[idx + 2] = acc[ai][1][m][0]; hb[idx + 3] = acc[ai][1][m][1];
                }
        }
        asm volatile("s_waitcnt lgkmcnt(0)" ::: "memory"); __builtin_amdgcn_s_barrier(); asm volatile("" ::: "memory");
        const int tf = (u.pm * 254) & 2047;
        if (dry < 2) { if (tf <= 1 || tf + 253 >= 2048) body<true>(acc, u, wr, wc, fr, fq, hb, R0); else body<false>(acc, u, wr, wc, fr, fq, hb, R0); }
        asm volatile("s_waitcnt lgkmcnt(0)" ::: "memory"); __builtin_amdgcn_s_barrier(); asm volatile("" ::: "memory");
    }
};
}
namespace attn {
using pg8::bf16_t; using pg8::bf16x8; using pg8::f32x4; using pg8::u32x4;
typedef float f32x16 __attribute__((ext_vector_type(16)));
typedef short s16x4 __attribute__((ext_vector_type(4)));
#define AT_LAS __attribute__((address_space(3)))
constexpr int LD = 3072, SEQ = 2048;
constexpr int KT_BYTES = 16384, VT_BYTES = 16384, STG = KT_BYTES + VT_BYTES;
constexpr int L_X = 0;
constexpr int L_WSF = 2 * STG;
constexpr int L_OST = L_WSF + 8 * 256;
constexpr int LDS_BYTES = L_OST + 4 * 8192;
__device__ __forceinline__ int crow(int r, int hi) { return (r & 3) + 8 * (r >> 2) + 4 * hi; }
__device__ __forceinline__ unsigned cvtpk(float lo, float hi) { typedef float f2 __attribute__((ext_vector_type(2))); typedef __bf16 b2 __attribute__((ext_vector_type(2))); f2 v = {lo, hi}; b2 b = __builtin_convertvector(v, b2); return __builtin_bit_cast(unsigned, b); }
__device__ __forceinline__ s16x4 vtr(const AT_LAS char* p) { typedef short v4 __attribute__((ext_vector_type(4))); return __builtin_bit_cast(s16x4, __builtin_amdgcn_ds_read_tr16_b64_v4i16((AT_LAS v4*)p)); }

struct Params { bf16_t* qkv; float mb; float lam; int dry; };

__device__ __forceinline__ void unit(const Params& P, int b, int h, int blk, AT_LAS char* lds, const int wave_s) {
    int tid = wave_s * 64 + HW_LANE(); asm volatile("" : "+v"(tid));
    const int lane = tid & 63, r32 = lane & 31, hi = lane >> 5;
    const int wid = __builtin_amdgcn_readfirstlane(tid >> 6), comp = wid >> 2, w4 = wid & 3;
    const size_t rowb = (size_t)b * SEQ;
    const int q0 = blk * 128;
    const int nt = 2 * blk + 2, my_nt = 2 * blk + (w4 >> 1) + 1;
    const bf16_t* Kg = P.qkv + rowb * LD + 1024 + h * 128;
    const bf16_t* Vg = P.qkv + rowb * LD + 2048 + h * 128;
    u32x4 kreg[2], vreg[2];
    int kdst[2], vdst[2];
#pragma unroll
    for (int i = 0; i < 2; ++i) {
        const int p = tid + 512 * i, key = p >> 4, c16 = p & 15;
        kdst[i] = key * 256 + ((c16 ^ (key & 15)) << 4);
        vdst[i] = KT_BYTES + (c16 >> 2) * 4096 + (key >> 4) * 1024 + ((key >> 3) & 1) * 512 + (key & 7) * 64 + (c16 & 3) * 16;
    }
#define AT_LOAD(t) do { _Pragma("unroll") for (int i = 0; i < 2; ++i) { const int p = tid + 512 * i, key = p >> 4, c16 = p & 15; const size_t go = (size_t)((t) * 64 + key) * LD + c16 * 8; \
        kreg[i] = *(const u32x4*)(Kg + go); vreg[i] = *(const u32x4*)(Vg + go); } } while (0)
#define AT_STORE(s) do { _Pragma("unroll") for (int i = 0; i < 2; ++i) { *(AT_LAS u32x4*)(lds + (s) * STG + kdst[i]) = kreg[i]; *(AT_LAS u32x4*)(lds + (s) * STG + vdst[i]) = vreg[i]; } } while (0)
    AT_LOAD(0);
    bf16x8 qr[4];
    {
        const bf16_t* Qw = P.qkv + (rowb + q0 + w4 * 32 + r32) * LD + h * 128 + comp * 64 + hi * 8;
#pragma unroll
        for (int d0 = 0; d0 < 4; ++d0) qr[d0] = *(const bf16x8*)(Qw + d0 * 16);
    }
    AT_STORE(0);
    __syncthreads();
    f32x16 o[4];
#pragma unroll
    for (int i = 0; i < 4; ++i)
#pragma unroll
        for (int r = 0; r < 16; ++r) o[i][r] = 0.f;
    float lsum = 0.f;
    f32x16 negm;
#pragma unroll
    for (int r = 0; r < 16; ++r) negm[r] = -P.mb;
    const int kbase = r32 * 256, ksw = r32 & 15;
    const int vbase = KT_BYTES + ((lane >> 4) & 1) * 32 + (lane & 3) * 8 + (4 * hi + ((lane & 15) >> 2)) * 64;
    for (int t = 0; t < nt; ++t) {
        const int s = t & 1;
        if (t + 1 < nt) AT_LOAD(t + 1);
        if (t < my_nt) {
            const AT_LAS char* st = lds + s * STG;
            bf16x8 kf[8];
#pragma unroll
            for (int d0 = 0; d0 < 4; ++d0) {
                const int ch = comp * 8 + 2 * d0 + hi;
                kf[2 * d0] = *(const AT_LAS bf16x8*)(st + kbase + ((ch ^ ksw) << 4));
                kf[2 * d0 + 1] = *(const AT_LAS bf16x8*)(st + kbase + 32 * 256 + ((ch ^ ksw) << 4));
            }
            s16x4 vlo[2][4], vhi[2][4];
#define AT_VLOAD(bk, buf) do { _Pragma("unroll") for (int ks = 0; ks < 4; ++ks) { vlo[buf][ks] = vtr(st + vbase + (bk) * 4096 + ks * 1024); vhi[buf][ks] = vtr(st + vbase + (bk) * 4096 + ks * 1024 + 512); } } while (0)
            AT_VLOAD(0, 0);
            __builtin_amdgcn_sched_barrier(0);
            f32x16 p0 = negm, p1 = negm;
#pragma unroll
            for (int d0 = 0; d0 < 4; ++d0) {
                p0 = __builtin_amdgcn_mfma_f32_32x32x16_bf16(kf[2 * d0], qr[d0], p0, 0, 0, 0);
                p1 = __builtin_amdgcn_mfma_f32_32x32x16_bf16(kf[2 * d0 + 1], qr[d0], p1, 0, 0, 0);
            }
            __builtin_amdgcn_sched_barrier(0);
            AT_VLOAD(1, 1);
            __builtin_amdgcn_sched_barrier(0);
            float sacc0 = 0.f, sacc1 = 0.f;
#pragma unroll
            for (int r = 0; r < 16; ++r) { p0[r] = __builtin_amdgcn_exp2f(p0[r]); p1[r] = __builtin_amdgcn_exp2f(p1[r]); sacc0 += p0[r]; sacc1 += p1[r]; }
            lsum += sacc0 + sacc1;
            u32x4 pw[4];
#pragma unroll
            for (int j = 0; j < 4; ++j) { pw[0][j] = cvtpk(p0[2 * j], p0[2 * j + 1]); pw[1][j] = cvtpk(p0[8 + 2 * j], p0[8 + 2 * j + 1]); pw[2][j] = cvtpk(p1[2 * j], p1[2 * j + 1]); pw[3][j] = cvtpk(p1[8 + 2 * j], p1[8 + 2 * j + 1]); }
#define AT_PV(bk, buf) do { _Pragma("unroll") for (int ks = 0; ks < 4; ++ks) { \
                const bf16x8 vf = {vlo[buf][ks][0], vlo[buf][ks][1], vlo[buf][ks][2], vlo[buf][ks][3], vhi[buf][ks][0], vhi[buf][ks][1], vhi[buf][ks][2], vhi[buf][ks][3]}; \
                o[bk] = __builtin_amdgcn_mfma_f32_32x32x16_bf16(__builtin_bit_cast(bf16x8, pw[ks]), vf, o[bk], 0, 0, 0); } } while (0)
            __builtin_amdgcn_sched_barrier(0);
            AT_PV(0, 0); __builtin_amdgcn_sched_barrier(0); AT_VLOAD(2, 0); __builtin_amdgcn_sched_barrier(0);
            AT_PV(1, 1); __builtin_amdgcn_sched_barrier(0); AT_VLOAD(3, 1); __builtin_amdgcn_sched_barrier(0);
            AT_PV(2, 0);
            AT_PV(3, 1);
#undef AT_VLOAD
#undef AT_PV
        }
        if (t + 1 < nt) AT_STORE(s ^ 1);
        __syncthreads();
    }
    lsum = xl_swap32_sum(lsum);
    AT_LAS float* wsf = (AT_LAS float*)(lds + L_WSF) + wid * 64;
    if (hi == 0) wsf[r32] = lsum;
    asm volatile("s_waitcnt lgkmcnt(0)" ::: "memory");
    float rl[16];
    const float sc = comp ? P.lam : 1.0f;
#pragma unroll
    for (int r = 0; r < 16; ++r) rl[r] = sc * __builtin_amdgcn_rcpf(wsf[crow(r, hi)]);
    AT_LAS float* X = (AT_LAS float*)(lds + L_X) + w4 * 4096 + lane;
    if (comp == 1) {
#pragma unroll
        for (int bk = 0; bk < 4; ++bk)
#pragma unroll
            for (int r = 0; r < 16; ++r) X[(bk * 16 + r) * 64] = o[bk][r] * rl[r];
    }
    __syncthreads();
    if (comp == 0) {
        float ss[16];
#pragma unroll
        for (int r = 0; r < 16; ++r) ss[r] = 0.f;
#pragma unroll
        for (int bk = 0; bk < 4; ++bk)
#pragma unroll
            for (int r = 0; r < 16; ++r) { const float v = o[bk][r] * rl[r] - X[(bk * 16 + r) * 64]; o[bk][r] = v; ss[r] += v * v; }
#pragma unroll
        for (int r = 0; r < 16; ++r) {
            float s = ss[r];
            s = xl_swap16_sum(xl_sum16(s));
            ss[r] = 1.0f / sqrtf(s * (1.0f / 128.0f) + 1e-6f);
        }
        AT_LAS bf16_t* stg = (AT_LAS bf16_t*)(lds + L_OST) + w4 * 4096;
#pragma unroll
        for (int bk = 0; bk < 4; ++bk)
#pragma unroll
            for (int r = 0; r < 16; ++r) { const float v = o[bk][r] * ss[r]; stg[crow(r, hi) * 128 + bk * 32 + r32] = (bf16_t)(cvtpk(v, 0.f) & 0xffffu); }
        asm volatile("s_waitcnt lgkmcnt(0)" ::: "memory");
        bf16_t* Ow = P.qkv + (rowb + q0 + w4 * 32) * LD + h * 128;
#pragma unroll
        for (int i = 0; i < 8; ++i) { const int row = i * 4 + (lane >> 4), c = lane & 15; const u32x4 v = *(const AT_LAS u32x4*)(stg + row * 128 + c * 8); if (!P.dry) *(u32x4*)(Ow + (size_t)row * LD + c * 8) = v; }
    }
    __syncthreads();
#undef AT_LOAD
#undef AT_STORE
}
}
namespace scan {
using pg8::bf16_t; using pg8::bf16x8; using pg8::f32x4; using pg8::u32x4; using pg8::u32x2;
typedef float f32x16 __attribute__((ext_vector_type(16)));
#define SC_LAS __attribute__((address_space(3)))
#define SC_BAR() do { asm volatile("s_waitcnt lgkmcnt(0)" ::: "memory"); __builtin_amdgcn_s_barrier(); asm volatile("" ::: "memory"); } while (0)
constexpr int SEQ = 2048, CH = 64;
constexpr int L_C = 0;
constexpr int L_B = 16384;
constexpr int L_XD = 32768;
constexpr int L_XW = 40960;
constexpr int L_G = 49152;
constexpr int L_H = 57344;
constexpr int L_Y = 73728;
constexpr int L_S = L_Y + 64 * 68 * 4;
constexpr int LDS_BYTES = L_S + 32 * 1024;
__device__ __forceinline__ unsigned cvtpk(float lo, float hi) { typedef float f2 __attribute__((ext_vector_type(2))); typedef __bf16 b2 __attribute__((ext_vector_type(2))); f2 v = {lo, hi}; b2 b = __builtin_convertvector(v, b2); return __builtin_bit_cast(unsigned, b); }
typedef short s16x4 __attribute__((ext_vector_type(4)));
__device__ __forceinline__ s16x4 vtr(const SC_LAS char* p) { typedef short v4 __attribute__((ext_vector_type(4))); return __builtin_bit_cast(s16x4, __builtin_amdgcn_ds_read_tr16_b64_v4i16((SC_LAS v4*)p)); }
__device__ __forceinline__ float lo16(unsigned w) { return __builtin_bit_cast(float, w << 16); }
__device__ __forceinline__ float hi16(unsigned w) { return __builtin_bit_cast(float, w & 0xffff0000u); }
__device__ __forceinline__ int img_off(int l) { return (l >> 4) * 1024 + ((l >> 3) & 1) * 512 + (l & 7) * 64; }

struct Params { const bf16_t* xbc; bf16_t* zp; const float* dt; const float* a_log; const float* dskip; float* ssqp; int dry; };

__device__ __forceinline__ void unit(const Params& P, int b, int h, SC_LAS char* lds, const int wave_s) {
    int tid = wave_s * 64 + HW_LANE(); asm volatile("" : "+v"(tid));
    const int wid = __builtin_amdgcn_readfirstlane(tid >> 6);
    const int g = h >> 3;
    const size_t rowb = (size_t)b * SEQ;
    const float a_h = -expf(P.a_log[h]), dsk = P.dskip[h];
    unsigned zu = 0u; asm volatile("" : "+v"(zu));
    {
        const int lane_ = tid & 63;
#pragma unroll
        for (int q = 0; q < 4; ++q) {
            const int cc = wid * 4 + q;
            const float dtv = P.dt[(rowb + cc * 64 + lane_) * 32 + h];
            float acs = dtv * a_h;
            acs = xl_scan64(acs);
            const float last = __builtin_bit_cast(float, __builtin_amdgcn_readlane(__builtin_bit_cast(int, acs), 63));
            SC_LAS float* sc = (SC_LAS float*)(lds + L_S) + cc * 256;
            sc[lane_] = dtv; sc[64 + lane_] = acs; sc[128 + lane_] = __expf(last - acs); sc[192 + lane_] = __expf(acs);
        }
    }
    for (int i = tid; i < 16384 / 16; i += 512) *(SC_LAS u32x4*)(lds + L_H + i * 16) = (u32x4){zu, zu, zu, zu};
    f32x16 hacc0, hacc1;
#pragma unroll
    for (int r = 0; r < 16; ++r) { hacc0[r] = 0.f; hacc1[r] = 0.f; }
    const int tid0 = tid;
    u32x4 xr, zr, br[2], cr[2];
#define SC_LOAD(t0_, XR, ZR) do { const int t_ = tid0; const size_t r1 = rowb + (t0_) + (t_ >> 3); \
        XR = *(const u32x4*)(P.xbc + r1 * 3072 + h * 64 + (t_ & 7) * 8); ZR = *(const u32x4*)(P.zp + r1 * 2048 + h * 64 + (t_ & 7) * 8); \
        _Pragma("unroll") for (int i = 0; i < 2; ++i) { const int p_ = t_ + 512 * i; const size_t r2 = rowb + (t0_) + (p_ >> 4); \
            br[i] = *(const u32x4*)(P.xbc + r2 * 3072 + 2048 + g * 128 + (p_ & 15) * 8); cr[i] = *(const u32x4*)(P.xbc + r2 * 3072 + 2560 + g * 128 + (p_ & 15) * 8); } } while (0)
    SC_LOAD(0, xr, zr);
    __syncthreads();
    for (int c = 0; c < SEQ / CH; ++c) {
        const int t0 = c * CH;
        int tid = tid0; asm volatile("" : "+v"(tid));
        const int lane = tid & 63, r32 = lane & 31, hi = lane >> 5, fr = lane & 15, fq = lane >> 4;
        const int orow = tid >> 3, ocg = tid & 7;
        SC_LAS float* s_dt = (SC_LAS float*)(lds + L_S) + c * 256; SC_LAS float* s_acs = s_dt + 64; SC_LAS float* s_dec = s_dt + 128; SC_LAS float* s_ea = s_dt + 192;
        {
            const float d = s_dt[orow], dd = d * s_dec[orow];
            u32x4 w1, w2;
#pragma unroll
            for (int i = 0; i < 4; ++i) { const float a = lo16(xr[i]), bq = hi16(xr[i]); w1[i] = cvtpk(a * d, bq * d); w2[i] = cvtpk(a * dd, bq * dd); }
            const int off = (ocg >> 2) * 4096 + img_off(orow) + (ocg & 3) * 16;
            *(SC_LAS u32x4*)(lds + L_XD + off) = w1; *(SC_LAS u32x4*)(lds + L_XW + off) = w2;
#pragma unroll
            for (int i = 0; i < 2; ++i) { const int p = tid + 512 * i, l = p >> 4, c16 = p & 15;
                *(SC_LAS u32x4*)(lds + L_B + (c16 >> 2) * 4096 + img_off(l) + (c16 & 3) * 16) = br[i];
                *(SC_LAS u32x4*)(lds + L_C + l * 256 + ((c16 ^ (l & 15)) << 4)) = cr[i]; }
        }
        const u32x4 xcur = xr, zcur = zr;
        if (c + 1 < SEQ / CH) SC_LOAD(t0 + CH, xr, zr);
        SC_BAR();
        f32x16 yacc;
#pragma unroll
        for (int r = 0; r < 16; ++r) yacc[r] = 0.f;
        const int yli = (wid >> 1) & 1, ypi = wid & 1;
        if (wid < 3) {
            const int si = (wid == 2) ? 1 : 0, li = (wid == 0) ? 0 : 1;
            const int srow = 32 * si + r32, lrow = 32 * li + r32;
            f32x16 cb;
#pragma unroll
            for (int r = 0; r < 16; ++r) cb[r] = 0.f;
            bf16x8 fa[8], fb[8];
#pragma unroll
            for (int ks = 0; ks < 8; ++ks) {
                const int chk = 2 * ks + hi;
                fa[ks] = *(const SC_LAS bf16x8*)(lds + L_B + (chk >> 2) * 4096 + img_off(srow) + (chk & 3) * 16);
                fb[ks] = *(const SC_LAS bf16x8*)(lds + L_C + lrow * 256 + ((chk ^ (lrow & 15)) << 4));
            }
            __builtin_amdgcn_sched_barrier(0);
#pragma unroll
            for (int ks = 0; ks < 8; ++ks) cb = __builtin_amdgcn_mfma_f32_32x32x16_bf16(fa[ks], fb[ks], cb, 0, 0, 0);
            const float al = s_acs[lrow];
#pragma unroll
            for (int q4 = 0; q4 < 4; ++q4) {
                const int s0 = 32 * si + 8 * q4 + 4 * hi;
                float gv[4];
#pragma unroll
                for (int e = 0; e < 4; ++e) { const int sidx = s0 + e; gv[e] = (sidx <= lrow) ? cb[4 * q4 + e] * __expf(al - s_acs[sidx]) : 0.f; }
                u32x2 w; w.x = cvtpk(gv[0], gv[1]); w.y = cvtpk(gv[2], gv[3]);
                *(SC_LAS u32x2*)(lds + L_G + lrow * 128 + (((s0 >> 3) ^ (lrow & 7)) << 4) + (s0 & 7) * 2) = w;
            }
        } else if (wid >= 4) {
            const int lrow = 32 * yli + r32, prow = 32 * ypi + r32;
            bf16x8 fa[8], fb[8];
#pragma unroll
            for (int ks = 0; ks < 8; ++ks) {
                const int chk = 2 * ks + hi;
                fa[ks] = *(const SC_LAS bf16x8*)(lds + L_C + lrow * 256 + ((chk ^ (lrow & 15)) << 4));
                fb[ks] = *(const SC_LAS bf16x8*)(lds + L_H + prow * 256 + ((chk ^ (prow & 15)) << 4));
            }
            __builtin_amdgcn_sched_barrier(0);
#pragma unroll
            for (int ks = 0; ks < 8; ++ks) yacc = __builtin_amdgcn_mfma_f32_32x32x16_bf16(fa[ks], fb[ks], yacc, 0, 0, 0);
        }
        SC_BAR();
        if (wid >= 4) {
#pragma unroll
            for (int r = 0; r < 16; ++r) yacc[r] *= s_ea[32 * yli + (r & 3) + 8 * (r >> 2) + 4 * hi];
            const int lrow = 32 * yli + r32;
            const int tbn = ((lane >> 4) & 1) * 32 + (lane & 3) * 8 + hi * 512 + ((lane & 15) >> 2) * 64;
            bf16x8 ga[4]; s16x4 xb0[4], xb1[4];
#pragma unroll
            for (int ks = 0; ks < 4; ++ks) {
                const int chk = 2 * ks + hi;
                ga[ks] = *(const SC_LAS bf16x8*)(lds + L_G + lrow * 128 + ((chk ^ (lrow & 7)) << 4));
                xb0[ks] = vtr(lds + L_XD + ypi * 4096 + ks * 1024 + tbn); xb1[ks] = vtr(lds + L_XD + ypi * 4096 + ks * 1024 + tbn + 256);
            }
            __builtin_amdgcn_sched_barrier(0);
#pragma unroll
            for (int ks = 0; ks < 4; ++ks) {
                if (ks < 2 * (yli + 1)) {
                    const bf16x8 bb = {xb0[ks][0], xb0[ks][1], xb0[ks][2], xb0[ks][3], xb1[ks][0], xb1[ks][1], xb1[ks][2], xb1[ks][3]};
                    yacc = __builtin_amdgcn_mfma_f32_32x32x16_bf16(ga[ks], bb, yacc, 0, 0, 0);
                }
            }
#pragma unroll
            for (int r = 0; r < 16; ++r) ((SC_LAS float*)(lds + L_Y))[(32 * yli + (r & 3) + 8 * (r >> 2) + 4 * hi) * 68 + 32 * ypi + r32] = yacc[r];
        } else {
            const float cd = __expf(s_acs[63]);
#pragma unroll
            for (int r = 0; r < 16; ++r) { hacc0[r] *= cd; hacc1[r] *= cd; }
            const int tb = ((lane >> 4) & 1) * 32 + (lane & 3) * 8 + (4 * hi + ((lane & 15) >> 2)) * 64;
            s16x4 a0[4], a1[4], b0[4], b1[4], c0[4], c1[4];
#pragma unroll
            for (int ks = 0; ks < 4; ++ks) {
                a0[ks] = vtr(lds + L_B + wid * 4096 + ks * 1024 + tb); a1[ks] = vtr(lds + L_B + wid * 4096 + ks * 1024 + 512 + tb);
                b0[ks] = vtr(lds + L_XW + ks * 1024 + tb); b1[ks] = vtr(lds + L_XW + ks * 1024 + 512 + tb);
                c0[ks] = vtr(lds + L_XW + 4096 + ks * 1024 + tb); c1[ks] = vtr(lds + L_XW + 4096 + ks * 1024 + 512 + tb);
            }
            __builtin_amdgcn_sched_barrier(0);
#pragma unroll
            for (int ks = 0; ks < 4; ++ks) {
                const bf16x8 a = {a0[ks][0], a0[ks][1], a0[ks][2], a0[ks][3], a1[ks][0], a1[ks][1], a1[ks][2], a1[ks][3]};
                const bf16x8 bb = {b0[ks][0], b0[ks][1], b0[ks][2], b0[ks][3], b1[ks][0], b1[ks][1], b1[ks][2], b1[ks][3]};
                const bf16x8 cc = {c0[ks][0], c0[ks][1], c0[ks][2], c0[ks][3], c1[ks][0], c1[ks][1], c1[ks][2], c1[ks][3]};
                hacc0 = __builtin_amdgcn_mfma_f32_32x32x16_bf16(a, bb, hacc0, 0, 0, 0);
                hacc1 = __builtin_amdgcn_mfma_f32_32x32x16_bf16(a, cc, hacc1, 0, 0, 0);
            }
#pragma unroll
            for (int q4 = 0; q4 < 4; ++q4) {
                const int n0 = 32 * wid + 8 * q4 + 4 * hi;
                u32x2 w0, w1; w0.x = cvtpk(hacc0[4 * q4 + 0], hacc0[4 * q4 + 1]); w0.y = cvtpk(hacc0[4 * q4 + 2], hacc0[4 * q4 + 3]);
                w1.x = cvtpk(hacc1[4 * q4 + 0], hacc1[4 * q4 + 1]); w1.y = cvtpk(hacc1[4 * q4 + 2], hacc1[4 * q4 + 3]);
                *(SC_LAS u32x2*)(lds + L_H + r32 * 256 + (((n0 >> 3) ^ (r32 & 15)) << 4) + (n0 & 7) * 2) = w0;
                *(SC_LAS u32x2*)(lds + L_H + (32 + r32) * 256 + (((n0 >> 3) ^ (r32 & 15)) << 4) + (n0 & 7) * 2) = w1;
            }
        }
        SC_BAR();
        {
            const SC_LAS float* yr = (const SC_LAS float*)(lds + L_Y) + orow * 68 + ocg * 8;
            const f32x4 y0 = *(const SC_LAS f32x4*)yr, y1 = *(const SC_LAS f32x4*)(yr + 4);
            float yv[8];
#pragma unroll
            for (int i = 0; i < 4; ++i) {
                const float ya = (i < 2) ? y0[2 * i] : y1[2 * i - 4], yb = (i < 2) ? y0[2 * i + 1] : y1[2 * i - 3];
                yv[2 * i] = (ya + dsk * lo16(xcur[i])) * lo16(zcur[i]); yv[2 * i + 1] = (yb + dsk * hi16(xcur[i])) * hi16(zcur[i]);
            }
            float ss = 0.f;
#pragma unroll
            for (int i = 0; i < 8; ++i) ss += yv[i] * yv[i];
            ss = xl_sum8(ss);
            if (ocg == 0) P.ssqp[(rowb + t0 + orow) * 32 + h] = ss;
            u32x4 w; w.x = cvtpk(yv[0], yv[1]); w.y = cvtpk(yv[2], yv[3]); w.z = cvtpk(yv[4], yv[5]); w.w = cvtpk(yv[6], yv[7]);
            if (!P.dry) *(u32x4*)(P.zp + (rowb + t0 + orow) * 2048 + h * 64 + ocg * 8) = w;
        }
    }
    __syncthreads();
#undef SC_LOAD
}
}
namespace mk {
#define GAS __attribute__((address_space(1)))
#define LAS __attribute__((address_space(3)))
typedef unsigned short bf16;
typedef unsigned v4u __attribute__((ext_vector_type(4)));
typedef float f32x4 __attribute__((ext_vector_type(4)));
typedef GAS unsigned gu32;
#define RLX_AGENT __ATOMIC_RELAXED, __HIP_MEMORY_SCOPE_AGENT
constexpr int NWAVES = 8;
constexpr int M = 16384, D = 1024, SEQ = 2048, NB = 8;
constexpr int SSD_NP = 5376, SSD_IN = 5152, SSD_DI = 2048, SSD_LD = 5120;
constexpr int AT_IN = 3072, DFF = 2816;
constexpr size_t MiB = 1u << 20;
constexpr size_t WS_CTL = 0, CTL_ZERO_BYTES = 64 * 1024;
constexpr size_t WS_CONST = 64 * 1024;
constexpr size_t WS_SSQ = 1 * MiB;
constexpr size_t WS_ROPE = 2 * MiB;
constexpr size_t WS_DT = 3 * MiB;
constexpr size_t WS_SSQP = 5 * MiB;
constexpr size_t WS_CP = 1 * MiB + 512 * 1024;
constexpr size_t WS_W = 7 * MiB;
constexpr size_t W_SSD_IN = 0, W_SSD_IN_SZ = (size_t)SSD_NP * D * 2;
constexpr size_t W_SSD_OUT = W_SSD_IN + 2 * W_SSD_IN_SZ, W_SSD_OUT_SZ = (size_t)D * SSD_DI * 2;
constexpr size_t W_AT_IN = W_SSD_OUT + 2 * W_SSD_OUT_SZ, W_AT_IN_SZ = (size_t)AT_IN * D * 2;
constexpr size_t W_AT_OUT = W_AT_IN + 2 * W_AT_IN_SZ, W_AT_OUT_SZ = (size_t)D * D * 2;
constexpr size_t W_UP = W_AT_OUT + 2 * W_AT_OUT_SZ, W_UP_SZ = (size_t)2 * DFF * D * 2;
constexpr size_t W_DOWN = W_UP + 4 * W_UP_SZ, W_DOWN_SZ = (size_t)D * DFF * 2;
constexpr size_t W_TOTAL = W_DOWN + 4 * W_DOWN_SZ;
constexpr size_t WS_XB = ((WS_W + W_TOTAL + MiB - 1) / MiB) * MiB;
constexpr size_t XB_PAD_FRONT = 4 * D * 2, XB_BYTES = (size_t)(M + 260) * D * 2;
constexpr size_t WS_BIG = ((WS_XB + XB_BYTES + MiB - 1) / MiB) * MiB;
constexpr size_t BIG_BYTES = (size_t)M * SSD_LD * 2;
constexpr size_t WS_DBG = WS_BIG + BIG_BYTES;
constexpr size_t WS_END = WS_DBG + (size_t)M * D * 2;
static_assert(WS_END <= 352 * MiB, "workspace map exceeds the guaranteed 352 MiB");
constexpr int CW_BAR = 1024;
constexpr int RING_BYTES = 131072, EPI_OFF = RING_BYTES, EPI_BYTES = 26624, MISC_OFF = EPI_OFF + EPI_BYTES;
constexpr int LDS_BYTES = 158720;
static_assert(MISC_OFF + 1024 <= LDS_BYTES && attn::LDS_BYTES <= RING_BYTES && scan::LDS_BYTES <= RING_BYTES, "LDS map");

#define LDS_WAIT() asm volatile("s_waitcnt lgkmcnt(0)" ::: "memory")
__device__ __forceinline__ unsigned f2bf(float f) { unsigned u = __builtin_bit_cast(unsigned, f); return (u + 0x7fffu + ((u >> 16) & 1u)) >> 16; }
__device__ __forceinline__ unsigned pk2(float lo, float hi) { return f2bf(lo) | (f2bf(hi) << 16); }

#define XB_TMO      128
#define XB_XCNT(j)  (256  + 64 * (j))
#define XB_XSUB(j)  (1280 + 64 * (j))
#define XB_XGEN(j)  (2304 + 64 * (j))
#define XB_TOP      3328
#define XB_TOPGEN   3392
#define XCD_BAR_WORDS 3456
#define XB_SPIN_CAP (1u << 20)
__device__ __forceinline__ unsigned xb_ld(unsigned* p)              { return __hip_atomic_load(p, __ATOMIC_RELAXED, __HIP_MEMORY_SCOPE_AGENT); }
__device__ __forceinline__ unsigned xb_add(unsigned* p, unsigned v) { return __hip_atomic_fetch_add(p, v, __ATOMIC_RELAXED, __HIP_MEMORY_SCOPE_AGENT); }
__device__ __forceinline__ unsigned xb_xcc_id() { return (unsigned)__builtin_amdgcn_s_getreg((3 << 11) | 20) & 0xFu; }
#define XB_SPIN(cond, bar) do { unsigned _sp = 0; while (cond) { __builtin_amdgcn_s_sleep(1); \
    if ((++_sp & 255u) == 0u) { if (xb_ld(&(bar)[XB_TMO])) break; if (_sp > XB_SPIN_CAP) { atomicAdd(&(bar)[XB_TMO], 1u); break; } } } } while (0)
struct XcdBarrier { unsigned* bar; unsigned x; volatile LAS unsigned* st; };
__device__ __forceinline__ XcdBarrier xcd_barrier_post(unsigned* bar, volatile LAS unsigned* st, bool leader) {
    XcdBarrier b; b.bar = bar; b.x = xb_xcc_id(); b.st = st;
    if (leader) (void)xb_add(&bar[XB_XCNT(b.x)], 1u);
    return b;
}
__device__ __forceinline__ void xcd_barrier_complete(unsigned* bar, unsigned x, unsigned& nloc, unsigned& nx) {
    const unsigned G = gridDim.x * gridDim.y * gridDim.z;
    unsigned sum, cnt, mine, sp = 0u;
    for (;;) {
        sum = 0u; cnt = 0u; mine = 0u;
#pragma unroll
        for (unsigned j = 0; j < 16; ++j) { const unsigned c = xb_ld(&bar[XB_XCNT(j)]); sum += c; cnt += (c > 0u) ? 1u : 0u; mine = (j == x) ? c : mine; }
        if (sum == G) break;
        __builtin_amdgcn_s_sleep(1);
        if ((++sp & 255u) == 0u) { if (xb_ld(&bar[XB_TMO])) break; if (sp > XB_SPIN_CAP) { atomicAdd(&bar[XB_TMO], 1u); break; } }
    }
    nloc = mine > 0u ? mine : 1u; nx = cnt > 0u ? cnt : 1u;
}
__device__ __forceinline__ void xcd_barrier(const XcdBarrier& b, const int wave_s) {
    asm volatile("s_waitcnt vmcnt(0)" ::: "memory");
    __syncthreads();
    if (wave_s == 0 && HW_LANE() == 0) {
        unsigned* bar = b.bar; asm volatile("" : "+s"(bar));
        __builtin_amdgcn_s_waitcnt(0);
        unsigned nloc = b.st[0], nx = b.st[1];
        if (nloc == 0u) { xcd_barrier_complete(bar, b.x, nloc, nx); b.st[0] = nloc; b.st[1] = nx; }
        const unsigned old = xb_add(&bar[XB_XSUB(b.x)], 1u);
        const unsigned gen = old / nloc;
        if (old + 1u == (gen + 1u) * nloc) {
            __builtin_amdgcn_fence(__ATOMIC_RELEASE, "agent");
            asm volatile("s_waitcnt vmcnt(0)" ::: "memory");
            const unsigned og = xb_add(&bar[XB_TOP], 1u);
            const unsigned tg = og / nx;
            if (og + 1u == (tg + 1u) * nx) xb_add(&bar[XB_TOPGEN], 1u);
            else XB_SPIN(xb_ld(&bar[XB_TOPGEN]) == tg, bar);
            __builtin_amdgcn_fence(__ATOMIC_ACQUIRE, "agent");
            xb_add(&bar[XB_XGEN(b.x)], 1u);
            asm volatile("s_waitcnt vmcnt(0)" ::: "memory");
        } else {
            XB_SPIN(xb_ld(&bar[XB_XGEN(b.x)]) == gen, bar);
            __builtin_amdgcn_fence(__ATOMIC_ACQUIRE, "agent");
            asm volatile("s_waitcnt vmcnt(0)" ::: "memory");
        }
    }
    __syncthreads();
}

__device__ __forceinline__ unsigned long long ldarg(LAS unsigned long long* AP, int i) {
    asm volatile("" : "+s"(i));
    const unsigned long long v = AP[i];
    return ((unsigned long long)(unsigned)__builtin_amdgcn_readfirstlane((int)(v >> 32)) << 32) | (unsigned long long)(unsigned)__builtin_amdgcn_readfirstlane((int)v);
}
struct Args { const void* in[25]; float* out; unsigned char* ws; int ph_lo, ph_hi; int dbg, pad; };

__device__ __forceinline__ float wave_sum(float v) {
    return xl_sum64(v);
}
template <class RowMap>
__device__ __forceinline__ void transpose_item(const float* W, int K, int N, const float* gain, int gmask, float gscale, bf16* WT, const RowMap& rm, LAS float* scr, int item, int item2, int lane) {
    const int nblk = N / 32, rs = lane >> 3, c4 = lane & 7, c = lane & 7;
    f32x4 va[8], vb[8]; float ga[8], gb[8];
    const int kA = 64 * (item / nblk), nA = 32 * (item % nblk);
    const int it2 = item2 < 0 ? item : item2; const int kB = 64 * (it2 / nblk), nB = 32 * (it2 % nblk);
#pragma unroll
    for (int i = 0; i < 8; ++i) { const int kk = 8 * i + rs; va[i] = *(const f32x4*)(W + (size_t)(kA + kk) * N + nA + 4 * c4); ga[i] = gain ? gain[(kA + kk) & gmask] * gscale : 1.0f; }
    if (item2 >= 0) {
#pragma unroll
        for (int i = 0; i < 8; ++i) { const int kk = 8 * i + rs; vb[i] = *(const f32x4*)(W + (size_t)(kB + kk) * N + nB + 4 * c4); gb[i] = gain ? gain[(kB + kk) & gmask] * gscale : 1.0f; }
    }
#pragma unroll
    for (int h = 0; h < 2; ++h) {
        if (h == 1 && item2 < 0) break;
        const int k0 = h ? kB : kA, n0 = h ? nB : nA;
#pragma unroll
        for (int i = 0; i < 8; ++i) { const int kk = 8 * i + rs; LAS float* d = scr + kk * 33 + 4 * c4; const f32x4 v = h ? vb[i] : va[i]; const float g = h ? gb[i] : ga[i]; d[0] = v[0] * g; d[1] = v[1] * g; d[2] = v[2] * g; d[3] = v[3] * g; }
        LDS_WAIT(); asm volatile("" ::: "memory");
#pragma unroll
        for (int j = 0; j < 4; ++j) { const int n = (lane >> 3) + 8 * j; const LAS float* sp = scr + (8 * c) * 33 + n;
            v4u o; o.x = pk2(sp[0 * 33], sp[1 * 33]); o.y = pk2(sp[2 * 33], sp[3 * 33]); o.z = pk2(sp[4 * 33], sp[5 * 33]); o.w = pk2(sp[6 * 33], sp[7 * 33]);
            *(GAS v4u*)(WT + (size_t)rm(n0 + n) * K + k0 + 8 * c) = o; }
        LDS_WAIT(); asm volatile("" ::: "memory");
    }
}
struct RowId { __device__ __forceinline__ int operator()(int n) const { return n; } };
struct RowUp { __device__ __forceinline__ int operator()(int n) const { const int u = n >= DFF, ch = u ? n - DFF : n; return (ch >> 7) * 256 + u * 128 + (ch & 127); } };

__global__ void __launch_bounds__(NWAVES * 64, 2) mega_fwd(Args args) {
    extern __shared__ __attribute__((aligned(16))) unsigned char lds_raw[];
    LAS unsigned char* lds = (LAS unsigned char*)lds_raw;
    volatile LAS unsigned* MISC = (volatile LAS unsigned*)(lds + MISC_OFF);
    const int G = gridDim.x; const int bx = blockIdx.x; const int vcu = (G % 8 == 0) ? (bx % 8) * (G / 8) + bx / 8 : bx;
    gu32* ctl = (gu32*)(args.ws + WS_CTL);
    const int wave_s = __builtin_amdgcn_readfirstlane((int)threadIdx.x >> 6);
    if (wave_s == 0) MISC[HW_LANE()] = 0u;
    __syncthreads();
    XcdBarrier bar = xcd_barrier_post((unsigned*)ctl + CW_BAR, MISC + 8, wave_s == 0 && HW_LANE() == 0);
#define GRID_BAR() xcd_barrier(bar, wave_s)
    LAS unsigned long long* AP = (LAS unsigned long long*)(lds + MISC_OFF + 256);
    if (wave_s == 0 && HW_LANE() < 27) AP[HW_LANE()] = ((const unsigned long long*)&args)[HW_LANE()];
    __syncthreads();
#define ARGP(T, i) ((T)(GAS void*)ldarg(AP, i))
#define x_in   ARGP(const float*, 0)
#define pos    ARGP(const int*, 1)
#define nmg    ARGP(const float*, 2)
#define nfg    ARGP(const float*, 3)
#define s_inw  ARGP(const float*, 4)
#define s_cw   ARGP(const float*, 5)
#define s_cb   ARGP(const float*, 6)
#define s_dtb  ARGP(const float*, 7)
#define s_alog ARGP(const float*, 8)
#define s_d    ARGP(const float*, 9)
#define s_ng   ARGP(const float*, 10)
#define s_ow   ARGP(const float*, 11)
#define a_inw  ARGP(const float*, 12)
#define a_qg   ARGP(const float*, 13)
#define a_kg   ARGP(const float*, 14)
#define a_lq1  ARGP(const float*, 15)
#define a_lk1  ARGP(const float*, 16)
#define a_lq2  ARGP(const float*, 17)
#define a_lk2  ARGP(const float*, 18)
#define a_sg   ARGP(const float*, 19)
#define a_ow   ARGP(const float*, 20)
#define f_uw   ARGP(const float*, 21)
#define f_cw   ARGP(const float*, 22)
#define f_cb   ARGP(const float*, 23)
#define f_dw   ARGP(const float*, 24)
#define xout   ARGP(float*, 25)
#define ws     ARGP(unsigned char*, 26)
#define cst    ((float*)(ws + WS_CONST))
#define SSQ    ((float*)(ws + WS_SSQ))
#define ROPE   ((float*)(ws + WS_ROPE))
#define DT     ((float*)(ws + WS_DT))
#define SSQP   ((float*)(ws + WS_SSQP))
#define Wb     ((bf16*)(ws + WS_W))
#define XB     ((bf16*)(ws + WS_XB + XB_PAD_FRONT))
#define BIG    ((bf16*)(ws + WS_BIG))
#define XLO    ((bf16*)(ws + WS_DBG))
#define CPT    ((float*)(ws + WS_CP))
#define ZPL    ((bf16*)(ws + WS_BIG))
#define XBCPL  ((bf16*)(ws + WS_BIG + (size_t)M * SSD_DI * 2))
#define CONV_MATRIX(kind_, idx_, worker_, nworkers_) do { \
        int tid_ = wave_s * 64 + HW_LANE(); asm volatile("" : "+v"(tid_)); const int lane_ = tid_ & 63, wave_ = wave_s; \
        LAS float* scr_ = (LAS float*)(lds + wave_ * 16384); const int j_ = (idx_); \
        constexpr int I_SI = (D / 64) * (SSD_IN / 32), I_SO = (SSD_DI / 64) * (D / 32), I_AI = (D / 64) * (AT_IN / 32), I_AO = (D / 64) * (D / 32), I_UP = (D / 64) * (2 * DFF / 32), I_DN = (DFF / 64) * (D / 32); \
        if ((kind_) == 0) { for (int it = (worker_); it < I_SI; it += 2 * (nworkers_)) transpose_item(s_inw + (size_t)j_ * D * SSD_IN, D, SSD_IN, nmg + (2 * j_) * D, 1023, 1.0f, (bf16*)((char*)Wb + W_SSD_IN + j_ * W_SSD_IN_SZ), RowId(), scr_, it, (it + (nworkers_) < I_SI) ? it + (nworkers_) : -1, lane_); \
            v4u* p_ = (v4u*)((char*)Wb + W_SSD_IN + j_ * W_SSD_IN_SZ + (size_t)SSD_IN * D * 2); const int n16_ = (SSD_NP - SSD_IN) * D * 2 / 16; \
            unsigned z_ = 0u; asm volatile("" : "+v"(z_)); for (int i = (worker_) * 64 + lane_; i < n16_; i += (nworkers_) * 64) p_[i] = (v4u){z_, z_, z_, z_}; } \
        else if ((kind_) == 1) { for (int it = (worker_); it < I_SO; it += 2 * (nworkers_)) transpose_item(s_ow + (size_t)j_ * SSD_DI * D, SSD_DI, D, s_ng + j_ * SSD_DI, 2047, 1.0f, (bf16*)((char*)Wb + W_SSD_OUT + j_ * W_SSD_OUT_SZ), RowId(), scr_, it, (it + (nworkers_) < I_SO) ? it + (nworkers_) : -1, lane_); } \
        else if ((kind_) == 2) { for (int it = (worker_); it < I_AI; it += 2 * (nworkers_)) transpose_item(a_inw + (size_t)j_ * D * AT_IN, D, AT_IN, nmg + (2 * j_ + 1) * D, 1023, 1.0f, (bf16*)((char*)Wb + W_AT_IN + j_ * W_AT_IN_SZ), RowId(), scr_, it, (it + (nworkers_) < I_AI) ? it + (nworkers_) : -1, lane_); } \
        else if ((kind_) == 3) { const float li_ = 0.8f - 0.6f * expf(-0.3f * (float)(2 * j_ + 1)); \
            for (int it = (worker_); it < I_AO; it += 2 * (nworkers_)) transpose_item(a_ow + (size_t)j_ * D * D, D, D, a_sg + j_ * 128, 127, 1.0f - li_, (bf16*)((char*)Wb + W_AT_OUT + j_ * W_AT_OUT_SZ), RowId(), scr_, it, (it + (nworkers_) < I_AO) ? it + (nworkers_) : -1, lane_); } \
        else if ((kind_) == 4) { for (int it = (worker_); it < I_UP; it += 2 * (nworkers_)) transpose_item(f_uw + (size_t)j_ * D * 2 * DFF, D, 2 * DFF, nfg + j_ * D, 1023, 1.0f, (bf16*)((char*)Wb + W_UP + j_ * W_UP_SZ), RowUp(), scr_, it, (it + (nworkers_) < I_UP) ? it + (nworkers_) : -1, lane_); } \
        else { for (int it = (worker_); it < I_DN; it += 2 * (nworkers_)) transpose_item(f_dw + (size_t)j_ * DFF * D, DFF, D, nullptr, 0, 1.0f, (bf16*)((char*)Wb + W_DOWN + j_ * W_DOWN_SZ), RowId(), scr_, it, (it + (nworkers_) < I_DN) ? it + (nworkers_) : -1, lane_); } \
    } while (0)
#define RUN_FILL(fid_, nwg_, part_) do { const int idle0_ = (nwg_) % G; if (bx >= idle0_ && idle0_ > 0) { \
        const int wk_ = (bx - idle0_) * NWAVES + wave_s, nwk_ = (G - idle0_) * NWAVES; \
          \
        unsigned long long code_ = (part_) == 0 ? ((fid_) == 0 ? 0xff1040ull : (fid_) == 1 ? 0xff51ull : (fid_) == 2 ? 0xff11ull : (fid_) == 3 ? 0xff42ull : 0xff53ull) \
                                                : ((fid_) == 0 ? 0xff302050ull : (fid_) == 1 ? 0xff41ull : (fid_) == 2 ? 0xff01ull : (fid_) == 3 ? 0xff312152ull : 0xff43ull); \
        for (;;) { const int e_ = (int)(code_ & 0xffu); if (e_ == 0xff) break; code_ >>= 8; CONV_MATRIX(e_ >> 4, e_ & 15, wk_, nwk_); } } } while (0)
    const int lo = args.ph_lo, hi = args.ph_hi;
    int phase = 0;
#define IN_PHASE() (phase >= lo && phase < hi)
#define END_PHASE(ty) do { if (IN_PHASE() && phase + 1 < hi) GRID_BAR(); ++phase; } while (0)
#ifndef PROBE_EPI_MODE
#define PROBE_EPI_MODE 0
#endif
#ifdef PROBE_DUP
#define REP_BEGIN(ty) _Pragma("unroll") for (int rep_ = ((ty) == PROBE_DUP ? 0 : 1); rep_ < 2; ++rep_) { const int dry = (rep_ == 0);
#define REP_END() if (dry) GRID_BAR(); }
#else
#define REP_BEGIN(ty) { const int dry = 0;
#define REP_END() }
#endif

    if (IN_PHASE()) { REP_BEGIN(0)
        int tid = wave_s * 64 + HW_LANE(); asm volatile("" : "+v"(tid));
        const int lane = tid & 63, wave = wave_s;
        LAS float* scr = (LAS float*)(lds + wave * 16384);
        const int gw = vcu * NWAVES + wave, NGW = G * NWAVES;
        CONV_MATRIX(0, 0, gw, NGW);
        { unsigned z_ = 0u; asm volatile("" : "+v"(z_));
          v4u* p = (v4u*)(ws + WS_XB); for (int i = vcu * 512 + tid; i < (int)(XB_PAD_FRONT / 16); i += G * 512) p[i] = (v4u){z_, z_, z_, z_};
          v4u* q = (v4u*)((char*)XB + (size_t)M * D * 2); for (int i = vcu * 512 + tid; i < 256 * D * 2 / 16; i += G * 512) q[i] = (v4u){z_, z_, z_, z_}; }
        for (int m = gw; m < M; m += NGW) {
            const f32x4* xr = (const f32x4*)(x_in + (size_t)m * D) + lane; float s = 0.f;
            unsigned long long* o8 = (unsigned long long*)(XB + (size_t)m * D) + lane;
#pragma unroll
            for (int j = 0; j < 4; ++j) { const f32x4 v = xr[64 * j]; s += (v[0] * v[0] + v[1] * v[1]) + (v[2] * v[2] + v[3] * v[3]); o8[64 * j] = (unsigned long long)pk2(v[0], v[1]) | ((unsigned long long)pk2(v[2], v[3]) << 32); }
            s = wave_sum(s);
            if (lane < 4) SSQ[(size_t)m * 4 + lane] = (lane == 0) ? s : 0.f;
            if (lane >= 16 && lane < 32) { const int i = lane & 7; const float invf = powf(500000.0f, -(float)(2 * i) / 16.0f); const float ang = (float)pos[m] * invf; ROPE[(size_t)m * 16 + (lane - 16)] = (lane < 24) ? cosf(ang) : sinf(ang); }
        }
        for (int i = vcu * 512 + tid; i < 2 * SSD_NP; i += G * 512) {
            const int j = i / SSD_NP, c = i % SSD_NP; float pb = 0.f, p0 = 0.f, p1 = 0.f, p2 = 0.f, p3 = 0.f;
            if (c < 2048) p3 = 1.f;
            else if (c < 5120) { const int ch = c - 2048; const float* w = s_cw + (size_t)j * 4 * 3072; pb = s_cb[(size_t)j * 3072 + ch]; p0 = w[ch]; p1 = w[3072 + ch]; p2 = w[2 * 3072 + ch]; p3 = w[3 * 3072 + ch]; }
            else if (c < 5152) { pb = s_dtb[j * 32 + (c - 5120)]; p3 = 1.f; }
            float* t = CPT + (size_t)j * 5 * SSD_NP; t[c] = pb; t[SSD_NP + c] = p0; t[2 * SSD_NP + c] = p1; t[3 * SSD_NP + c] = p2; t[4 * SSD_NP + c] = p3;
        }
        if (bx == 0 && wave == 0) {
            for (int j = 0; j < 2; ++j) {
                float mq = fabsf(a_qg[j * 64 + lane]), mkk = fabsf(a_kg[j * 64 + lane]);
                float d1 = a_lq1[j * 64 + lane] * a_lk1[j * 64 + lane], d2 = a_lq2[j * 64 + lane] * a_lk2[j * 64 + lane];
                mq = xl_max64(mq); mkk = xl_max64(mkk); d1 = xl_sum64(d1); d2 = xl_sum64(d2);
                const float li = 0.8f - 0.6f * expf(-0.3f * (float)(2 * j + 1));
                if (lane == 0) { cst[j] = mq * mkk * 64.0f * 0.125f * 1.4426950408889634f * 1.002f + 0.01f; cst[2 + j] = expf(d1) - expf(d2) + li; }
            }
        }
    REP_END() }
    END_PHASE(0);

    for (int layer = 0; layer < 4; ++layer) {
        const int j = layer >> 1;
        if ((layer & 1) == 0) {
            if (IN_PHASE()) { REP_BEGIN(1)
#ifdef PROBE_PLAIN_SSDIN
                if (dry) {
                    pg8::Gemm g0{XB, (const bf16*)((const char*)Wb + W_SSD_IN + j * W_SSD_IN_SZ), D, D, 256, 0};
                    pg8::StaticOrder S0; S0.init(64, 20, G, bx);
                    epi::EpiSsdIn E0{BIG, DT, s_dtb + j * 32, SSQ};
                    pg8::gemm_phase(lds, lds + EPI_OFF, g0, S0, E0, wave_s);
                } else
#endif
                {
                pg8::Gemm g{XB, (const bf16*)((const char*)Wb + W_SSD_IN + j * W_SSD_IN_SZ), D, D, 253, -3};
                pg8::StaticOrder S; S.init(65, SSD_NP / 256, G, bx);
                epi::EpiSsdConv E{ZPL, XBCPL, DT, SSQ, CPT + (size_t)j * 5 * SSD_NP};
                RUN_FILL(layer == 0 ? 0 : 3, 65 * (SSD_NP / 256), 0); __syncthreads();
                pg8::gemm_phase(lds, lds + EPI_OFF, g, S, E, wave_s);
                RUN_FILL(layer == 0 ? 0 : 3, 65 * (SSD_NP / 256), 1);
                }
            REP_END() }
            END_PHASE(1);
            if (IN_PHASE()) { REP_BEGIN(2)
                scan::Params sp{XBCPL, ZPL, DT, s_alog + j * 32, s_d + j * 32, SSQP, dry};
                for (int u = vcu; u < NB * 32; u += G) scan::unit(sp, u >> 5, u & 31, (LAS char*)lds, wave_s);
            REP_END() }
            END_PHASE(2);
            if (IN_PHASE()) { REP_BEGIN(4)
                pg8::Gemm g{ZPL, (const bf16*)((const char*)Wb + W_SSD_OUT + j * W_SSD_OUT_SZ), SSD_DI, SSD_DI, 256, 0};
                pg8::StaticOrder S; S.init(M / 256, D / 256, G, bx);
                if (layer == 0) { epi::EpiResidualG<1> E{x_in, XB, XLO, SSQ, SSQP, dry}; pg8::gemm_phase(lds, lds + EPI_OFF, g, S, E, wave_s); }
                else { epi::EpiResidualG<0> E{nullptr, XB, XLO, SSQ, SSQP, dry}; pg8::gemm_phase(lds, lds + EPI_OFF, g, S, E, wave_s); }
            REP_END() }
            END_PHASE(4);
        } else {
            if (IN_PHASE()) { REP_BEGIN(5)
                pg8::Gemm g{XB, (const bf16*)((const char*)Wb + W_AT_IN + j * W_AT_IN_SZ), D, D, 256, 0};
                pg8::StaticOrder S; S.init(M / 256, AT_IN / 256, G, bx);
                epi::EpiQKV E{BIG, SSQ, a_qg + j * 64, a_kg + j * 64, ROPE};
                pg8::gemm_phase(lds, lds + EPI_OFF, g, S, E, wave_s);
            REP_END() }
            END_PHASE(5);
            if (IN_PHASE()) { REP_BEGIN(6)
                attn::Params ap{BIG, cst[j], cst[2 + j], dry};
                for (int pi = vcu; pi < 512; pi += G) {
                    const int bh = pi >> 3, s = pi & 7;
                    attn::unit(ap, bh >> 3, bh & 7, s, (LAS char*)lds, wave_s);
                    attn::unit(ap, bh >> 3, bh & 7, 15 - s, (LAS char*)lds, wave_s);
                }
            REP_END() }
            END_PHASE(6);
            if (IN_PHASE()) { REP_BEGIN(7)
                pg8::Gemm g{BIG, (const bf16*)((const char*)Wb + W_AT_OUT + j * W_AT_OUT_SZ), AT_IN, D, 256, 0};
                pg8::StaticOrder S; S.init(M / 256, D / 256, G, bx);
                epi::EpiResidual<0> E{nullptr, nullptr, XB, XLO, SSQ, dry};
                pg8::gemm_phase(lds, lds + EPI_OFF, g, S, E, wave_s);
            REP_END() }
            END_PHASE(7);
        }
        if (IN_PHASE()) { REP_BEGIN(8)
            pg8::Gemm g{XB, (const bf16*)((const char*)Wb + W_UP + layer * W_UP_SZ), D, D, 254, -2};
            pg8::StaticOrder S; S.init(65, 2 * DFF / 256, G, bx);
            epi::EpiConvGate E{BIG, SSQ, f_cw + (size_t)layer * 3 * 2 * DFF, f_cb + (size_t)layer * 2 * DFF, dry * PROBE_EPI_MODE};
            if (layer < 3) { RUN_FILL(layer == 0 ? 1 : (layer == 1 ? 2 : 4), 65 * (2 * DFF / 256), 0); __syncthreads(); }
            pg8::gemm_phase(lds, lds + EPI_OFF, g, S, E, wave_s);
            if (layer < 3) RUN_FILL(layer == 0 ? 1 : (layer == 1 ? 2 : 4), 65 * (2 * DFF / 256), 1);
        REP_END() }
        END_PHASE(8);
        if (IN_PHASE()) { REP_BEGIN(9)
            pg8::Gemm g{BIG, (const bf16*)((const char*)Wb + W_DOWN + layer * W_DOWN_SZ), DFF, DFF, 256, 0};
            pg8::StaticOrder S; S.init(M / 256, D / 256, G, bx);
            if (layer == 3) { epi::EpiResidual<2> E{nullptr, xout, XB, XLO, SSQ, dry}; pg8::gemm_phase(lds, lds + EPI_OFF, g, S, E, wave_s); }
            else { epi::EpiResidual<0> E{nullptr, nullptr, XB, XLO, SSQ, dry}; pg8::gemm_phase(lds, lds + EPI_OFF, g, S, E, wave_s); }
        REP_END() }
        END_PHASE(9);
    }
#ifdef PROBE_EXTRA_BARS
    for (int i_ = 0; i_ < PROBE_EXTRA_BARS; ++i_) GRID_BAR();
#endif
}
#undef CONV_MATRIX
#undef RUN_FILL
#undef x_in
#undef pos
#undef nmg
#undef nfg
#undef s_inw
#undef s_cw
#undef s_cb
#undef s_dtb
#undef s_alog
#undef s_d
#undef s_ng
#undef s_ow
#undef a_inw
#undef a_qg
#undef a_kg
#undef a_lq1
#undef a_lk1
#undef a_lq2
#undef a_lk2
#undef a_sg
#undef a_ow
#undef f_uw
#undef f_cw
#undef f_cb
#undef f_dw
#undef xout
#undef ws
#undef cst
#undef SSQ
#undef ROPE
#undef DT
#undef SSQP
#undef Wb
#undef XB
#undef BIG
#undef XLO
#undef CPT
#undef ZPL
#undef XBCPL
#undef ARGP
constexpr int N_PHASES = 1 + 2 * 5 + 2 * 5;

static int g_grid = 0;
static void launch(void* const* d_in, float* d_out, void* d_ws, int ph_lo, int ph_hi, hipStream_t stream) {
    if (g_grid == 0) {
        int dev = 0, cus = 0;
        if (hipGetDevice(&dev) != hipSuccess || hipDeviceGetAttribute(&cus, hipDeviceAttributeMultiprocessorCount, dev) != hipSuccess) { fprintf(stderr, "device query failed\n"); g_grid = -1; return; }
        if (hipFuncSetAttribute((const void*)mega_fwd, hipFuncAttributeMaxDynamicSharedMemorySize, LDS_BYTES) != hipSuccess) { fprintf(stderr, "hipFuncSetAttribute failed\n"); g_grid = -1; return; }
        int per_cu = 0;
        (void)hipOccupancyMaxActiveBlocksPerMultiprocessor(&per_cu, (const void*)mega_fwd, NWAVES * 64, LDS_BYTES);
        (void)hipGetLastError();
        g_grid = cus;
        fprintf(stderr, "mega_fwd: %d CUs, occupancy query %d per CU\n", cus, per_cu);
    }
    if (g_grid < 0) return;
    (void)hipMemsetAsync((char*)d_ws + WS_CTL, 0, CTL_ZERO_BYTES, stream);
    Args a{};
    for (int i = 0; i < 25; ++i) a.in[i] = d_in[i];
    a.out = d_out; a.ws = (unsigned char*)d_ws; a.ph_lo = ph_lo; a.ph_hi = ph_hi;
    void* params[] = {&a};
    hipError_t e = hipLaunchCooperativeKernel((const void*)mega_fwd, dim3(g_grid), dim3(NWAVES * 64), params, LDS_BYTES, stream);
    if (e != hipSuccess) fprintf(stderr, "cooperative launch failed: %s (grid %d)\n", hipGetErrorString(e), g_grid);
}
}
extern "C" void kernel_launch(void* const* d_in, const int* in_sizes, int n_in, void* d_out, int out_size, void* d_ws, size_t ws_size, hipStream_t stream) {
    (void)in_sizes; (void)n_in; (void)out_size; (void)ws_size;
    mk::launch(d_in, (float*)d_out, d_ws, 0, mk::N_PHASES, stream);
}
```

```cpp
#include <hip/hip_runtime.h>
#include <stdint.h>
#include <math.h>
#include <cstdio>
__device__ __forceinline__ int hw_lane_() { unsigned m = ~0u; asm volatile("" : "+s"(m)); return (int)__builtin_amdgcn_mbcnt_hi(m, __builtin_amdgcn_mbcnt_lo(m, 0u)); }
#define HW_LANE() hw_lane_()
template <int CTRL> __device__ __forceinline__ float xl_dpp(float v) { return __builtin_bit_cast(float, __builtin_amdgcn_mov_dpp(__builtin_bit_cast(int, v), CTRL, 0xF, 0xF, true)); }
__device__ __forceinline__ float xl_swap16_sum(float v) { const auto r = __builtin_amdgcn_permlane16_swap(__builtin_bit_cast(unsigned, v), __builtin_bit_cast(unsigned, v), false, false); const unsigned r0 = r[0], r1 = r[1]; return __builtin_bit_cast(float, r0) + __builtin_bit_cast(float, r1); }
__device__ __forceinline__ float xl_swap32_sum(float v) { const auto r = __builtin_amdgcn_permlane32_swap(__builtin_bit_cast(unsigned, v), __builtin_bit_cast(unsigned, v), false, false); const unsigned r0 = r[0], r1 = r[1]; return __builtin_bit_cast(float, r0) + __builtin_bit_cast(float, r1); }
__device__ __forceinline__ float xl_swap16_max(float v) { const auto r = __builtin_amdgcn_permlane16_swap(__builtin_bit_cast(unsigned, v), __builtin_bit_cast(unsigned, v), false, false); const unsigned r0 = r[0], r1 = r[1]; return fmaxf(__builtin_bit_cast(float, r0), __builtin_bit_cast(float, r1)); }
__device__ __forceinline__ float xl_swap32_max(float v) { const auto r = __builtin_amdgcn_permlane32_swap(__builtin_bit_cast(unsigned, v), __builtin_bit_cast(unsigned, v), false, false); const unsigned r0 = r[0], r1 = r[1]; return fmaxf(__builtin_bit_cast(float, r0), __builtin_bit_cast(float, r1)); }
__device__ __forceinline__ float xl_xor16(float v, bool odd16) { const auto r = __builtin_amdgcn_permlane16_swap(__builtin_bit_cast(unsigned, v), __builtin_bit_cast(unsigned, v), false, false); const unsigned r0 = r[0], r1 = r[1]; return __builtin_bit_cast(float, odd16 ? r0 : r1); }
__device__ __forceinline__ float xl_sum4(float v) { v += xl_dpp<0xB1>(v); v += xl_dpp<0x4E>(v); return v; }
__device__ __forceinline__ float xl_sum8(float v) { v = xl_sum4(v); v += xl_dpp<0x141>(v); return v; }
__device__ __forceinline__ float xl_sum16(float v) { v = xl_sum8(v); v += xl_dpp<0x140>(v); return v; }
__device__ __forceinline__ float xl_sum64(float v) { v = xl_sum16(v); v = xl_swap16_sum(v); return xl_swap32_sum(v); }
__device__ __forceinline__ float xl_max64(float v) { v = fmaxf(v, xl_dpp<0xB1>(v)); v = fmaxf(v, xl_dpp<0x4E>(v)); v = fmaxf(v, xl_dpp<0x141>(v)); v = fmaxf(v, xl_dpp<0x140>(v)); v = xl_swap16_max(v); return xl_swap32_max(v); }
__device__ __forceinline__ float xl_scan64(float v) {
    v += xl_dpp<0x111>(v); v += xl_dpp<0x112>(v); v += xl_dpp<0x114>(v); v += xl_dpp<0x118>(v);
    v += __builtin_bit_cast(float, __builtin_amdgcn_update_dpp(0, __builtin_bit_cast(int, v), 0x142, 0xA, 0xF, false));
    v += __builtin_bit_cast(float, __builtin_amdgcn_update_dpp(0, __builtin_bit_cast(int, v), 0x143, 0xC, 0xF, false));
    return v;
}
#ifndef RES_F16
#define RES_F16 1
#endif
#ifndef PG8_SP2
#define PG8_SP2 1
#endif
namespace pg8 {
#define PG8_LAS __attribute__((address_space(3)))
typedef unsigned short bf16_t;
typedef short bf16x8 __attribute__((ext_vector_type(8)));
typedef float f32x4 __attribute__((ext_vector_type(4)));
typedef unsigned u32x4 __attribute__((ext_vector_type(4)));
typedef unsigned u32x2 __attribute__((ext_vector_type(2)));
constexpr int BM = 256, BK = 64, HALF = 128, HTB = HALF * BK * 2  , STAGE_BYTES = 8 * HTB, NXCD = 8, WGM = 8;

__host__ __device__ __forceinline__ int lds_byte(int r, int c) { const int st = (r >> 4) * 2 + (c >> 5), rr = r & 15, cc = c & 31, ob = rr * 64 + cc * 2; return st * 1024 + (ob ^ (((ob >> 9) & 1) << 5)); }
__host__ __device__ __forceinline__ void stage_rc(int b, int& R, int& C) { const int st = b / 1024, sb = b % 1024, swz = sb ^ (((sb >> 9) & 1) << 5); R = (st >> 1) * 16 + swz / 64; C = (st & 1) * 32 + (swz % 64) / 2; }
__host__ __device__ __forceinline__ int perm32(int rho) { const int n = rho >> 4, i = rho & 15; return 8 * (i >> 2) + 4 * n + (i & 3); }

typedef _Float16 f16x8 __attribute__((ext_vector_type(8)));
template <bool F16> __device__ __forceinline__ f32x4 mma16(bf16x8 a, bf16x8 b, f32x4 c) {
    if constexpr (F16) return __builtin_amdgcn_mfma_f32_16x16x32_f16(__builtin_bit_cast(f16x8, a), __builtin_bit_cast(f16x8, b), c, 0, 0, 0);
    else return __builtin_amdgcn_mfma_f32_16x16x32_bf16(a, b, c, 0, 0, 0);
}
struct Unit { int pm, pn; };
struct Gemm { const bf16_t* A; const bf16_t* Bt; int lda, K, a_stride, a_off; };

struct StaticOrder {
    int nM, nN, nwg, G, c;
    __host__ __device__ void init(int nM_, int nN_, int G_, int c_) { nM = nM_; nN = nN_; nwg = nM * nN; G = G_; c = c_; }
    __host__ __device__ bool next(int i, Unit& u) const {
        const long L = (long)i * G + c; if (L >= nwg) return false;
        int wgid = (int)L; { const int q = nwg / NXCD, r = nwg % NXCD, xcd = wgid % NXCD, off = wgid / NXCD; wgid = (xcd < r ? xcd * (q + 1) : r * (q + 1) + (xcd - r) * q) + off; }
        const int nig = WGM * nN, gid = wgid / nig, fm = gid * WGM, gsz = (nM - fm) < WGM ? (nM - fm) : WGM;
        u.pm = fm + ((wgid % nig) % gsz); u.pn = (wgid % nig) / gsz; return true;
    }
};

__device__ __forceinline__ unsigned cvt_pk_bf16(float lo, float hi) { unsigned r; asm volatile("v_cvt_pk_bf16_f32 %0, %1, %2" : "=v"(r) : "v"(lo), "v"(hi)); return r; }

template <class Epi, class Sched>
__device__ __forceinline__ void gemm_phase(PG8_LAS unsigned char* lds, PG8_LAS unsigned char* elds, const Gemm g, const Sched& S, const Epi& E, const int wave_s) {
    int tid = wave_s * 64 + HW_LANE(); asm volatile("" : "+v"(tid));
    const int wid = __builtin_amdgcn_readfirstlane(tid >> 6), lane = tid & 63, wr = wid >> 2, wc = wid & 3, fr = lane & 15, fq = lane >> 4;
    const int K = g.K, nt = K / BK, lda = g.lda;
    unsigned voffA[2], voffB[2]; int aoff, boff;
#define PG8_LANECONST() do { int t_ = wave_s * 64 + HW_LANE(); asm volatile("" : "+v"(t_)); const int fr_ = t_ & 15, fq_ = (t_ >> 4) & 3; \
        _Pragma("unroll") for (int i = 0; i < 2; ++i) { int R, C; stage_rc(t_ * 16 + i * 8192, R, C); const int Rb = Epi::PERM ? ((R & ~31) + perm32(R & 31)) : R; \
            const int Ra = Epi::ROWIL ? ((R & ~63) | ((R & 15) << 2) | ((R >> 4) & 3)) : R;     \
            voffA[i] = (unsigned)(Ra * lda + C) * 2u; voffB[i] = (unsigned)(Rb * K + C) * 2u; } \
        aoff = lds_byte(wr * 64 + fr_, fq_ * 8); boff = lds_byte(wc * 32 + fr_, fq_ * 8); } while (0)
    PG8_LANECONST();
    const size_t kstep = (size_t)(BK * 2);
    const size_t hstepA = (size_t)HALF * lda * 2, hstepB = (size_t)HALF * K * 2;
    const size_t tstepB = 2 * hstepB;
    const unsigned ldsw = (unsigned)wid * 1024u;
#define PG8_SA(b, h) (((b) * 2 + (h)) * HTB)
#define PG8_SB(b, h) ((4 + (b) * 2 + (h)) * HTB)
#define PG8_STAGE(bufoff, gbase, voff) do { _Pragma("unroll") for (int _i = 0; _i < 2; ++_i) \
        __builtin_amdgcn_global_load_lds((const unsigned*)((const char*)(gbase) + (voff)[_i]), (PG8_LAS unsigned*)(lds + (bufoff) + ldsw + _i * 8192), 16, 0, 0); } while (0)
#define PG8_LDA(dst, b, h) do { _Pragma("unroll") for (int m = 0; m < 4; ++m) _Pragma("unroll") for (int k = 0; k < 2; ++k) dst[m][k] = *(const PG8_LAS bf16x8*)(lds + PG8_SA(b, h) + aoff + m * 2048 + k * 1024); } while (0)
#define PG8_LDB(dst, b, h) do { _Pragma("unroll") for (int n = 0; n < 2; ++n) _Pragma("unroll") for (int k = 0; k < 2; ++k) dst[n][k] = *(const PG8_LAS bf16x8*)(lds + PG8_SB(b, h) + boff + n * 2048 + k * 1024); } while (0)
#define PG8_MMA(ai, bj, At, Bt) do { __builtin_amdgcn_s_setprio(1); _Pragma("unroll") for (int m = 0; m < 4; ++m) _Pragma("unroll") for (int n = 0; n < 2; ++n) _Pragma("unroll") for (int k = 0; k < 2; ++k) \
        acc[ai][bj][m][n] = mma16<Epi::AF16>(Bt[n][k], At[m][k], acc[ai][bj][m][n]); __builtin_amdgcn_s_setprio(0); } while (0)
#define PG8_WAIT_V(n) asm volatile("s_waitcnt vmcnt(" #n ")" ::: "memory")
#define PG8_WAIT_L(n) asm volatile("s_waitcnt lgkmcnt(" #n ")" ::: "memory")
#define PG8_BAR __builtin_amdgcn_s_barrier()
#define PG8_SCHED __builtin_amdgcn_sched_barrier(0)
    Unit cur, nxt; int ui = 0;
    if (!S.next(0, cur)) return;
    if constexpr (Epi::KGROUP) E.unit_begin(cur, elds, wave_s);
    if constexpr (Epi::PREFETCH) E.prefetch(cur, elds, wave_s);
    float zf = 0.f; if constexpr (!Epi::KGROUP) asm volatile("" : "+v"(zf));
    f32x4 acc[2][2][4][2];
#pragma unroll
    for (int a = 0; a < 2; ++a)
#pragma unroll
        for (int b = 0; b < 2; ++b)
#pragma unroll
            for (int m = 0; m < 4; ++m)
#pragma unroll
                for (int n = 0; n < 2; ++n) acc[a][b][m][n] = (f32x4){zf, zf, zf, zf};
    bf16x8 At[4][2], B0[2][2], B1[2][2];
    const char* cA = (const char*)g.A + ((long)cur.pm * g.a_stride + g.a_off) * (long)lda * 2; const char* cB = (const char*)g.Bt + (size_t)cur.pn * tstepB;
#if PG8_SP2
    PG8_STAGE(PG8_SB(0, 0), cB, voffB); PG8_STAGE(PG8_SB(0, 1), cB + hstepB, voffB); PG8_STAGE(PG8_SA(0, 0), cA, voffA); PG8_STAGE(PG8_SA(0, 1), cA + hstepA, voffA);
    if (wr == 1) PG8_BAR;
    PG8_WAIT_V(2); PG8_BAR;
    PG8_STAGE(PG8_SB(1, 0), cB + kstep, voffB); PG8_STAGE(PG8_SA(1, 0), cA + kstep, voffA); PG8_STAGE(PG8_SB(1, 1), cB + hstepB + kstep, voffB);
    PG8_WAIT_V(6); PG8_BAR;
#else
    PG8_STAGE(PG8_SB(0, 0), cB, voffB); PG8_STAGE(PG8_SA(0, 0), cA, voffA); PG8_STAGE(PG8_SB(0, 1), cB + hstepB, voffB); PG8_STAGE(PG8_SA(0, 1), cA + hstepA, voffA);
    if (wr == 1) PG8_BAR;
    PG8_WAIT_V(4); PG8_BAR;
    PG8_STAGE(PG8_SB(1, 0), cB + kstep, voffB); PG8_STAGE(PG8_SA(1, 0), cA + kstep, voffA); PG8_STAGE(PG8_SB(1, 1), cB + hstepB + kstep, voffB);
    PG8_WAIT_V(6); PG8_BAR;
#endif
    for (;;) {
        const bool has_next = S.next(ui + 1, nxt);
        const char* nA = has_next ? (const char*)g.A + ((long)nxt.pm * g.a_stride + g.a_off) * (long)lda * 2 : cA; const char* nB = has_next ? (const char*)g.Bt + (size_t)nxt.pn * tstepB : cB;
        for (int t = 0; t < nt; t += 2) {
            const bool last = (t == nt - 2);
            const char* a1 = cA + (size_t)(t + 1) * kstep;
            const char* a2 = last ? nA : cA + (size_t)(t + 2) * kstep; const char* b2 = last ? nB : cB + (size_t)(t + 2) * kstep;
            const char* a3 = a2 + kstep; const char* b3 = b2 + kstep;
            if constexpr (Epi::KGROUP) { if (t > 0 && (t & 7) == 0) E.kgroup(acc, t >> 3, wr, elds); }
#if PG8_SP2
            PG8_LDB(B0, 0, 0); PG8_LDB(B1, 0, 1); PG8_SCHED; PG8_LDA(At, 0, 0); PG8_STAGE(PG8_SA(1, 1), a1 + hstepA, voffA);
            PG8_WAIT_V(8); PG8_WAIT_L(0); PG8_BAR; PG8_MMA(0, 0, At, B0); PG8_MMA(0, 1, At, B1); PG8_BAR; PG8_SCHED;
            PG8_LDA(At, 0, 1); PG8_STAGE(PG8_SB(0, 0), b2, voffB); PG8_STAGE(PG8_SB(0, 1), b2 + hstepB, voffB); PG8_STAGE(PG8_SA(0, 0), a2, voffA);
            PG8_WAIT_V(8); PG8_WAIT_L(0); PG8_BAR; PG8_MMA(1, 0, At, B0); PG8_MMA(1, 1, At, B1); PG8_BAR; PG8_SCHED;
            PG8_LDB(B0, 1, 0); PG8_LDB(B1, 1, 1); PG8_SCHED; PG8_LDA(At, 1, 0); PG8_STAGE(PG8_SA(0, 1), a2 + hstepA, voffA);
            PG8_WAIT_V(8); PG8_WAIT_L(0); PG8_BAR; PG8_MMA(0, 0, At, B0); PG8_MMA(0, 1, At, B1); PG8_BAR; PG8_SCHED;
            PG8_LDA(At, 1, 1); PG8_STAGE(PG8_SB(1, 0), b3, voffB); PG8_STAGE(PG8_SB(1, 1), b3 + hstepB, voffB); PG8_STAGE(PG8_SA(1, 0), a3, voffA);
            PG8_WAIT_V(8); PG8_WAIT_L(0); PG8_BAR; PG8_MMA(1, 0, At, B0); PG8_MMA(1, 1, At, B1); PG8_BAR; PG8_SCHED;
#else
            PG8_LDB(B0, 0, 0); PG8_SCHED; PG8_LDA(At, 0, 0); PG8_STAGE(PG8_SA(1, 1), a1 + hstepA, voffA);
            PG8_WAIT_L(8); PG8_BAR; PG8_WAIT_L(0); PG8_MMA(0, 0, At, B0); PG8_BAR; PG8_SCHED;
            PG8_LDB(B1, 0, 1); PG8_STAGE(PG8_SB(0, 0), b2, voffB);
            PG8_BAR; PG8_WAIT_L(0); PG8_MMA(0, 1, At, B1); PG8_BAR;
            PG8_LDA(At, 0, 1); PG8_STAGE(PG8_SA(0, 0), a2, voffA);
            PG8_BAR; PG8_WAIT_L(0); PG8_MMA(1, 0, At, B0); PG8_BAR; PG8_SCHED;
            PG8_STAGE(PG8_SB(0, 1), b2 + hstepB, voffB);
            PG8_WAIT_V(6); PG8_BAR; PG8_MMA(1, 1, At, B1); PG8_BAR;
            PG8_LDB(B0, 1, 0); PG8_SCHED; PG8_LDA(At, 1, 0); PG8_STAGE(PG8_SA(0, 1), a2 + hstepA, voffA);
            PG8_WAIT_L(8); PG8_BAR; PG8_WAIT_L(0); PG8_MMA(0, 0, At, B0); PG8_BAR; PG8_SCHED;
            PG8_LDB(B1, 1, 1); PG8_STAGE(PG8_SB(1, 0), b3, voffB);
            PG8_BAR; PG8_WAIT_L(0); PG8_MMA(0, 1, At, B1); PG8_BAR;
            PG8_LDA(At, 1, 1); PG8_STAGE(PG8_SA(1, 0), a3, voffA);
            PG8_BAR; PG8_WAIT_L(0); PG8_MMA(1, 0, At, B0); PG8_BAR; PG8_SCHED;
            PG8_STAGE(PG8_SB(1, 1), b3 + hstepB, voffB);
            PG8_WAIT_V(6); PG8_BAR; PG8_MMA(1, 1, At, B1); PG8_BAR;
#endif
        }
        if (wr == 0) { if constexpr (Epi::PREFETCH) PG8_WAIT_V(8);
            PG8_BAR; }
        E(acc, cur, wr, wc, elds);
        if (!has_next) break;
        if constexpr (Epi::PREFETCH) E.prefetch(nxt, elds, wave_s);
#pragma unroll
        for (int a = 0; a < 2; ++a)
#pragma unroll
            for (int b = 0; b < 2; ++b)
#pragma unroll
                for (int m = 0; m < 4; ++m)
#pragma unroll
                    for (int n = 0; n < 2; ++n) acc[a][b][m][n] = (f32x4){zf, zf, zf, zf};
        cur = nxt; cA = nA; cB = nB; ++ui;
        if constexpr (Epi::KGROUP) E.unit_begin(cur, elds, wave_s);
        PG8_LANECONST();
        if (wr == 1) PG8_BAR;
    }
    PG8_WAIT_V(0);
    PG8_BAR;
#undef PG8_LANECONST
#undef PG8_SA
#undef PG8_SB
#undef PG8_STAGE
#undef PG8_LDA
#undef PG8_LDB
#undef PG8_MMA
}
}
namespace epi {
using pg8::f32x4; using pg8::u32x4; using pg8::u32x2; using pg8::bf16_t; using pg8::Unit; using pg8::cvt_pk_bf16;
constexpr int MROWS = 16384, DMODEL = 1024;
constexpr float EPS = 1e-6f;
#define EPI_LAS __attribute__((address_space(3)))

__device__ __forceinline__ float row_rstd(const float* ssq, int row) {
    const f32x4 a = *(const f32x4*)(ssq + (size_t)row * 4);
    const float s = (a[0] + a[1]) + (a[2] + a[3]);
    return 1.0f / sqrtf(s * (1.0f / DMODEL) + EPS);
}
template <int MSTEP> __device__ __forceinline__ void rstd8(const float* ssq, int row0, bool clamp, float (&rs)[2][4]) {
    f32x4 p[2][4];
#pragma unroll
    for (int ai = 0; ai < 2; ++ai)
#pragma unroll
        for (int m = 0; m < 4; ++m) { int row = row0 + ai * 128 + m * MSTEP; if (clamp) row = row < 0 ? 0 : (row >= MROWS ? MROWS - 1 : row); p[ai][m] = *(const f32x4*)(ssq + (size_t)row * 4); }
#pragma unroll
    for (int ai = 0; ai < 2; ++ai)
#pragma unroll
        for (int m = 0; m < 4; ++m) { const f32x4 a = p[ai][m]; rs[ai][m] = 1.0f / sqrtf(((a[0] + a[1]) + (a[2] + a[3])) * (1.0f / DMODEL) + EPS); }
}
template <int CTRL> __device__ __forceinline__ float dppf(float old, float src) {
    return __builtin_bit_cast(float, __builtin_amdgcn_update_dpp(__builtin_bit_cast(int, old), __builtin_bit_cast(int, src), CTRL, 0xF, 0xF, false));
}
template <int CTRL> __device__ __forceinline__ float dppa(float src) {
    return __builtin_bit_cast(float, __builtin_amdgcn_mov_dpp(__builtin_bit_cast(int, src), CTRL, 0xF, 0xF, true));
}
__device__ __forceinline__ f32x4 silu4(f32x4 v) {
    const f32x4 t = v * (-1.4426950408889634f); f32x4 e;
#pragma unroll
    for (int i = 0; i < 4; ++i) e[i] = __builtin_amdgcn_exp2f(t[i]);
    e = e + 1.0f;
#pragma unroll
    for (int i = 0; i < 4; ++i) e[i] = __builtin_amdgcn_rcpf(e[i]);
    return v * e;
}
template <int CTRL> __device__ __forceinline__ float dppz(float src) {
    return __builtin_bit_cast(float, __builtin_amdgcn_update_dpp(0, __builtin_bit_cast(int, src), CTRL, 0xF, 0xF, true));
}
__device__ __forceinline__ float silu_fast(float v) { return v * __builtin_amdgcn_rcpf(1.0f + __builtin_amdgcn_exp2f(-1.4426950408889634f * v)); }

#ifndef RES_LO
#define RES_LO (RES_F16 ? 0 : 1)
#endif
typedef _Float16 h2_t __attribute__((ext_vector_type(2)));
__device__ __forceinline__ unsigned pk_f16(float lo, float hi) { const h2_t v = {(_Float16)lo, (_Float16)hi}; return __builtin_bit_cast(unsigned, v); }
__device__ __forceinline__ float f16_lo(unsigned w) { const h2_t v = __builtin_bit_cast(h2_t, w); const _Float16 a = v[0]; return (float)a; }
__device__ __forceinline__ float f16_hi(unsigned w) { const h2_t v = __builtin_bit_cast(h2_t, w); const _Float16 a = v[1]; return (float)a; }
template <int MODE  > struct EpiResidual {
    static constexpr bool PERM = true, ROWIL = false, KGROUP = false, PREFETCH = false, AF16 = false;
    const float* xin_f32; float* xout_f32; bf16_t* xh; bf16_t* xl; float* ssq; int dry;
    __device__ __forceinline__ void operator()(f32x4 (&acc)[2][2][4][2], const Unit& u, int wr, int wc, EPI_LAS unsigned char* elds) const {
        int fr, fq; { int t_ = HW_LANE(); asm volatile("" : "+v"(t_)); fr = t_ & 15; fq = (t_ >> 4) & 3; }
        EPI_LAS float* P = (EPI_LAS float*)elds;
        const int col0 = u.pn * 256 + wc * 32 + 8 * fq;
#pragma unroll
        for (int ai = 0; ai < 2; ++ai) {
            u32x4 xa[4][2], xb_[4][2];
#pragma unroll
            for (int m = 0; m < 4; ++m)
#pragma unroll
                for (int bj = 0; bj < 2; ++bj) {
                    const size_t o = (size_t)(u.pm * 256 + ai * 128 + wr * 64 + m * 16 + fr) * DMODEL + col0 + bj * 128;
                    if (MODE == 1) { xa[m][bj] = *(const u32x4*)(xin_f32 + o); xb_[m][bj] = *(const u32x4*)(xin_f32 + o + 4); }
                    else { xa[m][bj] = *(const u32x4*)(xh + o); xb_[m][bj] = RES_LO ? *(const u32x4*)(xl + o) : (u32x4){0u, 0u, 0u, 0u}; }
                }
#pragma unroll
            for (int m = 0; m < 4; ++m) {
                const int row = u.pm * 256 + ai * 128 + wr * 64 + m * 16 + fr;
                float s = 0.f;
#pragma unroll
                for (int bj = 0; bj < 2; ++bj) {
                    const size_t o = (size_t)row * DMODEL + col0 + bj * 128;
                    f32x4 v0, v1;
                    if (MODE == 1) { v0 = __builtin_bit_cast(f32x4, xa[m][bj]); v1 = __builtin_bit_cast(f32x4, xb_[m][bj]); }
                    else {
#pragma unroll
                        for (int i = 0; i < 2; ++i) {
                            if (RES_F16) { v0[2 * i] = f16_lo(xa[m][bj][i]); v0[2 * i + 1] = f16_hi(xa[m][bj][i]); v1[2 * i] = f16_lo(xa[m][bj][2 + i]); v1[2 * i + 1] = f16_hi(xa[m][bj][2 + i]); continue; }
                            v0[2 * i] = __builtin_bit_cast(float, xa[m][bj][i] << 16) + __builtin_bit_cast(float, xb_[m][bj][i] << 16);
                            v0[2 * i + 1] = __builtin_bit_cast(float, xa[m][bj][i] & 0xffff0000u) + __builtin_bit_cast(float, xb_[m][bj][i] & 0xffff0000u);
                            v1[2 * i] = __builtin_bit_cast(float, xa[m][bj][2 + i] << 16) + __builtin_bit_cast(float, xb_[m][bj][2 + i] << 16);
                            v1[2 * i + 1] = __builtin_bit_cast(float, xa[m][bj][2 + i] & 0xffff0000u) + __builtin_bit_cast(float, xb_[m][bj][2 + i] & 0xffff0000u);
                        }
                    }
                    v0 = v0 + acc[ai][bj][m][0]; v1 = v1 + acc[ai][bj][m][1];
                    s += ((v0[0] * v0[0] + v0[1] * v0[1]) + (v0[2] * v0[2] + v0[3] * v0[3])) + ((v1[0] * v1[0] + v1[1] * v1[1]) + (v1[2] * v1[2] + v1[3] * v1[3]));
                    if (MODE == 2) { if (!dry) { *(f32x4*)(xout_f32 + o) = v0; *(f32x4*)(xout_f32 + o + 4) = v1; } }
                    else {
                        u32x4 h; h.x = cvt_pk_bf16(v0[0], v0[1]); h.y = cvt_pk_bf16(v0[2], v0[3]); h.z = cvt_pk_bf16(v1[0], v1[1]); h.w = cvt_pk_bf16(v1[2], v1[3]);
                        if (RES_F16) { h.x = pk_f16(v0[0], v0[1]); h.y = pk_f16(v0[2], v0[3]); h.z = pk_f16(v1[0], v1[1]); h.w = pk_f16(v1[2], v1[3]); }
                        u32x4 l;
                        l.x = cvt_pk_bf16(v0[0] - __builtin_bit_cast(float, h.x << 16), v0[1] - __builtin_bit_cast(float, h.x & 0xffff0000u));
                        l.y = cvt_pk_bf16(v0[2] - __builtin_bit_cast(float, h.y << 16), v0[3] - __builtin_bit_cast(float, h.y & 0xffff0000u));
                        l.z = cvt_pk_bf16(v1[0] - __builtin_bit_cast(float, h.z << 16), v1[1] - __builtin_bit_cast(float, h.z & 0xffff0000u));
                        l.w = cvt_pk_bf16(v1[2] - __builtin_bit_cast(float, h.w << 16), v1[3] - __builtin_bit_cast(float, h.w & 0xffff0000u));
                        if (!dry) { *(u32x4*)(xh + o) = h; if (RES_LO) *(u32x4*)(xl + o) = l; }
                    }
                }
                s = xl_swap32_sum(xl_swap16_sum(s));
                if (fq == 0) P[(ai * 128 + wr * 64 + m * 16 + fr) * 4 + wc] = s;
            }
            asm volatile("" ::: "memory");
        }
        asm volatile("s_waitcnt lgkmcnt(0)" ::: "memory"); __builtin_amdgcn_s_barrier(); asm volatile("" ::: "memory");
        { const int t = (wr * 4 + wc) * 64 + fq * 16 + fr; if (t < 256) { const f32x4 p = *(const EPI_LAS f32x4*)(P + t * 4); ssq[(size_t)(u.pm * 256 + t) * 4 + u.pn] = (p[0] + p[1]) + (p[2] + p[3]); } }
        asm volatile("s_waitcnt lgkmcnt(0)" ::: "memory"); __builtin_amdgcn_s_barrier(); asm volatile("" ::: "memory");
    }
};

template <int MODE> struct EpiResidualG {
    static constexpr bool PERM = true, ROWIL = false, KGROUP = true, PREFETCH = false, AF16 = false;
    const float* xin_f32; bf16_t* xh; bf16_t* xl; float* ssq; const float* ssqp; int dry;
    __device__ __forceinline__ void unit_begin(const Unit& u, EPI_LAS unsigned char* elds, int wave_s) const {
        int t = wave_s * 64 + HW_LANE(); asm volatile("" : "+v"(t));
        if (t < 256) {
            const f32x4* p = (const f32x4*)(ssqp + (size_t)(u.pm * 256 + t) * 32);
            float r[4];
#pragma unroll
            for (int g = 0; g < 4; ++g) { const f32x4 a = p[2 * g], b = p[2 * g + 1]; r[g] = 1.0f / sqrtf((((a[0] + a[1]) + (a[2] + a[3])) + ((b[0] + b[1]) + (b[2] + b[3]))) * (1.0f / 512.0f) + EPS); }
            *(EPI_LAS f32x4*)(elds + 4096 + t * 16) = (f32x4){r[0] / r[1], r[1] / r[2], r[2] / r[3], r[3]};
        }
    }
    __device__ __forceinline__ void kgroup(f32x4 (&acc)[2][2][4][2], int g, int wr, EPI_LAS unsigned char* elds) const {
        int fr; { int t_ = HW_LANE(); asm volatile("" : "+v"(t_)); fr = t_ & 15; }
        const EPI_LAS float* RG = (const EPI_LAS float*)(elds + 4096) + (g - 1);
#pragma unroll
        for (int ai = 0; ai < 2; ++ai)
#pragma unroll
            for (int m = 0; m < 4; ++m) {
                const float f = RG[(ai * 128 + wr * 64 + m * 16 + fr) * 4];
#pragma unroll
                for (int bj = 0; bj < 2; ++bj) { acc[ai][bj][m][0] *= f; acc[ai][bj][m][1] *= f; }
            }
    }
    __device__ __forceinline__ void operator()(f32x4 (&acc)[2][2][4][2], const Unit& u, int wr, int wc, EPI_LAS unsigned char* elds) const {
        kgroup(acc, 4, wr, elds);
        const EpiResidual<MODE> R{xin_f32, nullptr, xh, xl, ssq, dry};
        R(acc, u, wr, wc, elds);
    }
};

struct EpiSsdIn {
    static constexpr bool PERM = true, ROWIL = false, KGROUP = false, PREFETCH = false, AF16 = (RES_F16 != 0);
    bf16_t* proj; float* dt; const float* dtbias; const float* ssq;
    __device__ __forceinline__ void operator()(f32x4 (&acc)[2][2][4][2], const Unit& u, int wr, int wc, EPI_LAS unsigned char*) const {
        int fr, fq; { int t_ = HW_LANE(); asm volatile("" : "+v"(t_)); fr = t_ & 15; fq = (t_ >> 4) & 3; }
        float rsv[2][4]; rstd8<16>(ssq, u.pm * 256 + wr * 64 + fr, false, rsv);
#pragma unroll
        for (int ai = 0; ai < 2; ++ai)
#pragma unroll
            for (int m = 0; m < 4; ++m) {
                const int row = u.pm * 256 + ai * 128 + wr * 64 + m * 16 + fr;
                const float rs = rsv[ai][m];
                if (u.pn < 20) {
#pragma unroll
                    for (int bj = 0; bj < 2; ++bj) {
                        const f32x4 v0 = acc[ai][bj][m][0] * rs, v1 = acc[ai][bj][m][1] * rs;
                        u32x4 w; w.x = cvt_pk_bf16(v0[0], v0[1]); w.y = cvt_pk_bf16(v0[2], v0[3]); w.z = cvt_pk_bf16(v1[0], v1[1]); w.w = cvt_pk_bf16(v1[2], v1[3]);
                        *(u32x4*)(proj + (size_t)row * 5120 + u.pn * 256 + bj * 128 + wc * 32 + 8 * fq) = w;
                    }
                } else if (wc == 0) {
#pragma unroll
                    for (int n = 0; n < 2; ++n) {
                        const int c = 8 * fq + 4 * n;
                        const f32x4 b = *(const f32x4*)(dtbias + c);
                        f32x4 v = acc[ai][0][m][n] * rs + b, o;
#pragma unroll
                        for (int e = 0; e < 4; ++e) o[e] = fmaxf(v[e], 0.f) + log1pf(expf(-fabsf(v[e])));
                        *(f32x4*)(dt + (size_t)row * 32 + c) = o;
                    }
                }
            }
    }
};

struct EpiQKV {
    static constexpr bool PERM = true, ROWIL = false, KGROUP = false, PREFETCH = false, AF16 = (RES_F16 != 0);
    bf16_t* proj; const float* ssq; const float* qg; const float* kg; const float* rope;
    __device__ __forceinline__ void operator()(f32x4 (&acc)[2][2][4][2], const Unit& u, int wr, int wc, EPI_LAS unsigned char* elds) const {
        int fr, fq; { int t_ = HW_LANE(); asm volatile("" : "+v"(t_)); fr = t_ & 15; fq = (t_ >> 4) & 3; }
        EPI_LAS float* P = (EPI_LAS float*)elds;
        EPI_LAS f32x4* RT = (EPI_LAS f32x4*)(elds + 8192);
        const bool isqk = u.pn < 8;
        f32x4 rp_[2];
        const int t_id = (wr * 4 + wc) * 64 + fq * 16 + fr;
        if (isqk) {
#pragma unroll
            for (int i = 0; i < 2; ++i) rp_[i] = *(const f32x4*)(rope + (size_t)u.pm * 256 * 16 + (size_t)(t_id * 2 + i) * 4);
        }
        float rsv[2][4]; rstd8<16>(ssq, u.pm * 256 + wr * 64 + fr, false, rsv);
#pragma unroll
        for (int ai = 0; ai < 2; ++ai)
#pragma unroll
            for (int m = 0; m < 4; ++m) {
                const int trow = ai * 128 + wr * 64 + m * 16 + fr;
                const float rs = rsv[ai][m];
#pragma unroll
                for (int bj = 0; bj < 2; ++bj) {
                    acc[ai][bj][m][0] *= rs; acc[ai][bj][m][1] *= rs;
                    if (isqk) {
                        const f32x4 a = acc[ai][bj][m][0], b = acc[ai][bj][m][1];
                        float s = ((a[0] * a[0] + a[1] * a[1]) + (a[2] * a[2] + a[3] * a[3])) + ((b[0] * b[0] + b[1] * b[1]) + (b[2] * b[2] + b[3] * b[3]));
                        s = xl_swap32_sum(xl_swap16_sum(s));
                        if (fq == 0) P[trow * 8 + bj * 4 + wc] = s;
                    }
                }
            }
        if (isqk) { RT[t_id * 2] = rp_[0]; RT[t_id * 2 + 1] = rp_[1]; }
        if (isqk) {
            asm volatile("s_waitcnt lgkmcnt(0)" ::: "memory"); __builtin_amdgcn_s_barrier(); asm volatile("" ::: "memory");
            const float* g = (u.pn < 4) ? qg : kg;
            const int d0 = 32 * (wc & 1) + 8 * fq;
            const f32x4 g0 = *(const f32x4*)(g + d0), g1 = *(const f32x4*)(g + d0 + 4);
            const float qs = (u.pn < 4) ? (1.4426950408889634f * 0.125f) : 1.0f;
            const bool dorope = (wc & 1) == 0;
#pragma unroll
            for (int ai = 0; ai < 2; ++ai)
#pragma unroll
                for (int m = 0; m < 4; ++m) {
                    const int trow = ai * 128 + wr * 64 + m * 16 + fr;
                    const int row = u.pm * 256 + trow;
                    f32x4 c0 = {1.f, 1.f, 1.f, 1.f}, c1 = c0, s0 = {0.f, 0.f, 0.f, 0.f}, s1 = s0;
                    if (dorope && fq < 2) {
                        c0 = RT[trow * 4 + 0]; c1 = RT[trow * 4 + 1]; s0 = RT[trow * 4 + 2]; s1 = RT[trow * 4 + 3];
                        if (fq == 0) { s0 = -s0; s1 = -s1; }
                    }
#pragma unroll
                    for (int bj = 0; bj < 2; ++bj) {
                        const float tot = P[trow * 8 + bj * 4 + wc] + P[trow * 8 + bj * 4 + (wc ^ 1)];
                        const float nr = qs / sqrtf(tot * (1.0f / 64.0f) + EPS);
                        f32x4 v0 = acc[ai][bj][m][0] * g0 * nr, v1 = acc[ai][bj][m][1] * g1 * nr;
                        if (dorope) {
                            f32x4 o0, o1;
#pragma unroll
                            for (int e = 0; e < 4; ++e) { o0[e] = xl_xor16(v0[e], (fq & 1) != 0); o1[e] = xl_xor16(v1[e], (fq & 1) != 0); }
                            v0 = v0 * c0 + o0 * s0; v1 = v1 * c1 + o1 * s1;
                        }
                        u32x4 w; w.x = cvt_pk_bf16(v0[0], v0[1]); w.y = cvt_pk_bf16(v0[2], v0[3]); w.z = cvt_pk_bf16(v1[0], v1[1]); w.w = cvt_pk_bf16(v1[2], v1[3]);
                        *(u32x4*)(proj + (size_t)row * 3072 + u.pn * 256 + bj * 128 + wc * 32 + 8 * fq) = w;
                    }
                    asm volatile("" ::: "memory");
                }
            asm volatile("s_waitcnt lgkmcnt(0)" ::: "memory"); __builtin_amdgcn_s_barrier(); asm volatile("" ::: "memory");
        } else {
#pragma unroll
            for (int ai = 0; ai < 2; ++ai)
#pragma unroll
                for (int m = 0; m < 4; ++m) {
                    const int row = u.pm * 256 + ai * 128 + wr * 64 + m * 16 + fr;
#pragma unroll
                    for (int bj = 0; bj < 2; ++bj) {
                        const f32x4 v0 = acc[ai][bj][m][0], v1 = acc[ai][bj][m][1];
                        u32x4 w; w.x = cvt_pk_bf16(v0[0], v0[1]); w.y = cvt_pk_bf16(v0[2], v0[3]); w.z = cvt_pk_bf16(v1[0], v1[1]); w.w = cvt_pk_bf16(v1[2], v1[3]);
                        *(u32x4*)(proj + (size_t)row * 3072 + u.pn * 256 + bj * 128 + wc * 32 + 8 * fq) = w;
                    }
                }
        }
    }
};

struct EpiSsdConv {
    static constexpr bool PERM = true, ROWIL = true, KGROUP = false, PREFETCH = true, AF16 = (RES_F16 != 0);
    bf16_t* zp; bf16_t* xbc; float* dt; const float* ssq; const float* cp;
    template <bool MASK>
    __device__ __forceinline__ void conv_body(f32x4 (&acc)[2][2][4][2], const Unit& u, int wr, int wc, int fr, int fq, const EPI_LAS f32x4* hb, int R0) const {
        bf16_t* const obase = (u.pn < 8) ? zp + u.pn * 256 : xbc + (u.pn - 8) * 256;
        const int old_ = (u.pn < 8) ? 2048 : 3072;
#pragma unroll
        for (int bj = 0; bj < 2; ++bj) {
            u32x2 keep[2][4];
#pragma unroll
            for (int n = 0; n < 2; ++n) {
                const int tc = bj * 128 + wc * 32 + 8 * fq + 4 * n;
                const EPI_LAS float* pt = (const EPI_LAS float*)((const EPI_LAS unsigned char*)hb + 12288) + tc;
                const f32x4 bb = *(const EPI_LAS f32x4*)pt, w0 = *(const EPI_LAS f32x4*)(pt + 256), w1 = *(const EPI_LAS f32x4*)(pt + 512), w2 = *(const EPI_LAS f32x4*)(pt + 768), w3 = *(const EPI_LAS f32x4*)(pt + 1024);
#pragma unroll
                for (int ai = 0; ai < 2; ++ai) {
                    f32x4 h1 = {0.f, 0.f, 0.f, 0.f}, h2 = h1, h3 = h1;
                    const int pwr = wr ^ 1, pai = (wr == 1) ? ai : ai - 1;
                    if (pai >= 0 && fr == 0) { const int idx = (((pwr * 2 + pai) * 4 + wc) * 3 * 4 + fq) * 4 + bj * 2 + n;
                        h1 = hb[idx]; h2 = hb[idx + 16]; h3 = hb[idx + 32]; }
                    const f32x4 v0 = acc[ai][bj][0][n], v1 = acc[ai][bj][1][n], v2 = acc[ai][bj][2][n], v3 = acc[ai][bj][3][n];
                    f32x4 p1, p2, p3;
#pragma unroll
                    for (int e = 0; e < 4; ++e) { p1[e] = dppf<0x111>(h1[e], v1[e]); p2[e] = dppf<0x111>(h2[e], v2[e]); p3[e] = dppf<0x111>(h3[e], v3[e]); }
#pragma unroll
                    for (int m = 0; m < 4; ++m) {
                        const int trow = ai * 128 + wr * 64 + 4 * fr + m, row = R0 + trow;
                        const f32x4 cv = (m == 0) ? v0 : (m == 1) ? v1 : (m == 2) ? v2 : v3;
                        f32x4 x1 = (m == 0) ? p3 : (m == 1) ? v0 : (m == 2) ? v1 : v2;
                        f32x4 x2 = (m == 0) ? p2 : (m == 1) ? p3 : (m == 2) ? v0 : v1;
                        f32x4 x3 = (m == 0) ? p1 : (m == 1) ? p2 : (m == 2) ? p3 : v0;
                        if (MASK) { const int ts = row & 2047; const f32x4 z4 = {0.f, 0.f, 0.f, 0.f}; if (ts < 1) x1 = z4; if (ts < 2) x2 = z4; if (ts < 3) x3 = z4; }
                        const bool valid = trow >= 3 && row < MROWS;
                        const f32x4 o = silu4(bb + w0 * x3 + w1 * x2 + w2 * x1 + w3 * cv);
                        if (n == 0) { keep[ai][m].x = cvt_pk_bf16(o[0], o[1]); keep[ai][m].y = cvt_pk_bf16(o[2], o[3]); }
                        else if (valid) {
                            u32x4 w; w.x = keep[ai][m].x; w.y = keep[ai][m].y; w.z = cvt_pk_bf16(o[0], o[1]); w.w = cvt_pk_bf16(o[2], o[3]);
                            *(u32x4*)(obase + (size_t)row * old_ + tc - 4) = w;
                        }
                    }
                    asm volatile("" ::: "memory");
                }
            }
        }
    }
    __device__ __forceinline__ void prefetch(const Unit& u, EPI_LAS unsigned char* elds, int wave_s) const {
        if (wave_s < 5) {
            int l_ = HW_LANE(); asm volatile("" : "+v"(l_)); const int t_id = wave_s * 64 + l_;
            __builtin_amdgcn_global_load_lds((const unsigned*)(cp + (size_t)wave_s * 5376 + u.pn * 256 + l_ * 4), (EPI_LAS unsigned*)(elds + 12288 + wave_s * 1024), 16, 0, 0);
            if (wave_s < 4) {
                int row = u.pm * 253 - 3 + t_id; row = row < 0 ? 0 : (row >= MROWS ? MROWS - 1 : row);
                __builtin_amdgcn_global_load_lds((const unsigned*)(ssq + (size_t)row * 4), (EPI_LAS unsigned*)(elds + 17408 + wave_s * 1024), 16, 0, 0);
            }
        }
    }
    __device__ __forceinline__ void operator()(f32x4 (&acc)[2][2][4][2], const Unit& u, int wr, int wc, EPI_LAS unsigned char* elds) const {
        int fr, fq; { int t_ = HW_LANE(); asm volatile("" : "+v"(t_)); fr = t_ & 15; fq = (t_ >> 4) & 3; }
        const int R0 = u.pm * 253 - 3;
        EPI_LAS f32x4* hb = (EPI_LAS f32x4*)elds;
        { float rsv[2][4];
          const EPI_LAS f32x4* SS = (const EPI_LAS f32x4*)(elds + 17408) + wr * 64 + 4 * fr;
#pragma unroll
          for (int ai = 0; ai < 2; ++ai)
#pragma unroll
            for (int m = 0; m < 4; ++m) { const f32x4 a = SS[ai * 128 + m]; rsv[ai][m] = 1.0f / sqrtf(((a[0] + a[1]) + (a[2] + a[3])) * (1.0f / DMODEL) + EPS); }
#pragma unroll
          for (int ai = 0; ai < 2; ++ai)
#pragma unroll
            for (int m = 0; m < 4; ++m)
#pragma unroll
                for (int bj = 0; bj < 2; ++bj) { acc[ai][bj][m][0] *= rsv[ai][m]; acc[ai][bj][m][1] *= rsv[ai][m]; } }
        if (u.pn == 20) {
            if (wc == 0) {
#pragma unroll
                for (int ai = 0; ai < 2; ++ai)
#pragma unroll
                    for (int m = 0; m < 4; ++m) {
                        const int trow = ai * 128 + wr * 64 + 4 * fr + m, row = R0 + trow;
                        if (trow >= 3 && row < MROWS) {
#pragma unroll
                            for (int n = 0; n < 2; ++n) {
                                const int c = 8 * fq + 4 * n;
                                const f32x4 b = *(const EPI_LAS f32x4*)(elds + 12288 + c * 4);
                                f32x4 v = acc[ai][0][m][n] + b, o;
#pragma unroll
                                for (int e = 0; e < 4; ++e) o[e] = fmaxf(v[e], 0.f) + log1pf(expf(-fabsf(v[e])));
                                *(f32x4*)(dt + (size_t)row * 32 + c) = o;
                            }
                        }
                    }
            }
            asm volatile("s_waitcnt lgkmcnt(0)" ::: "memory"); __builtin_amdgcn_s_barrier(); asm volatile("" ::: "memory");
            return;
        }
        if (fr == 15) {
#pragma unroll
            for (int ai = 0; ai < 2; ++ai)
#pragma unroll
                for (int m = 1; m < 4; ++m) {
                    const int idx = ((((wr * 2 + ai) * 4 + wc) * 3 + (m - 1)) * 4 + fq) * 4;
                    hb[idx + 0] = acc[ai][0][m][0]; hb[idx + 1] = acc[ai][0][m][1]; hb[idx + 2] = acc[ai][1][m][0]; hb[idx + 3] = acc[ai][1][m][1];
                }
        }
        asm volatile("s_waitcnt lgkmcnt(0)" ::: "memory"); __builtin_amdgcn_s_barrier(); asm volatile("" ::: "memory");
        const int tf = (u.pm * 253) & 2047;
        if (tf <= 2 || tf + 252 >= 2048) conv_body<true>(acc, u, wr, wc, fr, fq, hb, R0); else conv_body<false>(acc, u, wr, wc, fr, fq, hb, R0);
        asm volatile("s_waitcnt lgkmcnt(0)" ::: "memory"); __builtin_amdgcn_s_barrier(); asm volatile("" ::: "memory");
    }
};

struct EpiConvGate {
    static constexpr bool PERM = true, ROWIL = true, KGROUP = false, PREFETCH = true, AF16 = (RES_F16 != 0);
    bf16_t* H; const float* ssq; const float* cw; const float* cb; int dry;
    template <bool MASK>
    __device__ __forceinline__ void body(f32x4 (&acc)[2][2][4][2], const Unit& u, int wr, int wc, int fr, int fq, const EPI_LAS f32x4* hb, int R0) const {
        constexpr int DFF = 2816;
        u32x2 keep[2][4];
#pragma unroll
        for (int n = 0; n < 2; ++n) {
            const int ch = u.pn * 128 + wc * 32 + 8 * fq + 4 * n;
            const EPI_LAS float* pt = (const EPI_LAS float*)((const EPI_LAS unsigned char*)hb + 8192) + wc * 32 + 8 * fq + 4 * n;
            const f32x4 bg = *(const EPI_LAS f32x4*)pt, bu = *(const EPI_LAS f32x4*)(pt + 128);
            const f32x4 w0g = *(const EPI_LAS f32x4*)(pt + 256), w0u = *(const EPI_LAS f32x4*)(pt + 384), w1g = *(const EPI_LAS f32x4*)(pt + 512), w1u = *(const EPI_LAS f32x4*)(pt + 640), w2g = *(const EPI_LAS f32x4*)(pt + 768), w2u = *(const EPI_LAS f32x4*)(pt + 896);
#pragma unroll
            for (int ai = 0; ai < 2; ++ai) {
                f32x4 hg2 = {0.f, 0.f, 0.f, 0.f}, hg3 = hg2, hu2 = hg2, hu3 = hg2;
                const int pwr = wr ^ 1, pai = (wr == 1) ? ai : ai - 1;
                if (pai >= 0 && fr == 0) { const int idx = (((pwr * 2 + pai) * 4 + wc) * 2 * 4 + fq) * 4;
                    hg2 = hb[idx + n]; hu2 = hb[idx + 2 + n]; hg3 = hb[idx + 16 + n]; hu3 = hb[idx + 16 + 2 + n]; }
                const f32x4 g0 = acc[ai][0][0][n], g1_ = acc[ai][0][1][n], g2_ = acc[ai][0][2][n], g3_ = acc[ai][0][3][n];
                const f32x4 u0 = acc[ai][1][0][n], u1_ = acc[ai][1][1][n], u2_ = acc[ai][1][2][n], u3_ = acc[ai][1][3][n];
                f32x4 pg2, pg3, pu2, pu3;
#pragma unroll
                for (int e = 0; e < 4; ++e) { pg2[e] = dppf<0x111>(hg2[e], g2_[e]); pg3[e] = dppf<0x111>(hg3[e], g3_[e]); pu2[e] = dppf<0x111>(hu2[e], u2_[e]); pu3[e] = dppf<0x111>(hu3[e], u3_[e]); }
#pragma unroll
                for (int m = 0; m < 4; ++m) {
                    const int trow = ai * 128 + wr * 64 + 4 * fr + m, row = R0 + trow;
                    const f32x4 cg = (m == 0) ? g0 : (m == 1) ? g1_ : (m == 2) ? g2_ : g3_, cu = (m == 0) ? u0 : (m == 1) ? u1_ : (m == 2) ? u2_ : u3_;
                    f32x4 xg1 = (m == 0) ? pg3 : (m == 1) ? g0 : (m == 2) ? g1_ : g2_, xg2 = (m == 0) ? pg2 : (m == 1) ? pg3 : (m == 2) ? g0 : g1_;
                    f32x4 xu1 = (m == 0) ? pu3 : (m == 1) ? u0 : (m == 2) ? u1_ : u2_, xu2 = (m == 0) ? pu2 : (m == 1) ? pu3 : (m == 2) ? u0 : u1_;
                    if (MASK) { const int ts = row & 2047; const f32x4 z4 = {0.f, 0.f, 0.f, 0.f}; if (ts < 1) { xg1 = z4; xu1 = z4; } if (ts < 2) { xg2 = z4; xu2 = z4; } }
                    const f32x4 gv = bg + w0g * xg2 + w1g * xg1 + w2g * cg;
                    const f32x4 uv = bu + w0u * xu2 + w1u * xu1 + w2u * cu;
                    const f32x4 o = silu4(gv) * uv;
                    if (n == 0) { keep[ai][m].x = cvt_pk_bf16(o[0], o[1]); keep[ai][m].y = cvt_pk_bf16(o[2], o[3]); }
                    else if (trow >= 2 && row < MROWS) {
                        u32x4 w; w.x = keep[ai][m].x; w.y = keep[ai][m].y; w.z = cvt_pk_bf16(o[0], o[1]); w.w = cvt_pk_bf16(o[2], o[3]);
                        asm volatile("" :: "v"(w.x), "v"(w.y), "v"(w.z), "v"(w.w));
                        if (!dry) *(u32x4*)(H + (size_t)row * DFF + ch - 4) = w;
                    }
                }
                asm volatile("" ::: "memory");
            }
        }
    }
    __device__ __forceinline__ void prefetch(const Unit& u, EPI_LAS unsigned char* elds, int wave_s) const {
        if (wave_s < 4) {
            int l_ = HW_LANE(); asm volatile("" : "+v"(l_)); const int t_id = wave_s * 64 + l_;
            const int k = t_id >> 5, c = u.pn * 128 + (t_id & 31) * 4;
            __builtin_amdgcn_global_load_lds((const unsigned*)((k < 2 ? cb + k * 2816 : cw + (size_t)(k - 2) * 2816) + c), (EPI_LAS unsigned*)(elds + 8192 + wave_s * 1024), 16, 0, 0);
            int row = u.pm * 254 - 2 + t_id; row = row < 0 ? 0 : (row >= MROWS ? MROWS - 1 : row);
            __builtin_amdgcn_global_load_lds((const unsigned*)(ssq + (size_t)row * 4), (EPI_LAS unsigned*)(elds + 12288 + wave_s * 1024), 16, 0, 0);
        }
    }
    __device__ __forceinline__ void operator()(f32x4 (&acc)[2][2][4][2], const Unit& u, int wr, int wc, EPI_LAS unsigned char* elds) const {
#ifdef PROBE_EPI_MODE
        if (dry == 3) { asm volatile("" :: "v"(acc[0][0][0][0][0]), "v"(acc[1][1][3][1][3])); return; }
#endif
        int fr, fq; { int t_ = HW_LANE(); asm volatile("" : "+v"(t_)); fr = t_ & 15; fq = (t_ >> 4) & 3; }
        const int R0 = u.pm * 254 - 2;
        EPI_LAS f32x4* hb = (EPI_LAS f32x4*)elds;
        const int t_id = (wr * 4 + wc) * 64 + fq * 16 + fr;
        (void)t_id;
        { float rsv[2][4];
          const EPI_LAS f32x4* SS = (const EPI_LAS f32x4*)(elds + 12288) + wr * 64 + 4 * fr;
#pragma unroll
          for (int ai = 0; ai < 2; ++ai)
#pragma unroll
            for (int m = 0; m < 4; ++m) { const f32x4 a = SS[ai * 128 + m]; rsv[ai][m] = 1.0f / sqrtf(((a[0] + a[1]) + (a[2] + a[3])) * (1.0f / DMODEL) + EPS); }
#pragma unroll
          for (int ai = 0; ai < 2; ++ai)
#pragma unroll
            for (int m = 0; m < 4; ++m)
#pragma unroll
                for (int bj = 0; bj < 2; ++bj) { acc[ai][bj][m][0] *= rsv[ai][m]; acc[ai][bj][m][1] *= rsv[ai][m]; } }
        if (fr == 15) {
#pragma unroll
            for (int ai = 0; ai < 2; ++ai)
#pragma unroll
                for (int m = 2; m < 4; ++m) {
                    const int idx = ((((wr * 2 + ai) * 4 + wc) * 2 + (m - 2)) * 4 + fq) * 4;
                    hb[idx + 0] = acc[ai][0][m][0]; hb[idx + 1] = acc[ai][0][m][1]; hb[idx + 2] = acc[ai][1][m][0]; hb[idx + 3] = acc[ai][1][m][1];
                }
        }
        asm volatile("s_waitcnt lgkmcnt(0)" ::: "memory"); __builtin_amdgcn_s_barrier(); asm volatile("" ::: "memory");
        const int tf = (u.pm * 254) & 2047;
        if (dry < 2 || dry > 4) { if (tf <= 1 || tf + 253 >= 2048) body<true>(acc, u, wr, wc, fr, fq, hb, R0); else body<false>(acc, u, wr, wc, fr, fq, hb, R0); }
        asm volatile("s_waitcnt lgkmcnt(0)" ::: "memory"); __builtin_amdgcn_s_barrier(); asm volatile("" ::: "memory");
    }
};
}
namespace attn {
using pg8::bf16_t; using pg8::bf16x8; using pg8::f32x4; using pg8::u32x4;
typedef float f32x16 __attribute__((ext_vector_type(16)));
typedef short s16x4 __attribute__((ext_vector_type(4)));
#define AT_LAS __attribute__((address_space(3)))
constexpr int LD = 3072, SEQ = 2048;
constexpr int KT_BYTES = 16384, VT_BYTES = 16384, STG = KT_BYTES + VT_BYTES;
constexpr int L_X = 0;
constexpr int L_WSF = 2 * STG;
constexpr int L_OST = L_WSF + 8 * 256;
constexpr int LDS_BYTES = L_OST + 4 * 8192;
__device__ __forceinline__ int crow(int r, int hi) { return (r & 3) + 8 * (r >> 2) + 4 * hi; }
__device__ __forceinline__ unsigned cvtpk(float lo, float hi) { typedef float f2 __attribute__((ext_vector_type(2))); typedef __bf16 b2 __attribute__((ext_vector_type(2))); f2 v = {lo, hi}; b2 b = __builtin_convertvector(v, b2); return __builtin_bit_cast(unsigned, b); }
__device__ __forceinline__ s16x4 vtr(const AT_LAS char* p) { typedef short v4 __attribute__((ext_vector_type(4))); return __builtin_bit_cast(s16x4, __builtin_amdgcn_ds_read_tr16_b64_v4i16((AT_LAS v4*)p)); }

struct Params { bf16_t* qkv; float mb; float lam; int dry; };

template <int MODE = 0>
__device__ __forceinline__ void unit(const Params& P, int b, int h, int blk, AT_LAS char* lds, const int wave_s) {
    int tid = wave_s * 64 + HW_LANE(); asm volatile("" : "+v"(tid));
    const int lane = tid & 63, r32 = lane & 31, hi = lane >> 5;
    const int wid = __builtin_amdgcn_readfirstlane(tid >> 6), comp = wid >> 2, w4 = wid & 3;
    const size_t rowb = (size_t)b * SEQ;
    const int q0 = blk * 128;
    const int nt = 2 * blk + 2, my_nt = 2 * blk + (w4 >> 1) + 1;
    const bf16_t* Kg = P.qkv + rowb * LD + 1024 + h * 128;
    const bf16_t* Vg = P.qkv + rowb * LD + 2048 + h * 128;
    u32x4 kreg[2], vreg[2];
    int kdst[2], vdst[2];
#pragma unroll
    for (int i = 0; i < 2; ++i) {
        const int p = tid + 512 * i, key = p >> 4, c16 = p & 15;
        kdst[i] = key * 256 + ((c16 ^ (key & 15)) << 4);
        vdst[i] = KT_BYTES + (c16 >> 2) * 4096 + (key >> 4) * 1024 + ((key >> 3) & 1) * 512 + (key & 7) * 64 + (c16 & 3) * 16;
    }
#define AT_LOAD(t) do { _Pragma("unroll") for (int i = 0; i < 2; ++i) { const int p = tid + 512 * i, key = p >> 4, c16 = p & 15; const size_t go = (size_t)((t) * 64 + key) * LD + c16 * 8; \
        kreg[i] = *(const u32x4*)(Kg + go); vreg[i] = *(const u32x4*)(Vg + go); } } while (0)
#define AT_STORE(s) do { _Pragma("unroll") for (int i = 0; i < 2; ++i) { *(AT_LAS u32x4*)(lds + (s) * STG + kdst[i]) = kreg[i]; *(AT_LAS u32x4*)(lds + (s) * STG + vdst[i]) = vreg[i]; } } while (0)
    AT_LOAD(0);
    bf16x8 qr[4];
    {
        const bf16_t* Qw = P.qkv + (rowb + q0 + w4 * 32 + r32) * LD + h * 128 + comp * 64 + hi * 8;
#pragma unroll
        for (int d0 = 0; d0 < 4; ++d0) qr[d0] = *(const bf16x8*)(Qw + d0 * 16);
    }
    AT_STORE(0);
    __syncthreads();
    f32x16 o[4];
#pragma unroll
    for (int i = 0; i < 4; ++i)
#pragma unroll
        for (int r = 0; r < 16; ++r) o[i][r] = 0.f;
    float lsum = 0.f;
    f32x16 negm;
#pragma unroll
    for (int r = 0; r < 16; ++r) negm[r] = -P.mb;
    const int kbase = r32 * 256, ksw = r32 & 15;
    const int vbase = KT_BYTES + ((lane >> 4) & 1) * 32 + (lane & 3) * 8 + (4 * hi + ((lane & 15) >> 2)) * 64;
    for (int t = 0; t < nt; ++t) {
        const int s = t & 1;
        if (MODE != 4) { if (t + 1 < nt) AT_LOAD(t + 1); }
        if (t < my_nt) {
            const AT_LAS char* st = lds + s * STG;
            bf16x8 kf[8];
#pragma unroll
            for (int d0 = 0; d0 < 4; ++d0) {
                const int ch = comp * 8 + 2 * d0 + hi;
                kf[2 * d0] = *(const AT_LAS bf16x8*)(st + kbase + ((ch ^ ksw) << 4));
                kf[2 * d0 + 1] = *(const AT_LAS bf16x8*)(st + kbase + 32 * 256 + ((ch ^ ksw) << 4));
            }
            s16x4 vlo[2][4], vhi[2][4];
#define AT_VLOAD(bk, buf) do { _Pragma("unroll") for (int ks = 0; ks < 4; ++ks) { vlo[buf][ks] = vtr(st + vbase + (bk) * 4096 + ks * 1024); vhi[buf][ks] = vtr(st + vbase + (bk) * 4096 + ks * 1024 + 512); } } while (0)
            AT_VLOAD(0, 0);
            __builtin_amdgcn_sched_barrier(0);
            f32x16 p0 = negm, p1 = negm;
            if (MODE != 3) {
#pragma unroll
            for (int d0 = 0; d0 < 4; ++d0) {
                p0 = __builtin_amdgcn_mfma_f32_32x32x16_bf16(kf[2 * d0], qr[d0], p0, 0, 0, 0);
                p1 = __builtin_amdgcn_mfma_f32_32x32x16_bf16(kf[2 * d0 + 1], qr[d0], p1, 0, 0, 0);
            } }
            __builtin_amdgcn_sched_barrier(0);
            AT_VLOAD(1, 1);
            __builtin_amdgcn_sched_barrier(0);
            float sacc0 = 0.f, sacc1 = 0.f;
#pragma unroll
            for (int r = 0; r < 16; ++r) { if (MODE != 1) { p0[r] = __builtin_amdgcn_exp2f(p0[r]); p1[r] = __builtin_amdgcn_exp2f(p1[r]); } sacc0 += p0[r]; sacc1 += p1[r]; }
            lsum += sacc0 + sacc1;
            u32x4 pw[4];
#pragma unroll
            for (int j = 0; j < 4; ++j) { pw[0][j] = cvtpk(p0[2 * j], p0[2 * j + 1]); pw[1][j] = cvtpk(p0[8 + 2 * j], p0[8 + 2 * j + 1]); pw[2][j] = cvtpk(p1[2 * j], p1[2 * j + 1]); pw[3][j] = cvtpk(p1[8 + 2 * j], p1[8 + 2 * j + 1]); }
#define AT_PV(bk, buf) do { _Pragma("unroll") for (int ks = 0; ks < 4; ++ks) { \
                const bf16x8 vf = {vlo[buf][ks][0], vlo[buf][ks][1], vlo[buf][ks][2], vlo[buf][ks][3], vhi[buf][ks][0], vhi[buf][ks][1], vhi[buf][ks][2], vhi[buf][ks][3]}; \
                if (MODE != 2) o[bk] = __builtin_amdgcn_mfma_f32_32x32x16_bf16(__builtin_bit_cast(bf16x8, pw[ks]), vf, o[bk], 0, 0, 0); else asm volatile("" :: "v"(pw[ks])); } } while (0)
            __builtin_amdgcn_sched_barrier(0);
            AT_PV(0, 0); __builtin_amdgcn_sched_barrier(0); AT_VLOAD(2, 0); __builtin_amdgcn_sched_barrier(0);
            AT_PV(1, 1); __builtin_amdgcn_sched_barrier(0); AT_VLOAD(3, 1); __builtin_amdgcn_sched_barrier(0);
            AT_PV(2, 0);
            AT_PV(3, 1);
#undef AT_VLOAD
#undef AT_PV
        }
        if (MODE != 4) { if (t + 1 < nt) AT_STORE(s ^ 1); }
        if (MODE != 5) __syncthreads();
    }
    lsum = xl_swap32_sum(lsum);
    AT_LAS float* wsf = (AT_LAS float*)(lds + L_WSF) + wid * 64;
    if (hi == 0) wsf[r32] = lsum;
    asm volatile("s_waitcnt lgkmcnt(0)" ::: "memory");
    float rl[16];
    const float sc = comp ? P.lam : 1.0f;
#pragma unroll
    for (int r = 0; r < 16; ++r) rl[r] = sc * __builtin_amdgcn_rcpf(wsf[crow(r, hi)]);
    AT_LAS float* X = (AT_LAS float*)(lds + L_X) + w4 * 4096 + lane;
    if (comp == 1) {
#pragma unroll
        for (int bk = 0; bk < 4; ++bk)
#pragma unroll
            for (int r = 0; r < 16; ++r) X[(bk * 16 + r) * 64] = o[bk][r] * rl[r];
    }
    __syncthreads();
    if (comp == 0) {
        float ss[16];
#pragma unroll
        for (int r = 0; r < 16; ++r) ss[r] = 0.f;
#pragma unroll
        for (int bk = 0; bk < 4; ++bk)
#pragma unroll
            for (int r = 0; r < 16; ++r) { const float v = o[bk][r] * rl[r] - X[(bk * 16 + r) * 64]; o[bk][r] = v; ss[r] += v * v; }
#pragma unroll
        for (int r = 0; r < 16; ++r) {
            float s = ss[r];
            s = xl_swap16_sum(xl_sum16(s));
            ss[r] = 1.0f / sqrtf(s * (1.0f / 128.0f) + 1e-6f);
        }
        AT_LAS bf16_t* stg = (AT_LAS bf16_t*)(lds + L_OST) + w4 * 4096;
#pragma unroll
        for (int bk = 0; bk < 4; ++bk)
#pragma unroll
            for (int r = 0; r < 16; ++r) { const float v = o[bk][r] * ss[r]; stg[crow(r, hi) * 128 + bk * 32 + r32] = (bf16_t)(cvtpk(v, 0.f) & 0xffffu); }
        asm volatile("s_waitcnt lgkmcnt(0)" ::: "memory");
        bf16_t* Ow = P.qkv + (rowb + q0 + w4 * 32) * LD + h * 128;
#pragma unroll
        for (int i = 0; i < 8; ++i) { const int row = i * 4 + (lane >> 4), c = lane & 15; const u32x4 v = *(const AT_LAS u32x4*)(stg + row * 128 + c * 8); if (!P.dry) *(u32x4*)(Ow + (size_t)row * LD + c * 8) = v; }
    }
    __syncthreads();
#undef AT_LOAD
#undef AT_STORE
}
}
namespace scan {
using pg8::bf16_t; using pg8::bf16x8; using pg8::f32x4; using pg8::u32x4; using pg8::u32x2;
typedef float f32x16 __attribute__((ext_vector_type(16)));
#define SC_LAS __attribute__((address_space(3)))
#define SC_BAR() do { asm volatile("s_waitcnt lgkmcnt(0)" ::: "memory"); __builtin_amdgcn_s_barrier(); asm volatile("" ::: "memory"); } while (0)
constexpr int SEQ = 2048, CH = 64;
constexpr int L_C = 0;
constexpr int L_B = 16384;
constexpr int L_XD = 32768;
constexpr int L_XW = 40960;
constexpr int L_G = 49152;
constexpr int L_H = 57344;
constexpr int L_Y = 73728;
constexpr int L_S = L_Y + 64 * 68 * 4;
constexpr int LDS_BYTES = L_S + 32 * 1024;
__device__ __forceinline__ unsigned cvtpk(float lo, float hi) { typedef float f2 __attribute__((ext_vector_type(2))); typedef __bf16 b2 __attribute__((ext_vector_type(2))); f2 v = {lo, hi}; b2 b = __builtin_convertvector(v, b2); return __builtin_bit_cast(unsigned, b); }
typedef short s16x4 __attribute__((ext_vector_type(4)));
__device__ __forceinline__ s16x4 vtr(const SC_LAS char* p) { typedef short v4 __attribute__((ext_vector_type(4))); return __builtin_bit_cast(s16x4, __builtin_amdgcn_ds_read_tr16_b64_v4i16((SC_LAS v4*)p)); }
__device__ __forceinline__ float lo16(unsigned w) { return __builtin_bit_cast(float, w << 16); }
__device__ __forceinline__ float hi16(unsigned w) { return __builtin_bit_cast(float, w & 0xffff0000u); }
__device__ __forceinline__ int img_off(int l) { return (l >> 4) * 1024 + ((l >> 3) & 1) * 512 + (l & 7) * 64; }

struct Params { const bf16_t* xbc; bf16_t* zp; const float* dt; const float* a_log; const float* dskip; float* ssqp; int dry; };

__device__ __forceinline__ void unit(const Params& P, int b, int h, SC_LAS char* lds, const int wave_s) {
    int tid = wave_s * 64 + HW_LANE(); asm volatile("" : "+v"(tid));
    const int wid = __builtin_amdgcn_readfirstlane(tid >> 6);
    const int g = h >> 3;
    const size_t rowb = (size_t)b * SEQ;
    const float a_h = -expf(P.a_log[h]), dsk = P.dskip[h];
    unsigned zu = 0u; asm volatile("" : "+v"(zu));
    {
        const int lane_ = tid & 63;
#pragma unroll
        for (int q = 0; q < 4; ++q) {
            const int cc = wid * 4 + q;
            const float dtv = P.dt[(rowb + cc * 64 + lane_) * 32 + h];
            float acs = dtv * a_h;
            acs = xl_scan64(acs);
            const float last = __builtin_bit_cast(float, __builtin_amdgcn_readlane(__builtin_bit_cast(int, acs), 63));
            SC_LAS float* sc = (SC_LAS float*)(lds + L_S) + cc * 256;
            sc[lane_] = dtv; sc[64 + lane_] = acs; sc[128 + lane_] = __expf(last - acs); sc[192 + lane_] = __expf(acs);
        }
    }
    for (int i = tid; i < 16384 / 16; i += 512) *(SC_LAS u32x4*)(lds + L_H + i * 16) = (u32x4){zu, zu, zu, zu};
    f32x16 hacc0, hacc1;
#pragma unroll
    for (int r = 0; r < 16; ++r) { hacc0[r] = 0.f; hacc1[r] = 0.f; }
    const int tid0 = tid;
    u32x4 xr, zr, br[2], cr[2];
#define SC_LOAD(t0_, XR, ZR) do { const int t_ = tid0; const size_t r1 = rowb + (t0_) + (t_ >> 3); \
        XR = *(const u32x4*)(P.xbc + r1 * 3072 + h * 64 + (t_ & 7) * 8); ZR = *(const u32x4*)(P.zp + r1 * 2048 + h * 64 + (t_ & 7) * 8); \
        _Pragma("unroll") for (int i = 0; i < 2; ++i) { const int p_ = t_ + 512 * i; const size_t r2 = rowb + (t0_) + (p_ >> 4); \
            br[i] = *(const u32x4*)(P.xbc + r2 * 3072 + 2048 + g * 128 + (p_ & 15) * 8); cr[i] = *(const u32x4*)(P.xbc + r2 * 3072 + 2560 + g * 128 + (p_ & 15) * 8); } } while (0)
    SC_LOAD(0, xr, zr);
    __syncthreads();
    for (int c = 0; c < SEQ / CH; ++c) {
        const int t0 = c * CH;
        int tid = tid0; asm volatile("" : "+v"(tid));
        const int lane = tid & 63, r32 = lane & 31, hi = lane >> 5, fr = lane & 15, fq = lane >> 4;
        const int orow = tid >> 3, ocg = tid & 7;
        SC_LAS float* s_dt = (SC_LAS float*)(lds + L_S) + c * 256; SC_LAS float* s_acs = s_dt + 64; SC_LAS float* s_dec = s_dt + 128; SC_LAS float* s_ea = s_dt + 192;
        {
            const float d = s_dt[orow], dd = d * s_dec[orow];
            u32x4 w1, w2;
#pragma unroll
            for (int i = 0; i < 4; ++i) { const float a = lo16(xr[i]), bq = hi16(xr[i]); w1[i] = cvtpk(a * d, bq * d); w2[i] = cvtpk(a * dd, bq * dd); }
            const int off = (ocg >> 2) * 4096 + img_off(orow) + (ocg & 3) * 16;
            *(SC_LAS u32x4*)(lds + L_XD + off) = w1; *(SC_LAS u32x4*)(lds + L_XW + off) = w2;
#pragma unroll
            for (int i = 0; i < 2; ++i) { const int p = tid + 512 * i, l = p >> 4, c16 = p & 15;
                *(SC_LAS u32x4*)(lds + L_B + (c16 >> 2) * 4096 + img_off(l) + (c16 & 3) * 16) = br[i];
                *(SC_LAS u32x4*)(lds + L_C + l * 256 + ((c16 ^ (l & 15)) << 4)) = cr[i]; }
        }
        const u32x4 xcur = xr, zcur = zr;
        if (c + 1 < SEQ / CH) SC_LOAD(t0 + CH, xr, zr);
        SC_BAR();
        f32x16 yacc;
#pragma unroll
        for (int r = 0; r < 16; ++r) yacc[r] = 0.f;
        const int yli = (wid >> 1) & 1, ypi = wid & 1;
        if (wid < 3) {
            const int si = (wid == 2) ? 1 : 0, li = (wid == 0) ? 0 : 1;
            const int srow = 32 * si + r32, lrow = 32 * li + r32;
            f32x16 cb;
#pragma unroll
            for (int r = 0; r < 16; ++r) cb[r] = 0.f;
            bf16x8 fa[8], fb[8];
#pragma unroll
            for (int ks = 0; ks < 8; ++ks) {
                const int chk = 2 * ks + hi;
                fa[ks] = *(const SC_LAS bf16x8*)(lds + L_B + (chk >> 2) * 4096 + img_off(srow) + (chk & 3) * 16);
                fb[ks] = *(const SC_LAS bf16x8*)(lds + L_C + lrow * 256 + ((chk ^ (lrow & 15)) << 4));
            }
            __builtin_amdgcn_sched_barrier(0);
#pragma unroll
            for (int ks = 0; ks < 8; ++ks) cb = __builtin_amdgcn_mfma_f32_32x32x16_bf16(fa[ks], fb[ks], cb, 0, 0, 0);
            const float al = s_acs[lrow];
#pragma unroll
            for (int q4 = 0; q4 < 4; ++q4) {
                const int s0 = 32 * si + 8 * q4 + 4 * hi;
                float gv[4];
#pragma unroll
                for (int e = 0; e < 4; ++e) { const int sidx = s0 + e; gv[e] = (sidx <= lrow) ? cb[4 * q4 + e] * __expf(al - s_acs[sidx]) : 0.f; }
                u32x2 w; w.x = cvtpk(gv[0], gv[1]); w.y = cvtpk(gv[2], gv[3]);
                *(SC_LAS u32x2*)(lds + L_G + lrow * 128 + (((s0 >> 3) ^ (lrow & 7)) << 4) + (s0 & 7) * 2) = w;
            }
        } else if (wid >= 4) {
            const int lrow = 32 * yli + r32, prow = 32 * ypi + r32;
            bf16x8 fa[8], fb[8];
#pragma unroll
            for (int ks = 0; ks < 8; ++ks) {
                const int chk = 2 * ks + hi;
                fa[ks] = *(const SC_LAS bf16x8*)(lds + L_C + lrow * 256 + ((chk ^ (lrow & 15)) << 4));
                fb[ks] = *(const SC_LAS bf16x8*)(lds + L_H + prow * 256 + ((chk ^ (prow & 15)) << 4));
            }
            __builtin_amdgcn_sched_barrier(0);
#pragma unroll
            for (int ks = 0; ks < 8; ++ks) yacc = __builtin_amdgcn_mfma_f32_32x32x16_bf16(fa[ks], fb[ks], yacc, 0, 0, 0);
        }
        SC_BAR();
        if (wid >= 4) {
#pragma unroll
            for (int r = 0; r < 16; ++r) yacc[r] *= s_ea[32 * yli + (r & 3) + 8 * (r >> 2) + 4 * hi];
            const int lrow = 32 * yli + r32;
            const int tbn = ((lane >> 4) & 1) * 32 + (lane & 3) * 8 + hi * 512 + ((lane & 15) >> 2) * 64;
            bf16x8 ga[4]; s16x4 xb0[4], xb1[4];
#pragma unroll
            for (int ks = 0; ks < 4; ++ks) {
                const int chk = 2 * ks + hi;
                ga[ks] = *(const SC_LAS bf16x8*)(lds + L_G + lrow * 128 + ((chk ^ (lrow & 7)) << 4));
                xb0[ks] = vtr(lds + L_XD + ypi * 4096 + ks * 1024 + tbn); xb1[ks] = vtr(lds + L_XD + ypi * 4096 + ks * 1024 + tbn + 256);
            }
            __builtin_amdgcn_sched_barrier(0);
#pragma unroll
            for (int ks = 0; ks < 4; ++ks) {
                if (ks < 2 * (yli + 1)) {
                    const bf16x8 bb = {xb0[ks][0], xb0[ks][1], xb0[ks][2], xb0[ks][3], xb1[ks][0], xb1[ks][1], xb1[ks][2], xb1[ks][3]};
                    yacc = __builtin_amdgcn_mfma_f32_32x32x16_bf16(ga[ks], bb, yacc, 0, 0, 0);
                }
            }
#pragma unroll
            for (int r = 0; r < 16; ++r) ((SC_LAS float*)(lds + L_Y))[(32 * yli + (r & 3) + 8 * (r >> 2) + 4 * hi) * 68 + 32 * ypi + r32] = yacc[r];
        } else {
            const float cd = __expf(s_acs[63]);
#pragma unroll
            for (int r = 0; r < 16; ++r) { hacc0[r] *= cd; hacc1[r] *= cd; }
            const int tb = ((lane >> 4) & 1) * 32 + (lane & 3) * 8 + (4 * hi + ((lane & 15) >> 2)) * 64;
            s16x4 a0[4], a1[4], b0[4], b1[4], c0[4], c1[4];
#pragma unroll
            for (int ks = 0; ks < 4; ++ks) {
                a0[ks] = vtr(lds + L_B + wid * 4096 + ks * 1024 + tb); a1[ks] = vtr(lds + L_B + wid * 4096 + ks * 1024 + 512 + tb);
                b0[ks] = vtr(lds + L_XW + ks * 1024 + tb); b1[ks] = vtr(lds + L_XW + ks * 1024 + 512 + tb);
                c0[ks] = vtr(lds + L_XW + 4096 + ks * 1024 + tb); c1[ks] = vtr(lds + L_XW + 4096 + ks * 1024 + 512 + tb);
            }
            __builtin_amdgcn_sched_barrier(0);
#pragma unroll
            for (int ks = 0; ks < 4; ++ks) {
                const bf16x8 a = {a0[ks][0], a0[ks][1], a0[ks][2], a0[ks][3], a1[ks][0], a1[ks][1], a1[ks][2], a1[ks][3]};
                const bf16x8 bb = {b0[ks][0], b0[ks][1], b0[ks][2], b0[ks][3], b1[ks][0], b1[ks][1], b1[ks][2], b1[ks][3]};
                const bf16x8 cc = {c0[ks][0], c0[ks][1], c0[ks][2], c0[ks][3], c1[ks][0], c1[ks][1], c1[ks][2], c1[ks][3]};
                hacc0 = __builtin_amdgcn_mfma_f32_32x32x16_bf16(a, bb, hacc0, 0, 0, 0);
                hacc1 = __builtin_amdgcn_mfma_f32_32x32x16_bf16(a, cc, hacc1, 0, 0, 0);
            }
#pragma unroll
            for (int q4 = 0; q4 < 4; ++q4) {
                const int n0 = 32 * wid + 8 * q4 + 4 * hi;
                u32x2 w0, w1; w0.x = cvtpk(hacc0[4 * q4 + 0], hacc0[4 * q4 + 1]); w0.y = cvtpk(hacc0[4 * q4 + 2], hacc0[4 * q4 + 3]);
                w1.x = cvtpk(hacc1[4 * q4 + 0], hacc1[4 * q4 + 1]); w1.y = cvtpk(hacc1[4 * q4 + 2], hacc1[4 * q4 + 3]);
                *(SC_LAS u32x2*)(lds + L_H + r32 * 256 + (((n0 >> 3) ^ (r32 & 15)) << 4) + (n0 & 7) * 2) = w0;
                *(SC_LAS u32x2*)(lds + L_H + (32 + r32) * 256 + (((n0 >> 3) ^ (r32 & 15)) << 4) + (n0 & 7) * 2) = w1;
            }
        }
        SC_BAR();
        {
            const SC_LAS float* yr = (const SC_LAS float*)(lds + L_Y) + orow * 68 + ocg * 8;
            const f32x4 y0 = *(const SC_LAS f32x4*)yr, y1 = *(const SC_LAS f32x4*)(yr + 4);
            float yv[8];
#pragma unroll
            for (int i = 0; i < 4; ++i) {
                const float ya = (i < 2) ? y0[2 * i] : y1[2 * i - 4], yb = (i < 2) ? y0[2 * i + 1] : y1[2 * i - 3];
                yv[2 * i] = (ya + dsk * lo16(xcur[i])) * lo16(zcur[i]); yv[2 * i + 1] = (yb + dsk * hi16(xcur[i])) * hi16(zcur[i]);
            }
            float ss = 0.f;
#pragma unroll
            for (int i = 0; i < 8; ++i) ss += yv[i] * yv[i];
            ss = xl_sum8(ss);
            if (ocg == 0) P.ssqp[(rowb + t0 + orow) * 32 + h] = ss;
            u32x4 w; w.x = cvtpk(yv[0], yv[1]); w.y = cvtpk(yv[2], yv[3]); w.z = cvtpk(yv[4], yv[5]); w.w = cvtpk(yv[6], yv[7]);
            if (!P.dry) *(u32x4*)(P.zp + (rowb + t0 + orow) * 2048 + h * 64 + ocg * 8) = w;
        }
    }
    __syncthreads();
#undef SC_LOAD
}
}
namespace mk {
#define GAS __attribute__((address_space(1)))
#define LAS __attribute__((address_space(3)))
typedef unsigned short bf16;
typedef unsigned v4u __attribute__((ext_vector_type(4)));
typedef float f32x4 __attribute__((ext_vector_type(4)));
typedef GAS unsigned gu32;
#define RLX_AGENT __ATOMIC_RELAXED, __HIP_MEMORY_SCOPE_AGENT
constexpr int NWAVES = 8;
constexpr int M = 16384, D = 1024, SEQ = 2048, NB = 8;
constexpr int SSD_NP = 5376, SSD_IN = 5152, SSD_DI = 2048, SSD_LD = 5120;
constexpr int AT_IN = 3072, DFF = 2816;
constexpr size_t MiB = 1u << 20;
constexpr size_t WS_CTL = 0, CTL_ZERO_BYTES = 64 * 1024;
constexpr size_t WS_CONST = 64 * 1024;
constexpr size_t WS_SSQ = 1 * MiB;
constexpr size_t WS_ROPE = 2 * MiB;
constexpr size_t WS_DT = 3 * MiB;
constexpr size_t WS_SSQP = 5 * MiB;
constexpr size_t WS_CP = 1 * MiB + 512 * 1024;
constexpr size_t WS_W = 7 * MiB;
constexpr size_t W_SSD_IN = 0, W_SSD_IN_SZ = (size_t)SSD_NP * D * 2;
constexpr size_t W_SSD_OUT = W_SSD_IN + 2 * W_SSD_IN_SZ, W_SSD_OUT_SZ = (size_t)D * SSD_DI * 2;
constexpr size_t W_AT_IN = W_SSD_OUT + 2 * W_SSD_OUT_SZ, W_AT_IN_SZ = (size_t)AT_IN * D * 2;
constexpr size_t W_AT_OUT = W_AT_IN + 2 * W_AT_IN_SZ, W_AT_OUT_SZ = (size_t)D * D * 2;
constexpr size_t W_UP = W_AT_OUT + 2 * W_AT_OUT_SZ, W_UP_SZ = (size_t)2 * DFF * D * 2;
constexpr size_t W_DOWN = W_UP + 4 * W_UP_SZ, W_DOWN_SZ = (size_t)D * DFF * 2;
constexpr size_t W_TOTAL = W_DOWN + 4 * W_DOWN_SZ;
constexpr size_t WS_XB = ((WS_W + W_TOTAL + MiB - 1) / MiB) * MiB;
constexpr size_t XB_PAD_FRONT = 4 * D * 2, XB_BYTES = (size_t)(M + 260) * D * 2;
constexpr size_t WS_BIG = ((WS_XB + XB_BYTES + MiB - 1) / MiB) * MiB;
constexpr size_t BIG_BYTES = (size_t)M * SSD_LD * 2;
constexpr size_t WS_DBG = WS_BIG + BIG_BYTES;
constexpr size_t WS_END = WS_DBG + (size_t)M * D * 2;
static_assert(WS_END <= 352 * MiB, "workspace map exceeds the guaranteed 352 MiB");
constexpr int CW_BAR = 1024;
constexpr int RING_BYTES = 131072, EPI_OFF = RING_BYTES, EPI_BYTES = 26624, MISC_OFF = EPI_OFF + EPI_BYTES;
constexpr int LDS_BYTES = 158720;
static_assert(MISC_OFF + 1024 <= LDS_BYTES && attn::LDS_BYTES <= RING_BYTES && scan::LDS_BYTES <= RING_BYTES, "LDS map");

#define LDS_WAIT() asm volatile("s_waitcnt lgkmcnt(0)" ::: "memory")
__device__ __forceinline__ unsigned f2bf(float f) { unsigned u = __builtin_bit_cast(unsigned, f); return (u + 0x7fffu + ((u >> 16) & 1u)) >> 16; }
__device__ __forceinline__ unsigned pk2(float lo, float hi) { return f2bf(lo) | (f2bf(hi) << 16); }
template <bool F16> __device__ __forceinline__ unsigned pk2x(float lo, float hi) { if constexpr (F16) return epi::pk_f16(lo, hi); else return pk2(lo, hi); }

#define XB_TMO      128
#define XB_XCNT(j)  (256  + 64 * (j))
#define XB_XSUB(j)  (1280 + 64 * (j))
#define XB_XGEN(j)  (2304 + 64 * (j))
#define XB_TOP      3328
#define XB_TOPGEN   3392
#define XCD_BAR_WORDS 3456
#define XB_SPIN_CAP (1u << 20)
__device__ __forceinline__ unsigned xb_ld(unsigned* p)              { return __hip_atomic_load(p, __ATOMIC_RELAXED, __HIP_MEMORY_SCOPE_AGENT); }
__device__ __forceinline__ unsigned xb_add(unsigned* p, unsigned v) { return __hip_atomic_fetch_add(p, v, __ATOMIC_RELAXED, __HIP_MEMORY_SCOPE_AGENT); }
__device__ __forceinline__ unsigned xb_xcc_id() { return (unsigned)__builtin_amdgcn_s_getreg((3 << 11) | 20) & 0xFu; }
#define XB_SPIN(cond, bar) do { unsigned _sp = 0; while (cond) { __builtin_amdgcn_s_sleep(1); \
    if ((++_sp & 255u) == 0u) { if (xb_ld(&(bar)[XB_TMO])) break; if (_sp > XB_SPIN_CAP) { atomicAdd(&(bar)[XB_TMO], 1u); break; } } } } while (0)
struct XcdBarrier { unsigned* bar; unsigned x; volatile LAS unsigned* st; };
__device__ __forceinline__ XcdBarrier xcd_barrier_post(unsigned* bar, volatile LAS unsigned* st, bool leader) {
    XcdBarrier b; b.bar = bar; b.x = xb_xcc_id(); b.st = st;
    if (leader) (void)xb_add(&bar[XB_XCNT(b.x)], 1u);
    return b;
}
__device__ __forceinline__ void xcd_barrier_complete(unsigned* bar, unsigned x, unsigned& nloc, unsigned& nx) {
    const unsigned G = gridDim.x * gridDim.y * gridDim.z;
    unsigned sum, cnt, mine, sp = 0u;
    for (;;) {
        sum = 0u; cnt = 0u; mine = 0u;
#pragma unroll
        for (unsigned j = 0; j < 16; ++j) { const unsigned c = xb_ld(&bar[XB_XCNT(j)]); sum += c; cnt += (c > 0u) ? 1u : 0u; mine = (j == x) ? c : mine; }
        if (sum == G) break;
        __builtin_amdgcn_s_sleep(1);
        if ((++sp & 255u) == 0u) { if (xb_ld(&bar[XB_TMO])) break; if (sp > XB_SPIN_CAP) { atomicAdd(&bar[XB_TMO], 1u); break; } }
    }
    nloc = mine > 0u ? mine : 1u; nx = cnt > 0u ? cnt : 1u;
}
__device__ __forceinline__ void xcd_barrier(const XcdBarrier& b, const int wave_s) {
    asm volatile("s_waitcnt vmcnt(0)" ::: "memory");
    __syncthreads();
    if (wave_s == 0 && HW_LANE() == 0) {
        unsigned* bar = b.bar; asm volatile("" : "+s"(bar));
        __builtin_amdgcn_s_waitcnt(0);
        unsigned nloc = b.st[0], nx = b.st[1];
        if (nloc == 0u) { xcd_barrier_complete(bar, b.x, nloc, nx); b.st[0] = nloc; b.st[1] = nx; }
        const unsigned old = xb_add(&bar[XB_XSUB(b.x)], 1u);
        const unsigned gen = old / nloc;
        if (old + 1u == (gen + 1u) * nloc) {
            __builtin_amdgcn_fence(__ATOMIC_RELEASE, "agent");
            asm volatile("s_waitcnt vmcnt(0)" ::: "memory");
            const unsigned og = xb_add(&bar[XB_TOP], 1u);
            const unsigned tg = og / nx;
            if (og + 1u == (tg + 1u) * nx) xb_add(&bar[XB_TOPGEN], 1u);
            else XB_SPIN(xb_ld(&bar[XB_TOPGEN]) == tg, bar);
            __builtin_amdgcn_fence(__ATOMIC_ACQUIRE, "agent");
            xb_add(&bar[XB_XGEN(b.x)], 1u);
            asm volatile("s_waitcnt vmcnt(0)" ::: "memory");
        } else {
            XB_SPIN(xb_ld(&bar[XB_XGEN(b.x)]) == gen, bar);
            __builtin_amdgcn_fence(__ATOMIC_ACQUIRE, "agent");
            asm volatile("s_waitcnt vmcnt(0)" ::: "memory");
        }
    }
    __syncthreads();
}

__device__ __forceinline__ unsigned long long ldarg(LAS unsigned long long* AP, int i) {
    asm volatile("" : "+s"(i));
    const unsigned long long v = AP[i];
    return ((unsigned long long)(unsigned)__builtin_amdgcn_readfirstlane((int)(v >> 32)) << 32) | (unsigned long long)(unsigned)__builtin_amdgcn_readfirstlane((int)v);
}
struct Args { const void* in[25]; float* out; unsigned char* ws; int ph_lo, ph_hi; int dbg, pad; };

__device__ __forceinline__ float wave_sum(float v) {
    return xl_sum64(v);
}
template <bool F16  , class RowMap>
__device__ __forceinline__ void transpose_item(const float* W, int K, int N, const float* gain, int gmask, float gscale, bf16* WT, const RowMap& rm, LAS float* scr, int item, int item2, int lane) {
    const int nblk = N / 32, rs = lane >> 3, c4 = lane & 7, c = lane & 7;
    f32x4 va[8], vb[8]; float ga[8], gb[8];
    const int kA = 64 * (item / nblk), nA = 32 * (item % nblk);
    const int it2 = item2 < 0 ? item : item2; const int kB = 64 * (it2 / nblk), nB = 32 * (it2 % nblk);
#pragma unroll
    for (int i = 0; i < 8; ++i) { const int kk = 8 * i + rs; va[i] = *(const f32x4*)(W + (size_t)(kA + kk) * N + nA + 4 * c4); ga[i] = gain ? gain[(kA + kk) & gmask] * gscale : 1.0f; }
    if (item2 >= 0) {
#pragma unroll
        for (int i = 0; i < 8; ++i) { const int kk = 8 * i + rs; vb[i] = *(const f32x4*)(W + (size_t)(kB + kk) * N + nB + 4 * c4); gb[i] = gain ? gain[(kB + kk) & gmask] * gscale : 1.0f; }
    }
#pragma unroll
    for (int h = 0; h < 2; ++h) {
        if (h == 1 && item2 < 0) break;
        const int k0 = h ? kB : kA, n0 = h ? nB : nA;
#pragma unroll
        for (int i = 0; i < 8; ++i) { const int kk = 8 * i + rs; LAS float* d = scr + kk * 33 + 4 * c4; const f32x4 v = h ? vb[i] : va[i]; const float g = h ? gb[i] : ga[i]; d[0] = v[0] * g; d[1] = v[1] * g; d[2] = v[2] * g; d[3] = v[3] * g; }
        LDS_WAIT(); asm volatile("" ::: "memory");
#pragma unroll
        for (int j = 0; j < 4; ++j) { const int n = (lane >> 3) + 8 * j; const LAS float* sp = scr + (8 * c) * 33 + n;
            v4u o; o.x = pk2x<F16>(sp[0 * 33], sp[1 * 33]); o.y = pk2x<F16>(sp[2 * 33], sp[3 * 33]); o.z = pk2x<F16>(sp[4 * 33], sp[5 * 33]); o.w = pk2x<F16>(sp[6 * 33], sp[7 * 33]);
            *(GAS v4u*)(WT + (size_t)rm(n0 + n) * K + k0 + 8 * c) = o; }
        LDS_WAIT(); asm volatile("" ::: "memory");
    }
}
struct RowId { __device__ __forceinline__ int operator()(int n) const { return n; } };
struct RowUp { __device__ __forceinline__ int operator()(int n) const { const int u = n >= DFF, ch = u ? n - DFF : n; return (ch >> 7) * 256 + u * 128 + (ch & 127); } };

__global__ void __launch_bounds__(NWAVES * 64, 2) mega_fwd(Args args) {
    extern __shared__ __attribute__((aligned(16))) unsigned char lds_raw[];
    LAS unsigned char* lds = (LAS unsigned char*)lds_raw;
    volatile LAS unsigned* MISC = (volatile LAS unsigned*)(lds + MISC_OFF);
    const int G = gridDim.x; const int bx = blockIdx.x; const int vcu = (G % 8 == 0) ? (bx % 8) * (G / 8) + bx / 8 : bx;
    gu32* ctl = (gu32*)(args.ws + WS_CTL);
    const int wave_s = __builtin_amdgcn_readfirstlane((int)threadIdx.x >> 6);
    if (wave_s == 0) MISC[HW_LANE()] = 0u;
    __syncthreads();
    XcdBarrier bar = xcd_barrier_post((unsigned*)ctl + CW_BAR, MISC + 8, wave_s == 0 && HW_LANE() == 0);
#define GRID_BAR() xcd_barrier(bar, wave_s)
    LAS unsigned long long* AP = (LAS unsigned long long*)(lds + MISC_OFF + 256);
    if (wave_s == 0 && HW_LANE() < 27) AP[HW_LANE()] = ((const unsigned long long*)&args)[HW_LANE()];
    __syncthreads();
#define ARGP(T, i) ((T)(GAS void*)ldarg(AP, i))
#define x_in   ARGP(const float*, 0)
#define pos    ARGP(const int*, 1)
#define nmg    ARGP(const float*, 2)
#define nfg    ARGP(const float*, 3)
#define s_inw  ARGP(const float*, 4)
#define s_cw   ARGP(const float*, 5)
#define s_cb   ARGP(const float*, 6)
#define s_dtb  ARGP(const float*, 7)
#define s_alog ARGP(const float*, 8)
#define s_d    ARGP(const float*, 9)
#define s_ng   ARGP(const float*, 10)
#define s_ow   ARGP(const float*, 11)
#define a_inw  ARGP(const float*, 12)
#define a_qg   ARGP(const float*, 13)
#define a_kg   ARGP(const float*, 14)
#define a_lq1  ARGP(const float*, 15)
#define a_lk1  ARGP(const float*, 16)
#define a_lq2  ARGP(const float*, 17)
#define a_lk2  ARGP(const float*, 18)
#define a_sg   ARGP(const float*, 19)
#define a_ow   ARGP(const float*, 20)
#define f_uw   ARGP(const float*, 21)
#define f_cw   ARGP(const float*, 22)
#define f_cb   ARGP(const float*, 23)
#define f_dw   ARGP(const float*, 24)
#define xout   ARGP(float*, 25)
#define ws     ARGP(unsigned char*, 26)
#define cst    ((float*)(ws + WS_CONST))
#define SSQ    ((float*)(ws + WS_SSQ))
#define ROPE   ((float*)(ws + WS_ROPE))
#define DT     ((float*)(ws + WS_DT))
#define SSQP   ((float*)(ws + WS_SSQP))
#define Wb     ((bf16*)(ws + WS_W))
#define XB     ((bf16*)(ws + WS_XB + XB_PAD_FRONT))
#define BIG    ((bf16*)(ws + WS_BIG))
#define XLO    ((bf16*)(ws + WS_DBG))
#define CPT    ((float*)(ws + WS_CP))
#define ZPL    ((bf16*)(ws + WS_BIG))
#define XBCPL  ((bf16*)(ws + WS_BIG + (size_t)M * SSD_DI * 2))
#define CONV_MATRIX(kind_, idx_, worker_, nworkers_) do { \
        int tid_ = wave_s * 64 + HW_LANE(); asm volatile("" : "+v"(tid_)); const int lane_ = tid_ & 63, wave_ = wave_s; \
        LAS float* scr_ = (LAS float*)(lds + wave_ * 16384); const int j_ = (idx_); \
        constexpr int I_SI = (D / 64) * (SSD_IN / 32), I_SO = (SSD_DI / 64) * (D / 32), I_AI = (D / 64) * (AT_IN / 32), I_AO = (D / 64) * (D / 32), I_UP = (D / 64) * (2 * DFF / 32), I_DN = (DFF / 64) * (D / 32); \
        if ((kind_) == 0) { for (int it = (worker_); it < I_SI; it += 2 * (nworkers_)) transpose_item<(RES_F16 != 0)>(s_inw + (size_t)j_ * D * SSD_IN, D, SSD_IN, nmg + (2 * j_) * D, 1023, 1.0f, (bf16*)((char*)Wb + W_SSD_IN + j_ * W_SSD_IN_SZ), RowId(), scr_, it, (it + (nworkers_) < I_SI) ? it + (nworkers_) : -1, lane_); \
            v4u* p_ = (v4u*)((char*)Wb + W_SSD_IN + j_ * W_SSD_IN_SZ + (size_t)SSD_IN * D * 2); const int n16_ = (SSD_NP - SSD_IN) * D * 2 / 16; \
            unsigned z_ = 0u; asm volatile("" : "+v"(z_)); for (int i = (worker_) * 64 + lane_; i < n16_; i += (nworkers_) * 64) p_[i] = (v4u){z_, z_, z_, z_}; } \
        else if ((kind_) == 1) { for (int it = (worker_); it < I_SO; it += 2 * (nworkers_)) transpose_item<false>(s_ow + (size_t)j_ * SSD_DI * D, SSD_DI, D, s_ng + j_ * SSD_DI, 2047, 1.0f, (bf16*)((char*)Wb + W_SSD_OUT + j_ * W_SSD_OUT_SZ), RowId(), scr_, it, (it + (nworkers_) < I_SO) ? it + (nworkers_) : -1, lane_); } \
        else if ((kind_) == 2) { for (int it = (worker_); it < I_AI; it += 2 * (nworkers_)) transpose_item<(RES_F16 != 0)>(a_inw + (size_t)j_ * D * AT_IN, D, AT_IN, nmg + (2 * j_ + 1) * D, 1023, 1.0f, (bf16*)((char*)Wb + W_AT_IN + j_ * W_AT_IN_SZ), RowId(), scr_, it, (it + (nworkers_) < I_AI) ? it + (nworkers_) : -1, lane_); } \
        else if ((kind_) == 3) { const float li_ = 0.8f - 0.6f * expf(-0.3f * (float)(2 * j_ + 1)); \
            for (int it = (worker_); it < I_AO; it += 2 * (nworkers_)) transpose_item<false>(a_ow + (size_t)j_ * D * D, D, D, a_sg + j_ * 128, 127, 1.0f - li_, (bf16*)((char*)Wb + W_AT_OUT + j_ * W_AT_OUT_SZ), RowId(), scr_, it, (it + (nworkers_) < I_AO) ? it + (nworkers_) : -1, lane_); } \
        else if ((kind_) == 4) { for (int it = (worker_); it < I_UP; it += 2 * (nworkers_)) transpose_item<(RES_F16 != 0)>(f_uw + (size_t)j_ * D * 2 * DFF, D, 2 * DFF, nfg + j_ * D, 1023, 1.0f, (bf16*)((char*)Wb + W_UP + j_ * W_UP_SZ), RowUp(), scr_, it, (it + (nworkers_) < I_UP) ? it + (nworkers_) : -1, lane_); } \
        else { for (int it = (worker_); it < I_DN; it += 2 * (nworkers_)) transpose_item<false>(f_dw + (size_t)j_ * DFF * D, DFF, D, nullptr, 0, 1.0f, (bf16*)((char*)Wb + W_DOWN + j_ * W_DOWN_SZ), RowId(), scr_, it, (it + (nworkers_) < I_DN) ? it + (nworkers_) : -1, lane_); } \
    } while (0)
#define RUN_FILL(fid_, nwg_, part_) do { const int idle0_ = (nwg_) % G; if (bx >= idle0_ && idle0_ > 0) { \
        const int wk_ = (bx - idle0_) * NWAVES + wave_s, nwk_ = (G - idle0_) * NWAVES; \
          \
        unsigned long long code_ = (part_) == 0 ? ((fid_) == 0 ? 0xff1040ull : (fid_) == 1 ? 0xff51ull : (fid_) == 2 ? 0xff11ull : (fid_) == 3 ? 0xff42ull : 0xff53ull) \
                                                : ((fid_) == 0 ? 0xff302050ull : (fid_) == 1 ? 0xff41ull : (fid_) == 2 ? 0xff01ull : (fid_) == 3 ? 0xff312152ull : 0xff43ull); \
        for (;;) { const int e_ = (int)(code_ & 0xffu); if (e_ == 0xff) break; code_ >>= 8; CONV_MATRIX(e_ >> 4, e_ & 15, wk_, nwk_); } } } while (0)
    const int lo = args.ph_lo, hi = args.ph_hi;
    int phase = 0;
#define IN_PHASE() (phase >= lo && phase < hi)
#define END_PHASE(ty) do { if (IN_PHASE() && phase + 1 < hi) GRID_BAR(); ++phase; } while (0)
#ifndef PROBE_EPI_MODE
#define PROBE_EPI_MODE 0
#endif
#ifdef PROBE_DUP
#define REP_BEGIN(ty) _Pragma("unroll") for (int rep_ = ((ty) == PROBE_DUP ? 0 : 1); rep_ < 2; ++rep_) { const int dry = (rep_ == 0);
#define REP_END() if (dry) GRID_BAR(); }
#else
#define REP_BEGIN(ty) { const int dry = 0;
#define REP_END() }
#endif

    if (IN_PHASE()) { REP_BEGIN(0)
        int tid = wave_s * 64 + HW_LANE(); asm volatile("" : "+v"(tid));
        const int lane = tid & 63, wave = wave_s;
        LAS float* scr = (LAS float*)(lds + wave * 16384);
        const int gw = vcu * NWAVES + wave, NGW = G * NWAVES;
        CONV_MATRIX(0, 0, gw, NGW);
        { unsigned z_ = 0u; asm volatile("" : "+v"(z_));
          v4u* p = (v4u*)(ws + WS_XB); for (int i = vcu * 512 + tid; i < (int)(XB_PAD_FRONT / 16); i += G * 512) p[i] = (v4u){z_, z_, z_, z_};
          v4u* q = (v4u*)((char*)XB + (size_t)M * D * 2); for (int i = vcu * 512 + tid; i < 256 * D * 2 / 16; i += G * 512) q[i] = (v4u){z_, z_, z_, z_}; }
        for (int m = gw; m < M; m += NGW) {
            const f32x4* xr = (const f32x4*)(x_in + (size_t)m * D) + lane; float s = 0.f;
            unsigned long long* o8 = (unsigned long long*)(XB + (size_t)m * D) + lane;
#pragma unroll
            for (int j = 0; j < 4; ++j) { const f32x4 v = xr[64 * j]; s += (v[0] * v[0] + v[1] * v[1]) + (v[2] * v[2] + v[3] * v[3]); o8[64 * j] = (unsigned long long)pk2x<(RES_F16 != 0)>(v[0], v[1]) | ((unsigned long long)pk2x<(RES_F16 != 0)>(v[2], v[3]) << 32); }
            s = wave_sum(s);
            if (lane < 4) SSQ[(size_t)m * 4 + lane] = (lane == 0) ? s : 0.f;
            if (lane >= 16 && lane < 32) { const int i = lane & 7; const float invf = powf(500000.0f, -(float)(2 * i) / 16.0f); const float ang = (float)pos[m] * invf; ROPE[(size_t)m * 16 + (lane - 16)] = (lane < 24) ? cosf(ang) : sinf(ang); }
        }
        for (int i = vcu * 512 + tid; i < 2 * SSD_NP; i += G * 512) {
            const int j = i / SSD_NP, c = i % SSD_NP; float pb = 0.f, p0 = 0.f, p1 = 0.f, p2 = 0.f, p3 = 0.f;
            if (c < 2048) p3 = 1.f;
            else if (c < 5120) { const int ch = c - 2048; const float* w = s_cw + (size_t)j * 4 * 3072; pb = s_cb[(size_t)j * 3072 + ch]; p0 = w[ch]; p1 = w[3072 + ch]; p2 = w[2 * 3072 + ch]; p3 = w[3 * 3072 + ch]; }
            else if (c < 5152) { pb = s_dtb[j * 32 + (c - 5120)]; p3 = 1.f; }
            float* t = CPT + (size_t)j * 5 * SSD_NP; t[c] = pb; t[SSD_NP + c] = p0; t[2 * SSD_NP + c] = p1; t[3 * SSD_NP + c] = p2; t[4 * SSD_NP + c] = p3;
        }
        if (bx == 0 && wave == 0) {
            for (int j = 0; j < 2; ++j) {
                float mq = fabsf(a_qg[j * 64 + lane]), mkk = fabsf(a_kg[j * 64 + lane]);
                float d1 = a_lq1[j * 64 + lane] * a_lk1[j * 64 + lane], d2 = a_lq2[j * 64 + lane] * a_lk2[j * 64 + lane];
                mq = xl_max64(mq); mkk = xl_max64(mkk); d1 = xl_sum64(d1); d2 = xl_sum64(d2);
                const float li = 0.8f - 0.6f * expf(-0.3f * (float)(2 * j + 1));
                if (lane == 0) { cst[j] = mq * mkk * 64.0f * 0.125f * 1.4426950408889634f * 1.002f + 0.01f; cst[2 + j] = expf(d1) - expf(d2) + li; }
            }
        }
    REP_END() }
    END_PHASE(0);

    for (int layer = 0; layer < 4; ++layer) {
        const int j = layer >> 1;
        if ((layer & 1) == 0) {
            if (IN_PHASE()) { REP_BEGIN(1)
#ifdef PROBE_PLAIN_SSDIN
                if (dry) {
                    pg8::Gemm g0{XB, (const bf16*)((const char*)Wb + W_SSD_IN + j * W_SSD_IN_SZ), D, D, 256, 0};
                    pg8::StaticOrder S0; S0.init(64, 20, G, bx);
                    epi::EpiSsdIn E0{BIG, DT, s_dtb + j * 32, SSQ};
                    pg8::gemm_phase(lds, lds + EPI_OFF, g0, S0, E0, wave_s);
                } else
#endif
                {
                pg8::Gemm g{XB, (const bf16*)((const char*)Wb + W_SSD_IN + j * W_SSD_IN_SZ), D, D, 253, -3};
                pg8::StaticOrder S; S.init(65, SSD_NP / 256, G, bx);
                epi::EpiSsdConv E{ZPL, XBCPL, DT, SSQ, CPT + (size_t)j * 5 * SSD_NP};
                RUN_FILL(layer == 0 ? 0 : 3, 65 * (SSD_NP / 256), 0); __syncthreads();
                pg8::gemm_phase(lds, lds + EPI_OFF, g, S, E, wave_s);
                RUN_FILL(layer == 0 ? 0 : 3, 65 * (SSD_NP / 256), 1);
                }
            REP_END() }
            END_PHASE(1);
            if (IN_PHASE()) { REP_BEGIN(2)
                scan::Params sp{XBCPL, ZPL, DT, s_alog + j * 32, s_d + j * 32, SSQP, dry};
                for (int u = vcu; u < NB * 32; u += G) scan::unit(sp, u >> 5, u & 31, (LAS char*)lds, wave_s);
            REP_END() }
            END_PHASE(2);
            if (IN_PHASE()) { REP_BEGIN(4)
                pg8::Gemm g{ZPL, (const bf16*)((const char*)Wb + W_SSD_OUT + j * W_SSD_OUT_SZ), SSD_DI, SSD_DI, 256, 0};
                pg8::StaticOrder S; S.init(M / 256, D / 256, G, bx);
                if (layer == 0) { epi::EpiResidualG<1> E{x_in, XB, XLO, SSQ, SSQP, dry}; pg8::gemm_phase(lds, lds + EPI_OFF, g, S, E, wave_s); }
                else { epi::EpiResidualG<0> E{nullptr, XB, XLO, SSQ, SSQP, dry}; pg8::gemm_phase(lds, lds + EPI_OFF, g, S, E, wave_s); }
            REP_END() }
            END_PHASE(4);
        } else {
            if (IN_PHASE()) { REP_BEGIN(5)
                pg8::Gemm g{XB, (const bf16*)((const char*)Wb + W_AT_IN + j * W_AT_IN_SZ), D, D, 256, 0};
                pg8::StaticOrder S; S.init(M / 256, AT_IN / 256, G, bx);
                epi::EpiQKV E{BIG, SSQ, a_qg + j * 64, a_kg + j * 64, ROPE};
                pg8::gemm_phase(lds, lds + EPI_OFF, g, S, E, wave_s);
            REP_END() }
            END_PHASE(5);
            if (IN_PHASE()) { REP_BEGIN(6)
                attn::Params ap{BIG, cst[j], cst[2 + j], dry};
                for (int pi = vcu; pi < 512; pi += G) {
                    const int bh = pi >> 3, s = pi & 7;
#ifdef PROBE_ATT_MODE
                    if (dry) { attn::unit<PROBE_ATT_MODE>(ap, bh >> 3, bh & 7, s, (LAS char*)lds, wave_s); attn::unit<PROBE_ATT_MODE>(ap, bh >> 3, bh & 7, 15 - s, (LAS char*)lds, wave_s); } else
#endif
                    { attn::unit(ap, bh >> 3, bh & 7, s, (LAS char*)lds, wave_s);
                      attn::unit(ap, bh >> 3, bh & 7, 15 - s, (LAS char*)lds, wave_s); }
                }
            REP_END() }
            END_PHASE(6);
            if (IN_PHASE()) { REP_BEGIN(7)
                pg8::Gemm g{BIG, (const bf16*)((const char*)Wb + W_AT_OUT + j * W_AT_OUT_SZ), AT_IN, D, 256, 0};
                pg8::StaticOrder S; S.init(M / 256, D / 256, G, bx);
                epi::EpiResidual<0> E{nullptr, nullptr, XB, XLO, SSQ, dry};
                pg8::gemm_phase(lds, lds + EPI_OFF, g, S, E, wave_s);
            REP_END() }
            END_PHASE(7);
        }
        if (IN_PHASE()) { REP_BEGIN(8)
            pg8::Gemm g{XB, (const bf16*)((const char*)Wb + W_UP + layer * W_UP_SZ), D, D, 254, -2};
            pg8::StaticOrder S; S.init(65, 2 * DFF / 256, G, bx);
            epi::EpiConvGate E{BIG, SSQ, f_cw + (size_t)layer * 3 * 2 * DFF, f_cb + (size_t)layer * 2 * DFF, dry * PROBE_EPI_MODE};
            if (layer < 3) { RUN_FILL(layer == 0 ? 1 : (layer == 1 ? 2 : 4), 65 * (2 * DFF / 256), 0); __syncthreads(); }
            pg8::gemm_phase(lds, lds + EPI_OFF, g, S, E, wave_s);
            if (layer < 3) RUN_FILL(layer == 0 ? 1 : (layer == 1 ? 2 : 4), 65 * (2 * DFF / 256), 1);
        REP_END() }
        END_PHASE(8);
        if (IN_PHASE()) { REP_BEGIN(9)
            pg8::Gemm g{BIG, (const bf16*)((const char*)Wb + W_DOWN + layer * W_DOWN_SZ), DFF, DFF, 256, 0};
            pg8::StaticOrder S; S.init(M / 256, D / 256, G, bx);
            if (layer == 3) { epi::EpiResidual<2> E{nullptr, xout, XB, XLO, SSQ, dry}; pg8::gemm_phase(lds, lds + EPI_OFF, g, S, E, wave_s); }
            else { epi::EpiResidual<0> E{nullptr, nullptr, XB, XLO, SSQ, dry}; pg8::gemm_phase(lds, lds + EPI_OFF, g, S, E, wave_s); }
        REP_END() }
        END_PHASE(9);
    }
#ifdef PROBE_EXTRA_BARS
    for (int i_ = 0; i_ < PROBE_EXTRA_BARS; ++i_) GRID_BAR();
#endif
}
#undef CONV_MATRIX
#undef RUN_FILL
#undef x_in
#undef pos
#undef nmg
#undef nfg
#undef s_inw
#undef s_cw
#undef s_cb
#undef s_dtb
#undef s_alog
#undef s_d
#undef s_ng
#undef s_ow
#undef a_inw
#undef a_qg
#undef a_kg
#undef a_lq1
#undef a_lk1
#undef a_lq2
#undef a_lk2
#undef a_sg
#undef a_ow
#undef f_uw
#undef f_cw
#undef f_cb
#undef f_dw
#undef xout
#undef ws
#undef cst
#undef SSQ
#undef ROPE
#undef DT
#undef SSQP
#undef Wb
#undef XB
#undef BIG
#undef XLO
#undef CPT
#undef ZPL
#undef XBCPL
#undef ARGP
constexpr int N_PHASES = 1 + 2 * 5 + 2 * 5;

static int g_grid = 0;
static void launch(void* const* d_in, float* d_out, void* d_ws, int ph_lo, int ph_hi, hipStream_t stream) {
    if (g_grid == 0) {
        int dev = 0, cus = 0;
        if (hipGetDevice(&dev) != hipSuccess || hipDeviceGetAttribute(&cus, hipDeviceAttributeMultiprocessorCount, dev) != hipSuccess) { fprintf(stderr, "device query failed\n"); g_grid = -1; return; }
        if (hipFuncSetAttribute((const void*)mega_fwd, hipFuncAttributeMaxDynamicSharedMemorySize, LDS_BYTES) != hipSuccess) { fprintf(stderr, "hipFuncSetAttribute failed\n"); g_grid = -1; return; }
        int per_cu = 0;
        (void)hipOccupancyMaxActiveBlocksPerMultiprocessor(&per_cu, (const void*)mega_fwd, NWAVES * 64, LDS_BYTES);
        (void)hipGetLastError();
        g_grid = cus;
        fprintf(stderr, "mega_fwd: %d CUs, occupancy query %d per CU\n", cus, per_cu);
    }
    if (g_grid < 0) return;
    (void)hipMemsetAsync((char*)d_ws + WS_CTL, 0, CTL_ZERO_BYTES, stream);
    Args a{};
    for (int i = 0; i < 25; ++i) a.in[i] = d_in[i];
    a.out = d_out; a.ws = (unsigned char*)d_ws; a.ph_lo = ph_lo; a.ph_hi = ph_hi;
    void* params[] = {&a};
    hipError_t e = hipLaunchCooperativeKernel((const void*)mega_fwd, dim3(g_grid), dim3(NWAVES * 64), params, LDS_BYTES, stream);
    if (e != hipSuccess) fprintf(stderr, "cooperative launch failed: %s (grid %d)\n", hipGetErrorString(e), g_grid);
}
}
extern "C" void kernel_launch(void* const* d_in, const int* in_sizes, int n_in, void* d_out, int out_size, void* d_ws, size_t ws_size, hipStream_t stream) {
    (void)in_sizes; (void)n_in; (void)out_size; (void)ws_size;
    mk::launch(d_in, (float*)d_out, d_ws, 0, mk::N_PHASES, stream);
}
```

```cpp
#include <hip/hip_runtime.h>
#include <stdint.h>
#include <math.h>
#include <cstdio>
__device__ __forceinline__ int hw_lane_() { unsigned m = ~0u; asm volatile("" : "+s"(m)); return (int)__builtin_amdgcn_mbcnt_hi(m, __builtin_amdgcn_mbcnt_lo(m, 0u)); }
#define HW_LANE() hw_lane_()
template <int CTRL> __device__ __forceinline__ float xl_dpp(float v) { return __builtin_bit_cast(float, __builtin_amdgcn_mov_dpp(__builtin_bit_cast(int, v), CTRL, 0xF, 0xF, true)); }
__device__ __forceinline__ float xl_swap16_sum(float v) { const auto r = __builtin_amdgcn_permlane16_swap(__builtin_bit_cast(unsigned, v), __builtin_bit_cast(unsigned, v), false, false); const unsigned r0 = r[0], r1 = r[1]; return __builtin_bit_cast(float, r0) + __builtin_bit_cast(float, r1); }
__device__ __forceinline__ float xl_swap32_sum(float v) { const auto r = __builtin_amdgcn_permlane32_swap(__builtin_bit_cast(unsigned, v), __builtin_bit_cast(unsigned, v), false, false); const unsigned r0 = r[0], r1 = r[1]; return __builtin_bit_cast(float, r0) + __builtin_bit_cast(float, r1); }
__device__ __forceinline__ float xl_swap16_max(float v) { const auto r = __builtin_amdgcn_permlane16_swap(__builtin_bit_cast(unsigned, v), __builtin_bit_cast(unsigned, v), false, false); const unsigned r0 = r[0], r1 = r[1]; return fmaxf(__builtin_bit_cast(float, r0), __builtin_bit_cast(float, r1)); }
__device__ __forceinline__ float xl_swap32_max(float v) { const auto r = __builtin_amdgcn_permlane32_swap(__builtin_bit_cast(unsigned, v), __builtin_bit_cast(unsigned, v), false, false); const unsigned r0 = r[0], r1 = r[1]; return fmaxf(__builtin_bit_cast(float, r0), __builtin_bit_cast(float, r1)); }
__device__ __forceinline__ float xl_xor16(float v, bool odd16) { const auto r = __builtin_amdgcn_permlane16_swap(__builtin_bit_cast(unsigned, v), __builtin_bit_cast(unsigned, v), false, false); const unsigned r0 = r[0], r1 = r[1]; return __builtin_bit_cast(float, odd16 ? r0 : r1); }
__device__ __forceinline__ float xl_sum4(float v) { v += xl_dpp<0xB1>(v); v += xl_dpp<0x4E>(v); return v; }
__device__ __forceinline__ float xl_sum8(float v) { v = xl_sum4(v); v += xl_dpp<0x141>(v); return v; }
__device__ __forceinline__ float xl_sum16(float v) { v = xl_sum8(v); v += xl_dpp<0x140>(v); return v; }
__device__ __forceinline__ float xl_sum64(float v) { v = xl_sum16(v); v = xl_swap16_sum(v); return xl_swap32_sum(v); }
__device__ __forceinline__ float xl_max64(float v) { v = fmaxf(v, xl_dpp<0xB1>(v)); v = fmaxf(v, xl_dpp<0x4E>(v)); v = fmaxf(v, xl_dpp<0x141>(v)); v = fmaxf(v, xl_dpp<0x140>(v)); v = xl_swap16_max(v); return xl_swap32_max(v); }
__device__ __forceinline__ float xl_scan64(float v) {
    v += xl_dpp<0x111>(v); v += xl_dpp<0x112>(v); v += xl_dpp<0x114>(v); v += xl_dpp<0x118>(v);
    v += __builtin_bit_cast(float, __builtin_amdgcn_update_dpp(0, __builtin_bit_cast(int, v), 0x142, 0xA, 0xF, false));
    v += __builtin_bit_cast(float, __builtin_amdgcn_update_dpp(0, __builtin_bit_cast(int, v), 0x143, 0xC, 0xF, false));
    return v;
}
#ifndef RES_F16
#define RES_F16 1
#endif
#ifndef PG8_SP2
#define PG8_SP2 1
#endif
namespace pg8 {
#define PG8_LAS __attribute__((address_space(3)))
typedef unsigned short bf16_t;
typedef short bf16x8 __attribute__((ext_vector_type(8)));
typedef float f32x4 __attribute__((ext_vector_type(4)));
typedef unsigned u32x4 __attribute__((ext_vector_type(4)));
typedef unsigned u32x2 __attribute__((ext_vector_type(2)));
constexpr int BM = 256, BK = 64, HALF = 128, HTB = HALF * BK * 2  , STAGE_BYTES = 8 * HTB, NXCD = 8, WGM = 8;

__host__ __device__ __forceinline__ int lds_byte(int r, int c) { const int st = (r >> 4) * 2 + (c >> 5), rr = r & 15, cc = c & 31, ob = rr * 64 + cc * 2; return st * 1024 + (ob ^ (((ob >> 9) & 1) << 5)); }
__host__ __device__ __forceinline__ void stage_rc(int b, int& R, int& C) { const int st = b / 1024, sb = b % 1024, swz = sb ^ (((sb >> 9) & 1) << 5); R = (st >> 1) * 16 + swz / 64; C = (st & 1) * 32 + (swz % 64) / 2; }
__host__ __device__ __forceinline__ int perm32(int rho) { const int n = rho >> 4, i = rho & 15; return 8 * (i >> 2) + 4 * n + (i & 3); }

typedef _Float16 f16x8 __attribute__((ext_vector_type(8)));
template <bool F16> __device__ __forceinline__ f32x4 mma16(bf16x8 a, bf16x8 b, f32x4 c) {
    if constexpr (F16) return __builtin_amdgcn_mfma_f32_16x16x32_f16(__builtin_bit_cast(f16x8, a), __builtin_bit_cast(f16x8, b), c, 0, 0, 0);
    else return __builtin_amdgcn_mfma_f32_16x16x32_bf16(a, b, c, 0, 0, 0);
}
struct Unit { int pm, pn; };
struct Gemm { const bf16_t* A; const bf16_t* Bt; int lda, K, a_stride, a_off; };

struct StaticOrder {
    int nM, nN, nwg, G, c;
    __host__ __device__ void init(int nM_, int nN_, int G_, int c_) { nM = nM_; nN = nN_; nwg = nM * nN; G = G_; c = c_; }
    __host__ __device__ bool next(int i, Unit& u) const {
        const long L = (long)i * G + c; if (L >= nwg) return false;
        int wgid = (int)L; { const int q = nwg / NXCD, r = nwg % NXCD, xcd = wgid % NXCD, off = wgid / NXCD; wgid = (xcd < r ? xcd * (q + 1) : r * (q + 1) + (xcd - r) * q) + off; }
        const int nig = WGM * nN, gid = wgid / nig, fm = gid * WGM, gsz = (nM - fm) < WGM ? (nM - fm) : WGM;
        u.pm = fm + ((wgid % nig) % gsz); u.pn = (wgid % nig) / gsz; return true;
    }
};

__device__ __forceinline__ unsigned cvt_pk_bf16(float lo, float hi) { unsigned r; asm volatile("v_cvt_pk_bf16_f32 %0, %1, %2" : "=v"(r) : "v"(lo), "v"(hi)); return r; }

template <class Epi, class Sched>
__device__ __forceinline__ void gemm_phase(PG8_LAS unsigned char* lds, PG8_LAS unsigned char* elds, const Gemm g, const Sched& S, const Epi& E, const int wave_s) {
    int tid = wave_s * 64 + HW_LANE(); asm volatile("" : "+v"(tid));
    const int wid = __builtin_amdgcn_readfirstlane(tid >> 6), lane = tid & 63, wr = wid >> 2, wc = wid & 3, fr = lane & 15, fq = lane >> 4;
    const int K = g.K, nt = K / BK, lda = g.lda;
    unsigned voffA[2], voffB[2]; int aoff, boff;
#define PG8_LANECONST() do { int t_ = wave_s * 64 + HW_LANE(); asm volatile("" : "+v"(t_)); const int fr_ = t_ & 15, fq_ = (t_ >> 4) & 3; \
        _Pragma("unroll") for (int i = 0; i < 2; ++i) { int R, C; stage_rc(t_ * 16 + i * 8192, R, C); const int Rb = Epi::PERM ? ((R & ~31) + perm32(R & 31)) : R; \
            const int Ra = Epi::ROWIL ? ((R & ~63) | ((R & 15) << 2) | ((R >> 4) & 3)) : R;     \
            voffA[i] = (unsigned)(Ra * lda + C) * 2u; voffB[i] = (unsigned)(Rb * K + C) * 2u; } \
        aoff = lds_byte(wr * 64 + fr_, fq_ * 8); boff = lds_byte(wc * 32 + fr_, fq_ * 8); } while (0)
    PG8_LANECONST();
    const size_t kstep = (size_t)(BK * 2);
    const size_t hstepA = (size_t)HALF * lda * 2, hstepB = (size_t)HALF * K * 2;
    const size_t tstepB = 2 * hstepB;
    const unsigned ldsw = (unsigned)wid * 1024u;
#define PG8_SA(b, h) (((b) * 2 + (h)) * HTB)
#define PG8_SB(b, h) ((4 + (b) * 2 + (h)) * HTB)
#define PG8_STAGE(bufoff, gbase, voff) do { _Pragma("unroll") for (int _i = 0; _i < 2; ++_i) \
        __builtin_amdgcn_global_load_lds((const unsigned*)((const char*)(gbase) + (voff)[_i]), (PG8_LAS unsigned*)(lds + (bufoff) + ldsw + _i * 8192), 16, 0, 0); } while (0)
#define PG8_LDA(dst, b, h) do { _Pragma("unroll") for (int m = 0; m < 4; ++m) _Pragma("unroll") for (int k = 0; k < 2; ++k) dst[m][k] = *(const PG8_LAS bf16x8*)(lds + PG8_SA(b, h) + aoff + m * 2048 + k * 1024); } while (0)
#define PG8_LDB(dst, b, h) do { _Pragma("unroll") for (int n = 0; n < 2; ++n) _Pragma("unroll") for (int k = 0; k < 2; ++k) dst[n][k] = *(const PG8_LAS bf16x8*)(lds + PG8_SB(b, h) + boff + n * 2048 + k * 1024); } while (0)
#define PG8_MMA(ai, bj, At, Bt) do { __builtin_amdgcn_s_setprio(1); _Pragma("unroll") for (int m = 0; m < 4; ++m) _Pragma("unroll") for (int n = 0; n < 2; ++n) _Pragma("unroll") for (int k = 0; k < 2; ++k) \
        acc[ai][bj][m][n] = mma16<Epi::AF16>(Bt[n][k], At[m][k], acc[ai][bj][m][n]); __builtin_amdgcn_s_setprio(0); } while (0)
#define PG8_WAIT_V(n) asm volatile("s_waitcnt vmcnt(" #n ")" ::: "memory")
#define PG8_WAIT_L(n) asm volatile("s_waitcnt lgkmcnt(" #n ")" ::: "memory")
#define PG8_BAR __builtin_amdgcn_s_barrier()
#define PG8_SCHED __builtin_amdgcn_sched_barrier(0)
    Unit cur, nxt; int ui = 0;
    if (!S.next(0, cur)) return;
    if constexpr (Epi::KGROUP) E.unit_begin(cur, elds, wave_s);
    if constexpr (Epi::PREFETCH) E.prefetch(cur, elds, wave_s);
    float zf = 0.f; if constexpr (!Epi::KGROUP) asm volatile("" : "+v"(zf));
    f32x4 acc[2][2][4][2];
#pragma unroll
    for (int a = 0; a < 2; ++a)
#pragma unroll
        for (int b = 0; b < 2; ++b)
#pragma unroll
            for (int m = 0; m < 4; ++m)
#pragma unroll
                for (int n = 0; n < 2; ++n) acc[a][b][m][n] = (f32x4){zf, zf, zf, zf};
    bf16x8 At[4][2], B0[2][2], B1[2][2];
    const char* cA = (const char*)g.A + ((long)cur.pm * g.a_stride + g.a_off) * (long)lda * 2; const char* cB = (const char*)g.Bt + (size_t)cur.pn * tstepB;
#if PG8_SP2
    PG8_STAGE(PG8_SB(0, 0), cB, voffB); PG8_STAGE(PG8_SB(0, 1), cB + hstepB, voffB); PG8_STAGE(PG8_SA(0, 0), cA, voffA); PG8_STAGE(PG8_SA(0, 1), cA + hstepA, voffA);
    if (wr == 1) PG8_BAR;
    PG8_WAIT_V(2); PG8_BAR;
    PG8_STAGE(PG8_SB(1, 0), cB + kstep, voffB); PG8_STAGE(PG8_SA(1, 0), cA + kstep, voffA); PG8_STAGE(PG8_SB(1, 1), cB + hstepB + kstep, voffB);
    PG8_WAIT_V(6); PG8_BAR;
#else
    PG8_STAGE(PG8_SB(0, 0), cB, voffB); PG8_STAGE(PG8_SA(0, 0), cA, voffA); PG8_STAGE(PG8_SB(0, 1), cB + hstepB, voffB); PG8_STAGE(PG8_SA(0, 1), cA + hstepA, voffA);
    if (wr == 1) PG8_BAR;
    PG8_WAIT_V(4); PG8_BAR;
    PG8_STAGE(PG8_SB(1, 0), cB + kstep, voffB); PG8_STAGE(PG8_SA(1, 0), cA + kstep, voffA); PG8_STAGE(PG8_SB(1, 1), cB + hstepB + kstep, voffB);
    PG8_WAIT_V(6); PG8_BAR;
#endif
    for (;;) {
        const bool has_next = S.next(ui + 1, nxt);
        const char* nA = has_next ? (const char*)g.A + ((long)nxt.pm * g.a_stride + g.a_off) * (long)lda * 2 : cA; const char* nB = has_next ? (const char*)g.Bt + (size_t)nxt.pn * tstepB : cB;
        for (int t = 0; t < nt; t += 2) {
            const bool last = (t == nt - 2);
            const char* a1 = cA + (size_t)(t + 1) * kstep;
            const char* a2 = last ? nA : cA + (size_t)(t + 2) * kstep; const char* b2 = last ? nB : cB + (size_t)(t + 2) * kstep;
            const char* a3 = a2 + kstep; const char* b3 = b2 + kstep;
            if constexpr (Epi::KGROUP) { if (t > 0 && (t & 7) == 0) E.kgroup(acc, t >> 3, wr, elds); }
#if PG8_SP2
            PG8_LDB(B0, 0, 0); PG8_LDB(B1, 0, 1); PG8_SCHED; PG8_LDA(At, 0, 0); PG8_STAGE(PG8_SA(1, 1), a1 + hstepA, voffA);
            PG8_WAIT_V(8); PG8_WAIT_L(0); PG8_BAR; PG8_MMA(0, 0, At, B0); PG8_MMA(0, 1, At, B1); PG8_BAR; PG8_SCHED;
            PG8_LDA(At, 0, 1); PG8_STAGE(PG8_SB(0, 0), b2, voffB); PG8_STAGE(PG8_SB(0, 1), b2 + hstepB, voffB); PG8_STAGE(PG8_SA(0, 0), a2, voffA);
            PG8_WAIT_V(8); PG8_WAIT_L(0); PG8_BAR; PG8_MMA(1, 0, At, B0); PG8_MMA(1, 1, At, B1); PG8_BAR; PG8_SCHED;
            PG8_LDB(B0, 1, 0); PG8_LDB(B1, 1, 1); PG8_SCHED; PG8_LDA(At, 1, 0); PG8_STAGE(PG8_SA(0, 1), a2 + hstepA, voffA);
            PG8_WAIT_V(8); PG8_WAIT_L(0); PG8_BAR; PG8_MMA(0, 0, At, B0); PG8_MMA(0, 1, At, B1); PG8_BAR; PG8_SCHED;
            PG8_LDA(At, 1, 1); PG8_STAGE(PG8_SB(1, 0), b3, voffB); PG8_STAGE(PG8_SB(1, 1), b3 + hstepB, voffB); PG8_STAGE(PG8_SA(1, 0), a3, voffA);
            PG8_WAIT_V(8); PG8_WAIT_L(0); PG8_BAR; PG8_MMA(1, 0, At, B0); PG8_MMA(1, 1, At, B1); PG8_BAR; PG8_SCHED;
#else
            PG8_LDB(B0, 0, 0); PG8_SCHED; PG8_LDA(At, 0, 0); PG8_STAGE(PG8_SA(1, 1), a1 + hstepA, voffA);
            PG8_WAIT_L(8); PG8_BAR; PG8_WAIT_L(0); PG8_MMA(0, 0, At, B0); PG8_BAR; PG8_SCHED;
            PG8_LDB(B1, 0, 1); PG8_STAGE(PG8_SB(0, 0), b2, voffB);
            PG8_BAR; PG8_WAIT_L(0); PG8_MMA(0, 1, At, B1); PG8_BAR;
            PG8_LDA(At, 0, 1); PG8_STAGE(PG8_SA(0, 0), a2, voffA);
            PG8_BAR; PG8_WAIT_L(0); PG8_MMA(1, 0, At, B0); PG8_BAR; PG8_SCHED;
            PG8_STAGE(PG8_SB(0, 1), b2 + hstepB, voffB);
            PG8_WAIT_V(6); PG8_BAR; PG8_MMA(1, 1, At, B1); PG8_BAR;
            PG8_LDB(B0, 1, 0); PG8_SCHED; PG8_LDA(At, 1, 0); PG8_STAGE(PG8_SA(0, 1), a2 + hstepA, voffA);
            PG8_WAIT_L(8); PG8_BAR; PG8_WAIT_L(0); PG8_MMA(0, 0, At, B0); PG8_BAR; PG8_SCHED;
            PG8_LDB(B1, 1, 1); PG8_STAGE(PG8_SB(1, 0), b3, voffB);
            PG8_BAR; PG8_WAIT_L(0); PG8_MMA(0, 1, At, B1); PG8_BAR;
            PG8_LDA(At, 1, 1); PG8_STAGE(PG8_SA(1, 0), a3, voffA);
            PG8_BAR; PG8_WAIT_L(0); PG8_MMA(1, 0, At, B0); PG8_BAR; PG8_SCHED;
            PG8_STAGE(PG8_SB(1, 1), b3 + hstepB, voffB);
            PG8_WAIT_V(6); PG8_BAR; PG8_MMA(1, 1, At, B1); PG8_BAR;
#endif
        }
        if (wr == 0) { if constexpr (Epi::PREFETCH) PG8_WAIT_V(8);
            PG8_BAR; }
        E(acc, cur, wr, wc, elds);
        if (!has_next) break;
        if constexpr (Epi::PREFETCH) E.prefetch(nxt, elds, wave_s);
#pragma unroll
        for (int a = 0; a < 2; ++a)
#pragma unroll
            for (int b = 0; b < 2; ++b)
#pragma unroll
                for (int m = 0; m < 4; ++m)
#pragma unroll
                    for (int n = 0; n < 2; ++n) acc[a][b][m][n] = (f32x4){zf, zf, zf, zf};
        cur = nxt; cA = nA; cB = nB; ++ui;
        if constexpr (Epi::KGROUP) E.unit_begin(cur, elds, wave_s);
        PG8_LANECONST();
        if (wr == 1) PG8_BAR;
    }
    PG8_WAIT_V(0);
    PG8_BAR;
#undef PG8_LANECONST
#undef PG8_SA
#undef PG8_SB
#undef PG8_STAGE
#undef PG8_LDA
#undef PG8_LDB
#undef PG8_MMA
}
}
namespace epi {
using pg8::f32x4; using pg8::u32x4; using pg8::u32x2; using pg8::bf16_t; using pg8::Unit; using pg8::cvt_pk_bf16;
constexpr int MROWS = 16384, DMODEL = 1024;
constexpr float EPS = 1e-6f;
#define EPI_LAS __attribute__((address_space(3)))

__device__ __forceinline__ float row_rstd(const float* ssq, int row) {
    const f32x4 a = *(const f32x4*)(ssq + (size_t)row * 4);
    const float s = (a[0] + a[1]) + (a[2] + a[3]);
    return __builtin_amdgcn_rsqf(s * (1.0f / DMODEL) + EPS);
}
template <int MSTEP> __device__ __forceinline__ void rstd8(const float* ssq, int row0, bool clamp, float (&rs)[2][4]) {
    f32x4 p[2][4];
#pragma unroll
    for (int ai = 0; ai < 2; ++ai)
#pragma unroll
        for (int m = 0; m < 4; ++m) { int row = row0 + ai * 128 + m * MSTEP; if (clamp) row = row < 0 ? 0 : (row >= MROWS ? MROWS - 1 : row); p[ai][m] = *(const f32x4*)(ssq + (size_t)row * 4); }
#pragma unroll
    for (int ai = 0; ai < 2; ++ai)
#pragma unroll
        for (int m = 0; m < 4; ++m) { const f32x4 a = p[ai][m]; rs[ai][m] = __builtin_amdgcn_rsqf(((a[0] + a[1]) + (a[2] + a[3])) * (1.0f / DMODEL) + EPS); }
}
template <int CTRL> __device__ __forceinline__ float dppf(float old, float src) {
    return __builtin_bit_cast(float, __builtin_amdgcn_update_dpp(__builtin_bit_cast(int, old), __builtin_bit_cast(int, src), CTRL, 0xF, 0xF, false));
}
template <int CTRL> __device__ __forceinline__ float dppa(float src) {
    return __builtin_bit_cast(float, __builtin_amdgcn_mov_dpp(__builtin_bit_cast(int, src), CTRL, 0xF, 0xF, true));
}
__device__ __forceinline__ f32x4 silu4(f32x4 v) {
    const f32x4 t = v * (-1.4426950408889634f); f32x4 e;
#pragma unroll
    for (int i = 0; i < 4; ++i) e[i] = __builtin_amdgcn_exp2f(t[i]);
    e = e + 1.0f;
#pragma unroll
    for (int i = 0; i < 4; ++i) e[i] = __builtin_amdgcn_rcpf(e[i]);
    return v * e;
}
template <int CTRL> __device__ __forceinline__ float dppz(float src) {
    return __builtin_bit_cast(float, __builtin_amdgcn_update_dpp(0, __builtin_bit_cast(int, src), CTRL, 0xF, 0xF, true));
}
__device__ __forceinline__ float softplus_fast(float v) {
    const float t = __builtin_amdgcn_exp2f(-1.4426950408889634f * fabsf(v));
    const float l = (t < 0.015625f) ? t * (1.0f - t * (0.5f - t * 0.33333334f)) : 0.6931471805599453f * __builtin_amdgcn_logf(1.0f + t);
    return fmaxf(v, 0.f) + l;
}
__device__ __forceinline__ float silu_fast(float v) { return v * __builtin_amdgcn_rcpf(1.0f + __builtin_amdgcn_exp2f(-1.4426950408889634f * v)); }

#ifndef RES_LO
#define RES_LO (RES_F16 ? 0 : 1)
#endif
typedef _Float16 h2_t __attribute__((ext_vector_type(2)));
__device__ __forceinline__ unsigned pk_f16(float lo, float hi) { const h2_t v = {(_Float16)lo, (_Float16)hi}; return __builtin_bit_cast(unsigned, v); }
__device__ __forceinline__ float f16_lo(unsigned w) { const h2_t v = __builtin_bit_cast(h2_t, w); const _Float16 a = v[0]; return (float)a; }
__device__ __forceinline__ float f16_hi(unsigned w) { const h2_t v = __builtin_bit_cast(h2_t, w); const _Float16 a = v[1]; return (float)a; }
template <int MODE  > struct EpiResidual {
    static constexpr bool PERM = true, ROWIL = false, KGROUP = false, PREFETCH = false, AF16 = false;
    const float* xin_f32; float* xout_f32; bf16_t* xh; bf16_t* xl; float* ssq; int dry;
    __device__ __forceinline__ void operator()(f32x4 (&acc)[2][2][4][2], const Unit& u, int wr, int wc, EPI_LAS unsigned char* elds) const {
        int fr, fq; { int t_ = HW_LANE(); asm volatile("" : "+v"(t_)); fr = t_ & 15; fq = (t_ >> 4) & 3; }
        EPI_LAS float* P = (EPI_LAS float*)elds;
        const int col0 = u.pn * 256 + wc * 32 + 8 * fq;
#pragma unroll
        for (int ai = 0; ai < 2; ++ai) {
            u32x4 xa[4][2], xb_[4][2];
#pragma unroll
            for (int m = 0; m < 4; ++m)
#pragma unroll
                for (int bj = 0; bj < 2; ++bj) {
                    const size_t o = (size_t)(u.pm * 256 + ai * 128 + wr * 64 + m * 16 + fr) * DMODEL + col0 + bj * 128;
                    if (MODE == 1) { xa[m][bj] = *(const u32x4*)(xin_f32 + o); xb_[m][bj] = *(const u32x4*)(xin_f32 + o + 4); }
                    else { xa[m][bj] = *(const u32x4*)(xh + o); xb_[m][bj] = RES_LO ? *(const u32x4*)(xl + o) : (u32x4){0u, 0u, 0u, 0u}; }
                }
#pragma unroll
            for (int m = 0; m < 4; ++m) {
                const int row = u.pm * 256 + ai * 128 + wr * 64 + m * 16 + fr;
                float s = 0.f;
#pragma unroll
                for (int bj = 0; bj < 2; ++bj) {
                    const size_t o = (size_t)row * DMODEL + col0 + bj * 128;
                    f32x4 v0, v1;
                    if (MODE == 1) { v0 = __builtin_bit_cast(f32x4, xa[m][bj]); v1 = __builtin_bit_cast(f32x4, xb_[m][bj]); }
                    else {
#pragma unroll
                        for (int i = 0; i < 2; ++i) {
                            if (RES_F16) { v0[2 * i] = f16_lo(xa[m][bj][i]); v0[2 * i + 1] = f16_hi(xa[m][bj][i]); v1[2 * i] = f16_lo(xa[m][bj][2 + i]); v1[2 * i + 1] = f16_hi(xa[m][bj][2 + i]); continue; }
                            v0[2 * i] = __builtin_bit_cast(float, xa[m][bj][i] << 16) + __builtin_bit_cast(float, xb_[m][bj][i] << 16);
                            v0[2 * i + 1] = __builtin_bit_cast(float, xa[m][bj][i] & 0xffff0000u) + __builtin_bit_cast(float, xb_[m][bj][i] & 0xffff0000u);
                            v1[2 * i] = __builtin_bit_cast(float, xa[m][bj][2 + i] << 16) + __builtin_bit_cast(float, xb_[m][bj][2 + i] << 16);
                            v1[2 * i + 1] = __builtin_bit_cast(float, xa[m][bj][2 + i] & 0xffff0000u) + __builtin_bit_cast(float, xb_[m][bj][2 + i] & 0xffff0000u);
                        }
                    }
                    v0 = v0 + acc[ai][bj][m][0]; v1 = v1 + acc[ai][bj][m][1];
                    s += ((v0[0] * v0[0] + v0[1] * v0[1]) + (v0[2] * v0[2] + v0[3] * v0[3])) + ((v1[0] * v1[0] + v1[1] * v1[1]) + (v1[2] * v1[2] + v1[3] * v1[3]));
                    if (MODE == 2) { if (!dry) { *(f32x4*)(xout_f32 + o) = v0; *(f32x4*)(xout_f32 + o + 4) = v1; } }
                    else {
                        u32x4 h; h.x = cvt_pk_bf16(v0[0], v0[1]); h.y = cvt_pk_bf16(v0[2], v0[3]); h.z = cvt_pk_bf16(v1[0], v1[1]); h.w = cvt_pk_bf16(v1[2], v1[3]);
                        if (RES_F16) { h.x = pk_f16(v0[0], v0[1]); h.y = pk_f16(v0[2], v0[3]); h.z = pk_f16(v1[0], v1[1]); h.w = pk_f16(v1[2], v1[3]); }
                        u32x4 l;
                        l.x = cvt_pk_bf16(v0[0] - __builtin_bit_cast(float, h.x << 16), v0[1] - __builtin_bit_cast(float, h.x & 0xffff0000u));
                        l.y = cvt_pk_bf16(v0[2] - __builtin_bit_cast(float, h.y << 16), v0[3] - __builtin_bit_cast(float, h.y & 0xffff0000u));
                        l.z = cvt_pk_bf16(v1[0] - __builtin_bit_cast(float, h.z << 16), v1[1] - __builtin_bit_cast(float, h.z & 0xffff0000u));
                        l.w = cvt_pk_bf16(v1[2] - __builtin_bit_cast(float, h.w << 16), v1[3] - __builtin_bit_cast(float, h.w & 0xffff0000u));
                        if (!dry) { *(u32x4*)(xh + o) = h; if (RES_LO) *(u32x4*)(xl + o) = l; }
                    }
                }
                s = xl_swap32_sum(xl_swap16_sum(s));
                if (fq == 0) P[(ai * 128 + wr * 64 + m * 16 + fr) * 4 + wc] = s;
            }
            asm volatile("" ::: "memory");
        }
        asm volatile("s_waitcnt lgkmcnt(0)" ::: "memory"); __builtin_amdgcn_s_barrier(); asm volatile("" ::: "memory");
        { const int t = (wr * 4 + wc) * 64 + fq * 16 + fr; if (t < 256) { const f32x4 p = *(const EPI_LAS f32x4*)(P + t * 4); ssq[(size_t)(u.pm * 256 + t) * 4 + u.pn] = (p[0] + p[1]) + (p[2] + p[3]); } }
        asm volatile("s_waitcnt lgkmcnt(0)" ::: "memory"); __builtin_amdgcn_s_barrier(); asm volatile("" ::: "memory");
    }
};

template <int MODE> struct EpiResidualG {
    static constexpr bool PERM = true, ROWIL = false, KGROUP = true, PREFETCH = false, AF16 = false;
    const float* xin_f32; bf16_t* xh; bf16_t* xl; float* ssq; const float* ssqp; int dry;
    __device__ __forceinline__ void unit_begin(const Unit& u, EPI_LAS unsigned char* elds, int wave_s) const {
        int t = wave_s * 64 + HW_LANE(); asm volatile("" : "+v"(t));
        if (t < 256) {
            const f32x4* p = (const f32x4*)(ssqp + (size_t)(u.pm * 256 + t) * 32);
            float r[4];
#pragma unroll
            for (int g = 0; g < 4; ++g) { const f32x4 a = p[2 * g], b = p[2 * g + 1]; r[g] = __builtin_amdgcn_rsqf((((a[0] + a[1]) + (a[2] + a[3])) + ((b[0] + b[1]) + (b[2] + b[3]))) * (1.0f / 512.0f) + EPS); }
            *(EPI_LAS f32x4*)(elds + 4096 + t * 16) = (f32x4){r[0] / r[1], r[1] / r[2], r[2] / r[3], r[3]};
        }
    }
    __device__ __forceinline__ void kgroup(f32x4 (&acc)[2][2][4][2], int g, int wr, EPI_LAS unsigned char* elds) const {
        int fr; { int t_ = HW_LANE(); asm volatile("" : "+v"(t_)); fr = t_ & 15; }
        const EPI_LAS float* RG = (const EPI_LAS float*)(elds + 4096) + (g - 1);
#pragma unroll
        for (int ai = 0; ai < 2; ++ai)
#pragma unroll
            for (int m = 0; m < 4; ++m) {
                const float f = RG[(ai * 128 + wr * 64 + m * 16 + fr) * 4];
#pragma unroll
                for (int bj = 0; bj < 2; ++bj) { acc[ai][bj][m][0] *= f; acc[ai][bj][m][1] *= f; }
            }
    }
    __device__ __forceinline__ void operator()(f32x4 (&acc)[2][2][4][2], const Unit& u, int wr, int wc, EPI_LAS unsigned char* elds) const {
        kgroup(acc, 4, wr, elds);
        const EpiResidual<MODE> R{xin_f32, nullptr, xh, xl, ssq, dry};
        R(acc, u, wr, wc, elds);
    }
};

struct EpiSsdIn {
    static constexpr bool PERM = true, ROWIL = false, KGROUP = false, PREFETCH = false, AF16 = (RES_F16 != 0);
    bf16_t* proj; float* dt; const float* dtbias; const float* ssq;
    __device__ __forceinline__ void operator()(f32x4 (&acc)[2][2][4][2], const Unit& u, int wr, int wc, EPI_LAS unsigned char*) const {
        int fr, fq; { int t_ = HW_LANE(); asm volatile("" : "+v"(t_)); fr = t_ & 15; fq = (t_ >> 4) & 3; }
        float rsv[2][4]; rstd8<16>(ssq, u.pm * 256 + wr * 64 + fr, false, rsv);
#pragma unroll
        for (int ai = 0; ai < 2; ++ai)
#pragma unroll
            for (int m = 0; m < 4; ++m) {
                const int row = u.pm * 256 + ai * 128 + wr * 64 + m * 16 + fr;
                const float rs = rsv[ai][m];
                if (u.pn < 20) {
#pragma unroll
                    for (int bj = 0; bj < 2; ++bj) {
                        const f32x4 v0 = acc[ai][bj][m][0] * rs, v1 = acc[ai][bj][m][1] * rs;
                        u32x4 w; w.x = cvt_pk_bf16(v0[0], v0[1]); w.y = cvt_pk_bf16(v0[2], v0[3]); w.z = cvt_pk_bf16(v1[0], v1[1]); w.w = cvt_pk_bf16(v1[2], v1[3]);
                        *(u32x4*)(proj + (size_t)row * 5120 + u.pn * 256 + bj * 128 + wc * 32 + 8 * fq) = w;
                    }
                } else if (wc == 0) {
#pragma unroll
                    for (int n = 0; n < 2; ++n) {
                        const int c = 8 * fq + 4 * n;
                        const f32x4 b = *(const f32x4*)(dtbias + c);
                        f32x4 v = acc[ai][0][m][n] * rs + b, o;
#pragma unroll
                        for (int e = 0; e < 4; ++e) o[e] = softplus_fast(v[e]);
                        *(f32x4*)(dt + (size_t)row * 32 + c) = o;
                    }
                }
            }
    }
};

struct EpiQKV {
    static constexpr bool PERM = true, ROWIL = false, KGROUP = false, PREFETCH = false, AF16 = (RES_F16 != 0);
    bf16_t* proj; const float* ssq; const float* qg; const float* kg; const float* rope;
    __device__ __forceinline__ void operator()(f32x4 (&acc)[2][2][4][2], const Unit& u, int wr, int wc, EPI_LAS unsigned char* elds) const {
        int fr, fq; { int t_ = HW_LANE(); asm volatile("" : "+v"(t_)); fr = t_ & 15; fq = (t_ >> 4) & 3; }
        EPI_LAS float* P = (EPI_LAS float*)elds;
        EPI_LAS f32x4* RT = (EPI_LAS f32x4*)(elds + 8192);
        const bool isqk = u.pn < 8;
        f32x4 rp_[2];
        const int t_id = (wr * 4 + wc) * 64 + fq * 16 + fr;
        if (isqk) {
#pragma unroll
            for (int i = 0; i < 2; ++i) rp_[i] = *(const f32x4*)(rope + (size_t)u.pm * 256 * 16 + (size_t)(t_id * 2 + i) * 4);
        }
        float rsv[2][4]; rstd8<16>(ssq, u.pm * 256 + wr * 64 + fr, false, rsv);
#pragma unroll
        for (int ai = 0; ai < 2; ++ai)
#pragma unroll
            for (int m = 0; m < 4; ++m) {
                const int trow = ai * 128 + wr * 64 + m * 16 + fr;
                const float rs = rsv[ai][m];
#pragma unroll
                for (int bj = 0; bj < 2; ++bj) {
                    acc[ai][bj][m][0] *= rs; acc[ai][bj][m][1] *= rs;
                    if (isqk) {
                        const f32x4 a = acc[ai][bj][m][0], b = acc[ai][bj][m][1];
                        float s = ((a[0] * a[0] + a[1] * a[1]) + (a[2] * a[2] + a[3] * a[3])) + ((b[0] * b[0] + b[1] * b[1]) + (b[2] * b[2] + b[3] * b[3]));
                        s = xl_swap32_sum(xl_swap16_sum(s));
                        if (fq == 0) P[trow * 8 + bj * 4 + wc] = s;
                    }
                }
            }
        if (isqk) { RT[t_id * 2] = rp_[0]; RT[t_id * 2 + 1] = rp_[1]; }
        if (isqk) {
            asm volatile("s_waitcnt lgkmcnt(0)" ::: "memory"); __builtin_amdgcn_s_barrier(); asm volatile("" ::: "memory");
            const float* g = (u.pn < 4) ? qg : kg;
            const int d0 = 32 * (wc & 1) + 8 * fq;
            const f32x4 g0 = *(const f32x4*)(g + d0), g1 = *(const f32x4*)(g + d0 + 4);
            const float qs = (u.pn < 4) ? (1.4426950408889634f * 0.125f) : 1.0f;
            const bool dorope = (wc & 1) == 0;
#pragma unroll
            for (int ai = 0; ai < 2; ++ai)
#pragma unroll
                for (int m = 0; m < 4; ++m) {
                    const int trow = ai * 128 + wr * 64 + m * 16 + fr;
                    const int row = u.pm * 256 + trow;
                    f32x4 c0 = {1.f, 1.f, 1.f, 1.f}, c1 = c0, s0 = {0.f, 0.f, 0.f, 0.f}, s1 = s0;
                    if (dorope && fq < 2) {
                        c0 = RT[trow * 4 + 0]; c1 = RT[trow * 4 + 1]; s0 = RT[trow * 4 + 2]; s1 = RT[trow * 4 + 3];
                        if (fq == 0) { s0 = -s0; s1 = -s1; }
                    }
#pragma unroll
                    for (int bj = 0; bj < 2; ++bj) {
                        const float tot = P[trow * 8 + bj * 4 + wc] + P[trow * 8 + bj * 4 + (wc ^ 1)];
                        const float nr = qs * __builtin_amdgcn_rsqf(tot * (1.0f / 64.0f) + EPS);
                        f32x4 v0 = acc[ai][bj][m][0] * g0 * nr, v1 = acc[ai][bj][m][1] * g1 * nr;
                        if (dorope) {
                            f32x4 o0, o1;
#pragma unroll
                            for (int e = 0; e < 4; ++e) { o0[e] = xl_xor16(v0[e], (fq & 1) != 0); o1[e] = xl_xor16(v1[e], (fq & 1) != 0); }
                            v0 = v0 * c0 + o0 * s0; v1 = v1 * c1 + o1 * s1;
                        }
                        u32x4 w; w.x = cvt_pk_bf16(v0[0], v0[1]); w.y = cvt_pk_bf16(v0[2], v0[3]); w.z = cvt_pk_bf16(v1[0], v1[1]); w.w = cvt_pk_bf16(v1[2], v1[3]);
                        *(u32x4*)(proj + (size_t)row * 3072 + u.pn * 256 + bj * 128 + wc * 32 + 8 * fq) = w;
                    }
                    asm volatile("" ::: "memory");
                }
            asm volatile("s_waitcnt lgkmcnt(0)" ::: "memory"); __builtin_amdgcn_s_barrier(); asm volatile("" ::: "memory");
        } else {
#pragma unroll
            for (int ai = 0; ai < 2; ++ai)
#pragma unroll
                for (int m = 0; m < 4; ++m) {
                    const int row = u.pm * 256 + ai * 128 + wr * 64 + m * 16 + fr;
#pragma unroll
                    for (int bj = 0; bj < 2; ++bj) {
                        const f32x4 v0 = acc[ai][bj][m][0], v1 = acc[ai][bj][m][1];
                        u32x4 w; w.x = cvt_pk_bf16(v0[0], v0[1]); w.y = cvt_pk_bf16(v0[2], v0[3]); w.z = cvt_pk_bf16(v1[0], v1[1]); w.w = cvt_pk_bf16(v1[2], v1[3]);
                        *(u32x4*)(proj + (size_t)row * 3072 + u.pn * 256 + bj * 128 + wc * 32 + 8 * fq) = w;
                    }
                }
        }
    }
};

struct EpiSsdConv {
    static constexpr bool PERM = true, ROWIL = true, KGROUP = false, PREFETCH = true, AF16 = (RES_F16 != 0);
    bf16_t* zp; bf16_t* xbc; float* dt; const float* ssq; const float* cp; int dry;
    template <bool MASK>
    __device__ __forceinline__ void conv_body(f32x4 (&acc)[2][2][4][2], const Unit& u, int wr, int wc, int fr, int fq, const EPI_LAS f32x4* hb, int R0) const {
        bf16_t* const obase = (u.pn < 8) ? zp + u.pn * 256 : xbc + (u.pn - 8) * 256;
        const int old_ = (u.pn < 8) ? 2048 : 3072;
#pragma unroll
        for (int bj = 0; bj < 2; ++bj) {
            u32x2 keep[2][4];
#pragma unroll
            for (int n = 0; n < 2; ++n) {
                const int tc = bj * 128 + wc * 32 + 8 * fq + 4 * n;
                const EPI_LAS float* pt = (const EPI_LAS float*)((const EPI_LAS unsigned char*)hb + 12288) + tc;
                const f32x4 bb = *(const EPI_LAS f32x4*)pt, w0 = *(const EPI_LAS f32x4*)(pt + 256), w1 = *(const EPI_LAS f32x4*)(pt + 512), w2 = *(const EPI_LAS f32x4*)(pt + 768), w3 = *(const EPI_LAS f32x4*)(pt + 1024);
#pragma unroll
                for (int ai = 0; ai < 2; ++ai) {
                    f32x4 h1 = {0.f, 0.f, 0.f, 0.f}, h2 = h1, h3 = h1;
                    const int pwr = wr ^ 1, pai = (wr == 1) ? ai : ai - 1;
                    if (pai >= 0 && fr == 0) { const int idx = (((pwr * 2 + pai) * 4 + wc) * 3 * 4 + fq) * 4 + bj * 2 + n;
                        h1 = hb[idx]; h2 = hb[idx + 16]; h3 = hb[idx + 32]; }
                    const f32x4 v0 = acc[ai][bj][0][n], v1 = acc[ai][bj][1][n], v2 = acc[ai][bj][2][n], v3 = acc[ai][bj][3][n];
                    f32x4 p1, p2, p3;
#pragma unroll
                    for (int e = 0; e < 4; ++e) { p1[e] = dppf<0x111>(h1[e], v1[e]); p2[e] = dppf<0x111>(h2[e], v2[e]); p3[e] = dppf<0x111>(h3[e], v3[e]); }
#pragma unroll
                    for (int m = 0; m < 4; ++m) {
                        const int trow = ai * 128 + wr * 64 + 4 * fr + m, row = R0 + trow;
                        const f32x4 cv = (m == 0) ? v0 : (m == 1) ? v1 : (m == 2) ? v2 : v3;
                        f32x4 x1 = (m == 0) ? p3 : (m == 1) ? v0 : (m == 2) ? v1 : v2;
                        f32x4 x2 = (m == 0) ? p2 : (m == 1) ? p3 : (m == 2) ? v0 : v1;
                        f32x4 x3 = (m == 0) ? p1 : (m == 1) ? p2 : (m == 2) ? p3 : v0;
                        if (MASK) { const int ts = row & 2047; const f32x4 z4 = {0.f, 0.f, 0.f, 0.f}; if (ts < 1) x1 = z4; if (ts < 2) x2 = z4; if (ts < 3) x3 = z4; }
                        const bool valid = trow >= 3 && row < MROWS;
                        const f32x4 o = silu4(bb + w0 * x3 + w1 * x2 + w2 * x1 + w3 * cv);
                        if (n == 0) { keep[ai][m].x = cvt_pk_bf16(o[0], o[1]); keep[ai][m].y = cvt_pk_bf16(o[2], o[3]); }
                        else if (valid) {
                            u32x4 w; w.x = keep[ai][m].x; w.y = keep[ai][m].y; w.z = cvt_pk_bf16(o[0], o[1]); w.w = cvt_pk_bf16(o[2], o[3]);
                            *(u32x4*)(obase + (size_t)row * old_ + tc - 4) = w;
                        }
                    }
                    asm volatile("" ::: "memory");
                }
            }
        }
    }
    __device__ __forceinline__ void prefetch(const Unit& u, EPI_LAS unsigned char* elds, int wave_s) const {
        if (wave_s < 5) {
            int l_ = HW_LANE(); asm volatile("" : "+v"(l_)); const int t_id = wave_s * 64 + l_;
            __builtin_amdgcn_global_load_lds((const unsigned*)(cp + (size_t)wave_s * 5376 + u.pn * 256 + l_ * 4), (EPI_LAS unsigned*)(elds + 12288 + wave_s * 1024), 16, 0, 0);
            if (wave_s < 4) {
                int row = u.pm * 253 - 3 + t_id; row = row < 0 ? 0 : (row >= MROWS ? MROWS - 1 : row);
                __builtin_amdgcn_global_load_lds((const unsigned*)(ssq + (size_t)row * 4), (EPI_LAS unsigned*)(elds + 17408 + wave_s * 1024), 16, 0, 0);
            }
        }
    }
    __device__ __forceinline__ void operator()(f32x4 (&acc)[2][2][4][2], const Unit& u, int wr, int wc, EPI_LAS unsigned char* elds) const {
#ifdef PROBE_EPI_MODE
        if (dry == 3) { asm volatile("" :: "v"(acc[0][0][0][0][0]), "v"(acc[1][1][3][1][3])); return; }
#endif
        int fr, fq; { int t_ = HW_LANE(); asm volatile("" : "+v"(t_)); fr = t_ & 15; fq = (t_ >> 4) & 3; }
        const int R0 = u.pm * 253 - 3;
        EPI_LAS f32x4* hb = (EPI_LAS f32x4*)elds;
        { float rsv[2][4];
          const EPI_LAS f32x4* SS = (const EPI_LAS f32x4*)(elds + 17408) + wr * 64 + 4 * fr;
#pragma unroll
          for (int ai = 0; ai < 2; ++ai)
#pragma unroll
            for (int m = 0; m < 4; ++m) { const f32x4 a = SS[ai * 128 + m]; rsv[ai][m] = __builtin_amdgcn_rsqf(((a[0] + a[1]) + (a[2] + a[3])) * (1.0f / DMODEL) + EPS); }
#pragma unroll
          for (int ai = 0; ai < 2; ++ai)
#pragma unroll
            for (int m = 0; m < 4; ++m)
#pragma unroll
                for (int bj = 0; bj < 2; ++bj) { acc[ai][bj][m][0] *= rsv[ai][m]; acc[ai][bj][m][1] *= rsv[ai][m]; } }
        if (u.pn == 20) {
            if (wc == 0) {
#pragma unroll
                for (int ai = 0; ai < 2; ++ai)
#pragma unroll
                    for (int m = 0; m < 4; ++m) {
                        const int trow = ai * 128 + wr * 64 + 4 * fr + m, row = R0 + trow;
                        if (trow >= 3 && row < MROWS) {
#pragma unroll
                            for (int n = 0; n < 2; ++n) {
                                const int c = 8 * fq + 4 * n;
                                const f32x4 b = *(const EPI_LAS f32x4*)(elds + 12288 + c * 4);
                                f32x4 v = acc[ai][0][m][n] + b, o;
#pragma unroll
                                for (int e = 0; e < 4; ++e) o[e] = softplus_fast(v[e]);
                                *(f32x4*)(dt + (size_t)row * 32 + c) = o;
                            }
                        }
                    }
            }
            asm volatile("s_waitcnt lgkmcnt(0)" ::: "memory"); __builtin_amdgcn_s_barrier(); asm volatile("" ::: "memory");
            return;
        }
        if (fr == 15) {
#pragma unroll
            for (int ai = 0; ai < 2; ++ai)
#pragma unroll
                for (int m = 1; m < 4; ++m) {
                    const int idx = ((((wr * 2 + ai) * 4 + wc) * 3 + (m - 1)) * 4 + fq) * 4;
                    hb[idx + 0] = acc[ai][0][m][0]; hb[idx + 1] = acc[ai][0][m][1]; hb[idx + 2] = acc[ai][1][m][0]; hb[idx + 3] = acc[ai][1][m][1];
                }
        }
        asm volatile("s_waitcnt lgkmcnt(0)" ::: "memory"); __builtin_amdgcn_s_barrier(); asm volatile("" ::: "memory");
        const int tf = (u.pm * 253) & 2047;
        if (dry < 2) { if (tf <= 2 || tf + 252 >= 2048) conv_body<true>(acc, u, wr, wc, fr, fq, hb, R0); else conv_body<false>(acc, u, wr, wc, fr, fq, hb, R0); }
        asm volatile("s_waitcnt lgkmcnt(0)" ::: "memory"); __builtin_amdgcn_s_barrier(); asm volatile("" ::: "memory");
    }
};

struct EpiConvGate {
    static constexpr bool PERM = true, ROWIL = true, KGROUP = false, PREFETCH = true, AF16 = (RES_F16 != 0);
    bf16_t* H; const float* ssq; const float* cw; const float* cb; int dry;
    template <bool MASK>
    __device__ __forceinline__ void body(f32x4 (&acc)[2][2][4][2], const Unit& u, int wr, int wc, int fr, int fq, const EPI_LAS f32x4* hb, int R0) const {
        constexpr int DFF = 2816;
        u32x2 keep[2][4];
#pragma unroll
        for (int n = 0; n < 2; ++n) {
            const int ch = u.pn * 128 + wc * 32 + 8 * fq + 4 * n;
            const EPI_LAS float* pt = (const EPI_LAS float*)((const EPI_LAS unsigned char*)hb + 8192) + wc * 32 + 8 * fq + 4 * n;
            const f32x4 bg = *(const EPI_LAS f32x4*)pt, bu = *(const EPI_LAS f32x4*)(pt + 128);
            const f32x4 w0g = *(const EPI_LAS f32x4*)(pt + 256), w0u = *(const EPI_LAS f32x4*)(pt + 384), w1g = *(const EPI_LAS f32x4*)(pt + 512), w1u = *(const EPI_LAS f32x4*)(pt + 640), w2g = *(const EPI_LAS f32x4*)(pt + 768), w2u = *(const EPI_LAS f32x4*)(pt + 896);
#pragma unroll
            for (int ai = 0; ai < 2; ++ai) {
                f32x4 hg2 = {0.f, 0.f, 0.f, 0.f}, hg3 = hg2, hu2 = hg2, hu3 = hg2;
                const int pwr = wr ^ 1, pai = (wr == 1) ? ai : ai - 1;
                if (pai >= 0 && fr == 0) { const int idx = (((pwr * 2 + pai) * 4 + wc) * 2 * 4 + fq) * 4;
                    hg2 = hb[idx + n]; hu2 = hb[idx + 2 + n]; hg3 = hb[idx + 16 + n]; hu3 = hb[idx + 16 + 2 + n]; }
                const f32x4 g0 = acc[ai][0][0][n], g1_ = acc[ai][0][1][n], g2_ = acc[ai][0][2][n], g3_ = acc[ai][0][3][n];
                const f32x4 u0 = acc[ai][1][0][n], u1_ = acc[ai][1][1][n], u2_ = acc[ai][1][2][n], u3_ = acc[ai][1][3][n];
                f32x4 pg2, pg3, pu2, pu3;
#pragma unroll
                for (int e = 0; e < 4; ++e) { pg2[e] = dppf<0x111>(hg2[e], g2_[e]); pg3[e] = dppf<0x111>(hg3[e], g3_[e]); pu2[e] = dppf<0x111>(hu2[e], u2_[e]); pu3[e] = dppf<0x111>(hu3[e], u3_[e]); }
#pragma unroll
                for (int m = 0; m < 4; ++m) {
                    const int trow = ai * 128 + wr * 64 + 4 * fr + m, row = R0 + trow;
                    const f32x4 cg = (m == 0) ? g0 : (m == 1) ? g1_ : (m == 2) ? g2_ : g3_, cu = (m == 0) ? u0 : (m == 1) ? u1_ : (m == 2) ? u2_ : u3_;
                    f32x4 xg1 = (m == 0) ? pg3 : (m == 1) ? g0 : (m == 2) ? g1_ : g2_, xg2 = (m == 0) ? pg2 : (m == 1) ? pg3 : (m == 2) ? g0 : g1_;
                    f32x4 xu1 = (m == 0) ? pu3 : (m == 1) ? u0 : (m == 2) ? u1_ : u2_, xu2 = (m == 0) ? pu2 : (m == 1) ? pu3 : (m == 2) ? u0 : u1_;
                    if (MASK) { const int ts = row & 2047; const f32x4 z4 = {0.f, 0.f, 0.f, 0.f}; if (ts < 1) { xg1 = z4; xu1 = z4; } if (ts < 2) { xg2 = z4; xu2 = z4; } }
                    const f32x4 gv = bg + w0g * xg2 + w1g * xg1 + w2g * cg;
                    const f32x4 uv = bu + w0u * xu2 + w1u * xu1 + w2u * cu;
                    const f32x4 o = silu4(gv) * uv;
                    if (n == 0) { keep[ai][m].x = cvt_pk_bf16(o[0], o[1]); keep[ai][m].y = cvt_pk_bf16(o[2], o[3]); }
                    else if (trow >= 2 && row < MROWS) {
                        u32x4 w; w.x = keep[ai][m].x; w.y = keep[ai][m].y; w.z = cvt_pk_bf16(o[0], o[1]); w.w = cvt_pk_bf16(o[2], o[3]);
                        asm volatile("" :: "v"(w.x), "v"(w.y), "v"(w.z), "v"(w.w));
                        if (!dry) *(u32x4*)(H + (size_t)row * DFF + ch - 4) = w;
                    }
                }
                asm volatile("" ::: "memory");
            }
        }
    }
    __device__ __forceinline__ void prefetch(const Unit& u, EPI_LAS unsigned char* elds, int wave_s) const {
        if (wave_s < 4) {
            int l_ = HW_LANE(); asm volatile("" : "+v"(l_)); const int t_id = wave_s * 64 + l_;
            const int k = t_id >> 5, c = u.pn * 128 + (t_id & 31) * 4;
            __builtin_amdgcn_global_load_lds((const unsigned*)((k < 2 ? cb + k * 2816 : cw + (size_t)(k - 2) * 2816) + c), (EPI_LAS unsigned*)(elds + 8192 + wave_s * 1024), 16, 0, 0);
            int row = u.pm * 254 - 2 + t_id; row = row < 0 ? 0 : (row >= MROWS ? MROWS - 1 : row);
            __builtin_amdgcn_global_load_lds((const unsigned*)(ssq + (size_t)row * 4), (EPI_LAS unsigned*)(elds + 12288 + wave_s * 1024), 16, 0, 0);
        }
    }
    __device__ __forceinline__ void operator()(f32x4 (&acc)[2][2][4][2], const Unit& u, int wr, int wc, EPI_LAS unsigned char* elds) const {
#ifdef PROBE_EPI_MODE
        if (dry == 3) { asm volatile("" :: "v"(acc[0][0][0][0][0]), "v"(acc[1][1][3][1][3])); return; }
#endif
        int fr, fq; { int t_ = HW_LANE(); asm volatile("" : "+v"(t_)); fr = t_ & 15; fq = (t_ >> 4) & 3; }
        const int R0 = u.pm * 254 - 2;
        EPI_LAS f32x4* hb = (EPI_LAS f32x4*)elds;
        const int t_id = (wr * 4 + wc) * 64 + fq * 16 + fr;
        (void)t_id;
        { float rsv[2][4];
          const EPI_LAS f32x4* SS = (const EPI_LAS f32x4*)(elds + 12288) + wr * 64 + 4 * fr;
#pragma unroll
          for (int ai = 0; ai < 2; ++ai)
#pragma unroll
            for (int m = 0; m < 4; ++m) { const f32x4 a = SS[ai * 128 + m]; rsv[ai][m] = __builtin_amdgcn_rsqf(((a[0] + a[1]) + (a[2] + a[3])) * (1.0f / DMODEL) + EPS); }
#pragma unroll
          for (int ai = 0; ai < 2; ++ai)
#pragma unroll
            for (int m = 0; m < 4; ++m)
#pragma unroll
                for (int bj = 0; bj < 2; ++bj) { acc[ai][bj][m][0] *= rsv[ai][m]; acc[ai][bj][m][1] *= rsv[ai][m]; } }
        if (fr == 15) {
#pragma unroll
            for (int ai = 0; ai < 2; ++ai)
#pragma unroll
                for (int m = 2; m < 4; ++m) {
                    const int idx = ((((wr * 2 + ai) * 4 + wc) * 2 + (m - 2)) * 4 + fq) * 4;
                    hb[idx + 0] = acc[ai][0][m][0]; hb[idx + 1] = acc[ai][0][m][1]; hb[idx + 2] = acc[ai][1][m][0]; hb[idx + 3] = acc[ai][1][m][1];
                }
        }
        asm volatile("s_waitcnt lgkmcnt(0)" ::: "memory"); __builtin_amdgcn_s_barrier(); asm volatile("" ::: "memory");
        const int tf = (u.pm * 254) & 2047;
        if (dry < 2 || dry > 4) { if (tf <= 1 || tf + 253 >= 2048) body<true>(acc, u, wr, wc, fr, fq, hb, R0); else body<false>(acc, u, wr, wc, fr, fq, hb, R0); }
        asm volatile("s_waitcnt lgkmcnt(0)" ::: "memory"); __builtin_amdgcn_s_barrier(); asm volatile("" ::: "memory");
    }
};
}
namespace attn {
using pg8::bf16_t; using pg8::bf16x8; using pg8::f32x4; using pg8::u32x4;
typedef float f32x16 __attribute__((ext_vector_type(16)));
typedef short s16x4 __attribute__((ext_vector_type(4)));
#define AT_LAS __attribute__((address_space(3)))
constexpr int LD = 3072, SEQ = 2048;
constexpr int KT_BYTES = 16384, VT_BYTES = 16384, STG = KT_BYTES + VT_BYTES;
constexpr int L_X = 0;
constexpr int L_WSF = 2 * STG;
constexpr int L_OST = L_WSF + 8 * 256;
constexpr int LDS_BYTES = L_OST + 4 * 8192;
__device__ __forceinline__ int crow(int r, int hi) { return (r & 3) + 8 * (r >> 2) + 4 * hi; }
__device__ __forceinline__ unsigned cvtpk(float lo, float hi) { typedef float f2 __attribute__((ext_vector_type(2))); typedef __bf16 b2 __attribute__((ext_vector_type(2))); f2 v = {lo, hi}; b2 b = __builtin_convertvector(v, b2); return __builtin_bit_cast(unsigned, b); }
__device__ __forceinline__ s16x4 vtr(const AT_LAS char* p) { typedef short v4 __attribute__((ext_vector_type(4))); return __builtin_bit_cast(s16x4, __builtin_amdgcn_ds_read_tr16_b64_v4i16((AT_LAS v4*)p)); }

struct Params { bf16_t* qkv; float mb; float lam; int dry; };

template <int MODE = 0>
__device__ __forceinline__ void unit(const Params& P, int b, int h, int blk, AT_LAS char* lds, const int wave_s) {
    int tid = wave_s * 64 + HW_LANE(); asm volatile("" : "+v"(tid));
    const int lane = tid & 63, r32 = lane & 31, hi = lane >> 5;
    const int wid = __builtin_amdgcn_readfirstlane(tid >> 6), comp = wid >> 2, w4 = wid & 3;
    const size_t rowb = (size_t)b * SEQ;
    const int q0 = blk * 128;
    const int nt = 2 * blk + 2, my_nt = 2 * blk + (w4 >> 1) + 1;
    const bf16_t* Kg = P.qkv + rowb * LD + 1024 + h * 128;
    const bf16_t* Vg = P.qkv + rowb * LD + 2048 + h * 128;
    u32x4 kreg[2], vreg[2];
    int kdst[2], vdst[2];
#pragma unroll
    for (int i = 0; i < 2; ++i) {
        const int p = tid + 512 * i, key = p >> 4, c16 = p & 15;
        kdst[i] = key * 256 + ((c16 ^ (key & 15)) << 4);
        vdst[i] = KT_BYTES + (c16 >> 2) * 4096 + (key >> 4) * 1024 + ((key >> 3) & 1) * 512 + (key & 7) * 64 + (c16 & 3) * 16;
    }
#define AT_LOAD(t) do { _Pragma("unroll") for (int i = 0; i < 2; ++i) { const int p = tid + 512 * i, key = p >> 4, c16 = p & 15; const size_t go = (size_t)((t) * 64 + key) * LD + c16 * 8; \
        kreg[i] = *(const u32x4*)(Kg + go); vreg[i] = *(const u32x4*)(Vg + go); } } while (0)
#define AT_STORE(s) do { _Pragma("unroll") for (int i = 0; i < 2; ++i) { *(AT_LAS u32x4*)(lds + (s) * STG + kdst[i]) = kreg[i]; *(AT_LAS u32x4*)(lds + (s) * STG + vdst[i]) = vreg[i]; } } while (0)
    AT_LOAD(0);
    bf16x8 qr[4];
    {
        const bf16_t* Qw = P.qkv + (rowb + q0 + w4 * 32 + r32) * LD + h * 128 + comp * 64 + hi * 8;
#pragma unroll
        for (int d0 = 0; d0 < 4; ++d0) qr[d0] = *(const bf16x8*)(Qw + d0 * 16);
    }
    AT_STORE(0);
    __syncthreads();
    f32x16 o[4];
#pragma unroll
    for (int i = 0; i < 4; ++i)
#pragma unroll
        for (int r = 0; r < 16; ++r) o[i][r] = 0.f;
    float lsum = 0.f;
    f32x16 negm;
#pragma unroll
    for (int r = 0; r < 16; ++r) negm[r] = -P.mb;
    const int kbase = r32 * 256, ksw = r32 & 15;
    const int vbase = KT_BYTES + ((lane >> 4) & 1) * 32 + (lane & 3) * 8 + (4 * hi + ((lane & 15) >> 2)) * 64;
    for (int t = 0; t < nt; ++t) {
        const int s = t & 1;
        if (MODE != 4) { if (t + 1 < nt) AT_LOAD(t + 1); }
        if (t < my_nt) {
            const AT_LAS char* st = lds + s * STG;
            bf16x8 kf[8];
#pragma unroll
            for (int d0 = 0; d0 < 4; ++d0) {
                const int ch = comp * 8 + 2 * d0 + hi;
                kf[2 * d0] = *(const AT_LAS bf16x8*)(st + kbase + ((ch ^ ksw) << 4));
                kf[2 * d0 + 1] = *(const AT_LAS bf16x8*)(st + kbase + 32 * 256 + ((ch ^ ksw) << 4));
            }
            s16x4 vlo[2][4], vhi[2][4];
#define AT_VLOAD(bk, buf) do { _Pragma("unroll") for (int ks = 0; ks < 4; ++ks) { vlo[buf][ks] = vtr(st + vbase + (bk) * 4096 + ks * 1024); vhi[buf][ks] = vtr(st + vbase + (bk) * 4096 + ks * 1024 + 512); } } while (0)
            AT_VLOAD(0, 0);
            __builtin_amdgcn_sched_barrier(0);
            f32x16 p0 = negm, p1 = negm;
            if (MODE != 3) {
#pragma unroll
            for (int d0 = 0; d0 < 4; ++d0) {
                p0 = __builtin_amdgcn_mfma_f32_32x32x16_bf16(kf[2 * d0], qr[d0], p0, 0, 0, 0);
                p1 = __builtin_amdgcn_mfma_f32_32x32x16_bf16(kf[2 * d0 + 1], qr[d0], p1, 0, 0, 0);
            } }
            __builtin_amdgcn_sched_barrier(0);
            AT_VLOAD(1, 1);
            __builtin_amdgcn_sched_barrier(0);
            float sacc0 = 0.f, sacc1 = 0.f;
#pragma unroll
            for (int r = 0; r < 16; ++r) { if (MODE != 1) { p0[r] = __builtin_amdgcn_exp2f(p0[r]); p1[r] = __builtin_amdgcn_exp2f(p1[r]); } sacc0 += p0[r]; sacc1 += p1[r]; }
            lsum += sacc0 + sacc1;
            u32x4 pw[4];
#pragma unroll
            for (int j = 0; j < 4; ++j) { pw[0][j] = cvtpk(p0[2 * j], p0[2 * j + 1]); pw[1][j] = cvtpk(p0[8 + 2 * j], p0[8 + 2 * j + 1]); pw[2][j] = cvtpk(p1[2 * j], p1[2 * j + 1]); pw[3][j] = cvtpk(p1[8 + 2 * j], p1[8 + 2 * j + 1]); }
#define AT_PV(bk, buf) do { _Pragma("unroll") for (int ks = 0; ks < 4; ++ks) { \
                const bf16x8 vf = {vlo[buf][ks][0], vlo[buf][ks][1], vlo[buf][ks][2], vlo[buf][ks][3], vhi[buf][ks][0], vhi[buf][ks][1], vhi[buf][ks][2], vhi[buf][ks][3]}; \
                if (MODE != 2) o[bk] = __builtin_amdgcn_mfma_f32_32x32x16_bf16(__builtin_bit_cast(bf16x8, pw[ks]), vf, o[bk], 0, 0, 0); else asm volatile("" :: "v"(pw[ks])); } } while (0)
            __builtin_amdgcn_sched_barrier(0);
            AT_PV(0, 0); __builtin_amdgcn_sched_barrier(0); AT_VLOAD(2, 0); __builtin_amdgcn_sched_barrier(0);
            AT_PV(1, 1); __builtin_amdgcn_sched_barrier(0); AT_VLOAD(3, 1); __builtin_amdgcn_sched_barrier(0);
            AT_PV(2, 0);
            AT_PV(3, 1);
#undef AT_VLOAD
#undef AT_PV
        }
        if (MODE != 4) { if (t + 1 < nt) AT_STORE(s ^ 1); }
        if (MODE != 5) __syncthreads();
    }
    lsum = xl_swap32_sum(lsum);
    AT_LAS float* wsf = (AT_LAS float*)(lds + L_WSF) + wid * 64;
    if (hi == 0) wsf[r32] = lsum;
    asm volatile("s_waitcnt lgkmcnt(0)" ::: "memory");
    float rl[16];
    const float sc = comp ? P.lam : 1.0f;
#pragma unroll
    for (int r = 0; r < 16; ++r) rl[r] = sc * __builtin_amdgcn_rcpf(wsf[crow(r, hi)]);
    AT_LAS float* X = (AT_LAS float*)(lds + L_X) + w4 * 4096 + lane;
    if (comp == 1) {
#pragma unroll
        for (int bk = 0; bk < 4; ++bk)
#pragma unroll
            for (int r = 0; r < 16; ++r) X[(bk * 16 + r) * 64] = o[bk][r] * rl[r];
    }
    __syncthreads();
    if (comp == 0) {
        float ss[16];
#pragma unroll
        for (int r = 0; r < 16; ++r) ss[r] = 0.f;
#pragma unroll
        for (int bk = 0; bk < 4; ++bk)
#pragma unroll
            for (int r = 0; r < 16; ++r) { const float v = o[bk][r] * rl[r] - X[(bk * 16 + r) * 64]; o[bk][r] = v; ss[r] += v * v; }
#pragma unroll
        for (int r = 0; r < 16; ++r) {
            float s = ss[r];
            s = xl_swap16_sum(xl_sum16(s));
            ss[r] = __builtin_amdgcn_rsqf(s * (1.0f / 128.0f) + 1e-6f);
        }
        AT_LAS bf16_t* stg = (AT_LAS bf16_t*)(lds + L_OST) + w4 * 4096;
#pragma unroll
        for (int bk = 0; bk < 4; ++bk)
#pragma unroll
            for (int r = 0; r < 16; ++r) { const float v = o[bk][r] * ss[r]; stg[crow(r, hi) * 128 + bk * 32 + r32] = (bf16_t)(cvtpk(v, 0.f) & 0xffffu); }
        asm volatile("s_waitcnt lgkmcnt(0)" ::: "memory");
        bf16_t* Ow = P.qkv + (rowb + q0 + w4 * 32) * LD + h * 128;
#pragma unroll
        for (int i = 0; i < 8; ++i) { const int row = i * 4 + (lane >> 4), c = lane & 15; const u32x4 v = *(const AT_LAS u32x4*)(stg + row * 128 + c * 8); if (!P.dry) *(u32x4*)(Ow + (size_t)row * LD + c * 8) = v; }
    }
    __syncthreads();
#undef AT_LOAD
#undef AT_STORE
}
}
namespace scan {
using pg8::bf16_t; using pg8::bf16x8; using pg8::f32x4; using pg8::u32x4; using pg8::u32x2;
typedef float f32x16 __attribute__((ext_vector_type(16)));
#define SC_LAS __attribute__((address_space(3)))
#define SC_BAR() do { asm volatile("s_waitcnt lgkmcnt(0)" ::: "memory"); __builtin_amdgcn_s_barrier(); asm volatile("" ::: "memory"); } while (0)
constexpr int SEQ = 2048, CH = 64;
constexpr int L_C = 0;
constexpr int L_B = 16384;
constexpr int L_XD = 32768;
constexpr int L_XW = 40960;
constexpr int L_G = 49152;
constexpr int L_H = 57344;
constexpr int L_Y = 73728;
constexpr int L_S = L_Y + 64 * 68 * 4;
constexpr int LDS_BYTES = L_S + 32 * 1024;
__device__ __forceinline__ unsigned cvtpk(float lo, float hi) { typedef float f2 __attribute__((ext_vector_type(2))); typedef __bf16 b2 __attribute__((ext_vector_type(2))); f2 v = {lo, hi}; b2 b = __builtin_convertvector(v, b2); return __builtin_bit_cast(unsigned, b); }
typedef short s16x4 __attribute__((ext_vector_type(4)));
__device__ __forceinline__ s16x4 vtr(const SC_LAS char* p) { typedef short v4 __attribute__((ext_vector_type(4))); return __builtin_bit_cast(s16x4, __builtin_amdgcn_ds_read_tr16_b64_v4i16((SC_LAS v4*)p)); }
__device__ __forceinline__ float lo16(unsigned w) { return __builtin_bit_cast(float, w << 16); }
__device__ __forceinline__ float hi16(unsigned w) { return __builtin_bit_cast(float, w & 0xffff0000u); }
__device__ __forceinline__ int img_off(int l) { return (l >> 4) * 1024 + ((l >> 3) & 1) * 512 + (l & 7) * 64; }

struct Params { const bf16_t* xbc; bf16_t* zp; const float* dt; const float* a_log; const float* dskip; float* ssqp; int dry; };

__device__ __forceinline__ void unit(const Params& P, int b, int h, SC_LAS char* lds, const int wave_s) {
    int tid = wave_s * 64 + HW_LANE(); asm volatile("" : "+v"(tid));
    const int wid = __builtin_amdgcn_readfirstlane(tid >> 6);
    const int g = h >> 3;
    const size_t rowb = (size_t)b * SEQ;
    const float a_h = -expf(P.a_log[h]), dsk = P.dskip[h];
    unsigned zu = 0u; asm volatile("" : "+v"(zu));
    {
        const int lane_ = tid & 63;
#pragma unroll
        for (int q = 0; q < 4; ++q) {
            const int cc = wid * 4 + q;
            const float dtv = P.dt[(rowb + cc * 64 + lane_) * 32 + h];
            float acs = dtv * a_h;
            acs = xl_scan64(acs);
            const float last = __builtin_bit_cast(float, __builtin_amdgcn_readlane(__builtin_bit_cast(int, acs), 63));
            SC_LAS float* sc = (SC_LAS float*)(lds + L_S) + cc * 256;
            sc[lane_] = dtv; sc[64 + lane_] = acs; sc[128 + lane_] = __expf(last - acs); sc[192 + lane_] = __expf(acs);
        }
    }
    for (int i = tid; i < 16384 / 16; i += 512) *(SC_LAS u32x4*)(lds + L_H + i * 16) = (u32x4){zu, zu, zu, zu};
    f32x16 hacc0, hacc1;
#pragma unroll
    for (int r = 0; r < 16; ++r) { hacc0[r] = 0.f; hacc1[r] = 0.f; }
    const int tid0 = tid;
    u32x4 xr, zr, br[2], cr[2];
#define SC_LOAD(t0_, XR, ZR) do { const int t_ = tid0; const size_t r1 = rowb + (t0_) + (t_ >> 3); \
        XR = *(const u32x4*)(P.xbc + r1 * 3072 + h * 64 + (t_ & 7) * 8); ZR = *(const u32x4*)(P.zp + r1 * 2048 + h * 64 + (t_ & 7) * 8); \
        _Pragma("unroll") for (int i = 0; i < 2; ++i) { const int p_ = t_ + 512 * i; const size_t r2 = rowb + (t0_) + (p_ >> 4); \
            br[i] = *(const u32x4*)(P.xbc + r2 * 3072 + 2048 + g * 128 + (p_ & 15) * 8); cr[i] = *(const u32x4*)(P.xbc + r2 * 3072 + 2560 + g * 128 + (p_ & 15) * 8); } } while (0)
    SC_LOAD(0, xr, zr);
    __syncthreads();
    for (int c = 0; c < SEQ / CH; ++c) {
        const int t0 = c * CH;
        int tid = tid0; asm volatile("" : "+v"(tid));
        const int lane = tid & 63, r32 = lane & 31, hi = lane >> 5, fr = lane & 15, fq = lane >> 4;
        const int orow = tid >> 3, ocg = tid & 7;
        SC_LAS float* s_dt = (SC_LAS float*)(lds + L_S) + c * 256; SC_LAS float* s_acs = s_dt + 64; SC_LAS float* s_dec = s_dt + 128; SC_LAS float* s_ea = s_dt + 192;
        {
            const float d = s_dt[orow], dd = d * s_dec[orow];
            u32x4 w1, w2;
#pragma unroll
            for (int i = 0; i < 4; ++i) { const float a = lo16(xr[i]), bq = hi16(xr[i]); w1[i] = cvtpk(a * d, bq * d); w2[i] = cvtpk(a * dd, bq * dd); }
            const int off = (ocg >> 2) * 4096 + img_off(orow) + (ocg & 3) * 16;
            *(SC_LAS u32x4*)(lds + L_XD + off) = w1; *(SC_LAS u32x4*)(lds + L_XW + off) = w2;
#pragma unroll
            for (int i = 0; i < 2; ++i) { const int p = tid + 512 * i, l = p >> 4, c16 = p & 15;
                *(SC_LAS u32x4*)(lds + L_B + (c16 >> 2) * 4096 + img_off(l) + (c16 & 3) * 16) = br[i];
                *(SC_LAS u32x4*)(lds + L_C + l * 256 + ((c16 ^ (l & 15)) << 4)) = cr[i]; }
        }
        const u32x4 xcur = xr, zcur = zr;
        if (c + 1 < SEQ / CH) SC_LOAD(t0 + CH, xr, zr);
        SC_BAR();
        f32x16 yacc;
#pragma unroll
        for (int r = 0; r < 16; ++r) yacc[r] = 0.f;
        const int yli = (wid >> 1) & 1, ypi = wid & 1;
        if (wid < 3) {
            const int si = (wid == 2) ? 1 : 0, li = (wid == 0) ? 0 : 1;
            const int srow = 32 * si + r32, lrow = 32 * li + r32;
            f32x16 cb;
#pragma unroll
            for (int r = 0; r < 16; ++r) cb[r] = 0.f;
            bf16x8 fa[8], fb[8];
#pragma unroll
            for (int ks = 0; ks < 8; ++ks) {
                const int chk = 2 * ks + hi;
                fa[ks] = *(const SC_LAS bf16x8*)(lds + L_B + (chk >> 2) * 4096 + img_off(srow) + (chk & 3) * 16);
                fb[ks] = *(const SC_LAS bf16x8*)(lds + L_C + lrow * 256 + ((chk ^ (lrow & 15)) << 4));
            }
            __builtin_amdgcn_sched_barrier(0);
#pragma unroll
            for (int ks = 0; ks < 8; ++ks) cb = __builtin_amdgcn_mfma_f32_32x32x16_bf16(fa[ks], fb[ks], cb, 0, 0, 0);
            const float al = s_acs[lrow];
#pragma unroll
            for (int q4 = 0; q4 < 4; ++q4) {
                const int s0 = 32 * si + 8 * q4 + 4 * hi;
                float gv[4];
#pragma unroll
                for (int e = 0; e < 4; ++e) { const int sidx = s0 + e; gv[e] = (sidx <= lrow) ? cb[4 * q4 + e] * __expf(al - s_acs[sidx]) : 0.f; }
                u32x2 w; w.x = cvtpk(gv[0], gv[1]); w.y = cvtpk(gv[2], gv[3]);
                *(SC_LAS u32x2*)(lds + L_G + lrow * 128 + (((s0 >> 3) ^ (lrow & 7)) << 4) + (s0 & 7) * 2) = w;
            }
        } else if (wid >= 4) {
            const int lrow = 32 * yli + r32, prow = 32 * ypi + r32;
            bf16x8 fa[8], fb[8];
#pragma unroll
            for (int ks = 0; ks < 8; ++ks) {
                const int chk = 2 * ks + hi;
                fa[ks] = *(const SC_LAS bf16x8*)(lds + L_C + lrow * 256 + ((chk ^ (lrow & 15)) << 4));
                fb[ks] = *(const SC_LAS bf16x8*)(lds + L_H + prow * 256 + ((chk ^ (prow & 15)) << 4));
            }
            __builtin_amdgcn_sched_barrier(0);
#pragma unroll
            for (int ks = 0; ks < 8; ++ks) yacc = __builtin_amdgcn_mfma_f32_32x32x16_bf16(fa[ks], fb[ks], yacc, 0, 0, 0);
        }
        SC_BAR();
        if (wid >= 4) {
#pragma unroll
            for (int r = 0; r < 16; ++r) yacc[r] *= s_ea[32 * yli + (r & 3) + 8 * (r >> 2) + 4 * hi];
            const int lrow = 32 * yli + r32;
            const int tbn = ((lane >> 4) & 1) * 32 + (lane & 3) * 8 + hi * 512 + ((lane & 15) >> 2) * 64;
            bf16x8 ga[4]; s16x4 xb0[4], xb1[4];
#pragma unroll
            for (int ks = 0; ks < 4; ++ks) {
                const int chk = 2 * ks + hi;
                ga[ks] = *(const SC_LAS bf16x8*)(lds + L_G + lrow * 128 + ((chk ^ (lrow & 7)) << 4));
                xb0[ks] = vtr(lds + L_XD + ypi * 4096 + ks * 1024 + tbn); xb1[ks] = vtr(lds + L_XD + ypi * 4096 + ks * 1024 + tbn + 256);
            }
            __builtin_amdgcn_sched_barrier(0);
#pragma unroll
            for (int ks = 0; ks < 4; ++ks) {
                if (ks < 2 * (yli + 1)) {
                    const bf16x8 bb = {xb0[ks][0], xb0[ks][1], xb0[ks][2], xb0[ks][3], xb1[ks][0], xb1[ks][1], xb1[ks][2], xb1[ks][3]};
                    yacc = __builtin_amdgcn_mfma_f32_32x32x16_bf16(ga[ks], bb, yacc, 0, 0, 0);
                }
            }
#pragma unroll
            for (int r = 0; r < 16; ++r) ((SC_LAS float*)(lds + L_Y))[(32 * yli + (r & 3) + 8 * (r >> 2) + 4 * hi) * 68 + 32 * ypi + r32] = yacc[r];
        } else {
            const float cd = __expf(s_acs[63]);
#pragma unroll
            for (int r = 0; r < 16; ++r) { hacc0[r] *= cd; hacc1[r] *= cd; }
            const int tb = ((lane >> 4) & 1) * 32 + (lane & 3) * 8 + (4 * hi + ((lane & 15) >> 2)) * 64;
            s16x4 a0[4], a1[4], b0[4], b1[4], c0[4], c1[4];
#pragma unroll
            for (int ks = 0; ks < 4; ++ks) {
                a0[ks] = vtr(lds + L_B + wid * 4096 + ks * 1024 + tb); a1[ks] = vtr(lds + L_B + wid * 4096 + ks * 1024 + 512 + tb);
                b0[ks] = vtr(lds + L_XW + ks * 1024 + tb); b1[ks] = vtr(lds + L_XW + ks * 1024 + 512 + tb);
                c0[ks] = vtr(lds + L_XW + 4096 + ks * 1024 + tb); c1[ks] = vtr(lds + L_XW + 4096 + ks * 1024 + 512 + tb);
            }
            __builtin_amdgcn_sched_barrier(0);
#pragma unroll
            for (int ks = 0; ks < 4; ++ks) {
                const bf16x8 a = {a0[ks][0], a0[ks][1], a0[ks][2], a0[ks][3], a1[ks][0], a1[ks][1], a1[ks][2], a1[ks][3]};
                const bf16x8 bb = {b0[ks][0], b0[ks][1], b0[ks][2], b0[ks][3], b1[ks][0], b1[ks][1], b1[ks][2], b1[ks][3]};
                const bf16x8 cc = {c0[ks][0], c0[ks][1], c0[ks][2], c0[ks][3], c1[ks][0], c1[ks][1], c1[ks][2], c1[ks][3]};
                hacc0 = __builtin_amdgcn_mfma_f32_32x32x16_bf16(a, bb, hacc0, 0, 0, 0);
                hacc1 = __builtin_amdgcn_mfma_f32_32x32x16_bf16(a, cc, hacc1, 0, 0, 0);
            }
#pragma unroll
            for (int q4 = 0; q4 < 4; ++q4) {
                const int n0 = 32 * wid + 8 * q4 + 4 * hi;
                u32x2 w0, w1; w0.x = cvtpk(hacc0[4 * q4 + 0], hacc0[4 * q4 + 1]); w0.y = cvtpk(hacc0[4 * q4 + 2], hacc0[4 * q4 + 3]);
                w1.x = cvtpk(hacc1[4 * q4 + 0], hacc1[4 * q4 + 1]); w1.y = cvtpk(hacc1[4 * q4 + 2], hacc1[4 * q4 + 3]);
                *(SC_LAS u32x2*)(lds + L_H + r32 * 256 + (((n0 >> 3) ^ (r32 & 15)) << 4) + (n0 & 7) * 2) = w0;
                *(SC_LAS u32x2*)(lds + L_H + (32 + r32) * 256 + (((n0 >> 3) ^ (r32 & 15)) << 4) + (n0 & 7) * 2) = w1;
            }
        }
        SC_BAR();
        {
            const SC_LAS float* yr = (const SC_LAS float*)(lds + L_Y) + orow * 68 + ocg * 8;
            const f32x4 y0 = *(const SC_LAS f32x4*)yr, y1 = *(const SC_LAS f32x4*)(yr + 4);
            float yv[8];
#pragma unroll
            for (int i = 0; i < 4; ++i) {
                const float ya = (i < 2) ? y0[2 * i] : y1[2 * i - 4], yb = (i < 2) ? y0[2 * i + 1] : y1[2 * i - 3];
                yv[2 * i] = (ya + dsk * lo16(xcur[i])) * lo16(zcur[i]); yv[2 * i + 1] = (yb + dsk * hi16(xcur[i])) * hi16(zcur[i]);
            }
            float ss = 0.f;
#pragma unroll
            for (int i = 0; i < 8; ++i) ss += yv[i] * yv[i];
            ss = xl_sum8(ss);
            if (ocg == 0) P.ssqp[(rowb + t0 + orow) * 32 + h] = ss;
            u32x4 w; w.x = cvtpk(yv[0], yv[1]); w.y = cvtpk(yv[2], yv[3]); w.z = cvtpk(yv[4], yv[5]); w.w = cvtpk(yv[6], yv[7]);
            if (!P.dry) *(u32x4*)(P.zp + (rowb + t0 + orow) * 2048 + h * 64 + ocg * 8) = w;
        }
    }
    __syncthreads();
#undef SC_LOAD
}
}
namespace mk {
#define GAS __attribute__((address_space(1)))
#define LAS __attribute__((address_space(3)))
typedef unsigned short bf16;
typedef unsigned v4u __attribute__((ext_vector_type(4)));
typedef float f32x4 __attribute__((ext_vector_type(4)));
typedef GAS unsigned gu32;
#define RLX_AGENT __ATOMIC_RELAXED, __HIP_MEMORY_SCOPE_AGENT
constexpr int NWAVES = 8;
constexpr int M = 16384, D = 1024, SEQ = 2048, NB = 8;
constexpr int SSD_NP = 5376, SSD_IN = 5152, SSD_DI = 2048, SSD_LD = 5120;
constexpr int AT_IN = 3072, DFF = 2816;
constexpr size_t MiB = 1u << 20;
constexpr size_t WS_CTL = 0, CTL_ZERO_BYTES = 64 * 1024;
constexpr size_t WS_CONST = 64 * 1024;
constexpr size_t WS_SSQ = 1 * MiB;
constexpr size_t WS_ROPE = 2 * MiB;
constexpr size_t WS_DT = 3 * MiB;
constexpr size_t WS_SSQP = 5 * MiB;
constexpr size_t WS_CP = 1 * MiB + 512 * 1024;
constexpr size_t WS_W = 7 * MiB;
constexpr size_t W_SSD_IN = 0, W_SSD_IN_SZ = (size_t)SSD_NP * D * 2;
constexpr size_t W_SSD_OUT = W_SSD_IN + 2 * W_SSD_IN_SZ, W_SSD_OUT_SZ = (size_t)D * SSD_DI * 2;
constexpr size_t W_AT_IN = W_SSD_OUT + 2 * W_SSD_OUT_SZ, W_AT_IN_SZ = (size_t)AT_IN * D * 2;
constexpr size_t W_AT_OUT = W_AT_IN + 2 * W_AT_IN_SZ, W_AT_OUT_SZ = (size_t)D * D * 2;
constexpr size_t W_UP = W_AT_OUT + 2 * W_AT_OUT_SZ, W_UP_SZ = (size_t)2 * DFF * D * 2;
constexpr size_t W_DOWN = W_UP + 4 * W_UP_SZ, W_DOWN_SZ = (size_t)D * DFF * 2;
constexpr size_t W_TOTAL = W_DOWN + 4 * W_DOWN_SZ;
constexpr size_t WS_XB = ((WS_W + W_TOTAL + MiB - 1) / MiB) * MiB;
constexpr size_t XB_PAD_FRONT = 4 * D * 2, XB_BYTES = (size_t)(M + 260) * D * 2;
constexpr size_t WS_BIG = ((WS_XB + XB_BYTES + MiB - 1) / MiB) * MiB;
constexpr size_t BIG_BYTES = (size_t)M * SSD_LD * 2;
constexpr size_t WS_DBG = WS_BIG + BIG_BYTES;
constexpr size_t WS_END = WS_DBG + (size_t)M * D * 2;
static_assert(WS_END <= 352 * MiB, "workspace map exceeds the guaranteed 352 MiB");
constexpr int CW_BAR = 1024;
constexpr int RING_BYTES = 131072, EPI_OFF = RING_BYTES, EPI_BYTES = 26624, MISC_OFF = EPI_OFF + EPI_BYTES;
constexpr int LDS_BYTES = 158720;
static_assert(MISC_OFF + 1024 <= LDS_BYTES && attn::LDS_BYTES <= RING_BYTES && scan::LDS_BYTES <= RING_BYTES, "LDS map");

#define LDS_WAIT() asm volatile("s_waitcnt lgkmcnt(0)" ::: "memory")
__device__ __forceinline__ unsigned f2bf(float f) { unsigned u = __builtin_bit_cast(unsigned, f); return (u + 0x7fffu + ((u >> 16) & 1u)) >> 16; }
__device__ __forceinline__ unsigned pk2(float lo, float hi) { return f2bf(lo) | (f2bf(hi) << 16); }
template <bool F16> __device__ __forceinline__ unsigned pk2x(float lo, float hi) { if constexpr (F16) return epi::pk_f16(lo, hi); else return pk2(lo, hi); }

#define XB_TMO      128
#define XB_XCNT(j)  (256  + 64 * (j))
#define XB_XSUB(j)  (1280 + 64 * (j))
#define XB_XGEN(j)  (2304 + 64 * (j))
#define XB_TOP      3328
#define XB_TOPGEN   3392
#define XCD_BAR_WORDS 3456
#define XB_SPIN_CAP (1u << 20)
__device__ __forceinline__ unsigned xb_ld(unsigned* p)              { return __hip_atomic_load(p, __ATOMIC_RELAXED, __HIP_MEMORY_SCOPE_AGENT); }
__device__ __forceinline__ unsigned xb_add(unsigned* p, unsigned v) { return __hip_atomic_fetch_add(p, v, __ATOMIC_RELAXED, __HIP_MEMORY_SCOPE_AGENT); }
__device__ __forceinline__ unsigned xb_xcc_id() { return (unsigned)__builtin_amdgcn_s_getreg((3 << 11) | 20) & 0xFu; }
#define XB_SPIN(cond, bar) do { unsigned _sp = 0; while (cond) { __builtin_amdgcn_s_sleep(1); \
    if ((++_sp & 255u) == 0u) { if (xb_ld(&(bar)[XB_TMO])) break; if (_sp > XB_SPIN_CAP) { atomicAdd(&(bar)[XB_TMO], 1u); break; } } } } while (0)
struct XcdBarrier { unsigned* bar; unsigned x; volatile LAS unsigned* st; };
__device__ __forceinline__ XcdBarrier xcd_barrier_post(unsigned* bar, volatile LAS unsigned* st, bool leader) {
    XcdBarrier b; b.bar = bar; b.x = xb_xcc_id(); b.st = st;
    if (leader) (void)xb_add(&bar[XB_XCNT(b.x)], 1u);
    return b;
}
__device__ __forceinline__ void xcd_barrier_complete(unsigned* bar, unsigned x, unsigned& nloc, unsigned& nx) {
    const unsigned G = gridDim.x * gridDim.y * gridDim.z;
    unsigned sum, cnt, mine, sp = 0u;
    for (;;) {
        sum = 0u; cnt = 0u; mine = 0u;
#pragma unroll
        for (unsigned j = 0; j < 16; ++j) { const unsigned c = xb_ld(&bar[XB_XCNT(j)]); sum += c; cnt += (c > 0u) ? 1u : 0u; mine = (j == x) ? c : mine; }
        if (sum == G) break;
        __builtin_amdgcn_s_sleep(1);
        if ((++sp & 255u) == 0u) { if (xb_ld(&bar[XB_TMO])) break; if (sp > XB_SPIN_CAP) { atomicAdd(&bar[XB_TMO], 1u); break; } }
    }
    nloc = mine > 0u ? mine : 1u; nx = cnt > 0u ? cnt : 1u;
}
__device__ __forceinline__ void xcd_barrier(const XcdBarrier& b, const int wave_s) {
    asm volatile("s_waitcnt vmcnt(0)" ::: "memory");
    __syncthreads();
    if (wave_s == 0 && HW_LANE() == 0) {
        unsigned* bar = b.bar; asm volatile("" : "+s"(bar));
        __builtin_amdgcn_s_waitcnt(0);
        unsigned nloc = b.st[0], nx = b.st[1];
        if (nloc == 0u) { xcd_barrier_complete(bar, b.x, nloc, nx); b.st[0] = nloc; b.st[1] = nx; }
        const unsigned old = xb_add(&bar[XB_XSUB(b.x)], 1u);
        const unsigned gen = old / nloc;
        if (old + 1u == (gen + 1u) * nloc) {
            __builtin_amdgcn_fence(__ATOMIC_RELEASE, "agent");
            asm volatile("s_waitcnt vmcnt(0)" ::: "memory");
            const unsigned og = xb_add(&bar[XB_TOP], 1u);
            const unsigned tg = og / nx;
            if (og + 1u == (tg + 1u) * nx) xb_add(&bar[XB_TOPGEN], 1u);
            else XB_SPIN(xb_ld(&bar[XB_TOPGEN]) == tg, bar);
            __builtin_amdgcn_fence(__ATOMIC_ACQUIRE, "agent");
            xb_add(&bar[XB_XGEN(b.x)], 1u);
            asm volatile("s_waitcnt vmcnt(0)" ::: "memory");
        } else {
            XB_SPIN(xb_ld(&bar[XB_XGEN(b.x)]) == gen, bar);
            __builtin_amdgcn_fence(__ATOMIC_ACQUIRE, "agent");
            asm volatile("s_waitcnt vmcnt(0)" ::: "memory");
        }
    }
    __syncthreads();
}

__device__ __forceinline__ unsigned long long ldarg(LAS unsigned long long* AP, int i) {
    asm volatile("" : "+s"(i));
    const unsigned long long v = AP[i];
    return ((unsigned long long)(unsigned)__builtin_amdgcn_readfirstlane((int)(v >> 32)) << 32) | (unsigned long long)(unsigned)__builtin_amdgcn_readfirstlane((int)v);
}
struct Args { const void* in[25]; float* out; unsigned char* ws; int ph_lo, ph_hi; int dbg, pad; };

__device__ __forceinline__ float wave_sum(float v) {
    return xl_sum64(v);
}
template <bool F16  , class RowMap>
__device__ __forceinline__ void transpose_item(const float* W, int K, int N, const float* gain, int gmask, float gscale, bf16* WT, const RowMap& rm, LAS float* scr, int item, int item2, int lane) {
    const int nblk = N / 32, rs = lane >> 3, c4 = lane & 7, c = lane & 7;
    f32x4 va[8], vb[8]; float ga[8], gb[8];
    const int kA = 64 * (item / nblk), nA = 32 * (item % nblk);
    const int it2 = item2 < 0 ? item : item2; const int kB = 64 * (it2 / nblk), nB = 32 * (it2 % nblk);
#pragma unroll
    for (int i = 0; i < 8; ++i) { const int kk = 8 * i + rs; va[i] = *(const f32x4*)(W + (size_t)(kA + kk) * N + nA + 4 * c4); ga[i] = gain ? gain[(kA + kk) & gmask] * gscale : 1.0f; }
    if (item2 >= 0) {
#pragma unroll
        for (int i = 0; i < 8; ++i) { const int kk = 8 * i + rs; vb[i] = *(const f32x4*)(W + (size_t)(kB + kk) * N + nB + 4 * c4); gb[i] = gain ? gain[(kB + kk) & gmask] * gscale : 1.0f; }
    }
#pragma unroll
    for (int h = 0; h < 2; ++h) {
        if (h == 1 && item2 < 0) break;
        const int k0 = h ? kB : kA, n0 = h ? nB : nA;
#pragma unroll
        for (int i = 0; i < 8; ++i) { const int kk = 8 * i + rs; LAS float* d = scr + kk * 33 + 4 * c4; const f32x4 v = h ? vb[i] : va[i]; const float g = h ? gb[i] : ga[i]; d[0] = v[0] * g; d[1] = v[1] * g; d[2] = v[2] * g; d[3] = v[3] * g; }
        LDS_WAIT(); asm volatile("" ::: "memory");
#pragma unroll
        for (int j = 0; j < 4; ++j) { const int n = (lane >> 3) + 8 * j; const LAS float* sp = scr + (8 * c) * 33 + n;
            v4u o; o.x = pk2x<F16>(sp[0 * 33], sp[1 * 33]); o.y = pk2x<F16>(sp[2 * 33], sp[3 * 33]); o.z = pk2x<F16>(sp[4 * 33], sp[5 * 33]); o.w = pk2x<F16>(sp[6 * 33], sp[7 * 33]);
            *(GAS v4u*)(WT + (size_t)rm(n0 + n) * K + k0 + 8 * c) = o; }
        LDS_WAIT(); asm volatile("" ::: "memory");
    }
}
struct RowId { __device__ __forceinline__ int operator()(int n) const { return n; } };
struct RowUp { __device__ __forceinline__ int operator()(int n) const { const int u = n >= DFF, ch = u ? n - DFF : n; return (ch >> 7) * 256 + u * 128 + (ch & 127); } };

__global__ void __launch_bounds__(NWAVES * 64, 2) mega_fwd(Args args) {
    extern __shared__ __attribute__((aligned(16))) unsigned char lds_raw[];
    LAS unsigned char* lds = (LAS unsigned char*)lds_raw;
    volatile LAS unsigned* MISC = (volatile LAS unsigned*)(lds + MISC_OFF);
    const int G = gridDim.x; const int bx = blockIdx.x; const int vcu = (G % 8 == 0) ? (bx % 8) * (G / 8) + bx / 8 : bx;
    gu32* ctl = (gu32*)(args.ws + WS_CTL);
    const int wave_s = __builtin_amdgcn_readfirstlane((int)threadIdx.x >> 6);
    if (wave_s == 0) MISC[HW_LANE()] = 0u;
    __syncthreads();
    XcdBarrier bar = xcd_barrier_post((unsigned*)ctl + CW_BAR, MISC + 8, wave_s == 0 && HW_LANE() == 0);
#define GRID_BAR() xcd_barrier(bar, wave_s)
    LAS unsigned long long* AP = (LAS unsigned long long*)(lds + MISC_OFF + 256);
    if (wave_s == 0 && HW_LANE() < 27) AP[HW_LANE()] = ((const unsigned long long*)&args)[HW_LANE()];
    __syncthreads();
#define ARGP(T, i) ((T)(GAS void*)ldarg(AP, i))
#define x_in   ARGP(const float*, 0)
#define pos    ARGP(const int*, 1)
#define nmg    ARGP(const float*, 2)
#define nfg    ARGP(const float*, 3)
#define s_inw  ARGP(const float*, 4)
#define s_cw   ARGP(const float*, 5)
#define s_cb   ARGP(const float*, 6)
#define s_dtb  ARGP(const float*, 7)
#define s_alog ARGP(const float*, 8)
#define s_d    ARGP(const float*, 9)
#define s_ng   ARGP(const float*, 10)
#define s_ow   ARGP(const float*, 11)
#define a_inw  ARGP(const float*, 12)
#define a_qg   ARGP(const float*, 13)
#define a_kg   ARGP(const float*, 14)
#define a_lq1  ARGP(const float*, 15)
#define a_lk1  ARGP(const float*, 16)
#define a_lq2  ARGP(const float*, 17)
#define a_lk2  ARGP(const float*, 18)
#define a_sg   ARGP(const float*, 19)
#define a_ow   ARGP(const float*, 20)
#define f_uw   ARGP(const float*, 21)
#define f_cw   ARGP(const float*, 22)
#define f_cb   ARGP(const float*, 23)
#define f_dw   ARGP(const float*, 24)
#define xout   ARGP(float*, 25)
#define ws     ARGP(unsigned char*, 26)
#define cst    ((float*)(ws + WS_CONST))
#define SSQ    ((float*)(ws + WS_SSQ))
#define ROPE   ((float*)(ws + WS_ROPE))
#define DT     ((float*)(ws + WS_DT))
#define SSQP   ((float*)(ws + WS_SSQP))
#define Wb     ((bf16*)(ws + WS_W))
#define XB     ((bf16*)(ws + WS_XB + XB_PAD_FRONT))
#define BIG    ((bf16*)(ws + WS_BIG))
#define XLO    ((bf16*)(ws + WS_DBG))
#define CPT    ((float*)(ws + WS_CP))
#define ZPL    ((bf16*)(ws + WS_BIG))
#define XBCPL  ((bf16*)(ws + WS_BIG + (size_t)M * SSD_DI * 2))
#define CONV_MATRIX(kind_, idx_, worker_, nworkers_) do { \
        int tid_ = wave_s * 64 + HW_LANE(); asm volatile("" : "+v"(tid_)); const int lane_ = tid_ & 63, wave_ = wave_s; \
        LAS float* scr_ = (LAS float*)(lds + wave_ * 16384); const int j_ = (idx_); \
        constexpr int I_SI = (D / 64) * (SSD_IN / 32), I_SO = (SSD_DI / 64) * (D / 32), I_AI = (D / 64) * (AT_IN / 32), I_AO = (D / 64) * (D / 32), I_UP = (D / 64) * (2 * DFF / 32), I_DN = (DFF / 64) * (D / 32); \
        if ((kind_) == 0) { for (int it = (worker_); it < I_SI; it += 2 * (nworkers_)) transpose_item<(RES_F16 != 0)>(s_inw + (size_t)j_ * D * SSD_IN, D, SSD_IN, nmg + (2 * j_) * D, 1023, 1.0f, (bf16*)((char*)Wb + W_SSD_IN + j_ * W_SSD_IN_SZ), RowId(), scr_, it, (it + (nworkers_) < I_SI) ? it + (nworkers_) : -1, lane_); \
            v4u* p_ = (v4u*)((char*)Wb + W_SSD_IN + j_ * W_SSD_IN_SZ + (size_t)SSD_IN * D * 2); const int n16_ = (SSD_NP - SSD_IN) * D * 2 / 16; \
            unsigned z_ = 0u; asm volatile("" : "+v"(z_)); for (int i = (worker_) * 64 + lane_; i < n16_; i += (nworkers_) * 64) p_[i] = (v4u){z_, z_, z_, z_}; } \
        else if ((kind_) == 1) { for (int it = (worker_); it < I_SO; it += 2 * (nworkers_)) transpose_item<false>(s_ow + (size_t)j_ * SSD_DI * D, SSD_DI, D, s_ng + j_ * SSD_DI, 2047, 1.0f, (bf16*)((char*)Wb + W_SSD_OUT + j_ * W_SSD_OUT_SZ), RowId(), scr_, it, (it + (nworkers_) < I_SO) ? it + (nworkers_) : -1, lane_); } \
        else if ((kind_) == 2) { for (int it = (worker_); it < I_AI; it += 2 * (nworkers_)) transpose_item<(RES_F16 != 0)>(a_inw + (size_t)j_ * D * AT_IN, D, AT_IN, nmg + (2 * j_ + 1) * D, 1023, 1.0f, (bf16*)((char*)Wb + W_AT_IN + j_ * W_AT_IN_SZ), RowId(), scr_, it, (it + (nworkers_) < I_AI) ? it + (nworkers_) : -1, lane_); } \
        else if ((kind_) == 3) { const float li_ = 0.8f - 0.6f * expf(-0.3f * (float)(2 * j_ + 1)); \
            for (int it = (worker_); it < I_AO; it += 2 * (nworkers_)) transpose_item<false>(a_ow + (size_t)j_ * D * D, D, D, a_sg + j_ * 128, 127, 1.0f - li_, (bf16*)((char*)Wb + W_AT_OUT + j_ * W_AT_OUT_SZ), RowId(), scr_, it, (it + (nworkers_) < I_AO) ? it + (nworkers_) : -1, lane_); } \
        else if ((kind_) == 4) { for (int it = (worker_); it < I_UP; it += 2 * (nworkers_)) transpose_item<(RES_F16 != 0)>(f_uw + (size_t)j_ * D * 2 * DFF, D, 2 * DFF, nfg + j_ * D, 1023, 1.0f, (bf16*)((char*)Wb + W_UP + j_ * W_UP_SZ), RowUp(), scr_, it, (it + (nworkers_) < I_UP) ? it + (nworkers_) : -1, lane_); } \
        else { for (int it = (worker_); it < I_DN; it += 2 * (nworkers_)) transpose_item<false>(f_dw + (size_t)j_ * DFF * D, DFF, D, nullptr, 0, 1.0f, (bf16*)((char*)Wb + W_DOWN + j_ * W_DOWN_SZ), RowId(), scr_, it, (it + (nworkers_) < I_DN) ? it + (nworkers_) : -1, lane_); } \
    } while (0)
#define RUN_FILL(fid_, nwg_, part_) do { const int idle0_ = (nwg_) % G; if (bx >= idle0_ && idle0_ > 0) { \
        const int wk_ = (bx - idle0_) * NWAVES + wave_s, nwk_ = (G - idle0_) * NWAVES; \
          \
        unsigned long long code_ = (part_) == 0 ? ((fid_) == 0 ? 0xff1040ull : (fid_) == 1 ? 0xff51ull : (fid_) == 2 ? 0xff11ull : (fid_) == 3 ? 0xff42ull : 0xff53ull) \
                                                : ((fid_) == 0 ? 0xff302050ull : (fid_) == 1 ? 0xff41ull : (fid_) == 2 ? 0xff01ull : (fid_) == 3 ? 0xff312152ull : 0xff43ull); \
        for (;;) { const int e_ = (int)(code_ & 0xffu); if (e_ == 0xff) break; code_ >>= 8; CONV_MATRIX(e_ >> 4, e_ & 15, wk_, nwk_); } } } while (0)
    const int lo = args.ph_lo, hi = args.ph_hi;
    int phase = 0;
#define IN_PHASE() (phase >= lo && phase < hi)
#define END_PHASE(ty) do { if (IN_PHASE() && phase + 1 < hi) GRID_BAR(); ++phase; } while (0)
#ifndef PROBE_EPI_MODE
#define PROBE_EPI_MODE 0
#endif
#ifdef PROBE_DUP
#define REP_BEGIN(ty) _Pragma("unroll") for (int rep_ = ((ty) == PROBE_DUP ? 0 : 1); rep_ < 2; ++rep_) { const int dry = (rep_ == 0);
#define REP_END() if (dry) GRID_BAR(); }
#else
#define REP_BEGIN(ty) { const int dry = 0;
#define REP_END() }
#endif

    if (IN_PHASE()) { REP_BEGIN(0)
        int tid = wave_s * 64 + HW_LANE(); asm volatile("" : "+v"(tid));
        const int lane = tid & 63, wave = wave_s;
        LAS float* scr = (LAS float*)(lds + wave * 16384);
        const int gw = vcu * NWAVES + wave, NGW = G * NWAVES;
        CONV_MATRIX(0, 0, gw, NGW);
        { unsigned z_ = 0u; asm volatile("" : "+v"(z_));
          v4u* p = (v4u*)(ws + WS_XB); for (int i = vcu * 512 + tid; i < (int)(XB_PAD_FRONT / 16); i += G * 512) p[i] = (v4u){z_, z_, z_, z_};
          v4u* q = (v4u*)((char*)XB + (size_t)M * D * 2); for (int i = vcu * 512 + tid; i < 256 * D * 2 / 16; i += G * 512) q[i] = (v4u){z_, z_, z_, z_}; }
        for (int m = gw; m < M; m += NGW) {
            const f32x4* xr = (const f32x4*)(x_in + (size_t)m * D) + lane; float s = 0.f;
            unsigned long long* o8 = (unsigned long long*)(XB + (size_t)m * D) + lane;
#pragma unroll
            for (int j = 0; j < 4; ++j) { const f32x4 v = xr[64 * j]; s += (v[0] * v[0] + v[1] * v[1]) + (v[2] * v[2] + v[3] * v[3]); o8[64 * j] = (unsigned long long)pk2x<(RES_F16 != 0)>(v[0], v[1]) | ((unsigned long long)pk2x<(RES_F16 != 0)>(v[2], v[3]) << 32); }
            s = wave_sum(s);
            if (lane < 4) SSQ[(size_t)m * 4 + lane] = (lane == 0) ? s : 0.f;
            if (lane >= 16 && lane < 32) { const int i = lane & 7; const float invf = powf(500000.0f, -(float)(2 * i) / 16.0f); const float ang = (float)pos[m] * invf; ROPE[(size_t)m * 16 + (lane - 16)] = (lane < 24) ? cosf(ang) : sinf(ang); }
        }
        for (int i = vcu * 512 + tid; i < 2 * SSD_NP; i += G * 512) {
            const int j = i / SSD_NP, c = i % SSD_NP; float pb = 0.f, p0 = 0.f, p1 = 0.f, p2 = 0.f, p3 = 0.f;
            if (c < 2048) p3 = 1.f;
            else if (c < 5120) { const int ch = c - 2048; const float* w = s_cw + (size_t)j * 4 * 3072; pb = s_cb[(size_t)j * 3072 + ch]; p0 = w[ch]; p1 = w[3072 + ch]; p2 = w[2 * 3072 + ch]; p3 = w[3 * 3072 + ch]; }
            else if (c < 5152) { pb = s_dtb[j * 32 + (c - 5120)]; p3 = 1.f; }
            float* t = CPT + (size_t)j * 5 * SSD_NP; t[c] = pb; t[SSD_NP + c] = p0; t[2 * SSD_NP + c] = p1; t[3 * SSD_NP + c] = p2; t[4 * SSD_NP + c] = p3;
        }
        if (bx == 0 && wave == 0) {
            for (int j = 0; j < 2; ++j) {
                float mq = fabsf(a_qg[j * 64 + lane]), mkk = fabsf(a_kg[j * 64 + lane]);
                float d1 = a_lq1[j * 64 + lane] * a_lk1[j * 64 + lane], d2 = a_lq2[j * 64 + lane] * a_lk2[j * 64 + lane];
                mq = xl_max64(mq); mkk = xl_max64(mkk); d1 = xl_sum64(d1); d2 = xl_sum64(d2);
                const float li = 0.8f - 0.6f * expf(-0.3f * (float)(2 * j + 1));
                if (lane == 0) { cst[j] = mq * mkk * 64.0f * 0.125f * 1.4426950408889634f * 1.002f + 0.01f; cst[2 + j] = expf(d1) - expf(d2) + li; }
            }
        }
    REP_END() }
    END_PHASE(0);

    for (int layer = 0; layer < 4; ++layer) {
        const int j = layer >> 1;
        if ((layer & 1) == 0) {
            if (IN_PHASE()) { REP_BEGIN(1)
#ifdef PROBE_PLAIN_SSDIN
                if (dry) {
                    pg8::Gemm g0{XB, (const bf16*)((const char*)Wb + W_SSD_IN + j * W_SSD_IN_SZ), D, D, 256, 0};
                    pg8::StaticOrder S0; S0.init(64, 20, G, bx);
                    epi::EpiSsdIn E0{BIG, DT, s_dtb + j * 32, SSQ};
                    pg8::gemm_phase(lds, lds + EPI_OFF, g0, S0, E0, wave_s);
                } else
#endif
                {
                pg8::Gemm g{XB, (const bf16*)((const char*)Wb + W_SSD_IN + j * W_SSD_IN_SZ), D, D, 253, -3};
                pg8::StaticOrder S; S.init(65, SSD_NP / 256, G, bx);
                epi::EpiSsdConv E{ZPL, XBCPL, DT, SSQ, CPT + (size_t)j * 5 * SSD_NP, dry * PROBE_EPI_MODE};
#ifdef PROBE_NOFILL
                if (!dry || (PROBE_NOFILL & 1) == 0)
#endif
                { RUN_FILL(layer == 0 ? 0 : 3, 65 * (SSD_NP / 256), 0); } __syncthreads();
#ifdef PROBE_FILLONLY
                if (!dry)
#endif
                pg8::gemm_phase(lds, lds + EPI_OFF, g, S, E, wave_s);
#ifdef PROBE_NOFILL
                if (!dry || (PROBE_NOFILL & 2) == 0)
#endif
                { RUN_FILL(layer == 0 ? 0 : 3, 65 * (SSD_NP / 256), 1); }
                }
            REP_END() }
            END_PHASE(1);
            if (IN_PHASE()) { REP_BEGIN(2)
                scan::Params sp{XBCPL, ZPL, DT, s_alog + j * 32, s_d + j * 32, SSQP, dry};
                for (int u = vcu; u < NB * 32; u += G) scan::unit(sp, u >> 5, u & 31, (LAS char*)lds, wave_s);
            REP_END() }
            END_PHASE(2);
            if (IN_PHASE()) { REP_BEGIN(4)
                pg8::Gemm g{ZPL, (const bf16*)((const char*)Wb + W_SSD_OUT + j * W_SSD_OUT_SZ), SSD_DI, SSD_DI, 256, 0};
                pg8::StaticOrder S; S.init(M / 256, D / 256, G, bx);
                if (layer == 0) { epi::EpiResidualG<1> E{x_in, XB, XLO, SSQ, SSQP, dry}; pg8::gemm_phase(lds, lds + EPI_OFF, g, S, E, wave_s); }
                else { epi::EpiResidualG<0> E{nullptr, XB, XLO, SSQ, SSQP, dry}; pg8::gemm_phase(lds, lds + EPI_OFF, g, S, E, wave_s); }
            REP_END() }
            END_PHASE(4);
        } else {
            if (IN_PHASE()) { REP_BEGIN(5)
                pg8::Gemm g{XB, (const bf16*)((const char*)Wb + W_AT_IN + j * W_AT_IN_SZ), D, D, 256, 0};
                pg8::StaticOrder S; S.init(M / 256, AT_IN / 256, G, bx);
                epi::EpiQKV E{BIG, SSQ, a_qg + j * 64, a_kg + j * 64, ROPE};
                pg8::gemm_phase(lds, lds + EPI_OFF, g, S, E, wave_s);
            REP_END() }
            END_PHASE(5);
            if (IN_PHASE()) { REP_BEGIN(6)
                attn::Params ap{BIG, cst[j], cst[2 + j], dry};
                for (int pi = vcu; pi < 512; pi += G) {
                    const int bh = pi >> 3, s = pi & 7;
#ifdef PROBE_ATT_MODE
                    if (dry) { attn::unit<PROBE_ATT_MODE>(ap, bh >> 3, bh & 7, s, (LAS char*)lds, wave_s); attn::unit<PROBE_ATT_MODE>(ap, bh >> 3, bh & 7, 15 - s, (LAS char*)lds, wave_s); } else
#endif
                    { attn::unit(ap, bh >> 3, bh & 7, s, (LAS char*)lds, wave_s);
                      attn::unit(ap, bh >> 3, bh & 7, 15 - s, (LAS char*)lds, wave_s); }
                }
            REP_END() }
            END_PHASE(6);
            if (IN_PHASE()) { REP_BEGIN(7)
                pg8::Gemm g{BIG, (const bf16*)((const char*)Wb + W_AT_OUT + j * W_AT_OUT_SZ), AT_IN, D, 256, 0};
                pg8::StaticOrder S; S.init(M / 256, D / 256, G, bx);
                epi::EpiResidual<0> E{nullptr, nullptr, XB, XLO, SSQ, dry};
                pg8::gemm_phase(lds, lds + EPI_OFF, g, S, E, wave_s);
            REP_END() }
            END_PHASE(7);
        }
        if (IN_PHASE()) { REP_BEGIN(8)
            pg8::Gemm g{XB, (const bf16*)((const char*)Wb + W_UP + layer * W_UP_SZ), D, D, 254, -2};
            pg8::StaticOrder S; S.init(65, 2 * DFF / 256, G, bx);
            epi::EpiConvGate E{BIG, SSQ, f_cw + (size_t)layer * 3 * 2 * DFF, f_cb + (size_t)layer * 2 * DFF, dry * PROBE_EPI_MODE};
            if (layer < 3) { RUN_FILL(layer == 0 ? 1 : (layer == 1 ? 2 : 4), 65 * (2 * DFF / 256), 0); __syncthreads(); }
            pg8::gemm_phase(lds, lds + EPI_OFF, g, S, E, wave_s);
            if (layer < 3) RUN_FILL(layer == 0 ? 1 : (layer == 1 ? 2 : 4), 65 * (2 * DFF / 256), 1);
        REP_END() }
        END_PHASE(8);
        if (IN_PHASE()) { REP_BEGIN(9)
            pg8::Gemm g{BIG, (const bf16*)((const char*)Wb + W_DOWN + layer * W_DOWN_SZ), DFF, DFF, 256, 0};
            pg8::StaticOrder S; S.init(M / 256, D / 256, G, bx);
            if (layer == 3) { epi::EpiResidual<2> E{nullptr, xout, XB, XLO, SSQ, dry}; pg8::gemm_phase(lds, lds + EPI_OFF, g, S, E, wave_s); }
            else { epi::EpiResidual<0> E{nullptr, nullptr, XB, XLO, SSQ, dry}; pg8::gemm_phase(lds, lds + EPI_OFF, g, S, E, wave_s); }
        REP_END() }
        END_PHASE(9);
    }
#ifdef PROBE_EXTRA_BARS
    for (int i_ = 0; i_ < PROBE_EXTRA_BARS; ++i_) GRID_BAR();
#endif
}
#undef CONV_MATRIX
#undef RUN_FILL
#undef x_in
#undef pos
#undef nmg
#undef nfg
#undef s_inw
#undef s_cw
#undef s_cb
#undef s_dtb
#undef s_alog
#undef s_d
#undef s_ng
#undef s_ow
#undef a_inw
#undef a_qg
#undef a_kg
#undef a_lq1
#undef a_lk1
#undef a_lq2
#undef a_lk2
#undef a_sg
#undef a_ow
#undef f_uw
#undef f_cw
#undef f_cb
#undef f_dw
#undef xout
#undef ws
#undef cst
#undef SSQ
#undef ROPE
#undef DT
#undef SSQP
#undef Wb
#undef XB
#undef BIG
#undef XLO
#undef CPT
#undef ZPL
#undef XBCPL
#undef ARGP
constexpr int N_PHASES = 1 + 2 * 5 + 2 * 5;

static int g_grid = 0;
static void launch(void* const* d_in, float* d_out, void* d_ws, int ph_lo, int ph_hi, hipStream_t stream) {
    if (g_grid == 0) {
        int dev = 0, cus = 0;
        if (hipGetDevice(&dev) != hipSuccess || hipDeviceGetAttribute(&cus, hipDeviceAttributeMultiprocessorCount, dev) != hipSuccess) { fprintf(stderr, "device query failed\n"); g_grid = -1; return; }
        if (hipFuncSetAttribute((const void*)mega_fwd, hipFuncAttributeMaxDynamicSharedMemorySize, LDS_BYTES) != hipSuccess) { fprintf(stderr, "hipFuncSetAttribute failed\n"); g_grid = -1; return; }
        int per_cu = 0;
        (void)hipOccupancyMaxActiveBlocksPerMultiprocessor(&per_cu, (const void*)mega_fwd, NWAVES * 64, LDS_BYTES);
        (void)hipGetLastError();
        g_grid = cus;
        fprintf(stderr, "mega_fwd: %d CUs, occupancy query %d per CU\n", cus, per_cu);
    }
    if (g_grid < 0) return;
    (void)hipMemsetAsync((char*)d_ws + WS_CTL, 0, CTL_ZERO_BYTES, stream);
    Args a{};
    for (int i = 0; i < 25; ++i) a.in[i] = d_in[i];
    a.out = d_out; a.ws = (unsigned char*)d_ws; a.ph_lo = ph_lo; a.ph_hi = ph_hi;
    void* params[] = {&a};
    hipError_t e = hipLaunchCooperativeKernel((const void*)mega_fwd, dim3(g_grid), dim3(NWAVES * 64), params, LDS_BYTES, stream);
    if (e != hipSuccess) fprintf(stderr, "cooperative launch failed: %s (grid %d)\n", hipGetErrorString(e), g_grid);
}
}
extern "C" void kernel_launch(void* const* d_in, const int* in_sizes, int n_in, void* d_out, int out_size, void* d_ws, size_t ws_size, hipStream_t stream) {
    (void)in_sizes; (void)n_in; (void)out_size; (void)ws_size;
    mk::launch(d_in, (float*)d_out, d_ws, 0, mk::N_PHASES, stream);
}
```

```cpp
#include <hip/hip_runtime.h>
#include <stdint.h>
#include <math.h>
#include <cstdio>
__device__ __forceinline__ int hw_lane_() { unsigned m = ~0u; asm volatile("" : "+s"(m)); return (int)__builtin_amdgcn_mbcnt_hi(m, __builtin_amdgcn_mbcnt_lo(m, 0u)); }
#define HW_LANE() hw_lane_()
template <int CTRL> __device__ __forceinline__ float xl_dpp(float v) { return __builtin_bit_cast(float, __builtin_amdgcn_mov_dpp(__builtin_bit_cast(int, v), CTRL, 0xF, 0xF, true)); }
__device__ __forceinline__ float xl_swap16_sum(float v) { const auto r = __builtin_amdgcn_permlane16_swap(__builtin_bit_cast(unsigned, v), __builtin_bit_cast(unsigned, v), false, false); const unsigned r0 = r[0], r1 = r[1]; return __builtin_bit_cast(float, r0) + __builtin_bit_cast(float, r1); }
__device__ __forceinline__ float xl_swap32_sum(float v) { const auto r = __builtin_amdgcn_permlane32_swap(__builtin_bit_cast(unsigned, v), __builtin_bit_cast(unsigned, v), false, false); const unsigned r0 = r[0], r1 = r[1]; return __builtin_bit_cast(float, r0) + __builtin_bit_cast(float, r1); }
__device__ __forceinline__ float xl_swap16_max(float v) { const auto r = __builtin_amdgcn_permlane16_swap(__builtin_bit_cast(unsigned, v), __builtin_bit_cast(unsigned, v), false, false); const unsigned r0 = r[0], r1 = r[1]; return fmaxf(__builtin_bit_cast(float, r0), __builtin_bit_cast(float, r1)); }
__device__ __forceinline__ float xl_swap32_max(float v) { const auto r = __builtin_amdgcn_permlane32_swap(__builtin_bit_cast(unsigned, v), __builtin_bit_cast(unsigned, v), false, false); const unsigned r0 = r[0], r1 = r[1]; return fmaxf(__builtin_bit_cast(float, r0), __builtin_bit_cast(float, r1)); }
__device__ __forceinline__ float xl_xor16(float v, bool odd16) { const auto r = __builtin_amdgcn_permlane16_swap(__builtin_bit_cast(unsigned, v), __builtin_bit_cast(unsigned, v), false, false); const unsigned r0 = r[0], r1 = r[1]; return __builtin_bit_cast(float, odd16 ? r0 : r1); }
__device__ __forceinline__ float xl_sum4(float v) { v += xl_dpp<0xB1>(v); v += xl_dpp<0x4E>(v); return v; }
__device__ __forceinline__ float xl_sum8(float v) { v = xl_sum4(v); v += xl_dpp<0x141>(v); return v; }
__device__ __forceinline__ float xl_sum16(float v) { v = xl_sum8(v); v += xl_dpp<0x140>(v); return v; }
__device__ __forceinline__ float xl_sum64(float v) { v = xl_sum16(v); v = xl_swap16_sum(v); return xl_swap32_sum(v); }
__device__ __forceinline__ float xl_max64(float v) { v = fmaxf(v, xl_dpp<0xB1>(v)); v = fmaxf(v, xl_dpp<0x4E>(v)); v = fmaxf(v, xl_dpp<0x141>(v)); v = fmaxf(v, xl_dpp<0x140>(v)); v = xl_swap16_max(v); return xl_swap32_max(v); }
__device__ __forceinline__ float xl_scan64(float v) {
    v += xl_dpp<0x111>(v); v += xl_dpp<0x112>(v); v += xl_dpp<0x114>(v); v += xl_dpp<0x118>(v);
    v += __builtin_bit_cast(float, __builtin_amdgcn_update_dpp(0, __builtin_bit_cast(int, v), 0x142, 0xA, 0xF, false));
    v += __builtin_bit_cast(float, __builtin_amdgcn_update_dpp(0, __builtin_bit_cast(int, v), 0x143, 0xC, 0xF, false));
    return v;
}
#ifndef RES_F16
#define RES_F16 1
#endif
#ifndef PG8_SP2
#define PG8_SP2 1
#endif
namespace pg8 {
#define PG8_LAS __attribute__((address_space(3)))
typedef unsigned short bf16_t;
typedef short bf16x8 __attribute__((ext_vector_type(8)));
typedef float f32x4 __attribute__((ext_vector_type(4)));
typedef unsigned u32x4 __attribute__((ext_vector_type(4)));
typedef unsigned u32x2 __attribute__((ext_vector_type(2)));
constexpr int BM = 256, BK = 64, HALF = 128, HTB = HALF * BK * 2  , STAGE_BYTES = 8 * HTB, NXCD = 8, WGM = 8;

__host__ __device__ __forceinline__ int lds_byte(int r, int c) { const int st = (r >> 4) * 2 + (c >> 5), rr = r & 15, cc = c & 31, ob = rr * 64 + cc * 2; return st * 1024 + (ob ^ (((ob >> 9) & 1) << 5)); }
__host__ __device__ __forceinline__ void stage_rc(int b, int& R, int& C) { const int st = b / 1024, sb = b % 1024, swz = sb ^ (((sb >> 9) & 1) << 5); R = (st >> 1) * 16 + swz / 64; C = (st & 1) * 32 + (swz % 64) / 2; }
__host__ __device__ __forceinline__ int perm32(int rho) { const int n = rho >> 4, i = rho & 15; return 8 * (i >> 2) + 4 * n + (i & 3); }

typedef _Float16 f16x8 __attribute__((ext_vector_type(8)));
template <bool F16> __device__ __forceinline__ f32x4 mma16(bf16x8 a, bf16x8 b, f32x4 c) {
    if constexpr (F16) return __builtin_amdgcn_mfma_f32_16x16x32_f16(__builtin_bit_cast(f16x8, a), __builtin_bit_cast(f16x8, b), c, 0, 0, 0);
    else return __builtin_amdgcn_mfma_f32_16x16x32_bf16(a, b, c, 0, 0, 0);
}
struct Unit { int pm, pn; };
struct Gemm { const bf16_t* A; const bf16_t* Bt; int lda, K, a_stride, a_off; };

struct StaticOrder {
    int nM, nN, nwg, G, c;
    __host__ __device__ void init(int nM_, int nN_, int G_, int c_) { nM = nM_; nN = nN_; nwg = nM * nN; G = G_; c = c_; }
    __host__ __device__ bool next(int i, Unit& u) const {
        const long L = (long)i * G + c; if (L >= nwg) return false;
        int wgid = (int)L; { const int q = nwg / NXCD, r = nwg % NXCD, xcd = wgid % NXCD, off = wgid / NXCD; wgid = (xcd < r ? xcd * (q + 1) : r * (q + 1) + (xcd - r) * q) + off; }
        const int nig = WGM * nN, gid = wgid / nig, fm = gid * WGM, gsz = (nM - fm) < WGM ? (nM - fm) : WGM;
        u.pm = fm + ((wgid % nig) % gsz); u.pn = (wgid % nig) / gsz; return true;
    }
};

__device__ __forceinline__ unsigned cvt_pk_bf16(float lo, float hi) { unsigned r; asm volatile("v_cvt_pk_bf16_f32 %0, %1, %2" : "=v"(r) : "v"(lo), "v"(hi)); return r; }

template <class Epi, class Sched>
__device__ __forceinline__ void gemm_phase(PG8_LAS unsigned char* lds, PG8_LAS unsigned char* elds, const Gemm g, const Sched& S, const Epi& E, const int wave_s) {
    int tid = wave_s * 64 + HW_LANE(); asm volatile("" : "+v"(tid));
    const int wid = __builtin_amdgcn_readfirstlane(tid >> 6), lane = tid & 63, wr = wid >> 2, wc = wid & 3, fr = lane & 15, fq = lane >> 4;
    const int K = g.K, nt = K / BK, lda = g.lda;
    unsigned voffA[2], voffB[2]; int aoff, boff;
#define PG8_LANECONST() do { int t_ = wave_s * 64 + HW_LANE(); asm volatile("" : "+v"(t_)); const int fr_ = t_ & 15, fq_ = (t_ >> 4) & 3; \
        _Pragma("unroll") for (int i = 0; i < 2; ++i) { int R, C; stage_rc(t_ * 16 + i * 8192, R, C); const int Rb = Epi::PERM ? ((R & ~31) + perm32(R & 31)) : R; \
            const int Ra = Epi::ROWIL ? ((R & ~63) | ((R & 15) << 2) | ((R >> 4) & 3)) : R;     \
            voffA[i] = (unsigned)(Ra * lda + C) * 2u; voffB[i] = (unsigned)(Rb * K + C) * 2u; } \
        aoff = lds_byte(wr * 64 + fr_, fq_ * 8); boff = lds_byte(wc * 32 + fr_, fq_ * 8); } while (0)
    PG8_LANECONST();
    const size_t kstep = (size_t)(BK * 2);
    const size_t hstepA = (size_t)HALF * lda * 2, hstepB = (size_t)HALF * K * 2;
    const size_t tstepB = 2 * hstepB;
    const unsigned ldsw = (unsigned)wid * 1024u;
#define PG8_SA(b, h) (((b) * 2 + (h)) * HTB)
#define PG8_SB(b, h) ((4 + (b) * 2 + (h)) * HTB)
#define PG8_STAGE(bufoff, gbase, voff) do { _Pragma("unroll") for (int _i = 0; _i < 2; ++_i) \
        __builtin_amdgcn_global_load_lds((const unsigned*)((const char*)(gbase) + (voff)[_i]), (PG8_LAS unsigned*)(lds + (bufoff) + ldsw + _i * 8192), 16, 0, 0); } while (0)
#define PG8_LDA(dst, b, h) do { _Pragma("unroll") for (int m = 0; m < 4; ++m) _Pragma("unroll") for (int k = 0; k < 2; ++k) dst[m][k] = *(const PG8_LAS bf16x8*)(lds + PG8_SA(b, h) + aoff + m * 2048 + k * 1024); } while (0)
#define PG8_LDB(dst, b, h) do { _Pragma("unroll") for (int n = 0; n < 2; ++n) _Pragma("unroll") for (int k = 0; k < 2; ++k) dst[n][k] = *(const PG8_LAS bf16x8*)(lds + PG8_SB(b, h) + boff + n * 2048 + k * 1024); } while (0)
#define PG8_MMA(ai, bj, At, Bt) do { __builtin_amdgcn_s_setprio(1); _Pragma("unroll") for (int m = 0; m < 4; ++m) _Pragma("unroll") for (int n = 0; n < 2; ++n) _Pragma("unroll") for (int k = 0; k < 2; ++k) \
        acc[ai][bj][m][n] = mma16<Epi::AF16>(Bt[n][k], At[m][k], acc[ai][bj][m][n]); __builtin_amdgcn_s_setprio(0); } while (0)
#define PG8_WAIT_V(n) asm volatile("s_waitcnt vmcnt(" #n ")" ::: "memory")
#define PG8_WAIT_L(n) asm volatile("s_waitcnt lgkmcnt(" #n ")" ::: "memory")
#define PG8_BAR __builtin_amdgcn_s_barrier()
#define PG8_SCHED __builtin_amdgcn_sched_barrier(0)
    Unit cur, nxt; int ui = 0;
    if (!S.next(0, cur)) return;
    if constexpr (Epi::KGROUP) E.unit_begin(cur, elds, wave_s);
    if constexpr (Epi::PREFETCH) E.prefetch(cur, elds, wave_s);
    float zf = 0.f; if constexpr (!Epi::KGROUP) asm volatile("" : "+v"(zf));
    f32x4 acc[2][2][4][2];
#pragma unroll
    for (int a = 0; a < 2; ++a)
#pragma unroll
        for (int b = 0; b < 2; ++b)
#pragma unroll
            for (int m = 0; m < 4; ++m)
#pragma unroll
                for (int n = 0; n < 2; ++n) acc[a][b][m][n] = (f32x4){zf, zf, zf, zf};
    bf16x8 At[4][2], B0[2][2], B1[2][2];
    const char* cA = (const char*)g.A + ((long)cur.pm * g.a_stride + g.a_off) * (long)lda * 2; const char* cB = (const char*)g.Bt + (size_t)cur.pn * tstepB;
#if PG8_SP2
    PG8_STAGE(PG8_SB(0, 0), cB, voffB); PG8_STAGE(PG8_SB(0, 1), cB + hstepB, voffB); PG8_STAGE(PG8_SA(0, 0), cA, voffA); PG8_STAGE(PG8_SA(0, 1), cA + hstepA, voffA);
    if (wr == 1) PG8_BAR;
    PG8_WAIT_V(2); PG8_BAR;
    PG8_STAGE(PG8_SB(1, 0), cB + kstep, voffB); PG8_STAGE(PG8_SA(1, 0), cA + kstep, voffA); PG8_STAGE(PG8_SB(1, 1), cB + hstepB + kstep, voffB);
    PG8_WAIT_V(6); PG8_BAR;
#else
    PG8_STAGE(PG8_SB(0, 0), cB, voffB); PG8_STAGE(PG8_SA(0, 0), cA, voffA); PG8_STAGE(PG8_SB(0, 1), cB + hstepB, voffB); PG8_STAGE(PG8_SA(0, 1), cA + hstepA, voffA);
    if (wr == 1) PG8_BAR;
    PG8_WAIT_V(4); PG8_BAR;
    PG8_STAGE(PG8_SB(1, 0), cB + kstep, voffB); PG8_STAGE(PG8_SA(1, 0), cA + kstep, voffA); PG8_STAGE(PG8_SB(1, 1), cB + hstepB + kstep, voffB);
    PG8_WAIT_V(6); PG8_BAR;
#endif
    for (;;) {
        const bool has_next = S.next(ui + 1, nxt);
        const char* nA = has_next ? (const char*)g.A + ((long)nxt.pm * g.a_stride + g.a_off) * (long)lda * 2 : cA; const char* nB = has_next ? (const char*)g.Bt + (size_t)nxt.pn * tstepB : cB;
        for (int t = 0; t < nt; t += 2) {
            const bool last = (t == nt - 2);
            const char* a1 = cA + (size_t)(t + 1) * kstep;
            const char* a2 = last ? nA : cA + (size_t)(t + 2) * kstep; const char* b2 = last ? nB : cB + (size_t)(t + 2) * kstep;
            const char* a3 = a2 + kstep; const char* b3 = b2 + kstep;
            if constexpr (Epi::KGROUP) { if (t > 0 && (t & 7) == 0) E.kgroup(acc, t >> 3, wr, elds); }
#if PG8_SP2
            PG8_LDB(B0, 0, 0); PG8_LDB(B1, 0, 1); PG8_SCHED; PG8_LDA(At, 0, 0); PG8_STAGE(PG8_SA(1, 1), a1 + hstepA, voffA);
            PG8_WAIT_V(8); PG8_WAIT_L(0); PG8_BAR; PG8_MMA(0, 0, At, B0); PG8_MMA(0, 1, At, B1); PG8_BAR; PG8_SCHED;
            PG8_LDA(At, 0, 1); PG8_STAGE(PG8_SB(0, 0), b2, voffB); PG8_STAGE(PG8_SB(0, 1), b2 + hstepB, voffB); PG8_STAGE(PG8_SA(0, 0), a2, voffA);
            PG8_WAIT_V(8); PG8_WAIT_L(0); PG8_BAR; PG8_MMA(1, 0, At, B0); PG8_MMA(1, 1, At, B1); PG8_BAR; PG8_SCHED;
            PG8_LDB(B0, 1, 0); PG8_LDB(B1, 1, 1); PG8_SCHED; PG8_LDA(At, 1, 0); PG8_STAGE(PG8_SA(0, 1), a2 + hstepA, voffA);
            PG8_WAIT_V(8); PG8_WAIT_L(0); PG8_BAR; PG8_MMA(0, 0, At, B0); PG8_MMA(0, 1, At, B1); PG8_BAR; PG8_SCHED;
            PG8_LDA(At, 1, 1); PG8_STAGE(PG8_SB(1, 0), b3, voffB); PG8_STAGE(PG8_SB(1, 1), b3 + hstepB, voffB); PG8_STAGE(PG8_SA(1, 0), a3, voffA);
            PG8_WAIT_V(8); PG8_WAIT_L(0); PG8_BAR; PG8_MMA(1, 0, At, B0); PG8_MMA(1, 1, At, B1); PG8_BAR; PG8_SCHED;
#else
            PG8_LDB(B0, 0, 0); PG8_SCHED; PG8_LDA(At, 0, 0); PG8_STAGE(PG8_SA(1, 1), a1 + hstepA, voffA);
            PG8_WAIT_L(8); PG8_BAR; PG8_WAIT_L(0); PG8_MMA(0, 0, At, B0); PG8_BAR; PG8_SCHED;
            PG8_LDB(B1, 0, 1); PG8_STAGE(PG8_SB(0, 0), b2, voffB);
            PG8_BAR; PG8_WAIT_L(0); PG8_MMA(0, 1, At, B1); PG8_BAR;
            PG8_LDA(At, 0, 1); PG8_STAGE(PG8_SA(0, 0), a2, voffA);
            PG8_BAR; PG8_WAIT_L(0); PG8_MMA(1, 0, At, B0); PG8_BAR; PG8_SCHED;
            PG8_STAGE(PG8_SB(0, 1), b2 + hstepB, voffB);
            PG8_WAIT_V(6); PG8_BAR; PG8_MMA(1, 1, At, B1); PG8_BAR;
            PG8_LDB(B0, 1, 0); PG8_SCHED; PG8_LDA(At, 1, 0); PG8_STAGE(PG8_SA(0, 1), a2 + hstepA, voffA);
            PG8_WAIT_L(8); PG8_BAR; PG8_WAIT_L(0); PG8_MMA(0, 0, At, B0); PG8_BAR; PG8_SCHED;
            PG8_LDB(B1, 1, 1); PG8_STAGE(PG8_SB(1, 0), b3, voffB);
            PG8_BAR; PG8_WAIT_L(0); PG8_MMA(0, 1, At, B1); PG8_BAR;
            PG8_LDA(At, 1, 1); PG8_STAGE(PG8_SA(1, 0), a3, voffA);
            PG8_BAR; PG8_WAIT_L(0); PG8_MMA(1, 0, At, B0); PG8_BAR; PG8_SCHED;
            PG8_STAGE(PG8_SB(1, 1), b3 + hstepB, voffB);
            PG8_WAIT_V(6); PG8_BAR; PG8_MMA(1, 1, At, B1); PG8_BAR;
#endif
        }
        if (wr == 0) { if constexpr (Epi::PREFETCH) PG8_WAIT_V(8);
            PG8_BAR; }
        E(acc, cur, wr, wc, elds);
        if (!has_next) break;
        if constexpr (Epi::PREFETCH) E.prefetch(nxt, elds, wave_s);
#pragma unroll
        for (int a = 0; a < 2; ++a)
#pragma unroll
            for (int b = 0; b < 2; ++b)
#pragma unroll
                for (int m = 0; m < 4; ++m)
#pragma unroll
                    for (int n = 0; n < 2; ++n) acc[a][b][m][n] = (f32x4){zf, zf, zf, zf};
        cur = nxt; cA = nA; cB = nB; ++ui;
        if constexpr (Epi::KGROUP) E.unit_begin(cur, elds, wave_s);
        PG8_LANECONST();
        if (wr == 1) PG8_BAR;
    }
    PG8_WAIT_V(0);
    PG8_BAR;
#undef PG8_LANECONST
#undef PG8_SA
#undef PG8_SB
#undef PG8_STAGE
#undef PG8_LDA
#undef PG8_LDB
#undef PG8_MMA
}
}
namespace epi {
using pg8::f32x4; using pg8::u32x4; using pg8::u32x2; using pg8::bf16_t; using pg8::Unit; using pg8::cvt_pk_bf16;
constexpr int MROWS = 16384, DMODEL = 1024;
constexpr float EPS = 1e-6f;
#define EPI_LAS __attribute__((address_space(3)))

__device__ __forceinline__ float row_rstd(const float* ssq, int row) {
    const f32x4 a = *(const f32x4*)(ssq + (size_t)row * 4);
    const float s = (a[0] + a[1]) + (a[2] + a[3]);
    return __builtin_amdgcn_rsqf(s * (1.0f / DMODEL) + EPS);
}
template <int MSTEP> __device__ __forceinline__ void rstd8(const float* ssq, int row0, bool clamp, float (&rs)[2][4]) {
    f32x4 p[2][4];
#pragma unroll
    for (int ai = 0; ai < 2; ++ai)
#pragma unroll
        for (int m = 0; m < 4; ++m) { int row = row0 + ai * 128 + m * MSTEP; if (clamp) row = row < 0 ? 0 : (row >= MROWS ? MROWS - 1 : row); p[ai][m] = *(const f32x4*)(ssq + (size_t)row * 4); }
#pragma unroll
    for (int ai = 0; ai < 2; ++ai)
#pragma unroll
        for (int m = 0; m < 4; ++m) { const f32x4 a = p[ai][m]; rs[ai][m] = __builtin_amdgcn_rsqf(((a[0] + a[1]) + (a[2] + a[3])) * (1.0f / DMODEL) + EPS); }
}
template <int CTRL> __device__ __forceinline__ float dppf(float old, float src) {
    return __builtin_bit_cast(float, __builtin_amdgcn_update_dpp(__builtin_bit_cast(int, old), __builtin_bit_cast(int, src), CTRL, 0xF, 0xF, false));
}
template <int CTRL> __device__ __forceinline__ float dppa(float src) {
    return __builtin_bit_cast(float, __builtin_amdgcn_mov_dpp(__builtin_bit_cast(int, src), CTRL, 0xF, 0xF, true));
}
__device__ __forceinline__ f32x4 silu4(f32x4 v) {
    const f32x4 t = v * (-1.4426950408889634f); f32x4 e;
#pragma unroll
    for (int i = 0; i < 4; ++i) e[i] = __builtin_amdgcn_exp2f(t[i]);
    e = e + 1.0f;
#pragma unroll
    for (int i = 0; i < 4; ++i) e[i] = __builtin_amdgcn_rcpf(e[i]);
    return v * e;
}
template <int CTRL> __device__ __forceinline__ float dppz(float src) {
    return __builtin_bit_cast(float, __builtin_amdgcn_update_dpp(0, __builtin_bit_cast(int, src), CTRL, 0xF, 0xF, true));
}
__device__ __forceinline__ float softplus_fast(float v) {
    const float t = __builtin_amdgcn_exp2f(-1.4426950408889634f * fabsf(v));
    const float l = (t < 0.015625f) ? t * (1.0f - t * (0.5f - t * 0.33333334f)) : 0.6931471805599453f * __builtin_amdgcn_logf(1.0f + t);
    return fmaxf(v, 0.f) + l;
}
__device__ __forceinline__ float silu_fast(float v) { return v * __builtin_amdgcn_rcpf(1.0f + __builtin_amdgcn_exp2f(-1.4426950408889634f * v)); }

#ifndef RES_LO
#define RES_LO (RES_F16 ? 0 : 1)
#endif
typedef _Float16 h2_t __attribute__((ext_vector_type(2)));
__device__ __forceinline__ unsigned pk_f16(float lo, float hi) { const h2_t v = {(_Float16)lo, (_Float16)hi}; return __builtin_bit_cast(unsigned, v); }
__device__ __forceinline__ float f16_lo(unsigned w) { const h2_t v = __builtin_bit_cast(h2_t, w); const _Float16 a = v[0]; return (float)a; }
__device__ __forceinline__ float f16_hi(unsigned w) { const h2_t v = __builtin_bit_cast(h2_t, w); const _Float16 a = v[1]; return (float)a; }
template <int MODE  > struct EpiResidual {
    static constexpr bool PERM = true, ROWIL = false, KGROUP = false, PREFETCH = false, AF16 = false;
    const float* xin_f32; float* xout_f32; bf16_t* xh; bf16_t* xl; float* ssq; int dry;
    __device__ __forceinline__ void operator()(f32x4 (&acc)[2][2][4][2], const Unit& u, int wr, int wc, EPI_LAS unsigned char* elds) const {
        int fr, fq; { int t_ = HW_LANE(); asm volatile("" : "+v"(t_)); fr = t_ & 15; fq = (t_ >> 4) & 3; }
        EPI_LAS float* P = (EPI_LAS float*)elds;
        const int col0 = u.pn * 256 + wc * 32 + 8 * fq;
#pragma unroll
        for (int ai = 0; ai < 2; ++ai) {
            u32x4 xa[4][2], xb_[4][2];
#pragma unroll
            for (int m = 0; m < 4; ++m)
#pragma unroll
                for (int bj = 0; bj < 2; ++bj) {
                    const size_t o = (size_t)(u.pm * 256 + ai * 128 + wr * 64 + m * 16 + fr) * DMODEL + col0 + bj * 128;
                    if (MODE == 1) { xa[m][bj] = *(const u32x4*)(xin_f32 + o); xb_[m][bj] = *(const u32x4*)(xin_f32 + o + 4); }
                    else { xa[m][bj] = *(const u32x4*)(xh + o); xb_[m][bj] = RES_LO ? *(const u32x4*)(xl + o) : (u32x4){0u, 0u, 0u, 0u}; }
                }
#pragma unroll
            for (int m = 0; m < 4; ++m) {
                const int row = u.pm * 256 + ai * 128 + wr * 64 + m * 16 + fr;
                float s = 0.f;
#pragma unroll
                for (int bj = 0; bj < 2; ++bj) {
                    const size_t o = (size_t)row * DMODEL + col0 + bj * 128;
                    f32x4 v0, v1;
                    if (MODE == 1) { v0 = __builtin_bit_cast(f32x4, xa[m][bj]); v1 = __builtin_bit_cast(f32x4, xb_[m][bj]); }
                    else {
#pragma unroll
                        for (int i = 0; i < 2; ++i) {
                            if (RES_F16) { v0[2 * i] = f16_lo(xa[m][bj][i]); v0[2 * i + 1] = f16_hi(xa[m][bj][i]); v1[2 * i] = f16_lo(xa[m][bj][2 + i]); v1[2 * i + 1] = f16_hi(xa[m][bj][2 + i]); continue; }
                            v0[2 * i] = __builtin_bit_cast(float, xa[m][bj][i] << 16) + __builtin_bit_cast(float, xb_[m][bj][i] << 16);
                            v0[2 * i + 1] = __builtin_bit_cast(float, xa[m][bj][i] & 0xffff0000u) + __builtin_bit_cast(float, xb_[m][bj][i] & 0xffff0000u);
                            v1[2 * i] = __builtin_bit_cast(float, xa[m][bj][2 + i] << 16) + __builtin_bit_cast(float, xb_[m][bj][2 + i] << 16);
                            v1[2 * i + 1] = __builtin_bit_cast(float, xa[m][bj][2 + i] & 0xffff0000u) + __builtin_bit_cast(float, xb_[m][bj][2 + i] & 0xffff0000u);
                        }
                    }
                    v0 = v0 + acc[ai][bj][m][0]; v1 = v1 + acc[ai][bj][m][1];
                    s += ((v0[0] * v0[0] + v0[1] * v0[1]) + (v0[2] * v0[2] + v0[3] * v0[3])) + ((v1[0] * v1[0] + v1[1] * v1[1]) + (v1[2] * v1[2] + v1[3] * v1[3]));
                    if (MODE == 2) { if (!dry) { *(f32x4*)(xout_f32 + o) = v0; *(f32x4*)(xout_f32 + o + 4) = v1; } }
                    else {
                        u32x4 h; h.x = cvt_pk_bf16(v0[0], v0[1]); h.y = cvt_pk_bf16(v0[2], v0[3]); h.z = cvt_pk_bf16(v1[0], v1[1]); h.w = cvt_pk_bf16(v1[2], v1[3]);
                        if (RES_F16) { h.x = pk_f16(v0[0], v0[1]); h.y = pk_f16(v0[2], v0[3]); h.z = pk_f16(v1[0], v1[1]); h.w = pk_f16(v1[2], v1[3]); }
                        u32x4 l;
                        l.x = cvt_pk_bf16(v0[0] - __builtin_bit_cast(float, h.x << 16), v0[1] - __builtin_bit_cast(float, h.x & 0xffff0000u));
                        l.y = cvt_pk_bf16(v0[2] - __builtin_bit_cast(float, h.y << 16), v0[3] - __builtin_bit_cast(float, h.y & 0xffff0000u));
                        l.z = cvt_pk_bf16(v1[0] - __builtin_bit_cast(float, h.z << 16), v1[1] - __builtin_bit_cast(float, h.z & 0xffff0000u));
                        l.w = cvt_pk_bf16(v1[2] - __builtin_bit_cast(float, h.w << 16), v1[3] - __builtin_bit_cast(float, h.w & 0xffff0000u));
                        if (!dry) { *(u32x4*)(xh + o) = h; if (RES_LO) *(u32x4*)(xl + o) = l; }
                    }
                }
                s = xl_swap32_sum(xl_swap16_sum(s));
                if (fq == 0) P[(ai * 128 + wr * 64 + m * 16 + fr) * 4 + wc] = s;
            }
            asm volatile("" ::: "memory");
        }
        asm volatile("s_waitcnt lgkmcnt(0)" ::: "memory"); __builtin_amdgcn_s_barrier(); asm volatile("" ::: "memory");
        { const int t = (wr * 4 + wc) * 64 + fq * 16 + fr; if (t < 256) { const f32x4 p = *(const EPI_LAS f32x4*)(P + t * 4); ssq[(size_t)(u.pm * 256 + t) * 4 + u.pn] = (p[0] + p[1]) + (p[2] + p[3]); } }
        asm volatile("s_waitcnt lgkmcnt(0)" ::: "memory"); __builtin_amdgcn_s_barrier(); asm volatile("" ::: "memory");
    }
};

template <int MODE> struct EpiResidualG {
    static constexpr bool PERM = true, ROWIL = false, KGROUP = true, PREFETCH = false, AF16 = false;
    const float* xin_f32; bf16_t* xh; bf16_t* xl; float* ssq; const float* ssqp; int dry;
    __device__ __forceinline__ void unit_begin(const Unit& u, EPI_LAS unsigned char* elds, int wave_s) const {
        int t = wave_s * 64 + HW_LANE(); asm volatile("" : "+v"(t));
        if (t < 256) {
            const f32x4* p = (const f32x4*)(ssqp + (size_t)(u.pm * 256 + t) * 32);
            float r[4];
#pragma unroll
            for (int g = 0; g < 4; ++g) { const f32x4 a = p[2 * g], b = p[2 * g + 1]; r[g] = __builtin_amdgcn_rsqf((((a[0] + a[1]) + (a[2] + a[3])) + ((b[0] + b[1]) + (b[2] + b[3]))) * (1.0f / 512.0f) + EPS); }
            *(EPI_LAS f32x4*)(elds + 4096 + t * 16) = (f32x4){r[0] / r[1], r[1] / r[2], r[2] / r[3], r[3]};
        }
    }
    __device__ __forceinline__ void kgroup(f32x4 (&acc)[2][2][4][2], int g, int wr, EPI_LAS unsigned char* elds) const {
        int fr; { int t_ = HW_LANE(); asm volatile("" : "+v"(t_)); fr = t_ & 15; }
        const EPI_LAS float* RG = (const EPI_LAS float*)(elds + 4096) + (g - 1);
#pragma unroll
        for (int ai = 0; ai < 2; ++ai)
#pragma unroll
            for (int m = 0; m < 4; ++m) {
                const float f = RG[(ai * 128 + wr * 64 + m * 16 + fr) * 4];
#pragma unroll
                for (int bj = 0; bj < 2; ++bj) { acc[ai][bj][m][0] *= f; acc[ai][bj][m][1] *= f; }
            }
    }
    __device__ __forceinline__ void operator()(f32x4 (&acc)[2][2][4][2], const Unit& u, int wr, int wc, EPI_LAS unsigned char* elds) const {
        kgroup(acc, 4, wr, elds);
        const EpiResidual<MODE> R{xin_f32, nullptr, xh, xl, ssq, dry};
        R(acc, u, wr, wc, elds);
    }
};

struct EpiSsdIn {
    static constexpr bool PERM = true, ROWIL = false, KGROUP = false, PREFETCH = false, AF16 = (RES_F16 != 0);
    bf16_t* proj; float* dt; const float* dtbias; const float* ssq;
    __device__ __forceinline__ void operator()(f32x4 (&acc)[2][2][4][2], const Unit& u, int wr, int wc, EPI_LAS unsigned char*) const {
        int fr, fq; { int t_ = HW_LANE(); asm volatile("" : "+v"(t_)); fr = t_ & 15; fq = (t_ >> 4) & 3; }
        float rsv[2][4]; rstd8<16>(ssq, u.pm * 256 + wr * 64 + fr, false, rsv);
#pragma unroll
        for (int ai = 0; ai < 2; ++ai)
#pragma unroll
            for (int m = 0; m < 4; ++m) {
                const int row = u.pm * 256 + ai * 128 + wr * 64 + m * 16 + fr;
                const float rs = rsv[ai][m];
                if (u.pn < 20) {
#pragma unroll
                    for (int bj = 0; bj < 2; ++bj) {
                        const f32x4 v0 = acc[ai][bj][m][0] * rs, v1 = acc[ai][bj][m][1] * rs;
                        u32x4 w; w.x = cvt_pk_bf16(v0[0], v0[1]); w.y = cvt_pk_bf16(v0[2], v0[3]); w.z = cvt_pk_bf16(v1[0], v1[1]); w.w = cvt_pk_bf16(v1[2], v1[3]);
                        *(u32x4*)(proj + (size_t)row * 5120 + u.pn * 256 + bj * 128 + wc * 32 + 8 * fq) = w;
                    }
                } else if (wc == 0) {
#pragma unroll
                    for (int n = 0; n < 2; ++n) {
                        const int c = 8 * fq + 4 * n;
                        const f32x4 b = *(const f32x4*)(dtbias + c);
                        f32x4 v = acc[ai][0][m][n] * rs + b, o;
#pragma unroll
                        for (int e = 0; e < 4; ++e) o[e] = softplus_fast(v[e]);
                        *(f32x4*)(dt + (size_t)row * 32 + c) = o;
                    }
                }
            }
    }
};

struct EpiQKV {
    static constexpr bool PERM = true, ROWIL = false, KGROUP = false, PREFETCH = false, AF16 = (RES_F16 != 0);
    bf16_t* proj; const float* ssq; const float* qg; const float* kg; const float* rope;
    __device__ __forceinline__ void operator()(f32x4 (&acc)[2][2][4][2], const Unit& u, int wr, int wc, EPI_LAS unsigned char* elds) const {
        int fr, fq; { int t_ = HW_LANE(); asm volatile("" : "+v"(t_)); fr = t_ & 15; fq = (t_ >> 4) & 3; }
        EPI_LAS float* P = (EPI_LAS float*)elds;
        EPI_LAS f32x4* RT = (EPI_LAS f32x4*)(elds + 8192);
        const bool isqk = u.pn < 8;
        f32x4 rp_[2];
        const int t_id = (wr * 4 + wc) * 64 + fq * 16 + fr;
        if (isqk) {
#pragma unroll
            for (int i = 0; i < 2; ++i) rp_[i] = *(const f32x4*)(rope + (size_t)u.pm * 256 * 16 + (size_t)(t_id * 2 + i) * 4);
        }
        float rsv[2][4]; rstd8<16>(ssq, u.pm * 256 + wr * 64 + fr, false, rsv);
#pragma unroll
        for (int ai = 0; ai < 2; ++ai)
#pragma unroll
            for (int m = 0; m < 4; ++m) {
                const int trow = ai * 128 + wr * 64 + m * 16 + fr;
                const float rs = rsv[ai][m];
#pragma unroll
                for (int bj = 0; bj < 2; ++bj) {
                    acc[ai][bj][m][0] *= rs; acc[ai][bj][m][1] *= rs;
                    if (isqk) {
                        const f32x4 a = acc[ai][bj][m][0], b = acc[ai][bj][m][1];
                        float s = ((a[0] * a[0] + a[1] * a[1]) + (a[2] * a[2] + a[3] * a[3])) + ((b[0] * b[0] + b[1] * b[1]) + (b[2] * b[2] + b[3] * b[3]));
                        s = xl_swap32_sum(xl_swap16_sum(s));
                        if (fq == 0) P[trow * 8 + bj * 4 + wc] = s;
                    }
                }
            }
        if (isqk) { RT[t_id * 2] = rp_[0]; RT[t_id * 2 + 1] = rp_[1]; }
        if (isqk) {
            asm volatile("s_waitcnt lgkmcnt(0)" ::: "memory"); __builtin_amdgcn_s_barrier(); asm volatile("" ::: "memory");
            const float* g = (u.pn < 4) ? qg : kg;
            const int d0 = 32 * (wc & 1) + 8 * fq;
            const f32x4 g0 = *(const f32x4*)(g + d0), g1 = *(const f32x4*)(g + d0 + 4);
            const float qs = (u.pn < 4) ? (1.4426950408889634f * 0.125f) : 1.0f;
            const bool dorope = (wc & 1) == 0;
#pragma unroll
            for (int ai = 0; ai < 2; ++ai)
#pragma unroll
                for (int m = 0; m < 4; ++m) {
                    const int trow = ai * 128 + wr * 64 + m * 16 + fr;
                    const int row = u.pm * 256 + trow;
                    f32x4 c0 = {1.f, 1.f, 1.f, 1.f}, c1 = c0, s0 = {0.f, 0.f, 0.f, 0.f}, s1 = s0;
                    if (dorope && fq < 2) {
                        c0 = RT[trow * 4 + 0]; c1 = RT[trow * 4 + 1]; s0 = RT[trow * 4 + 2]; s1 = RT[trow * 4 + 3];
                        if (fq == 0) { s0 = -s0; s1 = -s1; }
                    }
#pragma unroll
                    for (int bj = 0; bj < 2; ++bj) {
                        const float tot = P[trow * 8 + bj * 4 + wc] + P[trow * 8 + bj * 4 + (wc ^ 1)];
                        const float nr = qs * __builtin_amdgcn_rsqf(tot * (1.0f / 64.0f) + EPS);
                        f32x4 v0 = acc[ai][bj][m][0] * g0 * nr, v1 = acc[ai][bj][m][1] * g1 * nr;
                        if (dorope) {
                            f32x4 o0, o1;
#pragma unroll
                            for (int e = 0; e < 4; ++e) { o0[e] = xl_xor16(v0[e], (fq & 1) != 0); o1[e] = xl_xor16(v1[e], (fq & 1) != 0); }
                            v0 = v0 * c0 + o0 * s0; v1 = v1 * c1 + o1 * s1;
                        }
                        u32x4 w; w.x = cvt_pk_bf16(v0[0], v0[1]); w.y = cvt_pk_bf16(v0[2], v0[3]); w.z = cvt_pk_bf16(v1[0], v1[1]); w.w = cvt_pk_bf16(v1[2], v1[3]);
                        *(u32x4*)(proj + (size_t)row * 3072 + u.pn * 256 + bj * 128 + wc * 32 + 8 * fq) = w;
                    }
                    asm volatile("" ::: "memory");
                }
            asm volatile("s_waitcnt lgkmcnt(0)" ::: "memory"); __builtin_amdgcn_s_barrier(); asm volatile("" ::: "memory");
        } else {
#pragma unroll
            for (int ai = 0; ai < 2; ++ai)
#pragma unroll
                for (int m = 0; m < 4; ++m) {
                    const int row = u.pm * 256 + ai * 128 + wr * 64 + m * 16 + fr;
#pragma unroll
                    for (int bj = 0; bj < 2; ++bj) {
                        const f32x4 v0 = acc[ai][bj][m][0], v1 = acc[ai][bj][m][1];
                        u32x4 w; w.x = cvt_pk_bf16(v0[0], v0[1]); w.y = cvt_pk_bf16(v0[2], v0[3]); w.z = cvt_pk_bf16(v1[0], v1[1]); w.w = cvt_pk_bf16(v1[2], v1[3]);
                        *(u32x4*)(proj + (size_t)row * 3072 + u.pn * 256 + bj * 128 + wc * 32 + 8 * fq) = w;
                    }
                }
        }
    }
};

struct EpiSsdConv {
    static constexpr bool PERM = true, ROWIL = true, KGROUP = false, PREFETCH = true, AF16 = (RES_F16 != 0);
    bf16_t* zp; bf16_t* xbc; float* dt; const float* ssq; const float* cp; int dry;
    template <bool MASK>
    __device__ __forceinline__ void conv_body(f32x4 (&acc)[2][2][4][2], const Unit& u, int wr, int wc, int fr, int fq, const EPI_LAS f32x4* hb, int R0) const {
        bf16_t* const obase = (u.pn < 8) ? zp + u.pn * 256 : xbc + (u.pn - 8) * 256;
        const int old_ = (u.pn < 8) ? 2048 : 3072;
#pragma unroll
        for (int bj = 0; bj < 2; ++bj) {
            u32x2 keep[2][4];
#pragma unroll
            for (int n = 0; n < 2; ++n) {
                const int tc = bj * 128 + wc * 32 + 8 * fq + 4 * n;
                const EPI_LAS float* pt = (const EPI_LAS float*)((const EPI_LAS unsigned char*)hb + 12288) + tc;
                const f32x4 bb = *(const EPI_LAS f32x4*)pt, w0 = *(const EPI_LAS f32x4*)(pt + 256), w1 = *(const EPI_LAS f32x4*)(pt + 512), w2 = *(const EPI_LAS f32x4*)(pt + 768), w3 = *(const EPI_LAS f32x4*)(pt + 1024);
#pragma unroll
                for (int ai = 0; ai < 2; ++ai) {
                    f32x4 h1 = {0.f, 0.f, 0.f, 0.f}, h2 = h1, h3 = h1;
                    const int pwr = wr ^ 1, pai = (wr == 1) ? ai : ai - 1;
                    if (pai >= 0 && fr == 0) { const int idx = (((pwr * 2 + pai) * 4 + wc) * 3 * 4 + fq) * 4 + bj * 2 + n;
                        h1 = hb[idx]; h2 = hb[idx + 16]; h3 = hb[idx + 32]; }
                    const f32x4 v0 = acc[ai][bj][0][n], v1 = acc[ai][bj][1][n], v2 = acc[ai][bj][2][n], v3 = acc[ai][bj][3][n];
                    f32x4 p1, p2, p3;
#pragma unroll
                    for (int e = 0; e < 4; ++e) { p1[e] = dppf<0x111>(h1[e], v1[e]); p2[e] = dppf<0x111>(h2[e], v2[e]); p3[e] = dppf<0x111>(h3[e], v3[e]); }
#pragma unroll
                    for (int m = 0; m < 4; ++m) {
                        const int trow = ai * 128 + wr * 64 + 4 * fr + m, row = R0 + trow;
                        const f32x4 cv = (m == 0) ? v0 : (m == 1) ? v1 : (m == 2) ? v2 : v3;
                        f32x4 x1 = (m == 0) ? p3 : (m == 1) ? v0 : (m == 2) ? v1 : v2;
                        f32x4 x2 = (m == 0) ? p2 : (m == 1) ? p3 : (m == 2) ? v0 : v1;
                        f32x4 x3 = (m == 0) ? p1 : (m == 1) ? p2 : (m == 2) ? p3 : v0;
                        if (MASK) { const int ts = row & 2047; const f32x4 z4 = {0.f, 0.f, 0.f, 0.f}; if (ts < 1) x1 = z4; if (ts < 2) x2 = z4; if (ts < 3) x3 = z4; }
                        const bool valid = trow >= 3 && row < MROWS;
                        const f32x4 o = silu4(bb + w0 * x3 + w1 * x2 + w2 * x1 + w3 * cv);
                        if (n == 0) { keep[ai][m].x = cvt_pk_bf16(o[0], o[1]); keep[ai][m].y = cvt_pk_bf16(o[2], o[3]); }
                        else if (valid) {
                            u32x4 w; w.x = keep[ai][m].x; w.y = keep[ai][m].y; w.z = cvt_pk_bf16(o[0], o[1]); w.w = cvt_pk_bf16(o[2], o[3]);
                            *(u32x4*)(obase + (size_t)row * old_ + tc - 4) = w;
                        }
                    }
                    asm volatile("" ::: "memory");
                }
            }
        }
    }
    __device__ __forceinline__ void prefetch(const Unit& u, EPI_LAS unsigned char* elds, int wave_s) const {
        if (wave_s < 5) {
            int l_ = HW_LANE(); asm volatile("" : "+v"(l_)); const int t_id = wave_s * 64 + l_;
            __builtin_amdgcn_global_load_lds((const unsigned*)(cp + (size_t)wave_s * 5376 + u.pn * 256 + l_ * 4), (EPI_LAS unsigned*)(elds + 12288 + wave_s * 1024), 16, 0, 0);
            if (wave_s < 4) {
                int row = u.pm * 253 - 3 + t_id; row = row < 0 ? 0 : (row >= MROWS ? MROWS - 1 : row);
                __builtin_amdgcn_global_load_lds((const unsigned*)(ssq + (size_t)row * 4), (EPI_LAS unsigned*)(elds + 17408 + wave_s * 1024), 16, 0, 0);
            }
        }
    }
    __device__ __forceinline__ void operator()(f32x4 (&acc)[2][2][4][2], const Unit& u, int wr, int wc, EPI_LAS unsigned char* elds) const {
#ifdef PROBE_EPI_MODE
        if (dry == 3) { asm volatile("" :: "v"(acc[0][0][0][0][0]), "v"(acc[1][1][3][1][3])); return; }
#endif
        int fr, fq; { int t_ = HW_LANE(); asm volatile("" : "+v"(t_)); fr = t_ & 15; fq = (t_ >> 4) & 3; }
        const int R0 = u.pm * 253 - 3;
        EPI_LAS f32x4* hb = (EPI_LAS f32x4*)elds;
        { float rsv[2][4];
          const EPI_LAS f32x4* SS = (const EPI_LAS f32x4*)(elds + 17408) + wr * 64 + 4 * fr;
#pragma unroll
          for (int ai = 0; ai < 2; ++ai)
#pragma unroll
            for (int m = 0; m < 4; ++m) { const f32x4 a = SS[ai * 128 + m]; rsv[ai][m] = __builtin_amdgcn_rsqf(((a[0] + a[1]) + (a[2] + a[3])) * (1.0f / DMODEL) + EPS); }
#pragma unroll
          for (int ai = 0; ai < 2; ++ai)
#pragma unroll
            for (int m = 0; m < 4; ++m)
#pragma unroll
                for (int bj = 0; bj < 2; ++bj) { acc[ai][bj][m][0] *= rsv[ai][m]; acc[ai][bj][m][1] *= rsv[ai][m]; } }
        if (u.pn == 20) {
            if (wc == 0) {
#pragma unroll
                for (int ai = 0; ai < 2; ++ai)
#pragma unroll
                    for (int m = 0; m < 4; ++m) {
                        const int trow = ai * 128 + wr * 64 + 4 * fr + m, row = R0 + trow;
                        if (trow >= 3 && row < MROWS) {
#pragma unroll
                            for (int n = 0; n < 2; ++n) {
                                const int c = 8 * fq + 4 * n;
                                const f32x4 b = *(const EPI_LAS f32x4*)(elds + 12288 + c * 4);
                                f32x4 v = acc[ai][0][m][n] + b, o;
#pragma unroll
                                for (int e = 0; e < 4; ++e) o[e] = softplus_fast(v[e]);
                                *(f32x4*)(dt + (size_t)row * 32 + c) = o;
                            }
                        }
                    }
            }
            asm volatile("s_waitcnt lgkmcnt(0)" ::: "memory"); __builtin_amdgcn_s_barrier(); asm volatile("" ::: "memory");
            return;
        }
        if (fr == 15) {
#pragma unroll
            for (int ai = 0; ai < 2; ++ai)
#pragma unroll
                for (int m = 1; m < 4; ++m) {
                    const int idx = ((((wr * 2 + ai) * 4 + wc) * 3 + (m - 1)) * 4 + fq) * 4;
                    hb[idx + 0] = acc[ai][0][m][0]; hb[idx + 1] = acc[ai][0][m][1]; hb[idx + 2] = acc[ai][1][m][0]; hb[idx + 3] = acc[ai][1][m][1];
                }
        }
        asm volatile("s_waitcnt lgkmcnt(0)" ::: "memory"); __builtin_amdgcn_s_barrier(); asm volatile("" ::: "memory");
        const int tf = (u.pm * 253) & 2047;
        if (dry < 2) { if (tf <= 2 || tf + 252 >= 2048) conv_body<true>(acc, u, wr, wc, fr, fq, hb, R0); else conv_body<false>(acc, u, wr, wc, fr, fq, hb, R0); }
        asm volatile("s_waitcnt lgkmcnt(0)" ::: "memory"); __builtin_amdgcn_s_barrier(); asm volatile("" ::: "memory");
    }
};

struct EpiConvGate {
    static constexpr bool PERM = true, ROWIL = true, KGROUP = false, PREFETCH = true, AF16 = (RES_F16 != 0);
    bf16_t* H; const float* ssq; const float* cw; const float* cb; int dry;
    template <bool MASK>
    __device__ __forceinline__ void body(f32x4 (&acc)[2][2][4][2], const Unit& u, int wr, int wc, int fr, int fq, const EPI_LAS f32x4* hb, int R0) const {
        constexpr int DFF = 2816;
        u32x2 keep[2][4];
#pragma unroll
        for (int n = 0; n < 2; ++n) {
            const int ch = u.pn * 128 + wc * 32 + 8 * fq + 4 * n;
            const EPI_LAS float* pt = (const EPI_LAS float*)((const EPI_LAS unsigned char*)hb + 8192) + wc * 32 + 8 * fq + 4 * n;
            const f32x4 bg = *(const EPI_LAS f32x4*)pt, bu = *(const EPI_LAS f32x4*)(pt + 128);
            const f32x4 w0g = *(const EPI_LAS f32x4*)(pt + 256), w0u = *(const EPI_LAS f32x4*)(pt + 384), w1g = *(const EPI_LAS f32x4*)(pt + 512), w1u = *(const EPI_LAS f32x4*)(pt + 640), w2g = *(const EPI_LAS f32x4*)(pt + 768), w2u = *(const EPI_LAS f32x4*)(pt + 896);
#pragma unroll
            for (int ai = 0; ai < 2; ++ai) {
                f32x4 hg2 = {0.f, 0.f, 0.f, 0.f}, hg3 = hg2, hu2 = hg2, hu3 = hg2;
                const int pwr = wr ^ 1, pai = (wr == 1) ? ai : ai - 1;
                if (pai >= 0 && fr == 0) { const int idx = (((pwr * 2 + pai) * 4 + wc) * 2 * 4 + fq) * 4;
                    hg2 = hb[idx + n]; hu2 = hb[idx + 2 + n]; hg3 = hb[idx + 16 + n]; hu3 = hb[idx + 16 + 2 + n]; }
                const f32x4 g0 = acc[ai][0][0][n], g1_ = acc[ai][0][1][n], g2_ = acc[ai][0][2][n], g3_ = acc[ai][0][3][n];
                const f32x4 u0 = acc[ai][1][0][n], u1_ = acc[ai][1][1][n], u2_ = acc[ai][1][2][n], u3_ = acc[ai][1][3][n];
                f32x4 pg2, pg3, pu2, pu3;
#pragma unroll
                for (int e = 0; e < 4; ++e) { pg2[e] = dppf<0x111>(hg2[e], g2_[e]); pg3[e] = dppf<0x111>(hg3[e], g3_[e]); pu2[e] = dppf<0x111>(hu2[e], u2_[e]); pu3[e] = dppf<0x111>(hu3[e], u3_[e]); }
#pragma unroll
                for (int m = 0; m < 4; ++m) {
                    const int trow = ai * 128 + wr * 64 + 4 * fr + m, row = R0 + trow;
                    const f32x4 cg = (m == 0) ? g0 : (m == 1) ? g1_ : (m == 2) ? g2_ : g3_, cu = (m == 0) ? u0 : (m == 1) ? u1_ : (m == 2) ? u2_ : u3_;
                    f32x4 xg1 = (m == 0) ? pg3 : (m == 1) ? g0 : (m == 2) ? g1_ : g2_, xg2 = (m == 0) ? pg2 : (m == 1) ? pg3 : (m == 2) ? g0 : g1_;
                    f32x4 xu1 = (m == 0) ? pu3 : (m == 1) ? u0 : (m == 2) ? u1_ : u2_, xu2 = (m == 0) ? pu2 : (m == 1) ? pu3 : (m == 2) ? u0 : u1_;
                    if (MASK) { const int ts = row & 2047; const f32x4 z4 = {0.f, 0.f, 0.f, 0.f}; if (ts < 1) { xg1 = z4; xu1 = z4; } if (ts < 2) { xg2 = z4; xu2 = z4; } }
                    const f32x4 gv = bg + w0g * xg2 + w1g * xg1 + w2g * cg;
                    const f32x4 uv = bu + w0u * xu2 + w1u * xu1 + w2u * cu;
                    const f32x4 o = silu4(gv) * uv;
                    if (n == 0) { keep[ai][m].x = cvt_pk_bf16(o[0], o[1]); keep[ai][m].y = cvt_pk_bf16(o[2], o[3]); }
                    else if (trow >= 2 && row < MROWS) {
                        u32x4 w; w.x = keep[ai][m].x; w.y = keep[ai][m].y; w.z = cvt_pk_bf16(o[0], o[1]); w.w = cvt_pk_bf16(o[2], o[3]);
                        asm volatile("" :: "v"(w.x), "v"(w.y), "v"(w.z), "v"(w.w));
                        if (!dry) *(u32x4*)(H + (size_t)row * DFF + ch - 4) = w;
                    }
                }
                asm volatile("" ::: "memory");
            }
        }
    }
    __device__ __forceinline__ void prefetch(const Unit& u, EPI_LAS unsigned char* elds, int wave_s) const {
        if (wave_s < 4) {
            int l_ = HW_LANE(); asm volatile("" : "+v"(l_)); const int t_id = wave_s * 64 + l_;
            const int k = t_id >> 5, c = u.pn * 128 + (t_id & 31) * 4;
            __builtin_amdgcn_global_load_lds((const unsigned*)((k < 2 ? cb + k * 2816 : cw + (size_t)(k - 2) * 2816) + c), (EPI_LAS unsigned*)(elds + 8192 + wave_s * 1024), 16, 0, 0);
            int row = u.pm * 254 - 2 + t_id; row = row < 0 ? 0 : (row >= MROWS ? MROWS - 1 : row);
            __builtin_amdgcn_global_load_lds((const unsigned*)(ssq + (size_t)row * 4), (EPI_LAS unsigned*)(elds + 12288 + wave_s * 1024), 16, 0, 0);
        }
    }
    __device__ __forceinline__ void operator()(f32x4 (&acc)[2][2][4][2], const Unit& u, int wr, int wc, EPI_LAS unsigned char* elds) const {
#ifdef PROBE_EPI_MODE
        if (dry == 3) { asm volatile("" :: "v"(acc[0][0][0][0][0]), "v"(acc[1][1][3][1][3])); return; }
#endif
        int fr, fq; { int t_ = HW_LANE(); asm volatile("" : "+v"(t_)); fr = t_ & 15; fq = (t_ >> 4) & 3; }
        const int R0 = u.pm * 254 - 2;
        EPI_LAS f32x4* hb = (EPI_LAS f32x4*)elds;
        const int t_id = (wr * 4 + wc) * 64 + fq * 16 + fr;
        (void)t_id;
        { float rsv[2][4];
          const EPI_LAS f32x4* SS = (const EPI_LAS f32x4*)(elds + 12288) + wr * 64 + 4 * fr;
#pragma unroll
          for (int ai = 0; ai < 2; ++ai)
#pragma unroll
            for (int m = 0; m < 4; ++m) { const f32x4 a = SS[ai * 128 + m]; rsv[ai][m] = __builtin_amdgcn_rsqf(((a[0] + a[1]) + (a[2] + a[3])) * (1.0f / DMODEL) + EPS); }
#pragma unroll
          for (int ai = 0; ai < 2; ++ai)
#pragma unroll
            for (int m = 0; m < 4; ++m)
#pragma unroll
                for (int bj = 0; bj < 2; ++bj) { acc[ai][bj][m][0] *= rsv[ai][m]; acc[ai][bj][m][1] *= rsv[ai][m]; } }
        if (fr == 15) {
#pragma unroll
            for (int ai = 0; ai < 2; ++ai)
#pragma unroll
                for (int m = 2; m < 4; ++m) {
                    const int idx = ((((wr * 2 + ai) * 4 + wc) * 2 + (m - 2)) * 4 + fq) * 4;
                    hb[idx + 0] = acc[ai][0][m][0]; hb[idx + 1] = acc[ai][0][m][1]; hb[idx + 2] = acc[ai][1][m][0]; hb[idx + 3] = acc[ai][1][m][1];
                }
        }
        asm volatile("s_waitcnt lgkmcnt(0)" ::: "memory"); __builtin_amdgcn_s_barrier(); asm volatile("" ::: "memory");
        const int tf = (u.pm * 254) & 2047;
        if (dry < 2 || dry > 4) { if (tf <= 1 || tf + 253 >= 2048) body<true>(acc, u, wr, wc, fr, fq, hb, R0); else body<false>(acc, u, wr, wc, fr, fq, hb, R0); }
        asm volatile("s_waitcnt lgkmcnt(0)" ::: "memory"); __builtin_amdgcn_s_barrier(); asm volatile("" ::: "memory");
    }
};
}
namespace attn {
using pg8::bf16_t; using pg8::bf16x8; using pg8::f32x4; using pg8::u32x4;
typedef float f32x16 __attribute__((ext_vector_type(16)));
typedef short s16x4 __attribute__((ext_vector_type(4)));
#define AT_LAS __attribute__((address_space(3)))
constexpr int LD = 3072, SEQ = 2048;
constexpr int KT_BYTES = 16384, VT_BYTES = 16384, STG = KT_BYTES + VT_BYTES;
constexpr int L_X = 0;
constexpr int L_WSF = 2 * STG;
constexpr int L_OST = L_WSF + 8 * 256;
constexpr int LDS_BYTES = L_OST + 4 * 8192;
__device__ __forceinline__ int crow(int r, int hi) { return (r & 3) + 8 * (r >> 2) + 4 * hi; }
__device__ __forceinline__ unsigned cvtpk(float lo, float hi) { typedef float f2 __attribute__((ext_vector_type(2))); typedef __bf16 b2 __attribute__((ext_vector_type(2))); f2 v = {lo, hi}; b2 b = __builtin_convertvector(v, b2); return __builtin_bit_cast(unsigned, b); }
__device__ __forceinline__ s16x4 vtr(const AT_LAS char* p) { typedef short v4 __attribute__((ext_vector_type(4))); return __builtin_bit_cast(s16x4, __builtin_amdgcn_ds_read_tr16_b64_v4i16((AT_LAS v4*)p)); }

struct Params { bf16_t* qkv; float mb; float lam; int dry; };

template <int MODE = 0>
__device__ __forceinline__ void unit(const Params& P, int b, int h, int blk, AT_LAS char* lds, const int wave_s) {
    int tid = wave_s * 64 + HW_LANE(); asm volatile("" : "+v"(tid));
    const int lane = tid & 63, r32 = lane & 31, hi = lane >> 5;
    const int wid = __builtin_amdgcn_readfirstlane(tid >> 6), comp = wid >> 2, w4 = wid & 3;
    const size_t rowb = (size_t)b * SEQ;
    const int q0 = blk * 128;
    const int nt = 2 * blk + 2, my_nt = 2 * blk + (w4 >> 1) + 1;
    const bf16_t* Kg = P.qkv + rowb * LD + 1024 + h * 128;
    const bf16_t* Vg = P.qkv + rowb * LD + 2048 + h * 128;
    u32x4 kreg[2], vreg[2];
    int kdst[2], vdst[2];
#pragma unroll
    for (int i = 0; i < 2; ++i) {
        const int p = tid + 512 * i, key = p >> 4, c16 = p & 15;
        kdst[i] = key * 256 + ((c16 ^ (key & 15)) << 4);
        vdst[i] = KT_BYTES + (c16 >> 2) * 4096 + (key >> 4) * 1024 + ((key >> 3) & 1) * 512 + (key & 7) * 64 + (c16 & 3) * 16;
    }
#define AT_LOAD(t) do { _Pragma("unroll") for (int i = 0; i < 2; ++i) { const int p = tid + 512 * i, key = p >> 4, c16 = p & 15; const size_t go = (size_t)((t) * 64 + key) * LD + c16 * 8; \
        kreg[i] = *(const u32x4*)(Kg + go); vreg[i] = *(const u32x4*)(Vg + go); } } while (0)
#define AT_STORE(s) do { _Pragma("unroll") for (int i = 0; i < 2; ++i) { *(AT_LAS u32x4*)(lds + (s) * STG + kdst[i]) = kreg[i]; *(AT_LAS u32x4*)(lds + (s) * STG + vdst[i]) = vreg[i]; } } while (0)
    AT_LOAD(0);
    bf16x8 qr[4];
    {
        const bf16_t* Qw = P.qkv + (rowb + q0 + w4 * 32 + r32) * LD + h * 128 + comp * 64 + hi * 8;
#pragma unroll
        for (int d0 = 0; d0 < 4; ++d0) qr[d0] = *(const bf16x8*)(Qw + d0 * 16);
    }
    AT_STORE(0);
    __syncthreads();
    f32x16 o[4];
#pragma unroll
    for (int i = 0; i < 4; ++i)
#pragma unroll
        for (int r = 0; r < 16; ++r) o[i][r] = 0.f;
    float lsum = 0.f;
    f32x16 negm;
#pragma unroll
    for (int r = 0; r < 16; ++r) negm[r] = -P.mb;
    const int kbase = r32 * 256, ksw = r32 & 15;
    const int vbase = KT_BYTES + ((lane >> 4) & 1) * 32 + (lane & 3) * 8 + (4 * hi + ((lane & 15) >> 2)) * 64;
    for (int t = 0; t < nt; ++t) {
        const int s = t & 1;
        if (MODE != 4) { if (t + 1 < nt) AT_LOAD(t + 1); }
        if (t < my_nt) {
            const AT_LAS char* st = lds + s * STG;
            bf16x8 kf[8];
#pragma unroll
            for (int d0 = 0; d0 < 4; ++d0) {
                const int ch = comp * 8 + 2 * d0 + hi;
                kf[2 * d0] = *(const AT_LAS bf16x8*)(st + kbase + ((ch ^ ksw) << 4));
                kf[2 * d0 + 1] = *(const AT_LAS bf16x8*)(st + kbase + 32 * 256 + ((ch ^ ksw) << 4));
            }
            s16x4 vlo[2][4], vhi[2][4];
#define AT_VLOAD(bk, buf) do { _Pragma("unroll") for (int ks = 0; ks < 4; ++ks) { vlo[buf][ks] = vtr(st + vbase + (bk) * 4096 + ks * 1024); vhi[buf][ks] = vtr(st + vbase + (bk) * 4096 + ks * 1024 + 512); } } while (0)
            AT_VLOAD(0, 0);
            __builtin_amdgcn_sched_barrier(0);
            f32x16 p0 = negm, p1 = negm;
            if (MODE != 3) {
#pragma unroll
            for (int d0 = 0; d0 < 4; ++d0) {
                p0 = __builtin_amdgcn_mfma_f32_32x32x16_bf16(kf[2 * d0], qr[d0], p0, 0, 0, 0);
                p1 = __builtin_amdgcn_mfma_f32_32x32x16_bf16(kf[2 * d0 + 1], qr[d0], p1, 0, 0, 0);
            } }
            __builtin_amdgcn_sched_barrier(0);
            AT_VLOAD(1, 1);
            __builtin_amdgcn_sched_barrier(0);
            float sacc0 = 0.f, sacc1 = 0.f;
#pragma unroll
            for (int r = 0; r < 16; ++r) { if (MODE != 1) { p0[r] = __builtin_amdgcn_exp2f(p0[r]); p1[r] = __builtin_amdgcn_exp2f(p1[r]); } sacc0 += p0[r]; sacc1 += p1[r]; }
            lsum += sacc0 + sacc1;
            u32x4 pw[4];
#pragma unroll
            for (int j = 0; j < 4; ++j) { pw[0][j] = cvtpk(p0[2 * j], p0[2 * j + 1]); pw[1][j] = cvtpk(p0[8 + 2 * j], p0[8 + 2 * j + 1]); pw[2][j] = cvtpk(p1[2 * j], p1[2 * j + 1]); pw[3][j] = cvtpk(p1[8 + 2 * j], p1[8 + 2 * j + 1]); }
#define AT_PV(bk, buf) do { _Pragma("unroll") for (int ks = 0; ks < 4; ++ks) { \
                const bf16x8 vf = {vlo[buf][ks][0], vlo[buf][ks][1], vlo[buf][ks][2], vlo[buf][ks][3], vhi[buf][ks][0], vhi[buf][ks][1], vhi[buf][ks][2], vhi[buf][ks][3]}; \
                if (MODE != 2) o[bk] = __builtin_amdgcn_mfma_f32_32x32x16_bf16(__builtin_bit_cast(bf16x8, pw[ks]), vf, o[bk], 0, 0, 0); else asm volatile("" :: "v"(pw[ks])); } } while (0)
            __builtin_amdgcn_sched_barrier(0);
            AT_PV(0, 0); __builtin_amdgcn_sched_barrier(0); AT_VLOAD(2, 0); __builtin_amdgcn_sched_barrier(0);
            AT_PV(1, 1); __builtin_amdgcn_sched_barrier(0); AT_VLOAD(3, 1); __builtin_amdgcn_sched_barrier(0);
            AT_PV(2, 0);
            AT_PV(3, 1);
#undef AT_VLOAD
#undef AT_PV
        }
        if (MODE != 4) { if (t + 1 < nt) AT_STORE(s ^ 1); }
        if (MODE != 5) __syncthreads();
    }
    lsum = xl_swap32_sum(lsum);
    AT_LAS float* wsf = (AT_LAS float*)(lds + L_WSF) + wid * 64;
    if (hi == 0) wsf[r32] = lsum;
    asm volatile("s_waitcnt lgkmcnt(0)" ::: "memory");
    float rl[16];
    const float sc = comp ? P.lam : 1.0f;
#pragma unroll
    for (int r = 0; r < 16; ++r) rl[r] = sc * __builtin_amdgcn_rcpf(wsf[crow(r, hi)]);
    AT_LAS float* X = (AT_LAS float*)(lds + L_X) + w4 * 4096 + lane;
    if (comp == 1) {
#pragma unroll
        for (int bk = 0; bk < 4; ++bk)
#pragma unroll
            for (int r = 0; r < 16; ++r) X[(bk * 16 + r) * 64] = o[bk][r] * rl[r];
    }
    __syncthreads();
    if (comp == 0) {
        float ss[16];
#pragma unroll
        for (int r = 0; r < 16; ++r) ss[r] = 0.f;
#pragma unroll
        for (int bk = 0; bk < 4; ++bk)
#pragma unroll
            for (int r = 0; r < 16; ++r) { const float v = o[bk][r] * rl[r] - X[(bk * 16 + r) * 64]; o[bk][r] = v; ss[r] += v * v; }
#pragma unroll
        for (int r = 0; r < 16; ++r) {
            float s = ss[r];
            s = xl_swap16_sum(xl_sum16(s));
            ss[r] = __builtin_amdgcn_rsqf(s * (1.0f / 128.0f) + 1e-6f);
        }
        AT_LAS bf16_t* stg = (AT_LAS bf16_t*)(lds + L_OST) + w4 * 4096;
#pragma unroll
        for (int bk = 0; bk < 4; ++bk)
#pragma unroll
            for (int r = 0; r < 16; ++r) { const float v = o[bk][r] * ss[r]; stg[crow(r, hi) * 128 + bk * 32 + r32] = (bf16_t)(cvtpk(v, 0.f) & 0xffffu); }
        asm volatile("s_waitcnt lgkmcnt(0)" ::: "memory");
        bf16_t* Ow = P.qkv + (rowb + q0 + w4 * 32) * LD + h * 128;
#pragma unroll
        for (int i = 0; i < 8; ++i) { const int row = i * 4 + (lane >> 4), c = lane & 15; const u32x4 v = *(const AT_LAS u32x4*)(stg + row * 128 + c * 8); if (!P.dry) *(u32x4*)(Ow + (size_t)row * LD + c * 8) = v; }
    }
    __syncthreads();
#undef AT_LOAD
#undef AT_STORE
}
}
namespace scan {
using pg8::bf16_t; using pg8::bf16x8; using pg8::f32x4; using pg8::u32x4; using pg8::u32x2;
typedef float f32x16 __attribute__((ext_vector_type(16)));
#define SC_LAS __attribute__((address_space(3)))
#define SC_BAR() do { asm volatile("s_waitcnt lgkmcnt(0)" ::: "memory"); __builtin_amdgcn_s_barrier(); asm volatile("" ::: "memory"); } while (0)
constexpr int SEQ = 2048, CH = 64;
constexpr int L_C = 0;
constexpr int L_B = 16384;
constexpr int L_XD = 32768;
constexpr int L_XW = 40960;
constexpr int L_G = 49152;
constexpr int L_H = 57344;
constexpr int L_Y = 73728;
constexpr int L_S = L_Y + 64 * 68 * 4;
constexpr int LDS_BYTES = L_S + 32 * 1024;
__device__ __forceinline__ unsigned cvtpk(float lo, float hi) { typedef float f2 __attribute__((ext_vector_type(2))); typedef __bf16 b2 __attribute__((ext_vector_type(2))); f2 v = {lo, hi}; b2 b = __builtin_convertvector(v, b2); return __builtin_bit_cast(unsigned, b); }
typedef short s16x4 __attribute__((ext_vector_type(4)));
__device__ __forceinline__ s16x4 vtr(const SC_LAS char* p) { typedef short v4 __attribute__((ext_vector_type(4))); return __builtin_bit_cast(s16x4, __builtin_amdgcn_ds_read_tr16_b64_v4i16((SC_LAS v4*)p)); }
__device__ __forceinline__ float lo16(unsigned w) { return __builtin_bit_cast(float, w << 16); }
__device__ __forceinline__ float hi16(unsigned w) { return __builtin_bit_cast(float, w & 0xffff0000u); }
__device__ __forceinline__ int img_off(int l) { return (l >> 4) * 1024 + ((l >> 3) & 1) * 512 + (l & 7) * 64; }

struct Params { const bf16_t* xbc; bf16_t* zp; const float* dt; const float* a_log; const float* dskip; float* ssqp; int dry; };

__device__ __forceinline__ void unit(const Params& P, int b, int h, SC_LAS char* lds, const int wave_s) {
    int tid = wave_s * 64 + HW_LANE(); asm volatile("" : "+v"(tid));
    const int wid = __builtin_amdgcn_readfirstlane(tid >> 6);
    const int g = h >> 3;
    const size_t rowb = (size_t)b * SEQ;
    const float a_h = -expf(P.a_log[h]), dsk = P.dskip[h];
    unsigned zu = 0u; asm volatile("" : "+v"(zu));
    {
        const int lane_ = tid & 63;
#pragma unroll
        for (int q = 0; q < 4; ++q) {
            const int cc = wid * 4 + q;
            const float dtv = P.dt[(rowb + cc * 64 + lane_) * 32 + h];
            float acs = dtv * a_h;
            acs = xl_scan64(acs);
            const float last = __builtin_bit_cast(float, __builtin_amdgcn_readlane(__builtin_bit_cast(int, acs), 63));
            SC_LAS float* sc = (SC_LAS float*)(lds + L_S) + cc * 256;
            sc[lane_] = dtv; sc[64 + lane_] = acs; sc[128 + lane_] = __expf(last - acs); sc[192 + lane_] = __expf(acs);
        }
    }
    for (int i = tid; i < 16384 / 16; i += 512) *(SC_LAS u32x4*)(lds + L_H + i * 16) = (u32x4){zu, zu, zu, zu};
    f32x16 hacc0, hacc1;
#pragma unroll
    for (int r = 0; r < 16; ++r) { hacc0[r] = 0.f; hacc1[r] = 0.f; }
    const int tid0 = tid;
    u32x4 xr, zr, br[2], cr[2];
#define SC_LOAD(t0_, XR, ZR) do { const int t_ = tid0; const size_t r1 = rowb + (t0_) + (t_ >> 3); \
        XR = *(const u32x4*)(P.xbc + r1 * 3072 + h * 64 + (t_ & 7) * 8); ZR = *(const u32x4*)(P.zp + r1 * 2048 + h * 64 + (t_ & 7) * 8); \
        _Pragma("unroll") for (int i = 0; i < 2; ++i) { const int p_ = t_ + 512 * i; const size_t r2 = rowb + (t0_) + (p_ >> 4); \
            br[i] = *(const u32x4*)(P.xbc + r2 * 3072 + 2048 + g * 128 + (p_ & 15) * 8); cr[i] = *(const u32x4*)(P.xbc + r2 * 3072 + 2560 + g * 128 + (p_ & 15) * 8); } } while (0)
    SC_LOAD(0, xr, zr);
    __syncthreads();
    for (int c = 0; c < SEQ / CH; ++c) {
        const int t0 = c * CH;
        int tid = tid0; asm volatile("" : "+v"(tid));
        const int lane = tid & 63, r32 = lane & 31, hi = lane >> 5, fr = lane & 15, fq = lane >> 4;
        const int orow = tid >> 3, ocg = tid & 7;
        SC_LAS float* s_dt = (SC_LAS float*)(lds + L_S) + c * 256; SC_LAS float* s_acs = s_dt + 64; SC_LAS float* s_dec = s_dt + 128; SC_LAS float* s_ea = s_dt + 192;
        {
            const float d = s_dt[orow], dd = d * s_dec[orow];
            u32x4 w1, w2;
#pragma unroll
            for (int i = 0; i < 4; ++i) { const float a = lo16(xr[i]), bq = hi16(xr[i]); w1[i] = cvtpk(a * d, bq * d); w2[i] = cvtpk(a * dd, bq * dd); }
            const int off = (ocg >> 2) * 4096 + img_off(orow) + (ocg & 3) * 16;
            *(SC_LAS u32x4*)(lds + L_XD + off) = w1; *(SC_LAS u32x4*)(lds + L_XW + off) = w2;
#pragma unroll
            for (int i = 0; i < 2; ++i) { const int p = tid + 512 * i, l = p >> 4, c16 = p & 15;
                *(SC_LAS u32x4*)(lds + L_B + (c16 >> 2) * 4096 + img_off(l) + (c16 & 3) * 16) = br[i];
                *(SC_LAS u32x4*)(lds + L_C + l * 256 + ((c16 ^ (l & 15)) << 4)) = cr[i]; }
        }
        const u32x4 xcur = xr, zcur = zr;
        if (c + 1 < SEQ / CH) SC_LOAD(t0 + CH, xr, zr);
        SC_BAR();
        f32x16 yacc;
#pragma unroll
        for (int r = 0; r < 16; ++r) yacc[r] = 0.f;
        const int yli = (wid >> 1) & 1, ypi = wid & 1;
        if (wid < 3) {
            const int si = (wid == 2) ? 1 : 0, li = (wid == 0) ? 0 : 1;
            const int srow = 32 * si + r32, lrow = 32 * li + r32;
            f32x16 cb;
#pragma unroll
            for (int r = 0; r < 16; ++r) cb[r] = 0.f;
            bf16x8 fa[8], fb[8];
#pragma unroll
            for (int ks = 0; ks < 8; ++ks) {
                const int chk = 2 * ks + hi;
                fa[ks] = *(const SC_LAS bf16x8*)(lds + L_B + (chk >> 2) * 4096 + img_off(srow) + (chk & 3) * 16);
                fb[ks] = *(const SC_LAS bf16x8*)(lds + L_C + lrow * 256 + ((chk ^ (lrow & 15)) << 4));
            }
            __builtin_amdgcn_sched_barrier(0);
#pragma unroll
            for (int ks = 0; ks < 8; ++ks) cb = __builtin_amdgcn_mfma_f32_32x32x16_bf16(fa[ks], fb[ks], cb, 0, 0, 0);
            const float al = s_acs[lrow];
#pragma unroll
            for (int q4 = 0; q4 < 4; ++q4) {
                const int s0 = 32 * si + 8 * q4 + 4 * hi;
                float gv[4];
#pragma unroll
                for (int e = 0; e < 4; ++e) { const int sidx = s0 + e; gv[e] = (sidx <= lrow) ? cb[4 * q4 + e] * __expf(al - s_acs[sidx]) : 0.f; }
                u32x2 w; w.x = cvtpk(gv[0], gv[1]); w.y = cvtpk(gv[2], gv[3]);
                *(SC_LAS u32x2*)(lds + L_G + lrow * 128 + (((s0 >> 3) ^ (lrow & 7)) << 4) + (s0 & 7) * 2) = w;
            }
        } else if (wid >= 4) {
            const int lrow = 32 * yli + r32, prow = 32 * ypi + r32;
            bf16x8 fa[8], fb[8];
#pragma unroll
            for (int ks = 0; ks < 8; ++ks) {
                const int chk = 2 * ks + hi;
                fa[ks] = *(const SC_LAS bf16x8*)(lds + L_C + lrow * 256 + ((chk ^ (lrow & 15)) << 4));
                fb[ks] = *(const SC_LAS bf16x8*)(lds + L_H + prow * 256 + ((chk ^ (prow & 15)) << 4));
            }
            __builtin_amdgcn_sched_barrier(0);
#pragma unroll
            for (int ks = 0; ks < 8; ++ks) yacc = __builtin_amdgcn_mfma_f32_32x32x16_bf16(fa[ks], fb[ks], yacc, 0, 0, 0);
        }
        SC_BAR();
        if (wid >= 4) {
#pragma unroll
            for (int r = 0; r < 16; ++r) yacc[r] *= s_ea[32 * yli + (r & 3) + 8 * (r >> 2) + 4 * hi];
            const int lrow = 32 * yli + r32;
            const int tbn = ((lane >> 4) & 1) * 32 + (lane & 3) * 8 + hi * 512 + ((lane & 15) >> 2) * 64;
            bf16x8 ga[4]; s16x4 xb0[4], xb1[4];
#pragma unroll
            for (int ks = 0; ks < 4; ++ks) {
                const int chk = 2 * ks + hi;
                ga[ks] = *(const SC_LAS bf16x8*)(lds + L_G + lrow * 128 + ((chk ^ (lrow & 7)) << 4));
                xb0[ks] = vtr(lds + L_XD + ypi * 4096 + ks * 1024 + tbn); xb1[ks] = vtr(lds + L_XD + ypi * 4096 + ks * 1024 + tbn + 256);
            }
            __builtin_amdgcn_sched_barrier(0);
#pragma unroll
            for (int ks = 0; ks < 4; ++ks) {
                if (ks < 2 * (yli + 1)) {
                    const bf16x8 bb = {xb0[ks][0], xb0[ks][1], xb0[ks][2], xb0[ks][3], xb1[ks][0], xb1[ks][1], xb1[ks][2], xb1[ks][3]};
                    yacc = __builtin_amdgcn_mfma_f32_32x32x16_bf16(ga[ks], bb, yacc, 0, 0, 0);
                }
            }
#pragma unroll
            for (int r = 0; r < 16; ++r) ((SC_LAS float*)(lds + L_Y))[(32 * yli + (r & 3) + 8 * (r >> 2) + 4 * hi) * 68 + 32 * ypi + r32] = yacc[r];
        } else {
            const float cd = __expf(s_acs[63]);
#pragma unroll
            for (int r = 0; r < 16; ++r) { hacc0[r] *= cd; hacc1[r] *= cd; }
            const int tb = ((lane >> 4) & 1) * 32 + (lane & 3) * 8 + (4 * hi + ((lane & 15) >> 2)) * 64;
            s16x4 a0[4], a1[4], b0[4], b1[4], c0[4], c1[4];
#pragma unroll
            for (int ks = 0; ks < 4; ++ks) {
                a0[ks] = vtr(lds + L_B + wid * 4096 + ks * 1024 + tb); a1[ks] = vtr(lds + L_B + wid * 4096 + ks * 1024 + 512 + tb);
                b0[ks] = vtr(lds + L_XW + ks * 1024 + tb); b1[ks] = vtr(lds + L_XW + ks * 1024 + 512 + tb);
                c0[ks] = vtr(lds + L_XW + 4096 + ks * 1024 + tb); c1[ks] = vtr(lds + L_XW + 4096 + ks * 1024 + 512 + tb);
            }
            __builtin_amdgcn_sched_barrier(0);
#pragma unroll
            for (int ks = 0; ks < 4; ++ks) {
                const bf16x8 a = {a0[ks][0], a0[ks][1], a0[ks][2], a0[ks][3], a1[ks][0], a1[ks][1], a1[ks][2], a1[ks][3]};
                const bf16x8 bb = {b0[ks][0], b0[ks][1], b0[ks][2], b0[ks][3], b1[ks][0], b1[ks][1], b1[ks][2], b1[ks][3]};
                const bf16x8 cc = {c0[ks][0], c0[ks][1], c0[ks][2], c0[ks][3], c1[ks][0], c1[ks][1], c1[ks][2], c1[ks][3]};
                hacc0 = __builtin_amdgcn_mfma_f32_32x32x16_bf16(a, bb, hacc0, 0, 0, 0);
                hacc1 = __builtin_amdgcn_mfma_f32_32x32x16_bf16(a, cc, hacc1, 0, 0, 0);
            }
#pragma unroll
            for (int q4 = 0; q4 < 4; ++q4) {
                const int n0 = 32 * wid + 8 * q4 + 4 * hi;
                u32x2 w0, w1; w0.x = cvtpk(hacc0[4 * q4 + 0], hacc0[4 * q4 + 1]); w0.y = cvtpk(hacc0[4 * q4 + 2], hacc0[4 * q4 + 3]);
                w1.x = cvtpk(hacc1[4 * q4 + 0], hacc1[4 * q4 + 1]); w1.y = cvtpk(hacc1[4 * q4 + 2], hacc1[4 * q4 + 3]);
                *(SC_LAS u32x2*)(lds + L_H + r32 * 256 + (((n0 >> 3) ^ (r32 & 15)) << 4) + (n0 & 7) * 2) = w0;
                *(SC_LAS u32x2*)(lds + L_H + (32 + r32) * 256 + (((n0 >> 3) ^ (r32 & 15)) << 4) + (n0 & 7) * 2) = w1;
            }
        }
        SC_BAR();
        {
            const SC_LAS float* yr = (const SC_LAS float*)(lds + L_Y) + orow * 68 + ocg * 8;
            const f32x4 y0 = *(const SC_LAS f32x4*)yr, y1 = *(const SC_LAS f32x4*)(yr + 4);
            float yv[8];
#pragma unroll
            for (int i = 0; i < 4; ++i) {
                const float ya = (i < 2) ? y0[2 * i] : y1[2 * i - 4], yb = (i < 2) ? y0[2 * i + 1] : y1[2 * i - 3];
                yv[2 * i] = (ya + dsk * lo16(xcur[i])) * lo16(zcur[i]); yv[2 * i + 1] = (yb + dsk * hi16(xcur[i])) * hi16(zcur[i]);
            }
            float ss = 0.f;
#pragma unroll
            for (int i = 0; i < 8; ++i) ss += yv[i] * yv[i];
            ss = xl_sum8(ss);
            if (ocg == 0) P.ssqp[(rowb + t0 + orow) * 32 + h] = ss;
            u32x4 w; w.x = cvtpk(yv[0], yv[1]); w.y = cvtpk(yv[2], yv[3]); w.z = cvtpk(yv[4], yv[5]); w.w = cvtpk(yv[6], yv[7]);
            if (!P.dry) *(u32x4*)(P.zp + (rowb + t0 + orow) * 2048 + h * 64 + ocg * 8) = w;
        }
    }
    __syncthreads();
#undef SC_LOAD
}
}
namespace mk {
#define GAS __attribute__((address_space(1)))
#define LAS __attribute__((address_space(3)))
typedef unsigned short bf16;
typedef unsigned v4u __attribute__((ext_vector_type(4)));
typedef float f32x4 __attribute__((ext_vector_type(4)));
typedef GAS unsigned gu32;
#define RLX_AGENT __ATOMIC_RELAXED, __HIP_MEMORY_SCOPE_AGENT
constexpr int NWAVES = 8;
constexpr int M = 16384, D = 1024, SEQ = 2048, NB = 8;
constexpr int SSD_NP = 5376, SSD_IN = 5152, SSD_DI = 2048, SSD_LD = 5120;
constexpr int AT_IN = 3072, DFF = 2816;
constexpr size_t MiB = 1u << 20;
constexpr size_t WS_CTL = 0, CTL_ZERO_BYTES = 64 * 1024;
constexpr size_t WS_CONST = 64 * 1024;
constexpr size_t WS_SSQ = 1 * MiB;
constexpr size_t WS_ROPE = 2 * MiB;
constexpr size_t WS_DT = 3 * MiB;
constexpr size_t WS_SSQP = 5 * MiB;
constexpr size_t WS_CP = 1 * MiB + 512 * 1024;
constexpr size_t WS_W = 7 * MiB;
constexpr size_t W_SSD_IN = 0, W_SSD_IN_SZ = (size_t)SSD_NP * D * 2;
constexpr size_t W_SSD_OUT = W_SSD_IN + 2 * W_SSD_IN_SZ, W_SSD_OUT_SZ = (size_t)D * SSD_DI * 2;
constexpr size_t W_AT_IN = W_SSD_OUT + 2 * W_SSD_OUT_SZ, W_AT_IN_SZ = (size_t)AT_IN * D * 2;
constexpr size_t W_AT_OUT = W_AT_IN + 2 * W_AT_IN_SZ, W_AT_OUT_SZ = (size_t)D * D * 2;
constexpr size_t W_UP = W_AT_OUT + 2 * W_AT_OUT_SZ, W_UP_SZ = (size_t)2 * DFF * D * 2;
constexpr size_t W_DOWN = W_UP + 4 * W_UP_SZ, W_DOWN_SZ = (size_t)D * DFF * 2;
constexpr size_t W_TOTAL = W_DOWN + 4 * W_DOWN_SZ;
constexpr size_t WS_XB = ((WS_W + W_TOTAL + MiB - 1) / MiB) * MiB;
constexpr size_t XB_PAD_FRONT = 4 * D * 2, XB_BYTES = (size_t)(M + 260) * D * 2;
constexpr size_t WS_BIG = ((WS_XB + XB_BYTES + MiB - 1) / MiB) * MiB;
constexpr size_t BIG_BYTES = (size_t)M * SSD_LD * 2;
constexpr size_t WS_DBG = WS_BIG + BIG_BYTES;
constexpr size_t WS_END = WS_DBG + (size_t)M * D * 2;
static_assert(WS_END <= 352 * MiB, "workspace map exceeds the guaranteed 352 MiB");
constexpr int CW_BAR = 1024;
constexpr int RING_BYTES = 131072, EPI_OFF = RING_BYTES, EPI_BYTES = 26624, MISC_OFF = EPI_OFF + EPI_BYTES;
constexpr int LDS_BYTES = 158720;
static_assert(MISC_OFF + 1024 <= LDS_BYTES && attn::LDS_BYTES <= RING_BYTES && scan::LDS_BYTES <= RING_BYTES, "LDS map");

#define LDS_WAIT() asm volatile("s_waitcnt lgkmcnt(0)" ::: "memory")
__device__ __forceinline__ unsigned f2bf(float f) { unsigned u = __builtin_bit_cast(unsigned, f); return (u + 0x7fffu + ((u >> 16) & 1u)) >> 16; }
__device__ __forceinline__ unsigned pk2(float lo, float hi) { return f2bf(lo) | (f2bf(hi) << 16); }
template <bool F16> __device__ __forceinline__ unsigned pk2x(float lo, float hi) { if constexpr (F16) return epi::pk_f16(lo, hi); else return pk2(lo, hi); }

#define XB_TMO      128
#define XB_XCNT(j)  (256  + 64 * (j))
#define XB_XSUB(j)  (1280 + 64 * (j))
#define XB_XGEN(j)  (2304 + 64 * (j))
#define XB_TOP      3328
#define XB_TOPGEN   3392
#define XCD_BAR_WORDS 3456
#define XB_SPIN_CAP (1u << 20)
__device__ __forceinline__ unsigned xb_ld(unsigned* p)              { return __hip_atomic_load(p, __ATOMIC_RELAXED, __HIP_MEMORY_SCOPE_AGENT); }
__device__ __forceinline__ unsigned xb_add(unsigned* p, unsigned v) { return __hip_atomic_fetch_add(p, v, __ATOMIC_RELAXED, __HIP_MEMORY_SCOPE_AGENT); }
__device__ __forceinline__ unsigned xb_xcc_id() { return (unsigned)__builtin_amdgcn_s_getreg((3 << 11) | 20) & 0xFu; }
#define XB_SPIN(cond, bar) do { unsigned _sp = 0; while (cond) { __builtin_amdgcn_s_sleep(1); \
    if ((++_sp & 255u) == 0u) { if (xb_ld(&(bar)[XB_TMO])) break; if (_sp > XB_SPIN_CAP) { atomicAdd(&(bar)[XB_TMO], 1u); break; } } } } while (0)
struct XcdBarrier { unsigned* bar; unsigned x; volatile LAS unsigned* st; };
__device__ __forceinline__ XcdBarrier xcd_barrier_post(unsigned* bar, volatile LAS unsigned* st, bool leader) {
    XcdBarrier b; b.bar = bar; b.x = xb_xcc_id(); b.st = st;
    if (leader) (void)xb_add(&bar[XB_XCNT(b.x)], 1u);
    return b;
}
__device__ __forceinline__ void xcd_barrier_complete(unsigned* bar, unsigned x, unsigned& nloc, unsigned& nx) {
    const unsigned G = gridDim.x * gridDim.y * gridDim.z;
    unsigned sum, cnt, mine, sp = 0u;
    for (;;) {
        sum = 0u; cnt = 0u; mine = 0u;
#pragma unroll
        for (unsigned j = 0; j < 16; ++j) { const unsigned c = xb_ld(&bar[XB_XCNT(j)]); sum += c; cnt += (c > 0u) ? 1u : 0u; mine = (j == x) ? c : mine; }
        if (sum == G) break;
        __builtin_amdgcn_s_sleep(1);
        if ((++sp & 255u) == 0u) { if (xb_ld(&bar[XB_TMO])) break; if (sp > XB_SPIN_CAP) { atomicAdd(&bar[XB_TMO], 1u); break; } }
    }
    nloc = mine > 0u ? mine : 1u; nx = cnt > 0u ? cnt : 1u;
}
__device__ __forceinline__ void xcd_barrier(const XcdBarrier& b, const int wave_s) {
    asm volatile("s_waitcnt vmcnt(0)" ::: "memory");
    __syncthreads();
    if (wave_s == 0 && HW_LANE() == 0) {
        unsigned* bar = b.bar; asm volatile("" : "+s"(bar));
        __builtin_amdgcn_s_waitcnt(0);
        unsigned nloc = b.st[0], nx = b.st[1];
        if (nloc == 0u) { xcd_barrier_complete(bar, b.x, nloc, nx); b.st[0] = nloc; b.st[1] = nx; }
        const unsigned old = xb_add(&bar[XB_XSUB(b.x)], 1u);
        const unsigned gen = old / nloc;
        if (old + 1u == (gen + 1u) * nloc) {
            __builtin_amdgcn_fence(__ATOMIC_RELEASE, "agent");
            asm volatile("s_waitcnt vmcnt(0)" ::: "memory");
            const unsigned og = xb_add(&bar[XB_TOP], 1u);
            const unsigned tg = og / nx;
            if (og + 1u == (tg + 1u) * nx) xb_add(&bar[XB_TOPGEN], 1u);
            else XB_SPIN(xb_ld(&bar[XB_TOPGEN]) == tg, bar);
            __builtin_amdgcn_fence(__ATOMIC_ACQUIRE, "agent");
            xb_add(&bar[XB_XGEN(b.x)], 1u);
            asm volatile("s_waitcnt vmcnt(0)" ::: "memory");
        } else {
            XB_SPIN(xb_ld(&bar[XB_XGEN(b.x)]) == gen, bar);
            __builtin_amdgcn_fence(__ATOMIC_ACQUIRE, "agent");
            asm volatile("s_waitcnt vmcnt(0)" ::: "memory");
        }
    }
    __syncthreads();
}

__device__ __forceinline__ unsigned long long ldarg(LAS unsigned long long* AP, int i) {
    asm volatile("" : "+s"(i));
    const unsigned long long v = AP[i];
    return ((unsigned long long)(unsigned)__builtin_amdgcn_readfirstlane((int)(v >> 32)) << 32) | (unsigned long long)(unsigned)__builtin_amdgcn_readfirstlane((int)v);
}
struct Args { const void* in[25]; float* out; unsigned char* ws; int ph_lo, ph_hi; int dbg, pad; };

__device__ __forceinline__ float wave_sum(float v) {
    return xl_sum64(v);
}
template <bool F16  , class RowMap>
__device__ __forceinline__ void transpose_item(const float* W, int K, int N, const float* gain, int gmask, float gscale, bf16* WT, const RowMap& rm, LAS float* scr, int item, int item2, int lane) {
    const int nblk = N / 32, rs = lane >> 3, c4 = lane & 7, c = lane & 7;
    f32x4 va[8], vb[8]; float ga[8], gb[8];
    const int kA = 64 * (item / nblk), nA = 32 * (item % nblk);
    const int it2 = item2 < 0 ? item : item2; const int kB = 64 * (it2 / nblk), nB = 32 * (it2 % nblk);
#pragma unroll
    for (int i = 0; i < 8; ++i) { const int kk = 8 * i + rs; va[i] = *(const f32x4*)(W + (size_t)(kA + kk) * N + nA + 4 * c4); ga[i] = gain ? gain[(kA + kk) & gmask] * gscale : 1.0f; }
    if (item2 >= 0) {
#pragma unroll
        for (int i = 0; i < 8; ++i) { const int kk = 8 * i + rs; vb[i] = *(const f32x4*)(W + (size_t)(kB + kk) * N + nB + 4 * c4); gb[i] = gain ? gain[(kB + kk) & gmask] * gscale : 1.0f; }
    }
#pragma unroll
    for (int h = 0; h < 2; ++h) {
        if (h == 1 && item2 < 0) break;
        const int k0 = h ? kB : kA, n0 = h ? nB : nA;
#pragma unroll
        for (int i = 0; i < 8; ++i) { const int kk = 8 * i + rs; LAS float* d = scr + kk * 33 + 4 * c4; const f32x4 v = h ? vb[i] : va[i]; const float g = h ? gb[i] : ga[i]; d[0] = v[0] * g; d[1] = v[1] * g; d[2] = v[2] * g; d[3] = v[3] * g; }
        LDS_WAIT(); asm volatile("" ::: "memory");
#pragma unroll
        for (int j = 0; j < 4; ++j) { const int n = (lane >> 3) + 8 * j; const LAS float* sp = scr + (8 * c) * 33 + n;
            v4u o;
#ifndef W16_BF16_GRID
#define W16_BF16_GRID 1
#endif
#if W16_BF16_GRID
            if constexpr (F16) {
                float t_[8];
#pragma unroll
                for (int q_ = 0; q_ < 8; ++q_) t_[q_] = __builtin_bit_cast(float, f2bf(sp[q_ * 33]) << 16);
                o.x = epi::pk_f16(t_[0], t_[1]); o.y = epi::pk_f16(t_[2], t_[3]); o.z = epi::pk_f16(t_[4], t_[5]); o.w = epi::pk_f16(t_[6], t_[7]);
            } else
#endif
            { o.x = pk2x<F16>(sp[0 * 33], sp[1 * 33]); o.y = pk2x<F16>(sp[2 * 33], sp[3 * 33]); o.z = pk2x<F16>(sp[4 * 33], sp[5 * 33]); o.w = pk2x<F16>(sp[6 * 33], sp[7 * 33]); }
            *(GAS v4u*)(WT + (size_t)rm(n0 + n) * K + k0 + 8 * c) = o; }
        LDS_WAIT(); asm volatile("" ::: "memory");
    }
}
struct RowId { __device__ __forceinline__ int operator()(int n) const { return n; } };
struct RowUp { __device__ __forceinline__ int operator()(int n) const { const int u = n >= DFF, ch = u ? n - DFF : n; return (ch >> 7) * 256 + u * 128 + (ch & 127); } };

__global__ void __launch_bounds__(NWAVES * 64, 2) mega_fwd(Args args) {
    extern __shared__ __attribute__((aligned(16))) unsigned char lds_raw[];
    LAS unsigned char* lds = (LAS unsigned char*)lds_raw;
    volatile LAS unsigned* MISC = (volatile LAS unsigned*)(lds + MISC_OFF);
    const int G = gridDim.x; const int bx = blockIdx.x; const int vcu = (G % 8 == 0) ? (bx % 8) * (G / 8) + bx / 8 : bx;
    gu32* ctl = (gu32*)(args.ws + WS_CTL);
    const int wave_s = __builtin_amdgcn_readfirstlane((int)threadIdx.x >> 6);
    if (wave_s == 0) MISC[HW_LANE()] = 0u;
    __syncthreads();
    XcdBarrier bar = xcd_barrier_post((unsigned*)ctl + CW_BAR, MISC + 8, wave_s == 0 && HW_LANE() == 0);
#define GRID_BAR() xcd_barrier(bar, wave_s)
    LAS unsigned long long* AP = (LAS unsigned long long*)(lds + MISC_OFF + 256);
    if (wave_s == 0 && HW_LANE() < 27) AP[HW_LANE()] = ((const unsigned long long*)&args)[HW_LANE()];
    __syncthreads();
#define ARGP(T, i) ((T)(GAS void*)ldarg(AP, i))
#define x_in   ARGP(const float*, 0)
#define pos    ARGP(const int*, 1)
#define nmg    ARGP(const float*, 2)
#define nfg    ARGP(const float*, 3)
#define s_inw  ARGP(const float*, 4)
#define s_cw   ARGP(const float*, 5)
#define s_cb   ARGP(const float*, 6)
#define s_dtb  ARGP(const float*, 7)
#define s_alog ARGP(const float*, 8)
#define s_d    ARGP(const float*, 9)
#define s_ng   ARGP(const float*, 10)
#define s_ow   ARGP(const float*, 11)
#define a_inw  ARGP(const float*, 12)
#define a_qg   ARGP(const float*, 13)
#define a_kg   ARGP(const float*, 14)
#define a_lq1  ARGP(const float*, 15)
#define a_lk1  ARGP(const float*, 16)
#define a_lq2  ARGP(const float*, 17)
#define a_lk2  ARGP(const float*, 18)
#define a_sg   ARGP(const float*, 19)
#define a_ow   ARGP(const float*, 20)
#define f_uw   ARGP(const float*, 21)
#define f_cw   ARGP(const float*, 22)
#define f_cb   ARGP(const float*, 23)
#define f_dw   ARGP(const float*, 24)
#define xout   ARGP(float*, 25)
#define ws     ARGP(unsigned char*, 26)
#define cst    ((float*)(ws + WS_CONST))
#define SSQ    ((float*)(ws + WS_SSQ))
#define ROPE   ((float*)(ws + WS_ROPE))
#define DT     ((float*)(ws + WS_DT))
#define SSQP   ((float*)(ws + WS_SSQP))
#define Wb     ((bf16*)(ws + WS_W))
#define XB     ((bf16*)(ws + WS_XB + XB_PAD_FRONT))
#define BIG    ((bf16*)(ws + WS_BIG))
#define XLO    ((bf16*)(ws + WS_DBG))
#define CPT    ((float*)(ws + WS_CP))
#define ZPL    ((bf16*)(ws + WS_BIG))
#define XBCPL  ((bf16*)(ws + WS_BIG + (size_t)M * SSD_DI * 2))
#define CONV_MATRIX(kind_, idx_, worker_, nworkers_) do { \
        int tid_ = wave_s * 64 + HW_LANE(); asm volatile("" : "+v"(tid_)); const int lane_ = tid_ & 63, wave_ = wave_s; \
        LAS float* scr_ = (LAS float*)(lds + wave_ * 16384); const int j_ = (idx_); \
        constexpr int I_SI = (D / 64) * (SSD_IN / 32), I_SO = (SSD_DI / 64) * (D / 32), I_AI = (D / 64) * (AT_IN / 32), I_AO = (D / 64) * (D / 32), I_UP = (D / 64) * (2 * DFF / 32), I_DN = (DFF / 64) * (D / 32); \
        if ((kind_) == 0) { for (int it = (worker_); it < I_SI; it += 2 * (nworkers_)) transpose_item<(RES_F16 != 0)>(s_inw + (size_t)j_ * D * SSD_IN, D, SSD_IN, nmg + (2 * j_) * D, 1023, 1.0f, (bf16*)((char*)Wb + W_SSD_IN + j_ * W_SSD_IN_SZ), RowId(), scr_, it, (it + (nworkers_) < I_SI) ? it + (nworkers_) : -1, lane_); \
            v4u* p_ = (v4u*)((char*)Wb + W_SSD_IN + j_ * W_SSD_IN_SZ + (size_t)SSD_IN * D * 2); const int n16_ = (SSD_NP - SSD_IN) * D * 2 / 16; \
            unsigned z_ = 0u; asm volatile("" : "+v"(z_)); for (int i = (worker_) * 64 + lane_; i < n16_; i += (nworkers_) * 64) p_[i] = (v4u){z_, z_, z_, z_}; } \
        else if ((kind_) == 1) { for (int it = (worker_); it < I_SO; it += 2 * (nworkers_)) transpose_item<false>(s_ow + (size_t)j_ * SSD_DI * D, SSD_DI, D, s_ng + j_ * SSD_DI, 2047, 1.0f, (bf16*)((char*)Wb + W_SSD_OUT + j_ * W_SSD_OUT_SZ), RowId(), scr_, it, (it + (nworkers_) < I_SO) ? it + (nworkers_) : -1, lane_); } \
        else if ((kind_) == 2) { for (int it = (worker_); it < I_AI; it += 2 * (nworkers_)) transpose_item<(RES_F16 != 0)>(a_inw + (size_t)j_ * D * AT_IN, D, AT_IN, nmg + (2 * j_ + 1) * D, 1023, 1.0f, (bf16*)((char*)Wb + W_AT_IN + j_ * W_AT_IN_SZ), RowId(), scr_, it, (it + (nworkers_) < I_AI) ? it + (nworkers_) : -1, lane_); } \
        else if ((kind_) == 3) { const float li_ = 0.8f - 0.6f * expf(-0.3f * (float)(2 * j_ + 1)); \
            for (int it = (worker_); it < I_AO; it += 2 * (nworkers_)) transpose_item<false>(a_ow + (size_t)j_ * D * D, D, D, a_sg + j_ * 128, 127, 1.0f - li_, (bf16*)((char*)Wb + W_AT_OUT + j_ * W_AT_OUT_SZ), RowId(), scr_, it, (it + (nworkers_) < I_AO) ? it + (nworkers_) : -1, lane_); } \
        else if ((kind_) == 4) { for (int it = (worker_); it < I_UP; it += 2 * (nworkers_)) transpose_item<(RES_F16 != 0)>(f_uw + (size_t)j_ * D * 2 * DFF, D, 2 * DFF, nfg + j_ * D, 1023, 1.0f, (bf16*)((char*)Wb + W_UP + j_ * W_UP_SZ), RowUp(), scr_, it, (it + (nworkers_) < I_UP) ? it + (nworkers_) : -1, lane_); } \
        else { for (int it = (worker_); it < I_DN; it += 2 * (nworkers_)) transpose_item<false>(f_dw + (size_t)j_ * DFF * D, DFF, D, nullptr, 0, 1.0f, (bf16*)((char*)Wb + W_DOWN + j_ * W_DOWN_SZ), RowId(), scr_, it, (it + (nworkers_) < I_DN) ? it + (nworkers_) : -1, lane_); } \
    } while (0)
#define RUN_FILL(fid_, nwg_, part_) do { const int idle0_ = (nwg_) % G; if (bx >= idle0_ && idle0_ > 0) { \
        const int wk_ = (bx - idle0_) * NWAVES + wave_s, nwk_ = (G - idle0_) * NWAVES; \
          \
        unsigned long long code_ = (part_) == 0 ? ((fid_) == 0 ? 0xff1040ull : (fid_) == 1 ? 0xff51ull : (fid_) == 2 ? 0xff11ull : (fid_) == 3 ? 0xff42ull : 0xff53ull) \
                                                : ((fid_) == 0 ? 0xff302050ull : (fid_) == 1 ? 0xff41ull : (fid_) == 2 ? 0xff01ull : (fid_) == 3 ? 0xff312152ull : 0xff43ull); \
        for (;;) { const int e_ = (int)(code_ & 0xffu); if (e_ == 0xff) break; code_ >>= 8; CONV_MATRIX(e_ >> 4, e_ & 15, wk_, nwk_); } } } while (0)
    const int lo = args.ph_lo, hi = args.ph_hi;
    int phase = 0;
#define IN_PHASE() (phase >= lo && phase < hi)
#define END_PHASE(ty) do { if (IN_PHASE() && phase + 1 < hi) GRID_BAR(); ++phase; } while (0)
#ifndef PROBE_EPI_MODE
#define PROBE_EPI_MODE 0
#endif
#ifdef PROBE_DUP
#define REP_BEGIN(ty) _Pragma("unroll") for (int rep_ = ((ty) == PROBE_DUP ? 0 : 1); rep_ < 2; ++rep_) { const int dry = (rep_ == 0);
#define REP_END() if (dry) GRID_BAR(); }
#else
#define REP_BEGIN(ty) { const int dry = 0;
#define REP_END() }
#endif

    if (IN_PHASE()) { REP_BEGIN(0)
        int tid = wave_s * 64 + HW_LANE(); asm volatile("" : "+v"(tid));
        const int lane = tid & 63, wave = wave_s;
        LAS float* scr = (LAS float*)(lds + wave * 16384);
        const int gw = vcu * NWAVES + wave, NGW = G * NWAVES;
        CONV_MATRIX(0, 0, gw, NGW);
        { unsigned z_ = 0u; asm volatile("" : "+v"(z_));
          v4u* p = (v4u*)(ws + WS_XB); for (int i = vcu * 512 + tid; i < (int)(XB_PAD_FRONT / 16); i += G * 512) p[i] = (v4u){z_, z_, z_, z_};
          v4u* q = (v4u*)((char*)XB + (size_t)M * D * 2); for (int i = vcu * 512 + tid; i < 256 * D * 2 / 16; i += G * 512) q[i] = (v4u){z_, z_, z_, z_}; }
        for (int m = gw; m < M; m += NGW) {
            const f32x4* xr = (const f32x4*)(x_in + (size_t)m * D) + lane; float s = 0.f;
            unsigned long long* o8 = (unsigned long long*)(XB + (size_t)m * D) + lane;
#pragma unroll
            for (int j = 0; j < 4; ++j) { const f32x4 v = xr[64 * j]; s += (v[0] * v[0] + v[1] * v[1]) + (v[2] * v[2] + v[3] * v[3]); o8[64 * j] = (unsigned long long)pk2x<(RES_F16 != 0)>(v[0], v[1]) | ((unsigned long long)pk2x<(RES_F16 != 0)>(v[2], v[3]) << 32); }
            s = wave_sum(s);
            if (lane < 4) SSQ[(size_t)m * 4 + lane] = (lane == 0) ? s : 0.f;
            if (lane >= 16 && lane < 32) { const int i = lane & 7; const float invf = powf(500000.0f, -(float)(2 * i) / 16.0f); const float ang = (float)pos[m] * invf; ROPE[(size_t)m * 16 + (lane - 16)] = (lane < 24) ? cosf(ang) : sinf(ang); }
        }
        for (int i = vcu * 512 + tid; i < 2 * SSD_NP; i += G * 512) {
            const int j = i / SSD_NP, c = i % SSD_NP; float pb = 0.f, p0 = 0.f, p1 = 0.f, p2 = 0.f, p3 = 0.f;
            if (c < 2048) p3 = 1.f;
            else if (c < 5120) { const int ch = c - 2048; const float* w = s_cw + (size_t)j * 4 * 3072; pb = s_cb[(size_t)j * 3072 + ch]; p0 = w[ch]; p1 = w[3072 + ch]; p2 = w[2 * 3072 + ch]; p3 = w[3 * 3072 + ch]; }
            else if (c < 5152) { pb = s_dtb[j * 32 + (c - 5120)]; p3 = 1.f; }
            float* t = CPT + (size_t)j * 5 * SSD_NP; t[c] = pb; t[SSD_NP + c] = p0; t[2 * SSD_NP + c] = p1; t[3 * SSD_NP + c] = p2; t[4 * SSD_NP + c] = p3;
        }
        if (bx == 0 && wave == 0) {
            for (int j = 0; j < 2; ++j) {
                float mq = fabsf(a_qg[j * 64 + lane]), mkk = fabsf(a_kg[j * 64 + lane]);
                float d1 = a_lq1[j * 64 + lane] * a_lk1[j * 64 + lane], d2 = a_lq2[j * 64 + lane] * a_lk2[j * 64 + lane];
                mq = xl_max64(mq); mkk = xl_max64(mkk); d1 = xl_sum64(d1); d2 = xl_sum64(d2);
                const float li = 0.8f - 0.6f * expf(-0.3f * (float)(2 * j + 1));
                if (lane == 0) { cst[j] = mq * mkk * 64.0f * 0.125f * 1.4426950408889634f * 1.002f + 0.01f; cst[2 + j] = expf(d1) - expf(d2) + li; }
            }
        }
    REP_END() }
    END_PHASE(0);

    for (int layer = 0; layer < 4; ++layer) {
        const int j = layer >> 1;
        if ((layer & 1) == 0) {
            if (IN_PHASE()) { REP_BEGIN(1)
#ifdef PROBE_PLAIN_SSDIN
                if (dry) {
                    pg8::Gemm g0{XB, (const bf16*)((const char*)Wb + W_SSD_IN + j * W_SSD_IN_SZ), D, D, 256, 0};
                    pg8::StaticOrder S0; S0.init(64, 20, G, bx);
                    epi::EpiSsdIn E0{BIG, DT, s_dtb + j * 32, SSQ};
                    pg8::gemm_phase(lds, lds + EPI_OFF, g0, S0, E0, wave_s);
                } else
#endif
                {
                pg8::Gemm g{XB, (const bf16*)((const char*)Wb + W_SSD_IN + j * W_SSD_IN_SZ), D, D, 253, -3};
                pg8::StaticOrder S; S.init(65, SSD_NP / 256, G, bx);
                epi::EpiSsdConv E{ZPL, XBCPL, DT, SSQ, CPT + (size_t)j * 5 * SSD_NP, dry * PROBE_EPI_MODE};
#ifdef PROBE_NOFILL
                if (!dry || (PROBE_NOFILL & 1) == 0)
#endif
                { RUN_FILL(layer == 0 ? 0 : 3, 65 * (SSD_NP / 256), 0); } __syncthreads();
#ifdef PROBE_FILLONLY
                if (!dry)
#endif
                pg8::gemm_phase(lds, lds + EPI_OFF, g, S, E, wave_s);
#ifdef PROBE_NOFILL
                if (!dry || (PROBE_NOFILL & 2) == 0)
#endif
                { RUN_FILL(layer == 0 ? 0 : 3, 65 * (SSD_NP / 256), 1); }
                }
            REP_END() }
            END_PHASE(1);
            if (IN_PHASE()) { REP_BEGIN(2)
                scan::Params sp{XBCPL, ZPL, DT, s_alog + j * 32, s_d + j * 32, SSQP, dry};
                for (int u = vcu; u < NB * 32; u += G) scan::unit(sp, u >> 5, u & 31, (LAS char*)lds, wave_s);
            REP_END() }
            END_PHASE(2);
            if (IN_PHASE()) { REP_BEGIN(4)
                pg8::Gemm g{ZPL, (const bf16*)((const char*)Wb + W_SSD_OUT + j * W_SSD_OUT_SZ), SSD_DI, SSD_DI, 256, 0};
                pg8::StaticOrder S; S.init(M / 256, D / 256, G, bx);
                if (layer == 0) { epi::EpiResidualG<1> E{x_in, XB, XLO, SSQ, SSQP, dry}; pg8::gemm_phase(lds, lds + EPI_OFF, g, S, E, wave_s); }
                else { epi::EpiResidualG<0> E{nullptr, XB, XLO, SSQ, SSQP, dry}; pg8::gemm_phase(lds, lds + EPI_OFF, g, S, E, wave_s); }
            REP_END() }
            END_PHASE(4);
        } else {
            if (IN_PHASE()) { REP_BEGIN(5)
                pg8::Gemm g{XB, (const bf16*)((const char*)Wb + W_AT_IN + j * W_AT_IN_SZ), D, D, 256, 0};
                pg8::StaticOrder S; S.init(M / 256, AT_IN / 256, G, bx);
                epi::EpiQKV E{BIG, SSQ, a_qg + j * 64, a_kg + j * 64, ROPE};
                pg8::gemm_phase(lds, lds + EPI_OFF, g, S, E, wave_s);
            REP_END() }
            END_PHASE(5);
            if (IN_PHASE()) { REP_BEGIN(6)
                attn::Params ap{BIG, cst[j], cst[2 + j], dry};
                for (int pi = vcu; pi < 512; pi += G) {
                    const int bh = pi >> 3, s = pi & 7;
#ifdef PROBE_ATT_MODE
                    if (dry) { attn::unit<PROBE_ATT_MODE>(ap, bh >> 3, bh & 7, s, (LAS char*)lds, wave_s); attn::unit<PROBE_ATT_MODE>(ap, bh >> 3, bh & 7, 15 - s, (LAS char*)lds, wave_s); } else
#endif
                    { attn::unit(ap, bh >> 3, bh & 7, s, (LAS char*)lds, wave_s);
                      attn::unit(ap, bh >> 3, bh & 7, 15 - s, (LAS char*)lds, wave_s); }
                }
            REP_END() }
            END_PHASE(6);
            if (IN_PHASE()) { REP_BEGIN(7)
                pg8::Gemm g{BIG, (const bf16*)((const char*)Wb + W_AT_OUT + j * W_AT_OUT_SZ), AT_IN, D, 256, 0};
                pg8::StaticOrder S; S.init(M / 256, D / 256, G, bx);
                epi::EpiResidual<0> E{nullptr, nullptr, XB, XLO, SSQ, dry};
                pg8::gemm_phase(lds, lds + EPI_OFF, g, S, E, wave_s);
            REP_END() }
            END_PHASE(7);
        }
        if (IN_PHASE()) { REP_BEGIN(8)
            pg8::Gemm g{XB, (const bf16*)((const char*)Wb + W_UP + layer * W_UP_SZ), D, D, 254, -2};
            pg8::StaticOrder S; S.init(65, 2 * DFF / 256, G, bx);
            epi::EpiConvGate E{BIG, SSQ, f_cw + (size_t)layer * 3 * 2 * DFF, f_cb + (size_t)layer * 2 * DFF, dry * PROBE_EPI_MODE};
            if (layer < 3) { RUN_FILL(layer == 0 ? 1 : (layer == 1 ? 2 : 4), 65 * (2 * DFF / 256), 0); __syncthreads(); }
            pg8::gemm_phase(lds, lds + EPI_OFF, g, S, E, wave_s);
            if (layer < 3) RUN_FILL(layer == 0 ? 1 : (layer == 1 ? 2 : 4), 65 * (2 * DFF / 256), 1);
        REP_END() }
        END_PHASE(8);
        if (IN_PHASE()) { REP_BEGIN(9)
            pg8::Gemm g{BIG, (const bf16*)((const char*)Wb + W_DOWN + layer * W_DOWN_SZ), DFF, DFF, 256, 0};
            pg8::StaticOrder S; S.init(M / 256, D / 256, G, bx);
            if (layer == 3) { epi::EpiResidual<2> E{nullptr, xout, XB, XLO, SSQ, dry}; pg8::gemm_phase(lds, lds + EPI_OFF, g, S, E, wave_s); }
            else { epi::EpiResidual<0> E{nullptr, nullptr, XB, XLO, SSQ, dry}; pg8::gemm_phase(lds, lds + EPI_OFF, g, S, E, wave_s); }
        REP_END() }
        END_PHASE(9);
    }
#ifdef PROBE_EXTRA_BARS
    for (int i_ = 0; i_ < PROBE_EXTRA_BARS; ++i_) GRID_BAR();
#endif
}
#undef CONV_MATRIX
#undef RUN_FILL
#undef x_in
#undef pos
#undef nmg
#undef nfg
#undef s_inw
#undef s_cw
#undef s_cb
#undef s_dtb
#undef s_alog
#undef s_d
#undef s_ng
#undef s_ow
#undef a_inw
#undef a_qg
#undef a_kg
#undef a_lq1
#undef a_lk1
#undef a_lq2
#undef a_lk2
#undef a_sg
#undef a_ow
#undef f_uw
#undef f_cw
#undef f_cb
#undef f_dw
#undef xout
#undef ws
#undef cst
#undef SSQ
#undef ROPE
#undef DT
#undef SSQP
#undef Wb
#undef XB
#undef BIG
#undef XLO
#undef CPT
#undef ZPL
#undef XBCPL
#undef ARGP
constexpr int N_PHASES = 1 + 2 * 5 + 2 * 5;

static int g_grid = 0;
static void launch(void* const* d_in, float* d_out, void* d_ws, int ph_lo, int ph_hi, hipStream_t stream) {
    if (g_grid == 0) {
        int dev = 0, cus = 0;
        if (hipGetDevice(&dev) != hipSuccess || hipDeviceGetAttribute(&cus, hipDeviceAttributeMultiprocessorCount, dev) != hipSuccess) { fprintf(stderr, "device query failed\n"); g_grid = -1; return; }
        if (hipFuncSetAttribute((const void*)mega_fwd, hipFuncAttributeMaxDynamicSharedMemorySize, LDS_BYTES) != hipSuccess) { fprintf(stderr, "hipFuncSetAttribute failed\n"); g_grid = -1; return; }
        int per_cu = 0;
        (void)hipOccupancyMaxActiveBlocksPerMultiprocessor(&per_cu, (const void*)mega_fwd, NWAVES * 64, LDS_BYTES);
        (void)hipGetLastError();
        g_grid = cus;
        fprintf(stderr, "mega_fwd: %d CUs, occupancy query %d per CU\n", cus, per_cu);
    }
    if (g_grid < 0) return;
    (void)hipMemsetAsync((char*)d_ws + WS_CTL, 0, CTL_ZERO_BYTES, stream);
    Args a{};
    for (int i = 0; i < 25; ++i) a.in[i] = d_in[i];
    a.out = d_out; a.ws = (unsigned char*)d_ws; a.ph_lo = ph_lo; a.ph_hi = ph_hi;
    void* params[] = {&a};
    hipError_t e = hipLaunchCooperativeKernel((const void*)mega_fwd, dim3(g_grid), dim3(NWAVES * 64), params, LDS_BYTES, stream);
    if (e != hipSuccess) fprintf(stderr, "cooperative launch failed: %s (grid %d)\n", hipGetErrorString(e), g_grid);
}
}
extern "C" void kernel_launch(void* const* d_in, const int* in_sizes, int n_in, void* d_out, int out_size, void* d_ws, size_t ws_size, hipStream_t stream) {
    (void)in_sizes; (void)n_in; (void)out_size; (void)ws_size;
    mk::launch(d_in, (float*)d_out, d_ws, 0, mk::N_PHASES, stream);
}
```

```cpp
#include <hip/hip_runtime.h>
#include <stdint.h>
#include <math.h>
#include <cstdio>
__device__ __forceinline__ int hw_lane_() { unsigned m = ~0u; asm volatile("" : "+s"(m)); return (int)__builtin_amdgcn_mbcnt_hi(m, __builtin_amdgcn_mbcnt_lo(m, 0u)); }
#define HW_LANE() hw_lane_()
template <int CTRL> __device__ __forceinline__ float xl_dpp(float v) { return __builtin_bit_cast(float, __builtin_amdgcn_mov_dpp(__builtin_bit_cast(int, v), CTRL, 0xF, 0xF, true)); }
__device__ __forceinline__ float xl_swap16_sum(float v) { const auto r = __builtin_amdgcn_permlane16_swap(__builtin_bit_cast(unsigned, v), __builtin_bit_cast(unsigned, v), false, false); const unsigned r0 = r[0], r1 = r[1]; return __builtin_bit_cast(float, r0) + __builtin_bit_cast(float, r1); }
__device__ __forceinline__ float xl_swap32_sum(float v) { const auto r = __builtin_amdgcn_permlane32_swap(__builtin_bit_cast(unsigned, v), __builtin_bit_cast(unsigned, v), false, false); const unsigned r0 = r[0], r1 = r[1]; return __builtin_bit_cast(float, r0) + __builtin_bit_cast(float, r1); }
__device__ __forceinline__ float xl_swap16_max(float v) { const auto r = __builtin_amdgcn_permlane16_swap(__builtin_bit_cast(unsigned, v), __builtin_bit_cast(unsigned, v), false, false); const unsigned r0 = r[0], r1 = r[1]; return fmaxf(__builtin_bit_cast(float, r0), __builtin_bit_cast(float, r1)); }
__device__ __forceinline__ float xl_swap32_max(float v) { const auto r = __builtin_amdgcn_permlane32_swap(__builtin_bit_cast(unsigned, v), __builtin_bit_cast(unsigned, v), false, false); const unsigned r0 = r[0], r1 = r[1]; return fmaxf(__builtin_bit_cast(float, r0), __builtin_bit_cast(float, r1)); }
__device__ __forceinline__ float xl_xor16(float v, bool odd16) { const auto r = __builtin_amdgcn_permlane16_swap(__builtin_bit_cast(unsigned, v), __builtin_bit_cast(unsigned, v), false, false); const unsigned r0 = r[0], r1 = r[1]; return __builtin_bit_cast(float, odd16 ? r0 : r1); }
__device__ __forceinline__ float xl_sum4(float v) { v += xl_dpp<0xB1>(v); v += xl_dpp<0x4E>(v); return v; }
__device__ __forceinline__ float xl_sum8(float v) { v = xl_sum4(v); v += xl_dpp<0x141>(v); return v; }
__device__ __forceinline__ float xl_sum16(float v) { v = xl_sum8(v); v += xl_dpp<0x140>(v); return v; }
__device__ __forceinline__ float xl_sum64(float v) { v = xl_sum16(v); v = xl_swap16_sum(v); return xl_swap32_sum(v); }
__device__ __forceinline__ float xl_max64(float v) { v = fmaxf(v, xl_dpp<0xB1>(v)); v = fmaxf(v, xl_dpp<0x4E>(v)); v = fmaxf(v, xl_dpp<0x141>(v)); v = fmaxf(v, xl_dpp<0x140>(v)); v = xl_swap16_max(v); return xl_swap32_max(v); }
__device__ __forceinline__ float xl_scan64(float v) {
    v += xl_dpp<0x111>(v); v += xl_dpp<0x112>(v); v += xl_dpp<0x114>(v); v += xl_dpp<0x118>(v);
    v += __builtin_bit_cast(float, __builtin_amdgcn_update_dpp(0, __builtin_bit_cast(int, v), 0x142, 0xA, 0xF, false));
    v += __builtin_bit_cast(float, __builtin_amdgcn_update_dpp(0, __builtin_bit_cast(int, v), 0x143, 0xC, 0xF, false));
    return v;
}
#ifndef RES_F16
#define RES_F16 1
#endif
#ifndef PG8_SP2
#define PG8_SP2 1
#endif
namespace pg8 {
#define PG8_LAS __attribute__((address_space(3)))
typedef unsigned short bf16_t;
typedef short bf16x8 __attribute__((ext_vector_type(8)));
typedef float f32x4 __attribute__((ext_vector_type(4)));
typedef unsigned u32x4 __attribute__((ext_vector_type(4)));
typedef unsigned u32x2 __attribute__((ext_vector_type(2)));
constexpr int BM = 256, BK = 64, HALF = 128, HTB = HALF * BK * 2  , STAGE_BYTES = 8 * HTB, NXCD = 8, WGM = 4;

__host__ __device__ __forceinline__ int lds_byte(int r, int c) { const int st = (r >> 4) * 2 + (c >> 5), rr = r & 15, cc = c & 31, ob = rr * 64 + cc * 2; return st * 1024 + (ob ^ (((ob >> 9) & 1) << 5)); }
__host__ __device__ __forceinline__ void stage_rc(int b, int& R, int& C) { const int st = b / 1024, sb = b % 1024, swz = sb ^ (((sb >> 9) & 1) << 5); R = (st >> 1) * 16 + swz / 64; C = (st & 1) * 32 + (swz % 64) / 2; }
__host__ __device__ __forceinline__ int perm32(int rho) { const int n = rho >> 4, i = rho & 15; return 8 * (i >> 2) + 4 * n + (i & 3); }

typedef _Float16 f16x8 __attribute__((ext_vector_type(8)));
template <bool F16> __device__ __forceinline__ f32x4 mma16(bf16x8 a, bf16x8 b, f32x4 c) {
    if constexpr (F16) return __builtin_amdgcn_mfma_f32_16x16x32_f16(__builtin_bit_cast(f16x8, a), __builtin_bit_cast(f16x8, b), c, 0, 0, 0);
    else return __builtin_amdgcn_mfma_f32_16x16x32_bf16(a, b, c, 0, 0, 0);
}
struct Unit { int pm, pn; };
struct Gemm { const bf16_t* A; const bf16_t* Bt; int lda, K, a_stride, a_off; };

struct StaticOrder {
    int nM, nN, nwg, G, c;
    __host__ __device__ void init(int nM_, int nN_, int G_, int c_) { nM = nM_; nN = nN_; nwg = nM * nN; G = G_; c = c_; }
    __host__ __device__ bool next(int i, Unit& u) const {
        const long L = (long)i * G + c; if (L >= nwg) return false;
        int wgid = (int)L; { const int q = nwg / NXCD, r = nwg % NXCD, xcd = wgid % NXCD, off = wgid / NXCD; wgid = (xcd < r ? xcd * (q + 1) : r * (q + 1) + (xcd - r) * q) + off; }
        const int nig = WGM * nN, gid = wgid / nig, fm = gid * WGM, gsz = (nM - fm) < WGM ? (nM - fm) : WGM;
        u.pm = fm + ((wgid % nig) % gsz); u.pn = (wgid % nig) / gsz; return true;
    }
};

__device__ __forceinline__ unsigned cvt_pk_bf16(float lo, float hi) { unsigned r; asm volatile("v_cvt_pk_bf16_f32 %0, %1, %2" : "=v"(r) : "v"(lo), "v"(hi)); return r; }

template <class Epi, class Sched>
__device__ __forceinline__ void gemm_phase(PG8_LAS unsigned char* lds, PG8_LAS unsigned char* elds, const Gemm g, const Sched& S, const Epi& E, const int wave_s) {
    int tid = wave_s * 64 + HW_LANE(); asm volatile("" : "+v"(tid));
    const int wid = __builtin_amdgcn_readfirstlane(tid >> 6), lane = tid & 63, wr = wid >> 2, wc = wid & 3, fr = lane & 15, fq = lane >> 4;
    const int K = g.K, nt = K / BK, lda = g.lda;
    unsigned voffA[2], voffB[2]; int aoff, boff;
#define PG8_LANECONST() do { int t_ = wave_s * 64 + HW_LANE(); asm volatile("" : "+v"(t_)); const int fr_ = t_ & 15, fq_ = (t_ >> 4) & 3; \
        _Pragma("unroll") for (int i = 0; i < 2; ++i) { int R, C; stage_rc(t_ * 16 + i * 8192, R, C); const int Rb = Epi::PERM ? ((R & ~31) + perm32(R & 31)) : R; \
            const int Ra = Epi::ROWIL ? ((R & ~63) | ((R & 15) << 2) | ((R >> 4) & 3)) : R;     \
            voffA[i] = (unsigned)(Ra * lda + C) * 2u; voffB[i] = (unsigned)(Rb * K + C) * 2u; } \
        aoff = lds_byte(wr * 64 + fr_, fq_ * 8); boff = lds_byte(wc * 32 + fr_, fq_ * 8); } while (0)
    PG8_LANECONST();
    const size_t kstep = (size_t)(BK * 2);
    const size_t hstepA = (size_t)HALF * lda * 2, hstepB = (size_t)HALF * K * 2;
    const size_t tstepB = 2 * hstepB;
    const unsigned ldsw = (unsigned)wid * 1024u;
#define PG8_SA(b, h) (((b) * 2 + (h)) * HTB)
#define PG8_SB(b, h) ((4 + (b) * 2 + (h)) * HTB)
#define PG8_STAGE(bufoff, gbase, voff) do { _Pragma("unroll") for (int _i = 0; _i < 2; ++_i) \
        __builtin_amdgcn_global_load_lds((const unsigned*)((const char*)(gbase) + (voff)[_i]), (PG8_LAS unsigned*)(lds + (bufoff) + ldsw + _i * 8192), 16, 0, 0); } while (0)
#define PG8_LDA(dst, b, h) do { _Pragma("unroll") for (int m = 0; m < 4; ++m) _Pragma("unroll") for (int k = 0; k < 2; ++k) dst[m][k] = *(const PG8_LAS bf16x8*)(lds + PG8_SA(b, h) + aoff + m * 2048 + k * 1024); } while (0)
#define PG8_LDB(dst, b, h) do { _Pragma("unroll") for (int n = 0; n < 2; ++n) _Pragma("unroll") for (int k = 0; k < 2; ++k) dst[n][k] = *(const PG8_LAS bf16x8*)(lds + PG8_SB(b, h) + boff + n * 2048 + k * 1024); } while (0)
#define PG8_MMA(ai, bj, At, Bt) do { __builtin_amdgcn_s_setprio(1); _Pragma("unroll") for (int m = 0; m < 4; ++m) _Pragma("unroll") for (int n = 0; n < 2; ++n) _Pragma("unroll") for (int k = 0; k < 2; ++k) \
        acc[ai][bj][m][n] = mma16<Epi::AF16>(Bt[n][k], At[m][k], acc[ai][bj][m][n]); __builtin_amdgcn_s_setprio(0); } while (0)
#define PG8_WAIT_V(n) asm volatile("s_waitcnt vmcnt(" #n ")" ::: "memory")
#define PG8_WAIT_L(n) asm volatile("s_waitcnt lgkmcnt(" #n ")" ::: "memory")
#define PG8_BAR __builtin_amdgcn_s_barrier()
#define PG8_SCHED __builtin_amdgcn_sched_barrier(0)
    Unit cur, nxt; int ui = 0;
    if (!S.next(0, cur)) return;
    if constexpr (Epi::KGROUP) E.unit_begin(cur, elds, wave_s);
    if constexpr (Epi::PREFETCH) E.prefetch(cur, elds, wave_s);
    float zf = 0.f; if constexpr (!Epi::KGROUP) asm volatile("" : "+v"(zf));
    f32x4 acc[2][2][4][2];
    bf16x8 At[4][2], B0[2][2], B1[2][2];
    const char* cA = (const char*)g.A + ((long)cur.pm * g.a_stride + g.a_off) * (long)lda * 2; const char* cB = (const char*)g.Bt + (size_t)cur.pn * tstepB;
#if PG8_SP2
    PG8_STAGE(PG8_SB(0, 0), cB, voffB); PG8_STAGE(PG8_SB(0, 1), cB + hstepB, voffB); PG8_STAGE(PG8_SA(0, 0), cA, voffA); PG8_STAGE(PG8_SA(0, 1), cA + hstepA, voffA);
    __builtin_amdgcn_sched_barrier(0);
#pragma unroll
    for (int a = 0; a < 2; ++a)
#pragma unroll
        for (int b = 0; b < 2; ++b)
#pragma unroll
            for (int m = 0; m < 4; ++m)
#pragma unroll
                for (int n = 0; n < 2; ++n) acc[a][b][m][n] = (f32x4){zf, zf, zf, zf};
    if (wr == 1) PG8_BAR;
    PG8_WAIT_V(2); PG8_BAR;
    PG8_STAGE(PG8_SB(1, 0), cB + kstep, voffB); PG8_STAGE(PG8_SA(1, 0), cA + kstep, voffA); PG8_STAGE(PG8_SB(1, 1), cB + hstepB + kstep, voffB);
    PG8_WAIT_V(6); PG8_BAR;
#else
    PG8_STAGE(PG8_SB(0, 0), cB, voffB); PG8_STAGE(PG8_SA(0, 0), cA, voffA); PG8_STAGE(PG8_SB(0, 1), cB + hstepB, voffB); PG8_STAGE(PG8_SA(0, 1), cA + hstepA, voffA);
    if (wr == 1) PG8_BAR;
    PG8_WAIT_V(4); PG8_BAR;
    PG8_STAGE(PG8_SB(1, 0), cB + kstep, voffB); PG8_STAGE(PG8_SA(1, 0), cA + kstep, voffA); PG8_STAGE(PG8_SB(1, 1), cB + hstepB + kstep, voffB);
    PG8_WAIT_V(6); PG8_BAR;
#endif
    for (;;) {
        const bool has_next = S.next(ui + 1, nxt);
        const char* nA = has_next ? (const char*)g.A + ((long)nxt.pm * g.a_stride + g.a_off) * (long)lda * 2 : cA; const char* nB = has_next ? (const char*)g.Bt + (size_t)nxt.pn * tstepB : cB;
        for (int t = 0; t < nt; t += 2) {
            const bool last = (t == nt - 2);
            const char* a1 = cA + (size_t)(t + 1) * kstep;
            const char* a2 = last ? nA : cA + (size_t)(t + 2) * kstep; const char* b2 = last ? nB : cB + (size_t)(t + 2) * kstep;
            const char* a3 = a2 + kstep; const char* b3 = b2 + kstep;
            if constexpr (Epi::KGROUP) { if (t > 0 && (t & 7) == 0) E.kgroup(acc, t >> 3, wr, elds); }
#if PG8_SP2
            PG8_LDB(B0, 0, 0); PG8_LDB(B1, 0, 1); PG8_SCHED; PG8_LDA(At, 0, 0); PG8_STAGE(PG8_SA(1, 1), a1 + hstepA, voffA);
            PG8_WAIT_V(8); PG8_WAIT_L(0); PG8_BAR; PG8_MMA(0, 0, At, B0); PG8_MMA(0, 1, At, B1); PG8_BAR; PG8_SCHED;
            PG8_LDA(At, 0, 1); PG8_STAGE(PG8_SB(0, 0), b2, voffB); PG8_STAGE(PG8_SB(0, 1), b2 + hstepB, voffB); PG8_STAGE(PG8_SA(0, 0), a2, voffA);
            PG8_WAIT_V(8); PG8_WAIT_L(0); PG8_BAR; PG8_MMA(1, 0, At, B0); PG8_MMA(1, 1, At, B1); PG8_BAR; PG8_SCHED;
            PG8_LDB(B0, 1, 0); PG8_LDB(B1, 1, 1); PG8_SCHED; PG8_LDA(At, 1, 0); PG8_STAGE(PG8_SA(0, 1), a2 + hstepA, voffA);
            PG8_WAIT_V(8); PG8_WAIT_L(0); PG8_BAR; PG8_MMA(0, 0, At, B0); PG8_MMA(0, 1, At, B1); PG8_BAR; PG8_SCHED;
            PG8_LDA(At, 1, 1); PG8_STAGE(PG8_SB(1, 0), b3, voffB); PG8_STAGE(PG8_SB(1, 1), b3 + hstepB, voffB); PG8_STAGE(PG8_SA(1, 0), a3, voffA);
            PG8_WAIT_V(8); PG8_WAIT_L(0); PG8_BAR; PG8_MMA(1, 0, At, B0); PG8_MMA(1, 1, At, B1); PG8_BAR; PG8_SCHED;
#else
            PG8_LDB(B0, 0, 0); PG8_SCHED; PG8_LDA(At, 0, 0); PG8_STAGE(PG8_SA(1, 1), a1 + hstepA, voffA);
            PG8_WAIT_L(8); PG8_BAR; PG8_WAIT_L(0); PG8_MMA(0, 0, At, B0); PG8_BAR; PG8_SCHED;
            PG8_LDB(B1, 0, 1); PG8_STAGE(PG8_SB(0, 0), b2, voffB);
            PG8_BAR; PG8_WAIT_L(0); PG8_MMA(0, 1, At, B1); PG8_BAR;
            PG8_LDA(At, 0, 1); PG8_STAGE(PG8_SA(0, 0), a2, voffA);
            PG8_BAR; PG8_WAIT_L(0); PG8_MMA(1, 0, At, B0); PG8_BAR; PG8_SCHED;
            PG8_STAGE(PG8_SB(0, 1), b2 + hstepB, voffB);
            PG8_WAIT_V(6); PG8_BAR; PG8_MMA(1, 1, At, B1); PG8_BAR;
            PG8_LDB(B0, 1, 0); PG8_SCHED; PG8_LDA(At, 1, 0); PG8_STAGE(PG8_SA(0, 1), a2 + hstepA, voffA);
            PG8_WAIT_L(8); PG8_BAR; PG8_WAIT_L(0); PG8_MMA(0, 0, At, B0); PG8_BAR; PG8_SCHED;
            PG8_LDB(B1, 1, 1); PG8_STAGE(PG8_SB(1, 0), b3, voffB);
            PG8_BAR; PG8_WAIT_L(0); PG8_MMA(0, 1, At, B1); PG8_BAR;
            PG8_LDA(At, 1, 1); PG8_STAGE(PG8_SA(1, 0), a3, voffA);
            PG8_BAR; PG8_WAIT_L(0); PG8_MMA(1, 0, At, B0); PG8_BAR; PG8_SCHED;
            PG8_STAGE(PG8_SB(1, 1), b3 + hstepB, voffB);
            PG8_WAIT_V(6); PG8_BAR; PG8_MMA(1, 1, At, B1); PG8_BAR;
#endif
        }
        if (wr == 0) { if constexpr (Epi::PREFETCH) PG8_WAIT_V(8);
            PG8_BAR; }
        E(acc, cur, wr, wc, elds);
        if (!has_next) break;
        if constexpr (Epi::PREFETCH) E.prefetch(nxt, elds, wave_s);
#pragma unroll
        for (int a = 0; a < 2; ++a)
#pragma unroll
            for (int b = 0; b < 2; ++b)
#pragma unroll
                for (int m = 0; m < 4; ++m)
#pragma unroll
                    for (int n = 0; n < 2; ++n) acc[a][b][m][n] = (f32x4){zf, zf, zf, zf};
        cur = nxt; cA = nA; cB = nB; ++ui;
        if constexpr (Epi::KGROUP) E.unit_begin(cur, elds, wave_s);
        PG8_LANECONST();
        if (wr == 1) PG8_BAR;
    }
    PG8_WAIT_V(0);
    PG8_BAR;
#undef PG8_LANECONST
#undef PG8_SA
#undef PG8_SB
#undef PG8_STAGE
#undef PG8_LDA
#undef PG8_LDB
#undef PG8_MMA
}
}
namespace epi {
using pg8::f32x4; using pg8::u32x4; using pg8::u32x2; using pg8::bf16_t; using pg8::Unit; using pg8::cvt_pk_bf16;
constexpr int MROWS = 16384, DMODEL = 1024;
constexpr float EPS = 1e-6f;
#define EPI_LAS __attribute__((address_space(3)))

__device__ __forceinline__ float row_rstd(const float* ssq, int row) {
    const f32x4 a = *(const f32x4*)(ssq + (size_t)row * 4);
    const float s = (a[0] + a[1]) + (a[2] + a[3]);
    return __builtin_amdgcn_rsqf(s * (1.0f / DMODEL) + EPS);
}
template <int MSTEP> __device__ __forceinline__ void rstd8(const float* ssq, int row0, bool clamp, float (&rs)[2][4]) {
    f32x4 p[2][4];
#pragma unroll
    for (int ai = 0; ai < 2; ++ai)
#pragma unroll
        for (int m = 0; m < 4; ++m) { int row = row0 + ai * 128 + m * MSTEP; if (clamp) row = row < 0 ? 0 : (row >= MROWS ? MROWS - 1 : row); p[ai][m] = *(const f32x4*)(ssq + (size_t)row * 4); }
#pragma unroll
    for (int ai = 0; ai < 2; ++ai)
#pragma unroll
        for (int m = 0; m < 4; ++m) { const f32x4 a = p[ai][m]; rs[ai][m] = __builtin_amdgcn_rsqf(((a[0] + a[1]) + (a[2] + a[3])) * (1.0f / DMODEL) + EPS); }
}
template <int CTRL> __device__ __forceinline__ float dppf(float old, float src) {
    return __builtin_bit_cast(float, __builtin_amdgcn_update_dpp(__builtin_bit_cast(int, old), __builtin_bit_cast(int, src), CTRL, 0xF, 0xF, false));
}
template <int CTRL> __device__ __forceinline__ float dppa(float src) {
    return __builtin_bit_cast(float, __builtin_amdgcn_mov_dpp(__builtin_bit_cast(int, src), CTRL, 0xF, 0xF, true));
}
__device__ __forceinline__ f32x4 silu4(f32x4 v) {
    const f32x4 t = v * (-1.4426950408889634f); f32x4 e;
#pragma unroll
    for (int i = 0; i < 4; ++i) e[i] = __builtin_amdgcn_exp2f(t[i]);
    e = e + 1.0f;
#pragma unroll
    for (int i = 0; i < 4; ++i) e[i] = __builtin_amdgcn_rcpf(e[i]);
    return v * e;
}
template <int CTRL> __device__ __forceinline__ float dppz(float src) {
    return __builtin_bit_cast(float, __builtin_amdgcn_update_dpp(0, __builtin_bit_cast(int, src), CTRL, 0xF, 0xF, true));
}
__device__ __forceinline__ float softplus_fast(float v) {
    const float t = __builtin_amdgcn_exp2f(-1.4426950408889634f * fabsf(v));
    const float l = (t < 0.015625f) ? t * (1.0f - t * (0.5f - t * 0.33333334f)) : 0.6931471805599453f * __builtin_amdgcn_logf(1.0f + t);
    return fmaxf(v, 0.f) + l;
}
__device__ __forceinline__ float silu_fast(float v) { return v * __builtin_amdgcn_rcpf(1.0f + __builtin_amdgcn_exp2f(-1.4426950408889634f * v)); }

#ifndef RES_LO
#define RES_LO (RES_F16 ? 0 : 1)
#endif
typedef _Float16 h2_t __attribute__((ext_vector_type(2)));
__device__ __forceinline__ unsigned pk_f16(float lo, float hi) { const h2_t v = {(_Float16)lo, (_Float16)hi}; return __builtin_bit_cast(unsigned, v); }
__device__ __forceinline__ float f16_lo(unsigned w) { const h2_t v = __builtin_bit_cast(h2_t, w); const _Float16 a = v[0]; return (float)a; }
__device__ __forceinline__ float f16_hi(unsigned w) { const h2_t v = __builtin_bit_cast(h2_t, w); const _Float16 a = v[1]; return (float)a; }
template <int MODE  > struct EpiResidual {
    static constexpr bool PERM = true, ROWIL = false, KGROUP = false, PREFETCH = false, AF16 = false;
    const float* xin_f32; float* xout_f32; bf16_t* xh; bf16_t* xl; float* ssq; int dry;
    __device__ __forceinline__ void operator()(f32x4 (&acc)[2][2][4][2], const Unit& u, int wr, int wc, EPI_LAS unsigned char* elds) const {
        int fr, fq; { int t_ = HW_LANE(); asm volatile("" : "+v"(t_)); fr = t_ & 15; fq = (t_ >> 4) & 3; }
        EPI_LAS float* P = (EPI_LAS float*)elds;
        const int col0 = u.pn * 256 + wc * 32 + 8 * fq;
#pragma unroll
        for (int ai = 0; ai < 2; ++ai) {
            u32x4 xa[4][2], xb_[4][2];
#pragma unroll
            for (int m = 0; m < 4; ++m)
#pragma unroll
                for (int bj = 0; bj < 2; ++bj) {
                    const size_t o = (size_t)(u.pm * 256 + ai * 128 + wr * 64 + m * 16 + fr) * DMODEL + col0 + bj * 128;
                    if (MODE == 1) { xa[m][bj] = *(const u32x4*)(xin_f32 + o); xb_[m][bj] = *(const u32x4*)(xin_f32 + o + 4); }
                    else { xa[m][bj] = *(const u32x4*)(xh + o); xb_[m][bj] = RES_LO ? *(const u32x4*)(xl + o) : (u32x4){0u, 0u, 0u, 0u}; }
                }
#pragma unroll
            for (int m = 0; m < 4; ++m) {
                const int row = u.pm * 256 + ai * 128 + wr * 64 + m * 16 + fr;
                float s = 0.f;
#pragma unroll
                for (int bj = 0; bj < 2; ++bj) {
                    const size_t o = (size_t)row * DMODEL + col0 + bj * 128;
                    f32x4 v0, v1;
                    if (MODE == 1) { v0 = __builtin_bit_cast(f32x4, xa[m][bj]); v1 = __builtin_bit_cast(f32x4, xb_[m][bj]); }
                    else {
#pragma unroll
                        for (int i = 0; i < 2; ++i) {
                            if (RES_F16) { v0[2 * i] = f16_lo(xa[m][bj][i]); v0[2 * i + 1] = f16_hi(xa[m][bj][i]); v1[2 * i] = f16_lo(xa[m][bj][2 + i]); v1[2 * i + 1] = f16_hi(xa[m][bj][2 + i]); continue; }
                            v0[2 * i] = __builtin_bit_cast(float, xa[m][bj][i] << 16) + __builtin_bit_cast(float, xb_[m][bj][i] << 16);
                            v0[2 * i + 1] = __builtin_bit_cast(float, xa[m][bj][i] & 0xffff0000u) + __builtin_bit_cast(float, xb_[m][bj][i] & 0xffff0000u);
                            v1[2 * i] = __builtin_bit_cast(float, xa[m][bj][2 + i] << 16) + __builtin_bit_cast(float, xb_[m][bj][2 + i] << 16);
                            v1[2 * i + 1] = __builtin_bit_cast(float, xa[m][bj][2 + i] & 0xffff0000u) + __builtin_bit_cast(float, xb_[m][bj][2 + i] & 0xffff0000u);
                        }
                    }
                    v0 = v0 + acc[ai][bj][m][0]; v1 = v1 + acc[ai][bj][m][1];
                    s += ((v0[0] * v0[0] + v0[1] * v0[1]) + (v0[2] * v0[2] + v0[3] * v0[3])) + ((v1[0] * v1[0] + v1[1] * v1[1]) + (v1[2] * v1[2] + v1[3] * v1[3]));
                    if (MODE == 2) { if (!dry) { *(f32x4*)(xout_f32 + o) = v0; *(f32x4*)(xout_f32 + o + 4) = v1; } }
                    else {
                        u32x4 h; h.x = cvt_pk_bf16(v0[0], v0[1]); h.y = cvt_pk_bf16(v0[2], v0[3]); h.z = cvt_pk_bf16(v1[0], v1[1]); h.w = cvt_pk_bf16(v1[2], v1[3]);
                        if (RES_F16) { h.x = pk_f16(v0[0], v0[1]); h.y = pk_f16(v0[2], v0[3]); h.z = pk_f16(v1[0], v1[1]); h.w = pk_f16(v1[2], v1[3]); }
                        u32x4 l;
                        l.x = cvt_pk_bf16(v0[0] - __builtin_bit_cast(float, h.x << 16), v0[1] - __builtin_bit_cast(float, h.x & 0xffff0000u));
                        l.y = cvt_pk_bf16(v0[2] - __builtin_bit_cast(float, h.y << 16), v0[3] - __builtin_bit_cast(float, h.y & 0xffff0000u));
                        l.z = cvt_pk_bf16(v1[0] - __builtin_bit_cast(float, h.z << 16), v1[1] - __builtin_bit_cast(float, h.z & 0xffff0000u));
                        l.w = cvt_pk_bf16(v1[2] - __builtin_bit_cast(float, h.w << 16), v1[3] - __builtin_bit_cast(float, h.w & 0xffff0000u));
                        if (!dry) { *(u32x4*)(xh + o) = h; if (RES_LO) *(u32x4*)(xl + o) = l; }
                    }
                }
                s = xl_swap32_sum(xl_swap16_sum(s));
                if (fq == 0) P[(ai * 128 + wr * 64 + m * 16 + fr) * 4 + wc] = s;
            }
            asm volatile("" ::: "memory");
        }
        asm volatile("s_waitcnt lgkmcnt(0)" ::: "memory"); __builtin_amdgcn_s_barrier(); asm volatile("" ::: "memory");
        { const int t = (wr * 4 + wc) * 64 + fq * 16 + fr; if (t < 256) { const f32x4 p = *(const EPI_LAS f32x4*)(P + t * 4); ssq[(size_t)(u.pm * 256 + t) * 4 + u.pn] = (p[0] + p[1]) + (p[2] + p[3]); } }
        asm volatile("s_waitcnt lgkmcnt(0)" ::: "memory"); __builtin_amdgcn_s_barrier(); asm volatile("" ::: "memory");
    }
};

template <int MODE> struct EpiResidualG {
    static constexpr bool PERM = true, ROWIL = false, KGROUP = true, PREFETCH = false, AF16 = false;
    const float* xin_f32; bf16_t* xh; bf16_t* xl; float* ssq; const float* ssqp; int dry;
    __device__ __forceinline__ void unit_begin(const Unit& u, EPI_LAS unsigned char* elds, int wave_s) const {
        int t = wave_s * 64 + HW_LANE(); asm volatile("" : "+v"(t));
        if (t < 256) {
            const f32x4* p = (const f32x4*)(ssqp + (size_t)(u.pm * 256 + t) * 32);
            float r[4];
#pragma unroll
            for (int g = 0; g < 4; ++g) { const f32x4 a = p[2 * g], b = p[2 * g + 1]; r[g] = __builtin_amdgcn_rsqf((((a[0] + a[1]) + (a[2] + a[3])) + ((b[0] + b[1]) + (b[2] + b[3]))) * (1.0f / 512.0f) + EPS); }
            *(EPI_LAS f32x4*)(elds + 4096 + t * 16) = (f32x4){r[0] * __builtin_amdgcn_rcpf(r[1]), r[1] * __builtin_amdgcn_rcpf(r[2]), r[2] * __builtin_amdgcn_rcpf(r[3]), r[3]};
        }
    }
    __device__ __forceinline__ void kgroup(f32x4 (&acc)[2][2][4][2], int g, int wr, EPI_LAS unsigned char* elds) const {
        int fr; { int t_ = HW_LANE(); asm volatile("" : "+v"(t_)); fr = t_ & 15; }
        const EPI_LAS float* RG = (const EPI_LAS float*)(elds + 4096) + (g - 1);
#pragma unroll
        for (int ai = 0; ai < 2; ++ai)
#pragma unroll
            for (int m = 0; m < 4; ++m) {
                const float f = RG[(ai * 128 + wr * 64 + m * 16 + fr) * 4];
#pragma unroll
                for (int bj = 0; bj < 2; ++bj) { acc[ai][bj][m][0] *= f; acc[ai][bj][m][1] *= f; }
            }
    }
    __device__ __forceinline__ void operator()(f32x4 (&acc)[2][2][4][2], const Unit& u, int wr, int wc, EPI_LAS unsigned char* elds) const {
        kgroup(acc, 4, wr, elds);
        const EpiResidual<MODE> R{xin_f32, nullptr, xh, xl, ssq, dry};
        R(acc, u, wr, wc, elds);
    }
};

struct EpiSsdIn {
    static constexpr bool PERM = true, ROWIL = false, KGROUP = false, PREFETCH = false, AF16 = (RES_F16 != 0);
    bf16_t* proj; float* dt; const float* dtbias; const float* ssq;
    __device__ __forceinline__ void operator()(f32x4 (&acc)[2][2][4][2], const Unit& u, int wr, int wc, EPI_LAS unsigned char*) const {
        int fr, fq; { int t_ = HW_LANE(); asm volatile("" : "+v"(t_)); fr = t_ & 15; fq = (t_ >> 4) & 3; }
        float rsv[2][4]; rstd8<16>(ssq, u.pm * 256 + wr * 64 + fr, false, rsv);
#pragma unroll
        for (int ai = 0; ai < 2; ++ai)
#pragma unroll
            for (int m = 0; m < 4; ++m) {
                const int row = u.pm * 256 + ai * 128 + wr * 64 + m * 16 + fr;
                const float rs = rsv[ai][m];
                if (u.pn < 20) {
#pragma unroll
                    for (int bj = 0; bj < 2; ++bj) {
                        const f32x4 v0 = acc[ai][bj][m][0] * rs, v1 = acc[ai][bj][m][1] * rs;
                        u32x4 w; w.x = cvt_pk_bf16(v0[0], v0[1]); w.y = cvt_pk_bf16(v0[2], v0[3]); w.z = cvt_pk_bf16(v1[0], v1[1]); w.w = cvt_pk_bf16(v1[2], v1[3]);
                        *(u32x4*)(proj + (size_t)row * 5120 + u.pn * 256 + bj * 128 + wc * 32 + 8 * fq) = w;
                    }
                } else if (wc == 0) {
#pragma unroll
                    for (int n = 0; n < 2; ++n) {
                        const int c = 8 * fq + 4 * n;
                        const f32x4 b = *(const f32x4*)(dtbias + c);
                        f32x4 v = acc[ai][0][m][n] * rs + b, o;
#pragma unroll
                        for (int e = 0; e < 4; ++e) o[e] = softplus_fast(v[e]);
                        *(f32x4*)(dt + (size_t)row * 32 + c) = o;
                    }
                }
            }
    }
};

struct EpiQKV {
    static constexpr bool PERM = true, ROWIL = false, KGROUP = false, PREFETCH = true, AF16 = (RES_F16 != 0);
    bf16_t* proj; const float* ssq; const float* qg; const float* kg; const float* rope;
    __device__ __forceinline__ void prefetch(const Unit& u, EPI_LAS unsigned char* elds, int wave_s) const {
        int l_ = HW_LANE(); asm volatile("" : "+v"(l_));
        if (u.pn < 8) {
#pragma unroll
            for (int i = 0; i < 2; ++i) __builtin_amdgcn_global_load_lds((const unsigned*)(rope + (size_t)u.pm * 256 * 16 + (size_t)((wave_s * 2 + i) * 64 + l_) * 4), (EPI_LAS unsigned*)(elds + 8192 + (wave_s * 2 + i) * 1024), 16, 0, 0);
        }
        if (wave_s < 4) __builtin_amdgcn_global_load_lds((const unsigned*)(ssq + (size_t)(u.pm * 256 + wave_s * 64 + l_) * 4), (EPI_LAS unsigned*)(elds + 24576 + wave_s * 1024), 16, 0, 0);
        else if (wave_s == 4 && l_ < 32) __builtin_amdgcn_global_load_lds((const unsigned*)((l_ < 16 ? qg : kg) + (l_ & 15) * 4), (EPI_LAS unsigned*)(elds + 28672), 16, 0, 0);
    }
    __device__ __forceinline__ void operator()(f32x4 (&acc)[2][2][4][2], const Unit& u, int wr, int wc, EPI_LAS unsigned char* elds) const {
        int fr, fq; { int t_ = HW_LANE(); asm volatile("" : "+v"(t_)); fr = t_ & 15; fq = (t_ >> 4) & 3; }
        EPI_LAS float* P = (EPI_LAS float*)elds;
        EPI_LAS f32x4* RT = (EPI_LAS f32x4*)(elds + 8192);
        const bool isqk = u.pn < 8;
        float rsv[2][4];
        { const EPI_LAS f32x4* SS = (const EPI_LAS f32x4*)(elds + 24576) + wr * 64 + fr;
#pragma unroll
          for (int ai = 0; ai < 2; ++ai)
#pragma unroll
            for (int m = 0; m < 4; ++m) { const f32x4 a = SS[ai * 128 + m * 16]; rsv[ai][m] = __builtin_amdgcn_rsqf(((a[0] + a[1]) + (a[2] + a[3])) * (1.0f / DMODEL) + EPS); } }
#pragma unroll
        for (int ai = 0; ai < 2; ++ai)
#pragma unroll
            for (int m = 0; m < 4; ++m) {
                const int trow = ai * 128 + wr * 64 + m * 16 + fr;
                const float rs = rsv[ai][m];
#pragma unroll
                for (int bj = 0; bj < 2; ++bj) {
                    acc[ai][bj][m][0] *= rs; acc[ai][bj][m][1] *= rs;
                    if (isqk) {
                        const f32x4 a = acc[ai][bj][m][0], b = acc[ai][bj][m][1];
                        float s = ((a[0] * a[0] + a[1] * a[1]) + (a[2] * a[2] + a[3] * a[3])) + ((b[0] * b[0] + b[1] * b[1]) + (b[2] * b[2] + b[3] * b[3]));
                        s = xl_swap32_sum(xl_swap16_sum(s));
                        if (fq == 0) P[trow * 8 + bj * 4 + wc] = s;
                    }
                }
            }
        if (isqk) {
            asm volatile("s_waitcnt lgkmcnt(0)" ::: "memory"); __builtin_amdgcn_s_barrier(); asm volatile("" ::: "memory");
            const EPI_LAS float* g = (const EPI_LAS float*)(elds + 28672) + ((u.pn < 4) ? 0 : 64);
            const int d0 = 32 * (wc & 1) + 8 * fq;
            const f32x4 g0 = *(const EPI_LAS f32x4*)(g + d0), g1 = *(const EPI_LAS f32x4*)(g + d0 + 4);
            const float qs = (u.pn < 4) ? (1.4426950408889634f * 0.125f) : 1.0f;
            const bool dorope = (wc & 1) == 0;
#pragma unroll
            for (int ai = 0; ai < 2; ++ai)
#pragma unroll
                for (int m = 0; m < 4; ++m) {
                    const int trow = ai * 128 + wr * 64 + m * 16 + fr;
                    const int row = u.pm * 256 + trow;
                    f32x4 c0 = {1.f, 1.f, 1.f, 1.f}, c1 = c0, s0 = {0.f, 0.f, 0.f, 0.f}, s1 = s0;
                    if (dorope && fq < 2) {
                        c0 = RT[trow * 4 + 0]; c1 = RT[trow * 4 + 1]; s0 = RT[trow * 4 + 2]; s1 = RT[trow * 4 + 3];
                        if (fq == 0) { s0 = -s0; s1 = -s1; }
                    }
#pragma unroll
                    for (int bj = 0; bj < 2; ++bj) {
                        const float tot = P[trow * 8 + bj * 4 + wc] + P[trow * 8 + bj * 4 + (wc ^ 1)];
                        const float nr = qs * __builtin_amdgcn_rsqf(tot * (1.0f / 64.0f) + EPS);
                        f32x4 v0 = acc[ai][bj][m][0] * g0 * nr, v1 = acc[ai][bj][m][1] * g1 * nr;
                        if (dorope) {
                            f32x4 o0, o1;
#pragma unroll
                            for (int e = 0; e < 4; ++e) { o0[e] = xl_xor16(v0[e], (fq & 1) != 0); o1[e] = xl_xor16(v1[e], (fq & 1) != 0); }
                            v0 = v0 * c0 + o0 * s0; v1 = v1 * c1 + o1 * s1;
                        }
                        u32x4 w; w.x = cvt_pk_bf16(v0[0], v0[1]); w.y = cvt_pk_bf16(v0[2], v0[3]); w.z = cvt_pk_bf16(v1[0], v1[1]); w.w = cvt_pk_bf16(v1[2], v1[3]);
                        *(u32x4*)(proj + (size_t)row * 3072 + u.pn * 256 + bj * 128 + wc * 32 + 8 * fq) = w;
                    }
                    asm volatile("" ::: "memory");
                }
            asm volatile("s_waitcnt lgkmcnt(0)" ::: "memory"); __builtin_amdgcn_s_barrier(); asm volatile("" ::: "memory");
        } else {
#pragma unroll
            for (int ai = 0; ai < 2; ++ai)
#pragma unroll
                for (int m = 0; m < 4; ++m) {
                    const int row = u.pm * 256 + ai * 128 + wr * 64 + m * 16 + fr;
#pragma unroll
                    for (int bj = 0; bj < 2; ++bj) {
                        const f32x4 v0 = acc[ai][bj][m][0], v1 = acc[ai][bj][m][1];
                        u32x4 w; w.x = cvt_pk_bf16(v0[0], v0[1]); w.y = cvt_pk_bf16(v0[2], v0[3]); w.z = cvt_pk_bf16(v1[0], v1[1]); w.w = cvt_pk_bf16(v1[2], v1[3]);
                        *(u32x4*)(proj + (size_t)row * 3072 + u.pn * 256 + bj * 128 + wc * 32 + 8 * fq) = w;
                    }
                }
            asm volatile("s_waitcnt lgkmcnt(0)" ::: "memory"); __builtin_amdgcn_s_barrier(); asm volatile("" ::: "memory");
        }
    }
};

struct EpiSsdConv {
    static constexpr bool PERM = true, ROWIL = true, KGROUP = false, PREFETCH = true, AF16 = (RES_F16 != 0);
    bf16_t* zp; bf16_t* xbc; float* dt; const float* ssq; const float* cp; int dry;
    template <bool MASK>
    __device__ __forceinline__ void conv_body(f32x4 (&acc)[2][2][4][2], const Unit& u, int wr, int wc, int fr, int fq, const EPI_LAS f32x4* hb, int R0) const {
        bf16_t* const obase = (u.pn < 8) ? zp + u.pn * 256 : xbc + (u.pn - 8) * 256;
        const int old_ = (u.pn < 8) ? 2048 : 3072;
#pragma unroll
        for (int bj = 0; bj < 2; ++bj) {
            u32x2 keep[2][4];
#pragma unroll
            for (int n = 0; n < 2; ++n) {
                const int tc = bj * 128 + wc * 32 + 8 * fq + 4 * n;
                const EPI_LAS float* pt = (const EPI_LAS float*)((const EPI_LAS unsigned char*)hb + 12288) + tc;
                const f32x4 bb = *(const EPI_LAS f32x4*)pt, w0 = *(const EPI_LAS f32x4*)(pt + 256), w1 = *(const EPI_LAS f32x4*)(pt + 512), w2 = *(const EPI_LAS f32x4*)(pt + 768), w3 = *(const EPI_LAS f32x4*)(pt + 1024);
#pragma unroll
                for (int ai = 0; ai < 2; ++ai) {
                    f32x4 h1 = {0.f, 0.f, 0.f, 0.f}, h2 = h1, h3 = h1;
                    const int pwr = wr ^ 1, pai = (wr == 1) ? ai : ai - 1;
                    if (pai >= 0 && fr == 0) { const int idx = (((pwr * 2 + pai) * 4 + wc) * 3 * 4 + fq) * 4 + bj * 2 + n;
                        h1 = hb[idx]; h2 = hb[idx + 16]; h3 = hb[idx + 32]; }
                    const f32x4 v0 = acc[ai][bj][0][n], v1 = acc[ai][bj][1][n], v2 = acc[ai][bj][2][n], v3 = acc[ai][bj][3][n];
                    f32x4 p1, p2, p3;
#pragma unroll
                    for (int e = 0; e < 4; ++e) { p1[e] = dppf<0x111>(h1[e], v1[e]); p2[e] = dppf<0x111>(h2[e], v2[e]); p3[e] = dppf<0x111>(h3[e], v3[e]); }
#pragma unroll
                    for (int m = 0; m < 4; ++m) {
                        const int trow = ai * 128 + wr * 64 + 4 * fr + m, row = R0 + trow;
                        const f32x4 cv = (m == 0) ? v0 : (m == 1) ? v1 : (m == 2) ? v2 : v3;
                        f32x4 x1 = (m == 0) ? p3 : (m == 1) ? v0 : (m == 2) ? v1 : v2;
                        f32x4 x2 = (m == 0) ? p2 : (m == 1) ? p3 : (m == 2) ? v0 : v1;
                        f32x4 x3 = (m == 0) ? p1 : (m == 1) ? p2 : (m == 2) ? p3 : v0;
                        if (MASK) { const int ts = row & 2047; const f32x4 z4 = {0.f, 0.f, 0.f, 0.f}; if (ts < 1) x1 = z4; if (ts < 2) x2 = z4; if (ts < 3) x3 = z4; }
                        const bool valid = trow >= 3 && row < MROWS;
                        const f32x4 o = silu4(bb + w0 * x3 + w1 * x2 + w2 * x1 + w3 * cv);
                        if (n == 0) { keep[ai][m].x = cvt_pk_bf16(o[0], o[1]); keep[ai][m].y = cvt_pk_bf16(o[2], o[3]); }
                        else if (valid) {
                            u32x4 w; w.x = keep[ai][m].x; w.y = keep[ai][m].y; w.z = cvt_pk_bf16(o[0], o[1]); w.w = cvt_pk_bf16(o[2], o[3]);
                            *(u32x4*)(obase + (size_t)row * old_ + tc - 4) = w;
                        }
                    }
                    asm volatile("" ::: "memory");
                }
            }
        }
    }
    __device__ __forceinline__ void prefetch(const Unit& u, EPI_LAS unsigned char* elds, int wave_s) const {
        if (wave_s < 5) {
            int l_ = HW_LANE(); asm volatile("" : "+v"(l_)); const int t_id = wave_s * 64 + l_;
            __builtin_amdgcn_global_load_lds((const unsigned*)(cp + (size_t)wave_s * 5376 + u.pn * 256 + l_ * 4), (EPI_LAS unsigned*)(elds + 12288 + wave_s * 1024), 16, 0, 0);
            if (wave_s < 4) {
                int row = u.pm * 253 - 3 + t_id; row = row < 0 ? 0 : (row >= MROWS ? MROWS - 1 : row);
                __builtin_amdgcn_global_load_lds((const unsigned*)(ssq + (size_t)row * 4), (EPI_LAS unsigned*)(elds + 17408 + wave_s * 1024), 16, 0, 0);
            }
        }
    }
    __device__ __forceinline__ void operator()(f32x4 (&acc)[2][2][4][2], const Unit& u, int wr, int wc, EPI_LAS unsigned char* elds) const {
#ifdef PROBE_EPI_MODE
        if (dry == 3) { asm volatile("" :: "v"(acc[0][0][0][0][0]), "v"(acc[1][1][3][1][3])); return; }
#endif
        int fr, fq; { int t_ = HW_LANE(); asm volatile("" : "+v"(t_)); fr = t_ & 15; fq = (t_ >> 4) & 3; }
        const int R0 = u.pm * 253 - 3;
        EPI_LAS f32x4* hb = (EPI_LAS f32x4*)elds;
        { float rsv[2][4];
          const EPI_LAS f32x4* SS = (const EPI_LAS f32x4*)(elds + 17408) + wr * 64 + 4 * fr;
#pragma unroll
          for (int ai = 0; ai < 2; ++ai)
#pragma unroll
            for (int m = 0; m < 4; ++m) { const f32x4 a = SS[ai * 128 + m]; rsv[ai][m] = __builtin_amdgcn_rsqf(((a[0] + a[1]) + (a[2] + a[3])) * (1.0f / DMODEL) + EPS); }
#pragma unroll
          for (int ai = 0; ai < 2; ++ai)
#pragma unroll
            for (int m = 0; m < 4; ++m)
#pragma unroll
                for (int bj = 0; bj < 2; ++bj) { acc[ai][bj][m][0] *= rsv[ai][m]; acc[ai][bj][m][1] *= rsv[ai][m]; } }
        if (u.pn == 20) {
            if (wc == 0) {
#pragma unroll
                for (int ai = 0; ai < 2; ++ai)
#pragma unroll
                    for (int m = 0; m < 4; ++m) {
                        const int trow = ai * 128 + wr * 64 + 4 * fr + m, row = R0 + trow;
                        if (trow >= 3 && row < MROWS) {
#pragma unroll
                            for (int n = 0; n < 2; ++n) {
                                const int c = 8 * fq + 4 * n;
                                const f32x4 b = *(const EPI_LAS f32x4*)(elds + 12288 + c * 4);
                                f32x4 v = acc[ai][0][m][n] + b, o;
#pragma unroll
                                for (int e = 0; e < 4; ++e) o[e] = softplus_fast(v[e]);
                                *(f32x4*)(dt + (size_t)row * 32 + c) = o;
                            }
                        }
                    }
            }
            asm volatile("s_waitcnt lgkmcnt(0)" ::: "memory"); __builtin_amdgcn_s_barrier(); asm volatile("" ::: "memory");
            return;
        }
        if (u.pn < 8 && dry < 2) {
#pragma unroll
            for (int ai = 0; ai < 2; ++ai)
#pragma unroll
                for (int m = 0; m < 4; ++m) {
                    const int trow = ai * 128 + wr * 64 + 4 * fr + m, row = R0 + trow;
                    const bool valid = trow >= 3 && row < MROWS;
#pragma unroll
                    for (int bj = 0; bj < 2; ++bj) {
                        const f32x4 o0 = silu4(acc[ai][bj][m][0]), o1 = silu4(acc[ai][bj][m][1]);
                        u32x4 w; w.x = cvt_pk_bf16(o0[0], o0[1]); w.y = cvt_pk_bf16(o0[2], o0[3]); w.z = cvt_pk_bf16(o1[0], o1[1]); w.w = cvt_pk_bf16(o1[2], o1[3]);
                        if (valid) *(u32x4*)(zp + (size_t)row * 2048 + u.pn * 256 + bj * 128 + wc * 32 + 8 * fq) = w;
                    }
                }
            asm volatile("s_waitcnt lgkmcnt(0)" ::: "memory"); __builtin_amdgcn_s_barrier(); asm volatile("" ::: "memory");
            return;
        }
        if (fr == 15) {
#pragma unroll
            for (int ai = 0; ai < 2; ++ai)
#pragma unroll
                for (int m = 1; m < 4; ++m) {
                    const int idx = ((((wr * 2 + ai) * 4 + wc) * 3 + (m - 1)) * 4 + fq) * 4;
                    hb[idx + 0] = acc[ai][0][m][0]; hb[idx + 1] = acc[ai][0][m][1]; hb[idx + 2] = acc[ai][1][m][0]; hb[idx + 3] = acc[ai][1][m][1];
                }
        }
        asm volatile("s_waitcnt lgkmcnt(0)" ::: "memory"); __builtin_amdgcn_s_barrier(); asm volatile("" ::: "memory");
        const int tf = (u.pm * 253) & 2047;
        if (dry < 2) { if (tf <= 2 || tf + 252 >= 2048) conv_body<true>(acc, u, wr, wc, fr, fq, hb, R0); else conv_body<false>(acc, u, wr, wc, fr, fq, hb, R0); }
        asm volatile("s_waitcnt lgkmcnt(0)" ::: "memory"); __builtin_amdgcn_s_barrier(); asm volatile("" ::: "memory");
    }
};

struct EpiConvGate {
    static constexpr bool PERM = true, ROWIL = true, KGROUP = false, PREFETCH = true, AF16 = (RES_F16 != 0);
    bf16_t* H; const float* ssq; const float* cw; const float* cb; int dry;
    template <bool MASK>
    __device__ __forceinline__ void body(f32x4 (&acc)[2][2][4][2], const Unit& u, int wr, int wc, int fr, int fq, const EPI_LAS f32x4* hb, int R0) const {
        constexpr int DFF = 2816;
        u32x2 keep[2][4];
#pragma unroll
        for (int n = 0; n < 2; ++n) {
            const int ch = u.pn * 128 + wc * 32 + 8 * fq + 4 * n;
            const EPI_LAS float* pt = (const EPI_LAS float*)((const EPI_LAS unsigned char*)hb + 8192) + wc * 32 + 8 * fq + 4 * n;
            const f32x4 bg = *(const EPI_LAS f32x4*)pt, bu = *(const EPI_LAS f32x4*)(pt + 128);
            const f32x4 w0g = *(const EPI_LAS f32x4*)(pt + 256), w0u = *(const EPI_LAS f32x4*)(pt + 384), w1g = *(const EPI_LAS f32x4*)(pt + 512), w1u = *(const EPI_LAS f32x4*)(pt + 640), w2g = *(const EPI_LAS f32x4*)(pt + 768), w2u = *(const EPI_LAS f32x4*)(pt + 896);
#pragma unroll
            for (int ai = 0; ai < 2; ++ai) {
                f32x4 hg2 = {0.f, 0.f, 0.f, 0.f}, hg3 = hg2, hu2 = hg2, hu3 = hg2;
                const int pwr = wr ^ 1, pai = (wr == 1) ? ai : ai - 1;
                if (pai >= 0 && fr == 0) { const int idx = (((pwr * 2 + pai) * 4 + wc) * 2 * 4 + fq) * 4;
                    hg2 = hb[idx + n]; hu2 = hb[idx + 2 + n]; hg3 = hb[idx + 16 + n]; hu3 = hb[idx + 16 + 2 + n]; }
                const f32x4 g0 = acc[ai][0][0][n], g1_ = acc[ai][0][1][n], g2_ = acc[ai][0][2][n], g3_ = acc[ai][0][3][n];
                const f32x4 u0 = acc[ai][1][0][n], u1_ = acc[ai][1][1][n], u2_ = acc[ai][1][2][n], u3_ = acc[ai][1][3][n];
                f32x4 pg2, pg3, pu2, pu3;
#pragma unroll
                for (int e = 0; e < 4; ++e) { pg2[e] = dppf<0x111>(hg2[e], g2_[e]); pg3[e] = dppf<0x111>(hg3[e], g3_[e]); pu2[e] = dppf<0x111>(hu2[e], u2_[e]); pu3[e] = dppf<0x111>(hu3[e], u3_[e]); }
#pragma unroll
                for (int m = 0; m < 4; ++m) {
                    const int trow = ai * 128 + wr * 64 + 4 * fr + m, row = R0 + trow;
                    const f32x4 cg = (m == 0) ? g0 : (m == 1) ? g1_ : (m == 2) ? g2_ : g3_, cu = (m == 0) ? u0 : (m == 1) ? u1_ : (m == 2) ? u2_ : u3_;
                    f32x4 xg1 = (m == 0) ? pg3 : (m == 1) ? g0 : (m == 2) ? g1_ : g2_, xg2 = (m == 0) ? pg2 : (m == 1) ? pg3 : (m == 2) ? g0 : g1_;
                    f32x4 xu1 = (m == 0) ? pu3 : (m == 1) ? u0 : (m == 2) ? u1_ : u2_, xu2 = (m == 0) ? pu2 : (m == 1) ? pu3 : (m == 2) ? u0 : u1_;
                    if (MASK) { const int ts = row & 2047; const f32x4 z4 = {0.f, 0.f, 0.f, 0.f}; if (ts < 1) { xg1 = z4; xu1 = z4; } if (ts < 2) { xg2 = z4; xu2 = z4; } }
                    const f32x4 gv = bg + w0g * xg2 + w1g * xg1 + w2g * cg;
                    const f32x4 uv = bu + w0u * xu2 + w1u * xu1 + w2u * cu;
                    const f32x4 o = silu4(gv) * uv;
                    if (n == 0) { keep[ai][m].x = cvt_pk_bf16(o[0], o[1]); keep[ai][m].y = cvt_pk_bf16(o[2], o[3]); }
                    else if (trow >= 2 && row < MROWS) {
                        u32x4 w; w.x = keep[ai][m].x; w.y = keep[ai][m].y; w.z = cvt_pk_bf16(o[0], o[1]); w.w = cvt_pk_bf16(o[2], o[3]);
                        asm volatile("" :: "v"(w.x), "v"(w.y), "v"(w.z), "v"(w.w));
                        if (!dry) *(u32x4*)(H + (size_t)row * DFF + ch - 4) = w;
                    }
                }
                asm volatile("" ::: "memory");
            }
        }
    }
    __device__ __forceinline__ void prefetch(const Unit& u, EPI_LAS unsigned char* elds, int wave_s) const {
        if (wave_s < 4) {
            int l_ = HW_LANE(); asm volatile("" : "+v"(l_)); const int t_id = wave_s * 64 + l_;
            const int k = t_id >> 5, c = u.pn * 128 + (t_id & 31) * 4;
            __builtin_amdgcn_global_load_lds((const unsigned*)((k < 2 ? cb + k * 2816 : cw + (size_t)(k - 2) * 2816) + c), (EPI_LAS unsigned*)(elds + 8192 + wave_s * 1024), 16, 0, 0);
            int row = u.pm * 254 - 2 + t_id; row = row < 0 ? 0 : (row >= MROWS ? MROWS - 1 : row);
            __builtin_amdgcn_global_load_lds((const unsigned*)(ssq + (size_t)row * 4), (EPI_LAS unsigned*)(elds + 12288 + wave_s * 1024), 16, 0, 0);
        }
    }
    __device__ __forceinline__ void operator()(f32x4 (&acc)[2][2][4][2], const Unit& u, int wr, int wc, EPI_LAS unsigned char* elds) const {
#ifdef PROBE_EPI_MODE
        if (dry == 3) { asm volatile("" :: "v"(acc[0][0][0][0][0]), "v"(acc[1][1][3][1][3])); return; }
#endif
        int fr, fq; { int t_ = HW_LANE(); asm volatile("" : "+v"(t_)); fr = t_ & 15; fq = (t_ >> 4) & 3; }
        const int R0 = u.pm * 254 - 2;
        EPI_LAS f32x4* hb = (EPI_LAS f32x4*)elds;
        const int t_id = (wr * 4 + wc) * 64 + fq * 16 + fr;
        (void)t_id;
        { float rsv[2][4];
          const EPI_LAS f32x4* SS = (const EPI_LAS f32x4*)(elds + 12288) + wr * 64 + 4 * fr;
#pragma unroll
          for (int ai = 0; ai < 2; ++ai)
#pragma unroll
            for (int m = 0; m < 4; ++m) { const f32x4 a = SS[ai * 128 + m]; rsv[ai][m] = __builtin_amdgcn_rsqf(((a[0] + a[1]) + (a[2] + a[3])) * (1.0f / DMODEL) + EPS); }
#pragma unroll
          for (int ai = 0; ai < 2; ++ai)
#pragma unroll
            for (int m = 0; m < 4; ++m)
#pragma unroll
                for (int bj = 0; bj < 2; ++bj) { acc[ai][bj][m][0] *= rsv[ai][m]; acc[ai][bj][m][1] *= rsv[ai][m]; } }
        if (fr == 15) {
#pragma unroll
            for (int ai = 0; ai < 2; ++ai)
#pragma unroll
                for (int m = 2; m < 4; ++m) {
                    const int idx = ((((wr * 2 + ai) * 4 + wc) * 2 + (m - 2)) * 4 + fq) * 4;
                    hb[idx + 0] = acc[ai][0][m][0]; hb[idx + 1] = acc[ai][0][m][1]; hb[idx + 2] = acc[ai][1][m][0]; hb[idx + 3] = acc[ai][1][m][1];
                }
        }
        asm volatile("s_waitcnt lgkmcnt(0)" ::: "memory"); __builtin_amdgcn_s_barrier(); asm volatile("" ::: "memory");
        const int tf = (u.pm * 254) & 2047;
        if (dry < 2 || dry > 4) { if (tf <= 1 || tf + 253 >= 2048) body<true>(acc, u, wr, wc, fr, fq, hb, R0); else body<false>(acc, u, wr, wc, fr, fq, hb, R0); }
        asm volatile("s_waitcnt lgkmcnt(0)" ::: "memory"); __builtin_amdgcn_s_barrier(); asm volatile("" ::: "memory");
    }
};
}
namespace attn {
using pg8::bf16_t; using pg8::bf16x8; using pg8::f32x4; using pg8::u32x4;
typedef float f32x16 __attribute__((ext_vector_type(16)));
typedef short s16x4 __attribute__((ext_vector_type(4)));
#define AT_LAS __attribute__((address_space(3)))
constexpr int LD = 3072, SEQ = 2048;
constexpr int KT_BYTES = 16384, VT_BYTES = 16384, STG = KT_BYTES + VT_BYTES;
constexpr int L_X = 0;
constexpr int L_WSF = 2 * STG;
constexpr int L_OST = L_WSF + 8 * 256;
constexpr int LDS_BYTES = L_OST + 4 * 8192;
__device__ __forceinline__ int crow(int r, int hi) { return (r & 3) + 8 * (r >> 2) + 4 * hi; }
__device__ __forceinline__ unsigned cvtpk(float lo, float hi) { typedef float f2 __attribute__((ext_vector_type(2))); typedef __bf16 b2 __attribute__((ext_vector_type(2))); f2 v = {lo, hi}; b2 b = __builtin_convertvector(v, b2); return __builtin_bit_cast(unsigned, b); }
__device__ __forceinline__ float fadd_s(float a, float b) { float r; asm volatile("v_add_f32_e32 %0, %1, %2" : "=v"(r) : "v"(a), "v"(b)); return r; }
__device__ __forceinline__ s16x4 vtr(const AT_LAS char* p) { typedef short v4 __attribute__((ext_vector_type(4))); return __builtin_bit_cast(s16x4, __builtin_amdgcn_ds_read_tr16_b64_v4i16((AT_LAS v4*)p)); }

struct Params { bf16_t* qkv; float mb; float lam; int dry; };

template <int MODE = 0>
__device__ __forceinline__ void unit(const Params& P, int b, int h, int blk, AT_LAS char* lds, const int wave_s) {
    int tid = wave_s * 64 + HW_LANE(); asm volatile("" : "+v"(tid));
    const int lane = tid & 63, r32 = lane & 31, hi = lane >> 5;
    const int wid = __builtin_amdgcn_readfirstlane(tid >> 6), comp = wid >> 2, w4 = wid & 3;
    const size_t rowb = (size_t)b * SEQ;
    const int q0 = blk * 128;
    const int nt = 2 * blk + 2, my_nt = 2 * blk + (w4 >> 1) + 1;
    const bf16_t* Kg = P.qkv + rowb * LD + 1024 + h * 128;
    const bf16_t* Vg = P.qkv + rowb * LD + 2048 + h * 128;
    u32x4 kreg[2], vreg[2];
    int kdst[2], vdst[2];
#pragma unroll
    for (int i = 0; i < 2; ++i) {
        const int p = tid + 512 * i, key = p >> 4, c16 = p & 15;
        kdst[i] = key * 256 + ((c16 ^ (key & 15)) << 4);
        vdst[i] = KT_BYTES + (c16 >> 2) * 4096 + (key >> 4) * 1024 + ((key >> 3) & 1) * 512 + (key & 7) * 64 + (c16 & 3) * 16;
    }
#define AT_LOAD(t) do { _Pragma("unroll") for (int i = 0; i < 2; ++i) { const int p = tid + 512 * i, key = p >> 4, c16 = p & 15; const size_t go = (size_t)((t) * 64 + key) * LD + c16 * 8; \
        kreg[i] = *(const u32x4*)(Kg + go); vreg[i] = *(const u32x4*)(Vg + go); } } while (0)
#define AT_STORE(s) do { _Pragma("unroll") for (int i = 0; i < 2; ++i) { *(AT_LAS u32x4*)(lds + (s) * STG + kdst[i]) = kreg[i]; *(AT_LAS u32x4*)(lds + (s) * STG + vdst[i]) = vreg[i]; } } while (0)
    AT_LOAD(0);
    bf16x8 qr[4];
    {
        const bf16_t* Qw = P.qkv + (rowb + q0 + w4 * 32 + r32) * LD + h * 128 + comp * 64 + hi * 8;
#pragma unroll
        for (int d0 = 0; d0 < 4; ++d0) qr[d0] = *(const bf16x8*)(Qw + d0 * 16);
    }
    AT_STORE(0);
    __syncthreads();
    f32x16 o[4];
#pragma unroll
    for (int i = 0; i < 4; ++i)
#pragma unroll
        for (int r = 0; r < 16; ++r) o[i][r] = 0.f;
    float lsum = 0.f;
    f32x16 negm;
#pragma unroll
    for (int r = 0; r < 16; ++r) negm[r] = -P.mb;
    const int kbase = r32 * 256, ksw = r32 & 15;
    const int vbase = KT_BYTES + ((lane >> 4) & 1) * 32 + (lane & 3) * 8 + (4 * hi + ((lane & 15) >> 2)) * 64;
    for (int t = 0; t < nt; ++t) {
        const int s = t & 1;
        if (MODE != 4) { if (t + 1 < nt) AT_LOAD(t + 1); }
        if (t < my_nt) {
            const AT_LAS char* st = lds + s * STG;
            bf16x8 kf[8];
#pragma unroll
            for (int d0 = 0; d0 < 4; ++d0) {
                const int ch = comp * 8 + 2 * d0 + hi;
                kf[2 * d0] = *(const AT_LAS bf16x8*)(st + kbase + ((ch ^ ksw) << 4));
                kf[2 * d0 + 1] = *(const AT_LAS bf16x8*)(st + kbase + 32 * 256 + ((ch ^ ksw) << 4));
            }
            s16x4 vlo[2][4], vhi[2][4];
#define AT_VLOAD(bk, buf) do { _Pragma("unroll") for (int ks = 0; ks < 4; ++ks) { vlo[buf][ks] = vtr(st + vbase + (bk) * 4096 + ks * 1024); vhi[buf][ks] = vtr(st + vbase + (bk) * 4096 + ks * 1024 + 512); } } while (0)
            AT_VLOAD(0, 0);
            __builtin_amdgcn_sched_barrier(0);
            f32x16 p0 = negm, p1 = negm;
            if (MODE != 3) {
#pragma unroll
            for (int d0 = 0; d0 < 4; ++d0) {
                p0 = __builtin_amdgcn_mfma_f32_32x32x16_bf16(kf[2 * d0], qr[d0], p0, 0, 0, 0);
                p1 = __builtin_amdgcn_mfma_f32_32x32x16_bf16(kf[2 * d0 + 1], qr[d0], p1, 0, 0, 0);
            } }
            __builtin_amdgcn_sched_barrier(0);
            AT_VLOAD(1, 1);
            __builtin_amdgcn_sched_barrier(0);
            float sacc0 = 0.f, sacc1 = 0.f;
#pragma unroll
            for (int r = 0; r < 16; ++r) { if (MODE != 1) { p0[r] = __builtin_amdgcn_exp2f(p0[r]); p1[r] = __builtin_amdgcn_exp2f(p1[r]); } }
            __builtin_amdgcn_sched_barrier(0);
#pragma unroll
            for (int r = 0; r < 16; ++r) { sacc0 = fadd_s(sacc0, p0[r]); sacc1 = fadd_s(sacc1, p1[r]); }
            lsum += sacc0 + sacc1;
            u32x4 pw[4];
#pragma unroll
            for (int j = 0; j < 4; ++j) { pw[0][j] = cvtpk(p0[2 * j], p0[2 * j + 1]); pw[1][j] = cvtpk(p0[8 + 2 * j], p0[8 + 2 * j + 1]); pw[2][j] = cvtpk(p1[2 * j], p1[2 * j + 1]); pw[3][j] = cvtpk(p1[8 + 2 * j], p1[8 + 2 * j + 1]); }
#define AT_PV(bk, buf) do { _Pragma("unroll") for (int ks = 0; ks < 4; ++ks) { \
                const bf16x8 vf = {vlo[buf][ks][0], vlo[buf][ks][1], vlo[buf][ks][2], vlo[buf][ks][3], vhi[buf][ks][0], vhi[buf][ks][1], vhi[buf][ks][2], vhi[buf][ks][3]}; \
                if (MODE != 2) o[bk] = __builtin_amdgcn_mfma_f32_32x32x16_bf16(__builtin_bit_cast(bf16x8, pw[ks]), vf, o[bk], 0, 0, 0); else asm volatile("" :: "v"(pw[ks])); } } while (0)
            __builtin_amdgcn_sched_barrier(0);
            AT_PV(0, 0); __builtin_amdgcn_sched_barrier(0); AT_VLOAD(2, 0); __builtin_amdgcn_sched_barrier(0);
            AT_PV(1, 1); __builtin_amdgcn_sched_barrier(0); AT_VLOAD(3, 1); __builtin_amdgcn_sched_barrier(0);
            AT_PV(2, 0);
            AT_PV(3, 1);
#undef AT_VLOAD
#undef AT_PV
        }
        if (MODE != 4) { if (t + 1 < nt) AT_STORE(s ^ 1); }
        if (MODE != 5) __syncthreads();
    }
    lsum = xl_swap32_sum(lsum);
    AT_LAS float* wsf = (AT_LAS float*)(lds + L_WSF) + wid * 64;
    if (hi == 0) wsf[r32] = lsum;
    asm volatile("s_waitcnt lgkmcnt(0)" ::: "memory");
    float rl[16];
    const float sc = comp ? P.lam : 1.0f;
#pragma unroll
    for (int r = 0; r < 16; ++r) rl[r] = sc * __builtin_amdgcn_rcpf(wsf[crow(r, hi)]);
    AT_LAS f32x4* X4 = (AT_LAS f32x4*)(lds + L_X) + w4 * 1024 + lane;
    if (comp == 1) {
#pragma unroll
        for (int bk = 0; bk < 4; ++bk)
#pragma unroll
            for (int q = 0; q < 4; ++q) X4[(bk * 4 + q) * 64] = (f32x4){o[bk][4 * q] * rl[4 * q], o[bk][4 * q + 1] * rl[4 * q + 1], o[bk][4 * q + 2] * rl[4 * q + 2], o[bk][4 * q + 3] * rl[4 * q + 3]};
    }
    __syncthreads();
    if (comp == 0) {
        float ss[16];
#pragma unroll
        for (int r = 0; r < 16; ++r) ss[r] = 0.f;
#pragma unroll
        for (int bk = 0; bk < 4; ++bk)
#pragma unroll
            for (int q = 0; q < 4; ++q) { const f32x4 x4 = X4[(bk * 4 + q) * 64];
#pragma unroll
                for (int e = 0; e < 4; ++e) { const int r = 4 * q + e; const float v = o[bk][r] * rl[r] - x4[e]; o[bk][r] = v; ss[r] += v * v; } }
#pragma unroll
        for (int r = 0; r < 16; ++r) {
            float s = ss[r];
            s = xl_swap16_sum(xl_sum16(s));
            ss[r] = __builtin_amdgcn_rsqf(s * (1.0f / 128.0f) + 1e-6f);
        }
        AT_LAS bf16_t* stg = (AT_LAS bf16_t*)(lds + L_OST) + w4 * 4096;
#pragma unroll
        for (int bk = 0; bk < 4; ++bk)
#pragma unroll
            for (int r = 0; r < 16; ++r) { const float v = o[bk][r] * ss[r]; stg[crow(r, hi) * 128 + bk * 32 + r32] = (bf16_t)(cvtpk(v, 0.f) & 0xffffu); }
        asm volatile("s_waitcnt lgkmcnt(0)" ::: "memory");
        bf16_t* Ow = P.qkv + (rowb + q0 + w4 * 32) * LD + h * 128;
#pragma unroll
        for (int i = 0; i < 8; ++i) { const int row = i * 4 + (lane >> 4), c = lane & 15; const u32x4 v = *(const AT_LAS u32x4*)(stg + row * 128 + c * 8); if (!P.dry) *(u32x4*)(Ow + (size_t)row * LD + c * 8) = v; }
    }
    __syncthreads();
#undef AT_LOAD
#undef AT_STORE
}
}
namespace scan {
using pg8::bf16_t; using pg8::bf16x8; using pg8::f32x4; using pg8::u32x4; using pg8::u32x2;
typedef float f32x16 __attribute__((ext_vector_type(16)));
#define SC_LAS __attribute__((address_space(3)))
#define SC_BAR() do { asm volatile("s_waitcnt lgkmcnt(0)" ::: "memory"); __builtin_amdgcn_s_barrier(); asm volatile("" ::: "memory"); } while (0)
constexpr int SEQ = 2048, CH = 64;
constexpr int L_C = 0;
constexpr int L_B = 16384;
constexpr int L_XD = 32768;
constexpr int L_XW = 40960;
constexpr int L_G = 49152;
constexpr int L_H = 57344;
constexpr int L_Y = 73728;
constexpr int L_S = L_Y + 64 * 68 * 4;
constexpr int L_B2 = L_S + 32 * 1024;
constexpr int LDS_BYTES = L_B2 + 16384;
__device__ __forceinline__ unsigned cvtpk(float lo, float hi) { typedef float f2 __attribute__((ext_vector_type(2))); typedef __bf16 b2 __attribute__((ext_vector_type(2))); f2 v = {lo, hi}; b2 b = __builtin_convertvector(v, b2); return __builtin_bit_cast(unsigned, b); }
typedef short s16x4 __attribute__((ext_vector_type(4)));
__device__ __forceinline__ s16x4 vtr(const SC_LAS char* p) { typedef short v4 __attribute__((ext_vector_type(4))); return __builtin_bit_cast(s16x4, __builtin_amdgcn_ds_read_tr16_b64_v4i16((SC_LAS v4*)p)); }
__device__ __forceinline__ float lo16(unsigned w) { return __builtin_bit_cast(float, w << 16); }
__device__ __forceinline__ float hi16(unsigned w) { return __builtin_bit_cast(float, w & 0xffff0000u); }
__device__ __forceinline__ int img_off(int l) { return (l >> 4) * 1024 + ((l >> 3) & 1) * 512 + (l & 7) * 64; }

struct Params { const bf16_t* xbc; bf16_t* zp; const float* dt; const float* a_log; const float* dskip; float* ssqp; int dry; };

__device__ __forceinline__ void unit(const Params& P, int b, int h, SC_LAS char* lds, const int wave_s) {
    int tid = wave_s * 64 + HW_LANE(); asm volatile("" : "+v"(tid));
    const int wid = __builtin_amdgcn_readfirstlane(tid >> 6);
    const int g = h >> 3;
    const size_t rowb = (size_t)b * SEQ;
    const float a_h = -expf(P.a_log[h]), dsk = P.dskip[h];
    unsigned zu = 0u; asm volatile("" : "+v"(zu));
    {
        const int lane_ = tid & 63;
        float dt4[4];
#pragma unroll
        for (int q = 0; q < 4; ++q) dt4[q] = P.dt[(rowb + (wid * 4 + q) * 64 + lane_) * 32 + h];
        __builtin_amdgcn_sched_barrier(0);
#pragma unroll
        for (int q = 0; q < 4; ++q) {
            const int cc = wid * 4 + q;
            const float dtv = dt4[q];
            float acs = dtv * a_h;
            acs = xl_scan64(acs);
            const float last = __builtin_bit_cast(float, __builtin_amdgcn_readlane(__builtin_bit_cast(int, acs), 63));
            SC_LAS float* sc = (SC_LAS float*)(lds + L_S) + cc * 256;
            sc[lane_] = dtv; sc[64 + lane_] = acs * 1.4426950408889634f  ; sc[128 + lane_] = __expf(last - acs); sc[192 + lane_] = __expf(acs);
        }
    }
    for (int i = tid; i < 16384 / 16; i += 512) *(SC_LAS u32x4*)(lds + L_H + i * 16) = (u32x4){zu, zu, zu, zu};
    f32x16 hacc0, hacc1;
#pragma unroll
    for (int r = 0; r < 16; ++r) { hacc0[r] = 0.f; hacc1[r] = 0.f; }
    const int tid0 = tid;
    u32x4 xrA, zrA, brA[2], crA[2], xrB, zrB, brB[2], crB[2];
#define SC_LOAD(t0_, XR, ZR, BR, CR) do { const int t_ = tid0; const size_t r1 = rowb + (t0_) + (t_ >> 3); \
        XR = *(const u32x4*)(P.xbc + r1 * 3072 + h * 64 + (t_ & 7) * 8); ZR = *(const u32x4*)(P.zp + r1 * 2048 + h * 64 + (t_ & 7) * 8); \
        _Pragma("unroll") for (int i = 0; i < 2; ++i) { const int p_ = t_ + 512 * i; const size_t r2 = rowb + (t0_) + (p_ >> 4); \
            BR[i] = *(const u32x4*)(P.xbc + r2 * 3072 + 2048 + g * 128 + (p_ & 15) * 8); CR[i] = *(const u32x4*)(P.xbc + r2 * 3072 + 2560 + g * 128 + (p_ & 15) * 8); } } while (0)
    SC_LOAD(0, xrA, zrA, brA, crA);
    SC_LOAD(CH, xrB, zrB, brB, crB);
    __syncthreads();
    auto chunk = [&](const int c, u32x4& xr, u32x4& zr, u32x4 (&br)[2], u32x4 (&cr)[2]) __attribute__((always_inline)) {
        const int t0 = c * CH;
        int tid = tid0; asm volatile("" : "+v"(tid));
        const int lane = tid & 63, r32 = lane & 31, hi = lane >> 5, fr = lane & 15, fq = lane >> 4;
        const int orow = tid >> 3, ocg = tid & 7;
        SC_LAS float* s_dt = (SC_LAS float*)(lds + L_S) + c * 256; SC_LAS float* s_acs = s_dt + 64; SC_LAS float* s_dec = s_dt + 128; SC_LAS float* s_ea = s_dt + 192;
        {
            const float d = s_dt[orow], dd = d * s_dec[orow];
            u32x4 w1, w2;
#pragma unroll
            for (int i = 0; i < 4; ++i) { const float a = lo16(xr[i]), bq = hi16(xr[i]); w1[i] = cvtpk(a * d, bq * d); w2[i] = cvtpk(a * dd, bq * dd); }
            const int off = (ocg >> 2) * 4096 + img_off(orow) + (ocg & 3) * 16;
            *(SC_LAS u32x4*)(lds + L_XD + off) = w1; *(SC_LAS u32x4*)(lds + L_XW + off) = w2;
#pragma unroll
            for (int i = 0; i < 2; ++i) { const int p = tid + 512 * i, l = p >> 4, c16 = p & 15;
                *(SC_LAS u32x4*)(lds + L_B + (c16 >> 2) * 4096 + img_off(l) + (c16 & 3) * 16) = br[i];
                *(SC_LAS u32x4*)(lds + L_B2 + l * 256 + ((c16 ^ (l & 15)) << 4)) = br[i];
                *(SC_LAS u32x4*)(lds + L_C + l * 256 + ((c16 ^ (l & 15)) << 4)) = cr[i]; }
        }
        const u32x4 xcur = xr, zcur = zr;
        if (c + 2 < SEQ / CH) SC_LOAD(t0 + 2 * CH, xr, zr, br, cr);
        SC_BAR();
        f32x16 yacc;
#pragma unroll
        for (int r = 0; r < 16; ++r) yacc[r] = 0.f;
        const int yli = (wid >> 1) & 1, ypi = wid & 1;
        if (wid < 3) {
            const int si = (wid == 2) ? 1 : 0, li = (wid == 0) ? 0 : 1;
            const int srow = 32 * si + r32, lrow = 32 * li + r32;
            f32x16 cb;
#pragma unroll
            for (int r = 0; r < 16; ++r) cb[r] = 0.f;
            bf16x8 fa[8], fb[8];
#pragma unroll
            for (int ks = 0; ks < 8; ++ks) {
                const int chk = 2 * ks + hi;
                fa[ks] = *(const SC_LAS bf16x8*)(lds + L_B2 + srow * 256 + ((chk ^ (srow & 15)) << 4));
                fb[ks] = *(const SC_LAS bf16x8*)(lds + L_C + lrow * 256 + ((chk ^ (lrow & 15)) << 4));
            }
            __builtin_amdgcn_sched_barrier(0);
#pragma unroll
            for (int ks = 0; ks < 8; ++ks) cb = __builtin_amdgcn_mfma_f32_32x32x16_bf16(fa[ks], fb[ks], cb, 0, 0, 0);
            const float al = s_acs[lrow];
#pragma unroll
            for (int q4 = 0; q4 < 4; ++q4) {
                const int s0 = 32 * si + 8 * q4 + 4 * hi;
                float gv[4];
                const f32x4 a4 = *(const SC_LAS f32x4*)(s_acs + s0);
#pragma unroll
                for (int e = 0; e < 4; ++e) { const int sidx = s0 + e; const float ev = __builtin_amdgcn_exp2f(al - a4[e]) * cb[4 * q4 + e];
                    gv[e] = __builtin_bit_cast(float, __builtin_bit_cast(unsigned, ev) & ((sidx <= lrow) ? 0xffffffffu : 0u)); }
                u32x2 w; w.x = cvtpk(gv[0], gv[1]); w.y = cvtpk(gv[2], gv[3]);
                *(SC_LAS u32x2*)(lds + L_G + lrow * 128 + (((s0 >> 3) ^ (lrow & 7)) << 4) + (s0 & 7) * 2) = w;
            }
        } else if (wid >= 4) {
            const int lrow = 32 * yli + r32, prow = 32 * ypi + r32;
            bf16x8 fa[8], fb[8];
#pragma unroll
            for (int ks = 0; ks < 8; ++ks) {
                const int chk = 2 * ks + hi;
                fa[ks] = *(const SC_LAS bf16x8*)(lds + L_C + lrow * 256 + ((chk ^ (lrow & 15)) << 4));
                fb[ks] = *(const SC_LAS bf16x8*)(lds + L_H + prow * 256 + ((chk ^ (prow & 15)) << 4));
            }
            __builtin_amdgcn_sched_barrier(0);
#pragma unroll
            for (int ks = 0; ks < 8; ++ks) yacc = __builtin_amdgcn_mfma_f32_32x32x16_bf16(fa[ks], fb[ks], yacc, 0, 0, 0);
        }
        SC_BAR();
        if (wid >= 4) {
#pragma unroll
            for (int q = 0; q < 4; ++q) { const f32x4 e4 = *(const SC_LAS f32x4*)(s_ea + 32 * yli + 8 * q + 4 * hi);
#pragma unroll
                for (int e = 0; e < 4; ++e) yacc[4 * q + e] *= e4[e]; }
            const int lrow = 32 * yli + r32;
            const int tbn = ((lane >> 4) & 1) * 32 + (lane & 3) * 8 + hi * 512 + ((lane & 15) >> 2) * 64;
            bf16x8 ga[4]; s16x4 xb0[4], xb1[4];
#pragma unroll
            for (int ks = 0; ks < 4; ++ks) {
                const int chk = 2 * ks + hi;
                ga[ks] = *(const SC_LAS bf16x8*)(lds + L_G + lrow * 128 + ((chk ^ (lrow & 7)) << 4));
                xb0[ks] = vtr(lds + L_XD + ypi * 4096 + ks * 1024 + tbn); xb1[ks] = vtr(lds + L_XD + ypi * 4096 + ks * 1024 + tbn + 256);
            }
            __builtin_amdgcn_sched_barrier(0);
#pragma unroll
            for (int ks = 0; ks < 4; ++ks) {
                if (ks < 2 * (yli + 1)) {
                    const bf16x8 bb = {xb0[ks][0], xb0[ks][1], xb0[ks][2], xb0[ks][3], xb1[ks][0], xb1[ks][1], xb1[ks][2], xb1[ks][3]};
                    yacc = __builtin_amdgcn_mfma_f32_32x32x16_bf16(ga[ks], bb, yacc, 0, 0, 0);
                }
            }
#pragma unroll
            for (int r = 0; r < 16; ++r) ((SC_LAS float*)(lds + L_Y))[(32 * yli + (r & 3) + 8 * (r >> 2) + 4 * hi) * 68 + 32 * ypi + r32] = yacc[r];
        } else {
            const float cd = __builtin_amdgcn_exp2f(s_acs[63]);
#pragma unroll
            for (int r = 0; r < 16; ++r) { hacc0[r] *= cd; hacc1[r] *= cd; }
            const int tb = ((lane >> 4) & 1) * 32 + (lane & 3) * 8 + (4 * hi + ((lane & 15) >> 2)) * 64;
            s16x4 a0[4], a1[4], b0[4], b1[4], c0[4], c1[4];
#pragma unroll
            for (int ks = 0; ks < 4; ++ks) {
                a0[ks] = vtr(lds + L_B + wid * 4096 + ks * 1024 + tb); a1[ks] = vtr(lds + L_B + wid * 4096 + ks * 1024 + 512 + tb);
                b0[ks] = vtr(lds + L_XW + ks * 1024 + tb); b1[ks] = vtr(lds + L_XW + ks * 1024 + 512 + tb);
                c0[ks] = vtr(lds + L_XW + 4096 + ks * 1024 + tb); c1[ks] = vtr(lds + L_XW + 4096 + ks * 1024 + 512 + tb);
            }
            __builtin_amdgcn_sched_barrier(0);
#pragma unroll
            for (int ks = 0; ks < 4; ++ks) {
                const bf16x8 a = {a0[ks][0], a0[ks][1], a0[ks][2], a0[ks][3], a1[ks][0], a1[ks][1], a1[ks][2], a1[ks][3]};
                const bf16x8 bb = {b0[ks][0], b0[ks][1], b0[ks][2], b0[ks][3], b1[ks][0], b1[ks][1], b1[ks][2], b1[ks][3]};
                const bf16x8 cc = {c0[ks][0], c0[ks][1], c0[ks][2], c0[ks][3], c1[ks][0], c1[ks][1], c1[ks][2], c1[ks][3]};
                hacc0 = __builtin_amdgcn_mfma_f32_32x32x16_bf16(a, bb, hacc0, 0, 0, 0);
                hacc1 = __builtin_amdgcn_mfma_f32_32x32x16_bf16(a, cc, hacc1, 0, 0, 0);
            }
#pragma unroll
            for (int q4 = 0; q4 < 4; ++q4) {
                const int n0 = 32 * wid + 8 * q4 + 4 * hi;
                u32x2 w0, w1; w0.x = cvtpk(hacc0[4 * q4 + 0], hacc0[4 * q4 + 1]); w0.y = cvtpk(hacc0[4 * q4 + 2], hacc0[4 * q4 + 3]);
                w1.x = cvtpk(hacc1[4 * q4 + 0], hacc1[4 * q4 + 1]); w1.y = cvtpk(hacc1[4 * q4 + 2], hacc1[4 * q4 + 3]);
                *(SC_LAS u32x2*)(lds + L_H + r32 * 256 + (((n0 >> 3) ^ (r32 & 15)) << 4) + (n0 & 7) * 2) = w0;
                *(SC_LAS u32x2*)(lds + L_H + (32 + r32) * 256 + (((n0 >> 3) ^ (r32 & 15)) << 4) + (n0 & 7) * 2) = w1;
            }
        }
        SC_BAR();
        {
            const SC_LAS float* yr = (const SC_LAS float*)(lds + L_Y) + orow * 68 + ocg * 8;
            const f32x4 y0 = *(const SC_LAS f32x4*)yr, y1 = *(const SC_LAS f32x4*)(yr + 4);
            float yv[8];
#pragma unroll
            for (int i = 0; i < 4; ++i) {
                const float ya = (i < 2) ? y0[2 * i] : y1[2 * i - 4], yb = (i < 2) ? y0[2 * i + 1] : y1[2 * i - 3];
                yv[2 * i] = (ya + dsk * lo16(xcur[i])) * lo16(zcur[i]); yv[2 * i + 1] = (yb + dsk * hi16(xcur[i])) * hi16(zcur[i]);
            }
            float ss = 0.f;
#pragma unroll
            for (int i = 0; i < 8; ++i) ss += yv[i] * yv[i];
            ss = xl_sum8(ss);
            if (ocg == 0) P.ssqp[(rowb + t0 + orow) * 32 + h] = ss;
            u32x4 w; w.x = cvtpk(yv[0], yv[1]); w.y = cvtpk(yv[2], yv[3]); w.z = cvtpk(yv[4], yv[5]); w.w = cvtpk(yv[6], yv[7]);
            if (!P.dry) *(u32x4*)(P.zp + (rowb + t0 + orow) * 2048 + h * 64 + ocg * 8) = w;
        }
    };
    for (int c = 0; c < SEQ / CH; c += 2) { chunk(c, xrA, zrA, brA, crA); chunk(c + 1, xrB, zrB, brB, crB); }
    __syncthreads();
#undef SC_LOAD
}
}
namespace mk {
#define GAS __attribute__((address_space(1)))
#define LAS __attribute__((address_space(3)))
typedef unsigned short bf16;
typedef unsigned v4u __attribute__((ext_vector_type(4)));
typedef float f32x4 __attribute__((ext_vector_type(4)));
typedef GAS unsigned gu32;
#define RLX_AGENT __ATOMIC_RELAXED, __HIP_MEMORY_SCOPE_AGENT
constexpr int NWAVES = 8;
constexpr int M = 16384, D = 1024, SEQ = 2048, NB = 8;
constexpr int SSD_NP = 5376, SSD_IN = 5152, SSD_DI = 2048, SSD_LD = 5120;
constexpr int AT_IN = 3072, DFF = 2816;
constexpr size_t MiB = 1u << 20;
constexpr size_t WS_CTL = 0, CTL_ZERO_BYTES = 64 * 1024;
constexpr size_t WS_CONST = 64 * 1024;
constexpr size_t WS_SSQ = 1 * MiB;
constexpr size_t WS_ROPE = 2 * MiB;
constexpr size_t WS_DT = 3 * MiB;
constexpr size_t WS_SSQP = 5 * MiB;
constexpr size_t WS_CP = 1 * MiB + 512 * 1024;
constexpr size_t WS_W = 7 * MiB;
constexpr size_t W_SSD_IN = 0, W_SSD_IN_SZ = (size_t)SSD_NP * D * 2;
constexpr size_t W_SSD_OUT = W_SSD_IN + 2 * W_SSD_IN_SZ, W_SSD_OUT_SZ = (size_t)D * SSD_DI * 2;
constexpr size_t W_AT_IN = W_SSD_OUT + 2 * W_SSD_OUT_SZ, W_AT_IN_SZ = (size_t)AT_IN * D * 2;
constexpr size_t W_AT_OUT = W_AT_IN + 2 * W_AT_IN_SZ, W_AT_OUT_SZ = (size_t)D * D * 2;
constexpr size_t W_UP = W_AT_OUT + 2 * W_AT_OUT_SZ, W_UP_SZ = (size_t)2 * DFF * D * 2;
constexpr size_t W_DOWN = W_UP + 4 * W_UP_SZ, W_DOWN_SZ = (size_t)D * DFF * 2;
constexpr size_t W_TOTAL = W_DOWN + 4 * W_DOWN_SZ;
constexpr size_t WS_XB = ((WS_W + W_TOTAL + MiB - 1) / MiB) * MiB;
constexpr size_t XB_PAD_FRONT = 4 * D * 2, XB_BYTES = (size_t)(M + 260) * D * 2;
constexpr size_t WS_BIG = ((WS_XB + XB_BYTES + MiB - 1) / MiB) * MiB;
constexpr size_t BIG_BYTES = (size_t)M * SSD_LD * 2;
constexpr size_t WS_DBG = WS_BIG + BIG_BYTES;
constexpr size_t WS_END = WS_DBG + (size_t)M * D * 2;
static_assert(WS_END <= 352 * MiB, "workspace map exceeds the guaranteed 352 MiB");
constexpr int CW_BAR = 1024;
constexpr int RING_BYTES = 131072, EPI_OFF = RING_BYTES, EPI_BYTES = 30720, MISC_OFF = EPI_OFF + EPI_BYTES;
constexpr int LDS_BYTES = 162816;
static_assert(MISC_OFF + 1024 <= LDS_BYTES && attn::LDS_BYTES <= RING_BYTES && scan::LDS_BYTES <= MISC_OFF  , "LDS map");

#define LDS_WAIT() asm volatile("s_waitcnt lgkmcnt(0)" ::: "memory")
__device__ __forceinline__ unsigned f2bf(float f) { unsigned u = __builtin_bit_cast(unsigned, f); return (u + 0x7fffu + ((u >> 16) & 1u)) >> 16; }
__device__ __forceinline__ unsigned pk2(float lo, float hi) { return f2bf(lo) | (f2bf(hi) << 16); }
template <bool F16> __device__ __forceinline__ unsigned pk2x(float lo, float hi) { if constexpr (F16) return epi::pk_f16(lo, hi); else return pk2(lo, hi); }

#define XB_TMO      128
#define XB_XCNT(j)  (256  + 64 * (j))
#define XB_XSUB(j)  (1280 + 64 * (j))
#define XB_XGEN(j)  (2304 + 64 * (j))
#define XB_TOP      3328
#define XB_TOPGEN   3392
#define XCD_BAR_WORDS 3456
#define XB_SPIN_CAP (1u << 20)
__device__ __forceinline__ unsigned xb_ld(unsigned* p)              { return __hip_atomic_load(p, __ATOMIC_RELAXED, __HIP_MEMORY_SCOPE_AGENT); }
__device__ __forceinline__ unsigned xb_add(unsigned* p, unsigned v) { return __hip_atomic_fetch_add(p, v, __ATOMIC_RELAXED, __HIP_MEMORY_SCOPE_AGENT); }
__device__ __forceinline__ unsigned xb_xcc_id() { return (unsigned)__builtin_amdgcn_s_getreg((3 << 11) | 20) & 0xFu; }
#define XB_SPIN(cond, bar) do { unsigned _sp = 0; while (cond) { __builtin_amdgcn_s_sleep(1); \
    if ((++_sp & 255u) == 0u) { if (xb_ld(&(bar)[XB_TMO])) break; if (_sp > XB_SPIN_CAP) { atomicAdd(&(bar)[XB_TMO], 1u); break; } } } } while (0)
struct XcdBarrier { unsigned* bar; unsigned x; volatile LAS unsigned* st; };
__device__ __forceinline__ XcdBarrier xcd_barrier_post(unsigned* bar, volatile LAS unsigned* st, bool leader) {
    XcdBarrier b; b.bar = bar; b.x = xb_xcc_id(); b.st = st;
    if (leader) (void)xb_add(&bar[XB_XCNT(b.x)], 1u);
    return b;
}
__device__ __forceinline__ void xcd_barrier_complete(unsigned* bar, unsigned x, unsigned& nloc, unsigned& nx) {
    const unsigned G = gridDim.x * gridDim.y * gridDim.z;
    unsigned sum, cnt, mine, sp = 0u;
    for (;;) {
        sum = 0u; cnt = 0u; mine = 0u;
#pragma unroll
        for (unsigned j = 0; j < 16; ++j) { const unsigned c = xb_ld(&bar[XB_XCNT(j)]); sum += c; cnt += (c > 0u) ? 1u : 0u; mine = (j == x) ? c : mine; }
        if (sum == G) break;
        __builtin_amdgcn_s_sleep(1);
        if ((++sp & 255u) == 0u) { if (xb_ld(&bar[XB_TMO])) break; if (sp > XB_SPIN_CAP) { atomicAdd(&bar[XB_TMO], 1u); break; } }
    }
    nloc = mine > 0u ? mine : 1u; nx = cnt > 0u ? cnt : 1u;
}
__device__ __forceinline__ void xcd_barrier(const XcdBarrier& b, const int wave_s) {
    asm volatile("s_waitcnt vmcnt(0)" ::: "memory");
    __syncthreads();
    if (wave_s == 0 && HW_LANE() == 0) {
        unsigned* bar = b.bar; asm volatile("" : "+s"(bar));
        __builtin_amdgcn_s_waitcnt(0);
        unsigned nloc = b.st[0], nx = b.st[1];
        if (nloc == 0u) { xcd_barrier_complete(bar, b.x, nloc, nx); b.st[0] = nloc; b.st[1] = nx; }
        const unsigned old = xb_add(&bar[XB_XSUB(b.x)], 1u);
        const unsigned gen = old / nloc;
        if (old + 1u == (gen + 1u) * nloc) {
            __builtin_amdgcn_fence(__ATOMIC_RELEASE, "agent");
            asm volatile("s_waitcnt vmcnt(0)" ::: "memory");
            const unsigned og = xb_add(&bar[XB_TOP], 1u);
            const unsigned tg = og / nx;
            if (og + 1u == (tg + 1u) * nx) xb_add(&bar[XB_TOPGEN], 1u);
            else XB_SPIN(xb_ld(&bar[XB_TOPGEN]) == tg, bar);
            __builtin_amdgcn_fence(__ATOMIC_ACQUIRE, "agent");
            xb_add(&bar[XB_XGEN(b.x)], 1u);
            asm volatile("s_waitcnt vmcnt(0)" ::: "memory");
        } else {
            XB_SPIN(xb_ld(&bar[XB_XGEN(b.x)]) == gen, bar);
            __builtin_amdgcn_fence(__ATOMIC_ACQUIRE, "agent");
            asm volatile("s_waitcnt vmcnt(0)" ::: "memory");
        }
    }
    __syncthreads();
}

__device__ __forceinline__ unsigned long long ldarg(LAS unsigned long long* AP, int i) {
    asm volatile("" : "+s"(i));
    const unsigned long long v = AP[i];
    return ((unsigned long long)(unsigned)__builtin_amdgcn_readfirstlane((int)(v >> 32)) << 32) | (unsigned long long)(unsigned)__builtin_amdgcn_readfirstlane((int)v);
}
struct Args { const void* in[25]; float* out; unsigned char* ws; int ph_lo, ph_hi; int dbg, pad; };

__device__ __forceinline__ float wave_sum(float v) {
    return xl_sum64(v);
}
template <bool F16  , class RowMap>
__device__ __forceinline__ void transpose_item(const float* W, int K, int N, const float* gain, int gmask, float gscale, bf16* WT, const RowMap& rm, LAS float* scr, int item, int item2, int lane) {
    const int nblk = N / 32, rs = lane >> 3, c4 = lane & 7, c = lane & 7;
    f32x4 va[8], vb[8]; float ga[8], gb[8];
    const int kA = 64 * (item / nblk), nA = 32 * (item % nblk);
    const int it2 = item2 < 0 ? item : item2; const int kB = 64 * (it2 / nblk), nB = 32 * (it2 % nblk);
#pragma unroll
    for (int i = 0; i < 8; ++i) { const int kk = 8 * i + rs; va[i] = __builtin_nontemporal_load((const f32x4*)(W + (size_t)(kA + kk) * N + nA + 4 * c4));     ga[i] = gain ? gain[(kA + kk) & gmask] * gscale : 1.0f; }
    if (item2 >= 0) {
#pragma unroll
        for (int i = 0; i < 8; ++i) { const int kk = 8 * i + rs; vb[i] = __builtin_nontemporal_load((const f32x4*)(W + (size_t)(kB + kk) * N + nB + 4 * c4)); gb[i] = gain ? gain[(kB + kk) & gmask] * gscale : 1.0f; }
    }
#pragma unroll
    for (int h = 0; h < 2; ++h) {
        if (h == 1 && item2 < 0) break;
        const int k0 = h ? kB : kA, n0 = h ? nB : nA;
#pragma unroll
        for (int i = 0; i < 8; ++i) { const int kk = 8 * i + rs; LAS float* d = scr + kk * 33 + 4 * c4; const f32x4 v = h ? vb[i] : va[i]; const float g = h ? gb[i] : ga[i]; d[0] = v[0] * g; d[1] = v[1] * g; d[2] = v[2] * g; d[3] = v[3] * g; }
        LDS_WAIT(); asm volatile("" ::: "memory");
#pragma unroll
        for (int j = 0; j < 4; ++j) { const int n = (lane >> 3) + 8 * j; const LAS float* sp = scr + (8 * c) * 33 + n;
            v4u o;
#ifndef W16_BF16_GRID
#define W16_BF16_GRID 1
#endif
#if W16_BF16_GRID
            if constexpr (F16) {
                float t_[8];
#pragma unroll
                for (int q_ = 0; q_ < 8; ++q_) t_[q_] = __builtin_bit_cast(float, f2bf(sp[q_ * 33]) << 16);
                o.x = epi::pk_f16(t_[0], t_[1]); o.y = epi::pk_f16(t_[2], t_[3]); o.z = epi::pk_f16(t_[4], t_[5]); o.w = epi::pk_f16(t_[6], t_[7]);
            } else
#endif
            { o.x = pk2x<F16>(sp[0 * 33], sp[1 * 33]); o.y = pk2x<F16>(sp[2 * 33], sp[3 * 33]); o.z = pk2x<F16>(sp[4 * 33], sp[5 * 33]); o.w = pk2x<F16>(sp[6 * 33], sp[7 * 33]); }
            *(GAS v4u*)(WT + (size_t)rm(n0 + n) * K + k0 + 8 * c) = o; }
        LDS_WAIT(); asm volatile("" ::: "memory");
    }
}
struct RowId { __device__ __forceinline__ int operator()(int n) const { return n; } };
struct RowUp { __device__ __forceinline__ int operator()(int n) const { const int u = n >= DFF, ch = u ? n - DFF : n; return (ch >> 7) * 256 + u * 128 + (ch & 127); } };

__global__ void __launch_bounds__(NWAVES * 64, 2) mega_fwd(Args args) {
    extern __shared__ __attribute__((aligned(16))) unsigned char lds_raw[];
    LAS unsigned char* lds = (LAS unsigned char*)lds_raw;
    volatile LAS unsigned* MISC = (volatile LAS unsigned*)(lds + MISC_OFF);
    const int G = gridDim.x; const int bx = blockIdx.x; const int vcu = (G % 8 == 0) ? (bx % 8) * (G / 8) + bx / 8 : bx;
    gu32* ctl = (gu32*)(args.ws + WS_CTL);
    const int wave_s = __builtin_amdgcn_readfirstlane((int)threadIdx.x >> 6);
    if (wave_s == 0) MISC[HW_LANE()] = 0u;
    __syncthreads();
    XcdBarrier bar = xcd_barrier_post((unsigned*)ctl + CW_BAR, MISC + 8, wave_s == 0 && HW_LANE() == 0);
#define GRID_BAR() xcd_barrier(bar, wave_s)
    LAS unsigned long long* AP = (LAS unsigned long long*)(lds + MISC_OFF + 256);
    if (wave_s == 0 && HW_LANE() < 27) AP[HW_LANE()] = ((const unsigned long long*)&args)[HW_LANE()];
    __syncthreads();
#define ARGP(T, i) ((T)(GAS void*)ldarg(AP, i))
#define x_in   ARGP(const float*, 0)
#define pos    ARGP(const int*, 1)
#define nmg    ARGP(const float*, 2)
#define nfg    ARGP(const float*, 3)
#define s_inw  ARGP(const float*, 4)
#define s_cw   ARGP(const float*, 5)
#define s_cb   ARGP(const float*, 6)
#define s_dtb  ARGP(const float*, 7)
#define s_alog ARGP(const float*, 8)
#define s_d    ARGP(const float*, 9)
#define s_ng   ARGP(const float*, 10)
#define s_ow   ARGP(const float*, 11)
#define a_inw  ARGP(const float*, 12)
#define a_qg   ARGP(const float*, 13)
#define a_kg   ARGP(const float*, 14)
#define a_lq1  ARGP(const float*, 15)
#define a_lk1  ARGP(const float*, 16)
#define a_lq2  ARGP(const float*, 17)
#define a_lk2  ARGP(const float*, 18)
#define a_sg   ARGP(const float*, 19)
#define a_ow   ARGP(const float*, 20)
#define f_uw   ARGP(const float*, 21)
#define f_cw   ARGP(const float*, 22)
#define f_cb   ARGP(const float*, 23)
#define f_dw   ARGP(const float*, 24)
#define xout   ARGP(float*, 25)
#define ws     ARGP(unsigned char*, 26)
#define cst    ((float*)(ws + WS_CONST))
#define SSQ    ((float*)(ws + WS_SSQ))
#define ROPE   ((float*)(ws + WS_ROPE))
#define DT     ((float*)(ws + WS_DT))
#define SSQP   ((float*)(ws + WS_SSQP))
#define Wb     ((bf16*)(ws + WS_W))
#define XB     ((bf16*)(ws + WS_XB + XB_PAD_FRONT))
#define BIG    ((bf16*)(ws + WS_BIG))
#define XLO    ((bf16*)(ws + WS_DBG))
#define CPT    ((float*)(ws + WS_CP))
#define ZPL    ((bf16*)(ws + WS_BIG))
#define XBCPL  ((bf16*)(ws + WS_BIG + (size_t)M * SSD_DI * 2))
#define CONV_MATRIX(kind_, idx_, worker_, nworkers_) do { \
        int tid_ = wave_s * 64 + HW_LANE(); asm volatile("" : "+v"(tid_)); const int lane_ = tid_ & 63, wave_ = wave_s; \
        LAS float* scr_ = (LAS float*)(lds + wave_ * 16384); const int j_ = (idx_); \
        constexpr int I_SI = (D / 64) * (SSD_IN / 32), I_SO = (SSD_DI / 64) * (D / 32), I_AI = (D / 64) * (AT_IN / 32), I_AO = (D / 64) * (D / 32), I_UP = (D / 64) * (2 * DFF / 32), I_DN = (DFF / 64) * (D / 32); \
        if ((kind_) == 0) { for (int it = (worker_); it < I_SI; it += 2 * (nworkers_)) transpose_item<(RES_F16 != 0)>(s_inw + (size_t)j_ * D * SSD_IN, D, SSD_IN, nmg + (2 * j_) * D, 1023, 1.0f, (bf16*)((char*)Wb + W_SSD_IN + j_ * W_SSD_IN_SZ), RowId(), scr_, it, (it + (nworkers_) < I_SI) ? it + (nworkers_) : -1, lane_); \
            v4u* p_ = (v4u*)((char*)Wb + W_SSD_IN + j_ * W_SSD_IN_SZ + (size_t)SSD_IN * D * 2); const int n16_ = (SSD_NP - SSD_IN) * D * 2 / 16; \
            unsigned z_ = 0u; asm volatile("" : "+v"(z_)); for (int i = (worker_) * 64 + lane_; i < n16_; i += (nworkers_) * 64) p_[i] = (v4u){z_, z_, z_, z_}; } \
        else if ((kind_) == 1) { for (int it = (worker_); it < I_SO; it += 2 * (nworkers_)) transpose_item<false>(s_ow + (size_t)j_ * SSD_DI * D, SSD_DI, D, s_ng + j_ * SSD_DI, 2047, 1.0f, (bf16*)((char*)Wb + W_SSD_OUT + j_ * W_SSD_OUT_SZ), RowId(), scr_, it, (it + (nworkers_) < I_SO) ? it + (nworkers_) : -1, lane_); } \
        else if ((kind_) == 2) { for (int it = (worker_); it < I_AI; it += 2 * (nworkers_)) transpose_item<(RES_F16 != 0)>(a_inw + (size_t)j_ * D * AT_IN, D, AT_IN, nmg + (2 * j_ + 1) * D, 1023, 1.0f, (bf16*)((char*)Wb + W_AT_IN + j_ * W_AT_IN_SZ), RowId(), scr_, it, (it + (nworkers_) < I_AI) ? it + (nworkers_) : -1, lane_); } \
        else if ((kind_) == 3) { const float li_ = 0.8f - 0.6f * expf(-0.3f * (float)(2 * j_ + 1)); \
            for (int it = (worker_); it < I_AO; it += 2 * (nworkers_)) transpose_item<false>(a_ow + (size_t)j_ * D * D, D, D, a_sg + j_ * 128, 127, 1.0f - li_, (bf16*)((char*)Wb + W_AT_OUT + j_ * W_AT_OUT_SZ), RowId(), scr_, it, (it + (nworkers_) < I_AO) ? it + (nworkers_) : -1, lane_); } \
        else if ((kind_) == 4) { for (int it = (worker_); it < I_UP; it += 2 * (nworkers_)) transpose_item<(RES_F16 != 0)>(f_uw + (size_t)j_ * D * 2 * DFF, D, 2 * DFF, nfg + j_ * D, 1023, 1.0f, (bf16*)((char*)Wb + W_UP + j_ * W_UP_SZ), RowUp(), scr_, it, (it + (nworkers_) < I_UP) ? it + (nworkers_) : -1, lane_); } \
        else { for (int it = (worker_); it < I_DN; it += 2 * (nworkers_)) transpose_item<false>(f_dw + (size_t)j_ * DFF * D, DFF, D, nullptr, 0, 1.0f, (bf16*)((char*)Wb + W_DOWN + j_ * W_DOWN_SZ), RowId(), scr_, it, (it + (nworkers_) < I_DN) ? it + (nworkers_) : -1, lane_); } \
    } while (0)
#define RUN_FILL(fid_, nwg_, part_) do { const int idle0_ = (nwg_) % G; if (bx >= idle0_ && idle0_ > 0) { \
        const int wk_ = (bx - idle0_) * NWAVES + wave_s, nwk_ = (G - idle0_) * NWAVES; \
          \
          \
        unsigned long long code_ = (part_) == 0 ? ((fid_) == 0 ? 0xff1040ull : (fid_) == 1 ? 0xff20ull : (fid_) == 2 ? 0xff1151ull : (fid_) == 3 ? 0xff42ull : (fid_) == 4 ? 0xff21ull : 0xffull) \
                                                : ((fid_) == 0 ? 0xff50ull : (fid_) == 1 ? 0xff3041ull : (fid_) == 2 ? 0xff01ull : (fid_) == 3 ? 0xff52ull : (fid_) == 4 ? 0xff3143ull : 0xff53ull); \
        for (;;) { const int e_ = (int)(code_ & 0xffu); if (e_ == 0xff) break; code_ >>= 8; CONV_MATRIX(e_ >> 4, e_ & 15, wk_, nwk_); } } } while (0)
    const int lo = args.ph_lo, hi = args.ph_hi;
    int phase = 0;
#define IN_PHASE() (phase >= lo && phase < hi)
#define END_PHASE(ty) do { if (IN_PHASE() && phase + 1 < hi) GRID_BAR(); ++phase; } while (0)
#ifndef PROBE_EPI_MODE
#define PROBE_EPI_MODE 0
#endif
#ifdef PROBE_DUP
#define REP_BEGIN(ty) _Pragma("unroll") for (int rep_ = ((ty) == PROBE_DUP ? 0 : 1); rep_ < 2; ++rep_) { const int dry = (rep_ == 0);
#define REP_END() if (dry) GRID_BAR(); }
#else
#define REP_BEGIN(ty) { const int dry = 0;
#define REP_END() }
#endif

    if (IN_PHASE()) { REP_BEGIN(0)
        int tid = wave_s * 64 + HW_LANE(); asm volatile("" : "+v"(tid));
        const int lane = tid & 63, wave = wave_s;
        LAS float* scr = (LAS float*)(lds + wave * 16384);
        const int gw = vcu * NWAVES + wave, NGW = G * NWAVES;
        CONV_MATRIX(0, 0, gw, NGW);
        { unsigned z_ = 0u; asm volatile("" : "+v"(z_));
          v4u* p = (v4u*)(ws + WS_XB); for (int i = vcu * 512 + tid; i < (int)(XB_PAD_FRONT / 16); i += G * 512) p[i] = (v4u){z_, z_, z_, z_};
          v4u* q = (v4u*)((char*)XB + (size_t)M * D * 2); for (int i = vcu * 512 + tid; i < 256 * D * 2 / 16; i += G * 512) q[i] = (v4u){z_, z_, z_, z_}; }
        for (int m = gw; m < M; m += NGW) {
            const f32x4* xr = (const f32x4*)(x_in + (size_t)m * D) + lane; float s = 0.f;
            unsigned long long* o8 = (unsigned long long*)(XB + (size_t)m * D) + lane;
#pragma unroll
            for (int j = 0; j < 4; ++j) { const f32x4 v = __builtin_nontemporal_load(xr + 64 * j);     s += (v[0] * v[0] + v[1] * v[1]) + (v[2] * v[2] + v[3] * v[3]); o8[64 * j] = (unsigned long long)pk2x<(RES_F16 != 0)>(v[0], v[1]) | ((unsigned long long)pk2x<(RES_F16 != 0)>(v[2], v[3]) << 32); }
            s = wave_sum(s);
            if (lane < 4) SSQ[(size_t)m * 4 + lane] = (lane == 0) ? s : 0.f;
            if (lane >= 16 && lane < 32) { const int i = lane & 7; const float invf = powf(500000.0f, -(float)(2 * i) / 16.0f); const float ang = (float)pos[m] * invf; ROPE[(size_t)m * 16 + (lane - 16)] = (lane < 24) ? cosf(ang) : sinf(ang); }
        }
        for (int i = vcu * 512 + tid; i < 2 * SSD_NP; i += G * 512) {
            const int j = i / SSD_NP, c = i % SSD_NP; float pb = 0.f, p0 = 0.f, p1 = 0.f, p2 = 0.f, p3 = 0.f;
            if (c < 2048) p3 = 1.f;
            else if (c < 5120) { const int ch = c - 2048; const float* w = s_cw + (size_t)j * 4 * 3072; pb = s_cb[(size_t)j * 3072 + ch]; p0 = w[ch]; p1 = w[3072 + ch]; p2 = w[2 * 3072 + ch]; p3 = w[3 * 3072 + ch]; }
            else if (c < 5152) { pb = s_dtb[j * 32 + (c - 5120)]; p3 = 1.f; }
            float* t = CPT + (size_t)j * 5 * SSD_NP; t[c] = pb; t[SSD_NP + c] = p0; t[2 * SSD_NP + c] = p1; t[3 * SSD_NP + c] = p2; t[4 * SSD_NP + c] = p3;
        }
        if (bx == 0 && wave == 0) {
            for (int j = 0; j < 2; ++j) {
                float mq = fabsf(a_qg[j * 64 + lane]), mkk = fabsf(a_kg[j * 64 + lane]);
                float d1 = a_lq1[j * 64 + lane] * a_lk1[j * 64 + lane], d2 = a_lq2[j * 64 + lane] * a_lk2[j * 64 + lane];
                mq = xl_max64(mq); mkk = xl_max64(mkk); d1 = xl_sum64(d1); d2 = xl_sum64(d2);
                const float li = 0.8f - 0.6f * expf(-0.3f * (float)(2 * j + 1));
                if (lane == 0) { cst[j] = mq * mkk * 64.0f * 0.125f * 1.4426950408889634f * 1.002f + 0.01f; cst[2 + j] = expf(d1) - expf(d2) + li; }
            }
        }
    REP_END() }
    END_PHASE(0);

    for (int layer = 0; layer < 4; ++layer) {
        const int j = layer >> 1;
        if ((layer & 1) == 0) {
            if (IN_PHASE()) { REP_BEGIN(1)
#ifdef PROBE_PLAIN_SSDIN
                if (dry) {
                    pg8::Gemm g0{XB, (const bf16*)((const char*)Wb + W_SSD_IN + j * W_SSD_IN_SZ), D, D, 256, 0};
                    pg8::StaticOrder S0; S0.init(64, 20, G, bx);
                    epi::EpiSsdIn E0{BIG, DT, s_dtb + j * 32, SSQ};
                    pg8::gemm_phase(lds, lds + EPI_OFF, g0, S0, E0, wave_s);
                } else
#endif
                {
                pg8::Gemm g{XB, (const bf16*)((const char*)Wb + W_SSD_IN + j * W_SSD_IN_SZ), D, D, 253, -3};
                pg8::StaticOrder S; S.init(65, SSD_NP / 256, G, bx);
                epi::EpiSsdConv E{ZPL, XBCPL, DT, SSQ, CPT + (size_t)j * 5 * SSD_NP, dry * PROBE_EPI_MODE};
#ifdef PROBE_NOFILL
                if (!dry || (PROBE_NOFILL & 1) == 0)
#endif
                { RUN_FILL(layer == 0 ? 0 : 3, 65 * (SSD_NP / 256), 0); } __syncthreads();
#ifdef PROBE_FILLONLY
                if (!dry)
#endif
                pg8::gemm_phase(lds, lds + EPI_OFF, g, S, E, wave_s);
#ifdef PROBE_NOFILL
                if (!dry || (PROBE_NOFILL & 2) == 0)
#endif
                { RUN_FILL(layer == 0 ? 0 : 3, 65 * (SSD_NP / 256), 1); }
                }
            REP_END() }
            END_PHASE(1);
            if (IN_PHASE()) { REP_BEGIN(2)
                scan::Params sp{XBCPL, ZPL, DT, s_alog + j * 32, s_d + j * 32, SSQP, dry};
                for (int u = vcu; u < NB * 32; u += G) scan::unit(sp, u >> 5, u & 31, (LAS char*)lds, wave_s);
            REP_END() }
            END_PHASE(2);
            if (IN_PHASE()) { REP_BEGIN(4)
                pg8::Gemm g{ZPL, (const bf16*)((const char*)Wb + W_SSD_OUT + j * W_SSD_OUT_SZ), SSD_DI, SSD_DI, 256, 0};
                pg8::StaticOrder S; S.init(M / 256, D / 256, G, bx);
                if (layer == 0) { epi::EpiResidualG<1> E{x_in, XB, XLO, SSQ, SSQP, dry}; pg8::gemm_phase(lds, lds + EPI_OFF, g, S, E, wave_s); }
                else { epi::EpiResidualG<0> E{nullptr, XB, XLO, SSQ, SSQP, dry}; pg8::gemm_phase(lds, lds + EPI_OFF, g, S, E, wave_s); }
            REP_END() }
            END_PHASE(4);
        } else {
            if (IN_PHASE()) { REP_BEGIN(5)
                pg8::Gemm g{XB, (const bf16*)((const char*)Wb + W_AT_IN + j * W_AT_IN_SZ), D, D, 256, 0};
                pg8::StaticOrder S; S.init(M / 256, AT_IN / 256, G, bx);
                epi::EpiQKV E{BIG, SSQ, a_qg + j * 64, a_kg + j * 64, ROPE};
                pg8::gemm_phase(lds, lds + EPI_OFF, g, S, E, wave_s);
            REP_END() }
            END_PHASE(5);
            if (IN_PHASE()) { REP_BEGIN(6)
                attn::Params ap{BIG, cst[j], cst[2 + j], dry};
                for (int pi = vcu; pi < 512; pi += G) {
                    const int bh = pi >> 3, s = pi & 7;
#ifdef PROBE_ATT_MODE
                    if (dry) { attn::unit<PROBE_ATT_MODE>(ap, bh >> 3, bh & 7, s, (LAS char*)lds, wave_s); attn::unit<PROBE_ATT_MODE>(ap, bh >> 3, bh & 7, 15 - s, (LAS char*)lds, wave_s); } else
#endif
                    { attn::unit(ap, bh >> 3, bh & 7, s, (LAS char*)lds, wave_s);
                      attn::unit(ap, bh >> 3, bh & 7, 15 - s, (LAS char*)lds, wave_s); }
                }
            REP_END() }
            END_PHASE(6);
            if (IN_PHASE()) { REP_BEGIN(7)
                pg8::Gemm g{BIG, (const bf16*)((const char*)Wb + W_AT_OUT + j * W_AT_OUT_SZ), AT_IN, D, 256, 0};
                pg8::StaticOrder S; S.init(M / 256, D / 256, G, bx);
                epi::EpiResidual<0> E{nullptr, nullptr, XB, XLO, SSQ, dry};
                pg8::gemm_phase(lds, lds + EPI_OFF, g, S, E, wave_s);
            REP_END() }
            END_PHASE(7);
        }
        if (IN_PHASE()) { REP_BEGIN(8)
            pg8::Gemm g{XB, (const bf16*)((const char*)Wb + W_UP + layer * W_UP_SZ), D, D, 254, -2};
            pg8::StaticOrder S; S.init(65, 2 * DFF / 256, G, bx);
            epi::EpiConvGate E{BIG, SSQ, f_cw + (size_t)layer * 3 * 2 * DFF, f_cb + (size_t)layer * 2 * DFF, dry * PROBE_EPI_MODE};
            { RUN_FILL(layer == 0 ? 1 : (layer == 1 ? 2 : (layer == 2 ? 4 : 5)), 65 * (2 * DFF / 256), 0); __syncthreads(); }
            pg8::gemm_phase(lds, lds + EPI_OFF, g, S, E, wave_s);
            RUN_FILL(layer == 0 ? 1 : (layer == 1 ? 2 : (layer == 2 ? 4 : 5)), 65 * (2 * DFF / 256), 1);
        REP_END() }
        END_PHASE(8);
        if (IN_PHASE()) { REP_BEGIN(9)
            pg8::Gemm g{BIG, (const bf16*)((const char*)Wb + W_DOWN + layer * W_DOWN_SZ), DFF, DFF, 256, 0};
            pg8::StaticOrder S; S.init(M / 256, D / 256, G, bx);
            if (layer == 3) { epi::EpiResidual<2> E{nullptr, xout, XB, XLO, SSQ, dry}; pg8::gemm_phase(lds, lds + EPI_OFF, g, S, E, wave_s); }
            else { epi::EpiResidual<0> E{nullptr, nullptr, XB, XLO, SSQ, dry}; pg8::gemm_phase(lds, lds + EPI_OFF, g, S, E, wave_s); }
        REP_END() }
        END_PHASE(9);
    }
#ifdef PROBE_EXTRA_BARS
    for (int i_ = 0; i_ < PROBE_EXTRA_BARS; ++i_) GRID_BAR();
#endif
}
#undef CONV_MATRIX
#undef RUN_FILL
#undef x_in
#undef pos
#undef nmg
#undef nfg
#undef s_inw
#undef s_cw
#undef s_cb
#undef s_dtb
#undef s_alog
#undef s_d
#undef s_ng
#undef s_ow
#undef a_inw
#undef a_qg
#undef a_kg
#undef a_lq1
#undef a_lk1
#undef a_lq2
#undef a_lk2
#undef a_sg
#undef a_ow
#undef f_uw
#undef f_cw
#undef f_cb
#undef f_dw
#undef xout
#undef ws
#undef cst
#undef SSQ
#undef ROPE
#undef DT
#undef SSQP
#undef Wb
#undef XB
#undef BIG
#undef XLO
#undef CPT
#undef ZPL
#undef XBCPL
#undef ARGP
constexpr int N_PHASES = 1 + 2 * 5 + 2 * 5;

static int g_grid = 0;
static void launch(void* const* d_in, float* d_out, void* d_ws, int ph_lo, int ph_hi, hipStream_t stream) {
    if (g_grid == 0) {
        int dev = 0, cus = 0;
        if (hipGetDevice(&dev) != hipSuccess || hipDeviceGetAttribute(&cus, hipDeviceAttributeMultiprocessorCount, dev) != hipSuccess) { fprintf(stderr, "device query failed\n"); g_grid = -1; return; }
        if (hipFuncSetAttribute((const void*)mega_fwd, hipFuncAttributeMaxDynamicSharedMemorySize, LDS_BYTES) != hipSuccess) { fprintf(stderr, "hipFuncSetAttribute failed\n"); g_grid = -1; return; }
        int per_cu = 0;
        (void)hipOccupancyMaxActiveBlocksPerMultiprocessor(&per_cu, (const void*)mega_fwd, NWAVES * 64, LDS_BYTES);
        (void)hipGetLastError();
        g_grid = cus;
        fprintf(stderr, "mega_fwd: %d CUs, occupancy query %d per CU\n", cus, per_cu);
    }
    if (g_grid < 0) return;
    (void)hipMemsetAsync((char*)d_ws + WS_CTL, 0, CTL_ZERO_BYTES, stream);
    Args a{};
    for (int i = 0; i < 25; ++i) a.in[i] = d_in[i];
    a.out = d_out; a.ws = (unsigned char*)d_ws; a.ph_lo = ph_lo; a.ph_hi = ph_hi;
    void* params[] = {&a};
    hipError_t e = hipLaunchCooperativeKernel((const void*)mega_fwd, dim3(g_grid), dim3(NWAVES * 64), params, LDS_BYTES, stream);
    if (e != hipSuccess) fprintf(stderr, "cooperative launch failed: %s (grid %d)\n", hipGetErrorString(e), g_grid);
}
}
extern "C" void kernel_launch(void* const* d_in, const int* in_sizes, int n_in, void* d_out, int out_size, void* d_ws, size_t ws_size, hipStream_t stream) {
    (void)in_sizes; (void)n_in; (void)out_size; (void)ws_size;
    mk::launch(d_in, (float*)d_out, d_ws, 0, mk::N_PHASES, stream);
}
```
